# Optimizing an MI355X kernel written in HIP

```python
import jax, jax.numpy as jnp
from jax import lax
import numpy as np

D_MODEL = 2048
BATCH = 1
SEQ = 16384
DEPTH = 2

GRID_W = 64
EPS = 1e-6
ATT_HEADS = 8
ATT_KV_HEADS = 2
ATT_HEAD_DIM = D_MODEL // 16
ROPE_THETA = 10000.0
Q_BLOCK = 128
ML_HEADS = 4
ML_HEAD_DIM = D_MODEL // 8
ML_CHUNK = 128
CONV_W = 5
POOL_WINDOWS = (2, 4, 8, 16)
POOL_GROUPS = 4
POOL_DIM = D_MODEL // POOL_GROUPS
PEER_HEADS = 8
PEER_NKEYS = 128
PEER_EXPERTS = PEER_NKEYS * PEER_NKEYS
PEER_TOPK = 16
PEER_DKEY = 256
PEER_BLOCK = 128

N_EVEN = (DEPTH + 1) // 2
N_ODD = DEPTH // 2

ATT_Q = ATT_HEADS * ATT_HEAD_DIM
ATT_KV = ATT_KV_HEADS * ATT_HEAD_DIM
ML_W = ML_HEADS * ML_HEAD_DIM
N_GATE_COLS = 4 * ML_HEADS
MIX_W = ATT_Q + ML_W
IN_SPLITS = [ATT_Q, ATT_Q + ATT_KV, ATT_Q + 2 * ATT_KV, ATT_Q + 2 * ATT_KV + 2 * ML_W,
             ATT_Q + 2 * ATT_KV + 3 * ML_W, ATT_Q + 2 * ATT_KV + 4 * ML_W]
IN_WIDTH = ATT_Q + 2 * ATT_KV + 4 * ML_W + N_GATE_COLS

kernel_name = 'hybrid_gqa_mlstm_pool_peer_encoder'


def rmsnorm(x, g):
    xf = x.astype(jnp.float32)
    y = xf * lax.rsqrt(jnp.mean(xf * xf, axis=-1, keepdims=True) + EPS)
    return (y * g.astype(jnp.float32)).astype(x.dtype)


def axial_rope_tables(seq):
    rows = seq // GRID_W
    r, c = jnp.meshgrid(jnp.arange(rows), jnp.arange(GRID_W), indexing='ij')
    pos = jnp.stack([r.reshape(-1), c.reshape(-1)], axis=-1).astype(jnp.float32)
    nf = ATT_HEAD_DIM // 4
    inv = ROPE_THETA ** (-jnp.arange(nf, dtype=jnp.float32) / nf)
    ang = pos[:, :, None] * inv
    return jnp.cos(ang), jnp.sin(ang)


def apply_rope(x, cos, sin):
    b, h, s, d = x.shape
    xr = x.reshape(b, h, s, 2, 2, d // 4)
    x1, x2 = xr[..., 0, :], xr[..., 1, :]
    c, sn = cos.astype(x.dtype), sin.astype(x.dtype)
    out = jnp.stack([x1 * c - x2 * sn, x2 * c + x1 * sn], axis=-2)
    return out.reshape(b, h, s, d)


def gqa_attention(q, k, v):
    b, hq, s, d = q.shape
    g = hq // ATT_KV_HEADS
    nb = s // Q_BLOCK
    qb = q.reshape(b, ATT_KV_HEADS, g, nb, Q_BLOCK, d).transpose(3, 0, 1, 2, 4, 5)
    scale = d ** -0.5

    def block(qi):
        sc = jnp.einsum('bkgqd,bksd->bkgqs', qi, k).astype(jnp.float32) * scale
        p = jax.nn.softmax(sc, axis=-1).astype(v.dtype)
        return jnp.einsum('bkgqs,bksd->bkgqd', p, v)

    o = lax.map(block, qb)
    return o.transpose(1, 0, 4, 2, 3, 5).reshape(b, s, hq * d)


def centred_dwconv(x, w):
    s = x.shape[1]
    p = CONV_W // 2
    xp = jnp.pad(x, ((0, 0), (p, p), (0, 0)))
    return sum(xp[:, j:j + s] * w[j] for j in range(CONV_W))


def mlstm_chunkwise(q, k, v, i_pre, logf):
    b, h, s, d = q.shape
    L = ML_CHUNK
    nc = s // L
    q, k, v = (t.reshape(b, h, nc, L, d) for t in (q, k, v))
    i_pre = i_pre.reshape(b, h, nc, L)
    logf = logf.reshape(b, h, nc, L)
    bcum = jnp.cumsum(logf, axis=-1)
    g = bcum[..., -1]
    a = g[..., None] - bcum + i_pre
    a_max = jnp.max(a, axis=-1)
    w = jnp.exp(a - a_max[..., None])
    C_loc = jnp.einsum('bhcl,bhcld,bhcle->bhcde', w, k, v)
    n_loc = jnp.einsum('bhcl,bhcld->bhcd', w, k)

    def step(carry, xs):
        C, n, m = carry
        g_c, am_c, Cl, nl = xs
        m_new = jnp.maximum(g_c + m, am_c)
        dec = jnp.exp(g_c + m - m_new)
        add = jnp.exp(am_c - m_new)
        C_new = dec[..., None, None] * C + add[..., None, None] * Cl
        n_new = dec[..., None] * n + add[..., None] * nl
        return (C_new, n_new, m_new), (C, n, m)

    init = (jnp.zeros((b, h, d, d), jnp.float32), jnp.zeros((b, h, d), jnp.float32),
            jnp.zeros((b, h), jnp.float32))
    xs = (jnp.moveaxis(g, 2, 0), jnp.moveaxis(a_max, 2, 0),
          jnp.moveaxis(C_loc, 2, 0), jnp.moveaxis(n_loc, 2, 0))
    _, (C_prev, n_prev, m_prev) = lax.scan(step, init, xs)
    C_prev = jnp.moveaxis(C_prev, 0, 2)
    n_prev = jnp.moveaxis(n_prev, 0, 2)
    m_prev = jnp.moveaxis(m_prev, 0, 2)

    lower = jnp.tril(jnp.ones((L, L), bool))
    Dlog = bcum[..., :, None] - bcum[..., None, :] + i_pre[..., None, :]
    Dlog = jnp.where(lower, Dlog, -jnp.inf)
    inter_log = bcum + m_prev[..., None]
    m_j = jnp.maximum(inter_log, jnp.max(Dlog, axis=-1))
    Sqk = jnp.einsum('bhcjd,bhcrd->bhcjr', q, k) * jnp.exp(Dlog - m_j[..., None])
    inter_w = jnp.exp(inter_log - m_j)
    num = (inter_w[..., None] * jnp.einsum('bhcjd,bhcde->bhcje', q, C_prev)
           + jnp.einsum('bhcjr,bhcre->bhcje', Sqk, v))
    den = inter_w * jnp.einsum('bhcjd,bhcd->bhcj', q, n_prev) + jnp.sum(Sqk, axis=-1)
    out = num / jnp.maximum(jnp.abs(den), jnp.exp(-m_j))[..., None]
    return out.reshape(b, h, s, d)


def mlstm_bidir(q, k, v, i_f, f_f, i_b, f_b):
    h_fwd = mlstm_chunkwise(q, k, v, i_f, jax.nn.log_sigmoid(f_f))
    rev = lambda t: jnp.flip(t, axis=2)
    h_bwd = rev(mlstm_chunkwise(rev(q), rev(k), rev(v), rev(i_b), jax.nn.log_sigmoid(rev(f_b))))
    return h_fwd + h_bwd


def attn_mlstm_mixer(xn, w_in, b_gate, conv_w, q_gain, k_gain, ml_gain, w_out):
    b, s, _ = xn.shape
    f32 = jnp.float32
    proj = xn @ w_in
    aq, ak, av, mqk, mv, mo, gates = jnp.split(proj, IN_SPLITS, axis=-1)
    heads = lambda t, nh: t.reshape(b, s, nh, -1).transpose(0, 2, 1, 3)

    cos, sin = axial_rope_tables(s)
    q = apply_rope(rmsnorm(heads(aq, ATT_HEADS), q_gain), cos, sin)
    k = apply_rope(rmsnorm(heads(ak, ATT_KV_HEADS), k_gain), cos, sin)
    v = heads(av, ATT_KV_HEADS)
    y_att = gqa_attention(q, k, v)

    mqk = jax.nn.silu(centred_dwconv(mqk, conv_w))
    mq, mk = jnp.split(mqk, 2, axis=-1)
    mq = heads(mq, ML_HEADS).astype(f32)
    mk = heads(mk, ML_HEADS).astype(f32) * (ML_HEAD_DIM ** -0.5)
    mvh = heads(mv, ML_HEADS).astype(f32)
    gates = (gates + b_gate).astype(f32).transpose(0, 2, 1)
    i_f, f_f, i_b, f_b = jnp.split(gates, 4, axis=1)
    hm = mlstm_bidir(mq, mk, mvh, i_f, f_f, i_b, f_b)
    hm = rmsnorm(hm, ml_gain.reshape(ML_HEADS, 1, ML_HEAD_DIM))
    hm = hm.transpose(0, 2, 1, 3).reshape(b, s, ML_W)
    y_ml = (hm * jax.nn.sigmoid(mo.astype(f32))).astype(xn.dtype)

    return jnp.concatenate([y_att, y_ml], axis=-1) @ w_out


def multiscale_pool_mixer(xn, pool_w, layer_scale):
    b, s, d = xn.shape
    xf = xn.astype(jnp.float32)
    cs = jnp.concatenate([jnp.zeros((b, 1, d), jnp.float32), jnp.cumsum(xf, axis=1)], axis=1)
    cs = cs.reshape(b, s + 1, POOL_GROUPS, POOL_DIM)
    t = jnp.arange(s)[:, None]
    half = jnp.array([w // 2 for w in POOL_WINDOWS], jnp.int32)[None, :]
    lo = jnp.clip(t - half, 0, s)
    hi = jnp.clip(t + half, 0, s)
    grp = jnp.arange(POOL_GROUPS)[None, :]
    win_sum = cs[:, hi, grp] - cs[:, lo, grp]
    count = (hi - lo).astype(jnp.float32)[..., None]
    pooled = win_sum / count - xf.reshape(b, s, POOL_GROUPS, POOL_DIM)
    y = jnp.einsum('bsgc,gcd->bsgd', pooled.astype(xn.dtype), pool_w).reshape(b, s, d)
    return y * layer_scale


def peer_ffn(xn, w_query, sub_keys, u, v):
    b, s, d = xn.shape
    K = PEER_TOPK
    q = (xn @ w_query).reshape(b, s, PEER_HEADS, 2, PEER_DKEY // 2)
    sc = jnp.einsum('bshpc,hpnc->bshpn', q, sub_keys).astype(jnp.float32)
    s_top, i_top = lax.top_k(sc, K)
    cand = (s_top[..., 0, :, None] + s_top[..., 1, None, :]).reshape(b, s, PEER_HEADS, K * K)
    cand_idx = (i_top[..., 0, :, None] * PEER_NKEYS + i_top[..., 1, None, :]).reshape(b, s, PEER_HEADS, K * K)
    best, pos = lax.top_k(cand, K)
    expert = jnp.take_along_axis(cand_idx, pos, axis=-1)
    gate = jax.nn.softmax(best, axis=-1).astype(xn.dtype)
    nb = (b * s) // PEER_BLOCK
    xs = (xn.reshape(nb, PEER_BLOCK, d),
          expert.reshape(nb, PEER_BLOCK, PEER_HEADS * K),
          gate.reshape(nb, PEER_BLOCK, PEER_HEADS * K))

    def block(args):
        xt, e, g = args
        act = jax.nn.gelu(jnp.einsum('tkd,td->tk', u[e], xt), approximate=False)
        return jnp.einsum('tk,tkd->td', g * act, v[e])

    return lax.map(block, xs).reshape(b, s, d)


def setup_inputs(seed: int = 0) -> dict:
    key = jax.random.key(seed)
    ks = jax.random.split(key, 20)
    f32 = jnp.float32
    nrm = lambda k, shape, scale: jax.random.normal(k, shape, f32) * scale
    gain = lambda k, shape: 1.0 + 0.02 * jax.random.normal(k, shape, f32)
    f_bias = jnp.linspace(3.0, 6.0, ML_HEADS, dtype=f32)
    zeros_h = jnp.zeros((ML_HEADS,), f32)
    gate_base = jnp.concatenate([zeros_h, f_bias, zeros_h, f_bias])
    return {
        'x': nrm(ks[0], (BATCH, SEQ, D_MODEL), 1.0),
        'norm_mix_g': gain(ks[1], (DEPTH, D_MODEL)),
        'norm_ffn_g': gain(ks[2], (DEPTH, D_MODEL)),
        'w_in': nrm(ks[3], (N_EVEN, D_MODEL, IN_WIDTH), D_MODEL ** -0.5),
        'b_gate': gate_base[None, :] + nrm(ks[4], (N_EVEN, N_GATE_COLS), 0.1),
        'conv_w': nrm(ks[5], (N_EVEN, CONV_W, 2 * ML_W), CONV_W ** -0.5),
        'q_gain': gain(ks[6], (N_EVEN, ATT_HEAD_DIM)),
        'k_gain': gain(ks[7], (N_EVEN, ATT_HEAD_DIM)),
        'ml_gain': gain(ks[8], (N_EVEN, ML_W)),
        'w_out': nrm(ks[9], (N_EVEN, MIX_W, D_MODEL), MIX_W ** -0.5),
        'pool_w': nrm(ks[10], (N_ODD, POOL_GROUPS, POOL_DIM, POOL_DIM), POOL_DIM ** -0.5),
        'layer_scale': gain(ks[11], (N_ODD, D_MODEL)),
        'peer_wq': nrm(ks[12], (DEPTH, D_MODEL, PEER_HEADS * PEER_DKEY), D_MODEL ** -0.5),
        'peer_keys': nrm(ks[13], (DEPTH, PEER_HEADS, 2, PEER_NKEYS, PEER_DKEY // 2), (PEER_DKEY // 2) ** -0.5),
        'peer_u': nrm(ks[14], (DEPTH, PEER_EXPERTS, D_MODEL), D_MODEL ** -0.5),
        'peer_v': nrm(ks[15], (DEPTH, PEER_EXPERTS, D_MODEL), PEER_HEADS ** -0.5),
        'norm_f': gain(ks[16], (D_MODEL,)),
    }


def reference(x, norm_mix_g, norm_ffn_g, w_in, b_gate, conv_w, q_gain, k_gain, ml_gain,
              w_out, pool_w, layer_scale, peer_wq, peer_keys, peer_u, peer_v, norm_f):
    h = x
    for layer in range(DEPTH):
        hn = rmsnorm(h, norm_mix_g[layer])
        if layer % 2 == 0:
            e = layer // 2
            h = h + attn_mlstm_mixer(hn, w_in[e], b_gate[e], conv_w[e], q_gain[e], k_gain[e],
                                     ml_gain[e], w_out[e])
        else:
            o = layer // 2
            h = h + multiscale_pool_mixer(hn, pool_w[o], layer_scale[o])
        h = h + peer_ffn(rmsnorm(h, norm_ffn_g[layer]), peer_wq[layer], peer_keys[layer],
                         peer_u[layer], peer_v[layer])
    return rmsnorm(h, norm_f)
```

```cpp
#include <hip/hip_runtime.h>
#include <hip/hip_bf16.h>
#include <cstdio>
#include <cstdint>
#include <cmath>

constexpr int S = 16384, DM = 2048, NWAVES = 8, NTHR = 512;
constexpr int INW = 5648, INP = 5888;
constexpr int C_AQ = 0, C_AK = 1024, C_AV = 1280, C_MQK = 1536, C_MV = 3584, C_MO = 4608, C_GATE = 5632;
constexpr float EPS = 1e-6f;
constexpr int NPH = 18;
enum { PH_PRO = 0, PH_GEMM_IN, PH_POST, PH_ATTN, PH_MLA, PH_SCAN, PH_MLB, PH_GEMM_OUT, PH_NORM0, PH_GEMM_Q0, PH_TOPK0, PH_GATHER0,
       PH_POOLPREP, PH_GEMM_POOL, PH_NORM1, PH_GEMM_Q1, PH_TOPK1, PH_GATHER1 };

constexpr size_t MiB = 1u << 20;
constexpr size_t WS_CTL = 0, CTL_ZERO_BYTES = 1 * MiB;
constexpr size_t WS_WIN = 1 * MiB, WS_WOUT = 24 * MiB, WS_WQ0 = 32 * MiB, WS_WQ1 = 40 * MiB, WS_WPOOL = 48 * MiB, WS_KEYS = 50 * MiB;
constexpr size_t WS_GATES = 51 * MiB, WS_NST = 53 * MiB, WS_EIDX = 54 * MiB, WS_EGATE = 62 * MiB;
constexpr size_t WS_UB = 70 * MiB, WS_VB = 198 * MiB, WS_XN = 326 * MiB, WS_PROJ = 390 * MiB, WS_QP = WS_PROJ;
constexpr size_t WS_QB = 574 * MiB, WS_KVB = 606 * MiB, WS_MQ = 622 * MiB, WS_MK = 654 * MiB, WS_CST = 686 * MiB, WS_Y = 814 * MiB, WS_POOLED = WS_Y;
constexpr size_t WS_H = 878 * MiB, WS_END = 1006 * MiB;
constexpr int CW_BAR = 4096;
constexpr size_t GO_B = 0, GO_U = 8 * S * 4, GO_PM = 2 * 8 * S * 4, GO_G = 3 * 8 * S * 4, GO_PML = GO_G + 4096, GO_MPREV = GO_PML + 4096;

constexpr int LDS_BYTES = 147456, LDSCTL_OFF = 146944;

#define GAS __attribute__((address_space(1)))
#define LAS __attribute__((address_space(3)))
typedef unsigned short bf16_t;
typedef short bf16x8 __attribute__((ext_vector_type(8)));
typedef short s16x4 __attribute__((ext_vector_type(4)));
typedef short v4i16_t __attribute__((ext_vector_type(4)));
typedef float f32x4 __attribute__((ext_vector_type(4)));
typedef float f32x2 __attribute__((ext_vector_type(2)));
typedef float f32x16 __attribute__((ext_vector_type(16)));
typedef unsigned u32x4 __attribute__((ext_vector_type(4)));
typedef unsigned u32x2 __attribute__((ext_vector_type(2)));
typedef __bf16 bf16x2_t __attribute__((ext_vector_type(2)));
typedef GAS unsigned gu32;
#define RLX_AGENT __ATOMIC_RELAXED, __HIP_MEMORY_SCOPE_AGENT
#define LDS_WAIT() asm volatile("s_waitcnt lgkmcnt(0)" ::: "memory")
__device__ __forceinline__ unsigned f2bf(float f) { unsigned u = __builtin_bit_cast(unsigned, f); return (u + 0x7fffu + ((u >> 16) & 1u)) >> 16; }
__device__ __forceinline__ unsigned pk2(float lo, float hi) { f32x2 v = {lo, hi}; bf16x2_t b = __builtin_convertvector(v, bf16x2_t); return __builtin_bit_cast(unsigned, b); }
__device__ __forceinline__ float bflo(unsigned w) { return __builtin_bit_cast(float, w << 16); }
__device__ __forceinline__ float bfhi(unsigned w) { return __builtin_bit_cast(float, w & 0xffff0000u); }
__device__ __forceinline__ float wave_sum(float v) {
#pragma unroll
    for (int o = 1; o < 64; o <<= 1) v += __shfl_xor(v, o);
    return v;
}

namespace pg8 {
#define PG8_LAS __attribute__((address_space(3)))
typedef unsigned short bf16_t;
typedef short bf16x8 __attribute__((ext_vector_type(8)));
typedef float f32x4 __attribute__((ext_vector_type(4)));
typedef unsigned u32x4 __attribute__((ext_vector_type(4)));
constexpr int BM = 256, BK = 64, HALF = 128, HTB = HALF * BK * 2  , STAGE_BYTES = 8 * HTB, NXCD = 8, WGM = 8;

__host__ __device__ __forceinline__ int lds_byte(int r, int c) { const int st = (r >> 4) * 2 + (c >> 5), rr = r & 15, cc = c & 31, ob = rr * 64 + cc * 2; return st * 1024 + (ob ^ (((ob >> 9) & 1) << 5)); }
__host__ __device__ __forceinline__ void stage_rc(int b, int& R, int& C) { const int st = b / 1024, sb = b % 1024, swz = sb ^ (((sb >> 9) & 1) << 5); R = (st >> 1) * 16 + swz / 64; C = (st & 1) * 32 + (swz % 64) / 2; }
__host__ __device__ __forceinline__ int perm32(int rho) { const int n = rho >> 4, i = rho & 15; return 8 * (i >> 2) + 4 * n + (i & 3); }

struct Unit { int pm, pn; };
struct Gemm { const bf16_t* A; const bf16_t* Bt; int M, N, K, lda, ldb, agrp_shift; size_t agrp_bytes; };

struct StaticOrder {
    int nM, nN, nwg, G, c;
    __host__ __device__ void init(int M, int N, int G_, int c_) { nM = M / BM; nN = N / BM; nwg = nM * nN; G = G_; c = c_; }
    __host__ __device__ bool next(int i, Unit& u) const {
        const long L = (long)i * G + c; if (L >= nwg) return false;
        int wgid = (int)L; { const int q = nwg / NXCD, r = nwg % NXCD, xcd = wgid % NXCD, off = wgid / NXCD; wgid = (xcd < r ? xcd * (q + 1) : r * (q + 1) + (xcd - r) * q) + off; }
        const int nig = WGM * nN, gid = wgid / nig, fm = gid * WGM, gsz = (nM - fm) < WGM ? (nM - fm) : WGM;
        u.pm = fm + ((wgid % nig) % gsz); u.pn = (wgid % nig) / gsz; return true;
    }
    __device__ __forceinline__ void a_ready(const Unit&) const {}
    __device__ __forceinline__ void done(const Unit&) const {}
};

__device__ __forceinline__ unsigned cvt_pk_bf16(float lo, float hi) { unsigned r; asm volatile("v_cvt_pk_bf16_f32 %0, %1, %2" : "=v"(r) : "v"(lo), "v"(hi)); return r; }
typedef float f32x2 __attribute__((ext_vector_type(2)));
__device__ __forceinline__ f32x2 gelu_pk(f32x2 v) {
    const f32x2 av = __builtin_elementwise_abs(v), d = av * 0.2316418882f + 1.0f;
    f32x2 t; t.x = __builtin_amdgcn_rcpf(d.x); t.y = __builtin_amdgcn_rcpf(d.y);
    f32x2 q = t * 0.5307027145f + (-0.7265760135f); q = q * t + 0.7107068705f; q = q * t + (-0.142248368f); q = q * t + 0.127414796f; q = q * t;
    const f32x2 s = (v * v) * (-0.72134752044f);
    f32x2 e; e.x = __builtin_amdgcn_exp2f(s.x); e.y = __builtin_amdgcn_exp2f(s.y);
    const f32x2 m = v * (q * e), r = v - m;
    f32x2 o; o.x = v.x < 0.f ? m.x : r.x; o.y = v.y < 0.f ? m.y : r.y; return o;
}
template <int ACT  > struct EpiBf16 {
    static constexpr bool PERM = true, AFTER_DRAIN = false; static_assert(ACT == 0 || ACT == 1, "EpiBf16: ACT is 0 (none) or 1 (gelu_pk)");
    bf16_t* O; int ldc; const float* bias; int split_cols; size_t split_stride; float scale0;
    __device__ __forceinline__ void operator()(const f32x4 (&acc)[2][2][4][2], const Unit& u, int wr, int wc, int fr, int fq) const {
        const int row0 = u.pm * BM + wr * 64 + fr; int colt = u.pn * BM; bf16_t* base = O;
        float sc = 1.f; if (split_cols) { const int t = colt / split_cols; base += (size_t)t * split_stride; colt -= t * split_cols; if (t == 0) sc = scale0; }
        const int col0 = colt + wc * 32 + 8 * fq, bcol0 = u.pn * BM + wc * 32 + 8 * fq;
        f32x4 bv[2][2];
#pragma unroll
        for (int bj = 0; bj < 2; ++bj)
#pragma unroll
            for (int n = 0; n < 2; ++n) bv[bj][n] = bias ? *(const f32x4*)(bias + bcol0 + bj * HALF + 4 * n) : (f32x4){0.f, 0.f, 0.f, 0.f};
#pragma unroll
        for (int ai = 0; ai < 2; ++ai)
#pragma unroll
            for (int m = 0; m < 4; ++m) { bf16_t* rowp = base + (size_t)(row0 + ai * HALF + m * 16) * ldc + col0;
#pragma unroll
                for (int bj = 0; bj < 2; ++bj) { f32x4 v0 = acc[ai][bj][m][0] + bv[bj][0], v1 = acc[ai][bj][m][1] + bv[bj][1];
                    if (ACT == 1) { f32x2 a = gelu_pk((f32x2){v0[0], v0[1]}), b = gelu_pk((f32x2){v0[2], v0[3]}), c = gelu_pk((f32x2){v1[0], v1[1]}), d = gelu_pk((f32x2){v1[2], v1[3]});
                        v0 = (f32x4){a.x, a.y, b.x, b.y}; v1 = (f32x4){c.x, c.y, d.x, d.y}; }
                    v0 = v0 * sc; v1 = v1 * sc; u32x4 w; w.x = cvt_pk_bf16(v0[0], v0[1]); w.y = cvt_pk_bf16(v0[2], v0[3]); w.z = cvt_pk_bf16(v1[0], v1[1]); w.w = cvt_pk_bf16(v1[2], v1[3]);
                    *(u32x4*)(rowp + bj * HALF) = w; } }
    }
};
struct EpiResF32 {
    static constexpr bool PERM = false, AFTER_DRAIN = false;
    const float* base; float* out; int ldc; const float* colscale;
    __device__ __forceinline__ void operator()(const f32x4 (&acc)[2][2][4][2], const Unit& u, int wr, int wc, int fr, int fq) const {
        const int row0 = u.pm * BM + wr * 64 + fr, col0 = u.pn * BM + wc * 32 + 4 * fq;
        f32x4 cs[2][2];
#pragma unroll
        for (int bj = 0; bj < 2; ++bj)
#pragma unroll
            for (int n = 0; n < 2; ++n) cs[bj][n] = colscale ? *(const f32x4*)(colscale + col0 + bj * HALF + n * 16) : (f32x4){1.f, 1.f, 1.f, 1.f};
#pragma unroll
        for (int ai = 0; ai < 2; ++ai)
#pragma unroll
            for (int m = 0; m < 4; ++m) { const size_t off = (size_t)(row0 + ai * HALF + m * 16) * ldc + col0;
#pragma unroll
                for (int bj = 0; bj < 2; ++bj)
#pragma unroll
                    for (int n = 0; n < 2; ++n) { const f32x4 b = *(const f32x4*)(base + off + bj * HALF + n * 16);
                        *(f32x4*)(out + off + bj * HALF + n * 16) = b + acc[ai][bj][m][n] * cs[bj][n]; }
                asm volatile("" ::: "memory"); }
    }
};

template <class Epi, class Sched, bool ALIGN_EPI = false, bool SP2 = false>
__device__ __forceinline__ void gemm_phase(PG8_LAS unsigned char* lds, const Gemm g, const Sched& S, const Epi& E) {
    int tid_ = threadIdx.x; asm volatile("" : "+v"(tid_));
    const int tid = tid_, wid = __builtin_amdgcn_readfirstlane(tid >> 6), lane = tid & 63, wr = wid >> 2, wc = wid & 3, fr = lane & 15, fq = lane >> 4;
    const int K = g.K, nt = K / BK;
    unsigned voffA[2], voffB[2];
#pragma unroll
    for (int i = 0; i < 2; ++i) { int R, C; stage_rc(tid * 16 + i * 8192, R, C); const int Rb = Epi::PERM ? ((R & ~31) + perm32(R & 31)) : R;
        voffA[i] = (unsigned)(R * g.lda + C) * 2u; voffB[i] = (unsigned)(Rb * g.ldb + C) * 2u; }
    const size_t kstep = (size_t)(BK * 2);
    const size_t hstepA = (size_t)HALF * g.lda * 2, hstepB = (size_t)HALF * g.ldb * 2;
    const size_t tstepA = 2 * hstepA, tstepB = 2 * hstepB;
    const unsigned ldsw = (unsigned)wid * 1024u;
    const int aoff = lds_byte(wr * 64 + fr, fq * 8), boff = lds_byte(wc * 32 + fr, fq * 8);
#define PG8_SA(b, h) (((b) * 2 + (h)) * HTB)
#define PG8_SB(b, h) ((4 + (b) * 2 + (h)) * HTB)
#define PG8_STAGE(bufoff, gbase, voff) do { _Pragma("unroll") for (int _i = 0; _i < 2; ++_i) \
        __builtin_amdgcn_global_load_lds((const unsigned*)((const char*)(gbase) + (voff)[_i]), (PG8_LAS unsigned*)(lds + (bufoff) + ldsw + _i * 8192), 16, 0, 0); } while (0)
#define PG8_LDA(dst, b, h) do { _Pragma("unroll") for (int m = 0; m < 4; ++m) _Pragma("unroll") for (int k = 0; k < 2; ++k) dst[m][k] = *(const PG8_LAS bf16x8*)(lds + PG8_SA(b, h) + aoff + m * 2048 + k * 1024); } while (0)
#define PG8_LDB(dst, b, h) do { _Pragma("unroll") for (int n = 0; n < 2; ++n) _Pragma("unroll") for (int k = 0; k < 2; ++k) dst[n][k] = *(const PG8_LAS bf16x8*)(lds + PG8_SB(b, h) + boff + n * 2048 + k * 1024); } while (0)
#define PG8_MMA(ai, bj, At, Bt) do { __builtin_amdgcn_s_setprio(1); _Pragma("unroll") for (int m = 0; m < 4; ++m) _Pragma("unroll") for (int n = 0; n < 2; ++n) _Pragma("unroll") for (int k = 0; k < 2; ++k) \
        acc[ai][bj][m][n] = __builtin_amdgcn_mfma_f32_16x16x32_bf16(Bt[n][k], At[m][k], acc[ai][bj][m][n], 0, 0, 0); __builtin_amdgcn_s_setprio(0); } while (0)
#define PG8_WAIT_V(n) asm volatile("s_waitcnt vmcnt(" #n ")" ::: "memory")
#define PG8_WAIT_L(n) asm volatile("s_waitcnt lgkmcnt(" #n ")" ::: "memory")
#define PG8_BAR __builtin_amdgcn_s_barrier()
#define PG8_SCHED __builtin_amdgcn_sched_barrier(0)
    Unit cur, nxt; int ui = 0;
    if (!S.next(0, cur)) return;
    f32x4 acc[2][2][4][2];
#pragma unroll
    for (int a = 0; a < 2; ++a)
#pragma unroll
        for (int b = 0; b < 2; ++b)
#pragma unroll
            for (int m = 0; m < 4; ++m)
#pragma unroll
                for (int n = 0; n < 2; ++n) acc[a][b][m][n] = (f32x4){0.f, 0.f, 0.f, 0.f};
    bf16x8 At[4][2], B0[2][2], B1[2][2];
    const char* cA = (const char*)g.A + (size_t)cur.pm * tstepA + (size_t)(cur.pn >> g.agrp_shift) * g.agrp_bytes; const char* cB = (const char*)g.Bt + (size_t)cur.pn * tstepB;
    S.a_ready(cur);
    if constexpr (SP2) {
        PG8_STAGE(PG8_SB(0, 0), cB, voffB); PG8_STAGE(PG8_SB(0, 1), cB + hstepB, voffB); PG8_STAGE(PG8_SA(0, 0), cA, voffA); PG8_STAGE(PG8_SA(0, 1), cA + hstepA, voffA);
        if (wr == 1) PG8_BAR;
        PG8_WAIT_V(2); PG8_BAR;
        PG8_STAGE(PG8_SB(1, 0), cB + kstep, voffB); PG8_STAGE(PG8_SA(1, 0), cA + kstep, voffA); PG8_STAGE(PG8_SB(1, 1), cB + hstepB + kstep, voffB);
        PG8_WAIT_V(6); PG8_BAR;
    } else {
        PG8_STAGE(PG8_SB(0, 0), cB, voffB); PG8_STAGE(PG8_SA(0, 0), cA, voffA); PG8_STAGE(PG8_SB(0, 1), cB + hstepB, voffB); PG8_STAGE(PG8_SA(0, 1), cA + hstepA, voffA);
        if (wr == 1) PG8_BAR;
        PG8_WAIT_V(4); PG8_BAR;
        PG8_STAGE(PG8_SB(1, 0), cB + kstep, voffB); PG8_STAGE(PG8_SA(1, 0), cA + kstep, voffA); PG8_STAGE(PG8_SB(1, 1), cB + hstepB + kstep, voffB);
        PG8_WAIT_V(6); PG8_BAR;
    }
    for (;;) {
        const bool has_next = S.next(ui + 1, nxt);
        const char* nA = has_next ? (const char*)g.A + (size_t)nxt.pm * tstepA + (size_t)(nxt.pn >> g.agrp_shift) * g.agrp_bytes : cA; const char* nB = has_next ? (const char*)g.Bt + (size_t)nxt.pn * tstepB : cB;
        for (int t = 0; t < nt; t += 2) {
            const bool last = (t == nt - 2);
            const char* a1 = cA + (size_t)(t + 1) * kstep;
            const char* a2 = last ? nA : cA + (size_t)(t + 2) * kstep; const char* b2 = last ? nB : cB + (size_t)(t + 2) * kstep;
            const char* a3 = a2 + kstep; const char* b3 = b2 + kstep;
            if (last && has_next) S.a_ready(nxt);
            if constexpr (SP2) {
            PG8_LDB(B0, 0, 0); PG8_LDB(B1, 0, 1); PG8_SCHED; PG8_LDA(At, 0, 0); PG8_STAGE(PG8_SA(1, 1), a1 + hstepA, voffA);
            PG8_WAIT_V(8); PG8_WAIT_L(0); PG8_BAR; PG8_MMA(0, 0, At, B0); PG8_MMA(0, 1, At, B1); PG8_BAR; PG8_SCHED;
            PG8_LDA(At, 0, 1); PG8_STAGE(PG8_SB(0, 0), b2, voffB); PG8_STAGE(PG8_SB(0, 1), b2 + hstepB, voffB); PG8_STAGE(PG8_SA(0, 0), a2, voffA);
            PG8_WAIT_V(8); PG8_WAIT_L(0); PG8_BAR; PG8_MMA(1, 0, At, B0); PG8_MMA(1, 1, At, B1); PG8_BAR; PG8_SCHED;
            PG8_LDB(B0, 1, 0); PG8_LDB(B1, 1, 1); PG8_SCHED; PG8_LDA(At, 1, 0); PG8_STAGE(PG8_SA(0, 1), a2 + hstepA, voffA);
            PG8_WAIT_V(8); PG8_WAIT_L(0); PG8_BAR; PG8_MMA(0, 0, At, B0); PG8_MMA(0, 1, At, B1); PG8_BAR; PG8_SCHED;
            PG8_LDA(At, 1, 1); PG8_STAGE(PG8_SB(1, 0), b3, voffB); PG8_STAGE(PG8_SB(1, 1), b3 + hstepB, voffB); PG8_STAGE(PG8_SA(1, 0), a3, voffA);
            PG8_WAIT_V(8); PG8_WAIT_L(0); PG8_BAR; PG8_MMA(1, 0, At, B0); PG8_MMA(1, 1, At, B1); PG8_BAR; PG8_SCHED;
            } else {
            PG8_LDB(B0, 0, 0); PG8_SCHED; PG8_LDA(At, 0, 0); PG8_STAGE(PG8_SA(1, 1), a1 + hstepA, voffA);
            PG8_WAIT_L(8); PG8_BAR; PG8_WAIT_L(0); PG8_MMA(0, 0, At, B0); PG8_BAR; PG8_SCHED;
            PG8_LDB(B1, 0, 1); PG8_STAGE(PG8_SB(0, 0), b2, voffB);
            PG8_BAR; PG8_WAIT_L(0); PG8_MMA(0, 1, At, B1); PG8_BAR;
            PG8_LDA(At, 0, 1); PG8_STAGE(PG8_SA(0, 0), a2, voffA);
            PG8_BAR; PG8_WAIT_L(0); PG8_MMA(1, 0, At, B0); PG8_BAR; PG8_SCHED;
            PG8_STAGE(PG8_SB(0, 1), b2 + hstepB, voffB);
            PG8_WAIT_V(6); PG8_BAR; PG8_MMA(1, 1, At, B1); PG8_BAR;
            PG8_LDB(B0, 1, 0); PG8_SCHED; PG8_LDA(At, 1, 0); PG8_STAGE(PG8_SA(0, 1), a2 + hstepA, voffA);
            PG8_WAIT_L(8); PG8_BAR; PG8_WAIT_L(0); PG8_MMA(0, 0, At, B0); PG8_BAR; PG8_SCHED;
            PG8_LDB(B1, 1, 1); PG8_STAGE(PG8_SB(1, 0), b3, voffB);
            PG8_BAR; PG8_WAIT_L(0); PG8_MMA(0, 1, At, B1); PG8_BAR;
            PG8_LDA(At, 1, 1); PG8_STAGE(PG8_SA(1, 0), a3, voffA);
            PG8_BAR; PG8_WAIT_L(0); PG8_MMA(1, 0, At, B0); PG8_BAR; PG8_SCHED;
            PG8_STAGE(PG8_SB(1, 1), b3 + hstepB, voffB);
            PG8_WAIT_V(6); PG8_BAR; PG8_MMA(1, 1, At, B1); PG8_BAR;
            }
        }
        if constexpr (ALIGN_EPI) { if (wr == 0) PG8_BAR; }
        if constexpr (!Epi::AFTER_DRAIN) { E(acc, cur, wr, wc, fr, fq); S.done(cur); }
        if (!has_next) break;
#pragma unroll
        for (int a = 0; a < 2; ++a)
#pragma unroll
            for (int b = 0; b < 2; ++b)
#pragma unroll
                for (int m = 0; m < 4; ++m)
#pragma unroll
                    for (int n = 0; n < 2; ++n) acc[a][b][m][n] = (f32x4){0.f, 0.f, 0.f, 0.f};
        cur = nxt; cA = nA; cB = nB; ++ui;
        if constexpr (ALIGN_EPI) { if (wr == 1) PG8_BAR; }
    }
    PG8_WAIT_V(0);
    if constexpr (!ALIGN_EPI) { if (wr == 0) PG8_BAR; }
    PG8_BAR;
    if constexpr (Epi::AFTER_DRAIN) { E.fused(acc, cur, wr, wc, fr, fq, lds, wid, lane); S.done(cur); }
#undef PG8_SA
#undef PG8_SB
#undef PG8_STAGE
#undef PG8_LDA
#undef PG8_LDB
#undef PG8_MMA
#undef PG8_WAIT_V
#undef PG8_WAIT_L
#undef PG8_BAR
#undef PG8_SCHED
}
}
#define XB_TMO      128
#define XB_XCNT(j)  (256  + 64 * (j))
#define XB_XSUB(j)  (1280 + 64 * (j))
#define XB_XGEN(j)  (2304 + 64 * (j))
#define XB_TOP      3328
#define XB_TOPGEN   3392
#define XCD_BAR_WORDS 3456
#define XB_SPIN_CAP (1u << 18)

__device__ __forceinline__ unsigned xb_ld(unsigned* p)              { return __hip_atomic_load(p, __ATOMIC_RELAXED, __HIP_MEMORY_SCOPE_AGENT); }
__device__ __forceinline__ unsigned xb_add(unsigned* p, unsigned v) { return __hip_atomic_fetch_add(p, v, __ATOMIC_RELAXED, __HIP_MEMORY_SCOPE_AGENT); }
__device__ __forceinline__ unsigned xb_xcc_id() { return (unsigned)__builtin_amdgcn_s_getreg((3 << 11) | 20) & 0xFu; }
#define XB_SPIN(cond, bar) do { unsigned _sp = 0; while (cond) { __builtin_amdgcn_s_sleep(1); \
    if ((++_sp & 255u) == 0u) { if (xb_ld(&(bar)[XB_TMO])) break; if (_sp > XB_SPIN_CAP) { atomicAdd(&(bar)[XB_TMO], 1u); break; } } } } while (0)

struct XcdBarrier {
    unsigned* bar; unsigned x;
    volatile LAS unsigned* st;
};

__device__ __forceinline__ XcdBarrier xcd_barrier_post(unsigned* bar, volatile LAS unsigned* st) {
    XcdBarrier b; b.bar = bar; b.x = xb_xcc_id(); b.st = st;
    if (threadIdx.x == 0) (void)xb_add(&bar[XB_XCNT(b.x)], 1u);
    return b;
}
__device__ __forceinline__ void xcd_barrier_complete(unsigned* bar, unsigned x, unsigned& nloc, unsigned& nx) {
    const unsigned G = gridDim.x * gridDim.y * gridDim.z;
    unsigned sum, cnt, mine, sp = 0u;
    for (;;) {
        sum = 0u; cnt = 0u; mine = 0u;
#pragma unroll
        for (unsigned j = 0; j < 16; ++j) { const unsigned c = xb_ld(&bar[XB_XCNT(j)]); sum += c; cnt += (c > 0u) ? 1u : 0u; mine = (j == x) ? c : mine; }
        if (sum == G) break;
        __builtin_amdgcn_s_sleep(1);
        if ((++sp & 255u) == 0u) { if (xb_ld(&bar[XB_TMO])) break; if (sp > XB_SPIN_CAP) { atomicAdd(&bar[XB_TMO], 1u); break; } }
    }
    nloc = mine > 0u ? mine : 1u; nx = cnt > 0u ? cnt : 1u;
}

__device__ __forceinline__ void xcd_barrier(const XcdBarrier& b) {
    asm volatile("s_waitcnt vmcnt(0)" ::: "memory");
    __syncthreads();
    if (threadIdx.x == 0) {
        unsigned* bar = b.bar;
        __builtin_amdgcn_s_waitcnt(0);
        unsigned nloc = b.st[0], nx = b.st[1];
        if (nloc == 0u) { xcd_barrier_complete(bar, b.x, nloc, nx); b.st[0] = nloc; b.st[1] = nx; }
        const unsigned old = xb_add(&bar[XB_XSUB(b.x)], 1u);
        const unsigned gen = old / nloc;
        if (old + 1u == (gen + 1u) * nloc) {
            __builtin_amdgcn_fence(__ATOMIC_RELEASE, "agent");
            asm volatile("s_waitcnt vmcnt(0)" ::: "memory");
            const unsigned og = xb_add(&bar[XB_TOP], 1u);
            const unsigned tg = og / nx;
            if (og + 1u == (tg + 1u) * nx) xb_add(&bar[XB_TOPGEN], 1u);
            else XB_SPIN(xb_ld(&bar[XB_TOPGEN]) == tg, bar);
            __builtin_amdgcn_fence(__ATOMIC_ACQUIRE, "agent");
            xb_add(&bar[XB_XGEN(b.x)], 1u);
            asm volatile("s_waitcnt vmcnt(0)" ::: "memory");
        } else {
            XB_SPIN(xb_ld(&bar[XB_XGEN(b.x)]) == gen, bar);
            __builtin_amdgcn_fence(__ATOMIC_ACQUIRE, "agent");
            asm volatile("s_waitcnt vmcnt(0)" ::: "memory");
        }
    }
    __syncthreads();
}
namespace att {
using bf16 = __hip_bfloat16;
constexpr int   D = 128, NW = 8, QBLK = 32, KVBLK = 64;
constexpr float SCALE = 0.088388347648318440f;
constexpr float THR = 8.f;
constexpr int SDEPTH = 1;
constexpr int LDQ = 1024, LDK = 512, LDO = 2048;
constexpr size_t SHM_V = KVBLK * D * 2, SHM_K = KVBLK * D * 2, SHM_ATTN = 2 * SHM_V + 2 * SHM_K + NW * 64 * 4;
using bf16x8 = __attribute__((ext_vector_type(8))) short;
using s16x4  = __attribute__((ext_vector_type(4))) short;
using f32x16 = __attribute__((ext_vector_type(16))) float;
using f32x8  = __attribute__((ext_vector_type(8))) float;
using u32x4  = __attribute__((ext_vector_type(4))) unsigned;
#define KSWZ(row, colB) ((row) * 256 + ((colB) ^ (((row) & 7) << 4)))
#define SBAR() __builtin_amdgcn_sched_barrier(0)
__device__ __forceinline__ int crow(int r, int hi) { return (r & 3) + 8 * (r >> 2) + 4 * hi; }
__device__ __forceinline__ unsigned cvtpk(float lo, float hi) {
  unsigned r; asm volatile("v_cvt_pk_bf16_f32 %0, %1, %2" : "=v"(r) : "v"(lo), "v"(hi)); return r;
}
template <typename TIn> struct Stage;
template <> struct Stage<bf16>  { using T = bf16x8;
  __device__ static __forceinline__ T ld8(const bf16* p) { return *reinterpret_cast<const bf16x8*>(p); }
  __device__ static __forceinline__ bf16x8 tobf(T x) { return x; } };
template <> struct Stage<float> { using T = f32x8;
  __device__ static __forceinline__ T ld8(const float* p) { return *reinterpret_cast<const f32x8*>(p); }
  __device__ static __forceinline__ bf16x8 tobf(T x) {
    u32x4 w = {cvtpk(x[0], x[1]), cvtpk(x[2], x[3]), cvtpk(x[4], x[5]), cvtpk(x[6], x[7])}; return *reinterpret_cast<bf16x8*>(&w); } };

__device__ __forceinline__ void partialSM(f32x16& p0, f32x16& p1, float& m_reg, float& mn, float& alpha) {
  constexpr float C = SCALE * 1.4426950408889634f;
  float pmax = p0[0]; for (int r = 1; r < 16; ++r) pmax = fmaxf(pmax, p0[r]); for (int r = 0; r < 16; ++r) pmax = fmaxf(pmax, p1[r]);
  { auto rr = __builtin_amdgcn_permlane32_swap(__float_as_uint(pmax), __float_as_uint(pmax), false, false);
    pmax = fmaxf(__uint_as_float(rr[0]), __uint_as_float(rr[1])); }
  if (__builtin_expect(__all(pmax - m_reg <= THR / SCALE), 1)) { mn = m_reg; alpha = 1.f; }
  else { mn = fmaxf(m_reg, pmax); alpha = __builtin_amdgcn_exp2f((m_reg - mn) * C); m_reg = mn; }
  float mnC = -mn * C;
  for (int r = 0; r < 16; ++r) p0[r] = fmaf(p0[r], C, mnC); for (int r = 0; r < 16; ++r) p1[r] = fmaf(p1[r], C, mnC);
  for (int r = 0; r < 16; ++r) p0[r] = __builtin_amdgcn_exp2f(p0[r]);
}
__device__ __forceinline__ void finishSM(f32x16& p0, f32x16& p1, float alpha, float& l_reg, bf16x8& pa0, bf16x8& pa1, bf16x8& pa2, bf16x8& pa3) {
  for (int r = 0; r < 16; ++r) p1[r] = __builtin_amdgcn_exp2f(p1[r]);
  float ps = 0; for (int r = 0; r < 16; ++r) ps += p0[r]; for (int r = 0; r < 16; ++r) ps += p1[r];
  { auto rr = __builtin_amdgcn_permlane32_swap(__float_as_uint(ps), __float_as_uint(ps), false, false);
    ps = __uint_as_float(rr[0]) + __uint_as_float(rr[1]); }
  l_reg = l_reg * alpha + ps;
#define PK4(P, BASE, OUT) do { unsigned a0 = cvtpk(P[BASE + 0], P[BASE + 1]), a1 = cvtpk(P[BASE + 2], P[BASE + 3]);   \
    unsigned b0 = cvtpk(P[BASE + 4], P[BASE + 5]), b1 = cvtpk(P[BASE + 6], P[BASE + 7]);                              \
    auto r0 = __builtin_amdgcn_permlane32_swap(a0, b0, false, false); auto r1 = __builtin_amdgcn_permlane32_swap(a1, b1, false, false); \
    u32x4 w = {r0[0], r1[0], r0[1], r1[1]}; OUT = *reinterpret_cast<bf16x8*>(&w); } while (0)
  PK4(p0, 0, pa0); PK4(p0, 8, pa1); PK4(p1, 0, pa2); PK4(p1, 8, pa3);
#undef PK4
}
__device__ __forceinline__ void qkt(f32x16& p0, f32x16& p1, const bf16* Ks, const bf16x8* qr, int r32, int hi) {
  p0 = f32x16{}; p1 = f32x16{};
  for (int d0 = 0; d0 < 8; ++d0) { int cb = (d0 * 16 + hi * 8) * 2;
    bf16x8 b0 = *reinterpret_cast<const bf16x8*>((const char*)Ks + KSWZ(r32, cb));
    bf16x8 b1 = *reinterpret_cast<const bf16x8*>((const char*)Ks + KSWZ(32 + r32, cb));
    p0 = __builtin_amdgcn_mfma_f32_32x32x16_bf16(b0, qr[d0], p0, 0, 0, 0);
    p1 = __builtin_amdgcn_mfma_f32_32x32x16_bf16(b1, qr[d0], p1, 0, 0, 0); }
}
__device__ __forceinline__ int v_st(int k, int c) { const int kk = (k & ~0xC) | ((k & 4) << 1) | ((k & 8) >> 1); return ((kk >> 3) * 4 + (c >> 5)) * 512 + ((kk & 7) * 32 + (c & 31)) * 2; }
__device__ __forceinline__ int v_rd_base(int lane) { return ((lane & 3) << 3) | (((lane >> 2) & 3) << 6) | (((lane >> 4) & 1) << 5) | (((lane >> 5) & 1) << 8); }
constexpr int v_rd_off(int d0, int ks, int half) { return d0 * 512 + ks * 4096 + half * 2048; }
template <int OFF> __device__ __forceinline__ s16x4 tr_read(int vb) {
  s16x4 r; asm volatile("ds_read_b64_tr_b16 %0, %1 offset:%2" : "=&v"(r) : "v"(vb), "i"(OFF) : "memory"); return r;
}
template <int D0> __device__ __forceinline__ void pv_one(f32x16& od, int vb, bf16x8 pa0, bf16x8 pa1, bf16x8 pa2, bf16x8 pa3) {
  const s16x4 l0 = tr_read<v_rd_off(D0, 0, 0)>(vb), h0 = tr_read<v_rd_off(D0, 0, 1)>(vb), l1 = tr_read<v_rd_off(D0, 1, 0)>(vb), h1 = tr_read<v_rd_off(D0, 1, 1)>(vb);
  const s16x4 l2 = tr_read<v_rd_off(D0, 2, 0)>(vb), h2 = tr_read<v_rd_off(D0, 2, 1)>(vb), l3 = tr_read<v_rd_off(D0, 3, 0)>(vb), h3 = tr_read<v_rd_off(D0, 3, 1)>(vb);
  asm volatile("s_waitcnt lgkmcnt(0)" ::: "memory"); SBAR();
#define PK(L, H) (bf16x8){L[0], L[1], L[2], L[3], H[0], H[1], H[2], H[3]}
  od = __builtin_amdgcn_mfma_f32_32x32x16_bf16(pa0, PK(l0, h0), od, 0, 0, 0);
  od = __builtin_amdgcn_mfma_f32_32x32x16_bf16(pa1, PK(l1, h1), od, 0, 0, 0);
  od = __builtin_amdgcn_mfma_f32_32x32x16_bf16(pa2, PK(l2, h2), od, 0, 0, 0);
  od = __builtin_amdgcn_mfma_f32_32x32x16_bf16(pa3, PK(l3, h3), od, 0, 0, 0);
#undef PK
}
__device__ __forceinline__ void pv_d0(f32x16* o, int vb, bf16x8 pa0, bf16x8 pa1, bf16x8 pa2, bf16x8 pa3) {
  pv_one<0>(o[0], vb, pa0, pa1, pa2, pa3); pv_one<1>(o[1], vb, pa0, pa1, pa2, pa3); pv_one<2>(o[2], vb, pa0, pa1, pa2, pa3); pv_one<3>(o[3], vb, pa0, pa1, pa2, pa3);
}

template <typename TQ>
__device__ __forceinline__ void attn_dense_body(const TQ* __restrict__ Qb, const bf16* __restrict__ Kh, const bf16* __restrict__ Vh,
                                                bf16* __restrict__ Ob, int seq, char* lds) {
  using St = Stage<bf16>; using SQ = Stage<TQ>;
  int tid_ = threadIdx.x; asm volatile("" : "+v"(tid_));
  const int tid = tid_, wid = tid >> 6, lane = tid & 63, r32 = lane & 31, hi = lane >> 5;
  bf16* V_lds = (bf16*)lds; bf16* K_lds = (bf16*)(lds + 2 * SHM_V);
  float* ws = (float*)(lds + 2 * SHM_V + 2 * SHM_K) + wid * 64; float* li_l = ws; float* al_l = ws + 32;
  float m_reg = -1e30f, l_reg = 0; f32x16 o[4] = {}; bf16x8 qr[8];
  const TQ* Qw = Qb + (long)(wid * QBLK + r32) * LDQ + hi * 8;
#pragma unroll
  for (int d0 = 0; d0 < 8; ++d0) qr[d0] = SQ::tobf(SQ::ld8(Qw + d0 * 16));
  const int sr = tid >> 4, sc = (tid & 15) * 8, vst0 = v_st(sr, sc), vst1 = v_st(32 + sr, sc);
  const int vb0 = (int)(uintptr_t)V_lds + v_rd_base(lane);
  struct { typename St::T vs0, vs1, ks0, ks1; } sr_[SDEPTH];
#define SLOAD(i, k0) do { sr_[i].vs0 = St::ld8(&Vh[(long)((k0) + sr) * LDK + sc]); sr_[i].vs1 = St::ld8(&Vh[(long)((k0) + 32 + sr) * LDK + sc]); \
    sr_[i].ks0 = St::ld8(&Kh[(long)((k0) + sr) * LDK + sc]); sr_[i].ks1 = St::ld8(&Kh[(long)((k0) + 32 + sr) * LDK + sc]); } while (0)
#define SWRITE(b, i) do { *(bf16x8*)((char*)V_lds + (b) * SHM_V + vst0) = St::tobf(sr_[i].vs0);          \
    *(bf16x8*)((char*)V_lds + (b) * SHM_V + vst1) = St::tobf(sr_[i].vs1); int kc = sc * 2;               \
    *(bf16x8*)((char*)K_lds + (b) * SHM_K + KSWZ(sr, kc)) = St::tobf(sr_[i].ks0);                       \
    *(bf16x8*)((char*)K_lds + (b) * SHM_K + KSWZ(32 + sr, kc)) = St::tobf(sr_[i].ks1); } while (0)
#define SWAIT() do { if constexpr (SDEPTH == 2) asm volatile("s_waitcnt vmcnt(4)" ::: "memory"); else asm volatile("s_waitcnt vmcnt(0)" ::: "memory"); } while (0)
#define RESC(a) do { if (__any((a) < 1.f)) { if (hi == 0) al_l[r32] = (a); asm volatile("s_waitcnt lgkmcnt(0)" ::: "memory"); \
    for (int d = 0; d < 4; ++d) for (int r = 0; r < 16; ++r) o[d][r] *= al_l[crow(r, hi)]; } } while (0)
  f32x16 pA0, pA1, pB0, pB1; float mnA, mnB, alA, alB; bf16x8 pa0, pa1, pa2, pa3; const int NT = seq / KVBLK;
  constexpr int SE = 0, SO = SDEPTH - 1;
  SLOAD(SE, 0); asm volatile("s_waitcnt vmcnt(0)" ::: "memory"); SWRITE(0, SE); __syncthreads();
  qkt(pA0, pA1, K_lds, qr, r32, hi); partialSM(pA0, pA1, m_reg, mnA, alA);
  SLOAD(SO, KVBLK); if constexpr (SDEPTH == 2) { if (2 < NT) SLOAD(SE, 2 * KVBLK); }
  SWAIT(); SWRITE(1, SO); __syncthreads();
  for (int j = 1; j + 1 < NT; j += 2) {
    SBAR(); qkt(pB0, pB1, (bf16*)((char*)K_lds + SHM_K), qr, r32, hi);
    finishSM(pA0, pA1, alA, l_reg, pa0, pa1, pa2, pa3); SBAR();
    SLOAD(SO, (j + SDEPTH) * KVBLK); SBAR();
    pv_d0(o, vb0, pa0, pa1, pa2, pa3); partialSM(pB0, pB1, m_reg, mnB, alB);
    __syncthreads(); SWAIT(); SWRITE(0, SE);
    RESC(alB); __syncthreads();
    SBAR(); qkt(pA0, pA1, K_lds, qr, r32, hi);
    finishSM(pB0, pB1, alB, l_reg, pa0, pa1, pa2, pa3); SBAR();
    if (SDEPTH == 1 || j + 3 < NT) SLOAD(SE, (j + 1 + SDEPTH) * KVBLK); SBAR();
    pv_d0(o, vb0 + (int)SHM_V, pa0, pa1, pa2, pa3); partialSM(pA0, pA1, m_reg, mnA, alA);
    __syncthreads(); SWAIT(); SWRITE(1, SO);
    RESC(alA); __syncthreads();
  }
  SBAR(); qkt(pB0, pB1, (bf16*)((char*)K_lds + SHM_K), qr, r32, hi);
  finishSM(pA0, pA1, alA, l_reg, pa0, pa1, pa2, pa3); SBAR();
  pv_d0(o, vb0, pa0, pa1, pa2, pa3); partialSM(pB0, pB1, m_reg, mnB, alB);
  __syncthreads(); RESC(alB);
  finishSM(pB0, pB1, alB, l_reg, pa0, pa1, pa2, pa3); SBAR();
  pv_d0(o, vb0 + (int)SHM_V, pa0, pa1, pa2, pa3);
  if (hi == 0) li_l[r32] = l_reg; asm volatile("s_waitcnt lgkmcnt(0)" ::: "memory");
  float rli[16];
#pragma unroll
  for (int r = 0; r < 16; ++r) rli[r] = __builtin_amdgcn_rcpf(li_l[crow(r, hi)]);
  bf16* Ow = Ob + (long)(wid * QBLK) * LDO;
#pragma unroll
  for (int r = 0; r < 16; ++r) { int orow = crow(r, hi);
    for (int d0 = 0; d0 < 4; ++d0) Ow[(long)orow * LDO + d0 * 32 + r32] = __float2bfloat16(o[d0][r] * rli[r]); }
  __syncthreads();
#undef SLOAD
#undef SWRITE
#undef SWAIT
#undef RESC
}
#undef KSWZ
#undef SBAR
}

struct Frame {
    LAS unsigned char* lds;
    char* ldsg;
    int tid, lane, wave, vcu, G;
    unsigned char* ws;
};
__device__ __forceinline__ const float* frame_in(const Frame& F, int i) {
    const LAS unsigned* p = (const LAS unsigned*)(F.lds + LDSCTL_OFF + 64) + 2 * i;
    const unsigned lo = __builtin_amdgcn_readfirstlane(p[0]), hi = __builtin_amdgcn_readfirstlane(p[1]);
    return (const float*)(((unsigned long long)hi << 32) | lo);
}
#define FIN(i) frame_in(F, (i))
#define FOUT() ((float*)frame_in(F, 17))
#define WSP(T, off) ((T*)(F.ws + (off)))

__device__ __forceinline__ void p0_transpose_item(const float* W, int K, int N, int Npad, bf16_t* WT, int row_off, LAS float* scr, int item, int lane) {
    const int nblk = Npad / 32, kb = item / nblk, nb = item % nblk, k0 = 64 * kb, n0 = 32 * nb;
    const int nn = n0 + (lane & 31);
#pragma unroll 8
    for (int i = 0; i < 32; ++i) { const int kk = 2 * i + (lane >> 5); scr[kk * 33 + (lane & 31)] = nn < N ? W[(size_t)(k0 + kk) * N + nn] : 0.f; }
    LDS_WAIT(); asm volatile("" ::: "memory");
    const int c = lane & 7;
#pragma unroll
    for (int j = 0; j < 4; ++j) { const int n = (lane >> 3) + 8 * j; const LAS float* s = scr + (8 * c) * 33 + n;
        u32x4 o; o.x = pk2(s[0 * 33], s[1 * 33]); o.y = pk2(s[2 * 33], s[3 * 33]); o.z = pk2(s[4 * 33], s[5 * 33]); o.w = pk2(s[6 * 33], s[7 * 33]);
        *(GAS u32x4*)(WT + (size_t)(row_off + n0 + n) * K + k0 + 8 * c) = o; }
    LDS_WAIT(); asm volatile("" ::: "memory");
}
__device__ __forceinline__ u32x4 cvt8(const float* p) {
    const f32x4 a = *(const f32x4*)p, b = *(const f32x4*)(p + 4);
    u32x4 o; o.x = pk2(a.x, a.y); o.y = pk2(a.z, a.w); o.z = pk2(b.x, b.y); o.w = pk2(b.z, b.w); return o;
}
__device__ __forceinline__ void rms_row_to_bf16(const float* xrow, const float* g, bf16_t* orow, int lane) {
    const f32x4* xr = (const f32x4*)xrow + lane;
    f32x4 v[8]; float s = 0.f;
#pragma unroll
    for (int j = 0; j < 8; ++j) { v[j] = xr[64 * j]; s += (v[j].x * v[j].x + v[j].y * v[j].y) + (v[j].z * v[j].z + v[j].w * v[j].w); }
    const float r = 1.0f / sqrtf(wave_sum(s) * (1.f / DM) + EPS);
    u32x2* o8 = (u32x2*)orow + lane;
#pragma unroll
    for (int j = 0; j < 8; ++j) { const f32x4 gg = ((const f32x4*)g)[lane + 64 * j]; u32x2 w; w.x = pk2(v[j].x * r * gg.x, v[j].y * r * gg.y); w.y = pk2(v[j].z * r * gg.z, v[j].w * r * gg.w); o8[64 * j] = w; }
}
__device__ __forceinline__ void ph_prologue(const Frame& F) {
    LAS float* scr = (LAS float*)(F.lds + F.wave * 16384);
    const int gw = F.vcu * NWAVES + F.wave, NGW = F.G * NWAVES;
    {   constexpr int PER = (2 * 16384 * 2048) / 4096;
        for (int it = gw; it < 2 * PER; it += NGW) {
            const bool isv = it >= PER; const int r = isv ? it - PER : it;
            const float* src = FIN(isv ? 15 : 14) + (size_t)r * 4096 + F.lane * 8; bf16_t* dst = WSP(bf16_t, isv ? WS_VB : WS_UB) + (size_t)r * 4096 + F.lane * 8;
#pragma unroll
            for (int q = 0; q < 8; ++q) *(u32x4*)(dst + q * 512) = cvt8(src + q * 512);
        }
    }
    {   constexpr int I_IN = (DM / 64) * (INP / 32), I_SQ = (DM / 64) * (DM / 32), I_PL = 4 * (512 / 64) * (512 / 32);
        constexpr int NIT = I_IN + 3 * I_SQ + I_PL;
        for (int it = gw; it < NIT; it += NGW) {
            int r = it;
            if (r < I_IN) { p0_transpose_item(FIN(3), DM, INW, INP, WSP(bf16_t, WS_WIN), 0, scr, r, F.lane); continue; } r -= I_IN;
            if (r < I_SQ) { p0_transpose_item(FIN(9), DM, DM, DM, WSP(bf16_t, WS_WOUT), 0, scr, r, F.lane); continue; } r -= I_SQ;
            if (r < I_SQ) { p0_transpose_item(FIN(12), DM, DM, DM, WSP(bf16_t, WS_WQ0), 0, scr, r, F.lane); continue; } r -= I_SQ;
            if (r < I_SQ) { p0_transpose_item(FIN(12) + (size_t)DM * DM, DM, DM, DM, WSP(bf16_t, WS_WQ1), 0, scr, r, F.lane); continue; } r -= I_SQ;
            const int grp = r / 128, ri = r % 128;
            p0_transpose_item(FIN(10) + (size_t)grp * 512 * 512, 512, 512, 512, WSP(bf16_t, WS_WPOOL), grp * 512, scr, ri, F.lane);
        }
    }
    for (int it = gw; it < 1024; it += NGW) *(u32x4*)(WSP(bf16_t, WS_KEYS) + (size_t)it * 512 + F.lane * 8) = cvt8(FIN(13) + (size_t)it * 512 + F.lane * 8);
    for (int m = gw; m < S; m += NGW) rms_row_to_bf16(FIN(0) + (size_t)m * DM, FIN(1), WSP(bf16_t, WS_XN) + (size_t)m * DM, F.lane);
}

__device__ __forceinline__ float silu_f(float z) { return z / (1.f + __expf(-z)); }
__device__ __forceinline__ void p2_qkv_token(const Frame& F, int t) {
    const int lane = F.lane, i8 = lane & 7;
    const bf16_t* pr = WSP(bf16_t, WS_PROJ) + (size_t)t * INP;
    const int axis = i8 >> 2, half = (i8 >> 1) & 1, f0 = (i8 & 1) * 16;
    const float pos = (float)(axis == 0 ? (t >> 6) : (t & 63));
    float cs[16], sn[16];
#pragma unroll
    for (int e = 0; e < 16; ++e) { const float inv = exp2f(-(float)(f0 + e) * (13.287712379549449f / 32.f));
        float rev = pos * inv * 0.15915494309189535f; rev -= rintf(rev);
        cs[e] = __builtin_amdgcn_cosf(rev); sn[e] = __builtin_amdgcn_sinf(rev); }
    const float sgn = half ? 1.f : -1.f;
    {   const u32x4 w0 = *(const u32x4*)(pr + C_AQ + lane * 16), w1 = *(const u32x4*)(pr + C_AQ + lane * 16 + 8);
        float v[16]; const unsigned ww[8] = {w0.x, w0.y, w0.z, w0.w, w1.x, w1.y, w1.z, w1.w};
#pragma unroll
        for (int e = 0; e < 8; ++e) { v[2 * e] = bflo(ww[e]); v[2 * e + 1] = bfhi(ww[e]); }
        float ss = 0.f;
#pragma unroll
        for (int e = 0; e < 16; ++e) ss += v[e] * v[e];
        ss += __shfl_xor(ss, 1); ss += __shfl_xor(ss, 2); ss += __shfl_xor(ss, 4);
        const float r = 1.0f / sqrtf(ss * (1.f / 128.f) + EPS);
        const float* gq = FIN(6) + i8 * 16;
        unsigned ow[8];
        float y[16];
#pragma unroll
        for (int e = 0; e < 16; ++e) y[e] = v[e] * r * gq[e];
#pragma unroll
        for (int e = 0; e < 16; ++e) { const float yp = __shfl_xor(y[e], 2); y[e] = y[e] * cs[e] + sgn * yp * sn[e]; }
#pragma unroll
        for (int e = 0; e < 8; ++e) ow[e] = pk2(y[2 * e], y[2 * e + 1]);
        bf16_t* dst = WSP(bf16_t, WS_QB) + (size_t)t * 1024 + lane * 16;
        *(u32x4*)dst = (u32x4){ow[0], ow[1], ow[2], ow[3]}; *(u32x4*)(dst + 8) = (u32x4){ow[4], ow[5], ow[6], ow[7]};
    }
    {   const int l16 = lane & 15;
        const u32x4 w0 = *(const u32x4*)(pr + C_AK + l16 * 16), w1 = *(const u32x4*)(pr + C_AK + l16 * 16 + 8);
        float v[16]; const unsigned ww[8] = {w0.x, w0.y, w0.z, w0.w, w1.x, w1.y, w1.z, w1.w};
#pragma unroll
        for (int e = 0; e < 8; ++e) { v[2 * e] = bflo(ww[e]); v[2 * e + 1] = bfhi(ww[e]); }
        float ss = 0.f;
#pragma unroll
        for (int e = 0; e < 16; ++e) ss += v[e] * v[e];
        ss += __shfl_xor(ss, 1); ss += __shfl_xor(ss, 2); ss += __shfl_xor(ss, 4);
        const float r = 1.0f / sqrtf(ss * (1.f / 128.f) + EPS);
        const float* gk = FIN(7) + i8 * 16;
        float y[16]; unsigned ow[8];
#pragma unroll
        for (int e = 0; e < 16; ++e) y[e] = v[e] * r * gk[e];
#pragma unroll
        for (int e = 0; e < 16; ++e) { const float yp = __shfl_xor(y[e], 2); y[e] = y[e] * cs[e] + sgn * yp * sn[e]; }
#pragma unroll
        for (int e = 0; e < 8; ++e) ow[e] = pk2(y[2 * e], y[2 * e + 1]);
        bf16_t* kv = WSP(bf16_t, WS_KVB) + (size_t)t * 512;
        if (lane < 16) { *(u32x4*)(kv + lane * 16) = (u32x4){ow[0], ow[1], ow[2], ow[3]}; *(u32x4*)(kv + lane * 16 + 8) = (u32x4){ow[4], ow[5], ow[6], ow[7]}; }
        else if (lane < 32) { const u32x4 a = *(const u32x4*)(pr + C_AV + l16 * 16), b = *(const u32x4*)(pr + C_AV + l16 * 16 + 8);
            *(u32x4*)(kv + 256 + l16 * 16) = a; *(u32x4*)(kv + 256 + l16 * 16 + 8) = b; }
    }
}
__device__ __forceinline__ void p2_conv_item(const Frame& F, int item) {
    const int tb = item >> 2, sl = item & 3, lane = F.lane, c = sl * 512 + lane * 8, t0 = tb * 16;
    float w[5][8];
#pragma unroll
    for (int j = 0; j < 5; ++j) { const f32x4 a = *(const f32x4*)(FIN(5) + j * 2048 + c), b = *(const f32x4*)(FIN(5) + j * 2048 + c + 4);
        w[j][0] = a.x; w[j][1] = a.y; w[j][2] = a.z; w[j][3] = a.w; w[j][4] = b.x; w[j][5] = b.y; w[j][6] = b.z; w[j][7] = b.w; }
    const bf16_t* src = WSP(bf16_t, WS_PROJ) + C_MQK + c;
    const float osc = (c >= 1024) ? 0.0625f : 1.f;
    bf16_t* dst = (c >= 1024) ? WSP(bf16_t, WS_MK) + (c - 1024) : WSP(bf16_t, WS_MQ) + c;
    u32x4 rows[5];
#pragma unroll
    for (int j = 0; j < 4; ++j) { const int tt = t0 - 2 + j; rows[j + 1] = (tt >= 0 && tt < S) ? *(const u32x4*)(src + (size_t)tt * INP) : (u32x4){0u, 0u, 0u, 0u}; }
#pragma unroll 1
    for (int q = 0; q < 16; ++q) {
        const int tn = t0 + q + 2;
        rows[0] = rows[1]; rows[1] = rows[2]; rows[2] = rows[3]; rows[3] = rows[4];
        rows[4] = (tn < S) ? *(const u32x4*)(src + (size_t)tn * INP) : (u32x4){0u, 0u, 0u, 0u};
        float acc[8];
#pragma unroll
        for (int e = 0; e < 8; ++e) acc[e] = 0.f;
#pragma unroll
        for (int j = 0; j < 5; ++j) { const unsigned ww[4] = {rows[j].x, rows[j].y, rows[j].z, rows[j].w};
#pragma unroll
            for (int e = 0; e < 4; ++e) { acc[2 * e] += bflo(ww[e]) * w[j][2 * e]; acc[2 * e + 1] += bfhi(ww[e]) * w[j][2 * e + 1]; } }
        u32x4 o; o.x = pk2(silu_f(acc[0]) * osc, silu_f(acc[1]) * osc); o.y = pk2(silu_f(acc[2]) * osc, silu_f(acc[3]) * osc);
        o.z = pk2(silu_f(acc[4]) * osc, silu_f(acc[5]) * osc); o.w = pk2(silu_f(acc[6]) * osc, silu_f(acc[7]) * osc);
        *(u32x4*)(dst + (size_t)(t0 + q) * 1024) = o;
    }
}
__device__ __forceinline__ float wave_incl_scan_add(float v, int lane) {
#pragma unroll
    for (int o = 1; o < 64; o <<= 1) { const float u = __shfl_up(v, o); if (lane >= o) v += u; }
    return v;
}
__device__ __forceinline__ float wave_incl_scan_max(float v, int lane) {
#pragma unroll
    for (int o = 1; o < 64; o <<= 1) { const float u = __shfl_up(v, o); if (lane >= o) v = fmaxf(v, u); }
    return v;
}
__device__ __forceinline__ float logsigmoid_f(float x) { return fminf(x, 0.f) - log1pf(__expf(-fabsf(x))); }
__device__ __forceinline__ void p2_gate_item(const Frame& F, int item) {
    const int dh = item >> 7, c = item & 127, dir = dh >> 2, h = dh & 3, lane = F.lane;
    const int p0 = 128 * c + 2 * lane, t0 = dir ? (S - 1 - p0) : p0, t1 = dir ? (t0 - 1) : (t0 + 1);
    const bf16_t* pg = WSP(bf16_t, WS_PROJ) + C_GATE + dir * 8 + h;
    const float bi = FIN(4)[dir * 8 + h], bf = FIN(4)[dir * 8 + 4 + h];
    const float i0 = bflo((unsigned)pg[(size_t)t0 * INP]) + bi, f0 = bflo((unsigned)pg[(size_t)t0 * INP + 4]) + bf;
    const float i1 = bflo((unsigned)pg[(size_t)t1 * INP]) + bi, f1 = bflo((unsigned)pg[(size_t)t1 * INP + 4]) + bf;
    const float lf0 = logsigmoid_f(f0), lf1 = logsigmoid_f(f1);
    const float incl = wave_incl_scan_add(lf0 + lf1, lane);
    const float b1 = incl, b0 = incl - lf1;
    const float u0 = i0 - b0, u1 = i1 - b1;
    const float mincl = wave_incl_scan_max(fmaxf(u0, u1), lane);
    float mprevl = __shfl_up(mincl, 1); if (lane == 0) mprevl = -INFINITY;
    const float pm0 = fmaxf(mprevl, u0), pm1 = mincl;
    float* GB = (float*)(F.ws + WS_GATES + GO_B) + (size_t)dh * S; float* GU = (float*)(F.ws + WS_GATES + GO_U) + (size_t)dh * S; float* GPM = (float*)(F.ws + WS_GATES + GO_PM) + (size_t)dh * S;
    GB[t0] = b0; GB[t1] = b1; GU[t0] = u0; GU[t1] = u1; GPM[t0] = pm0; GPM[t1] = pm1;
    if (lane == 63) { ((float*)(F.ws + WS_GATES + GO_G))[dh * 128 + c] = b1; ((float*)(F.ws + WS_GATES + GO_PML))[dh * 128 + c] = pm1; }
}
__device__ __forceinline__ void ph_post(const Frame& F) {
    const int gw = F.vcu * NWAVES + F.wave, NGW = F.G * NWAVES;
    for (int it = gw; it < 1024; it += NGW) p2_gate_item(F, it);
    for (int it = gw; it < 4096; it += NGW) p2_conv_item(F, it);
    for (int t = gw; t < S; t += NGW) p2_qkv_token(F, t);
}

#define MFMA16(a, b, c) __builtin_amdgcn_mfma_f32_16x16x32_bf16((a), (b), (c), 0, 0, 0)
__device__ __forceinline__ bf16x8 frag_tr(LAS const unsigned char* base, int pitch, int k0, int x0, int lane) {
    const int g = lane >> 4, i = lane & 15;
    LAS const unsigned char* p = base + (k0 + 8 * g + (i >> 2)) * pitch + (x0 + 4 * (i & 3)) * 2;
    const s16x4 lo = __builtin_bit_cast(s16x4, __builtin_amdgcn_ds_read_tr16_b64_v4i16((LAS v4i16_t*)p));
    const s16x4 hi = __builtin_bit_cast(s16x4, __builtin_amdgcn_ds_read_tr16_b64_v4i16((LAS v4i16_t*)(p + 4 * pitch)));
    return (bf16x8){lo[0], lo[1], lo[2], lo[3], hi[0], hi[1], hi[2], hi[3]};
}
__device__ __forceinline__ bf16x8 frag_kc(LAS const unsigned char* base, int pitch, int x0, int k0, int lane) {
    return *(LAS const bf16x8*)(base + (x0 + (lane & 15)) * pitch + (k0 + 8 * (lane >> 4)) * 2);
}

constexpr int MLA_PK = 544, MLA_PV = 288;
constexpr int MLA_OFF_V = 128 * MLA_PK;
__device__ __forceinline__ void ph_mla(const Frame& F) {
    const int tid = F.tid, lane = F.lane, wave = F.wave;
    LAS unsigned char* Kw = F.lds; LAS unsigned char* Vs = F.lds + MLA_OFF_V;
    const float* GU = (const float*)(F.ws + WS_GATES + GO_U); const float* GPML = (const float*)(F.ws + WS_GATES + GO_PML);
    for (int item = F.vcu; item < 2048; item += F.G) {
        const int hv = item & 1, c = (item >> 1) & 127, dh = item >> 8, dir = dh >> 2, head = dh & 3;
        const int tc = dir ? 127 - c : c, t0 = tc * 128;
        const float pml = GPML[dh * 128 + c];
        {   const bf16_t* mk = WSP(bf16_t, WS_MK) + (size_t)t0 * 1024 + head * 256;
#pragma unroll
            for (int j = 0; j < 8; ++j) { const int r = (tid >> 5) + 16 * j, c8 = (tid & 31) * 8;
                const u32x4 x = *(const u32x4*)(mk + (size_t)r * 1024 + c8); const float w = __expf(GU[(size_t)dh * S + t0 + r] - pml);
                u32x4 o; o.x = pk2(bflo(x.x) * w, bfhi(x.x) * w); o.y = pk2(bflo(x.y) * w, bfhi(x.y) * w); o.z = pk2(bflo(x.z) * w, bfhi(x.z) * w); o.w = pk2(bflo(x.w) * w, bfhi(x.w) * w);
                *(LAS u32x4*)(Kw + r * MLA_PK + c8 * 2) = o; }
            const bf16_t* mv = WSP(bf16_t, WS_PROJ) + (size_t)t0 * INP + C_MV + head * 256 + hv * 128;
#pragma unroll
            for (int j = 0; j < 4; ++j) { const int r = (tid >> 4) + 32 * j, c8 = (tid & 15) * 8;
                *(LAS u32x4*)(Vs + r * MLA_PV + c8 * 2) = *(const u32x4*)(mv + (size_t)r * INP + c8); }
        }
        __syncthreads();
        f32x4 acc[4][4];
#pragma unroll
        for (int a = 0; a < 4; ++a)
#pragma unroll
            for (int b = 0; b < 4; ++b) acc[a][b] = (f32x4){0.f, 0.f, 0.f, 0.f};
        const int mb = (wave & 3) * 64, nb = (wave >> 2) * 64;
#pragma unroll
        for (int ks = 0; ks < 4; ++ks) {
            bf16x8 af[4], bfr[4];
#pragma unroll
            for (int a = 0; a < 4; ++a) af[a] = frag_tr(Kw, MLA_PK, 32 * ks, mb + 16 * a, lane);
#pragma unroll
            for (int b = 0; b < 4; ++b) bfr[b] = frag_tr(Vs, MLA_PV, 32 * ks, nb + 16 * b, lane);
#pragma unroll
            for (int a = 0; a < 4; ++a)
#pragma unroll
                for (int b = 0; b < 4; ++b) acc[a][b] = MFMA16(af[a], bfr[b], acc[a][b]);
        }
        {   bf16_t* cst = WSP(bf16_t, WS_CST) + ((size_t)(dh * 128 + c) << 16);
            const int g = lane >> 4, i = lane & 15;
#pragma unroll
            for (int a = 0; a < 4; ++a)
#pragma unroll
                for (int b = 0; b < 4; ++b) { u32x2 o; o.x = pk2(acc[a][b][0], acc[a][b][1]); o.y = pk2(acc[a][b][2], acc[a][b][3]);
                    *(u32x2*)(cst + (size_t)(hv * 128 + nb + 16 * b + i) * 256 + mb + 16 * a + 4 * g) = o; }
        }
        if (hv == 0 && tid < 256) { float s = 0.f;
#pragma unroll 8
            for (int r = 0; r < 128; ++r) s += bflo((unsigned)*(LAS const bf16_t*)(Kw + r * MLA_PK + tid * 2));
            ((float*)(F.ws + WS_NST))[(size_t)(dh * 128 + c) * 256 + tid] = s; }
        __syncthreads();
    }
}

__device__ __forceinline__ void ph_scan(const Frame& F) {
    const float* GG = (const float*)(F.ws + WS_GATES + GO_G); const float* GPML = (const float*)(F.ws + WS_GATES + GO_PML); float* MPREV = (float*)(F.ws + WS_GATES + GO_MPREV);
    const int nthreads = F.G * NTHR;
    for (int gi = F.vcu * NTHR + F.tid; gi < 8 * 16384; gi += nthreads) {
        const int dh = gi >> 14, e4 = gi & 16383;
        bf16_t* base = WSP(bf16_t, WS_CST) + ((size_t)dh * 128 << 16) + e4 * 4;
        float st0 = 0.f, st1 = 0.f, st2 = 0.f, st3 = 0.f, m = 0.f;
#pragma unroll 1
        for (int c0 = 0; c0 < 128; c0 += 8) {
            u32x2 ld[8];
#pragma unroll
            for (int q = 0; q < 8; ++q) ld[q] = *(const u32x2*)(base + ((size_t)(c0 + q) << 16));
#pragma unroll
            for (int q = 0; q < 8; ++q) { const int c = c0 + q;
                const float g = GG[dh * 128 + c], amax = g + GPML[dh * 128 + c];
                const float mn = fmaxf(g + m, amax), dec = __expf(g + m - mn), add = __expf(amax - mn);
                if (e4 == 0) MPREV[dh * 128 + c] = m;
                u32x2 o; o.x = pk2(st0, st1); o.y = pk2(st2, st3);
                *(u32x2*)(base + ((size_t)c << 16)) = o;
                st0 = dec * st0 + add * bflo(ld[q].x); st1 = dec * st1 + add * bfhi(ld[q].x); st2 = dec * st2 + add * bflo(ld[q].y); st3 = dec * st3 + add * bfhi(ld[q].y);
                m = mn; }
        }
    }
    for (int gi = F.vcu * NTHR + F.tid; gi < 8 * 256; gi += nthreads) {
        const int dh = gi >> 8, e = gi & 255;
        float* base = (float*)(F.ws + WS_NST) + (size_t)dh * 128 * 256 + e;
        float st = 0.f, m = 0.f;
#pragma unroll 4
        for (int c = 0; c < 128; ++c) {
            const float g = GG[dh * 128 + c], amax = g + GPML[dh * 128 + c];
            const float mn = fmaxf(g + m, amax), dec = __expf(g + m - mn), add = __expf(amax - mn);
            const float ld = base[c * 256]; base[c * 256] = st; st = dec * st + add * ld; m = mn; }
    }
}

constexpr int MLB_PIECE = 34816;
constexpr int MLB_PKC = 528, MLB_PTR = 544, MLB_PP = 272;
constexpr int MLB_OFF_P = 2 * MLB_PIECE;
constexpr int MLB_OFF_N = MLB_OFF_P + 2 * 8 * 16 * MLB_PP;
static_assert(MLB_OFF_N + 2048 <= LDSCTL_OFF, "mLSTM-B LDS map");
__device__ __forceinline__ void ph_mlb(const Frame& F) {
    const int wave = F.wave;
    const float* GB = (const float*)(F.ws + WS_GATES + GO_B); const float* GU = (const float*)(F.ws + WS_GATES + GO_U); const float* GPM = (const float*)(F.ws + WS_GATES + GO_PM);
    const float* MPREV = (const float*)(F.ws + WS_GATES + GO_MPREV);
    LAS unsigned char* buf0 = F.lds; LAS unsigned char* buf1 = F.lds + MLB_PIECE;
    LAS float* nprev = (LAS float*)(F.lds + MLB_OFF_N);
    for (int unit = F.vcu; unit < 512; unit += F.G) {
        int tid = F.tid; asm volatile("" : "+v"(tid));
        const int lane = tid & 63, g = lane >> 4, i = lane & 15;
        const int head = unit >> 7, tc = unit & 127, t0 = tc * 128, j0 = 16 * wave;
        const bf16_t* mkp = WSP(bf16_t, WS_MK) + (size_t)t0 * 1024 + head * 256;
        const bf16_t* mvp = WSP(bf16_t, WS_PROJ) + (size_t)t0 * INP + C_MV + head * 256;
        const int c_f = tc, c_b = 127 - tc;
        u32x4 stg[4];
        const int sr = tid >> 5, sc8 = (tid & 31) * 8;
#define PIECE_LOAD(srcp, pitch_el) do { _Pragma("unroll") for (int q_ = 0; q_ < 4; ++q_) stg[q_] = *(const u32x4*)((srcp) + (size_t)(sr + 16 * q_) * (pitch_el) + sc8); } while (0)
#define PIECE_WRITE(dstbuf, pitchB) do { _Pragma("unroll") for (int q_ = 0; q_ < 4; ++q_) *(LAS u32x4*)((dstbuf) + (sr + 16 * q_) * (pitchB) + sc8 * 2) = stg[q_]; } while (0)
        { const int d = tid >> 8, e = tid & 255; nprev[d * 256 + e] = ((const float*)(F.ws + WS_NST))[(size_t)((d * 4 + head) * 128 + (d ? c_b : c_f)) * 256 + e]; }
        bf16x8 qa[8];
        {   const bf16_t* mq = WSP(bf16_t, WS_MQ) + (size_t)(t0 + j0 + i) * 1024 + head * 256 + 8 * g;
#pragma unroll
            for (int s = 0; s < 8; ++s) qa[s] = *(const bf16x8*)(mq + 32 * s); }
        f32x4 sacc[8];
#pragma unroll
        for (int n = 0; n < 8; ++n) sacc[n] = (f32x4){0.f, 0.f, 0.f, 0.f};
        PIECE_LOAD(mkp, 1024); PIECE_WRITE(buf0, MLB_PKC);
        PIECE_LOAD(mkp + (size_t)64 * 1024, 1024);
        __syncthreads();
#pragma unroll
        for (int n = 0; n < 4; ++n)
            { _Pragma("unroll") for (int s = 0; s < 8; ++s) sacc[n] = MFMA16(qa[s], frag_kc(buf0, MLB_PKC, 16 * n, 32 * s, lane), sacc[n]); __builtin_amdgcn_sched_barrier(0); }
        PIECE_WRITE(buf1, MLB_PKC);
        __syncthreads();
#pragma unroll
        for (int n = 0; n < 4; ++n)
            { _Pragma("unroll") for (int s = 0; s < 8; ++s) sacc[4 + n] = MFMA16(qa[s], frag_kc(buf1, MLB_PKC, 16 * n, 32 * s, lane), sacc[4 + n]); __builtin_amdgcn_sched_barrier(0); }
        const bf16_t* cst0 = WSP(bf16_t, WS_CST) + ((size_t)((0 * 4 + head) * 128 + c_f) << 16);
        const bf16_t* cst1 = WSP(bf16_t, WS_CST) + ((size_t)((1 * 4 + head) * 128 + c_b) << 16);
        PIECE_LOAD(cst0, 256);
        float qsc0, qsc1;
#pragma unroll
        for (int d = 0; d < 2; ++d) {
            const int dh = d * 4 + head; const float mp = MPREV[dh * 128 + (d ? c_b : c_f)];
            f32x4 dacc = (f32x4){0.f, 0.f, 0.f, 0.f};
#pragma unroll
            for (int s = 0; s < 8; ++s) { bf16x8 bn; const LAS float* np = nprev + d * 256 + 32 * s + 8 * g;
#pragma unroll
                for (int e = 0; e < 8; ++e) bn[e] = (i == 0) ? (short)f2bf(np[e]) : (short)0;
                dacc = MFMA16(qa[s], bn, dacc); }
            float ur[8];
#pragma unroll
            for (int n = 0; n < 8; ++n) ur[n] = GU[(size_t)dh * S + t0 + 16 * n + i];
            LAS unsigned char* pw = F.lds + MLB_OFF_P + (d * 8 + wave) * (16 * MLB_PP);
            float es[4];
#pragma unroll
            for (int rg = 0; rg < 4; ++rg) { const int jl = 4 * g + rg, j = j0 + jl;
                const float M = fmaxf(mp, GPM[(size_t)dh * S + t0 + j]), ej = __expf(mp - M), mj = GB[(size_t)dh * S + t0 + j] + M;
                float rs = 0.f;
#pragma unroll
                for (int n = 0; n < 8; ++n) { const int r = 16 * n + i; const bool keep = d ? (r >= j) : (r <= j); rs += keep ? sacc[n][rg] * __expf(ur[n] - M) : 0.f; }
                rs += __shfl_xor(rs, 1); rs += __shfl_xor(rs, 2); rs += __shfl_xor(rs, 4); rs += __shfl_xor(rs, 8);
                const float qn = __shfl(dacc[rg], lane & 48);
                const float den = ej * qn + rs, sj = 1.0f / fmaxf(fabsf(den), __expf(-mj));
                es[rg] = ej * sj;
#pragma unroll
                for (int n = 0; n < 8; ++n) { const int r = 16 * n + i; const bool keep = d ? (r >= j) : (r <= j);
                    const float p = keep ? sacc[n][rg] * __expf(ur[n] - M) * sj : 0.f;
                    *(LAS bf16_t*)(pw + jl * MLB_PP + r * 2) = (bf16_t)f2bf(p); } }
            const int srcl = (i >> 2) << 4;
            const float t0_ = __shfl(es[0], srcl), t1_ = __shfl(es[1], srcl), t2_ = __shfl(es[2], srcl), t3_ = __shfl(es[3], srcl);
            const float qs_ = (i & 3) == 0 ? t0_ : (i & 3) == 1 ? t1_ : (i & 3) == 2 ? t2_ : t3_;
            if (d == 0) qsc0 = qs_; else qsc1 = qs_;
        }
        __syncthreads();
        f32x4 hacc[16];
#pragma unroll
        for (int n = 0; n < 16; ++n) hacc[n] = (f32x4){0.f, 0.f, 0.f, 0.f};
#pragma unroll
        for (int d = 0; d < 2; ++d) {
            const bf16_t* cst = d ? cst1 : cst0; const float qsc = d ? qsc1 : qsc0;
            bf16x8 qs[8];
#pragma unroll
            for (int s = 0; s < 8; ++s) { const u32x4 w = __builtin_bit_cast(u32x4, qa[s]); u32x4 o;
                o.x = pk2(bflo(w.x) * qsc, bfhi(w.x) * qsc); o.y = pk2(bflo(w.y) * qsc, bfhi(w.y) * qsc); o.z = pk2(bflo(w.z) * qsc, bfhi(w.z) * qsc); o.w = pk2(bflo(w.w) * qsc, bfhi(w.w) * qsc);
                qs[s] = __builtin_bit_cast(bf16x8, o); }
#pragma unroll
            for (int cp = 0; cp < 4; ++cp) {
                LAS unsigned char* cur = (cp & 1) ? buf1 : buf0;
                PIECE_WRITE(cur, MLB_PKC);
                if (cp < 3) PIECE_LOAD(cst + (size_t)(64 * (cp + 1)) * 256, 256); else PIECE_LOAD(mvp, INP);
                __syncthreads();
#pragma unroll
                for (int n = 0; n < 4; ++n)
                    { _Pragma("unroll") for (int s = 0; s < 8; ++s) hacc[4 * cp + n] = MFMA16(qs[s], frag_kc(cur, MLB_PKC, 16 * n, 32 * s, lane), hacc[4 * cp + n]); __builtin_amdgcn_sched_barrier(0); }
            }
            LAS const unsigned char* pw = F.lds + MLB_OFF_P + (d * 8 + wave) * (16 * MLB_PP);
#pragma unroll
            for (int vp = 0; vp < 2; ++vp) {
                LAS unsigned char* cur = (vp & 1) ? buf1 : buf0;
                PIECE_WRITE(cur, MLB_PTR);
                if (vp == 0) PIECE_LOAD(mvp + (size_t)64 * INP, INP); else if (d == 0) PIECE_LOAD(cst1, 256);
                __syncthreads();
#pragma unroll
                for (int ks = 0; ks < 2; ++ks) { const bf16x8 a = *(LAS const bf16x8*)(pw + i * MLB_PP + (64 * vp + 32 * ks + 8 * g) * 2);
#pragma unroll
                    for (int n = 0; n < 16; ++n) { hacc[n] = MFMA16(a, frag_tr(cur, MLB_PTR, 32 * ks, 16 * n, lane), hacc[n]); if ((n & 3) == 3) __builtin_amdgcn_sched_barrier(0); } }
            }
            __syncthreads();
        }
        {   const float* mg = FIN(8) + head * 256;
            const bf16_t* mo = WSP(bf16_t, WS_PROJ) + C_MO + head * 256; bf16_t* y = WSP(bf16_t, WS_Y) + 1024 + head * 256;
#pragma unroll
            for (int rg = 0; rg < 4; ++rg) { float ss = 0.f;
#pragma unroll
                for (int n = 0; n < 16; ++n) ss += hacc[n][rg] * hacc[n][rg];
                ss += __shfl_xor(ss, 1); ss += __shfl_xor(ss, 2); ss += __shfl_xor(ss, 4); ss += __shfl_xor(ss, 8);
                const float r = 1.0f / sqrtf(ss * (1.f / 256.f) + EPS); const size_t t = (size_t)(t0 + j0 + 4 * g + rg);
#pragma unroll
                for (int n = 0; n < 16; ++n) { const int col = 16 * n + i; const float o = bflo((unsigned)mo[t * INP + col]);
                    #if defined(DBG_ZERO_ML)
                    y[t * DM + col] = 0;
#else
                    y[t * DM + col] = (bf16_t)f2bf(hacc[n][rg] * r * mg[col] * (1.f / (1.f + __expf(-o))));
#endif
                    } }
        }
#undef PIECE_LOAD
#undef PIECE_WRITE
    }
}

#define MFMA32(a, b, c) __builtin_amdgcn_mfma_f32_32x32x16_bf16((a), (b), (c), 0, 0, 0)
__device__ __forceinline__ int fkey(float x) { const int b = __builtin_bit_cast(int, x); return b ^ ((b >> 31) & 0x7fffffff); }
__device__ __forceinline__ float kval(int k) { return __builtin_bit_cast(float, k ^ ((k >> 31) & 0x7fffffff)); }
#define TOP_INS(top, x) do { int x_ = (x); _Pragma("unroll") for (int k_ = 0; k_ < 16; ++k_) { const int hi_ = max(top[k_], x_); x_ = min(top[k_], x_); top[k_] = hi_; } } while (0)
__device__ __forceinline__ int pick4(int sel, int a, int b, int c, int d) { return sel == 0 ? a : sel == 1 ? b : sel == 2 ? c : d; }
__device__ __forceinline__ void topk_item(const Frame& F, int layer, int item) {
    const int tile = item >> 3, h = item & 7, lane = F.lane, r32 = lane & 31, hi = lane >> 5;
    const int t = tile * 32 + r32;
    const bf16_t* qrow = WSP(bf16_t, WS_QP) + (size_t)t * DM + h * 256 + 8 * hi;
    int tops[2][16];
#pragma unroll
    for (int p = 0; p < 2; ++p) {
        const bf16_t* keys = WSP(bf16_t, WS_KEYS) + (size_t)(((layer * 8 + h) * 2 + p) * 128) * 128 + 8 * hi;
        bf16x8 bq[8];
#pragma unroll
        for (int s = 0; s < 8; ++s) bq[s] = *(const bf16x8*)(qrow + p * 128 + 16 * s);
        int top[16];
#pragma unroll
        for (int k = 0; k < 16; ++k) top[k] = (int)0x80000000;
#pragma unroll
        for (int kt = 0; kt < 4; ++kt) {
            f32x16 acc = {};
#pragma unroll
            for (int s = 0; s < 8; ++s) { const bf16x8 a = *(const bf16x8*)(keys + (size_t)(32 * kt + r32) * 128 + 16 * s); acc = MFMA32(a, bq[s], acc); }
#pragma unroll
            for (int r = 0; r < 16; ++r) { const int idx = 32 * kt + (r & 3) + 8 * (r >> 2) + 4 * hi; TOP_INS(top, (fkey(acc[r]) & ~127) | idx); }
        }
        int pt[16];
#pragma unroll
        for (int k = 0; k < 16; ++k) pt[k] = __shfl_xor(top[k], 32);
#pragma unroll
        for (int k = 0; k < 16; ++k) TOP_INS(top, pt[k]);
#pragma unroll
        for (int k = 0; k < 16; ++k) tops[p][k] = top[k];
    }
    float af[16], bfv[16];
#pragma unroll
    for (int k = 0; k < 16; ++k) { af[k] = kval(tops[0][k] & ~127); bfv[k] = kval(tops[1][k] & ~127); }
    int top2[16];
#pragma unroll
    for (int k = 0; k < 16; ++k) top2[k] = (int)0x80000000;
#pragma unroll
    for (int i = 0; i < 16; ++i)
#pragma unroll
        for (int j = 0; j < 16; ++j) if ((i + 1) * (j + 1) <= 16) TOP_INS(top2, (fkey(af[i] + bfv[j]) & ~255) | (i << 4) | j);
    int pa[4], pb[4];
#pragma unroll
    for (int q = 0; q < 4; ++q) { pa[q] = (tops[0][4 * q] & 127) | ((tops[0][4 * q + 1] & 127) << 8) | ((tops[0][4 * q + 2] & 127) << 16) | ((tops[0][4 * q + 3] & 127) << 24);
                                  pb[q] = (tops[1][4 * q] & 127) | ((tops[1][4 * q + 1] & 127) << 8) | ((tops[1][4 * q + 2] & 127) << 16) | ((tops[1][4 * q + 3] & 127) << 24); }
    int ex[16]; float sc[16];
#pragma unroll
    for (int k = 0; k < 16; ++k) { const int code = top2[k] & 255, ii = code >> 4, jj = code & 15;
        const int ea = (pick4(ii >> 2, pa[0], pa[1], pa[2], pa[3]) >> ((ii & 3) * 8)) & 127, eb = (pick4(jj >> 2, pb[0], pb[1], pb[2], pb[3]) >> ((jj & 3) * 8)) & 127;
        ex[k] = ea * 128 + eb; sc[k] = kval(top2[k] & ~255); }
    const float mx = sc[0]; float sum = 0.f;
#pragma unroll
    for (int k = 0; k < 16; ++k) { sc[k] = __expf(sc[k] - mx); sum += sc[k]; }
    const float inv = 1.0f / sum;
    if (hi == 0) { int* d = WSP(int, WS_EIDX) + (size_t)t * 128 + h * 16;
#pragma unroll
        for (int q = 0; q < 4; ++q) *(u32x4*)(d + 4 * q) = (u32x4){(unsigned)ex[4 * q], (unsigned)ex[4 * q + 1], (unsigned)ex[4 * q + 2], (unsigned)ex[4 * q + 3]}; }
    else { float* d = WSP(float, WS_EGATE) + (size_t)t * 128 + h * 16;
#pragma unroll
        for (int q = 0; q < 4; ++q) *(f32x4*)(d + 4 * q) = (f32x4){sc[4 * q] * inv, sc[4 * q + 1] * inv, sc[4 * q + 2] * inv, sc[4 * q + 3] * inv}; }
}
__device__ __forceinline__ void ph_topk(const Frame& F, int layer) {
    const int gw = F.vcu * NWAVES + F.wave, NGW = F.G * NWAVES;
    for (int it = gw; it < 4096; it += NGW) topk_item(F, layer, it);
}

typedef __bf16 bf2 __attribute__((ext_vector_type(2)));
__device__ __forceinline__ float dot2bf(unsigned a, unsigned b, float c) { return __builtin_amdgcn_fdot2_f32_bf16(__builtin_bit_cast(bf2, a), __builtin_bit_cast(bf2, b), c, false); }
constexpr int GA_OFF = 0;
__device__ __forceinline__ void ph_gather(const Frame& F, int layer, bool final_layer) {
    const int lane = F.lane, gw = F.vcu * NWAVES + F.wave, NGW = F.G * NWAVES;
    LAS float* wact = (LAS float*)(F.lds + GA_OFF + F.wave * 1024);
    const bf16_t* U = WSP(bf16_t, WS_UB) + (size_t)layer * 16384 * 2048; const bf16_t* V = WSP(bf16_t, WS_VB) + (size_t)layer * 16384 * 2048;
    const float* gnext = final_layer ? FIN(16) : (FIN(1) + DM);
    for (int t = gw; t < S; t += NGW) {
        u32x4 xp[4];
#pragma unroll
        for (int j = 0; j < 4; ++j) xp[j] = *(const u32x4*)(WSP(bf16_t, WS_XN) + (size_t)t * DM + (lane + 64 * j) * 8);
        const int idl = WSP(int, WS_EIDX)[(size_t)t * 128 + lane], idh = WSP(int, WS_EIDX)[(size_t)t * 128 + 64 + lane];
        const float gl = WSP(float, WS_EGATE)[(size_t)t * 128 + lane], gh = WSP(float, WS_EGATE)[(size_t)t * 128 + 64 + lane];
#pragma unroll 1
        for (int b = 0; b < 16; ++b) {
            u32x4 ur[8][4];
#pragma unroll
            for (int e = 0; e < 8; ++e) { const int k = 8 * b + e; const int id = __builtin_amdgcn_readlane(b < 8 ? idl : idh, k & 63);
                const bf16_t* row = U + (size_t)id * DM + lane * 8;
#pragma unroll
                for (int j = 0; j < 4; ++j) ur[e][j] = *(const u32x4*)(row + 512 * j); }
            float v[8];
#pragma unroll
            for (int e = 0; e < 8; ++e) { float a = 0.f;
#pragma unroll
                for (int j = 0; j < 4; ++j) { a = dot2bf(ur[e][j].x, xp[j].x, a); a = dot2bf(ur[e][j].y, xp[j].y, a); a = dot2bf(ur[e][j].z, xp[j].z, a); a = dot2bf(ur[e][j].w, xp[j].w, a); }
                v[e] = a; }
            float r4[4], r2[2], z;
            { const bool up = lane & 32;
#pragma unroll
              for (int q = 0; q < 4; ++q) { const float keep = up ? v[q + 4] : v[q], give = up ? v[q] : v[q + 4]; r4[q] = keep + __shfl_xor(give, 32); } }
            { const bool up = lane & 16;
#pragma unroll
              for (int q = 0; q < 2; ++q) { const float keep = up ? r4[q + 2] : r4[q], give = up ? r4[q] : r4[q + 2]; r2[q] = keep + __shfl_xor(give, 16); } }
            { const bool up = lane & 8; const float keep = up ? r2[1] : r2[0], give = up ? r2[0] : r2[1]; z = keep + __shfl_xor(give, 8); }
            z += __shfl_xor(z, 4); z += __shfl_xor(z, 2); z += __shfl_xor(z, 1);
            if ((lane & 7) == 0) wact[8 * b + ((lane >> 5) & 1) * 4 + ((lane >> 4) & 1) * 2 + ((lane >> 3) & 1)] = z;
        }
        { const float a0 = wact[lane], a1 = wact[64 + lane];
          const float w0 = 0.5f * a0 * (1.f + erff(a0 * 0.70710678118654752f)) * gl, w1 = 0.5f * a1 * (1.f + erff(a1 * 0.70710678118654752f)) * gh;
          wact[lane] = w0; wact[64 + lane] = w1; }
        float out[32];
#pragma unroll
        for (int q = 0; q < 32; ++q) out[q] = 0.f;
#pragma unroll 1
        for (int b = 0; b < 32; ++b) {
            u32x4 vr[4][4]; float w[4];
#pragma unroll
            for (int e = 0; e < 4; ++e) { const int k = 4 * b + e; const int id = __builtin_amdgcn_readlane(b < 16 ? idl : idh, k & 63);
                const bf16_t* row = V + (size_t)id * DM + lane * 8; w[e] = wact[k];
#pragma unroll
                for (int j = 0; j < 4; ++j) vr[e][j] = *(const u32x4*)(row + 512 * j); }
#pragma unroll
            for (int e = 0; e < 4; ++e)
#pragma unroll
                for (int j = 0; j < 4; ++j) { const unsigned ww[4] = {vr[e][j].x, vr[e][j].y, vr[e][j].z, vr[e][j].w};
#pragma unroll
                    for (int q = 0; q < 4; ++q) { out[8 * j + 2 * q] += w[e] * bflo(ww[q]); out[8 * j + 2 * q + 1] += w[e] * bfhi(ww[q]); } }
        }
#if defined(DBG_ZERO_PEER)
#pragma unroll
        for (int q = 0; q < 32; ++q) out[q] = 0.f;
#endif
        float* hrow = WSP(float, WS_H) + (size_t)t * DM; float ss = 0.f;
#pragma unroll
        for (int j = 0; j < 4; ++j) { const f32x4 a = *(const f32x4*)(hrow + (lane + 64 * j) * 8), c = *(const f32x4*)(hrow + (lane + 64 * j) * 8 + 4);
            out[8 * j + 0] += a.x; out[8 * j + 1] += a.y; out[8 * j + 2] += a.z; out[8 * j + 3] += a.w; out[8 * j + 4] += c.x; out[8 * j + 5] += c.y; out[8 * j + 6] += c.z; out[8 * j + 7] += c.w; }
#pragma unroll
        for (int q = 0; q < 32; ++q) ss += out[q] * out[q];
        const float r = 1.0f / sqrtf(wave_sum(ss) * (1.f / DM) + EPS);
#pragma unroll
        for (int j = 0; j < 4; ++j) { const int c0 = (lane + 64 * j) * 8; const f32x4 g0 = *(const f32x4*)(gnext + c0), g1 = *(const f32x4*)(gnext + c0 + 4);
            if (final_layer) { *(f32x4*)(FOUT() + (size_t)t * DM + c0) = (f32x4){out[8 * j] * r * g0.x, out[8 * j + 1] * r * g0.y, out[8 * j + 2] * r * g0.z, out[8 * j + 3] * r * g0.w};
                               *(f32x4*)(FOUT() + (size_t)t * DM + c0 + 4) = (f32x4){out[8 * j + 4] * r * g1.x, out[8 * j + 5] * r * g1.y, out[8 * j + 6] * r * g1.z, out[8 * j + 7] * r * g1.w}; }
            else { *(f32x4*)(hrow + c0) = (f32x4){out[8 * j], out[8 * j + 1], out[8 * j + 2], out[8 * j + 3]}; *(f32x4*)(hrow + c0 + 4) = (f32x4){out[8 * j + 4], out[8 * j + 5], out[8 * j + 6], out[8 * j + 7]};
                   u32x4 o; o.x = pk2(out[8 * j] * r * g0.x, out[8 * j + 1] * r * g0.y); o.y = pk2(out[8 * j + 2] * r * g0.z, out[8 * j + 3] * r * g0.w);
                   o.z = pk2(out[8 * j + 4] * r * g1.x, out[8 * j + 5] * r * g1.y); o.w = pk2(out[8 * j + 6] * r * g1.z, out[8 * j + 7] * r * g1.w);
                   *(u32x4*)(WSP(bf16_t, WS_XN) + (size_t)t * DM + c0) = o; } }
    }
}

__device__ __forceinline__ void ph_poolprep(const Frame& F) {
    const int lane = F.lane, gw = F.vcu * NWAVES + F.wave, NGW = F.G * NWAVES;
    const bf16_t* xn = WSP(bf16_t, WS_XN);
    for (int t = gw; t < S; t += NGW) {
#pragma unroll
        for (int j = 0; j < 4; ++j) {
            const int half = 1 << j, lo = max(t - half, 0), hi = min(t + half, S), c0 = (lane + 64 * j) * 8;
            float a[8];
#pragma unroll
            for (int q = 0; q < 8; ++q) a[q] = 0.f;
            for (int r = lo; r < hi; ++r) { const u32x4 x = *(const u32x4*)(xn + (size_t)r * DM + c0);
                a[0] += bflo(x.x); a[1] += bfhi(x.x); a[2] += bflo(x.y); a[3] += bfhi(x.y); a[4] += bflo(x.z); a[5] += bfhi(x.z); a[6] += bflo(x.w); a[7] += bfhi(x.w); }
            const u32x4 x = *(const u32x4*)(xn + (size_t)t * DM + c0); const float ic = 1.0f / (float)(hi - lo);
            u32x4 o; o.x = pk2(a[0] * ic - bflo(x.x), a[1] * ic - bfhi(x.x)); o.y = pk2(a[2] * ic - bflo(x.y), a[3] * ic - bfhi(x.y));
            o.z = pk2(a[4] * ic - bflo(x.z), a[5] * ic - bfhi(x.z)); o.w = pk2(a[6] * ic - bflo(x.w), a[7] * ic - bfhi(x.w));
            *(u32x4*)(WSP(bf16_t, WS_POOLED) + (size_t)t * DM + c0) = o;
        }
    }
}
__device__ __forceinline__ void ph_norm(const Frame& F, int layer) {
    const int gw = F.vcu * NWAVES + F.wave, NGW = F.G * NWAVES;
    for (int m = gw; m < S; m += NGW) rms_row_to_bf16(WSP(float, WS_H) + (size_t)m * DM, FIN(2) + layer * DM, WSP(bf16_t, WS_XN) + (size_t)m * DM, F.lane);
}

__device__ __forceinline__ void ph_attn(const Frame& F) {
    const int nunits = 8 * 64;
    for (int u = F.vcu * 2; u < nunits; u += F.G * 2)
#pragma unroll 1
        for (int k = 0; k < 2; ++k) { const int unit = u + k, head = unit >> 6, qb = unit & 63, kvh = head >> 2;
            att::attn_dense_body<att::bf16>(WSP(att::bf16, WS_QB) + (size_t)(qb * 256) * 1024 + head * 128, WSP(att::bf16, WS_KVB) + kvh * 128, WSP(att::bf16, WS_KVB) + 256 + kvh * 128,
                                 WSP(att::bf16, WS_Y) + (size_t)(qb * 256) * DM + head * 128, S, F.ldsg); }
}

#ifndef PHASE_MASK
#define PHASE_MASK 0x3ffff
#endif
#define PH_ON(k) (((PHASE_MASK) >> (k)) & 1)
struct Args { const float* in[17]; float* out; unsigned char* ws; int ph_lo, ph_hi; };
static_assert(sizeof(Args) == 17 * 8 + 8 + 8 + 8, "Args has no padding");
__global__ void __launch_bounds__(NTHR, 2) fwd_kernel(Args args) {
    extern __shared__ __attribute__((aligned(16))) unsigned char lds[];
    Frame F;
    F.lds = (LAS unsigned char*)lds; F.ldsg = (char*)lds;
    F.tid = threadIdx.x; F.lane = F.tid & 63; F.wave = __builtin_amdgcn_readfirstlane(F.tid >> 6);
    F.G = gridDim.x; { const int bx = blockIdx.x; F.vcu = (F.G % 8 == 0) ? (bx % 8) * (F.G / 8) + bx / 8 : bx; }
    F.ws = args.ws;
    volatile LAS unsigned* MISC = (volatile LAS unsigned*)(F.lds + LDSCTL_OFF);
    if (F.tid < 16) ((LAS unsigned*)(F.lds + LDSCTL_OFF))[F.tid] = 0u;
    if (F.tid >= 64 && F.tid < 64 + 36) ((LAS unsigned*)(F.lds + LDSCTL_OFF + 64))[F.tid - 64] = ((const unsigned*)&args)[F.tid - 64];
    __syncthreads();
    const int lo = args.ph_lo, hi = args.ph_hi;
    XcdBarrier bar; bar.bar = (unsigned*)(F.ws + WS_CTL) + CW_BAR; bar.x = 0; bar.st = nullptr;
    if (hi - lo > 1) bar = xcd_barrier_post((unsigned*)(F.ws + WS_CTL) + CW_BAR, MISC + 8);
#pragma unroll 1
    for (int ph = lo; ph < hi; ++ph) {
        if (ph > lo) xcd_barrier(bar);
        { int t_ = threadIdx.x; asm volatile("" : "+v"(t_)); F.tid = t_; F.lane = t_ & 63; F.wave = __builtin_amdgcn_readfirstlane(t_ >> 6);
          unsigned long long w_ = (unsigned long long)args.ws; asm volatile("" : "+s"(w_)); F.ws = (unsigned char*)w_; }
        switch (ph) {
#define PHM(n) asm volatile("; PHASE_MARK " #n ::: "memory")
        case PH_PRO: if constexpr (PH_ON(PH_PRO)) { PHM(PH_PRO); ph_prologue(F); } break;
        case PH_GEMM_IN: if constexpr (PH_ON(PH_GEMM_IN)) { PHM(PH_GEMM_IN);  pg8::Gemm g{WSP(bf16_t, WS_XN), WSP(bf16_t, WS_WIN), S, INP, DM, DM, DM, 0, 0}; pg8::StaticOrder So; So.init(S, INP, F.G, (int)blockIdx.x);
            pg8::EpiBf16<0> E{WSP(bf16_t, WS_PROJ), INP, nullptr, 0, 0, 1.f};
            pg8::gemm_phase<pg8::EpiBf16<0>, pg8::StaticOrder, true, true>(F.lds, g, So, E); } break;
        case PH_POST: if constexpr (PH_ON(PH_POST)) { PHM(PH_POST); ph_post(F); } break;
        case PH_ATTN: if constexpr (PH_ON(PH_ATTN)) { PHM(PH_ATTN); ph_attn(F); } break;
        case PH_MLA: if constexpr (PH_ON(PH_MLA)) { PHM(PH_MLA); ph_mla(F); } break;
        case PH_SCAN: if constexpr (PH_ON(PH_SCAN)) { PHM(PH_SCAN); ph_scan(F); } break;
        case PH_MLB: if constexpr (PH_ON(PH_MLB)) { PHM(PH_MLB); ph_mlb(F); } break;
        case PH_GEMM_OUT: if constexpr (PH_ON(PH_GEMM_OUT)) { PHM(PH_GEMM_OUT);  pg8::Gemm g{WSP(bf16_t, WS_Y), WSP(bf16_t, WS_WOUT), S, DM, DM, DM, DM, 0, 0}; pg8::StaticOrder So; So.init(S, DM, F.G, (int)blockIdx.x);
            pg8::EpiResF32 E{FIN(0), WSP(float, WS_H), DM, nullptr};
            pg8::gemm_phase<pg8::EpiResF32, pg8::StaticOrder, true, true>(F.lds, g, So, E); } break;
        case PH_NORM0: if constexpr (PH_ON(PH_NORM0)) { PHM(PH_NORM0); ph_norm(F, 0); } break;
        case PH_NORM1: if constexpr (PH_ON(PH_NORM1)) { PHM(PH_NORM1); ph_norm(F, 1); } break;
        case PH_GEMM_Q0: case PH_GEMM_Q1: if constexpr (PH_ON(PH_GEMM_Q0)) { PHM(PH_GEMM_Q0);  pg8::Gemm g{WSP(bf16_t, WS_XN), WSP(bf16_t, ph == PH_GEMM_Q0 ? WS_WQ0 : WS_WQ1), S, DM, DM, DM, DM, 0, 0}; pg8::StaticOrder So; So.init(S, DM, F.G, (int)blockIdx.x);
            pg8::EpiBf16<0> E{WSP(bf16_t, WS_QP), DM, nullptr, 0, 0, 1.f};
            pg8::gemm_phase<pg8::EpiBf16<0>, pg8::StaticOrder, true, true>(F.lds, g, So, E); } break;
        case PH_TOPK0: if constexpr (PH_ON(PH_TOPK0)) { PHM(PH_TOPK0); ph_topk(F, 0); } break;
        case PH_TOPK1: if constexpr (PH_ON(PH_TOPK1)) { PHM(PH_TOPK1); ph_topk(F, 1); } break;
        case PH_GATHER0: if constexpr (PH_ON(PH_GATHER0)) { PHM(PH_GATHER0); ph_gather(F, 0, false); } break;
        case PH_GATHER1: if constexpr (PH_ON(PH_GATHER1)) { PHM(PH_GATHER1); ph_gather(F, 1, true); } break;
        case PH_POOLPREP: if constexpr (PH_ON(PH_POOLPREP)) { PHM(PH_POOLPREP); ph_poolprep(F); } break;
        case PH_GEMM_POOL: if constexpr (PH_ON(PH_GEMM_POOL)) { PHM(PH_GEMM_POOL);  pg8::Gemm g{WSP(bf16_t, WS_POOLED), WSP(bf16_t, WS_WPOOL), S, DM, 512, DM, 512, 1, 512 * 2}; pg8::StaticOrder So; So.init(S, DM, F.G, (int)blockIdx.x);
            pg8::EpiResF32 E{WSP(float, WS_H), WSP(float, WS_H), DM, FIN(11)};
            pg8::gemm_phase<pg8::EpiResF32, pg8::StaticOrder, true, true>(F.lds, g, So, E); } break;
        default: break;
        }
    }
}

#ifndef N_LAUNCH_MODE
#define N_LAUNCH_MODE 1
#endif
extern "C" void kernel_launch(void* const* d_in, const int* in_sizes, int n_in, void* d_out, int out_size, void* d_ws, size_t ws_size, hipStream_t stream) {
    static int grid = 0;
    if (grid == 0) {
        if (n_in != 17 || in_sizes[0] != S * DM || out_size != S * DM || ws_size < WS_END) { fprintf(stderr, "kernel_launch: unexpected shapes (n_in %d, in0 %d, out %d, ws %zu; need ws >= %zu)\n", n_in, n_in > 0 ? in_sizes[0] : -1, out_size, ws_size, (size_t)WS_END); grid = -1; return; }
        int dev = 0, cus = 0;
        if (hipGetDevice(&dev) != hipSuccess || hipDeviceGetAttribute(&cus, hipDeviceAttributeMultiprocessorCount, dev) != hipSuccess) { grid = -1; return; }
        if (hipFuncSetAttribute((const void*)fwd_kernel, hipFuncAttributeMaxDynamicSharedMemorySize, LDS_BYTES) != hipSuccess) { fprintf(stderr, "kernel_launch: hipFuncSetAttribute failed\n"); grid = -1; return; }
        int per_cu = 0;
        if (hipOccupancyMaxActiveBlocksPerMultiprocessor(&per_cu, (const void*)fwd_kernel, NTHR, LDS_BYTES) != hipSuccess || per_cu < 1) fprintf(stderr, "kernel_launch: occupancy query reports %d\n", per_cu);
        (void)hipGetLastError();
        grid = cus;
    }
    if (grid < 0) return;
    (void)hipMemsetAsync((char*)d_ws + WS_CTL, 0, CTL_ZERO_BYTES, stream);
    Args a{};
    for (int i = 0; i < 17; ++i) a.in[i] = (const float*)d_in[i];
    a.out = (float*)d_out; a.ws = (unsigned char*)d_ws;
#if N_LAUNCH_MODE == 1
    a.ph_lo = 0; a.ph_hi = NPH;
    hipLaunchKernelGGL(fwd_kernel, dim3(grid), dim3(NTHR), LDS_BYTES, stream, a);
#else
    for (int ph = 0; ph < NPH; ++ph) { a.ph_lo = ph; a.ph_hi = ph + 1; hipLaunchKernelGGL(fwd_kernel, dim3(grid), dim3(NTHR), LDS_BYTES, stream, a); }
#endif
    const hipError_t le = hipPeekAtLastError();
    if (le != hipSuccess) fprintf(stderr, "kernel_launch: launch failed: %s\n", hipGetErrorName(le));
}
```

```cpp
#include <hip/hip_runtime.h>
#include <hip/hip_bf16.h>
#include <cstdio>
#include <cstdint>
#include <cmath>

constexpr int S = 16384, DM = 2048, NWAVES = 8, NTHR = 512;
constexpr int INW = 5648, INP = 5888;
constexpr int C_AQ = 0, C_AK = 1024, C_AV = 1280, C_MQK = 1536, C_MV = 3584, C_MO = 4608, C_GATE = 5632;
constexpr float EPS = 1e-6f;
constexpr int NPH = 18;
enum { PH_PRO = 0, PH_GEMM_IN, PH_POST, PH_ATTN, PH_MLA, PH_SCAN, PH_MLB, PH_GEMM_OUT, PH_NORM0, PH_GEMM_Q0, PH_TOPK0, PH_GATHER0,
       PH_POOLPREP, PH_GEMM_POOL, PH_NORM1, PH_GEMM_Q1, PH_TOPK1, PH_GATHER1 };

constexpr size_t MiB = 1u << 20;
constexpr size_t WS_CTL = 0, CTL_ZERO_BYTES = 1 * MiB;
constexpr size_t WS_WIN = 1 * MiB, WS_WOUT = 24 * MiB, WS_WQ0 = 32 * MiB, WS_WQ1 = 40 * MiB, WS_WPOOL = 48 * MiB, WS_KEYS = 50 * MiB;
constexpr size_t WS_TSC = 52 * MiB + 768 * 1024  , WS_GATES = 51 * MiB, WS_NST = 53 * MiB, WS_EIDX = 54 * MiB, WS_EGATE = 62 * MiB;
constexpr size_t WS_UB = 70 * MiB, WS_VB = 198 * MiB, WS_XN = 326 * MiB, WS_PROJ = 390 * MiB, WS_QP = WS_PROJ;
constexpr size_t WS_QB = 574 * MiB, WS_KVB = 606 * MiB, WS_MQ = 622 * MiB, WS_MK = 654 * MiB, WS_CST = 686 * MiB, WS_Y = 814 * MiB, WS_POOLED = WS_Y;
constexpr size_t WS_H = 878 * MiB, WS_END = 1006 * MiB;
constexpr int CW_BAR = 4096;
constexpr size_t GO_B = 0, GO_U = 8 * S * 4, GO_PM = 2 * 8 * S * 4, GO_G = 3 * 8 * S * 4, GO_PML = GO_G + 4096, GO_MPREV = GO_PML + 4096;

constexpr int LDS_BYTES = 147456, LDSCTL_OFF = 146944;

#define GAS __attribute__((address_space(1)))
#define LAS __attribute__((address_space(3)))
typedef unsigned short bf16_t;
typedef short bf16x8 __attribute__((ext_vector_type(8)));
typedef short s16x4 __attribute__((ext_vector_type(4)));
typedef short v4i16_t __attribute__((ext_vector_type(4)));
typedef float f32x4 __attribute__((ext_vector_type(4)));
typedef float f32x2 __attribute__((ext_vector_type(2)));
typedef float f32x16 __attribute__((ext_vector_type(16)));
typedef unsigned u32x4 __attribute__((ext_vector_type(4)));
typedef unsigned u32x2 __attribute__((ext_vector_type(2)));
typedef __bf16 bf16x2_t __attribute__((ext_vector_type(2)));
typedef GAS unsigned gu32;
#define RLX_AGENT __ATOMIC_RELAXED, __HIP_MEMORY_SCOPE_AGENT
#define LDS_WAIT() asm volatile("s_waitcnt lgkmcnt(0)" ::: "memory")
__device__ __forceinline__ unsigned f2bf(float f) { unsigned u = __builtin_bit_cast(unsigned, f); return (u + 0x7fffu + ((u >> 16) & 1u)) >> 16; }
__device__ __forceinline__ unsigned pk2(float lo, float hi) { f32x2 v = {lo, hi}; bf16x2_t b = __builtin_convertvector(v, bf16x2_t); return __builtin_bit_cast(unsigned, b); }
__device__ __forceinline__ float bflo(unsigned w) { return __builtin_bit_cast(float, w << 16); }
__device__ __forceinline__ float bfhi(unsigned w) { return __builtin_bit_cast(float, w & 0xffff0000u); }
__device__ __forceinline__ float wave_sum(float v) {
#pragma unroll
    for (int o = 1; o < 64; o <<= 1) v += __shfl_xor(v, o);
    return v;
}

namespace pg8 {
#define PG8_LAS __attribute__((address_space(3)))
typedef unsigned short bf16_t;
typedef short bf16x8 __attribute__((ext_vector_type(8)));
typedef float f32x4 __attribute__((ext_vector_type(4)));
typedef unsigned u32x4 __attribute__((ext_vector_type(4)));
constexpr int BM = 256, BK = 64, HALF = 128, HTB = HALF * BK * 2  , STAGE_BYTES = 8 * HTB, NXCD = 8, WGM = 8;

__host__ __device__ __forceinline__ int lds_byte(int r, int c) { const int st = (r >> 4) * 2 + (c >> 5), rr = r & 15, cc = c & 31, ob = rr * 64 + cc * 2; return st * 1024 + (ob ^ (((ob >> 9) & 1) << 5)); }
__host__ __device__ __forceinline__ void stage_rc(int b, int& R, int& C) { const int st = b / 1024, sb = b % 1024, swz = sb ^ (((sb >> 9) & 1) << 5); R = (st >> 1) * 16 + swz / 64; C = (st & 1) * 32 + (swz % 64) / 2; }
__host__ __device__ __forceinline__ int perm32(int rho) { const int n = rho >> 4, i = rho & 15; return 8 * (i >> 2) + 4 * n + (i & 3); }

struct Unit { int pm, pn; };
struct Gemm { const bf16_t* A; const bf16_t* Bt; int M, N, K, lda, ldb, agrp_shift; size_t agrp_bytes; };

struct StaticOrder {
    int nM, nN, nwg, G, c;
    __host__ __device__ void init(int M, int N, int G_, int c_) { nM = M / BM; nN = N / BM; nwg = nM * nN; G = G_; c = c_; }
    __host__ __device__ bool next(int i, Unit& u) const {
        const long L = (long)i * G + c; if (L >= nwg) return false;
        int wgid = (int)L; { const int q = nwg / NXCD, r = nwg % NXCD, xcd = wgid % NXCD, off = wgid / NXCD; wgid = (xcd < r ? xcd * (q + 1) : r * (q + 1) + (xcd - r) * q) + off; }
        const int nig = WGM * nN, gid = wgid / nig, fm = gid * WGM, gsz = (nM - fm) < WGM ? (nM - fm) : WGM;
        u.pm = fm + ((wgid % nig) % gsz); u.pn = (wgid % nig) / gsz; return true;
    }
    __device__ __forceinline__ void a_ready(const Unit&) const {}
    __device__ __forceinline__ void done(const Unit&) const {}
};

__device__ __forceinline__ unsigned cvt_pk_bf16(float lo, float hi) { unsigned r; asm volatile("v_cvt_pk_bf16_f32 %0, %1, %2" : "=v"(r) : "v"(lo), "v"(hi)); return r; }
typedef float f32x2 __attribute__((ext_vector_type(2)));
__device__ __forceinline__ f32x2 gelu_pk(f32x2 v) {
    const f32x2 av = __builtin_elementwise_abs(v), d = av * 0.2316418882f + 1.0f;
    f32x2 t; t.x = __builtin_amdgcn_rcpf(d.x); t.y = __builtin_amdgcn_rcpf(d.y);
    f32x2 q = t * 0.5307027145f + (-0.7265760135f); q = q * t + 0.7107068705f; q = q * t + (-0.142248368f); q = q * t + 0.127414796f; q = q * t;
    const f32x2 s = (v * v) * (-0.72134752044f);
    f32x2 e; e.x = __builtin_amdgcn_exp2f(s.x); e.y = __builtin_amdgcn_exp2f(s.y);
    const f32x2 m = v * (q * e), r = v - m;
    f32x2 o; o.x = v.x < 0.f ? m.x : r.x; o.y = v.y < 0.f ? m.y : r.y; return o;
}
template <int ACT  > struct EpiBf16 {
    static constexpr bool PERM = true, AFTER_DRAIN = false; static_assert(ACT == 0 || ACT == 1, "EpiBf16: ACT is 0 (none) or 1 (gelu_pk)");
    bf16_t* O; int ldc; const float* bias; int split_cols; size_t split_stride; float scale0;
    __device__ __forceinline__ void operator()(const f32x4 (&acc)[2][2][4][2], const Unit& u, int wr, int wc, int fr, int fq) const {
        const int row0 = u.pm * BM + wr * 64 + fr; int colt = u.pn * BM; bf16_t* base = O;
        float sc = 1.f; if (split_cols) { const int t = colt / split_cols; base += (size_t)t * split_stride; colt -= t * split_cols; if (t == 0) sc = scale0; }
        const int col0 = colt + wc * 32 + 8 * fq, bcol0 = u.pn * BM + wc * 32 + 8 * fq;
        f32x4 bv[2][2];
#pragma unroll
        for (int bj = 0; bj < 2; ++bj)
#pragma unroll
            for (int n = 0; n < 2; ++n) bv[bj][n] = bias ? *(const f32x4*)(bias + bcol0 + bj * HALF + 4 * n) : (f32x4){0.f, 0.f, 0.f, 0.f};
#pragma unroll
        for (int ai = 0; ai < 2; ++ai)
#pragma unroll
            for (int m = 0; m < 4; ++m) { bf16_t* rowp = base + (size_t)(row0 + ai * HALF + m * 16) * ldc + col0;
#pragma unroll
                for (int bj = 0; bj < 2; ++bj) { f32x4 v0 = acc[ai][bj][m][0] + bv[bj][0], v1 = acc[ai][bj][m][1] + bv[bj][1];
                    if (ACT == 1) { f32x2 a = gelu_pk((f32x2){v0[0], v0[1]}), b = gelu_pk((f32x2){v0[2], v0[3]}), c = gelu_pk((f32x2){v1[0], v1[1]}), d = gelu_pk((f32x2){v1[2], v1[3]});
                        v0 = (f32x4){a.x, a.y, b.x, b.y}; v1 = (f32x4){c.x, c.y, d.x, d.y}; }
                    v0 = v0 * sc; v1 = v1 * sc; u32x4 w; w.x = cvt_pk_bf16(v0[0], v0[1]); w.y = cvt_pk_bf16(v0[2], v0[3]); w.z = cvt_pk_bf16(v1[0], v1[1]); w.w = cvt_pk_bf16(v1[2], v1[3]);
                    *(u32x4*)(rowp + bj * HALF) = w; } }
    }
};
struct EpiResF32 {
    static constexpr bool PERM = false, AFTER_DRAIN = false;
    const float* base; float* out; int ldc; const float* colscale;
    __device__ __forceinline__ void operator()(const f32x4 (&acc)[2][2][4][2], const Unit& u, int wr, int wc, int fr, int fq) const {
        const int row0 = u.pm * BM + wr * 64 + fr, col0 = u.pn * BM + wc * 32 + 4 * fq;
        f32x4 cs[2][2];
#pragma unroll
        for (int bj = 0; bj < 2; ++bj)
#pragma unroll
            for (int n = 0; n < 2; ++n) cs[bj][n] = colscale ? *(const f32x4*)(colscale + col0 + bj * HALF + n * 16) : (f32x4){1.f, 1.f, 1.f, 1.f};
#pragma unroll
        for (int ai = 0; ai < 2; ++ai)
#pragma unroll
            for (int m = 0; m < 4; ++m) { const size_t off = (size_t)(row0 + ai * HALF + m * 16) * ldc + col0;
#pragma unroll
                for (int bj = 0; bj < 2; ++bj)
#pragma unroll
                    for (int n = 0; n < 2; ++n) { const f32x4 b = *(const f32x4*)(base + off + bj * HALF + n * 16);
                        *(f32x4*)(out + off + bj * HALF + n * 16) = b + acc[ai][bj][m][n] * cs[bj][n]; }
                asm volatile("" ::: "memory"); }
    }
};

template <class Epi, class Sched, bool ALIGN_EPI = false, bool SP2 = false>
__device__ __forceinline__ void gemm_phase(PG8_LAS unsigned char* lds, const Gemm g, const Sched& S, const Epi& E) {
    int tid_ = threadIdx.x; asm volatile("" : "+v"(tid_));
    const int tid = tid_, wid = __builtin_amdgcn_readfirstlane(tid >> 6), lane = tid & 63, wr = wid >> 2, wc = wid & 3, fr = lane & 15, fq = lane >> 4;
    const int K = g.K, nt = K / BK;
    unsigned voffA[2], voffB[2];
#pragma unroll
    for (int i = 0; i < 2; ++i) { int R, C; stage_rc(tid * 16 + i * 8192, R, C); const int Rb = Epi::PERM ? ((R & ~31) + perm32(R & 31)) : R;
        voffA[i] = (unsigned)(R * g.lda + C) * 2u; voffB[i] = (unsigned)(Rb * g.ldb + C) * 2u; }
    const size_t kstep = (size_t)(BK * 2);
    const size_t hstepA = (size_t)HALF * g.lda * 2, hstepB = (size_t)HALF * g.ldb * 2;
    const size_t tstepA = 2 * hstepA, tstepB = 2 * hstepB;
    const unsigned ldsw = (unsigned)wid * 1024u;
    const int aoff = lds_byte(wr * 64 + fr, fq * 8), boff = lds_byte(wc * 32 + fr, fq * 8);
#define PG8_SA(b, h) (((b) * 2 + (h)) * HTB)
#define PG8_SB(b, h) ((4 + (b) * 2 + (h)) * HTB)
#define PG8_STAGE(bufoff, gbase, voff) do { _Pragma("unroll") for (int _i = 0; _i < 2; ++_i) \
        __builtin_amdgcn_global_load_lds((const unsigned*)((const char*)(gbase) + (voff)[_i]), (PG8_LAS unsigned*)(lds + (bufoff) + ldsw + _i * 8192), 16, 0, 0); } while (0)
#define PG8_LDA(dst, b, h) do { _Pragma("unroll") for (int m = 0; m < 4; ++m) _Pragma("unroll") for (int k = 0; k < 2; ++k) dst[m][k] = *(const PG8_LAS bf16x8*)(lds + PG8_SA(b, h) + aoff + m * 2048 + k * 1024); } while (0)
#define PG8_LDB(dst, b, h) do { _Pragma("unroll") for (int n = 0; n < 2; ++n) _Pragma("unroll") for (int k = 0; k < 2; ++k) dst[n][k] = *(const PG8_LAS bf16x8*)(lds + PG8_SB(b, h) + boff + n * 2048 + k * 1024); } while (0)
#define PG8_MMA(ai, bj, At, Bt) do { __builtin_amdgcn_s_setprio(1); _Pragma("unroll") for (int m = 0; m < 4; ++m) _Pragma("unroll") for (int n = 0; n < 2; ++n) _Pragma("unroll") for (int k = 0; k < 2; ++k) \
        acc[ai][bj][m][n] = __builtin_amdgcn_mfma_f32_16x16x32_bf16(Bt[n][k], At[m][k], acc[ai][bj][m][n], 0, 0, 0); __builtin_amdgcn_s_setprio(0); } while (0)
#define PG8_WAIT_V(n) asm volatile("s_waitcnt vmcnt(" #n ")" ::: "memory")
#define PG8_WAIT_L(n) asm volatile("s_waitcnt lgkmcnt(" #n ")" ::: "memory")
#define PG8_BAR __builtin_amdgcn_s_barrier()
#define PG8_SCHED __builtin_amdgcn_sched_barrier(0)
    Unit cur, nxt; int ui = 0;
    if (!S.next(0, cur)) return;
    f32x4 acc[2][2][4][2];
#pragma unroll
    for (int a = 0; a < 2; ++a)
#pragma unroll
        for (int b = 0; b < 2; ++b)
#pragma unroll
            for (int m = 0; m < 4; ++m)
#pragma unroll
                for (int n = 0; n < 2; ++n) acc[a][b][m][n] = (f32x4){0.f, 0.f, 0.f, 0.f};
    bf16x8 At[4][2], B0[2][2], B1[2][2];
    const char* cA = (const char*)g.A + (size_t)cur.pm * tstepA + (size_t)(cur.pn >> g.agrp_shift) * g.agrp_bytes; const char* cB = (const char*)g.Bt + (size_t)cur.pn * tstepB;
    S.a_ready(cur);
    if constexpr (SP2) {
        PG8_STAGE(PG8_SB(0, 0), cB, voffB); PG8_STAGE(PG8_SB(0, 1), cB + hstepB, voffB); PG8_STAGE(PG8_SA(0, 0), cA, voffA); PG8_STAGE(PG8_SA(0, 1), cA + hstepA, voffA);
        if (wr == 1) PG8_BAR;
        PG8_WAIT_V(2); PG8_BAR;
        PG8_STAGE(PG8_SB(1, 0), cB + kstep, voffB); PG8_STAGE(PG8_SA(1, 0), cA + kstep, voffA); PG8_STAGE(PG8_SB(1, 1), cB + hstepB + kstep, voffB);
        PG8_WAIT_V(6); PG8_BAR;
    } else {
        PG8_STAGE(PG8_SB(0, 0), cB, voffB); PG8_STAGE(PG8_SA(0, 0), cA, voffA); PG8_STAGE(PG8_SB(0, 1), cB + hstepB, voffB); PG8_STAGE(PG8_SA(0, 1), cA + hstepA, voffA);
        if (wr == 1) PG8_BAR;
        PG8_WAIT_V(4); PG8_BAR;
        PG8_STAGE(PG8_SB(1, 0), cB + kstep, voffB); PG8_STAGE(PG8_SA(1, 0), cA + kstep, voffA); PG8_STAGE(PG8_SB(1, 1), cB + hstepB + kstep, voffB);
        PG8_WAIT_V(6); PG8_BAR;
    }
    for (;;) {
        const bool has_next = S.next(ui + 1, nxt);
        const char* nA = has_next ? (const char*)g.A + (size_t)nxt.pm * tstepA + (size_t)(nxt.pn >> g.agrp_shift) * g.agrp_bytes : cA; const char* nB = has_next ? (const char*)g.Bt + (size_t)nxt.pn * tstepB : cB;
        for (int t = 0; t < nt; t += 2) {
            const bool last = (t == nt - 2);
            const char* a1 = cA + (size_t)(t + 1) * kstep;
            const char* a2 = last ? nA : cA + (size_t)(t + 2) * kstep; const char* b2 = last ? nB : cB + (size_t)(t + 2) * kstep;
            const char* a3 = a2 + kstep; const char* b3 = b2 + kstep;
            if (last && has_next) S.a_ready(nxt);
            if constexpr (SP2) {
            PG8_LDB(B0, 0, 0); PG8_LDB(B1, 0, 1); PG8_SCHED; PG8_LDA(At, 0, 0); PG8_STAGE(PG8_SA(1, 1), a1 + hstepA, voffA);
            PG8_WAIT_V(8); PG8_WAIT_L(0); PG8_BAR; PG8_MMA(0, 0, At, B0); PG8_MMA(0, 1, At, B1); PG8_BAR; PG8_SCHED;
            PG8_LDA(At, 0, 1); PG8_STAGE(PG8_SB(0, 0), b2, voffB); PG8_STAGE(PG8_SB(0, 1), b2 + hstepB, voffB); PG8_STAGE(PG8_SA(0, 0), a2, voffA);
            PG8_WAIT_V(8); PG8_WAIT_L(0); PG8_BAR; PG8_MMA(1, 0, At, B0); PG8_MMA(1, 1, At, B1); PG8_BAR; PG8_SCHED;
            PG8_LDB(B0, 1, 0); PG8_LDB(B1, 1, 1); PG8_SCHED; PG8_LDA(At, 1, 0); PG8_STAGE(PG8_SA(0, 1), a2 + hstepA, voffA);
            PG8_WAIT_V(8); PG8_WAIT_L(0); PG8_BAR; PG8_MMA(0, 0, At, B0); PG8_MMA(0, 1, At, B1); PG8_BAR; PG8_SCHED;
            PG8_LDA(At, 1, 1); PG8_STAGE(PG8_SB(1, 0), b3, voffB); PG8_STAGE(PG8_SB(1, 1), b3 + hstepB, voffB); PG8_STAGE(PG8_SA(1, 0), a3, voffA);
            PG8_WAIT_V(8); PG8_WAIT_L(0); PG8_BAR; PG8_MMA(1, 0, At, B0); PG8_MMA(1, 1, At, B1); PG8_BAR; PG8_SCHED;
            } else {
            PG8_LDB(B0, 0, 0); PG8_SCHED; PG8_LDA(At, 0, 0); PG8_STAGE(PG8_SA(1, 1), a1 + hstepA, voffA);
            PG8_WAIT_L(8); PG8_BAR; PG8_WAIT_L(0); PG8_MMA(0, 0, At, B0); PG8_BAR; PG8_SCHED;
            PG8_LDB(B1, 0, 1); PG8_STAGE(PG8_SB(0, 0), b2, voffB);
            PG8_BAR; PG8_WAIT_L(0); PG8_MMA(0, 1, At, B1); PG8_BAR;
            PG8_LDA(At, 0, 1); PG8_STAGE(PG8_SA(0, 0), a2, voffA);
            PG8_BAR; PG8_WAIT_L(0); PG8_MMA(1, 0, At, B0); PG8_BAR; PG8_SCHED;
            PG8_STAGE(PG8_SB(0, 1), b2 + hstepB, voffB);
            PG8_WAIT_V(6); PG8_BAR; PG8_MMA(1, 1, At, B1); PG8_BAR;
            PG8_LDB(B0, 1, 0); PG8_SCHED; PG8_LDA(At, 1, 0); PG8_STAGE(PG8_SA(0, 1), a2 + hstepA, voffA);
            PG8_WAIT_L(8); PG8_BAR; PG8_WAIT_L(0); PG8_MMA(0, 0, At, B0); PG8_BAR; PG8_SCHED;
            PG8_LDB(B1, 1, 1); PG8_STAGE(PG8_SB(1, 0), b3, voffB);
            PG8_BAR; PG8_WAIT_L(0); PG8_MMA(0, 1, At, B1); PG8_BAR;
            PG8_LDA(At, 1, 1); PG8_STAGE(PG8_SA(1, 0), a3, voffA);
            PG8_BAR; PG8_WAIT_L(0); PG8_MMA(1, 0, At, B0); PG8_BAR; PG8_SCHED;
            PG8_STAGE(PG8_SB(1, 1), b3 + hstepB, voffB);
            PG8_WAIT_V(6); PG8_BAR; PG8_MMA(1, 1, At, B1); PG8_BAR;
            }
        }
        if constexpr (ALIGN_EPI) { if (wr == 0) PG8_BAR; }
        if constexpr (!Epi::AFTER_DRAIN) { E(acc, cur, wr, wc, fr, fq); S.done(cur); }
        if (!has_next) break;
#pragma unroll
        for (int a = 0; a < 2; ++a)
#pragma unroll
            for (int b = 0; b < 2; ++b)
#pragma unroll
                for (int m = 0; m < 4; ++m)
#pragma unroll
                    for (int n = 0; n < 2; ++n) acc[a][b][m][n] = (f32x4){0.f, 0.f, 0.f, 0.f};
        cur = nxt; cA = nA; cB = nB; ++ui;
        if constexpr (ALIGN_EPI) { if (wr == 1) PG8_BAR; }
    }
    PG8_WAIT_V(0);
    if constexpr (!ALIGN_EPI) { if (wr == 0) PG8_BAR; }
    PG8_BAR;
    if constexpr (Epi::AFTER_DRAIN) { E.fused(acc, cur, wr, wc, fr, fq, lds, wid, lane); S.done(cur); }
#undef PG8_SA
#undef PG8_SB
#undef PG8_STAGE
#undef PG8_LDA
#undef PG8_LDB
#undef PG8_MMA
#undef PG8_WAIT_V
#undef PG8_WAIT_L
#undef PG8_BAR
#undef PG8_SCHED
}
}
#define XB_TMO      128
#define XB_XCNT(j)  (256  + 64 * (j))
#define XB_XSUB(j)  (1280 + 64 * (j))
#define XB_XGEN(j)  (2304 + 64 * (j))
#define XB_TOP      3328
#define XB_TOPGEN   3392
#define XCD_BAR_WORDS 3456
#define XB_SPIN_CAP (1u << 18)

__device__ __forceinline__ unsigned xb_ld(unsigned* p)              { return __hip_atomic_load(p, __ATOMIC_RELAXED, __HIP_MEMORY_SCOPE_AGENT); }
__device__ __forceinline__ unsigned xb_add(unsigned* p, unsigned v) { return __hip_atomic_fetch_add(p, v, __ATOMIC_RELAXED, __HIP_MEMORY_SCOPE_AGENT); }
__device__ __forceinline__ unsigned xb_xcc_id() { return (unsigned)__builtin_amdgcn_s_getreg((3 << 11) | 20) & 0xFu; }
#define XB_SPIN(cond, bar) do { unsigned _sp = 0; while (cond) { __builtin_amdgcn_s_sleep(1); \
    if ((++_sp & 255u) == 0u) { if (xb_ld(&(bar)[XB_TMO])) break; if (_sp > XB_SPIN_CAP) { atomicAdd(&(bar)[XB_TMO], 1u); break; } } } } while (0)

struct XcdBarrier {
    unsigned* bar; unsigned x;
    volatile LAS unsigned* st;
};

__device__ __forceinline__ XcdBarrier xcd_barrier_post(unsigned* bar, volatile LAS unsigned* st) {
    XcdBarrier b; b.bar = bar; b.x = xb_xcc_id(); b.st = st;
    if (threadIdx.x == 0) (void)xb_add(&bar[XB_XCNT(b.x)], 1u);
    return b;
}
__device__ __forceinline__ void xcd_barrier_complete(unsigned* bar, unsigned x, unsigned& nloc, unsigned& nx) {
    const unsigned G = gridDim.x * gridDim.y * gridDim.z;
    unsigned sum, cnt, mine, sp = 0u;
    for (;;) {
        sum = 0u; cnt = 0u; mine = 0u;
#pragma unroll
        for (unsigned j = 0; j < 16; ++j) { const unsigned c = xb_ld(&bar[XB_XCNT(j)]); sum += c; cnt += (c > 0u) ? 1u : 0u; mine = (j == x) ? c : mine; }
        if (sum == G) break;
        __builtin_amdgcn_s_sleep(1);
        if ((++sp & 255u) == 0u) { if (xb_ld(&bar[XB_TMO])) break; if (sp > XB_SPIN_CAP) { atomicAdd(&bar[XB_TMO], 1u); break; } }
    }
    nloc = mine > 0u ? mine : 1u; nx = cnt > 0u ? cnt : 1u;
}

__device__ __forceinline__ void xcd_barrier(const XcdBarrier& b) {
    asm volatile("s_waitcnt vmcnt(0)" ::: "memory");
    __syncthreads();
    if (threadIdx.x == 0) {
        unsigned* bar = b.bar;
        __builtin_amdgcn_s_waitcnt(0);
        unsigned nloc = b.st[0], nx = b.st[1];
        if (nloc == 0u) { xcd_barrier_complete(bar, b.x, nloc, nx); b.st[0] = nloc; b.st[1] = nx; }
        const unsigned old = xb_add(&bar[XB_XSUB(b.x)], 1u);
        const unsigned gen = old / nloc;
        if (old + 1u == (gen + 1u) * nloc) {
            __builtin_amdgcn_fence(__ATOMIC_RELEASE, "agent");
            asm volatile("s_waitcnt vmcnt(0)" ::: "memory");
            const unsigned og = xb_add(&bar[XB_TOP], 1u);
            const unsigned tg = og / nx;
            if (og + 1u == (tg + 1u) * nx) xb_add(&bar[XB_TOPGEN], 1u);
            else XB_SPIN(xb_ld(&bar[XB_TOPGEN]) == tg, bar);
            __builtin_amdgcn_fence(__ATOMIC_ACQUIRE, "agent");
            xb_add(&bar[XB_XGEN(b.x)], 1u);
            asm volatile("s_waitcnt vmcnt(0)" ::: "memory");
        } else {
            XB_SPIN(xb_ld(&bar[XB_XGEN(b.x)]) == gen, bar);
            __builtin_amdgcn_fence(__ATOMIC_ACQUIRE, "agent");
            asm volatile("s_waitcnt vmcnt(0)" ::: "memory");
        }
    }
    __syncthreads();
}
namespace att {
using bf16 = __hip_bfloat16;
constexpr int   D = 128, NW = 8, QBLK = 32, KVBLK = 64;
constexpr float SCALE = 0.088388347648318440f;
constexpr float THR = 8.f;
constexpr int SDEPTH = 1;
constexpr int LDQ = 1024, LDK = 512, LDO = 2048;
constexpr size_t SHM_V = KVBLK * D * 2, SHM_K = KVBLK * D * 2, SHM_ATTN = 2 * SHM_V + 2 * SHM_K + NW * 64 * 4;
using bf16x8 = __attribute__((ext_vector_type(8))) short;
using s16x4  = __attribute__((ext_vector_type(4))) short;
using f32x16 = __attribute__((ext_vector_type(16))) float;
using f32x8  = __attribute__((ext_vector_type(8))) float;
using u32x4  = __attribute__((ext_vector_type(4))) unsigned;
#define KSWZ(row, colB) ((row) * 256 + ((colB) ^ (((row) & 7) << 4)))
#define SBAR() __builtin_amdgcn_sched_barrier(0)
__device__ __forceinline__ int crow(int r, int hi) { return (r & 3) + 8 * (r >> 2) + 4 * hi; }
__device__ __forceinline__ unsigned cvtpk(float lo, float hi) {
  unsigned r; asm volatile("v_cvt_pk_bf16_f32 %0, %1, %2" : "=v"(r) : "v"(lo), "v"(hi)); return r;
}
template <typename TIn> struct Stage;
template <> struct Stage<bf16>  { using T = bf16x8;
  __device__ static __forceinline__ T ld8(const bf16* p) { return *reinterpret_cast<const bf16x8*>(p); }
  __device__ static __forceinline__ bf16x8 tobf(T x) { return x; } };
template <> struct Stage<float> { using T = f32x8;
  __device__ static __forceinline__ T ld8(const float* p) { return *reinterpret_cast<const f32x8*>(p); }
  __device__ static __forceinline__ bf16x8 tobf(T x) {
    u32x4 w = {cvtpk(x[0], x[1]), cvtpk(x[2], x[3]), cvtpk(x[4], x[5]), cvtpk(x[6], x[7])}; return *reinterpret_cast<bf16x8*>(&w); } };

__device__ __forceinline__ void partialSM(f32x16& p0, f32x16& p1, float& m_reg, float& mn, float& alpha) {
  constexpr float C = SCALE * 1.4426950408889634f;
  float pmax = p0[0]; for (int r = 1; r < 16; ++r) pmax = fmaxf(pmax, p0[r]); for (int r = 0; r < 16; ++r) pmax = fmaxf(pmax, p1[r]);
  { auto rr = __builtin_amdgcn_permlane32_swap(__float_as_uint(pmax), __float_as_uint(pmax), false, false);
    pmax = fmaxf(__uint_as_float(rr[0]), __uint_as_float(rr[1])); }
  if (__builtin_expect(__all(pmax - m_reg <= THR / SCALE), 1)) { mn = m_reg; alpha = 1.f; }
  else { mn = fmaxf(m_reg, pmax); alpha = __builtin_amdgcn_exp2f((m_reg - mn) * C); m_reg = mn; }
  float mnC = -mn * C;
  for (int r = 0; r < 16; ++r) p0[r] = fmaf(p0[r], C, mnC); for (int r = 0; r < 16; ++r) p1[r] = fmaf(p1[r], C, mnC);
  for (int r = 0; r < 16; ++r) p0[r] = __builtin_amdgcn_exp2f(p0[r]);
}
__device__ __forceinline__ void finishSM(f32x16& p0, f32x16& p1, float alpha, float& l_reg, bf16x8& pa0, bf16x8& pa1, bf16x8& pa2, bf16x8& pa3) {
  for (int r = 0; r < 16; ++r) p1[r] = __builtin_amdgcn_exp2f(p1[r]);
  float ps = 0; for (int r = 0; r < 16; ++r) ps += p0[r]; for (int r = 0; r < 16; ++r) ps += p1[r];
  { auto rr = __builtin_amdgcn_permlane32_swap(__float_as_uint(ps), __float_as_uint(ps), false, false);
    ps = __uint_as_float(rr[0]) + __uint_as_float(rr[1]); }
  l_reg = l_reg * alpha + ps;
#define PK4(P, BASE, OUT) do { unsigned a0 = cvtpk(P[BASE + 0], P[BASE + 1]), a1 = cvtpk(P[BASE + 2], P[BASE + 3]);   \
    unsigned b0 = cvtpk(P[BASE + 4], P[BASE + 5]), b1 = cvtpk(P[BASE + 6], P[BASE + 7]);                              \
    auto r0 = __builtin_amdgcn_permlane32_swap(a0, b0, false, false); auto r1 = __builtin_amdgcn_permlane32_swap(a1, b1, false, false); \
    u32x4 w = {r0[0], r1[0], r0[1], r1[1]}; OUT = *reinterpret_cast<bf16x8*>(&w); } while (0)
  PK4(p0, 0, pa0); PK4(p0, 8, pa1); PK4(p1, 0, pa2); PK4(p1, 8, pa3);
#undef PK4
}
__device__ __forceinline__ void qkt(f32x16& p0, f32x16& p1, const bf16* Ks, const bf16x8* qr, int r32, int hi) {
  p0 = f32x16{}; p1 = f32x16{};
  for (int d0 = 0; d0 < 8; ++d0) { int cb = (d0 * 16 + hi * 8) * 2;
    bf16x8 b0 = *reinterpret_cast<const bf16x8*>((const char*)Ks + KSWZ(r32, cb));
    bf16x8 b1 = *reinterpret_cast<const bf16x8*>((const char*)Ks + KSWZ(32 + r32, cb));
    p0 = __builtin_amdgcn_mfma_f32_32x32x16_bf16(b0, qr[d0], p0, 0, 0, 0);
    p1 = __builtin_amdgcn_mfma_f32_32x32x16_bf16(b1, qr[d0], p1, 0, 0, 0); }
}
__device__ __forceinline__ int v_st(int k, int c) { const int kk = (k & ~0xC) | ((k & 4) << 1) | ((k & 8) >> 1); return ((kk >> 3) * 4 + (c >> 5)) * 512 + ((kk & 7) * 32 + (c & 31)) * 2; }
__device__ __forceinline__ int v_rd_base(int lane) { return ((lane & 3) << 3) | (((lane >> 2) & 3) << 6) | (((lane >> 4) & 1) << 5) | (((lane >> 5) & 1) << 8); }
constexpr int v_rd_off(int d0, int ks, int half) { return d0 * 512 + ks * 4096 + half * 2048; }
template <int OFF> __device__ __forceinline__ s16x4 tr_read(int vb) {
  s16x4 r; asm volatile("ds_read_b64_tr_b16 %0, %1 offset:%2" : "=&v"(r) : "v"(vb), "i"(OFF) : "memory"); return r;
}
template <int D0> __device__ __forceinline__ void pv_one(f32x16& od, int vb, bf16x8 pa0, bf16x8 pa1, bf16x8 pa2, bf16x8 pa3) {
  const s16x4 l0 = tr_read<v_rd_off(D0, 0, 0)>(vb), h0 = tr_read<v_rd_off(D0, 0, 1)>(vb), l1 = tr_read<v_rd_off(D0, 1, 0)>(vb), h1 = tr_read<v_rd_off(D0, 1, 1)>(vb);
  const s16x4 l2 = tr_read<v_rd_off(D0, 2, 0)>(vb), h2 = tr_read<v_rd_off(D0, 2, 1)>(vb), l3 = tr_read<v_rd_off(D0, 3, 0)>(vb), h3 = tr_read<v_rd_off(D0, 3, 1)>(vb);
  asm volatile("s_waitcnt lgkmcnt(0)" ::: "memory"); SBAR();
#define PK(L, H) (bf16x8){L[0], L[1], L[2], L[3], H[0], H[1], H[2], H[3]}
  od = __builtin_amdgcn_mfma_f32_32x32x16_bf16(pa0, PK(l0, h0), od, 0, 0, 0);
  od = __builtin_amdgcn_mfma_f32_32x32x16_bf16(pa1, PK(l1, h1), od, 0, 0, 0);
  od = __builtin_amdgcn_mfma_f32_32x32x16_bf16(pa2, PK(l2, h2), od, 0, 0, 0);
  od = __builtin_amdgcn_mfma_f32_32x32x16_bf16(pa3, PK(l3, h3), od, 0, 0, 0);
#undef PK
}
__device__ __forceinline__ void pv_d0(f32x16* o, int vb, bf16x8 pa0, bf16x8 pa1, bf16x8 pa2, bf16x8 pa3) {
  pv_one<0>(o[0], vb, pa0, pa1, pa2, pa3); pv_one<1>(o[1], vb, pa0, pa1, pa2, pa3); pv_one<2>(o[2], vb, pa0, pa1, pa2, pa3); pv_one<3>(o[3], vb, pa0, pa1, pa2, pa3);
}

template <typename TQ>
__device__ __forceinline__ void attn_dense_body(const TQ* __restrict__ Qb, const bf16* __restrict__ Kh, const bf16* __restrict__ Vh,
                                                bf16* __restrict__ Ob, int seq, char* lds) {
  using St = Stage<bf16>; using SQ = Stage<TQ>;
  int tid_ = threadIdx.x; asm volatile("" : "+v"(tid_));
  const int tid = tid_, wid = tid >> 6, lane = tid & 63, r32 = lane & 31, hi = lane >> 5;
  bf16* V_lds = (bf16*)lds; bf16* K_lds = (bf16*)(lds + 2 * SHM_V);
  float* ws = (float*)(lds + 2 * SHM_V + 2 * SHM_K) + wid * 64; float* li_l = ws; float* al_l = ws + 32;
  float m_reg = -1e30f, l_reg = 0; f32x16 o[4] = {}; bf16x8 qr[8];
  const TQ* Qw = Qb + (long)(wid * QBLK + r32) * LDQ + hi * 8;
#pragma unroll
  for (int d0 = 0; d0 < 8; ++d0) qr[d0] = SQ::tobf(SQ::ld8(Qw + d0 * 16));
  const int sr = tid >> 4, sc = (tid & 15) * 8, vst0 = v_st(sr, sc), vst1 = v_st(32 + sr, sc);
  const int vb0 = (int)(uintptr_t)V_lds + v_rd_base(lane);
  struct { typename St::T vs0, vs1, ks0, ks1; } sr_[SDEPTH];
#define SLOAD(i, k0) do { sr_[i].vs0 = St::ld8(&Vh[(long)((k0) + sr) * LDK + sc]); sr_[i].vs1 = St::ld8(&Vh[(long)((k0) + 32 + sr) * LDK + sc]); \
    sr_[i].ks0 = St::ld8(&Kh[(long)((k0) + sr) * LDK + sc]); sr_[i].ks1 = St::ld8(&Kh[(long)((k0) + 32 + sr) * LDK + sc]); } while (0)
#define SWRITE(b, i) do { *(bf16x8*)((char*)V_lds + (b) * SHM_V + vst0) = St::tobf(sr_[i].vs0);          \
    *(bf16x8*)((char*)V_lds + (b) * SHM_V + vst1) = St::tobf(sr_[i].vs1); int kc = sc * 2;               \
    *(bf16x8*)((char*)K_lds + (b) * SHM_K + KSWZ(sr, kc)) = St::tobf(sr_[i].ks0);                       \
    *(bf16x8*)((char*)K_lds + (b) * SHM_K + KSWZ(32 + sr, kc)) = St::tobf(sr_[i].ks1); } while (0)
#define SWAIT() do { if constexpr (SDEPTH == 2) asm volatile("s_waitcnt vmcnt(4)" ::: "memory"); else asm volatile("s_waitcnt vmcnt(0)" ::: "memory"); } while (0)
#define RESC(a) do { if (__any((a) < 1.f)) { if (hi == 0) al_l[r32] = (a); asm volatile("s_waitcnt lgkmcnt(0)" ::: "memory"); \
    for (int d = 0; d < 4; ++d) for (int r = 0; r < 16; ++r) o[d][r] *= al_l[crow(r, hi)]; } } while (0)
  f32x16 pA0, pA1, pB0, pB1; float mnA, mnB, alA, alB; bf16x8 pa0, pa1, pa2, pa3; const int NT = seq / KVBLK;
  constexpr int SE = 0, SO = SDEPTH - 1;
  SLOAD(SE, 0); asm volatile("s_waitcnt vmcnt(0)" ::: "memory"); SWRITE(0, SE); __syncthreads();
  qkt(pA0, pA1, K_lds, qr, r32, hi); partialSM(pA0, pA1, m_reg, mnA, alA);
  SLOAD(SO, KVBLK); if constexpr (SDEPTH == 2) { if (2 < NT) SLOAD(SE, 2 * KVBLK); }
  SWAIT(); SWRITE(1, SO); __syncthreads();
  for (int j = 1; j + 1 < NT; j += 2) {
    SBAR(); qkt(pB0, pB1, (bf16*)((char*)K_lds + SHM_K), qr, r32, hi);
    finishSM(pA0, pA1, alA, l_reg, pa0, pa1, pa2, pa3); SBAR();
    SLOAD(SO, (j + SDEPTH) * KVBLK); SBAR();
    pv_d0(o, vb0, pa0, pa1, pa2, pa3); partialSM(pB0, pB1, m_reg, mnB, alB);
    __syncthreads(); SWAIT(); SWRITE(0, SE);
    RESC(alB); __syncthreads();
    SBAR(); qkt(pA0, pA1, K_lds, qr, r32, hi);
    finishSM(pB0, pB1, alB, l_reg, pa0, pa1, pa2, pa3); SBAR();
    if (SDEPTH == 1 || j + 3 < NT) SLOAD(SE, (j + 1 + SDEPTH) * KVBLK); SBAR();
    pv_d0(o, vb0 + (int)SHM_V, pa0, pa1, pa2, pa3); partialSM(pA0, pA1, m_reg, mnA, alA);
    __syncthreads(); SWAIT(); SWRITE(1, SO);
    RESC(alA); __syncthreads();
  }
  SBAR(); qkt(pB0, pB1, (bf16*)((char*)K_lds + SHM_K), qr, r32, hi);
  finishSM(pA0, pA1, alA, l_reg, pa0, pa1, pa2, pa3); SBAR();
  pv_d0(o, vb0, pa0, pa1, pa2, pa3); partialSM(pB0, pB1, m_reg, mnB, alB);
  __syncthreads(); RESC(alB);
  finishSM(pB0, pB1, alB, l_reg, pa0, pa1, pa2, pa3); SBAR();
  pv_d0(o, vb0 + (int)SHM_V, pa0, pa1, pa2, pa3);
  if (hi == 0) li_l[r32] = l_reg; asm volatile("s_waitcnt lgkmcnt(0)" ::: "memory");
  float rli[16];
#pragma unroll
  for (int r = 0; r < 16; ++r) rli[r] = __builtin_amdgcn_rcpf(li_l[crow(r, hi)]);
  bf16* Ow = Ob + (long)(wid * QBLK) * LDO;
#pragma unroll
  for (int r = 0; r < 16; ++r) { int orow = crow(r, hi);
    for (int d0 = 0; d0 < 4; ++d0) Ow[(long)orow * LDO + d0 * 32 + r32] = __float2bfloat16(o[d0][r] * rli[r]); }
  __syncthreads();
#undef SLOAD
#undef SWRITE
#undef SWAIT
#undef RESC
}
#undef KSWZ
#undef SBAR
}

struct Frame {
    LAS unsigned char* lds;
    char* ldsg;
    int tid, lane, wave, vcu, G;
    unsigned char* ws;
};
__device__ __forceinline__ const float* frame_in(const Frame& F, int i) {
    const LAS unsigned* p = (const LAS unsigned*)(F.lds + LDSCTL_OFF + 64) + 2 * i;
    const unsigned lo = __builtin_amdgcn_readfirstlane(p[0]), hi = __builtin_amdgcn_readfirstlane(p[1]);
    return (const float*)(((unsigned long long)hi << 32) | lo);
}
#define FIN(i) frame_in(F, (i))
#define FOUT() ((float*)frame_in(F, 17))
#define WSP(T, off) ((T*)(F.ws + (off)))

__device__ __forceinline__ void p0_transpose_item(const float* W, int K, int N, int Npad, bf16_t* WT, int row_off, LAS float* scr, int item, int lane) {
    const int nblk = Npad / 32, kb = item / nblk, nb = item % nblk, k0 = 64 * kb, n0 = 32 * nb;
    const int nn = n0 + (lane & 31);
#pragma unroll 8
    for (int i = 0; i < 32; ++i) { const int kk = 2 * i + (lane >> 5); scr[kk * 33 + (lane & 31)] = nn < N ? W[(size_t)(k0 + kk) * N + nn] : 0.f; }
    LDS_WAIT(); asm volatile("" ::: "memory");
    const int c = lane & 7;
#pragma unroll
    for (int j = 0; j < 4; ++j) { const int n = (lane >> 3) + 8 * j; const LAS float* s = scr + (8 * c) * 33 + n;
        u32x4 o; o.x = pk2(s[0 * 33], s[1 * 33]); o.y = pk2(s[2 * 33], s[3 * 33]); o.z = pk2(s[4 * 33], s[5 * 33]); o.w = pk2(s[6 * 33], s[7 * 33]);
        *(GAS u32x4*)(WT + (size_t)(row_off + n0 + n) * K + k0 + 8 * c) = o; }
    LDS_WAIT(); asm volatile("" ::: "memory");
}
__device__ __forceinline__ u32x4 cvt8(const float* p) {
    const f32x4 a = *(const f32x4*)p, b = *(const f32x4*)(p + 4);
    u32x4 o; o.x = pk2(a.x, a.y); o.y = pk2(a.z, a.w); o.z = pk2(b.x, b.y); o.w = pk2(b.z, b.w); return o;
}
__device__ __forceinline__ void rms_row_to_bf16(const float* xrow, const float* g, bf16_t* orow, int lane) {
    const f32x4* xr = (const f32x4*)xrow + lane;
    f32x4 v[8]; float s = 0.f;
#pragma unroll
    for (int j = 0; j < 8; ++j) { v[j] = xr[64 * j]; s += (v[j].x * v[j].x + v[j].y * v[j].y) + (v[j].z * v[j].z + v[j].w * v[j].w); }
    const float r = 1.0f / sqrtf(wave_sum(s) * (1.f / DM) + EPS);
    u32x2* o8 = (u32x2*)orow + lane;
#pragma unroll
    for (int j = 0; j < 8; ++j) { const f32x4 gg = ((const f32x4*)g)[lane + 64 * j]; u32x2 w; w.x = pk2(v[j].x * r * gg.x, v[j].y * r * gg.y); w.y = pk2(v[j].z * r * gg.z, v[j].w * r * gg.w); o8[64 * j] = w; }
}
__device__ __forceinline__ void ph_prologue(const Frame& F) {
    LAS float* scr = (LAS float*)(F.lds + F.wave * 16384);
    const int gw = F.vcu * NWAVES + F.wave, NGW = F.G * NWAVES;
    for (int row = gw; row < 4 * 16384; row += NGW) {
        const int tb = row >> 15, rr = row & 32767;
        const float* src = FIN(14 + tb) + (size_t)rr * DM + F.lane * 16;
        f32x4 v[8]; float am = 0.f;
#pragma unroll
        for (int q = 0; q < 8; ++q) { v[q] = *(const f32x4*)(src + (q >> 2) * 1024 + (q & 3) * 4);
            am = fmaxf(am, fmaxf(fmaxf(fabsf(v[q].x), fabsf(v[q].y)), fmaxf(fabsf(v[q].z), fabsf(v[q].w)))); }
#pragma unroll
        for (int o = 1; o < 64; o <<= 1) am = fmaxf(am, __shfl_xor(am, o));
        const float sc = am > 0.f ? am * (1.f / 448.f) : 1.f, isc = 1.0f / sc;
        unsigned w[8];
#pragma unroll
        for (int q = 0; q < 8; ++q) { unsigned p = __builtin_amdgcn_cvt_pk_fp8_f32(v[q].x * isc, v[q].y * isc, 0u, false); w[q] = __builtin_amdgcn_cvt_pk_fp8_f32(v[q].z * isc, v[q].w * isc, p, true); }
        unsigned char* dst = F.ws + (tb ? WS_VB : WS_UB) + (size_t)rr * DM + F.lane * 16;
        *(u32x4*)dst = (u32x4){w[0], w[1], w[2], w[3]}; *(u32x4*)(dst + 1024) = (u32x4){w[4], w[5], w[6], w[7]};
        if (F.lane == 0) ((float*)(F.ws + WS_TSC))[row] = sc;
    }
    {   constexpr int I_IN = (DM / 64) * (INP / 32), I_SQ = (DM / 64) * (DM / 32), I_PL = 4 * (512 / 64) * (512 / 32);
        constexpr int NIT = I_IN + 3 * I_SQ + I_PL;
        for (int it = gw; it < NIT; it += NGW) {
            int r = it;
            if (r < I_IN) { p0_transpose_item(FIN(3), DM, INW, INP, WSP(bf16_t, WS_WIN), 0, scr, r, F.lane); continue; } r -= I_IN;
            if (r < I_SQ) { p0_transpose_item(FIN(9), DM, DM, DM, WSP(bf16_t, WS_WOUT), 0, scr, r, F.lane); continue; } r -= I_SQ;
            if (r < I_SQ) { p0_transpose_item(FIN(12), DM, DM, DM, WSP(bf16_t, WS_WQ0), 0, scr, r, F.lane); continue; } r -= I_SQ;
            if (r < I_SQ) { p0_transpose_item(FIN(12) + (size_t)DM * DM, DM, DM, DM, WSP(bf16_t, WS_WQ1), 0, scr, r, F.lane); continue; } r -= I_SQ;
            const int grp = r / 128, ri = r % 128;
            p0_transpose_item(FIN(10) + (size_t)grp * 512 * 512, 512, 512, 512, WSP(bf16_t, WS_WPOOL), grp * 512, scr, ri, F.lane);
        }
    }
    for (int it = gw; it < 1024; it += NGW) *(u32x4*)(WSP(bf16_t, WS_KEYS) + (size_t)it * 512 + F.lane * 8) = cvt8(FIN(13) + (size_t)it * 512 + F.lane * 8);
    for (int m = gw; m < S; m += NGW) rms_row_to_bf16(FIN(0) + (size_t)m * DM, FIN(1), WSP(bf16_t, WS_XN) + (size_t)m * DM, F.lane);
}

__device__ __forceinline__ float silu_f(float z) { return z / (1.f + __expf(-z)); }
__device__ __forceinline__ void p2_qkv_token(const Frame& F, int t) {
    const int lane = F.lane, i8 = lane & 7;
    const bf16_t* pr = WSP(bf16_t, WS_PROJ) + (size_t)t * INP;
    const int axis = i8 >> 2, half = (i8 >> 1) & 1, f0 = (i8 & 1) * 16;
    const float pos = (float)(axis == 0 ? (t >> 6) : (t & 63));
    float cs[16], sn[16];
#pragma unroll
    for (int e = 0; e < 16; ++e) { const float inv = exp2f(-(float)(f0 + e) * (13.287712379549449f / 32.f));
        float rev = pos * inv * 0.15915494309189535f; rev -= rintf(rev);
        cs[e] = __builtin_amdgcn_cosf(rev); sn[e] = __builtin_amdgcn_sinf(rev); }
    const float sgn = half ? 1.f : -1.f;
    {   const u32x4 w0 = *(const u32x4*)(pr + C_AQ + lane * 16), w1 = *(const u32x4*)(pr + C_AQ + lane * 16 + 8);
        float v[16]; const unsigned ww[8] = {w0.x, w0.y, w0.z, w0.w, w1.x, w1.y, w1.z, w1.w};
#pragma unroll
        for (int e = 0; e < 8; ++e) { v[2 * e] = bflo(ww[e]); v[2 * e + 1] = bfhi(ww[e]); }
        float ss = 0.f;
#pragma unroll
        for (int e = 0; e < 16; ++e) ss += v[e] * v[e];
        ss += __shfl_xor(ss, 1); ss += __shfl_xor(ss, 2); ss += __shfl_xor(ss, 4);
        const float r = 1.0f / sqrtf(ss * (1.f / 128.f) + EPS);
        const float* gq = FIN(6) + i8 * 16;
        unsigned ow[8];
        float y[16];
#pragma unroll
        for (int e = 0; e < 16; ++e) y[e] = v[e] * r * gq[e];
#pragma unroll
        for (int e = 0; e < 16; ++e) { const float yp = __shfl_xor(y[e], 2); y[e] = y[e] * cs[e] + sgn * yp * sn[e]; }
#pragma unroll
        for (int e = 0; e < 8; ++e) ow[e] = pk2(y[2 * e], y[2 * e + 1]);
        bf16_t* dst = WSP(bf16_t, WS_QB) + (size_t)t * 1024 + lane * 16;
        *(u32x4*)dst = (u32x4){ow[0], ow[1], ow[2], ow[3]}; *(u32x4*)(dst + 8) = (u32x4){ow[4], ow[5], ow[6], ow[7]};
    }
    {   const int l16 = lane & 15;
        const u32x4 w0 = *(const u32x4*)(pr + C_AK + l16 * 16), w1 = *(const u32x4*)(pr + C_AK + l16 * 16 + 8);
        float v[16]; const unsigned ww[8] = {w0.x, w0.y, w0.z, w0.w, w1.x, w1.y, w1.z, w1.w};
#pragma unroll
        for (int e = 0; e < 8; ++e) { v[2 * e] = bflo(ww[e]); v[2 * e + 1] = bfhi(ww[e]); }
        float ss = 0.f;
#pragma unroll
        for (int e = 0; e < 16; ++e) ss += v[e] * v[e];
        ss += __shfl_xor(ss, 1); ss += __shfl_xor(ss, 2); ss += __shfl_xor(ss, 4);
        const float r = 1.0f / sqrtf(ss * (1.f / 128.f) + EPS);
        const float* gk = FIN(7) + i8 * 16;
        float y[16]; unsigned ow[8];
#pragma unroll
        for (int e = 0; e < 16; ++e) y[e] = v[e] * r * gk[e];
#pragma unroll
        for (int e = 0; e < 16; ++e) { const float yp = __shfl_xor(y[e], 2); y[e] = y[e] * cs[e] + sgn * yp * sn[e]; }
#pragma unroll
        for (int e = 0; e < 8; ++e) ow[e] = pk2(y[2 * e], y[2 * e + 1]);
        bf16_t* kv = WSP(bf16_t, WS_KVB) + (size_t)t * 512;
        if (lane < 16) { *(u32x4*)(kv + lane * 16) = (u32x4){ow[0], ow[1], ow[2], ow[3]}; *(u32x4*)(kv + lane * 16 + 8) = (u32x4){ow[4], ow[5], ow[6], ow[7]}; }
        else if (lane < 32) { const u32x4 a = *(const u32x4*)(pr + C_AV + l16 * 16), b = *(const u32x4*)(pr + C_AV + l16 * 16 + 8);
            *(u32x4*)(kv + 256 + l16 * 16) = a; *(u32x4*)(kv + 256 + l16 * 16 + 8) = b; }
    }
}
__device__ __forceinline__ void p2_conv_item(const Frame& F, int item) {
    const int tb = item >> 2, sl = item & 3, lane = F.lane, c = sl * 512 + lane * 8, t0 = tb * 16;
    float w[5][8];
#pragma unroll
    for (int j = 0; j < 5; ++j) { const f32x4 a = *(const f32x4*)(FIN(5) + j * 2048 + c), b = *(const f32x4*)(FIN(5) + j * 2048 + c + 4);
        w[j][0] = a.x; w[j][1] = a.y; w[j][2] = a.z; w[j][3] = a.w; w[j][4] = b.x; w[j][5] = b.y; w[j][6] = b.z; w[j][7] = b.w; }
    const bf16_t* src = WSP(bf16_t, WS_PROJ) + C_MQK + c;
    const float osc = (c >= 1024) ? 0.0625f : 1.f;
    bf16_t* dst = (c >= 1024) ? WSP(bf16_t, WS_MK) + (c - 1024) : WSP(bf16_t, WS_MQ) + c;
    u32x4 rows[5];
#pragma unroll
    for (int j = 0; j < 4; ++j) { const int tt = t0 - 2 + j; rows[j + 1] = (tt >= 0 && tt < S) ? *(const u32x4*)(src + (size_t)tt * INP) : (u32x4){0u, 0u, 0u, 0u}; }
#pragma unroll 1
    for (int q = 0; q < 16; ++q) {
        const int tn = t0 + q + 2;
        rows[0] = rows[1]; rows[1] = rows[2]; rows[2] = rows[3]; rows[3] = rows[4];
        rows[4] = (tn < S) ? *(const u32x4*)(src + (size_t)tn * INP) : (u32x4){0u, 0u, 0u, 0u};
        float acc[8];
#pragma unroll
        for (int e = 0; e < 8; ++e) acc[e] = 0.f;
#pragma unroll
        for (int j = 0; j < 5; ++j) { const unsigned ww[4] = {rows[j].x, rows[j].y, rows[j].z, rows[j].w};
#pragma unroll
            for (int e = 0; e < 4; ++e) { acc[2 * e] += bflo(ww[e]) * w[j][2 * e]; acc[2 * e + 1] += bfhi(ww[e]) * w[j][2 * e + 1]; } }
        u32x4 o; o.x = pk2(silu_f(acc[0]) * osc, silu_f(acc[1]) * osc); o.y = pk2(silu_f(acc[2]) * osc, silu_f(acc[3]) * osc);
        o.z = pk2(silu_f(acc[4]) * osc, silu_f(acc[5]) * osc); o.w = pk2(silu_f(acc[6]) * osc, silu_f(acc[7]) * osc);
        *(u32x4*)(dst + (size_t)(t0 + q) * 1024) = o;
    }
}
__device__ __forceinline__ float wave_incl_scan_add(float v, int lane) {
#pragma unroll
    for (int o = 1; o < 64; o <<= 1) { const float u = __shfl_up(v, o); if (lane >= o) v += u; }
    return v;
}
__device__ __forceinline__ float wave_incl_scan_max(float v, int lane) {
#pragma unroll
    for (int o = 1; o < 64; o <<= 1) { const float u = __shfl_up(v, o); if (lane >= o) v = fmaxf(v, u); }
    return v;
}
__device__ __forceinline__ float logsigmoid_f(float x) { return fminf(x, 0.f) - log1pf(__expf(-fabsf(x))); }
__device__ __forceinline__ void p2_gate_item(const Frame& F, int item) {
    const int dh = item >> 7, c = item & 127, dir = dh >> 2, h = dh & 3, lane = F.lane;
    const int p0 = 128 * c + 2 * lane, t0 = dir ? (S - 1 - p0) : p0, t1 = dir ? (t0 - 1) : (t0 + 1);
    const bf16_t* pg = WSP(bf16_t, WS_PROJ) + C_GATE + dir * 8 + h;
    const float bi = FIN(4)[dir * 8 + h], bf = FIN(4)[dir * 8 + 4 + h];
    const float i0 = bflo((unsigned)pg[(size_t)t0 * INP]) + bi, f0 = bflo((unsigned)pg[(size_t)t0 * INP + 4]) + bf;
    const float i1 = bflo((unsigned)pg[(size_t)t1 * INP]) + bi, f1 = bflo((unsigned)pg[(size_t)t1 * INP + 4]) + bf;
    const float lf0 = logsigmoid_f(f0), lf1 = logsigmoid_f(f1);
    const float incl = wave_incl_scan_add(lf0 + lf1, lane);
    const float b1 = incl, b0 = incl - lf1;
    const float u0 = i0 - b0, u1 = i1 - b1;
    const float mincl = wave_incl_scan_max(fmaxf(u0, u1), lane);
    float mprevl = __shfl_up(mincl, 1); if (lane == 0) mprevl = -INFINITY;
    const float pm0 = fmaxf(mprevl, u0), pm1 = mincl;
    float* GB = (float*)(F.ws + WS_GATES + GO_B) + (size_t)dh * S; float* GU = (float*)(F.ws + WS_GATES + GO_U) + (size_t)dh * S; float* GPM = (float*)(F.ws + WS_GATES + GO_PM) + (size_t)dh * S;
    GB[t0] = b0; GB[t1] = b1; GU[t0] = u0; GU[t1] = u1; GPM[t0] = pm0; GPM[t1] = pm1;
    if (lane == 63) { ((float*)(F.ws + WS_GATES + GO_G))[dh * 128 + c] = b1; ((float*)(F.ws + WS_GATES + GO_PML))[dh * 128 + c] = pm1; }
}
__device__ __forceinline__ void ph_post(const Frame& F) {
    const int gw = F.vcu * NWAVES + F.wave, NGW = F.G * NWAVES;
    for (int it = gw; it < 1024; it += NGW) p2_gate_item(F, it);
    for (int it = gw; it < 4096; it += NGW) p2_conv_item(F, it);
    for (int t = gw; t < S; t += NGW) p2_qkv_token(F, t);
}

#define MFMA16(a, b, c) __builtin_amdgcn_mfma_f32_16x16x32_bf16((a), (b), (c), 0, 0, 0)
__device__ __forceinline__ bf16x8 frag_tr(LAS const unsigned char* base, int pitch, int k0, int x0, int lane) {
    const int g = lane >> 4, i = lane & 15;
    LAS const unsigned char* p = base + (k0 + 8 * g + (i >> 2)) * pitch + (x0 + 4 * (i & 3)) * 2;
    const s16x4 lo = __builtin_bit_cast(s16x4, __builtin_amdgcn_ds_read_tr16_b64_v4i16((LAS v4i16_t*)p));
    const s16x4 hi = __builtin_bit_cast(s16x4, __builtin_amdgcn_ds_read_tr16_b64_v4i16((LAS v4i16_t*)(p + 4 * pitch)));
    return (bf16x8){lo[0], lo[1], lo[2], lo[3], hi[0], hi[1], hi[2], hi[3]};
}
__device__ __forceinline__ bf16x8 frag_kc(LAS const unsigned char* base, int pitch, int x0, int k0, int lane) {
    return *(LAS const bf16x8*)(base + (x0 + (lane & 15)) * pitch + (k0 + 8 * (lane >> 4)) * 2);
}

constexpr int MLA_PK = 544, MLA_PV = 288;
constexpr int MLA_OFF_V = 128 * MLA_PK;
__device__ __forceinline__ void ph_mla(const Frame& F) {
    const int tid = F.tid, lane = F.lane, wave = F.wave;
    LAS unsigned char* Kw = F.lds; LAS unsigned char* Vs = F.lds + MLA_OFF_V;
    const float* GU = (const float*)(F.ws + WS_GATES + GO_U); const float* GPML = (const float*)(F.ws + WS_GATES + GO_PML);
    for (int item = F.vcu; item < 2048; item += F.G) {
        const int hv = item & 1, c = (item >> 1) & 127, dh = item >> 8, dir = dh >> 2, head = dh & 3;
        const int tc = dir ? 127 - c : c, t0 = tc * 128;
        const float pml = GPML[dh * 128 + c];
        {   const bf16_t* mk = WSP(bf16_t, WS_MK) + (size_t)t0 * 1024 + head * 256;
#pragma unroll
            for (int j = 0; j < 8; ++j) { const int r = (tid >> 5) + 16 * j, c8 = (tid & 31) * 8;
                const u32x4 x = *(const u32x4*)(mk + (size_t)r * 1024 + c8); const float w = __expf(GU[(size_t)dh * S + t0 + r] - pml);
                u32x4 o; o.x = pk2(bflo(x.x) * w, bfhi(x.x) * w); o.y = pk2(bflo(x.y) * w, bfhi(x.y) * w); o.z = pk2(bflo(x.z) * w, bfhi(x.z) * w); o.w = pk2(bflo(x.w) * w, bfhi(x.w) * w);
                *(LAS u32x4*)(Kw + r * MLA_PK + c8 * 2) = o; }
            const bf16_t* mv = WSP(bf16_t, WS_PROJ) + (size_t)t0 * INP + C_MV + head * 256 + hv * 128;
#pragma unroll
            for (int j = 0; j < 4; ++j) { const int r = (tid >> 4) + 32 * j, c8 = (tid & 15) * 8;
                *(LAS u32x4*)(Vs + r * MLA_PV + c8 * 2) = *(const u32x4*)(mv + (size_t)r * INP + c8); }
        }
        __syncthreads();
        f32x4 acc[4][4];
#pragma unroll
        for (int a = 0; a < 4; ++a)
#pragma unroll
            for (int b = 0; b < 4; ++b) acc[a][b] = (f32x4){0.f, 0.f, 0.f, 0.f};
        const int mb = (wave & 3) * 64, nb = (wave >> 2) * 64;
#pragma unroll
        for (int ks = 0; ks < 4; ++ks) {
            bf16x8 af[4], bfr[4];
#pragma unroll
            for (int a = 0; a < 4; ++a) af[a] = frag_tr(Kw, MLA_PK, 32 * ks, mb + 16 * a, lane);
#pragma unroll
            for (int b = 0; b < 4; ++b) bfr[b] = frag_tr(Vs, MLA_PV, 32 * ks, nb + 16 * b, lane);
#pragma unroll
            for (int a = 0; a < 4; ++a)
#pragma unroll
                for (int b = 0; b < 4; ++b) acc[a][b] = MFMA16(af[a], bfr[b], acc[a][b]);
        }
        {   bf16_t* cst = WSP(bf16_t, WS_CST) + ((size_t)(dh * 128 + c) << 16);
            const int g = lane >> 4, i = lane & 15;
#pragma unroll
            for (int a = 0; a < 4; ++a)
#pragma unroll
                for (int b = 0; b < 4; ++b) { u32x2 o; o.x = pk2(acc[a][b][0], acc[a][b][1]); o.y = pk2(acc[a][b][2], acc[a][b][3]);
                    *(u32x2*)(cst + (size_t)(hv * 128 + nb + 16 * b + i) * 256 + mb + 16 * a + 4 * g) = o; }
        }
        if (hv == 0 && tid < 256) { float s = 0.f;
#pragma unroll 8
            for (int r = 0; r < 128; ++r) s += bflo((unsigned)*(LAS const bf16_t*)(Kw + r * MLA_PK + tid * 2));
            ((float*)(F.ws + WS_NST))[(size_t)(dh * 128 + c) * 256 + tid] = s; }
        __syncthreads();
    }
}

__device__ __forceinline__ void ph_scan(const Frame& F) {
    const float* GG = (const float*)(F.ws + WS_GATES + GO_G); const float* GPML = (const float*)(F.ws + WS_GATES + GO_PML); float* MPREV = (float*)(F.ws + WS_GATES + GO_MPREV);
    const int nthreads = F.G * NTHR;
    for (int gi = F.vcu * NTHR + F.tid; gi < 8 * 16384; gi += nthreads) {
        const int dh = gi >> 14, e4 = gi & 16383;
        bf16_t* base = WSP(bf16_t, WS_CST) + ((size_t)dh * 128 << 16) + e4 * 4;
        float st0 = 0.f, st1 = 0.f, st2 = 0.f, st3 = 0.f, m = 0.f;
#pragma unroll 1
        for (int c0 = 0; c0 < 128; c0 += 8) {
            u32x2 ld[8];
#pragma unroll
            for (int q = 0; q < 8; ++q) ld[q] = *(const u32x2*)(base + ((size_t)(c0 + q) << 16));
#pragma unroll
            for (int q = 0; q < 8; ++q) { const int c = c0 + q;
                const float g = GG[dh * 128 + c], amax = g + GPML[dh * 128 + c];
                const float mn = fmaxf(g + m, amax), dec = __expf(g + m - mn), add = __expf(amax - mn);
                if (e4 == 0) MPREV[dh * 128 + c] = m;
                u32x2 o; o.x = pk2(st0, st1); o.y = pk2(st2, st3);
                *(u32x2*)(base + ((size_t)c << 16)) = o;
                st0 = dec * st0 + add * bflo(ld[q].x); st1 = dec * st1 + add * bfhi(ld[q].x); st2 = dec * st2 + add * bflo(ld[q].y); st3 = dec * st3 + add * bfhi(ld[q].y);
                m = mn; }
        }
    }
    for (int gi = F.vcu * NTHR + F.tid; gi < 8 * 256; gi += nthreads) {
        const int dh = gi >> 8, e = gi & 255;
        float* base = (float*)(F.ws + WS_NST) + (size_t)dh * 128 * 256 + e;
        float st = 0.f, m = 0.f;
#pragma unroll 4
        for (int c = 0; c < 128; ++c) {
            const float g = GG[dh * 128 + c], amax = g + GPML[dh * 128 + c];
            const float mn = fmaxf(g + m, amax), dec = __expf(g + m - mn), add = __expf(amax - mn);
            const float ld = base[c * 256]; base[c * 256] = st; st = dec * st + add * ld; m = mn; }
    }
}

constexpr int MLB_PIECE = 34816;
constexpr int MLB_PKC = 528, MLB_PTR = 544, MLB_PP = 272;
constexpr int MLB_OFF_P = 2 * MLB_PIECE;
constexpr int MLB_OFF_N = MLB_OFF_P + 2 * 8 * 16 * MLB_PP;
static_assert(MLB_OFF_N + 2048 <= LDSCTL_OFF, "mLSTM-B LDS map");
__device__ __forceinline__ void ph_mlb(const Frame& F) {
    const int wave = F.wave;
    const float* GB = (const float*)(F.ws + WS_GATES + GO_B); const float* GU = (const float*)(F.ws + WS_GATES + GO_U); const float* GPM = (const float*)(F.ws + WS_GATES + GO_PM);
    const float* MPREV = (const float*)(F.ws + WS_GATES + GO_MPREV);
    LAS unsigned char* buf0 = F.lds; LAS unsigned char* buf1 = F.lds + MLB_PIECE;
    LAS float* nprev = (LAS float*)(F.lds + MLB_OFF_N);
    for (int unit = F.vcu; unit < 512; unit += F.G) {
        int tid = F.tid; asm volatile("" : "+v"(tid));
        const int lane = tid & 63, g = lane >> 4, i = lane & 15;
        const int head = unit >> 7, tc = unit & 127, t0 = tc * 128, j0 = 16 * wave;
        const bf16_t* mkp = WSP(bf16_t, WS_MK) + (size_t)t0 * 1024 + head * 256;
        const bf16_t* mvp = WSP(bf16_t, WS_PROJ) + (size_t)t0 * INP + C_MV + head * 256;
        const int c_f = tc, c_b = 127 - tc;
        u32x4 stg[4];
        const int sr = tid >> 5, sc8 = (tid & 31) * 8;
#define PIECE_LOAD(srcp, pitch_el) do { _Pragma("unroll") for (int q_ = 0; q_ < 4; ++q_) stg[q_] = *(const u32x4*)((srcp) + (size_t)(sr + 16 * q_) * (pitch_el) + sc8); } while (0)
#define PIECE_WRITE(dstbuf, pitchB) do { _Pragma("unroll") for (int q_ = 0; q_ < 4; ++q_) *(LAS u32x4*)((dstbuf) + (sr + 16 * q_) * (pitchB) + sc8 * 2) = stg[q_]; } while (0)
        { const int d = tid >> 8, e = tid & 255; nprev[d * 256 + e] = ((const float*)(F.ws + WS_NST))[(size_t)((d * 4 + head) * 128 + (d ? c_b : c_f)) * 256 + e]; }
        bf16x8 qa[8];
        {   const bf16_t* mq = WSP(bf16_t, WS_MQ) + (size_t)(t0 + j0 + i) * 1024 + head * 256 + 8 * g;
#pragma unroll
            for (int s = 0; s < 8; ++s) qa[s] = *(const bf16x8*)(mq + 32 * s); }
        f32x4 sacc[8];
#pragma unroll
        for (int n = 0; n < 8; ++n) sacc[n] = (f32x4){0.f, 0.f, 0.f, 0.f};
        PIECE_LOAD(mkp, 1024); PIECE_WRITE(buf0, MLB_PKC);
        PIECE_LOAD(mkp + (size_t)64 * 1024, 1024);
        __syncthreads();
#pragma unroll
        for (int n = 0; n < 4; ++n)
            { _Pragma("unroll") for (int s = 0; s < 8; ++s) sacc[n] = MFMA16(qa[s], frag_kc(buf0, MLB_PKC, 16 * n, 32 * s, lane), sacc[n]); __builtin_amdgcn_sched_barrier(0); }
        PIECE_WRITE(buf1, MLB_PKC);
        __syncthreads();
#pragma unroll
        for (int n = 0; n < 4; ++n)
            { _Pragma("unroll") for (int s = 0; s < 8; ++s) sacc[4 + n] = MFMA16(qa[s], frag_kc(buf1, MLB_PKC, 16 * n, 32 * s, lane), sacc[4 + n]); __builtin_amdgcn_sched_barrier(0); }
        const bf16_t* cst0 = WSP(bf16_t, WS_CST) + ((size_t)((0 * 4 + head) * 128 + c_f) << 16);
        const bf16_t* cst1 = WSP(bf16_t, WS_CST) + ((size_t)((1 * 4 + head) * 128 + c_b) << 16);
        PIECE_LOAD(cst0, 256);
        float qsc0, qsc1;
#pragma unroll
        for (int d = 0; d < 2; ++d) {
            const int dh = d * 4 + head; const float mp = MPREV[dh * 128 + (d ? c_b : c_f)];
            f32x4 dacc = (f32x4){0.f, 0.f, 0.f, 0.f};
#pragma unroll
            for (int s = 0; s < 8; ++s) { bf16x8 bn; const LAS float* np = nprev + d * 256 + 32 * s + 8 * g;
#pragma unroll
                for (int e = 0; e < 8; ++e) bn[e] = (i == 0) ? (short)f2bf(np[e]) : (short)0;
                dacc = MFMA16(qa[s], bn, dacc); }
            float ur[8];
#pragma unroll
            for (int n = 0; n < 8; ++n) ur[n] = GU[(size_t)dh * S + t0 + 16 * n + i];
            LAS unsigned char* pw = F.lds + MLB_OFF_P + (d * 8 + wave) * (16 * MLB_PP);
            float es[4];
#pragma unroll
            for (int rg = 0; rg < 4; ++rg) { const int jl = 4 * g + rg, j = j0 + jl;
                const float M = fmaxf(mp, GPM[(size_t)dh * S + t0 + j]), ej = __expf(mp - M), mj = GB[(size_t)dh * S + t0 + j] + M;
                float rs = 0.f;
#pragma unroll
                for (int n = 0; n < 8; ++n) { const int r = 16 * n + i; const bool keep = d ? (r >= j) : (r <= j); rs += keep ? sacc[n][rg] * __expf(ur[n] - M) : 0.f; }
                rs += __shfl_xor(rs, 1); rs += __shfl_xor(rs, 2); rs += __shfl_xor(rs, 4); rs += __shfl_xor(rs, 8);
                const float qn = __shfl(dacc[rg], lane & 48);
                const float den = ej * qn + rs, sj = 1.0f / fmaxf(fabsf(den), __expf(-mj));
                es[rg] = ej * sj;
#pragma unroll
                for (int n = 0; n < 8; ++n) { const int r = 16 * n + i; const bool keep = d ? (r >= j) : (r <= j);
                    const float p = keep ? sacc[n][rg] * __expf(ur[n] - M) * sj : 0.f;
                    *(LAS bf16_t*)(pw + jl * MLB_PP + r * 2) = (bf16_t)f2bf(p); } }
            const int srcl = (i >> 2) << 4;
            const float t0_ = __shfl(es[0], srcl), t1_ = __shfl(es[1], srcl), t2_ = __shfl(es[2], srcl), t3_ = __shfl(es[3], srcl);
            const float qs_ = (i & 3) == 0 ? t0_ : (i & 3) == 1 ? t1_ : (i & 3) == 2 ? t2_ : t3_;
            if (d == 0) qsc0 = qs_; else qsc1 = qs_;
        }
        __syncthreads();
        f32x4 hacc[16];
#pragma unroll
        for (int n = 0; n < 16; ++n) hacc[n] = (f32x4){0.f, 0.f, 0.f, 0.f};
#pragma unroll
        for (int d = 0; d < 2; ++d) {
            const bf16_t* cst = d ? cst1 : cst0; const float qsc = d ? qsc1 : qsc0;
            bf16x8 qs[8];
#pragma unroll
            for (int s = 0; s < 8; ++s) { const u32x4 w = __builtin_bit_cast(u32x4, qa[s]); u32x4 o;
                o.x = pk2(bflo(w.x) * qsc, bfhi(w.x) * qsc); o.y = pk2(bflo(w.y) * qsc, bfhi(w.y) * qsc); o.z = pk2(bflo(w.z) * qsc, bfhi(w.z) * qsc); o.w = pk2(bflo(w.w) * qsc, bfhi(w.w) * qsc);
                qs[s] = __builtin_bit_cast(bf16x8, o); }
#pragma unroll
            for (int cp = 0; cp < 4; ++cp) {
                LAS unsigned char* cur = (cp & 1) ? buf1 : buf0;
                PIECE_WRITE(cur, MLB_PKC);
                if (cp < 3) PIECE_LOAD(cst + (size_t)(64 * (cp + 1)) * 256, 256); else PIECE_LOAD(mvp, INP);
                __syncthreads();
#pragma unroll
                for (int n = 0; n < 4; ++n)
                    { _Pragma("unroll") for (int s = 0; s < 8; ++s) hacc[4 * cp + n] = MFMA16(qs[s], frag_kc(cur, MLB_PKC, 16 * n, 32 * s, lane), hacc[4 * cp + n]); __builtin_amdgcn_sched_barrier(0); }
            }
            LAS const unsigned char* pw = F.lds + MLB_OFF_P + (d * 8 + wave) * (16 * MLB_PP);
#pragma unroll
            for (int vp = 0; vp < 2; ++vp) {
                LAS unsigned char* cur = (vp & 1) ? buf1 : buf0;
                PIECE_WRITE(cur, MLB_PTR);
                if (vp == 0) PIECE_LOAD(mvp + (size_t)64 * INP, INP); else if (d == 0) PIECE_LOAD(cst1, 256);
                __syncthreads();
#pragma unroll
                for (int ks = 0; ks < 2; ++ks) { const bf16x8 a = *(LAS const bf16x8*)(pw + i * MLB_PP + (64 * vp + 32 * ks + 8 * g) * 2);
#pragma unroll
                    for (int n = 0; n < 16; ++n) { hacc[n] = MFMA16(a, frag_tr(cur, MLB_PTR, 32 * ks, 16 * n, lane), hacc[n]); if ((n & 3) == 3) __builtin_amdgcn_sched_barrier(0); } }
            }
            __syncthreads();
        }
        {   const float* mg = FIN(8) + head * 256;
            const bf16_t* mo = WSP(bf16_t, WS_PROJ) + C_MO + head * 256; bf16_t* y = WSP(bf16_t, WS_Y) + 1024 + head * 256;
#pragma unroll
            for (int rg = 0; rg < 4; ++rg) { float ss = 0.f;
#pragma unroll
                for (int n = 0; n < 16; ++n) ss += hacc[n][rg] * hacc[n][rg];
                ss += __shfl_xor(ss, 1); ss += __shfl_xor(ss, 2); ss += __shfl_xor(ss, 4); ss += __shfl_xor(ss, 8);
                const float r = 1.0f / sqrtf(ss * (1.f / 256.f) + EPS); const size_t t = (size_t)(t0 + j0 + 4 * g + rg);
#pragma unroll
                for (int n = 0; n < 16; ++n) { const int col = 16 * n + i; const float o = bflo((unsigned)mo[t * INP + col]);
                    #if defined(DBG_ZERO_ML)
                    y[t * DM + col] = 0;
#else
                    y[t * DM + col] = (bf16_t)f2bf(hacc[n][rg] * r * mg[col] * (1.f / (1.f + __expf(-o))));
#endif
                    } }
        }
#undef PIECE_LOAD
#undef PIECE_WRITE
    }
}

#define MFMA32(a, b, c) __builtin_amdgcn_mfma_f32_32x32x16_bf16((a), (b), (c), 0, 0, 0)
__device__ __forceinline__ int fkey(float x) { const int b = __builtin_bit_cast(int, x); return b ^ ((b >> 31) & 0x7fffffff); }
__device__ __forceinline__ float kval(int k) { return __builtin_bit_cast(float, k ^ ((k >> 31) & 0x7fffffff)); }
#define TOP_INS(top, x) do { int x_ = (x); _Pragma("unroll") for (int k_ = 0; k_ < 16; ++k_) { const int hi_ = max(top[k_], x_); x_ = min(top[k_], x_); top[k_] = hi_; } } while (0)
__device__ __forceinline__ int pick4(int sel, int a, int b, int c, int d) { return sel == 0 ? a : sel == 1 ? b : sel == 2 ? c : d; }
__device__ __forceinline__ void topk_item(const Frame& F, int layer, int item) {
    const int tile = item >> 3, h = item & 7, lane = F.lane, r32 = lane & 31, hi = lane >> 5;
    const int t = tile * 32 + r32;
    const bf16_t* qrow = WSP(bf16_t, WS_QP) + (size_t)t * DM + h * 256 + 8 * hi;
    int tops[2][16];
#pragma unroll
    for (int p = 0; p < 2; ++p) {
        const bf16_t* keys = WSP(bf16_t, WS_KEYS) + (size_t)(((layer * 8 + h) * 2 + p) * 128) * 128 + 8 * hi;
        bf16x8 bq[8];
#pragma unroll
        for (int s = 0; s < 8; ++s) bq[s] = *(const bf16x8*)(qrow + p * 128 + 16 * s);
        int top[16];
#pragma unroll
        for (int k = 0; k < 16; ++k) top[k] = (int)0x80000000;
#pragma unroll
        for (int kt = 0; kt < 4; ++kt) {
            f32x16 acc = {};
#pragma unroll
            for (int s = 0; s < 8; ++s) { const bf16x8 a = *(const bf16x8*)(keys + (size_t)(32 * kt + r32) * 128 + 16 * s); acc = MFMA32(a, bq[s], acc); }
#pragma unroll
            for (int r = 0; r < 16; ++r) { const int idx = 32 * kt + (r & 3) + 8 * (r >> 2) + 4 * hi; TOP_INS(top, (fkey(acc[r]) & ~127) | idx); }
        }
        int pt[16];
#pragma unroll
        for (int k = 0; k < 16; ++k) pt[k] = __shfl_xor(top[k], 32);
#pragma unroll
        for (int k = 0; k < 16; ++k) TOP_INS(top, pt[k]);
#pragma unroll
        for (int k = 0; k < 16; ++k) tops[p][k] = top[k];
    }
    float af[16], bfv[16];
#pragma unroll
    for (int k = 0; k < 16; ++k) { af[k] = kval(tops[0][k] & ~127); bfv[k] = kval(tops[1][k] & ~127); }
    int top2[16];
#pragma unroll
    for (int k = 0; k < 16; ++k) top2[k] = (int)0x80000000;
#pragma unroll
    for (int i = 0; i < 16; ++i)
#pragma unroll
        for (int j = 0; j < 16; ++j) if ((i + 1) * (j + 1) <= 16) TOP_INS(top2, (fkey(af[i] + bfv[j]) & ~255) | (i << 4) | j);
    int pa[4], pb[4];
#pragma unroll
    for (int q = 0; q < 4; ++q) { pa[q] = (tops[0][4 * q] & 127) | ((tops[0][4 * q + 1] & 127) << 8) | ((tops[0][4 * q + 2] & 127) << 16) | ((tops[0][4 * q + 3] & 127) << 24);
                                  pb[q] = (tops[1][4 * q] & 127) | ((tops[1][4 * q + 1] & 127) << 8) | ((tops[1][4 * q + 2] & 127) << 16) | ((tops[1][4 * q + 3] & 127) << 24); }
    int ex[16]; float sc[16];
#pragma unroll
    for (int k = 0; k < 16; ++k) { const int code = top2[k] & 255, ii = code >> 4, jj = code & 15;
        const int ea = (pick4(ii >> 2, pa[0], pa[1], pa[2], pa[3]) >> ((ii & 3) * 8)) & 127, eb = (pick4(jj >> 2, pb[0], pb[1], pb[2], pb[3]) >> ((jj & 3) * 8)) & 127;
        ex[k] = ea * 128 + eb; sc[k] = kval(top2[k] & ~255); }
    const float mx = sc[0]; float sum = 0.f;
#pragma unroll
    for (int k = 0; k < 16; ++k) { sc[k] = __expf(sc[k] - mx); sum += sc[k]; }
    const float inv = 1.0f / sum;
    if (hi == 0) { int* d = WSP(int, WS_EIDX) + (size_t)t * 128 + h * 16;
#pragma unroll
        for (int q = 0; q < 4; ++q) *(u32x4*)(d + 4 * q) = (u32x4){(unsigned)ex[4 * q], (unsigned)ex[4 * q + 1], (unsigned)ex[4 * q + 2], (unsigned)ex[4 * q + 3]}; }
    else { float* d = WSP(float, WS_EGATE) + (size_t)t * 128 + h * 16;
#pragma unroll
        for (int q = 0; q < 4; ++q) *(f32x4*)(d + 4 * q) = (f32x4){sc[4 * q] * inv, sc[4 * q + 1] * inv, sc[4 * q + 2] * inv, sc[4 * q + 3] * inv}; }
}
__device__ __forceinline__ void ph_topk(const Frame& F, int layer) {
    const int gw = F.vcu * NWAVES + F.wave, NGW = F.G * NWAVES;
    for (int it = gw; it < 4096; it += NGW) topk_item(F, layer, it);
}

typedef __bf16 bf2 __attribute__((ext_vector_type(2)));
__device__ __forceinline__ float dot2bf(bf2 a, unsigned b, float c) { return __builtin_amdgcn_fdot2_f32_bf16(a, __builtin_bit_cast(bf2, b), c, false); }
__device__ __forceinline__ float dot4_fp8(unsigned w, unsigned xlo, unsigned xhi, float c) {
    c = dot2bf(__builtin_amdgcn_cvt_scalef32_pk_bf16_fp8(w, 1.0f, false), xlo, c);
    return dot2bf(__builtin_amdgcn_cvt_scalef32_pk_bf16_fp8(w, 1.0f, true), xhi, c);
}
constexpr int GA_OFF = 0;
__device__ __forceinline__ void ph_gather(const Frame& F, int layer, bool final_layer) {
    const int lane = F.lane, gw = F.vcu * NWAVES + F.wave, NGW = F.G * NWAVES;
    LAS float* wact = (LAS float*)(F.lds + GA_OFF + F.wave * 1024);
    const unsigned char* U = F.ws + WS_UB + (size_t)layer * 16384 * 2048 + lane * 16; const unsigned char* V = F.ws + WS_VB + (size_t)layer * 16384 * 2048 + lane * 16;
    const float* su = (const float*)(F.ws + WS_TSC) + layer * 16384; const float* sv = su + 32768;
    const float* gnext = final_layer ? FIN(16) : (FIN(1) + DM);
    for (int t = gw; t < S; t += NGW) {
        u32x4 xp[4];
        { const bf16_t* xr = WSP(bf16_t, WS_XN) + (size_t)t * DM + lane * 16;
          xp[0] = *(const u32x4*)xr; xp[1] = *(const u32x4*)(xr + 8); xp[2] = *(const u32x4*)(xr + 1024); xp[3] = *(const u32x4*)(xr + 1032); }
        const int idl = WSP(int, WS_EIDX)[(size_t)t * 128 + lane], idh = WSP(int, WS_EIDX)[(size_t)t * 128 + 64 + lane];
        const float gl = WSP(float, WS_EGATE)[(size_t)t * 128 + lane] * sv[idl], gh = WSP(float, WS_EGATE)[(size_t)t * 128 + 64 + lane] * sv[idh];
        const float sul = su[idl], suh = su[idh];
#pragma unroll 1
        for (int b = 0; b < 16; ++b) {
            u32x4 ur[8][2];
#pragma unroll
            for (int e = 0; e < 8; ++e) { const int k = 8 * b + e; const int id = __builtin_amdgcn_readlane(b < 8 ? idl : idh, k & 63);
                const unsigned char* row = U + (size_t)id * DM; ur[e][0] = *(const u32x4*)row; ur[e][1] = *(const u32x4*)(row + 1024); }
            float v[8];
#pragma unroll
            for (int e = 0; e < 8; ++e) { float a = 0.f;
#pragma unroll
                for (int j = 0; j < 2; ++j) { const u32x4 w = ur[e][j]; const u32x4 x0 = xp[2 * j], x1 = xp[2 * j + 1];
                    a = dot4_fp8(w.x, x0.x, x0.y, a); a = dot4_fp8(w.y, x0.z, x0.w, a); a = dot4_fp8(w.z, x1.x, x1.y, a); a = dot4_fp8(w.w, x1.z, x1.w, a); }
                v[e] = a; }
            float r4[4], r2[2], z;
            { const bool up = lane & 32;
#pragma unroll
              for (int q = 0; q < 4; ++q) { const float keep = up ? v[q + 4] : v[q], give = up ? v[q] : v[q + 4]; r4[q] = keep + __shfl_xor(give, 32); } }
            { const bool up = lane & 16;
#pragma unroll
              for (int q = 0; q < 2; ++q) { const float keep = up ? r4[q + 2] : r4[q], give = up ? r4[q] : r4[q + 2]; r2[q] = keep + __shfl_xor(give, 16); } }
            { const bool up = lane & 8; const float keep = up ? r2[1] : r2[0], give = up ? r2[0] : r2[1]; z = keep + __shfl_xor(give, 8); }
            z += __shfl_xor(z, 4); z += __shfl_xor(z, 2); z += __shfl_xor(z, 1);
            if ((lane & 7) == 0) wact[8 * b + ((lane >> 5) & 1) * 4 + ((lane >> 4) & 1) * 2 + ((lane >> 3) & 1)] = z;
        }
        { const float a0 = wact[lane] * sul, a1 = wact[64 + lane] * suh;
          const float w0 = 0.5f * a0 * (1.f + erff(a0 * 0.70710678118654752f)) * gl, w1 = 0.5f * a1 * (1.f + erff(a1 * 0.70710678118654752f)) * gh;
          wact[lane] = w0; wact[64 + lane] = w1; }
        f32x2 out[16];
#pragma unroll
        for (int q = 0; q < 16; ++q) out[q] = (f32x2){0.f, 0.f};
#pragma unroll 1
        for (int b = 0; b < 16; ++b) {
            u32x4 vr[8][2]; float w[8];
#pragma unroll
            for (int e = 0; e < 8; ++e) { const int k = 8 * b + e; const int id = __builtin_amdgcn_readlane(b < 8 ? idl : idh, k & 63);
                const unsigned char* row = V + (size_t)id * DM; w[e] = wact[k]; vr[e][0] = *(const u32x4*)row; vr[e][1] = *(const u32x4*)(row + 1024); }
#pragma unroll
            for (int e = 0; e < 8; ++e) { const f32x2 ww = {w[e], w[e]};
#pragma unroll
                for (int j = 0; j < 2; ++j) { const unsigned d4[4] = {vr[e][j].x, vr[e][j].y, vr[e][j].z, vr[e][j].w};
#pragma unroll
                    for (int q = 0; q < 4; ++q) { out[8 * j + 2 * q] += ww * __builtin_amdgcn_cvt_pk_f32_fp8(d4[q], false); out[8 * j + 2 * q + 1] += ww * __builtin_amdgcn_cvt_pk_f32_fp8(d4[q], true); } } }
        }
#if defined(DBG_ZERO_PEER)
#pragma unroll
        for (int q = 0; q < 16; ++q) out[q] = (f32x2){0.f, 0.f};
#endif
        float* hrow = WSP(float, WS_H) + (size_t)t * DM + lane * 16; float ss = 0.f;
#pragma unroll
        for (int j = 0; j < 2; ++j)
#pragma unroll
            for (int q = 0; q < 4; ++q) { const f32x4 a = *(const f32x4*)(hrow + 1024 * j + 4 * q); out[8 * j + 2 * q] += (f32x2){a.x, a.y}; out[8 * j + 2 * q + 1] += (f32x2){a.z, a.w}; }
#pragma unroll
        for (int q = 0; q < 16; ++q) ss += out[q].x * out[q].x + out[q].y * out[q].y;
        const float r = 1.0f / sqrtf(wave_sum(ss) * (1.f / DM) + EPS);
#pragma unroll
        for (int j = 0; j < 2; ++j) { const int c0 = 1024 * j + lane * 16;
            if (!final_layer) {
#pragma unroll
                for (int q = 0; q < 4; ++q) *(f32x4*)(hrow + 1024 * j + 4 * q) = (f32x4){out[8 * j + 2 * q].x, out[8 * j + 2 * q].y, out[8 * j + 2 * q + 1].x, out[8 * j + 2 * q + 1].y}; }
            unsigned ow[8];
#pragma unroll
            for (int q = 0; q < 4; ++q) { const f32x4 gg = *(const f32x4*)(gnext + c0 + 4 * q);
                const f32x4 y = {out[8 * j + 2 * q].x * r * gg.x, out[8 * j + 2 * q].y * r * gg.y, out[8 * j + 2 * q + 1].x * r * gg.z, out[8 * j + 2 * q + 1].y * r * gg.w};
                if (final_layer) *(f32x4*)(FOUT() + (size_t)t * DM + c0 + 4 * q) = y; else { ow[2 * q] = pk2(y.x, y.y); ow[2 * q + 1] = pk2(y.z, y.w); } }
            if (!final_layer) { bf16_t* xo = WSP(bf16_t, WS_XN) + (size_t)t * DM + c0; *(u32x4*)xo = (u32x4){ow[0], ow[1], ow[2], ow[3]}; *(u32x4*)(xo + 8) = (u32x4){ow[4], ow[5], ow[6], ow[7]}; }
        }
    }
}

__device__ __forceinline__ void ph_poolprep(const Frame& F) {
    const int lane = F.lane, gw = F.vcu * NWAVES + F.wave, NGW = F.G * NWAVES;
    const bf16_t* xn = WSP(bf16_t, WS_XN);
    for (int t = gw; t < S; t += NGW) {
#pragma unroll
        for (int j = 0; j < 4; ++j) {
            const int half = 1 << j, lo = max(t - half, 0), hi = min(t + half, S), c0 = (lane + 64 * j) * 8;
            float a[8];
#pragma unroll
            for (int q = 0; q < 8; ++q) a[q] = 0.f;
            for (int r = lo; r < hi; ++r) { const u32x4 x = *(const u32x4*)(xn + (size_t)r * DM + c0);
                a[0] += bflo(x.x); a[1] += bfhi(x.x); a[2] += bflo(x.y); a[3] += bfhi(x.y); a[4] += bflo(x.z); a[5] += bfhi(x.z); a[6] += bflo(x.w); a[7] += bfhi(x.w); }
            const u32x4 x = *(const u32x4*)(xn + (size_t)t * DM + c0); const float ic = 1.0f / (float)(hi - lo);
            u32x4 o; o.x = pk2(a[0] * ic - bflo(x.x), a[1] * ic - bfhi(x.x)); o.y = pk2(a[2] * ic - bflo(x.y), a[3] * ic - bfhi(x.y));
            o.z = pk2(a[4] * ic - bflo(x.z), a[5] * ic - bfhi(x.z)); o.w = pk2(a[6] * ic - bflo(x.w), a[7] * ic - bfhi(x.w));
            *(u32x4*)(WSP(bf16_t, WS_POOLED) + (size_t)t * DM + c0) = o;
        }
    }
}
__device__ __forceinline__ void ph_norm(const Frame& F, int layer) {
    const int gw = F.vcu * NWAVES + F.wave, NGW = F.G * NWAVES;
    for (int m = gw; m < S; m += NGW) rms_row_to_bf16(WSP(float, WS_H) + (size_t)m * DM, FIN(2) + layer * DM, WSP(bf16_t, WS_XN) + (size_t)m * DM, F.lane);
}

__device__ __forceinline__ void ph_attn(const Frame& F) {
    const int nunits = 8 * 64;
    for (int u = F.vcu * 2; u < nunits; u += F.G * 2)
#pragma unroll 1
        for (int k = 0; k < 2; ++k) { const int unit = u + k, head = unit >> 6, qb = unit & 63, kvh = head >> 2;
            att::attn_dense_body<att::bf16>(WSP(att::bf16, WS_QB) + (size_t)(qb * 256) * 1024 + head * 128, WSP(att::bf16, WS_KVB) + kvh * 128, WSP(att::bf16, WS_KVB) + 256 + kvh * 128,
                                 WSP(att::bf16, WS_Y) + (size_t)(qb * 256) * DM + head * 128, S, F.ldsg); }
}

#ifndef PHASE_MASK
#define PHASE_MASK 0x3ffff
#endif
#define PH_ON(k) (((PHASE_MASK) >> (k)) & 1)
struct Args { const float* in[17]; float* out; unsigned char* ws; int ph_lo, ph_hi; };
static_assert(sizeof(Args) == 17 * 8 + 8 + 8 + 8, "Args has no padding");
__global__ void __launch_bounds__(NTHR, 2) fwd_kernel(Args args) {
    extern __shared__ __attribute__((aligned(16))) unsigned char lds[];
    Frame F;
    F.lds = (LAS unsigned char*)lds; F.ldsg = (char*)lds;
    F.tid = threadIdx.x; F.lane = F.tid & 63; F.wave = __builtin_amdgcn_readfirstlane(F.tid >> 6);
    F.G = gridDim.x; { const int bx = blockIdx.x; F.vcu = (F.G % 8 == 0) ? (bx % 8) * (F.G / 8) + bx / 8 : bx; }
    F.ws = args.ws;
    volatile LAS unsigned* MISC = (volatile LAS unsigned*)(F.lds + LDSCTL_OFF);
    if (F.tid < 16) ((LAS unsigned*)(F.lds + LDSCTL_OFF))[F.tid] = 0u;
    if (F.tid >= 64 && F.tid < 64 + 36) ((LAS unsigned*)(F.lds + LDSCTL_OFF + 64))[F.tid - 64] = ((const unsigned*)&args)[F.tid - 64];
    __syncthreads();
    const int lo = args.ph_lo, hi = args.ph_hi;
    XcdBarrier bar; bar.bar = (unsigned*)(F.ws + WS_CTL) + CW_BAR; bar.x = 0; bar.st = nullptr;
    if (hi - lo > 1) bar = xcd_barrier_post((unsigned*)(F.ws + WS_CTL) + CW_BAR, MISC + 8);
#pragma unroll 1
    for (int ph = lo; ph < hi; ++ph) {
        if (ph > lo) xcd_barrier(bar);
        { int t_ = threadIdx.x; asm volatile("" : "+v"(t_)); F.tid = t_; F.lane = t_ & 63; F.wave = __builtin_amdgcn_readfirstlane(t_ >> 6);
          unsigned long long w_ = (unsigned long long)args.ws; asm volatile("" : "+s"(w_)); F.ws = (unsigned char*)w_; }
#if defined(PROBE_PH)
        unsigned long long tprobe0 = 0; if (ph == PROBE_PH) tprobe0 = __builtin_amdgcn_s_memrealtime();
        if (ph == PROBE_PH + 1 || (PROBE_PH == NPH - 1 && false)) { }
#endif
        switch (ph) {
#define PHM(n) asm volatile("; PHASE_MARK " #n ::: "memory")
        case PH_PRO: if constexpr (PH_ON(PH_PRO)) { PHM(PH_PRO); ph_prologue(F); } break;
        case PH_GEMM_IN: if constexpr (PH_ON(PH_GEMM_IN)) { PHM(PH_GEMM_IN);  pg8::Gemm g{WSP(bf16_t, WS_XN), WSP(bf16_t, WS_WIN), S, INP, DM, DM, DM, 0, 0}; pg8::StaticOrder So; So.init(S, INP, F.G, (int)blockIdx.x);
            pg8::EpiBf16<0> E{WSP(bf16_t, WS_PROJ), INP, nullptr, 0, 0, 1.f};
            pg8::gemm_phase<pg8::EpiBf16<0>, pg8::StaticOrder, true, true>(F.lds, g, So, E); } break;
        case PH_POST: if constexpr (PH_ON(PH_POST)) { PHM(PH_POST); ph_post(F); } break;
        case PH_ATTN: if constexpr (PH_ON(PH_ATTN)) { PHM(PH_ATTN); ph_attn(F); } break;
        case PH_MLA: if constexpr (PH_ON(PH_MLA)) { PHM(PH_MLA); ph_mla(F); } break;
        case PH_SCAN: if constexpr (PH_ON(PH_SCAN)) { PHM(PH_SCAN); ph_scan(F); } break;
        case PH_MLB: if constexpr (PH_ON(PH_MLB)) { PHM(PH_MLB); ph_mlb(F); } break;
        case PH_GEMM_OUT: if constexpr (PH_ON(PH_GEMM_OUT)) { PHM(PH_GEMM_OUT);  pg8::Gemm g{WSP(bf16_t, WS_Y), WSP(bf16_t, WS_WOUT), S, DM, DM, DM, DM, 0, 0}; pg8::StaticOrder So; So.init(S, DM, F.G, (int)blockIdx.x);
            pg8::EpiResF32 E{FIN(0), WSP(float, WS_H), DM, nullptr};
            pg8::gemm_phase<pg8::EpiResF32, pg8::StaticOrder, true, true>(F.lds, g, So, E); } break;
        case PH_NORM0: if constexpr (PH_ON(PH_NORM0)) { PHM(PH_NORM0); ph_norm(F, 0); } break;
        case PH_NORM1: if constexpr (PH_ON(PH_NORM1)) { PHM(PH_NORM1); ph_norm(F, 1); } break;
        case PH_GEMM_Q0: case PH_GEMM_Q1: if constexpr (PH_ON(PH_GEMM_Q0)) { PHM(PH_GEMM_Q0);  pg8::Gemm g{WSP(bf16_t, WS_XN), WSP(bf16_t, ph == PH_GEMM_Q0 ? WS_WQ0 : WS_WQ1), S, DM, DM, DM, DM, 0, 0}; pg8::StaticOrder So; So.init(S, DM, F.G, (int)blockIdx.x);
            pg8::EpiBf16<0> E{WSP(bf16_t, WS_QP), DM, nullptr, 0, 0, 1.f};
            pg8::gemm_phase<pg8::EpiBf16<0>, pg8::StaticOrder, true, true>(F.lds, g, So, E); } break;
        case PH_TOPK0: if constexpr (PH_ON(PH_TOPK0)) { PHM(PH_TOPK0); ph_topk(F, 0); } break;
        case PH_TOPK1: if constexpr (PH_ON(PH_TOPK1)) { PHM(PH_TOPK1); ph_topk(F, 1); } break;
        case PH_GATHER0: if constexpr (PH_ON(PH_GATHER0)) { PHM(PH_GATHER0); ph_gather(F, 0, false); } break;
        case PH_GATHER1: if constexpr (PH_ON(PH_GATHER1)) { PHM(PH_GATHER1); ph_gather(F, 1, true); } break;
        case PH_POOLPREP: if constexpr (PH_ON(PH_POOLPREP)) { PHM(PH_POOLPREP); ph_poolprep(F); } break;
        case PH_GEMM_POOL: if constexpr (PH_ON(PH_GEMM_POOL)) { PHM(PH_GEMM_POOL);  pg8::Gemm g{WSP(bf16_t, WS_POOLED), WSP(bf16_t, WS_WPOOL), S, DM, 512, DM, 512, 1, 512 * 2}; pg8::StaticOrder So; So.init(S, DM, F.G, (int)blockIdx.x);
            pg8::EpiResF32 E{WSP(float, WS_H), WSP(float, WS_H), DM, FIN(11)};
            pg8::gemm_phase<pg8::EpiResF32, pg8::StaticOrder, true, true>(F.lds, g, So, E); } break;
        default: break;
        }
#if defined(PROBE_PH)
        if (ph == PROBE_PH) { __syncthreads(); const unsigned long long t1 = __builtin_amdgcn_s_memrealtime(), dt = t1 - tprobe0;
            while (__builtin_amdgcn_s_memrealtime() - t1 < 4ull * dt) __builtin_amdgcn_s_sleep(8); }
#endif
    }
}

#ifndef N_LAUNCH_MODE
#define N_LAUNCH_MODE 1
#endif
extern "C" void kernel_launch(void* const* d_in, const int* in_sizes, int n_in, void* d_out, int out_size, void* d_ws, size_t ws_size, hipStream_t stream) {
    static int grid = 0;
    if (grid == 0) {
        if (n_in != 17 || in_sizes[0] != S * DM || out_size != S * DM || ws_size < WS_END) { fprintf(stderr, "kernel_launch: unexpected shapes (n_in %d, in0 %d, out %d, ws %zu; need ws >= %zu)\n", n_in, n_in > 0 ? in_sizes[0] : -1, out_size, ws_size, (size_t)WS_END); grid = -1; return; }
        int dev = 0, cus = 0;
        if (hipGetDevice(&dev) != hipSuccess || hipDeviceGetAttribute(&cus, hipDeviceAttributeMultiprocessorCount, dev) != hipSuccess) { grid = -1; return; }
        if (hipFuncSetAttribute((const void*)fwd_kernel, hipFuncAttributeMaxDynamicSharedMemorySize, LDS_BYTES) != hipSuccess) { fprintf(stderr, "kernel_launch: hipFuncSetAttribute failed\n"); grid = -1; return; }
        int per_cu = 0;
        if (hipOccupancyMaxActiveBlocksPerMultiprocessor(&per_cu, (const void*)fwd_kernel, NTHR, LDS_BYTES) != hipSuccess || per_cu < 1) fprintf(stderr, "kernel_launch: occupancy query reports %d\n", per_cu);
        (void)hipGetLastError();
        grid = cus;
    }
    if (grid < 0) return;
    (void)hipMemsetAsync((char*)d_ws + WS_CTL, 0, CTL_ZERO_BYTES, stream);
    Args a{};
    for (int i = 0; i < 17; ++i) a.in[i] = (const float*)d_in[i];
    a.out = (float*)d_out; a.ws = (unsigned char*)d_ws;
#if N_LAUNCH_MODE == 1
    a.ph_lo = 0; a.ph_hi = NPH;
    hipLaunchKernelGGL(fwd_kernel, dim3(grid), dim3(NTHR), LDS_BYTES, stream, a);
#else
    for (int ph = 0; ph < NPH; ++ph) { a.ph_lo = ph; a.ph_hi = ph + 1; hipLaunchKernelGGL(fwd_kernel, dim3(grid), dim3(NTHR), LDS_BYTES, stream, a); }
#endif
    const hipError_t le = hipPeekAtLastError();
    if (le != hipSuccess) fprintf(stderr, "kernel_launch: launch failed: %s\n", hipGetErrorName(le));
}
```

```cpp
#include <hip/hip_runtime.h>
#include <hip/hip_bf16.h>
#include <cstdio>
#include <cstdint>
#include <cmath>

constexpr int S = 16384, DM = 2048, NWAVES = 8, NTHR = 512;
constexpr int INW = 5648, INP = 5888;
constexpr int C_AQ = 0, C_AK = 1024, C_AV = 1280, C_MQK = 1536, C_MV = 3584, C_MO = 4608, C_GATE = 5632;
constexpr float EPS = 1e-6f;
constexpr int NPH = 24;
enum { PH_PRO = 0, PH_GEMM_IN, PH_POST, PH_ATTN, PH_MLA, PH_SCAN, PH_MLB, PH_GEMM_OUT, PH_NORM0, PH_GEMM_Q0, PH_TOPK0, PH_GU0, PH_ACT0, PH_GV0, PH_NORMP,
       PH_POOLPREP, PH_GEMM_POOL, PH_NORM1, PH_GEMM_Q1, PH_TOPK1, PH_GU1, PH_ACT1, PH_GV1, PH_NORMF };

constexpr size_t MiB = 1u << 20;
constexpr size_t WS_CTL = 0, CTL_ZERO_BYTES = 1 * MiB;
constexpr size_t WS_WIN = 1 * MiB, WS_WOUT = 24 * MiB, WS_WQ0 = 32 * MiB, WS_WQ1 = 40 * MiB, WS_WPOOL = 48 * MiB, WS_KEYS = 50 * MiB;
constexpr size_t WS_TSC = 52 * MiB + 768 * 1024  , WS_GATES = 51 * MiB, WS_NST = 53 * MiB, WS_EIDX = 54 * MiB, WS_EGATE = 62 * MiB;
constexpr size_t WS_UB = 70 * MiB, WS_VB = 198 * MiB, WS_XN = 326 * MiB, WS_PROJ = 390 * MiB, WS_QP = WS_PROJ;
constexpr size_t WS_QB = 574 * MiB, WS_KVB = 606 * MiB, WS_MQ = 622 * MiB, WS_MK = 654 * MiB, WS_CST = 686 * MiB, WS_Y = 814 * MiB, WS_POOLED = WS_Y;
constexpr size_t WS_H = 878 * MiB, WS_END = 1006 * MiB;
constexpr int CW_BAR = 4096;
constexpr size_t GO_B = 0, GO_U = 8 * S * 4, GO_PM = 2 * 8 * S * 4, GO_G = 3 * 8 * S * 4, GO_PML = GO_G + 4096, GO_MPREV = GO_PML + 4096;

constexpr int LDS_BYTES = 147456, LDSCTL_OFF = 146944;

#define GAS __attribute__((address_space(1)))
#define LAS __attribute__((address_space(3)))
typedef unsigned short bf16_t;
typedef short bf16x8 __attribute__((ext_vector_type(8)));
typedef short s16x4 __attribute__((ext_vector_type(4)));
typedef short v4i16_t __attribute__((ext_vector_type(4)));
typedef float f32x4 __attribute__((ext_vector_type(4)));
typedef float f32x2 __attribute__((ext_vector_type(2)));
typedef float f32x16 __attribute__((ext_vector_type(16)));
typedef unsigned u32x4 __attribute__((ext_vector_type(4)));
typedef unsigned u32x2 __attribute__((ext_vector_type(2)));
typedef __bf16 bf16x2_t __attribute__((ext_vector_type(2)));
typedef GAS unsigned gu32;
#define RLX_AGENT __ATOMIC_RELAXED, __HIP_MEMORY_SCOPE_AGENT
#define LDS_WAIT() asm volatile("s_waitcnt lgkmcnt(0)" ::: "memory")
__device__ __forceinline__ unsigned f2bf(float f) { unsigned u = __builtin_bit_cast(unsigned, f); return (u + 0x7fffu + ((u >> 16) & 1u)) >> 16; }
__device__ __forceinline__ unsigned pk2(float lo, float hi) { f32x2 v = {lo, hi}; bf16x2_t b = __builtin_convertvector(v, bf16x2_t); return __builtin_bit_cast(unsigned, b); }
__device__ __forceinline__ float bflo(unsigned w) { return __builtin_bit_cast(float, w << 16); }
__device__ __forceinline__ float bfhi(unsigned w) { return __builtin_bit_cast(float, w & 0xffff0000u); }
__device__ __forceinline__ float wave_sum(float v) {
#pragma unroll
    for (int o = 1; o < 64; o <<= 1) v += __shfl_xor(v, o);
    return v;
}

namespace pg8 {
#define PG8_LAS __attribute__((address_space(3)))
typedef unsigned short bf16_t;
typedef short bf16x8 __attribute__((ext_vector_type(8)));
typedef float f32x4 __attribute__((ext_vector_type(4)));
typedef unsigned u32x4 __attribute__((ext_vector_type(4)));
constexpr int BM = 256, BK = 64, HALF = 128, HTB = HALF * BK * 2  , STAGE_BYTES = 8 * HTB, NXCD = 8, WGM = 8;

__host__ __device__ __forceinline__ int lds_byte(int r, int c) { const int st = (r >> 4) * 2 + (c >> 5), rr = r & 15, cc = c & 31, ob = rr * 64 + cc * 2; return st * 1024 + (ob ^ (((ob >> 9) & 1) << 5)); }
__host__ __device__ __forceinline__ void stage_rc(int b, int& R, int& C) { const int st = b / 1024, sb = b % 1024, swz = sb ^ (((sb >> 9) & 1) << 5); R = (st >> 1) * 16 + swz / 64; C = (st & 1) * 32 + (swz % 64) / 2; }
__host__ __device__ __forceinline__ int perm32(int rho) { const int n = rho >> 4, i = rho & 15; return 8 * (i >> 2) + 4 * n + (i & 3); }

struct Unit { int pm, pn; };
struct Gemm { const bf16_t* A; const bf16_t* Bt; int M, N, K, lda, ldb, agrp_shift; size_t agrp_bytes; };

struct StaticOrder {
    int nM, nN, nwg, G, c;
    __host__ __device__ void init(int M, int N, int G_, int c_) { nM = M / BM; nN = N / BM; nwg = nM * nN; G = G_; c = c_; }
    __host__ __device__ bool next(int i, Unit& u) const {
        const long L = (long)i * G + c; if (L >= nwg) return false;
        int wgid = (int)L; { const int q = nwg / NXCD, r = nwg % NXCD, xcd = wgid % NXCD, off = wgid / NXCD; wgid = (xcd < r ? xcd * (q + 1) : r * (q + 1) + (xcd - r) * q) + off; }
        const int nig = WGM * nN, gid = wgid / nig, fm = gid * WGM, gsz = (nM - fm) < WGM ? (nM - fm) : WGM;
        u.pm = fm + ((wgid % nig) % gsz); u.pn = (wgid % nig) / gsz; return true;
    }
    __device__ __forceinline__ void a_ready(const Unit&) const {}
    __device__ __forceinline__ void done(const Unit&) const {}
};

__device__ __forceinline__ unsigned cvt_pk_bf16(float lo, float hi) { unsigned r; asm volatile("v_cvt_pk_bf16_f32 %0, %1, %2" : "=v"(r) : "v"(lo), "v"(hi)); return r; }
typedef float f32x2 __attribute__((ext_vector_type(2)));
__device__ __forceinline__ f32x2 gelu_pk(f32x2 v) {
    const f32x2 av = __builtin_elementwise_abs(v), d = av * 0.2316418882f + 1.0f;
    f32x2 t; t.x = __builtin_amdgcn_rcpf(d.x); t.y = __builtin_amdgcn_rcpf(d.y);
    f32x2 q = t * 0.5307027145f + (-0.7265760135f); q = q * t + 0.7107068705f; q = q * t + (-0.142248368f); q = q * t + 0.127414796f; q = q * t;
    const f32x2 s = (v * v) * (-0.72134752044f);
    f32x2 e; e.x = __builtin_amdgcn_exp2f(s.x); e.y = __builtin_amdgcn_exp2f(s.y);
    const f32x2 m = v * (q * e), r = v - m;
    f32x2 o; o.x = v.x < 0.f ? m.x : r.x; o.y = v.y < 0.f ? m.y : r.y; return o;
}
template <int ACT  > struct EpiBf16 {
    static constexpr bool PERM = true, AFTER_DRAIN = false; static_assert(ACT == 0 || ACT == 1, "EpiBf16: ACT is 0 (none) or 1 (gelu_pk)");
    bf16_t* O; int ldc; const float* bias; int split_cols; size_t split_stride; float scale0;
    __device__ __forceinline__ void operator()(const f32x4 (&acc)[2][2][4][2], const Unit& u, int wr, int wc, int fr, int fq) const {
        const int row0 = u.pm * BM + wr * 64 + fr; int colt = u.pn * BM; bf16_t* base = O;
        float sc = 1.f; if (split_cols) { const int t = colt / split_cols; base += (size_t)t * split_stride; colt -= t * split_cols; if (t == 0) sc = scale0; }
        const int col0 = colt + wc * 32 + 8 * fq, bcol0 = u.pn * BM + wc * 32 + 8 * fq;
        f32x4 bv[2][2];
#pragma unroll
        for (int bj = 0; bj < 2; ++bj)
#pragma unroll
            for (int n = 0; n < 2; ++n) bv[bj][n] = bias ? *(const f32x4*)(bias + bcol0 + bj * HALF + 4 * n) : (f32x4){0.f, 0.f, 0.f, 0.f};
#pragma unroll
        for (int ai = 0; ai < 2; ++ai)
#pragma unroll
            for (int m = 0; m < 4; ++m) { bf16_t* rowp = base + (size_t)(row0 + ai * HALF + m * 16) * ldc + col0;
#pragma unroll
                for (int bj = 0; bj < 2; ++bj) { f32x4 v0 = acc[ai][bj][m][0] + bv[bj][0], v1 = acc[ai][bj][m][1] + bv[bj][1];
                    if (ACT == 1) { f32x2 a = gelu_pk((f32x2){v0[0], v0[1]}), b = gelu_pk((f32x2){v0[2], v0[3]}), c = gelu_pk((f32x2){v1[0], v1[1]}), d = gelu_pk((f32x2){v1[2], v1[3]});
                        v0 = (f32x4){a.x, a.y, b.x, b.y}; v1 = (f32x4){c.x, c.y, d.x, d.y}; }
                    v0 = v0 * sc; v1 = v1 * sc; u32x4 w; w.x = cvt_pk_bf16(v0[0], v0[1]); w.y = cvt_pk_bf16(v0[2], v0[3]); w.z = cvt_pk_bf16(v1[0], v1[1]); w.w = cvt_pk_bf16(v1[2], v1[3]);
                    *(u32x4*)(rowp + bj * HALF) = w; } }
    }
};
struct EpiResF32 {
    static constexpr bool PERM = false, AFTER_DRAIN = false;
    const float* base; float* out; int ldc; const float* colscale;
    __device__ __forceinline__ void operator()(const f32x4 (&acc)[2][2][4][2], const Unit& u, int wr, int wc, int fr, int fq) const {
        const int row0 = u.pm * BM + wr * 64 + fr, col0 = u.pn * BM + wc * 32 + 4 * fq;
        f32x4 cs[2][2];
#pragma unroll
        for (int bj = 0; bj < 2; ++bj)
#pragma unroll
            for (int n = 0; n < 2; ++n) cs[bj][n] = colscale ? *(const f32x4*)(colscale + col0 + bj * HALF + n * 16) : (f32x4){1.f, 1.f, 1.f, 1.f};
#pragma unroll
        for (int ai = 0; ai < 2; ++ai)
#pragma unroll
            for (int m = 0; m < 4; ++m) { const size_t off = (size_t)(row0 + ai * HALF + m * 16) * ldc + col0;
#pragma unroll
                for (int bj = 0; bj < 2; ++bj)
#pragma unroll
                    for (int n = 0; n < 2; ++n) { const f32x4 b = *(const f32x4*)(base + off + bj * HALF + n * 16);
                        *(f32x4*)(out + off + bj * HALF + n * 16) = b + acc[ai][bj][m][n] * cs[bj][n]; }
                asm volatile("" ::: "memory"); }
    }
};

template <class Epi, class Sched, bool ALIGN_EPI = false, bool SP2 = false>
__device__ __forceinline__ void gemm_phase(PG8_LAS unsigned char* lds, const Gemm g, const Sched& S, const Epi& E) {
    int tid_ = threadIdx.x; asm volatile("" : "+v"(tid_));
    const int tid = tid_, wid = __builtin_amdgcn_readfirstlane(tid >> 6), lane = tid & 63, wr = wid >> 2, wc = wid & 3, fr = lane & 15, fq = lane >> 4;
    const int K = g.K, nt = K / BK;
    unsigned voffA[2], voffB[2];
#pragma unroll
    for (int i = 0; i < 2; ++i) { int R, C; stage_rc(tid * 16 + i * 8192, R, C); const int Rb = Epi::PERM ? ((R & ~31) + perm32(R & 31)) : R;
        voffA[i] = (unsigned)(R * g.lda + C) * 2u; voffB[i] = (unsigned)(Rb * g.ldb + C) * 2u; }
    const size_t kstep = (size_t)(BK * 2);
    const size_t hstepA = (size_t)HALF * g.lda * 2, hstepB = (size_t)HALF * g.ldb * 2;
    const size_t tstepA = 2 * hstepA, tstepB = 2 * hstepB;
    const unsigned ldsw = (unsigned)wid * 1024u;
    const int aoff = lds_byte(wr * 64 + fr, fq * 8), boff = lds_byte(wc * 32 + fr, fq * 8);
#define PG8_SA(b, h) (((b) * 2 + (h)) * HTB)
#define PG8_SB(b, h) ((4 + (b) * 2 + (h)) * HTB)
#define PG8_STAGE(bufoff, gbase, voff) do { _Pragma("unroll") for (int _i = 0; _i < 2; ++_i) \
        __builtin_amdgcn_global_load_lds((const unsigned*)((const char*)(gbase) + (voff)[_i]), (PG8_LAS unsigned*)(lds + (bufoff) + ldsw + _i * 8192), 16, 0, 0); } while (0)
#define PG8_LDA(dst, b, h) do { _Pragma("unroll") for (int m = 0; m < 4; ++m) _Pragma("unroll") for (int k = 0; k < 2; ++k) dst[m][k] = *(const PG8_LAS bf16x8*)(lds + PG8_SA(b, h) + aoff + m * 2048 + k * 1024); } while (0)
#define PG8_LDB(dst, b, h) do { _Pragma("unroll") for (int n = 0; n < 2; ++n) _Pragma("unroll") for (int k = 0; k < 2; ++k) dst[n][k] = *(const PG8_LAS bf16x8*)(lds + PG8_SB(b, h) + boff + n * 2048 + k * 1024); } while (0)
#define PG8_MMA(ai, bj, At, Bt) do { __builtin_amdgcn_s_setprio(1); _Pragma("unroll") for (int m = 0; m < 4; ++m) _Pragma("unroll") for (int n = 0; n < 2; ++n) _Pragma("unroll") for (int k = 0; k < 2; ++k) \
        acc[ai][bj][m][n] = __builtin_amdgcn_mfma_f32_16x16x32_bf16(Bt[n][k], At[m][k], acc[ai][bj][m][n], 0, 0, 0); __builtin_amdgcn_s_setprio(0); } while (0)
#define PG8_WAIT_V(n) asm volatile("s_waitcnt vmcnt(" #n ")" ::: "memory")
#define PG8_WAIT_L(n) asm volatile("s_waitcnt lgkmcnt(" #n ")" ::: "memory")
#define PG8_BAR __builtin_amdgcn_s_barrier()
#define PG8_SCHED __builtin_amdgcn_sched_barrier(0)
    Unit cur, nxt; int ui = 0;
    if (!S.next(0, cur)) return;
    f32x4 acc[2][2][4][2];
#pragma unroll
    for (int a = 0; a < 2; ++a)
#pragma unroll
        for (int b = 0; b < 2; ++b)
#pragma unroll
            for (int m = 0; m < 4; ++m)
#pragma unroll
                for (int n = 0; n < 2; ++n) acc[a][b][m][n] = (f32x4){0.f, 0.f, 0.f, 0.f};
    bf16x8 At[4][2], B0[2][2], B1[2][2];
    const char* cA = (const char*)g.A + (size_t)cur.pm * tstepA + (size_t)(cur.pn >> g.agrp_shift) * g.agrp_bytes; const char* cB = (const char*)g.Bt + (size_t)cur.pn * tstepB;
    S.a_ready(cur);
    if constexpr (SP2) {
        PG8_STAGE(PG8_SB(0, 0), cB, voffB); PG8_STAGE(PG8_SB(0, 1), cB + hstepB, voffB); PG8_STAGE(PG8_SA(0, 0), cA, voffA); PG8_STAGE(PG8_SA(0, 1), cA + hstepA, voffA);
        if (wr == 1) PG8_BAR;
        PG8_WAIT_V(2); PG8_BAR;
        PG8_STAGE(PG8_SB(1, 0), cB + kstep, voffB); PG8_STAGE(PG8_SA(1, 0), cA + kstep, voffA); PG8_STAGE(PG8_SB(1, 1), cB + hstepB + kstep, voffB);
        PG8_WAIT_V(6); PG8_BAR;
    } else {
        PG8_STAGE(PG8_SB(0, 0), cB, voffB); PG8_STAGE(PG8_SA(0, 0), cA, voffA); PG8_STAGE(PG8_SB(0, 1), cB + hstepB, voffB); PG8_STAGE(PG8_SA(0, 1), cA + hstepA, voffA);
        if (wr == 1) PG8_BAR;
        PG8_WAIT_V(4); PG8_BAR;
        PG8_STAGE(PG8_SB(1, 0), cB + kstep, voffB); PG8_STAGE(PG8_SA(1, 0), cA + kstep, voffA); PG8_STAGE(PG8_SB(1, 1), cB + hstepB + kstep, voffB);
        PG8_WAIT_V(6); PG8_BAR;
    }
    for (;;) {
        const bool has_next = S.next(ui + 1, nxt);
        const char* nA = has_next ? (const char*)g.A + (size_t)nxt.pm * tstepA + (size_t)(nxt.pn >> g.agrp_shift) * g.agrp_bytes : cA; const char* nB = has_next ? (const char*)g.Bt + (size_t)nxt.pn * tstepB : cB;
        for (int t = 0; t < nt; t += 2) {
            const bool last = (t == nt - 2);
            const char* a1 = cA + (size_t)(t + 1) * kstep;
            const char* a2 = last ? nA : cA + (size_t)(t + 2) * kstep; const char* b2 = last ? nB : cB + (size_t)(t + 2) * kstep;
            const char* a3 = a2 + kstep; const char* b3 = b2 + kstep;
            if (last && has_next) S.a_ready(nxt);
            if constexpr (SP2) {
            PG8_LDB(B0, 0, 0); PG8_LDB(B1, 0, 1); PG8_SCHED; PG8_LDA(At, 0, 0); PG8_STAGE(PG8_SA(1, 1), a1 + hstepA, voffA);
            PG8_WAIT_V(8); PG8_WAIT_L(0); PG8_BAR; PG8_MMA(0, 0, At, B0); PG8_MMA(0, 1, At, B1); PG8_BAR; PG8_SCHED;
            PG8_LDA(At, 0, 1); PG8_STAGE(PG8_SB(0, 0), b2, voffB); PG8_STAGE(PG8_SB(0, 1), b2 + hstepB, voffB); PG8_STAGE(PG8_SA(0, 0), a2, voffA);
            PG8_WAIT_V(8); PG8_WAIT_L(0); PG8_BAR; PG8_MMA(1, 0, At, B0); PG8_MMA(1, 1, At, B1); PG8_BAR; PG8_SCHED;
            PG8_LDB(B0, 1, 0); PG8_LDB(B1, 1, 1); PG8_SCHED; PG8_LDA(At, 1, 0); PG8_STAGE(PG8_SA(0, 1), a2 + hstepA, voffA);
            PG8_WAIT_V(8); PG8_WAIT_L(0); PG8_BAR; PG8_MMA(0, 0, At, B0); PG8_MMA(0, 1, At, B1); PG8_BAR; PG8_SCHED;
            PG8_LDA(At, 1, 1); PG8_STAGE(PG8_SB(1, 0), b3, voffB); PG8_STAGE(PG8_SB(1, 1), b3 + hstepB, voffB); PG8_STAGE(PG8_SA(1, 0), a3, voffA);
            PG8_WAIT_V(8); PG8_WAIT_L(0); PG8_BAR; PG8_MMA(1, 0, At, B0); PG8_MMA(1, 1, At, B1); PG8_BAR; PG8_SCHED;
            } else {
            PG8_LDB(B0, 0, 0); PG8_SCHED; PG8_LDA(At, 0, 0); PG8_STAGE(PG8_SA(1, 1), a1 + hstepA, voffA);
            PG8_WAIT_L(8); PG8_BAR; PG8_WAIT_L(0); PG8_MMA(0, 0, At, B0); PG8_BAR; PG8_SCHED;
            PG8_LDB(B1, 0, 1); PG8_STAGE(PG8_SB(0, 0), b2, voffB);
            PG8_BAR; PG8_WAIT_L(0); PG8_MMA(0, 1, At, B1); PG8_BAR;
            PG8_LDA(At, 0, 1); PG8_STAGE(PG8_SA(0, 0), a2, voffA);
            PG8_BAR; PG8_WAIT_L(0); PG8_MMA(1, 0, At, B0); PG8_BAR; PG8_SCHED;
            PG8_STAGE(PG8_SB(0, 1), b2 + hstepB, voffB);
            PG8_WAIT_V(6); PG8_BAR; PG8_MMA(1, 1, At, B1); PG8_BAR;
            PG8_LDB(B0, 1, 0); PG8_SCHED; PG8_LDA(At, 1, 0); PG8_STAGE(PG8_SA(0, 1), a2 + hstepA, voffA);
            PG8_WAIT_L(8); PG8_BAR; PG8_WAIT_L(0); PG8_MMA(0, 0, At, B0); PG8_BAR; PG8_SCHED;
            PG8_LDB(B1, 1, 1); PG8_STAGE(PG8_SB(1, 0), b3, voffB);
            PG8_BAR; PG8_WAIT_L(0); PG8_MMA(0, 1, At, B1); PG8_BAR;
            PG8_LDA(At, 1, 1); PG8_STAGE(PG8_SA(1, 0), a3, voffA);
            PG8_BAR; PG8_WAIT_L(0); PG8_MMA(1, 0, At, B0); PG8_BAR; PG8_SCHED;
            PG8_STAGE(PG8_SB(1, 1), b3 + hstepB, voffB);
            PG8_WAIT_V(6); PG8_BAR; PG8_MMA(1, 1, At, B1); PG8_BAR;
            }
        }
        if constexpr (ALIGN_EPI) { if (wr == 0) PG8_BAR; }
        if constexpr (!Epi::AFTER_DRAIN) { E(acc, cur, wr, wc, fr, fq); S.done(cur); }
        if (!has_next) break;
#pragma unroll
        for (int a = 0; a < 2; ++a)
#pragma unroll
            for (int b = 0; b < 2; ++b)
#pragma unroll
                for (int m = 0; m < 4; ++m)
#pragma unroll
                    for (int n = 0; n < 2; ++n) acc[a][b][m][n] = (f32x4){0.f, 0.f, 0.f, 0.f};
        cur = nxt; cA = nA; cB = nB; ++ui;
        if constexpr (ALIGN_EPI) { if (wr == 1) PG8_BAR; }
    }
    PG8_WAIT_V(0);
    if constexpr (!ALIGN_EPI) { if (wr == 0) PG8_BAR; }
    PG8_BAR;
    if constexpr (Epi::AFTER_DRAIN) { E.fused(acc, cur, wr, wc, fr, fq, lds, wid, lane); S.done(cur); }
#undef PG8_SA
#undef PG8_SB
#undef PG8_STAGE
#undef PG8_LDA
#undef PG8_LDB
#undef PG8_MMA
#undef PG8_WAIT_V
#undef PG8_WAIT_L
#undef PG8_BAR
#undef PG8_SCHED
}
}
#define XB_TMO      128
#define XB_XCNT(j)  (256  + 64 * (j))
#define XB_XSUB(j)  (1280 + 64 * (j))
#define XB_XGEN(j)  (2304 + 64 * (j))
#define XB_TOP      3328
#define XB_TOPGEN   3392
#define XCD_BAR_WORDS 3456
#define XB_SPIN_CAP (1u << 18)

__device__ __forceinline__ unsigned xb_ld(unsigned* p)              { return __hip_atomic_load(p, __ATOMIC_RELAXED, __HIP_MEMORY_SCOPE_AGENT); }
__device__ __forceinline__ unsigned xb_add(unsigned* p, unsigned v) { return __hip_atomic_fetch_add(p, v, __ATOMIC_RELAXED, __HIP_MEMORY_SCOPE_AGENT); }
__device__ __forceinline__ unsigned xb_xcc_id() { return (unsigned)__builtin_amdgcn_s_getreg((3 << 11) | 20) & 0xFu; }
#define XB_SPIN(cond, bar) do { unsigned _sp = 0; while (cond) { __builtin_amdgcn_s_sleep(1); \
    if ((++_sp & 255u) == 0u) { if (xb_ld(&(bar)[XB_TMO])) break; if (_sp > XB_SPIN_CAP) { atomicAdd(&(bar)[XB_TMO], 1u); break; } } } } while (0)

struct XcdBarrier {
    unsigned* bar; unsigned x;
    volatile LAS unsigned* st;
};

__device__ __forceinline__ XcdBarrier xcd_barrier_post(unsigned* bar, volatile LAS unsigned* st) {
    XcdBarrier b; b.bar = bar; b.x = xb_xcc_id(); b.st = st;
    if (threadIdx.x == 0) (void)xb_add(&bar[XB_XCNT(b.x)], 1u);
    return b;
}
__device__ __forceinline__ void xcd_barrier_complete(unsigned* bar, unsigned x, unsigned& nloc, unsigned& nx) {
    const unsigned G = gridDim.x * gridDim.y * gridDim.z;
    unsigned sum, cnt, mine, sp = 0u;
    for (;;) {
        sum = 0u; cnt = 0u; mine = 0u;
#pragma unroll
        for (unsigned j = 0; j < 16; ++j) { const unsigned c = xb_ld(&bar[XB_XCNT(j)]); sum += c; cnt += (c > 0u) ? 1u : 0u; mine = (j == x) ? c : mine; }
        if (sum == G) break;
        __builtin_amdgcn_s_sleep(1);
        if ((++sp & 255u) == 0u) { if (xb_ld(&bar[XB_TMO])) break; if (sp > XB_SPIN_CAP) { atomicAdd(&bar[XB_TMO], 1u); break; } }
    }
    nloc = mine > 0u ? mine : 1u; nx = cnt > 0u ? cnt : 1u;
}

__device__ __forceinline__ void xcd_barrier(const XcdBarrier& b) {
    asm volatile("s_waitcnt vmcnt(0)" ::: "memory");
    __syncthreads();
    if (threadIdx.x == 0) {
        unsigned* bar = b.bar;
        __builtin_amdgcn_s_waitcnt(0);
        unsigned nloc = b.st[0], nx = b.st[1];
        if (nloc == 0u) { xcd_barrier_complete(bar, b.x, nloc, nx); b.st[0] = nloc; b.st[1] = nx; }
        const unsigned old = xb_add(&bar[XB_XSUB(b.x)], 1u);
        const unsigned gen = old / nloc;
        if (old + 1u == (gen + 1u) * nloc) {
            __builtin_amdgcn_fence(__ATOMIC_RELEASE, "agent");
            asm volatile("s_waitcnt vmcnt(0)" ::: "memory");
            const unsigned og = xb_add(&bar[XB_TOP], 1u);
            const unsigned tg = og / nx;
            if (og + 1u == (tg + 1u) * nx) xb_add(&bar[XB_TOPGEN], 1u);
            else XB_SPIN(xb_ld(&bar[XB_TOPGEN]) == tg, bar);
            __builtin_amdgcn_fence(__ATOMIC_ACQUIRE, "agent");
            xb_add(&bar[XB_XGEN(b.x)], 1u);
            asm volatile("s_waitcnt vmcnt(0)" ::: "memory");
        } else {
            XB_SPIN(xb_ld(&bar[XB_XGEN(b.x)]) == gen, bar);
            __builtin_amdgcn_fence(__ATOMIC_ACQUIRE, "agent");
            asm volatile("s_waitcnt vmcnt(0)" ::: "memory");
        }
    }
    __syncthreads();
}
namespace att {
using bf16 = __hip_bfloat16;
constexpr int   D = 128, NW = 8, QBLK = 32, KVBLK = 64;
constexpr float SCALE = 0.088388347648318440f;
constexpr float THR = 8.f;
constexpr int SDEPTH = 1;
constexpr int LDQ = 1024, LDK = 512, LDO = 2048;
constexpr size_t SHM_V = KVBLK * D * 2, SHM_K = KVBLK * D * 2, SHM_ATTN = 2 * SHM_V + 2 * SHM_K + NW * 64 * 4;
using bf16x8 = __attribute__((ext_vector_type(8))) short;
using s16x4  = __attribute__((ext_vector_type(4))) short;
using f32x16 = __attribute__((ext_vector_type(16))) float;
using f32x8  = __attribute__((ext_vector_type(8))) float;
using u32x4  = __attribute__((ext_vector_type(4))) unsigned;
#define KSWZ(row, colB) ((row) * 256 + ((colB) ^ (((row) & 7) << 4)))
#define SBAR() __builtin_amdgcn_sched_barrier(0)
__device__ __forceinline__ int crow(int r, int hi) { return (r & 3) + 8 * (r >> 2) + 4 * hi; }
__device__ __forceinline__ unsigned cvtpk(float lo, float hi) {
  unsigned r; asm volatile("v_cvt_pk_bf16_f32 %0, %1, %2" : "=v"(r) : "v"(lo), "v"(hi)); return r;
}
template <typename TIn> struct Stage;
template <> struct Stage<bf16>  { using T = bf16x8;
  __device__ static __forceinline__ T ld8(const bf16* p) { return *reinterpret_cast<const bf16x8*>(p); }
  __device__ static __forceinline__ bf16x8 tobf(T x) { return x; } };
template <> struct Stage<float> { using T = f32x8;
  __device__ static __forceinline__ T ld8(const float* p) { return *reinterpret_cast<const f32x8*>(p); }
  __device__ static __forceinline__ bf16x8 tobf(T x) {
    u32x4 w = {cvtpk(x[0], x[1]), cvtpk(x[2], x[3]), cvtpk(x[4], x[5]), cvtpk(x[6], x[7])}; return *reinterpret_cast<bf16x8*>(&w); } };

__device__ __forceinline__ void partialSM(f32x16& p0, f32x16& p1, float& m_reg, float& mn, float& alpha) {
  constexpr float C = SCALE * 1.4426950408889634f;
  float pmax = p0[0]; for (int r = 1; r < 16; ++r) pmax = fmaxf(pmax, p0[r]); for (int r = 0; r < 16; ++r) pmax = fmaxf(pmax, p1[r]);
  { auto rr = __builtin_amdgcn_permlane32_swap(__float_as_uint(pmax), __float_as_uint(pmax), false, false);
    pmax = fmaxf(__uint_as_float(rr[0]), __uint_as_float(rr[1])); }
  if (__builtin_expect(__all(pmax - m_reg <= THR / SCALE), 1)) { mn = m_reg; alpha = 1.f; }
  else { mn = fmaxf(m_reg, pmax); alpha = __builtin_amdgcn_exp2f((m_reg - mn) * C); m_reg = mn; }
  float mnC = -mn * C;
  for (int r = 0; r < 16; ++r) p0[r] = fmaf(p0[r], C, mnC); for (int r = 0; r < 16; ++r) p1[r] = fmaf(p1[r], C, mnC);
  for (int r = 0; r < 16; ++r) p0[r] = __builtin_amdgcn_exp2f(p0[r]);
}
__device__ __forceinline__ void finishSM(f32x16& p0, f32x16& p1, float alpha, float& l_reg, bf16x8& pa0, bf16x8& pa1, bf16x8& pa2, bf16x8& pa3) {
  for (int r = 0; r < 16; ++r) p1[r] = __builtin_amdgcn_exp2f(p1[r]);
  float ps = 0; for (int r = 0; r < 16; ++r) ps += p0[r]; for (int r = 0; r < 16; ++r) ps += p1[r];
  { auto rr = __builtin_amdgcn_permlane32_swap(__float_as_uint(ps), __float_as_uint(ps), false, false);
    ps = __uint_as_float(rr[0]) + __uint_as_float(rr[1]); }
  l_reg = l_reg * alpha + ps;
#define PK4(P, BASE, OUT) do { unsigned a0 = cvtpk(P[BASE + 0], P[BASE + 1]), a1 = cvtpk(P[BASE + 2], P[BASE + 3]);   \
    unsigned b0 = cvtpk(P[BASE + 4], P[BASE + 5]), b1 = cvtpk(P[BASE + 6], P[BASE + 7]);                              \
    auto r0 = __builtin_amdgcn_permlane32_swap(a0, b0, false, false); auto r1 = __builtin_amdgcn_permlane32_swap(a1, b1, false, false); \
    u32x4 w = {r0[0], r1[0], r0[1], r1[1]}; OUT = *reinterpret_cast<bf16x8*>(&w); } while (0)
  PK4(p0, 0, pa0); PK4(p0, 8, pa1); PK4(p1, 0, pa2); PK4(p1, 8, pa3);
#undef PK4
}
__device__ __forceinline__ void qkt(f32x16& p0, f32x16& p1, const bf16* Ks, const bf16x8* qr, int r32, int hi) {
  p0 = f32x16{}; p1 = f32x16{};
  for (int d0 = 0; d0 < 8; ++d0) { int cb = (d0 * 16 + hi * 8) * 2;
    bf16x8 b0 = *reinterpret_cast<const bf16x8*>((const char*)Ks + KSWZ(r32, cb));
    bf16x8 b1 = *reinterpret_cast<const bf16x8*>((const char*)Ks + KSWZ(32 + r32, cb));
    p0 = __builtin_amdgcn_mfma_f32_32x32x16_bf16(b0, qr[d0], p0, 0, 0, 0);
    p1 = __builtin_amdgcn_mfma_f32_32x32x16_bf16(b1, qr[d0], p1, 0, 0, 0); }
}
__device__ __forceinline__ int v_st(int k, int c) { const int kk = (k & ~0xC) | ((k & 4) << 1) | ((k & 8) >> 1); return ((kk >> 3) * 4 + (c >> 5)) * 512 + ((kk & 7) * 32 + (c & 31)) * 2; }
__device__ __forceinline__ int v_rd_base(int lane) { return ((lane & 3) << 3) | (((lane >> 2) & 3) << 6) | (((lane >> 4) & 1) << 5) | (((lane >> 5) & 1) << 8); }
constexpr int v_rd_off(int d0, int ks, int half) { return d0 * 512 + ks * 4096 + half * 2048; }
template <int OFF> __device__ __forceinline__ s16x4 tr_read(int vb) {
  s16x4 r; asm volatile("ds_read_b64_tr_b16 %0, %1 offset:%2" : "=&v"(r) : "v"(vb), "i"(OFF) : "memory"); return r;
}
template <int D0> __device__ __forceinline__ void pv_one(f32x16& od, int vb, bf16x8 pa0, bf16x8 pa1, bf16x8 pa2, bf16x8 pa3) {
  const s16x4 l0 = tr_read<v_rd_off(D0, 0, 0)>(vb), h0 = tr_read<v_rd_off(D0, 0, 1)>(vb), l1 = tr_read<v_rd_off(D0, 1, 0)>(vb), h1 = tr_read<v_rd_off(D0, 1, 1)>(vb);
  const s16x4 l2 = tr_read<v_rd_off(D0, 2, 0)>(vb), h2 = tr_read<v_rd_off(D0, 2, 1)>(vb), l3 = tr_read<v_rd_off(D0, 3, 0)>(vb), h3 = tr_read<v_rd_off(D0, 3, 1)>(vb);
  asm volatile("s_waitcnt lgkmcnt(0)" ::: "memory"); SBAR();
#define PK(L, H) (bf16x8){L[0], L[1], L[2], L[3], H[0], H[1], H[2], H[3]}
  od = __builtin_amdgcn_mfma_f32_32x32x16_bf16(pa0, PK(l0, h0), od, 0, 0, 0);
  od = __builtin_amdgcn_mfma_f32_32x32x16_bf16(pa1, PK(l1, h1), od, 0, 0, 0);
  od = __builtin_amdgcn_mfma_f32_32x32x16_bf16(pa2, PK(l2, h2), od, 0, 0, 0);
  od = __builtin_amdgcn_mfma_f32_32x32x16_bf16(pa3, PK(l3, h3), od, 0, 0, 0);
#undef PK
}
__device__ __forceinline__ void pv_d0(f32x16* o, int vb, bf16x8 pa0, bf16x8 pa1, bf16x8 pa2, bf16x8 pa3) {
  pv_one<0>(o[0], vb, pa0, pa1, pa2, pa3); pv_one<1>(o[1], vb, pa0, pa1, pa2, pa3); pv_one<2>(o[2], vb, pa0, pa1, pa2, pa3); pv_one<3>(o[3], vb, pa0, pa1, pa2, pa3);
}

template <typename TQ>
__device__ __forceinline__ void attn_dense_body(const TQ* __restrict__ Qb, const bf16* __restrict__ Kh, const bf16* __restrict__ Vh,
                                                bf16* __restrict__ Ob, int seq, char* lds) {
  using St = Stage<bf16>; using SQ = Stage<TQ>;
  int tid_ = threadIdx.x; asm volatile("" : "+v"(tid_));
  const int tid = tid_, wid = tid >> 6, lane = tid & 63, r32 = lane & 31, hi = lane >> 5;
  bf16* V_lds = (bf16*)lds; bf16* K_lds = (bf16*)(lds + 2 * SHM_V);
  float* ws = (float*)(lds + 2 * SHM_V + 2 * SHM_K) + wid * 64; float* li_l = ws; float* al_l = ws + 32;
  float m_reg = -1e30f, l_reg = 0; f32x16 o[4] = {}; bf16x8 qr[8];
  const TQ* Qw = Qb + (long)(wid * QBLK + r32) * LDQ + hi * 8;
#pragma unroll
  for (int d0 = 0; d0 < 8; ++d0) qr[d0] = SQ::tobf(SQ::ld8(Qw + d0 * 16));
  const int sr = tid >> 4, sc = (tid & 15) * 8, vst0 = v_st(sr, sc), vst1 = v_st(32 + sr, sc);
  const int vb0 = (int)(uintptr_t)V_lds + v_rd_base(lane);
  struct { typename St::T vs0, vs1, ks0, ks1; } sr_[SDEPTH];
#define SLOAD(i, k0) do { sr_[i].vs0 = St::ld8(&Vh[(long)((k0) + sr) * LDK + sc]); sr_[i].vs1 = St::ld8(&Vh[(long)((k0) + 32 + sr) * LDK + sc]); \
    sr_[i].ks0 = St::ld8(&Kh[(long)((k0) + sr) * LDK + sc]); sr_[i].ks1 = St::ld8(&Kh[(long)((k0) + 32 + sr) * LDK + sc]); } while (0)
#define SWRITE(b, i) do { *(bf16x8*)((char*)V_lds + (b) * SHM_V + vst0) = St::tobf(sr_[i].vs0);          \
    *(bf16x8*)((char*)V_lds + (b) * SHM_V + vst1) = St::tobf(sr_[i].vs1); int kc = sc * 2;               \
    *(bf16x8*)((char*)K_lds + (b) * SHM_K + KSWZ(sr, kc)) = St::tobf(sr_[i].ks0);                       \
    *(bf16x8*)((char*)K_lds + (b) * SHM_K + KSWZ(32 + sr, kc)) = St::tobf(sr_[i].ks1); } while (0)
#define SWAIT() do { if constexpr (SDEPTH == 2) asm volatile("s_waitcnt vmcnt(4)" ::: "memory"); else asm volatile("s_waitcnt vmcnt(0)" ::: "memory"); } while (0)
#define RESC(a) do { if (__any((a) < 1.f)) { if (hi == 0) al_l[r32] = (a); asm volatile("s_waitcnt lgkmcnt(0)" ::: "memory"); \
    for (int d = 0; d < 4; ++d) for (int r = 0; r < 16; ++r) o[d][r] *= al_l[crow(r, hi)]; } } while (0)
  f32x16 pA0, pA1, pB0, pB1; float mnA, mnB, alA, alB; bf16x8 pa0, pa1, pa2, pa3; const int NT = seq / KVBLK;
  constexpr int SE = 0, SO = SDEPTH - 1;
  SLOAD(SE, 0); asm volatile("s_waitcnt vmcnt(0)" ::: "memory"); SWRITE(0, SE); __syncthreads();
  qkt(pA0, pA1, K_lds, qr, r32, hi); partialSM(pA0, pA1, m_reg, mnA, alA);
  SLOAD(SO, KVBLK); if constexpr (SDEPTH == 2) { if (2 < NT) SLOAD(SE, 2 * KVBLK); }
  SWAIT(); SWRITE(1, SO); __syncthreads();
  for (int j = 1; j + 1 < NT; j += 2) {
    SBAR(); qkt(pB0, pB1, (bf16*)((char*)K_lds + SHM_K), qr, r32, hi);
    finishSM(pA0, pA1, alA, l_reg, pa0, pa1, pa2, pa3); SBAR();
    SLOAD(SO, (j + SDEPTH) * KVBLK); SBAR();
    pv_d0(o, vb0, pa0, pa1, pa2, pa3); partialSM(pB0, pB1, m_reg, mnB, alB);
    __syncthreads(); SWAIT(); SWRITE(0, SE);
    RESC(alB); __syncthreads();
    SBAR(); qkt(pA0, pA1, K_lds, qr, r32, hi);
    finishSM(pB0, pB1, alB, l_reg, pa0, pa1, pa2, pa3); SBAR();
    if (SDEPTH == 1 || j + 3 < NT) SLOAD(SE, (j + 1 + SDEPTH) * KVBLK); SBAR();
    pv_d0(o, vb0 + (int)SHM_V, pa0, pa1, pa2, pa3); partialSM(pA0, pA1, m_reg, mnA, alA);
    __syncthreads(); SWAIT(); SWRITE(1, SO);
    RESC(alA); __syncthreads();
  }
  SBAR(); qkt(pB0, pB1, (bf16*)((char*)K_lds + SHM_K), qr, r32, hi);
  finishSM(pA0, pA1, alA, l_reg, pa0, pa1, pa2, pa3); SBAR();
  pv_d0(o, vb0, pa0, pa1, pa2, pa3); partialSM(pB0, pB1, m_reg, mnB, alB);
  __syncthreads(); RESC(alB);
  finishSM(pB0, pB1, alB, l_reg, pa0, pa1, pa2, pa3); SBAR();
  pv_d0(o, vb0 + (int)SHM_V, pa0, pa1, pa2, pa3);
  if (hi == 0) li_l[r32] = l_reg; asm volatile("s_waitcnt lgkmcnt(0)" ::: "memory");
  float rli[16];
#pragma unroll
  for (int r = 0; r < 16; ++r) rli[r] = __builtin_amdgcn_rcpf(li_l[crow(r, hi)]);
  bf16* Ow = Ob + (long)(wid * QBLK) * LDO;
#pragma unroll
  for (int r = 0; r < 16; ++r) { int orow = crow(r, hi);
    for (int d0 = 0; d0 < 4; ++d0) Ow[(long)orow * LDO + d0 * 32 + r32] = __float2bfloat16(o[d0][r] * rli[r]); }
  __syncthreads();
#undef SLOAD
#undef SWRITE
#undef SWAIT
#undef RESC
}
#undef KSWZ
#undef SBAR
}

struct Frame {
    LAS unsigned char* lds;
    char* ldsg;
    int tid, lane, wave, vcu, G;
    unsigned char* ws;
};
__device__ __forceinline__ const float* frame_in(const Frame& F, int i) {
    const LAS unsigned* p = (const LAS unsigned*)(F.lds + LDSCTL_OFF + 64) + 2 * i;
    const unsigned lo = __builtin_amdgcn_readfirstlane(p[0]), hi = __builtin_amdgcn_readfirstlane(p[1]);
    return (const float*)(const GAS float*)(((unsigned long long)hi << 32) | lo);
}
#define FIN(i) frame_in(F, (i))
#define FOUT() ((float*)frame_in(F, 17))
#define WSP(T, off) ((T*)(F.ws + (off)))

__device__ __forceinline__ void p0_transpose_item(const float* W, int K, int N, int Npad, bf16_t* WT, int row_off, LAS float* scr, int item, int lane) {
    const int nblk = Npad / 32, kb = item / nblk, nb = item % nblk, k0 = 64 * kb, n0 = 32 * nb;
    const int nn = n0 + (lane & 31);
#pragma unroll 8
    for (int i = 0; i < 32; ++i) { const int kk = 2 * i + (lane >> 5); scr[kk * 33 + (lane & 31)] = nn < N ? W[(size_t)(k0 + kk) * N + nn] : 0.f; }
    LDS_WAIT(); asm volatile("" ::: "memory");
    const int c = lane & 7;
#pragma unroll
    for (int j = 0; j < 4; ++j) { const int n = (lane >> 3) + 8 * j; const LAS float* s = scr + (8 * c) * 33 + n;
        u32x4 o; o.x = pk2(s[0 * 33], s[1 * 33]); o.y = pk2(s[2 * 33], s[3 * 33]); o.z = pk2(s[4 * 33], s[5 * 33]); o.w = pk2(s[6 * 33], s[7 * 33]);
        *(GAS u32x4*)(WT + (size_t)(row_off + n0 + n) * K + k0 + 8 * c) = o; }
    LDS_WAIT(); asm volatile("" ::: "memory");
}
__device__ __forceinline__ u32x4 cvt8(const float* p) {
    const f32x4 a = *(const f32x4*)p, b = *(const f32x4*)(p + 4);
    u32x4 o; o.x = pk2(a.x, a.y); o.y = pk2(a.z, a.w); o.z = pk2(b.x, b.y); o.w = pk2(b.z, b.w); return o;
}
__device__ __forceinline__ void rms_row_to_bf16(const float* xrow, const float* g, bf16_t* orow, int lane) {
    const f32x4* xr = (const f32x4*)xrow + lane;
    f32x4 v[8]; float s = 0.f;
#pragma unroll
    for (int j = 0; j < 8; ++j) { v[j] = xr[64 * j]; s += (v[j].x * v[j].x + v[j].y * v[j].y) + (v[j].z * v[j].z + v[j].w * v[j].w); }
    const float r = 1.0f / sqrtf(wave_sum(s) * (1.f / DM) + EPS);
    u32x2* o8 = (u32x2*)orow + lane;
#pragma unroll
    for (int j = 0; j < 8; ++j) { const f32x4 gg = ((const f32x4*)g)[lane + 64 * j]; u32x2 w; w.x = pk2(v[j].x * r * gg.x, v[j].y * r * gg.y); w.y = pk2(v[j].z * r * gg.z, v[j].w * r * gg.w); o8[64 * j] = w; }
}
__device__ __forceinline__ void ph_prologue(const Frame& F) {
    LAS float* scr = (LAS float*)(F.lds + F.wave * 16384);
    const int gw = F.vcu * NWAVES + F.wave, NGW = F.G * NWAVES;
    for (int row = gw; row < 4 * 16384; row += NGW) {
        const int tb = row >> 15, rr = row & 32767;
        const float* src = FIN(14 + tb) + (size_t)rr * DM + F.lane * 16;
        f32x4 v[8]; float am = 0.f;
#pragma unroll
        for (int q = 0; q < 8; ++q) { v[q] = *(const f32x4*)(src + (q >> 2) * 1024 + (q & 3) * 4);
            am = fmaxf(am, fmaxf(fmaxf(fabsf(v[q].x), fabsf(v[q].y)), fmaxf(fabsf(v[q].z), fabsf(v[q].w)))); }
#pragma unroll
        for (int o = 1; o < 64; o <<= 1) am = fmaxf(am, __shfl_xor(am, o));
        const float sc = am > 0.f ? am * (1.f / 448.f) : 1.f, isc = 1.0f / sc;
        unsigned w[8];
#pragma unroll
        for (int q = 0; q < 8; ++q) { unsigned p = __builtin_amdgcn_cvt_pk_fp8_f32(v[q].x * isc, v[q].y * isc, 0u, false); w[q] = __builtin_amdgcn_cvt_pk_fp8_f32(v[q].z * isc, v[q].w * isc, p, true); }
        unsigned char* dst = F.ws + (tb ? WS_VB : WS_UB) + (size_t)(rr >> 14) * (16384 * 2048) + ((size_t)(F.lane >> 3) * 16384 + (rr & 16383)) * 128 + (F.lane & 7) * 16;
        *(u32x4*)dst = (u32x4){w[0], w[1], w[2], w[3]}; *(u32x4*)(dst + (size_t)8 * 16384 * 128) = (u32x4){w[4], w[5], w[6], w[7]};
        if (F.lane == 0) ((float*)(F.ws + WS_TSC))[row] = sc;
    }
    {   constexpr int I_IN = (DM / 64) * (INP / 32), I_SQ = (DM / 64) * (DM / 32), I_PL = 4 * (512 / 64) * (512 / 32);
        constexpr int NIT = I_IN + 3 * I_SQ + I_PL;
        for (int it = gw; it < NIT; it += NGW) {
            int r = it;
            if (r < I_IN) { p0_transpose_item(FIN(3), DM, INW, INP, WSP(bf16_t, WS_WIN), 0, scr, r, F.lane); continue; } r -= I_IN;
            if (r < I_SQ) { p0_transpose_item(FIN(9), DM, DM, DM, WSP(bf16_t, WS_WOUT), 0, scr, r, F.lane); continue; } r -= I_SQ;
            if (r < I_SQ) { p0_transpose_item(FIN(12), DM, DM, DM, WSP(bf16_t, WS_WQ0), 0, scr, r, F.lane); continue; } r -= I_SQ;
            if (r < I_SQ) { p0_transpose_item(FIN(12) + (size_t)DM * DM, DM, DM, DM, WSP(bf16_t, WS_WQ1), 0, scr, r, F.lane); continue; } r -= I_SQ;
            const int grp = r / 128, ri = r % 128;
            p0_transpose_item(FIN(10) + (size_t)grp * 512 * 512, 512, 512, 512, WSP(bf16_t, WS_WPOOL), grp * 512, scr, ri, F.lane);
        }
    }
    for (int it = gw; it < 1024; it += NGW) *(u32x4*)(WSP(bf16_t, WS_KEYS) + (size_t)it * 512 + F.lane * 8) = cvt8(FIN(13) + (size_t)it * 512 + F.lane * 8);
    for (int m = gw; m < S; m += NGW) rms_row_to_bf16(FIN(0) + (size_t)m * DM, FIN(1), WSP(bf16_t, WS_XN) + (size_t)m * DM, F.lane);
}

__device__ __forceinline__ float silu_f(float z) { return z / (1.f + __expf(-z)); }
__device__ __forceinline__ void p2_qkv_token(const Frame& F, int t) {
    const int lane = F.lane, i8 = lane & 7;
    const bf16_t* pr = WSP(bf16_t, WS_PROJ) + (size_t)t * INP;
    const int axis = i8 >> 2, half = (i8 >> 1) & 1, f0 = (i8 & 1) * 16;
    const float pos = (float)(axis == 0 ? (t >> 6) : (t & 63));
    float cs[16], sn[16];
#pragma unroll
    for (int e = 0; e < 16; ++e) { const float inv = exp2f(-(float)(f0 + e) * (13.287712379549449f / 32.f));
        float rev = pos * inv * 0.15915494309189535f; rev -= rintf(rev);
        cs[e] = __builtin_amdgcn_cosf(rev); sn[e] = __builtin_amdgcn_sinf(rev); }
    const float sgn = half ? 1.f : -1.f;
    {   const u32x4 w0 = *(const u32x4*)(pr + C_AQ + lane * 16), w1 = *(const u32x4*)(pr + C_AQ + lane * 16 + 8);
        float v[16]; const unsigned ww[8] = {w0.x, w0.y, w0.z, w0.w, w1.x, w1.y, w1.z, w1.w};
#pragma unroll
        for (int e = 0; e < 8; ++e) { v[2 * e] = bflo(ww[e]); v[2 * e + 1] = bfhi(ww[e]); }
        float ss = 0.f;
#pragma unroll
        for (int e = 0; e < 16; ++e) ss += v[e] * v[e];
        ss += __shfl_xor(ss, 1); ss += __shfl_xor(ss, 2); ss += __shfl_xor(ss, 4);
        const float r = 1.0f / sqrtf(ss * (1.f / 128.f) + EPS);
        const float* gq = FIN(6) + i8 * 16;
        unsigned ow[8];
        float y[16];
#pragma unroll
        for (int e = 0; e < 16; ++e) y[e] = v[e] * r * gq[e];
#pragma unroll
        for (int e = 0; e < 16; ++e) { const float yp = __shfl_xor(y[e], 2); y[e] = y[e] * cs[e] + sgn * yp * sn[e]; }
#pragma unroll
        for (int e = 0; e < 8; ++e) ow[e] = pk2(y[2 * e], y[2 * e + 1]);
        bf16_t* dst = WSP(bf16_t, WS_QB) + (size_t)t * 1024 + lane * 16;
        *(u32x4*)dst = (u32x4){ow[0], ow[1], ow[2], ow[3]}; *(u32x4*)(dst + 8) = (u32x4){ow[4], ow[5], ow[6], ow[7]};
    }
    {   const int l16 = lane & 15;
        const u32x4 w0 = *(const u32x4*)(pr + C_AK + l16 * 16), w1 = *(const u32x4*)(pr + C_AK + l16 * 16 + 8);
        float v[16]; const unsigned ww[8] = {w0.x, w0.y, w0.z, w0.w, w1.x, w1.y, w1.z, w1.w};
#pragma unroll
        for (int e = 0; e < 8; ++e) { v[2 * e] = bflo(ww[e]); v[2 * e + 1] = bfhi(ww[e]); }
        float ss = 0.f;
#pragma unroll
        for (int e = 0; e < 16; ++e) ss += v[e] * v[e];
        ss += __shfl_xor(ss, 1); ss += __shfl_xor(ss, 2); ss += __shfl_xor(ss, 4);
        const float r = 1.0f / sqrtf(ss * (1.f / 128.f) + EPS);
        const float* gk = FIN(7) + i8 * 16;
        float y[16]; unsigned ow[8];
#pragma unroll
        for (int e = 0; e < 16; ++e) y[e] = v[e] * r * gk[e];
#pragma unroll
        for (int e = 0; e < 16; ++e) { const float yp = __shfl_xor(y[e], 2); y[e] = y[e] * cs[e] + sgn * yp * sn[e]; }
#pragma unroll
        for (int e = 0; e < 8; ++e) ow[e] = pk2(y[2 * e], y[2 * e + 1]);
        bf16_t* kv = WSP(bf16_t, WS_KVB) + (size_t)t * 512;
        if (lane < 16) { *(u32x4*)(kv + lane * 16) = (u32x4){ow[0], ow[1], ow[2], ow[3]}; *(u32x4*)(kv + lane * 16 + 8) = (u32x4){ow[4], ow[5], ow[6], ow[7]}; }
        else if (lane < 32) { const u32x4 a = *(const u32x4*)(pr + C_AV + l16 * 16), b = *(const u32x4*)(pr + C_AV + l16 * 16 + 8);
            *(u32x4*)(kv + 256 + l16 * 16) = a; *(u32x4*)(kv + 256 + l16 * 16 + 8) = b; }
    }
}
__device__ __forceinline__ void p2_conv_item(const Frame& F, int item) {
    const int tb = item >> 2, sl = item & 3, lane = F.lane, c = sl * 512 + lane * 8, t0 = tb * 16;
    float w[5][8];
#pragma unroll
    for (int j = 0; j < 5; ++j) { const f32x4 a = *(const f32x4*)(FIN(5) + j * 2048 + c), b = *(const f32x4*)(FIN(5) + j * 2048 + c + 4);
        w[j][0] = a.x; w[j][1] = a.y; w[j][2] = a.z; w[j][3] = a.w; w[j][4] = b.x; w[j][5] = b.y; w[j][6] = b.z; w[j][7] = b.w; }
    const bf16_t* src = WSP(bf16_t, WS_PROJ) + C_MQK + c;
    const float osc = (c >= 1024) ? 0.0625f : 1.f;
    bf16_t* dst = (c >= 1024) ? WSP(bf16_t, WS_MK) + (c - 1024) : WSP(bf16_t, WS_MQ) + c;
    u32x4 rows[5];
#pragma unroll
    for (int j = 0; j < 4; ++j) { const int tt = t0 - 2 + j; rows[j + 1] = (tt >= 0 && tt < S) ? *(const u32x4*)(src + (size_t)tt * INP) : (u32x4){0u, 0u, 0u, 0u}; }
#pragma unroll 1
    for (int q = 0; q < 16; ++q) {
        const int tn = t0 + q + 2;
        rows[0] = rows[1]; rows[1] = rows[2]; rows[2] = rows[3]; rows[3] = rows[4];
        rows[4] = (tn < S) ? *(const u32x4*)(src + (size_t)tn * INP) : (u32x4){0u, 0u, 0u, 0u};
        float acc[8];
#pragma unroll
        for (int e = 0; e < 8; ++e) acc[e] = 0.f;
#pragma unroll
        for (int j = 0; j < 5; ++j) { const unsigned ww[4] = {rows[j].x, rows[j].y, rows[j].z, rows[j].w};
#pragma unroll
            for (int e = 0; e < 4; ++e) { acc[2 * e] += bflo(ww[e]) * w[j][2 * e]; acc[2 * e + 1] += bfhi(ww[e]) * w[j][2 * e + 1]; } }
        u32x4 o; o.x = pk2(silu_f(acc[0]) * osc, silu_f(acc[1]) * osc); o.y = pk2(silu_f(acc[2]) * osc, silu_f(acc[3]) * osc);
        o.z = pk2(silu_f(acc[4]) * osc, silu_f(acc[5]) * osc); o.w = pk2(silu_f(acc[6]) * osc, silu_f(acc[7]) * osc);
        *(u32x4*)(dst + (size_t)(t0 + q) * 1024) = o;
    }
}
__device__ __forceinline__ float wave_incl_scan_add(float v, int lane) {
#pragma unroll
    for (int o = 1; o < 64; o <<= 1) { const float u = __shfl_up(v, o); if (lane >= o) v += u; }
    return v;
}
__device__ __forceinline__ float wave_incl_scan_max(float v, int lane) {
#pragma unroll
    for (int o = 1; o < 64; o <<= 1) { const float u = __shfl_up(v, o); if (lane >= o) v = fmaxf(v, u); }
    return v;
}
__device__ __forceinline__ float logsigmoid_f(float x) { return fminf(x, 0.f) - log1pf(__expf(-fabsf(x))); }
__device__ __forceinline__ void p2_gate_item(const Frame& F, int item) {
    const int dh = item >> 7, c = item & 127, dir = dh >> 2, h = dh & 3, lane = F.lane;
    const int p0 = 128 * c + 2 * lane, t0 = dir ? (S - 1 - p0) : p0, t1 = dir ? (t0 - 1) : (t0 + 1);
    const bf16_t* pg = WSP(bf16_t, WS_PROJ) + C_GATE + dir * 8 + h;
    const float bi = FIN(4)[dir * 8 + h], bf = FIN(4)[dir * 8 + 4 + h];
    const float i0 = bflo((unsigned)pg[(size_t)t0 * INP]) + bi, f0 = bflo((unsigned)pg[(size_t)t0 * INP + 4]) + bf;
    const float i1 = bflo((unsigned)pg[(size_t)t1 * INP]) + bi, f1 = bflo((unsigned)pg[(size_t)t1 * INP + 4]) + bf;
    const float lf0 = logsigmoid_f(f0), lf1 = logsigmoid_f(f1);
    const float incl = wave_incl_scan_add(lf0 + lf1, lane);
    const float b1 = incl, b0 = incl - lf1;
    const float u0 = i0 - b0, u1 = i1 - b1;
    const float mincl = wave_incl_scan_max(fmaxf(u0, u1), lane);
    float mprevl = __shfl_up(mincl, 1); if (lane == 0) mprevl = -INFINITY;
    const float pm0 = fmaxf(mprevl, u0), pm1 = mincl;
    float* GB = (float*)(F.ws + WS_GATES + GO_B) + (size_t)dh * S; float* GU = (float*)(F.ws + WS_GATES + GO_U) + (size_t)dh * S; float* GPM = (float*)(F.ws + WS_GATES + GO_PM) + (size_t)dh * S;
    GB[t0] = b0; GB[t1] = b1; GU[t0] = u0; GU[t1] = u1; GPM[t0] = pm0; GPM[t1] = pm1;
    if (lane == 63) { ((float*)(F.ws + WS_GATES + GO_G))[dh * 128 + c] = b1; ((float*)(F.ws + WS_GATES + GO_PML))[dh * 128 + c] = pm1; }
}
__device__ __forceinline__ void ph_post(const Frame& F) {
    const int gw = F.vcu * NWAVES + F.wave, NGW = F.G * NWAVES;
    for (int it = gw; it < 1024; it += NGW) p2_gate_item(F, it);
    for (int it = gw; it < 4096; it += NGW) p2_conv_item(F, it);
    for (int t = gw; t < S; t += NGW) p2_qkv_token(F, t);
}

#define MFMA16(a, b, c) __builtin_amdgcn_mfma_f32_16x16x32_bf16((a), (b), (c), 0, 0, 0)
__device__ __forceinline__ bf16x8 frag_tr(LAS const unsigned char* base, int pitch, int k0, int x0, int lane) {
    const int g = lane >> 4, i = lane & 15;
    LAS const unsigned char* p = base + (k0 + 8 * g + (i >> 2)) * pitch + (x0 + 4 * (i & 3)) * 2;
    const s16x4 lo = __builtin_bit_cast(s16x4, __builtin_amdgcn_ds_read_tr16_b64_v4i16((LAS v4i16_t*)p));
    const s16x4 hi = __builtin_bit_cast(s16x4, __builtin_amdgcn_ds_read_tr16_b64_v4i16((LAS v4i16_t*)(p + 4 * pitch)));
    return (bf16x8){lo[0], lo[1], lo[2], lo[3], hi[0], hi[1], hi[2], hi[3]};
}
__device__ __forceinline__ bf16x8 frag_kc(LAS const unsigned char* base, int pitch, int x0, int k0, int lane) {
    return *(LAS const bf16x8*)(base + (x0 + (lane & 15)) * pitch + (k0 + 8 * (lane >> 4)) * 2);
}

constexpr int MLA_PK = 544, MLA_PV = 288;
constexpr int MLA_OFF_V = 128 * MLA_PK;
__device__ __forceinline__ void ph_mla(const Frame& F) {
    const int tid = F.tid, lane = F.lane, wave = F.wave;
    LAS unsigned char* Kw = F.lds; LAS unsigned char* Vs = F.lds + MLA_OFF_V;
    const float* GU = (const float*)(F.ws + WS_GATES + GO_U); const float* GPML = (const float*)(F.ws + WS_GATES + GO_PML);
    for (int item = F.vcu; item < 2048; item += F.G) {
        const int hv = item & 1, c = (item >> 1) & 127, dh = item >> 8, dir = dh >> 2, head = dh & 3;
        const int tc = dir ? 127 - c : c, t0 = tc * 128;
        const float pml = GPML[dh * 128 + c];
        {   const bf16_t* mk = WSP(bf16_t, WS_MK) + (size_t)t0 * 1024 + head * 256;
#pragma unroll
            for (int j = 0; j < 8; ++j) { const int r = (tid >> 5) + 16 * j, c8 = (tid & 31) * 8;
                const u32x4 x = *(const u32x4*)(mk + (size_t)r * 1024 + c8); const float w = __expf(GU[(size_t)dh * S + t0 + r] - pml);
                u32x4 o; o.x = pk2(bflo(x.x) * w, bfhi(x.x) * w); o.y = pk2(bflo(x.y) * w, bfhi(x.y) * w); o.z = pk2(bflo(x.z) * w, bfhi(x.z) * w); o.w = pk2(bflo(x.w) * w, bfhi(x.w) * w);
                *(LAS u32x4*)(Kw + r * MLA_PK + c8 * 2) = o; }
            const bf16_t* mv = WSP(bf16_t, WS_PROJ) + (size_t)t0 * INP + C_MV + head * 256 + hv * 128;
#pragma unroll
            for (int j = 0; j < 4; ++j) { const int r = (tid >> 4) + 32 * j, c8 = (tid & 15) * 8;
                *(LAS u32x4*)(Vs + r * MLA_PV + c8 * 2) = *(const u32x4*)(mv + (size_t)r * INP + c8); }
        }
        __syncthreads();
        f32x4 acc[4][4];
#pragma unroll
        for (int a = 0; a < 4; ++a)
#pragma unroll
            for (int b = 0; b < 4; ++b) acc[a][b] = (f32x4){0.f, 0.f, 0.f, 0.f};
        const int mb = (wave & 3) * 64, nb = (wave >> 2) * 64;
#pragma unroll
        for (int ks = 0; ks < 4; ++ks) {
            bf16x8 af[4], bfr[4];
#pragma unroll
            for (int a = 0; a < 4; ++a) af[a] = frag_tr(Kw, MLA_PK, 32 * ks, mb + 16 * a, lane);
#pragma unroll
            for (int b = 0; b < 4; ++b) bfr[b] = frag_tr(Vs, MLA_PV, 32 * ks, nb + 16 * b, lane);
#pragma unroll
            for (int a = 0; a < 4; ++a)
#pragma unroll
                for (int b = 0; b < 4; ++b) acc[a][b] = MFMA16(af[a], bfr[b], acc[a][b]);
        }
        {   bf16_t* cst = WSP(bf16_t, WS_CST) + ((size_t)(dh * 128 + c) << 16);
            const int g = lane >> 4, i = lane & 15;
#pragma unroll
            for (int a = 0; a < 4; ++a)
#pragma unroll
                for (int b = 0; b < 4; ++b) { u32x2 o; o.x = pk2(acc[a][b][0], acc[a][b][1]); o.y = pk2(acc[a][b][2], acc[a][b][3]);
                    *(u32x2*)(cst + (size_t)(hv * 128 + nb + 16 * b + i) * 256 + mb + 16 * a + 4 * g) = o; }
        }
        if (hv == 0 && tid < 256) { float s = 0.f;
#pragma unroll 8
            for (int r = 0; r < 128; ++r) s += bflo((unsigned)*(LAS const bf16_t*)(Kw + r * MLA_PK + tid * 2));
            ((float*)(F.ws + WS_NST))[(size_t)(dh * 128 + c) * 256 + tid] = s; }
        __syncthreads();
    }
}

__device__ __forceinline__ void ph_scan(const Frame& F) {
    const float* GG = (const float*)(F.ws + WS_GATES + GO_G); const float* GPML = (const float*)(F.ws + WS_GATES + GO_PML); float* MPREV = (float*)(F.ws + WS_GATES + GO_MPREV);
    const int nthreads = F.G * NTHR;
    for (int gi = F.vcu * NTHR + F.tid; gi < 8 * 16384; gi += nthreads) {
        const int dh = gi >> 14, e4 = gi & 16383;
        bf16_t* base = WSP(bf16_t, WS_CST) + ((size_t)dh * 128 << 16) + e4 * 4;
        float st0 = 0.f, st1 = 0.f, st2 = 0.f, st3 = 0.f, m = 0.f;
#pragma unroll 1
        for (int c0 = 0; c0 < 128; c0 += 8) {
            u32x2 ld[8];
#pragma unroll
            for (int q = 0; q < 8; ++q) ld[q] = *(const u32x2*)(base + ((size_t)(c0 + q) << 16));
#pragma unroll
            for (int q = 0; q < 8; ++q) { const int c = c0 + q;
                const float g = GG[dh * 128 + c], amax = g + GPML[dh * 128 + c];
                const float mn = fmaxf(g + m, amax), dec = __expf(g + m - mn), add = __expf(amax - mn);
                if (e4 == 0) MPREV[dh * 128 + c] = m;
                u32x2 o; o.x = pk2(st0, st1); o.y = pk2(st2, st3);
                *(u32x2*)(base + ((size_t)c << 16)) = o;
                st0 = dec * st0 + add * bflo(ld[q].x); st1 = dec * st1 + add * bfhi(ld[q].x); st2 = dec * st2 + add * bflo(ld[q].y); st3 = dec * st3 + add * bfhi(ld[q].y);
                m = mn; }
        }
    }
    for (int gi = F.vcu * NTHR + F.tid; gi < 8 * 256; gi += nthreads) {
        const int dh = gi >> 8, e = gi & 255;
        float* base = (float*)(F.ws + WS_NST) + (size_t)dh * 128 * 256 + e;
        float st = 0.f, m = 0.f;
#pragma unroll 4
        for (int c = 0; c < 128; ++c) {
            const float g = GG[dh * 128 + c], amax = g + GPML[dh * 128 + c];
            const float mn = fmaxf(g + m, amax), dec = __expf(g + m - mn), add = __expf(amax - mn);
            const float ld = base[c * 256]; base[c * 256] = st; st = dec * st + add * ld; m = mn; }
    }
}

constexpr int MLB_PIECE = 34816;
constexpr int MLB_PKC = 528, MLB_PTR = 544, MLB_PP = 272;
constexpr int MLB_OFF_P = 2 * MLB_PIECE;
constexpr int MLB_OFF_N = MLB_OFF_P + 2 * 8 * 16 * MLB_PP;
static_assert(MLB_OFF_N + 2048 <= LDSCTL_OFF, "mLSTM-B LDS map");
__device__ __forceinline__ void ph_mlb(const Frame& F) {
    const int wave = F.wave;
    const float* GB = (const float*)(F.ws + WS_GATES + GO_B); const float* GU = (const float*)(F.ws + WS_GATES + GO_U); const float* GPM = (const float*)(F.ws + WS_GATES + GO_PM);
    const float* MPREV = (const float*)(F.ws + WS_GATES + GO_MPREV);
    LAS unsigned char* buf0 = F.lds; LAS unsigned char* buf1 = F.lds + MLB_PIECE;
    LAS float* nprev = (LAS float*)(F.lds + MLB_OFF_N);
    for (int unit = F.vcu; unit < 512; unit += F.G) {
        int tid = F.tid; asm volatile("" : "+v"(tid));
        const int lane = tid & 63, g = lane >> 4, i = lane & 15;
        const int head = unit >> 7, tc = unit & 127, t0 = tc * 128, j0 = 16 * wave;
        const bf16_t* mkp = WSP(bf16_t, WS_MK) + (size_t)t0 * 1024 + head * 256;
        const bf16_t* mvp = WSP(bf16_t, WS_PROJ) + (size_t)t0 * INP + C_MV + head * 256;
        const int c_f = tc, c_b = 127 - tc;
        u32x4 stg[4];
        const int sr = tid >> 5, sc8 = (tid & 31) * 8;
#define PIECE_LOAD(srcp, pitch_el) do { _Pragma("unroll") for (int q_ = 0; q_ < 4; ++q_) stg[q_] = *(const u32x4*)((srcp) + (size_t)(sr + 16 * q_) * (pitch_el) + sc8); } while (0)
#define PIECE_WRITE(dstbuf, pitchB) do { _Pragma("unroll") for (int q_ = 0; q_ < 4; ++q_) *(LAS u32x4*)((dstbuf) + (sr + 16 * q_) * (pitchB) + sc8 * 2) = stg[q_]; } while (0)
        { const int d = tid >> 8, e = tid & 255; nprev[d * 256 + e] = ((const float*)(F.ws + WS_NST))[(size_t)((d * 4 + head) * 128 + (d ? c_b : c_f)) * 256 + e]; }
        bf16x8 qa[8];
        {   const bf16_t* mq = WSP(bf16_t, WS_MQ) + (size_t)(t0 + j0 + i) * 1024 + head * 256 + 8 * g;
#pragma unroll
            for (int s = 0; s < 8; ++s) qa[s] = *(const bf16x8*)(mq + 32 * s); }
        f32x4 sacc[8];
#pragma unroll
        for (int n = 0; n < 8; ++n) sacc[n] = (f32x4){0.f, 0.f, 0.f, 0.f};
        PIECE_LOAD(mkp, 1024); PIECE_WRITE(buf0, MLB_PKC);
        PIECE_LOAD(mkp + (size_t)64 * 1024, 1024);
        __syncthreads();
#pragma unroll
        for (int n = 0; n < 4; ++n)
            { _Pragma("unroll") for (int s = 0; s < 8; ++s) sacc[n] = MFMA16(qa[s], frag_kc(buf0, MLB_PKC, 16 * n, 32 * s, lane), sacc[n]); __builtin_amdgcn_sched_barrier(0); }
        PIECE_WRITE(buf1, MLB_PKC);
        __syncthreads();
#pragma unroll
        for (int n = 0; n < 4; ++n)
            { _Pragma("unroll") for (int s = 0; s < 8; ++s) sacc[4 + n] = MFMA16(qa[s], frag_kc(buf1, MLB_PKC, 16 * n, 32 * s, lane), sacc[4 + n]); __builtin_amdgcn_sched_barrier(0); }
        const bf16_t* cst0 = WSP(bf16_t, WS_CST) + ((size_t)((0 * 4 + head) * 128 + c_f) << 16);
        const bf16_t* cst1 = WSP(bf16_t, WS_CST) + ((size_t)((1 * 4 + head) * 128 + c_b) << 16);
        PIECE_LOAD(cst0, 256);
        float qsc0, qsc1;
#pragma unroll
        for (int d = 0; d < 2; ++d) {
            const int dh = d * 4 + head; const float mp = MPREV[dh * 128 + (d ? c_b : c_f)];
            f32x4 dacc = (f32x4){0.f, 0.f, 0.f, 0.f};
#pragma unroll
            for (int s = 0; s < 8; ++s) { bf16x8 bn; const LAS float* np = nprev + d * 256 + 32 * s + 8 * g;
#pragma unroll
                for (int e = 0; e < 8; ++e) bn[e] = (i == 0) ? (short)f2bf(np[e]) : (short)0;
                dacc = MFMA16(qa[s], bn, dacc); }
            float ur[8];
#pragma unroll
            for (int n = 0; n < 8; ++n) ur[n] = GU[(size_t)dh * S + t0 + 16 * n + i];
            LAS unsigned char* pw = F.lds + MLB_OFF_P + (d * 8 + wave) * (16 * MLB_PP);
            float es[4];
#pragma unroll
            for (int rg = 0; rg < 4; ++rg) { const int jl = 4 * g + rg, j = j0 + jl;
                const float M = fmaxf(mp, GPM[(size_t)dh * S + t0 + j]), ej = __expf(mp - M), mj = GB[(size_t)dh * S + t0 + j] + M;
                float rs = 0.f;
#pragma unroll
                for (int n = 0; n < 8; ++n) { const int r = 16 * n + i; const bool keep = d ? (r >= j) : (r <= j); rs += keep ? sacc[n][rg] * __expf(ur[n] - M) : 0.f; }
                rs += __shfl_xor(rs, 1); rs += __shfl_xor(rs, 2); rs += __shfl_xor(rs, 4); rs += __shfl_xor(rs, 8);
                const float qn = __shfl(dacc[rg], lane & 48);
                const float den = ej * qn + rs, sj = 1.0f / fmaxf(fabsf(den), __expf(-mj));
                es[rg] = ej * sj;
#pragma unroll
                for (int n = 0; n < 8; ++n) { const int r = 16 * n + i; const bool keep = d ? (r >= j) : (r <= j);
                    const float p = keep ? sacc[n][rg] * __expf(ur[n] - M) * sj : 0.f;
                    *(LAS bf16_t*)(pw + jl * MLB_PP + r * 2) = (bf16_t)f2bf(p); } }
            const int srcl = (i >> 2) << 4;
            const float t0_ = __shfl(es[0], srcl), t1_ = __shfl(es[1], srcl), t2_ = __shfl(es[2], srcl), t3_ = __shfl(es[3], srcl);
            const float qs_ = (i & 3) == 0 ? t0_ : (i & 3) == 1 ? t1_ : (i & 3) == 2 ? t2_ : t3_;
            if (d == 0) qsc0 = qs_; else qsc1 = qs_;
        }
        __syncthreads();
        f32x4 hacc[16];
#pragma unroll
        for (int n = 0; n < 16; ++n) hacc[n] = (f32x4){0.f, 0.f, 0.f, 0.f};
#pragma unroll
        for (int d = 0; d < 2; ++d) {
            const bf16_t* cst = d ? cst1 : cst0; const float qsc = d ? qsc1 : qsc0;
            bf16x8 qs[8];
#pragma unroll
            for (int s = 0; s < 8; ++s) { const u32x4 w = __builtin_bit_cast(u32x4, qa[s]); u32x4 o;
                o.x = pk2(bflo(w.x) * qsc, bfhi(w.x) * qsc); o.y = pk2(bflo(w.y) * qsc, bfhi(w.y) * qsc); o.z = pk2(bflo(w.z) * qsc, bfhi(w.z) * qsc); o.w = pk2(bflo(w.w) * qsc, bfhi(w.w) * qsc);
                qs[s] = __builtin_bit_cast(bf16x8, o); }
#pragma unroll
            for (int cp = 0; cp < 4; ++cp) {
                LAS unsigned char* cur = (cp & 1) ? buf1 : buf0;
                PIECE_WRITE(cur, MLB_PKC);
                if (cp < 3) PIECE_LOAD(cst + (size_t)(64 * (cp + 1)) * 256, 256); else PIECE_LOAD(mvp, INP);
                __syncthreads();
#pragma unroll
                for (int n = 0; n < 4; ++n)
                    { _Pragma("unroll") for (int s = 0; s < 8; ++s) hacc[4 * cp + n] = MFMA16(qs[s], frag_kc(cur, MLB_PKC, 16 * n, 32 * s, lane), hacc[4 * cp + n]); __builtin_amdgcn_sched_barrier(0); }
            }
            LAS const unsigned char* pw = F.lds + MLB_OFF_P + (d * 8 + wave) * (16 * MLB_PP);
#pragma unroll
            for (int vp = 0; vp < 2; ++vp) {
                LAS unsigned char* cur = (vp & 1) ? buf1 : buf0;
                PIECE_WRITE(cur, MLB_PTR);
                if (vp == 0) PIECE_LOAD(mvp + (size_t)64 * INP, INP); else if (d == 0) PIECE_LOAD(cst1, 256);
                __syncthreads();
#pragma unroll
                for (int ks = 0; ks < 2; ++ks) { const bf16x8 a = *(LAS const bf16x8*)(pw + i * MLB_PP + (64 * vp + 32 * ks + 8 * g) * 2);
#pragma unroll
                    for (int n = 0; n < 16; ++n) { hacc[n] = MFMA16(a, frag_tr(cur, MLB_PTR, 32 * ks, 16 * n, lane), hacc[n]); if ((n & 3) == 3) __builtin_amdgcn_sched_barrier(0); } }
            }
            __syncthreads();
        }
        {   const float* mg = FIN(8) + head * 256;
            const bf16_t* mo = WSP(bf16_t, WS_PROJ) + C_MO + head * 256; bf16_t* y = WSP(bf16_t, WS_Y) + 1024 + head * 256;
#pragma unroll
            for (int rg = 0; rg < 4; ++rg) { float ss = 0.f;
#pragma unroll
                for (int n = 0; n < 16; ++n) ss += hacc[n][rg] * hacc[n][rg];
                ss += __shfl_xor(ss, 1); ss += __shfl_xor(ss, 2); ss += __shfl_xor(ss, 4); ss += __shfl_xor(ss, 8);
                const float r = 1.0f / sqrtf(ss * (1.f / 256.f) + EPS); const size_t t = (size_t)(t0 + j0 + 4 * g + rg);
#pragma unroll
                for (int n = 0; n < 16; ++n) { const int col = 16 * n + i; const float o = bflo((unsigned)mo[t * INP + col]);
                    #if defined(DBG_ZERO_ML)
                    y[t * DM + col] = 0;
#else
                    y[t * DM + col] = (bf16_t)f2bf(hacc[n][rg] * r * mg[col] * (1.f / (1.f + __expf(-o))));
#endif
                    } }
        }
#undef PIECE_LOAD
#undef PIECE_WRITE
    }
}

#define MFMA32(a, b, c) __builtin_amdgcn_mfma_f32_32x32x16_bf16((a), (b), (c), 0, 0, 0)
__device__ __forceinline__ int fkey(float x) { const int b = __builtin_bit_cast(int, x); return b ^ ((b >> 31) & 0x7fffffff); }
__device__ __forceinline__ float kval(int k) { return __builtin_bit_cast(float, k ^ ((k >> 31) & 0x7fffffff)); }
#define TOP_INS(top, x) do { int x_ = (x); _Pragma("unroll") for (int k_ = 0; k_ < 16; ++k_) { const int hi_ = max(top[k_], x_); x_ = min(top[k_], x_); top[k_] = hi_; } } while (0)
__device__ __forceinline__ int pick4(int sel, int a, int b, int c, int d) { return sel == 0 ? a : sel == 1 ? b : sel == 2 ? c : d; }
__device__ __forceinline__ void topk_item(const Frame& F, int layer, int item) {
    const int tile = item >> 3, h = item & 7, lane = F.lane, r32 = lane & 31, hi = lane >> 5;
    const int t = tile * 32 + r32;
    const bf16_t* qrow = WSP(bf16_t, WS_QP) + (size_t)t * DM + h * 256 + 8 * hi;
    int tops[2][16];
#pragma unroll
    for (int p = 0; p < 2; ++p) {
        const bf16_t* keys = WSP(bf16_t, WS_KEYS) + (size_t)(((layer * 8 + h) * 2 + p) * 128) * 128 + 8 * hi;
        bf16x8 bq[8];
#pragma unroll
        for (int s = 0; s < 8; ++s) bq[s] = *(const bf16x8*)(qrow + p * 128 + 16 * s);
        int top[16];
#pragma unroll
        for (int k = 0; k < 16; ++k) top[k] = (int)0x80000000;
#pragma unroll
        for (int kt = 0; kt < 4; ++kt) {
            f32x16 acc = {};
#pragma unroll
            for (int s = 0; s < 8; ++s) { const bf16x8 a = *(const bf16x8*)(keys + (size_t)(32 * kt + r32) * 128 + 16 * s); acc = MFMA32(a, bq[s], acc); }
#pragma unroll
            for (int r = 0; r < 16; ++r) { const int idx = 32 * kt + (r & 3) + 8 * (r >> 2) + 4 * hi; TOP_INS(top, (fkey(acc[r]) & ~127) | idx); }
        }
        int pt[16];
#pragma unroll
        for (int k = 0; k < 16; ++k) pt[k] = __shfl_xor(top[k], 32);
#pragma unroll
        for (int k = 0; k < 16; ++k) TOP_INS(top, pt[k]);
#pragma unroll
        for (int k = 0; k < 16; ++k) tops[p][k] = top[k];
    }
    float af[16], bfv[16];
#pragma unroll
    for (int k = 0; k < 16; ++k) { af[k] = kval(tops[0][k] & ~127); bfv[k] = kval(tops[1][k] & ~127); }
    int top2[16];
#pragma unroll
    for (int k = 0; k < 16; ++k) top2[k] = (int)0x80000000;
#pragma unroll
    for (int i = 0; i < 16; ++i)
#pragma unroll
        for (int j = 0; j < 16; ++j) if ((i + 1) * (j + 1) <= 16) TOP_INS(top2, (fkey(af[i] + bfv[j]) & ~255) | (i << 4) | j);
    int pa[4], pb[4];
#pragma unroll
    for (int q = 0; q < 4; ++q) { pa[q] = (tops[0][4 * q] & 127) | ((tops[0][4 * q + 1] & 127) << 8) | ((tops[0][4 * q + 2] & 127) << 16) | ((tops[0][4 * q + 3] & 127) << 24);
                                  pb[q] = (tops[1][4 * q] & 127) | ((tops[1][4 * q + 1] & 127) << 8) | ((tops[1][4 * q + 2] & 127) << 16) | ((tops[1][4 * q + 3] & 127) << 24); }
    int ex[16]; float sc[16];
#pragma unroll
    for (int k = 0; k < 16; ++k) { const int code = top2[k] & 255, ii = code >> 4, jj = code & 15;
        const int ea = (pick4(ii >> 2, pa[0], pa[1], pa[2], pa[3]) >> ((ii & 3) * 8)) & 127, eb = (pick4(jj >> 2, pb[0], pb[1], pb[2], pb[3]) >> ((jj & 3) * 8)) & 127;
        ex[k] = ea * 128 + eb; sc[k] = kval(top2[k] & ~255); }
    const float mx = sc[0]; float sum = 0.f;
#pragma unroll
    for (int k = 0; k < 16; ++k) { sc[k] = __expf(sc[k] - mx); sum += sc[k]; }
    const float inv = 1.0f / sum;
    if (hi == 0) { int* d = WSP(int, WS_EIDX) + (size_t)t * 128 + h * 16;
#pragma unroll
        for (int q = 0; q < 4; ++q) *(u32x4*)(d + 4 * q) = (u32x4){(unsigned)ex[4 * q], (unsigned)ex[4 * q + 1], (unsigned)ex[4 * q + 2], (unsigned)ex[4 * q + 3]}; }
    else { float* d = WSP(float, WS_EGATE) + (size_t)t * 128 + h * 16;
#pragma unroll
        for (int q = 0; q < 4; ++q) *(f32x4*)(d + 4 * q) = (f32x4){sc[4 * q] * inv, sc[4 * q + 1] * inv, sc[4 * q + 2] * inv, sc[4 * q + 3] * inv}; }
}
__device__ __forceinline__ void ph_topk(const Frame& F, int layer) {
    const int gw = F.vcu * NWAVES + F.wave, NGW = F.G * NWAVES;
    for (int it = gw; it < 4096; it += NGW) topk_item(F, layer, it);
}

typedef __bf16 bf2 __attribute__((ext_vector_type(2)));
__device__ __forceinline__ float dot2bf(bf2 a, unsigned b, float c) { return __builtin_amdgcn_fdot2_f32_bf16(a, __builtin_bit_cast(bf2, b), c, false); }
__device__ __forceinline__ float dot4_fp8(unsigned w, unsigned xlo, unsigned xhi, float c) {
    c = dot2bf(__builtin_amdgcn_cvt_scalef32_pk_bf16_fp8(w, 1.0f, false), xlo, c);
    return dot2bf(__builtin_amdgcn_cvt_scalef32_pk_bf16_fp8(w, 1.0f, true), xhi, c);
}
constexpr int NSL = 16;
constexpr size_t WS_PART = WS_CST;
constexpr size_t WS_W = WS_KVB;
__device__ __forceinline__ void ph_gu(const Frame& F, int layer) {
    const int lane = F.lane, r8 = lane >> 3, c16 = lane & 7;
    const int nper = F.G >> 3, xl = F.vcu / nper, wx = (F.vcu % nper) * NWAVES + F.wave, nwx = nper * NWAVES;
    const unsigned char* U = F.ws + WS_UB + (size_t)layer * 16384 * 2048 + c16 * 16;
    const int* eidx = WSP(int, WS_EIDX) + 16 * r8;
#pragma unroll 1
    for (int p = 0; p < 2; ++p) {
        const int s = xl + 8 * p;
        const unsigned char* Us = U + (size_t)s * (16384 * 128);
        float* part = WSP(float, WS_PART) + (size_t)s * S * 128 + 2 * lane;
        const bf16_t* xs = WSP(bf16_t, WS_XN) + s * 128 + c16 * 16;
        u32x4 ia[2][4];
#pragma unroll
        for (int q = 0; q < 4; ++q) { ia[0][q] = *(const u32x4*)(eidx + (size_t)wx * 128 + 4 * q); ia[1][q] = *(const u32x4*)(eidx + (size_t)(wx + nwx) * 128 + 4 * q); }
#pragma unroll 1
        for (int t = wx; t < S; t += 2 * nwx) {
            const int t1 = t + nwx;
            u32x4 ur[2][16];
#pragma unroll
            for (int z = 0; z < 2; ++z)
#pragma unroll
                for (int q = 0; q < 16; ++q) { const unsigned id = ia[z][q >> 2][q & 3]; ur[z][q] = *(const u32x4*)(Us + (size_t)id * 128); }
            { const int tn = (t + 2 * nwx < S) ? t + 2 * nwx : t;
#pragma unroll
              for (int q = 0; q < 4; ++q) { ia[0][q] = *(const u32x4*)(eidx + (size_t)tn * 128 + 4 * q); ia[1][q] = *(const u32x4*)(eidx + (size_t)(tn + nwx) * 128 + 4 * q); } }
#pragma unroll
            for (int z = 0; z < 2; ++z) {
                const bf16_t* xr = xs + (size_t)(z ? t1 : t) * DM; const u32x4 x0 = *(const u32x4*)xr, x1 = *(const u32x4*)(xr + 8);
                float v[16];
#pragma unroll
                for (int q = 0; q < 16; ++q) { const u32x4 w = ur[z][q]; float a = dot4_fp8(w.x, x0.x, x0.y, 0.f); a = dot4_fp8(w.y, x0.z, x0.w, a); a = dot4_fp8(w.z, x1.x, x1.y, a); v[q] = dot4_fp8(w.w, x1.z, x1.w, a); }
                float r8v[8], r4v[4], r2v[2];
                { const bool up = lane & 4;
#pragma unroll
                  for (int q = 0; q < 8; ++q) { const float keep = up ? v[q + 8] : v[q], give = up ? v[q] : v[q + 8]; r8v[q] = keep + __shfl_xor(give, 4); } }
                { const bool up = lane & 2;
#pragma unroll
                  for (int q = 0; q < 4; ++q) { const float keep = up ? r8v[q + 4] : r8v[q], give = up ? r8v[q] : r8v[q + 4]; r4v[q] = keep + __shfl_xor(give, 2); } }
                { const bool up = lane & 1;
#pragma unroll
                  for (int q = 0; q < 2; ++q) { const float keep = up ? r4v[q + 2] : r4v[q], give = up ? r4v[q] : r4v[q + 2]; r2v[q] = keep + __shfl_xor(give, 1); } }
                *(f32x2*)(part + (size_t)(z ? t1 : t) * 128) = (f32x2){r2v[0], r2v[1]};
            }
        }
    }
}
__device__ __forceinline__ void ph_act(const Frame& F, int layer) {
    const int lane = F.lane, gw = F.vcu * NWAVES + F.wave, NGW = F.G * NWAVES;
    const float* su = (const float*)(F.ws + WS_TSC) + layer * 16384; const float* sv = su + 32768;
    for (int t = gw; t < S; t += NGW) {
        const float* part = WSP(float, WS_PART) + (size_t)t * 128 + 2 * lane;
        f32x2 a = {0.f, 0.f};
#pragma unroll
        for (int s = 0; s < NSL; ++s) a += *(const f32x2*)(part + (size_t)s * S * 128);
        const u32x2 id = *(const u32x2*)(WSP(int, WS_EIDX) + (size_t)t * 128 + 2 * lane); const f32x2 g = *(const f32x2*)(WSP(float, WS_EGATE) + (size_t)t * 128 + 2 * lane);
        const float a0 = a.x * su[id.x], a1 = a.y * su[id.y];
        const float w0 = 0.5f * a0 * (1.f + erff(a0 * 0.70710678118654752f)) * g.x * sv[id.x], w1 = 0.5f * a1 * (1.f + erff(a1 * 0.70710678118654752f)) * g.y * sv[id.y];
        *(f32x2*)(WSP(float, WS_W) + (size_t)t * 128 + 2 * lane) = (f32x2){w0, w1};
    }
}
__device__ __forceinline__ void ph_gv(const Frame& F, int layer) {
    const int lane = F.lane, r8 = lane >> 3, c16 = lane & 7;
    const int nper = F.G >> 3, xl = F.vcu / nper, wx = (F.vcu % nper) * NWAVES + F.wave, nwx = nper * NWAVES;
    const unsigned char* V = F.ws + WS_VB + (size_t)layer * 16384 * 2048 + c16 * 16;
    const int* eidx = WSP(int, WS_EIDX) + 16 * r8; const float* wv = WSP(float, WS_W) + 16 * r8;
#pragma unroll 1
    for (int p = 0; p < 2; ++p) {
        const int s = xl + 8 * p;
        const unsigned char* Vs = V + (size_t)s * (16384 * 128);
        float* hs = WSP(float, WS_H) + s * 128 + 16 * c16 + 2 * r8;
        u32x4 ia[2][4];
#pragma unroll
        for (int q = 0; q < 4; ++q) { ia[0][q] = *(const u32x4*)(eidx + (size_t)wx * 128 + 4 * q); ia[1][q] = *(const u32x4*)(eidx + (size_t)(wx + nwx) * 128 + 4 * q); }
#pragma unroll 1
        for (int t = wx; t < S; t += 2 * nwx) {
            const int t1 = t + nwx;
            u32x4 vr[2][16];
#pragma unroll
            for (int z = 0; z < 2; ++z)
#pragma unroll
                for (int q = 0; q < 16; ++q) { const unsigned id = ia[z][q >> 2][q & 3]; vr[z][q] = *(const u32x4*)(Vs + (size_t)id * 128); }
            { const int tn = (t + 2 * nwx < S) ? t + 2 * nwx : t;
#pragma unroll
              for (int q = 0; q < 4; ++q) { ia[0][q] = *(const u32x4*)(eidx + (size_t)tn * 128 + 4 * q); ia[1][q] = *(const u32x4*)(eidx + (size_t)(tn + nwx) * 128 + 4 * q); } }
            f32x4 wqa[2][4]; f32x2 hold[2];
#pragma unroll
            for (int z = 0; z < 2; ++z) { const size_t tt = (size_t)(z ? t1 : t);
#pragma unroll
                for (int q = 0; q < 4; ++q) wqa[z][q] = *(const f32x4*)(wv + tt * 128 + 4 * q);
                hold[z] = *(const f32x2*)(hs + tt * DM); }
#pragma unroll
            for (int z = 0; z < 2; ++z) {
                const size_t tt = (size_t)(z ? t1 : t);
                f32x4 wq[4];
#pragma unroll
                for (int q = 0; q < 4; ++q) wq[q] = wqa[z][q];
                f32x2 acc[8];
#pragma unroll
                for (int e = 0; e < 8; ++e) acc[e] = (f32x2){0.f, 0.f};
#pragma unroll
                for (int q = 0; q < 16; ++q) { const float w = wq[q >> 2][q & 3]; const f32x2 ww = {w, w}; const unsigned d4[4] = {vr[z][q].x, vr[z][q].y, vr[z][q].z, vr[z][q].w};
#pragma unroll
                    for (int e = 0; e < 4; ++e) { acc[2 * e] += ww * __builtin_amdgcn_cvt_pk_f32_fp8(d4[e], false); acc[2 * e + 1] += ww * __builtin_amdgcn_cvt_pk_f32_fp8(d4[e], true); } }
                f32x2 b4[4], b2[2], b1;
                { const bool up = lane & 32;
#pragma unroll
                  for (int e = 0; e < 4; ++e) { const f32x2 keep = up ? acc[e + 4] : acc[e], give = up ? acc[e] : acc[e + 4]; b4[e] = keep + (f32x2){__shfl_xor(give.x, 32), __shfl_xor(give.y, 32)}; } }
                { const bool up = lane & 16;
#pragma unroll
                  for (int e = 0; e < 2; ++e) { const f32x2 keep = up ? b4[e + 2] : b4[e], give = up ? b4[e] : b4[e + 2]; b2[e] = keep + (f32x2){__shfl_xor(give.x, 16), __shfl_xor(give.y, 16)}; } }
                { const bool up = lane & 8; const f32x2 keep = up ? b2[1] : b2[0], give = up ? b2[0] : b2[1]; b1 = keep + (f32x2){__shfl_xor(give.x, 8), __shfl_xor(give.y, 8)}; }
#if defined(DBG_ZERO_PEER)
                b1 = (f32x2){0.f, 0.f};
#endif
                *(f32x2*)(hs + tt * DM) = hold[z] + b1;
            }
        }
    }
}
__device__ __forceinline__ void ph_normg(const Frame& F, bool final_layer) {
    const int gw = F.vcu * NWAVES + F.wave, NGW = F.G * NWAVES, lane = F.lane;
    if (!final_layer) { for (int m = gw; m < S; m += NGW) rms_row_to_bf16(WSP(float, WS_H) + (size_t)m * DM, FIN(1) + DM, WSP(bf16_t, WS_XN) + (size_t)m * DM, lane); return; }
    const float* g = FIN(16); float* out = FOUT();
    for (int m = gw; m < S; m += NGW) {
        const f32x4* xr = (const f32x4*)(WSP(float, WS_H) + (size_t)m * DM) + lane;
        f32x4 v[8]; float s = 0.f;
#pragma unroll
        for (int j = 0; j < 8; ++j) { v[j] = xr[64 * j]; s += (v[j].x * v[j].x + v[j].y * v[j].y) + (v[j].z * v[j].z + v[j].w * v[j].w); }
        const float r = 1.0f / sqrtf(wave_sum(s) * (1.f / DM) + EPS);
        f32x4* o = (f32x4*)(out + (size_t)m * DM) + lane;
#pragma unroll
        for (int j = 0; j < 8; ++j) { const f32x4 gg = ((const f32x4*)g)[lane + 64 * j]; o[64 * j] = v[j] * r * gg; }
    }
}

__device__ __forceinline__ void ph_poolprep(const Frame& F) {
    const int lane = F.lane, gw = F.vcu * NWAVES + F.wave, NGW = F.G * NWAVES;
    const bf16_t* xn = WSP(bf16_t, WS_XN);
    for (int t = gw; t < S; t += NGW) {
#pragma unroll
        for (int j = 0; j < 4; ++j) {
            const int half = 1 << j, lo = max(t - half, 0), hi = min(t + half, S), c0 = (lane + 64 * j) * 8;
            float a[8];
#pragma unroll
            for (int q = 0; q < 8; ++q) a[q] = 0.f;
            for (int r = lo; r < hi; ++r) { const u32x4 x = *(const u32x4*)(xn + (size_t)r * DM + c0);
                a[0] += bflo(x.x); a[1] += bfhi(x.x); a[2] += bflo(x.y); a[3] += bfhi(x.y); a[4] += bflo(x.z); a[5] += bfhi(x.z); a[6] += bflo(x.w); a[7] += bfhi(x.w); }
            const u32x4 x = *(const u32x4*)(xn + (size_t)t * DM + c0); const float ic = 1.0f / (float)(hi - lo);
            u32x4 o; o.x = pk2(a[0] * ic - bflo(x.x), a[1] * ic - bfhi(x.x)); o.y = pk2(a[2] * ic - bflo(x.y), a[3] * ic - bfhi(x.y));
            o.z = pk2(a[4] * ic - bflo(x.z), a[5] * ic - bfhi(x.z)); o.w = pk2(a[6] * ic - bflo(x.w), a[7] * ic - bfhi(x.w));
            *(u32x4*)(WSP(bf16_t, WS_POOLED) + (size_t)t * DM + c0) = o;
        }
    }
}
__device__ __forceinline__ void ph_norm(const Frame& F, int layer) {
    const int gw = F.vcu * NWAVES + F.wave, NGW = F.G * NWAVES;
    for (int m = gw; m < S; m += NGW) rms_row_to_bf16(WSP(float, WS_H) + (size_t)m * DM, FIN(2) + layer * DM, WSP(bf16_t, WS_XN) + (size_t)m * DM, F.lane);
}

__device__ __forceinline__ void ph_attn(const Frame& F) {
    const int nunits = 8 * 64;
    for (int u = F.vcu * 2; u < nunits; u += F.G * 2)
#pragma unroll 1
        for (int k = 0; k < 2; ++k) { const int unit = u + k, head = unit >> 6, qb = unit & 63, kvh = head >> 2;
            att::attn_dense_body<att::bf16>(WSP(att::bf16, WS_QB) + (size_t)(qb * 256) * 1024 + head * 128, WSP(att::bf16, WS_KVB) + kvh * 128, WSP(att::bf16, WS_KVB) + 256 + kvh * 128,
                                 WSP(att::bf16, WS_Y) + (size_t)(qb * 256) * DM + head * 128, S, F.ldsg); }
}

#ifndef PHASE_MASK
#define PHASE_MASK 0xffffff
#endif
#define PH_ON(k) (((PHASE_MASK) >> (k)) & 1)
struct Args { const float* in[17]; float* out; unsigned char* ws; int ph_lo, ph_hi; };
static_assert(sizeof(Args) == 17 * 8 + 8 + 8 + 8, "Args has no padding");
__global__ void __launch_bounds__(NTHR, 2) fwd_kernel(Args args) {
    extern __shared__ __attribute__((aligned(16))) unsigned char lds[];
    Frame F;
    F.lds = (LAS unsigned char*)lds; F.ldsg = (char*)lds;
    F.tid = threadIdx.x; F.lane = F.tid & 63; F.wave = __builtin_amdgcn_readfirstlane(F.tid >> 6);
    F.G = gridDim.x; { const int bx = blockIdx.x; F.vcu = (F.G % 8 == 0) ? (bx % 8) * (F.G / 8) + bx / 8 : bx; }
    F.ws = args.ws;
    volatile LAS unsigned* MISC = (volatile LAS unsigned*)(F.lds + LDSCTL_OFF);
    if (F.tid < 16) ((LAS unsigned*)(F.lds + LDSCTL_OFF))[F.tid] = 0u;
    if (F.tid >= 64 && F.tid < 64 + 36) ((LAS unsigned*)(F.lds + LDSCTL_OFF + 64))[F.tid - 64] = ((const unsigned*)&args)[F.tid - 64];
    __syncthreads();
    const int lo = args.ph_lo, hi = args.ph_hi;
    XcdBarrier bar; bar.bar = (unsigned*)(F.ws + WS_CTL) + CW_BAR; bar.x = 0; bar.st = nullptr;
    if (hi - lo > 1) bar = xcd_barrier_post((unsigned*)(F.ws + WS_CTL) + CW_BAR, MISC + 8);
#pragma unroll 1
    for (int ph = lo; ph < hi; ++ph) {
        if (ph > lo) xcd_barrier(bar);
#if defined(PROBE_PH)
        unsigned long long tprobe0 = 0; if (ph == PROBE_PH) tprobe0 = __builtin_amdgcn_s_memrealtime();
        if (ph == PROBE_PH + 1 || (PROBE_PH == NPH - 1 && false)) { }
#endif
        switch (ph) {
#define PHM(n) do { asm volatile("; PHASE_MARK " #n ::: "memory"); int t_ = threadIdx.x; asm volatile("" : "+v"(t_)); F.tid = t_; F.lane = t_ & 63; F.wave = __builtin_amdgcn_readfirstlane(t_ >> 6); \
    unsigned long long z_ = 0; asm volatile("" : "+s"(z_)); F.ws = args.ws + z_; } while (0)
        case PH_PRO: if constexpr (PH_ON(PH_PRO)) { PHM(PH_PRO); ph_prologue(F); } break;
        case PH_GEMM_IN: if constexpr (PH_ON(PH_GEMM_IN)) { PHM(PH_GEMM_IN);  pg8::Gemm g{WSP(bf16_t, WS_XN), WSP(bf16_t, WS_WIN), S, INP, DM, DM, DM, 0, 0}; pg8::StaticOrder So; So.init(S, INP, F.G, (int)blockIdx.x);
            pg8::EpiBf16<0> E{WSP(bf16_t, WS_PROJ), INP, nullptr, 0, 0, 1.f};
            pg8::gemm_phase<pg8::EpiBf16<0>, pg8::StaticOrder, true, true>(F.lds, g, So, E); } break;
        case PH_POST: if constexpr (PH_ON(PH_POST)) { PHM(PH_POST); ph_post(F); } break;
        case PH_ATTN: if constexpr (PH_ON(PH_ATTN)) { PHM(PH_ATTN); ph_attn(F); } break;
        case PH_MLA: if constexpr (PH_ON(PH_MLA)) { PHM(PH_MLA); ph_mla(F); } break;
        case PH_SCAN: if constexpr (PH_ON(PH_SCAN)) { PHM(PH_SCAN); ph_scan(F); } break;
        case PH_MLB: if constexpr (PH_ON(PH_MLB)) { PHM(PH_MLB); ph_mlb(F); } break;
        case PH_GEMM_OUT: if constexpr (PH_ON(PH_GEMM_OUT)) { PHM(PH_GEMM_OUT);  pg8::Gemm g{WSP(bf16_t, WS_Y), WSP(bf16_t, WS_WOUT), S, DM, DM, DM, DM, 0, 0}; pg8::StaticOrder So; So.init(S, DM, F.G, (int)blockIdx.x);
            pg8::EpiResF32 E{FIN(0), WSP(float, WS_H), DM, nullptr};
            pg8::gemm_phase<pg8::EpiResF32, pg8::StaticOrder, true, true>(F.lds, g, So, E); } break;
        case PH_NORM0: if constexpr (PH_ON(PH_NORM0)) { PHM(PH_NORM0); ph_norm(F, 0); } break;
        case PH_NORM1: if constexpr (PH_ON(PH_NORM1)) { PHM(PH_NORM1); ph_norm(F, 1); } break;
        case PH_GEMM_Q0: case PH_GEMM_Q1: if constexpr (PH_ON(PH_GEMM_Q0)) { PHM(PH_GEMM_Q0);  pg8::Gemm g{WSP(bf16_t, WS_XN), WSP(bf16_t, ph == PH_GEMM_Q0 ? WS_WQ0 : WS_WQ1), S, DM, DM, DM, DM, 0, 0}; pg8::StaticOrder So; So.init(S, DM, F.G, (int)blockIdx.x);
            pg8::EpiBf16<0> E{WSP(bf16_t, WS_QP), DM, nullptr, 0, 0, 1.f};
            pg8::gemm_phase<pg8::EpiBf16<0>, pg8::StaticOrder, true, true>(F.lds, g, So, E); } break;
        case PH_TOPK0: if constexpr (PH_ON(PH_TOPK0)) { PHM(PH_TOPK0); ph_topk(F, 0); } break;
        case PH_TOPK1: if constexpr (PH_ON(PH_TOPK1)) { PHM(PH_TOPK1); ph_topk(F, 1); } break;
        case PH_GU0: if constexpr (PH_ON(PH_GU0)) { PHM(PH_GU0); ph_gu(F, 0); } break;
        case PH_GU1: if constexpr (PH_ON(PH_GU1)) { PHM(PH_GU1); ph_gu(F, 1); } break;
        case PH_ACT0: if constexpr (PH_ON(PH_ACT0)) { PHM(PH_ACT0); ph_act(F, 0); } break;
        case PH_ACT1: if constexpr (PH_ON(PH_ACT1)) { PHM(PH_ACT1); ph_act(F, 1); } break;
        case PH_GV0: if constexpr (PH_ON(PH_GV0)) { PHM(PH_GV0); ph_gv(F, 0); } break;
        case PH_GV1: if constexpr (PH_ON(PH_GV1)) { PHM(PH_GV1); ph_gv(F, 1); } break;
        case PH_NORMP: if constexpr (PH_ON(PH_NORMP)) { PHM(PH_NORMP); ph_normg(F, false); } break;
        case PH_NORMF: if constexpr (PH_ON(PH_NORMF)) { PHM(PH_NORMF); ph_normg(F, true); } break;
        case PH_POOLPREP: if constexpr (PH_ON(PH_POOLPREP)) { PHM(PH_POOLPREP); ph_poolprep(F); } break;
        case PH_GEMM_POOL: if constexpr (PH_ON(PH_GEMM_POOL)) { PHM(PH_GEMM_POOL);  pg8::Gemm g{WSP(bf16_t, WS_POOLED), WSP(bf16_t, WS_WPOOL), S, DM, 512, DM, 512, 1, 512 * 2}; pg8::StaticOrder So; So.init(S, DM, F.G, (int)blockIdx.x);
            pg8::EpiResF32 E{WSP(float, WS_H), WSP(float, WS_H), DM, FIN(11)};
            pg8::gemm_phase<pg8::EpiResF32, pg8::StaticOrder, true, true>(F.lds, g, So, E); } break;
        default: break;
        }
#if defined(PROBE_PH)
        if (ph == PROBE_PH) { __syncthreads(); const unsigned long long t1 = __builtin_amdgcn_s_memrealtime(), dt = t1 - tprobe0;
            while (__builtin_amdgcn_s_memrealtime() - t1 < 4ull * dt) __builtin_amdgcn_s_sleep(8); }
#endif
    }
}

#ifndef N_LAUNCH_MODE
#define N_LAUNCH_MODE 1
#endif
extern "C" void kernel_launch(void* const* d_in, const int* in_sizes, int n_in, void* d_out, int out_size, void* d_ws, size_t ws_size, hipStream_t stream) {
    static int grid = 0;
    if (grid == 0) {
        if (n_in != 17 || in_sizes[0] != S * DM || out_size != S * DM || ws_size < WS_END) { fprintf(stderr, "kernel_launch: unexpected shapes (n_in %d, in0 %d, out %d, ws %zu; need ws >= %zu)\n", n_in, n_in > 0 ? in_sizes[0] : -1, out_size, ws_size, (size_t)WS_END); grid = -1; return; }
        int dev = 0, cus = 0;
        if (hipGetDevice(&dev) != hipSuccess || hipDeviceGetAttribute(&cus, hipDeviceAttributeMultiprocessorCount, dev) != hipSuccess) { grid = -1; return; }
        if (hipFuncSetAttribute((const void*)fwd_kernel, hipFuncAttributeMaxDynamicSharedMemorySize, LDS_BYTES) != hipSuccess) { fprintf(stderr, "kernel_launch: hipFuncSetAttribute failed\n"); grid = -1; return; }
        int per_cu = 0;
        if (hipOccupancyMaxActiveBlocksPerMultiprocessor(&per_cu, (const void*)fwd_kernel, NTHR, LDS_BYTES) != hipSuccess || per_cu < 1) fprintf(stderr, "kernel_launch: occupancy query reports %d\n", per_cu);
        (void)hipGetLastError();
        grid = cus;
        if (grid != 256) { fprintf(stderr, "kernel_launch: built for a 256-CU device (got %d CUs)\n", grid); grid = -1; return; }
    }
    if (grid < 0) return;
    (void)hipMemsetAsync((char*)d_ws + WS_CTL, 0, CTL_ZERO_BYTES, stream);
    Args a{};
    for (int i = 0; i < 17; ++i) a.in[i] = (const float*)d_in[i];
    a.out = (float*)d_out; a.ws = (unsigned char*)d_ws;
#if N_LAUNCH_MODE == 1
    a.ph_lo = 0; a.ph_hi = NPH;
    hipLaunchKernelGGL(fwd_kernel, dim3(grid), dim3(NTHR), LDS_BYTES, stream, a);
#else
    for (int ph = 0; ph < NPH; ++ph) { a.ph_lo = ph; a.ph_hi = ph + 1; hipLaunchKernelGGL(fwd_kernel, dim3(grid), dim3(NTHR), LDS_BYTES, stream, a); }
#endif
    const hipError_t le = hipPeekAtLastError();
    if (le != hipSuccess) fprintf(stderr, "kernel_launch: launch failed: %s\n", hipGetErrorName(le));
}
```

```cpp
#include <hip/hip_runtime.h>
#include <hip/hip_bf16.h>
#include <cstdio>
#include <cstdint>
#include <cmath>

#ifndef TBL_FP4
#define TBL_FP4 1
#endif
constexpr int S = 16384, DM = 2048, NWAVES = 8, NTHR = 512;
constexpr int INW = 5648, INP = 5888;
constexpr int C_AQ = 0, C_AK = 1024, C_AV = 1280, C_MQK = 1536, C_MV = 3584, C_MO = 4608, C_GATE = 5632;
constexpr float EPS = 1e-6f;
constexpr int NPH = 24;
enum { PH_PRO = 0, PH_GEMM_IN, PH_POST, PH_ATTN, PH_MLA, PH_SCAN, PH_MLB, PH_GEMM_OUT, PH_NORM0, PH_GEMM_Q0, PH_TOPK0, PH_GU0, PH_ACT0, PH_GV0, PH_NORMP,
       PH_POOLPREP, PH_GEMM_POOL, PH_NORM1, PH_GEMM_Q1, PH_TOPK1, PH_GU1, PH_ACT1, PH_GV1, PH_NORMF };

constexpr size_t MiB = 1u << 20;
constexpr size_t WS_CTL = 0, CTL_ZERO_BYTES = 1 * MiB;
constexpr size_t WS_WIN = 1 * MiB, WS_WOUT = 24 * MiB, WS_WQ0 = 32 * MiB, WS_WQ1 = 40 * MiB, WS_WPOOL = 48 * MiB, WS_KEYS = 50 * MiB;
constexpr size_t WS_TSC = 52 * MiB + 768 * 1024  , WS_GATES = 51 * MiB, WS_NST = 53 * MiB, WS_EIDX = 54 * MiB, WS_EGATE = 62 * MiB;
constexpr size_t WS_UB = 70 * MiB, WS_VB = 198 * MiB, WS_XN = 326 * MiB, WS_PROJ = 390 * MiB, WS_QP = WS_PROJ;
constexpr size_t WS_QB = 574 * MiB, WS_KVB = 606 * MiB, WS_MQ = 622 * MiB, WS_MK = 654 * MiB, WS_CST = 686 * MiB, WS_Y = 814 * MiB, WS_POOLED = WS_Y;
constexpr size_t WS_H = 878 * MiB, WS_END = 1006 * MiB;
constexpr int CW_BAR = 4096;
constexpr size_t GO_B = 0, GO_U = 8 * S * 4, GO_PM = 2 * 8 * S * 4, GO_G = 3 * 8 * S * 4, GO_PML = GO_G + 4096, GO_MPREV = GO_PML + 4096;

constexpr int LDS_BYTES = 147456, LDSCTL_OFF = 146944;

#define GAS __attribute__((address_space(1)))
#define LAS __attribute__((address_space(3)))
typedef unsigned short bf16_t;
typedef short bf16x8 __attribute__((ext_vector_type(8)));
typedef short s16x4 __attribute__((ext_vector_type(4)));
typedef short v4i16_t __attribute__((ext_vector_type(4)));
typedef float f32x4 __attribute__((ext_vector_type(4)));
typedef float f32x2 __attribute__((ext_vector_type(2)));
typedef float f32x16 __attribute__((ext_vector_type(16)));
typedef unsigned u32x4 __attribute__((ext_vector_type(4)));
typedef unsigned u32x2 __attribute__((ext_vector_type(2)));
typedef __bf16 bf16x2_t __attribute__((ext_vector_type(2)));
typedef GAS unsigned gu32;
#define RLX_AGENT __ATOMIC_RELAXED, __HIP_MEMORY_SCOPE_AGENT
#define LDS_WAIT() asm volatile("s_waitcnt lgkmcnt(0)" ::: "memory")
__device__ __forceinline__ unsigned f2bf(float f) { unsigned u = __builtin_bit_cast(unsigned, f); return (u + 0x7fffu + ((u >> 16) & 1u)) >> 16; }
__device__ __forceinline__ unsigned pk2(float lo, float hi) { f32x2 v = {lo, hi}; bf16x2_t b = __builtin_convertvector(v, bf16x2_t); return __builtin_bit_cast(unsigned, b); }
__device__ __forceinline__ float bflo(unsigned w) { return __builtin_bit_cast(float, w << 16); }
__device__ __forceinline__ float bfhi(unsigned w) { return __builtin_bit_cast(float, w & 0xffff0000u); }
__device__ __forceinline__ float wave_sum(float v) {
#pragma unroll
    for (int o = 1; o < 64; o <<= 1) v += __shfl_xor(v, o);
    return v;
}

namespace pg8 {
#define PG8_LAS __attribute__((address_space(3)))
typedef unsigned short bf16_t;
typedef short bf16x8 __attribute__((ext_vector_type(8)));
typedef float f32x4 __attribute__((ext_vector_type(4)));
typedef unsigned u32x4 __attribute__((ext_vector_type(4)));
constexpr int BM = 256, BK = 64, HALF = 128, HTB = HALF * BK * 2  , STAGE_BYTES = 8 * HTB, NXCD = 8, WGM = 8;

__host__ __device__ __forceinline__ int lds_byte(int r, int c) { const int st = (r >> 4) * 2 + (c >> 5), rr = r & 15, cc = c & 31, ob = rr * 64 + cc * 2; return st * 1024 + (ob ^ (((ob >> 9) & 1) << 5)); }
__host__ __device__ __forceinline__ void stage_rc(int b, int& R, int& C) { const int st = b / 1024, sb = b % 1024, swz = sb ^ (((sb >> 9) & 1) << 5); R = (st >> 1) * 16 + swz / 64; C = (st & 1) * 32 + (swz % 64) / 2; }
__host__ __device__ __forceinline__ int perm32(int rho) { const int n = rho >> 4, i = rho & 15; return 8 * (i >> 2) + 4 * n + (i & 3); }

struct Unit { int pm, pn; };
struct Gemm { const bf16_t* A; const bf16_t* Bt; int M, N, K, lda, ldb, agrp_shift; size_t agrp_bytes; };

struct StaticOrder {
    int nM, nN, nwg, G, c;
    __host__ __device__ void init(int M, int N, int G_, int c_) { nM = M / BM; nN = N / BM; nwg = nM * nN; G = G_; c = c_; }
    __host__ __device__ bool next(int i, Unit& u) const {
        const long L = (long)i * G + c; if (L >= nwg) return false;
        int wgid = (int)L; { const int q = nwg / NXCD, r = nwg % NXCD, xcd = wgid % NXCD, off = wgid / NXCD; wgid = (xcd < r ? xcd * (q + 1) : r * (q + 1) + (xcd - r) * q) + off; }
        const int nig = WGM * nN, gid = wgid / nig, fm = gid * WGM, gsz = (nM - fm) < WGM ? (nM - fm) : WGM;
        u.pm = fm + ((wgid % nig) % gsz); u.pn = (wgid % nig) / gsz; return true;
    }
    __device__ __forceinline__ void a_ready(const Unit&) const {}
    __device__ __forceinline__ void done(const Unit&) const {}
};

__device__ __forceinline__ unsigned cvt_pk_bf16(float lo, float hi) { unsigned r; asm volatile("v_cvt_pk_bf16_f32 %0, %1, %2" : "=v"(r) : "v"(lo), "v"(hi)); return r; }
typedef float f32x2 __attribute__((ext_vector_type(2)));
__device__ __forceinline__ f32x2 gelu_pk(f32x2 v) {
    const f32x2 av = __builtin_elementwise_abs(v), d = av * 0.2316418882f + 1.0f;
    f32x2 t; t.x = __builtin_amdgcn_rcpf(d.x); t.y = __builtin_amdgcn_rcpf(d.y);
    f32x2 q = t * 0.5307027145f + (-0.7265760135f); q = q * t + 0.7107068705f; q = q * t + (-0.142248368f); q = q * t + 0.127414796f; q = q * t;
    const f32x2 s = (v * v) * (-0.72134752044f);
    f32x2 e; e.x = __builtin_amdgcn_exp2f(s.x); e.y = __builtin_amdgcn_exp2f(s.y);
    const f32x2 m = v * (q * e), r = v - m;
    f32x2 o; o.x = v.x < 0.f ? m.x : r.x; o.y = v.y < 0.f ? m.y : r.y; return o;
}
template <int ACT  > struct EpiBf16 {
    static constexpr bool PERM = true, AFTER_DRAIN = false; static_assert(ACT == 0 || ACT == 1, "EpiBf16: ACT is 0 (none) or 1 (gelu_pk)");
    bf16_t* O; int ldc; const float* bias; int split_cols; size_t split_stride; float scale0;
    __device__ __forceinline__ void operator()(const f32x4 (&acc)[2][2][4][2], const Unit& u, int wr, int wc, int fr, int fq) const {
        const int row0 = u.pm * BM + wr * 64 + fr; int colt = u.pn * BM; bf16_t* base = O;
        float sc = 1.f; if (split_cols) { const int t = colt / split_cols; base += (size_t)t * split_stride; colt -= t * split_cols; if (t == 0) sc = scale0; }
        const int col0 = colt + wc * 32 + 8 * fq, bcol0 = u.pn * BM + wc * 32 + 8 * fq;
        f32x4 bv[2][2];
#pragma unroll
        for (int bj = 0; bj < 2; ++bj)
#pragma unroll
            for (int n = 0; n < 2; ++n) bv[bj][n] = bias ? *(const f32x4*)(bias + bcol0 + bj * HALF + 4 * n) : (f32x4){0.f, 0.f, 0.f, 0.f};
#pragma unroll
        for (int ai = 0; ai < 2; ++ai)
#pragma unroll
            for (int m = 0; m < 4; ++m) { bf16_t* rowp = base + (size_t)(row0 + ai * HALF + m * 16) * ldc + col0;
#pragma unroll
                for (int bj = 0; bj < 2; ++bj) { f32x4 v0 = acc[ai][bj][m][0] + bv[bj][0], v1 = acc[ai][bj][m][1] + bv[bj][1];
                    if (ACT == 1) { f32x2 a = gelu_pk((f32x2){v0[0], v0[1]}), b = gelu_pk((f32x2){v0[2], v0[3]}), c = gelu_pk((f32x2){v1[0], v1[1]}), d = gelu_pk((f32x2){v1[2], v1[3]});
                        v0 = (f32x4){a.x, a.y, b.x, b.y}; v1 = (f32x4){c.x, c.y, d.x, d.y}; }
                    v0 = v0 * sc; v1 = v1 * sc; u32x4 w; w.x = cvt_pk_bf16(v0[0], v0[1]); w.y = cvt_pk_bf16(v0[2], v0[3]); w.z = cvt_pk_bf16(v1[0], v1[1]); w.w = cvt_pk_bf16(v1[2], v1[3]);
                    *(u32x4*)(rowp + bj * HALF) = w; } }
    }
};
struct EpiResF32 {
    static constexpr bool PERM = false, AFTER_DRAIN = false;
    const float* base; float* out; int ldc; const float* colscale;
    __device__ __forceinline__ void operator()(const f32x4 (&acc)[2][2][4][2], const Unit& u, int wr, int wc, int fr, int fq) const {
        const int row0 = u.pm * BM + wr * 64 + fr, col0 = u.pn * BM + wc * 32 + 4 * fq;
        f32x4 cs[2][2];
#pragma unroll
        for (int bj = 0; bj < 2; ++bj)
#pragma unroll
            for (int n = 0; n < 2; ++n) cs[bj][n] = colscale ? *(const f32x4*)(colscale + col0 + bj * HALF + n * 16) : (f32x4){1.f, 1.f, 1.f, 1.f};
#pragma unroll
        for (int ai = 0; ai < 2; ++ai)
#pragma unroll
            for (int m = 0; m < 4; ++m) { const size_t off = (size_t)(row0 + ai * HALF + m * 16) * ldc + col0;
#pragma unroll
                for (int bj = 0; bj < 2; ++bj)
#pragma unroll
                    for (int n = 0; n < 2; ++n) { const f32x4 b = *(const f32x4*)(base + off + bj * HALF + n * 16);
                        *(f32x4*)(out + off + bj * HALF + n * 16) = b + acc[ai][bj][m][n] * cs[bj][n]; }
                asm volatile("" ::: "memory"); }
    }
};

template <class Epi, class Sched, bool ALIGN_EPI = false, bool SP2 = false>
__device__ __forceinline__ void gemm_phase(PG8_LAS unsigned char* lds, const Gemm g, const Sched& S, const Epi& E) {
    int tid_ = threadIdx.x; asm volatile("" : "+v"(tid_));
    const int tid = tid_, wid = __builtin_amdgcn_readfirstlane(tid >> 6), lane = tid & 63, wr = wid >> 2, wc = wid & 3, fr = lane & 15, fq = lane >> 4;
    const int K = g.K, nt = K / BK;
    unsigned voffA[2], voffB[2];
#pragma unroll
    for (int i = 0; i < 2; ++i) { int R, C; stage_rc(tid * 16 + i * 8192, R, C); const int Rb = Epi::PERM ? ((R & ~31) + perm32(R & 31)) : R;
        voffA[i] = (unsigned)(R * g.lda + C) * 2u; voffB[i] = (unsigned)(Rb * g.ldb + C) * 2u; }
    const size_t kstep = (size_t)(BK * 2);
    const size_t hstepA = (size_t)HALF * g.lda * 2, hstepB = (size_t)HALF * g.ldb * 2;
    const size_t tstepA = 2 * hstepA, tstepB = 2 * hstepB;
    const unsigned ldsw = (unsigned)wid * 1024u;
    const int aoff = lds_byte(wr * 64 + fr, fq * 8), boff = lds_byte(wc * 32 + fr, fq * 8);
#define PG8_SA(b, h) (((b) * 2 + (h)) * HTB)
#define PG8_SB(b, h) ((4 + (b) * 2 + (h)) * HTB)
#define PG8_STAGE(bufoff, gbase, voff) do { _Pragma("unroll") for (int _i = 0; _i < 2; ++_i) \
        __builtin_amdgcn_global_load_lds((const unsigned*)((const char*)(gbase) + (voff)[_i]), (PG8_LAS unsigned*)(lds + (bufoff) + ldsw + _i * 8192), 16, 0, 0); } while (0)
#define PG8_LDA(dst, b, h) do { _Pragma("unroll") for (int m = 0; m < 4; ++m) _Pragma("unroll") for (int k = 0; k < 2; ++k) dst[m][k] = *(const PG8_LAS bf16x8*)(lds + PG8_SA(b, h) + aoff + m * 2048 + k * 1024); } while (0)
#define PG8_LDB(dst, b, h) do { _Pragma("unroll") for (int n = 0; n < 2; ++n) _Pragma("unroll") for (int k = 0; k < 2; ++k) dst[n][k] = *(const PG8_LAS bf16x8*)(lds + PG8_SB(b, h) + boff + n * 2048 + k * 1024); } while (0)
#define PG8_MMA(ai, bj, At, Bt) do { __builtin_amdgcn_s_setprio(1); _Pragma("unroll") for (int m = 0; m < 4; ++m) _Pragma("unroll") for (int n = 0; n < 2; ++n) _Pragma("unroll") for (int k = 0; k < 2; ++k) \
        acc[ai][bj][m][n] = __builtin_amdgcn_mfma_f32_16x16x32_bf16(Bt[n][k], At[m][k], acc[ai][bj][m][n], 0, 0, 0); __builtin_amdgcn_s_setprio(0); } while (0)
#define PG8_WAIT_V(n) asm volatile("s_waitcnt vmcnt(" #n ")" ::: "memory")
#define PG8_WAIT_L(n) asm volatile("s_waitcnt lgkmcnt(" #n ")" ::: "memory")
#define PG8_BAR __builtin_amdgcn_s_barrier()
#define PG8_SCHED __builtin_amdgcn_sched_barrier(0)
    Unit cur, nxt; int ui = 0;
    if (!S.next(0, cur)) return;
    f32x4 acc[2][2][4][2];
#pragma unroll
    for (int a = 0; a < 2; ++a)
#pragma unroll
        for (int b = 0; b < 2; ++b)
#pragma unroll
            for (int m = 0; m < 4; ++m)
#pragma unroll
                for (int n = 0; n < 2; ++n) acc[a][b][m][n] = (f32x4){0.f, 0.f, 0.f, 0.f};
    bf16x8 At[4][2], B0[2][2], B1[2][2];
    const char* cA = (const char*)g.A + (size_t)cur.pm * tstepA + (size_t)(cur.pn >> g.agrp_shift) * g.agrp_bytes; const char* cB = (const char*)g.Bt + (size_t)cur.pn * tstepB;
    S.a_ready(cur);
    if constexpr (SP2) {
        PG8_STAGE(PG8_SB(0, 0), cB, voffB); PG8_STAGE(PG8_SB(0, 1), cB + hstepB, voffB); PG8_STAGE(PG8_SA(0, 0), cA, voffA); PG8_STAGE(PG8_SA(0, 1), cA + hstepA, voffA);
        if (wr == 1) PG8_BAR;
        PG8_WAIT_V(2); PG8_BAR;
        PG8_STAGE(PG8_SB(1, 0), cB + kstep, voffB); PG8_STAGE(PG8_SA(1, 0), cA + kstep, voffA); PG8_STAGE(PG8_SB(1, 1), cB + hstepB + kstep, voffB);
        PG8_WAIT_V(6); PG8_BAR;
    } else {
        PG8_STAGE(PG8_SB(0, 0), cB, voffB); PG8_STAGE(PG8_SA(0, 0), cA, voffA); PG8_STAGE(PG8_SB(0, 1), cB + hstepB, voffB); PG8_STAGE(PG8_SA(0, 1), cA + hstepA, voffA);
        if (wr == 1) PG8_BAR;
        PG8_WAIT_V(4); PG8_BAR;
        PG8_STAGE(PG8_SB(1, 0), cB + kstep, voffB); PG8_STAGE(PG8_SA(1, 0), cA + kstep, voffA); PG8_STAGE(PG8_SB(1, 1), cB + hstepB + kstep, voffB);
        PG8_WAIT_V(6); PG8_BAR;
    }
    for (;;) {
        const bool has_next = S.next(ui + 1, nxt);
        const char* nA = has_next ? (const char*)g.A + (size_t)nxt.pm * tstepA + (size_t)(nxt.pn >> g.agrp_shift) * g.agrp_bytes : cA; const char* nB = has_next ? (const char*)g.Bt + (size_t)nxt.pn * tstepB : cB;
        for (int t = 0; t < nt; t += 2) {
            const bool last = (t == nt - 2);
            const char* a1 = cA + (size_t)(t + 1) * kstep;
            const char* a2 = last ? nA : cA + (size_t)(t + 2) * kstep; const char* b2 = last ? nB : cB + (size_t)(t + 2) * kstep;
            const char* a3 = a2 + kstep; const char* b3 = b2 + kstep;
            if (last && has_next) S.a_ready(nxt);
            if constexpr (SP2) {
            PG8_LDB(B0, 0, 0); PG8_LDB(B1, 0, 1); PG8_SCHED; PG8_LDA(At, 0, 0); PG8_STAGE(PG8_SA(1, 1), a1 + hstepA, voffA);
            PG8_WAIT_V(8); PG8_WAIT_L(0); PG8_BAR; PG8_MMA(0, 0, At, B0); PG8_MMA(0, 1, At, B1); PG8_BAR; PG8_SCHED;
            PG8_LDA(At, 0, 1); PG8_STAGE(PG8_SB(0, 0), b2, voffB); PG8_STAGE(PG8_SB(0, 1), b2 + hstepB, voffB); PG8_STAGE(PG8_SA(0, 0), a2, voffA);
            PG8_WAIT_V(8); PG8_WAIT_L(0); PG8_BAR; PG8_MMA(1, 0, At, B0); PG8_MMA(1, 1, At, B1); PG8_BAR; PG8_SCHED;
            PG8_LDB(B0, 1, 0); PG8_LDB(B1, 1, 1); PG8_SCHED; PG8_LDA(At, 1, 0); PG8_STAGE(PG8_SA(0, 1), a2 + hstepA, voffA);
            PG8_WAIT_V(8); PG8_WAIT_L(0); PG8_BAR; PG8_MMA(0, 0, At, B0); PG8_MMA(0, 1, At, B1); PG8_BAR; PG8_SCHED;
            PG8_LDA(At, 1, 1); PG8_STAGE(PG8_SB(1, 0), b3, voffB); PG8_STAGE(PG8_SB(1, 1), b3 + hstepB, voffB); PG8_STAGE(PG8_SA(1, 0), a3, voffA);
            PG8_WAIT_V(8); PG8_WAIT_L(0); PG8_BAR; PG8_MMA(1, 0, At, B0); PG8_MMA(1, 1, At, B1); PG8_BAR; PG8_SCHED;
            } else {
            PG8_LDB(B0, 0, 0); PG8_SCHED; PG8_LDA(At, 0, 0); PG8_STAGE(PG8_SA(1, 1), a1 + hstepA, voffA);
            PG8_WAIT_L(8); PG8_BAR; PG8_WAIT_L(0); PG8_MMA(0, 0, At, B0); PG8_BAR; PG8_SCHED;
            PG8_LDB(B1, 0, 1); PG8_STAGE(PG8_SB(0, 0), b2, voffB);
            PG8_BAR; PG8_WAIT_L(0); PG8_MMA(0, 1, At, B1); PG8_BAR;
            PG8_LDA(At, 0, 1); PG8_STAGE(PG8_SA(0, 0), a2, voffA);
            PG8_BAR; PG8_WAIT_L(0); PG8_MMA(1, 0, At, B0); PG8_BAR; PG8_SCHED;
            PG8_STAGE(PG8_SB(0, 1), b2 + hstepB, voffB);
            PG8_WAIT_V(6); PG8_BAR; PG8_MMA(1, 1, At, B1); PG8_BAR;
            PG8_LDB(B0, 1, 0); PG8_SCHED; PG8_LDA(At, 1, 0); PG8_STAGE(PG8_SA(0, 1), a2 + hstepA, voffA);
            PG8_WAIT_L(8); PG8_BAR; PG8_WAIT_L(0); PG8_MMA(0, 0, At, B0); PG8_BAR; PG8_SCHED;
            PG8_LDB(B1, 1, 1); PG8_STAGE(PG8_SB(1, 0), b3, voffB);
            PG8_BAR; PG8_WAIT_L(0); PG8_MMA(0, 1, At, B1); PG8_BAR;
            PG8_LDA(At, 1, 1); PG8_STAGE(PG8_SA(1, 0), a3, voffA);
            PG8_BAR; PG8_WAIT_L(0); PG8_MMA(1, 0, At, B0); PG8_BAR; PG8_SCHED;
            PG8_STAGE(PG8_SB(1, 1), b3 + hstepB, voffB);
            PG8_WAIT_V(6); PG8_BAR; PG8_MMA(1, 1, At, B1); PG8_BAR;
            }
        }
        if constexpr (ALIGN_EPI) { if (wr == 0) PG8_BAR; }
        if constexpr (!Epi::AFTER_DRAIN) { E(acc, cur, wr, wc, fr, fq); S.done(cur); }
        if (!has_next) break;
#pragma unroll
        for (int a = 0; a < 2; ++a)
#pragma unroll
            for (int b = 0; b < 2; ++b)
#pragma unroll
                for (int m = 0; m < 4; ++m)
#pragma unroll
                    for (int n = 0; n < 2; ++n) acc[a][b][m][n] = (f32x4){0.f, 0.f, 0.f, 0.f};
        cur = nxt; cA = nA; cB = nB; ++ui;
        if constexpr (ALIGN_EPI) { if (wr == 1) PG8_BAR; }
    }
    PG8_WAIT_V(0);
    if constexpr (!ALIGN_EPI) { if (wr == 0) PG8_BAR; }
    PG8_BAR;
    if constexpr (Epi::AFTER_DRAIN) { E.fused(acc, cur, wr, wc, fr, fq, lds, wid, lane); S.done(cur); }
#undef PG8_SA
#undef PG8_SB
#undef PG8_STAGE
#undef PG8_LDA
#undef PG8_LDB
#undef PG8_MMA
#undef PG8_WAIT_V
#undef PG8_WAIT_L
#undef PG8_BAR
#undef PG8_SCHED
}
}
#define XB_TMO      128
#define XB_XCNT(j)  (256  + 64 * (j))
#define XB_XSUB(j)  (1280 + 64 * (j))
#define XB_XGEN(j)  (2304 + 64 * (j))
#define XB_TOP      3328
#define XB_TOPGEN   3392
#define XCD_BAR_WORDS 3456
#define XB_SPIN_CAP (1u << 18)

__device__ __forceinline__ unsigned xb_ld(unsigned* p)              { return __hip_atomic_load(p, __ATOMIC_RELAXED, __HIP_MEMORY_SCOPE_AGENT); }
__device__ __forceinline__ unsigned xb_add(unsigned* p, unsigned v) { return __hip_atomic_fetch_add(p, v, __ATOMIC_RELAXED, __HIP_MEMORY_SCOPE_AGENT); }
__device__ __forceinline__ unsigned xb_xcc_id() { return (unsigned)__builtin_amdgcn_s_getreg((3 << 11) | 20) & 0xFu; }
#define XB_SPIN(cond, bar) do { unsigned _sp = 0; while (cond) { __builtin_amdgcn_s_sleep(1); \
    if ((++_sp & 255u) == 0u) { if (xb_ld(&(bar)[XB_TMO])) break; if (_sp > XB_SPIN_CAP) { atomicAdd(&(bar)[XB_TMO], 1u); break; } } } } while (0)

struct XcdBarrier {
    unsigned* bar; unsigned x;
    volatile LAS unsigned* st;
};

__device__ __forceinline__ XcdBarrier xcd_barrier_post(unsigned* bar, volatile LAS unsigned* st) {
    XcdBarrier b; b.bar = bar; b.x = xb_xcc_id(); b.st = st;
    if (threadIdx.x == 0) (void)xb_add(&bar[XB_XCNT(b.x)], 1u);
    return b;
}
__device__ __forceinline__ void xcd_barrier_complete(unsigned* bar, unsigned x, unsigned& nloc, unsigned& nx) {
    const unsigned G = gridDim.x * gridDim.y * gridDim.z;
    unsigned sum, cnt, mine, sp = 0u;
    for (;;) {
        sum = 0u; cnt = 0u; mine = 0u;
#pragma unroll
        for (unsigned j = 0; j < 16; ++j) { const unsigned c = xb_ld(&bar[XB_XCNT(j)]); sum += c; cnt += (c > 0u) ? 1u : 0u; mine = (j == x) ? c : mine; }
        if (sum == G) break;
        __builtin_amdgcn_s_sleep(1);
        if ((++sp & 255u) == 0u) { if (xb_ld(&bar[XB_TMO])) break; if (sp > XB_SPIN_CAP) { atomicAdd(&bar[XB_TMO], 1u); break; } }
    }
    nloc = mine > 0u ? mine : 1u; nx = cnt > 0u ? cnt : 1u;
}

__device__ __forceinline__ void xcd_barrier(const XcdBarrier& b) {
    asm volatile("s_waitcnt vmcnt(0)" ::: "memory");
    __syncthreads();
    if (threadIdx.x == 0) {
        unsigned* bar = b.bar;
        __builtin_amdgcn_s_waitcnt(0);
        unsigned nloc = b.st[0], nx = b.st[1];
        if (nloc == 0u) { xcd_barrier_complete(bar, b.x, nloc, nx); b.st[0] = nloc; b.st[1] = nx; }
        const unsigned old = xb_add(&bar[XB_XSUB(b.x)], 1u);
        const unsigned gen = old / nloc;
        if (old + 1u == (gen + 1u) * nloc) {
            __builtin_amdgcn_fence(__ATOMIC_RELEASE, "agent");
            asm volatile("s_waitcnt vmcnt(0)" ::: "memory");
            const unsigned og = xb_add(&bar[XB_TOP], 1u);
            const unsigned tg = og / nx;
            if (og + 1u == (tg + 1u) * nx) xb_add(&bar[XB_TOPGEN], 1u);
            else XB_SPIN(xb_ld(&bar[XB_TOPGEN]) == tg, bar);
            __builtin_amdgcn_fence(__ATOMIC_ACQUIRE, "agent");
            xb_add(&bar[XB_XGEN(b.x)], 1u);
            asm volatile("s_waitcnt vmcnt(0)" ::: "memory");
        } else {
            XB_SPIN(xb_ld(&bar[XB_XGEN(b.x)]) == gen, bar);
            __builtin_amdgcn_fence(__ATOMIC_ACQUIRE, "agent");
            asm volatile("s_waitcnt vmcnt(0)" ::: "memory");
        }
    }
    __syncthreads();
}
namespace att {
using bf16 = __hip_bfloat16;
constexpr int   D = 128, NW = 8, QBLK = 32, KVBLK = 64;
constexpr float SCALE = 0.088388347648318440f;
constexpr float THR = 8.f;
constexpr int SDEPTH = 1;
constexpr int LDQ = 1024, LDK = 512, LDO = 2048;
constexpr size_t SHM_V = KVBLK * D * 2, SHM_K = KVBLK * D * 2, SHM_ATTN = 2 * SHM_V + 2 * SHM_K + NW * 64 * 4;
using bf16x8 = __attribute__((ext_vector_type(8))) short;
using s16x4  = __attribute__((ext_vector_type(4))) short;
using f32x16 = __attribute__((ext_vector_type(16))) float;
using f32x8  = __attribute__((ext_vector_type(8))) float;
using u32x4  = __attribute__((ext_vector_type(4))) unsigned;
#define KSWZ(row, colB) ((row) * 256 + ((colB) ^ (((row) & 7) << 4)))
#define SBAR() __builtin_amdgcn_sched_barrier(0)
__device__ __forceinline__ int crow(int r, int hi) { return (r & 3) + 8 * (r >> 2) + 4 * hi; }
__device__ __forceinline__ unsigned cvtpk(float lo, float hi) {
  unsigned r; asm volatile("v_cvt_pk_bf16_f32 %0, %1, %2" : "=v"(r) : "v"(lo), "v"(hi)); return r;
}
template <typename TIn> struct Stage;
template <> struct Stage<bf16>  { using T = bf16x8;
  __device__ static __forceinline__ T ld8(const bf16* p) { return *reinterpret_cast<const bf16x8*>(p); }
  __device__ static __forceinline__ bf16x8 tobf(T x) { return x; } };
template <> struct Stage<float> { using T = f32x8;
  __device__ static __forceinline__ T ld8(const float* p) { return *reinterpret_cast<const f32x8*>(p); }
  __device__ static __forceinline__ bf16x8 tobf(T x) {
    u32x4 w = {cvtpk(x[0], x[1]), cvtpk(x[2], x[3]), cvtpk(x[4], x[5]), cvtpk(x[6], x[7])}; return *reinterpret_cast<bf16x8*>(&w); } };

__device__ __forceinline__ void partialSM(f32x16& p0, f32x16& p1, float mC) {
  constexpr float C = SCALE * 1.4426950408889634f;
  for (int r = 0; r < 16; ++r) p0[r] = fmaf(p0[r], C, mC); for (int r = 0; r < 16; ++r) p1[r] = fmaf(p1[r], C, mC);
  for (int r = 0; r < 16; ++r) p0[r] = __builtin_amdgcn_exp2f(p0[r]);
}
__device__ __forceinline__ void finishSM(f32x16& p0, f32x16& p1, float& l_reg, bf16x8& pa0, bf16x8& pa1, bf16x8& pa2, bf16x8& pa3) {
  for (int r = 0; r < 16; ++r) p1[r] = __builtin_amdgcn_exp2f(p1[r]);
  float ps = 0; for (int r = 0; r < 16; ++r) ps += p0[r]; for (int r = 0; r < 16; ++r) ps += p1[r];
  l_reg += ps;
#define PK4(P, BASE, OUT) do { unsigned a0 = cvtpk(P[BASE + 0], P[BASE + 1]), a1 = cvtpk(P[BASE + 2], P[BASE + 3]);   \
    unsigned b0 = cvtpk(P[BASE + 4], P[BASE + 5]), b1 = cvtpk(P[BASE + 6], P[BASE + 7]);                              \
    auto r0 = __builtin_amdgcn_permlane32_swap(a0, b0, false, false); auto r1 = __builtin_amdgcn_permlane32_swap(a1, b1, false, false); \
    u32x4 w = {r0[0], r1[0], r0[1], r1[1]}; OUT = *reinterpret_cast<bf16x8*>(&w); } while (0)
  PK4(p0, 0, pa0); PK4(p0, 8, pa1); PK4(p1, 0, pa2); PK4(p1, 8, pa3);
#undef PK4
}
__device__ __forceinline__ void qkt(f32x16& p0, f32x16& p1, const bf16* Ks, const bf16x8* qr, int r32, int hi) {
  p0 = f32x16{}; p1 = f32x16{};
  for (int d0 = 0; d0 < 8; ++d0) { int cb = (d0 * 16 + hi * 8) * 2;
    bf16x8 b0 = *reinterpret_cast<const bf16x8*>((const char*)Ks + KSWZ(r32, cb));
    bf16x8 b1 = *reinterpret_cast<const bf16x8*>((const char*)Ks + KSWZ(32 + r32, cb));
    p0 = __builtin_amdgcn_mfma_f32_32x32x16_bf16(b0, qr[d0], p0, 0, 0, 0);
    p1 = __builtin_amdgcn_mfma_f32_32x32x16_bf16(b1, qr[d0], p1, 0, 0, 0); }
}
__device__ __forceinline__ int v_st(int k, int c) { const int kk = (k & ~0xC) | ((k & 4) << 1) | ((k & 8) >> 1); return ((kk >> 3) * 4 + (c >> 5)) * 512 + ((kk & 7) * 32 + (c & 31)) * 2; }
__device__ __forceinline__ int v_rd_base(int lane) { return ((lane & 3) << 3) | (((lane >> 2) & 3) << 6) | (((lane >> 4) & 1) << 5) | (((lane >> 5) & 1) << 8); }
constexpr int v_rd_off(int d0, int ks, int half) { return d0 * 512 + ks * 4096 + half * 2048; }
template <int OFF> __device__ __forceinline__ s16x4 tr_read(int vb) {
  s16x4 r; asm volatile("ds_read_b64_tr_b16 %0, %1 offset:%2" : "=&v"(r) : "v"(vb), "i"(OFF) : "memory"); return r;
}
template <int D0> __device__ __forceinline__ void pv_one(f32x16& od, int vb, bf16x8 pa0, bf16x8 pa1, bf16x8 pa2, bf16x8 pa3) {
  const s16x4 l0 = tr_read<v_rd_off(D0, 0, 0)>(vb), h0 = tr_read<v_rd_off(D0, 0, 1)>(vb), l1 = tr_read<v_rd_off(D0, 1, 0)>(vb), h1 = tr_read<v_rd_off(D0, 1, 1)>(vb);
  const s16x4 l2 = tr_read<v_rd_off(D0, 2, 0)>(vb), h2 = tr_read<v_rd_off(D0, 2, 1)>(vb), l3 = tr_read<v_rd_off(D0, 3, 0)>(vb), h3 = tr_read<v_rd_off(D0, 3, 1)>(vb);
  asm volatile("s_waitcnt lgkmcnt(0)" ::: "memory"); SBAR();
#define PK(L, H) (bf16x8){L[0], L[1], L[2], L[3], H[0], H[1], H[2], H[3]}
  od = __builtin_amdgcn_mfma_f32_32x32x16_bf16(pa0, PK(l0, h0), od, 0, 0, 0);
  od = __builtin_amdgcn_mfma_f32_32x32x16_bf16(pa1, PK(l1, h1), od, 0, 0, 0);
  od = __builtin_amdgcn_mfma_f32_32x32x16_bf16(pa2, PK(l2, h2), od, 0, 0, 0);
  od = __builtin_amdgcn_mfma_f32_32x32x16_bf16(pa3, PK(l3, h3), od, 0, 0, 0);
#undef PK
}
__device__ __forceinline__ void pv_d0(f32x16* o, int vb, bf16x8 pa0, bf16x8 pa1, bf16x8 pa2, bf16x8 pa3) {
  pv_one<0>(o[0], vb, pa0, pa1, pa2, pa3); pv_one<1>(o[1], vb, pa0, pa1, pa2, pa3); pv_one<2>(o[2], vb, pa0, pa1, pa2, pa3); pv_one<3>(o[3], vb, pa0, pa1, pa2, pa3);
}

template <typename TQ>
__device__ __forceinline__ void attn_dense_body(const TQ* __restrict__ Qb, const bf16* __restrict__ Kh, const bf16* __restrict__ Vh,
                                                bf16* __restrict__ Ob, int seq, char* lds, float mC) {
  using St = Stage<bf16>; using SQ = Stage<TQ>;
  int tid_ = threadIdx.x; asm volatile("" : "+v"(tid_));
  const int tid = tid_, wid = tid >> 6, lane = tid & 63, r32 = lane & 31, hi = lane >> 5;
  bf16* V_lds = (bf16*)lds; bf16* K_lds = (bf16*)(lds + 2 * SHM_V);
  float* ws = (float*)(lds + 2 * SHM_V + 2 * SHM_K) + wid * 64; float* li_l = ws;
  float l_reg = 0; f32x16 o[4] = {}; bf16x8 qr[8];
  const TQ* Qw = Qb + (long)(wid * QBLK + r32) * LDQ + hi * 8;
#pragma unroll
  for (int d0 = 0; d0 < 8; ++d0) qr[d0] = SQ::tobf(SQ::ld8(Qw + d0 * 16));
  const int sr = tid >> 4, sc = (tid & 15) * 8, vst0 = v_st(sr, sc), vst1 = v_st(32 + sr, sc);
  const int vb0 = (int)(uintptr_t)V_lds + v_rd_base(lane);
  struct { typename St::T vs0, vs1, ks0, ks1; } sr_[SDEPTH];
#define SLOAD(i, k0) do { sr_[i].vs0 = St::ld8(&Vh[(long)((k0) + sr) * LDK + sc]); sr_[i].vs1 = St::ld8(&Vh[(long)((k0) + 32 + sr) * LDK + sc]); \
    sr_[i].ks0 = St::ld8(&Kh[(long)((k0) + sr) * LDK + sc]); sr_[i].ks1 = St::ld8(&Kh[(long)((k0) + 32 + sr) * LDK + sc]); } while (0)
#define SWRITE(b, i) do { *(bf16x8*)((char*)V_lds + (b) * SHM_V + vst0) = St::tobf(sr_[i].vs0);          \
    *(bf16x8*)((char*)V_lds + (b) * SHM_V + vst1) = St::tobf(sr_[i].vs1); int kc = sc * 2;               \
    *(bf16x8*)((char*)K_lds + (b) * SHM_K + KSWZ(sr, kc)) = St::tobf(sr_[i].ks0);                       \
    *(bf16x8*)((char*)K_lds + (b) * SHM_K + KSWZ(32 + sr, kc)) = St::tobf(sr_[i].ks1); } while (0)
#define SWAIT() do { if constexpr (SDEPTH == 2) asm volatile("s_waitcnt vmcnt(4)" ::: "memory"); else asm volatile("s_waitcnt vmcnt(0)" ::: "memory"); } while (0)
  f32x16 pA0, pA1, pB0, pB1; bf16x8 pa0, pa1, pa2, pa3; const int NT = seq / KVBLK;
  constexpr int SE = 0, SO = SDEPTH - 1;
  SLOAD(SE, 0); asm volatile("s_waitcnt vmcnt(0)" ::: "memory"); SWRITE(0, SE); __syncthreads();
  qkt(pA0, pA1, K_lds, qr, r32, hi); partialSM(pA0, pA1, mC);
  SLOAD(SO, KVBLK); if constexpr (SDEPTH == 2) { if (2 < NT) SLOAD(SE, 2 * KVBLK); }
  SWAIT(); SWRITE(1, SO); __syncthreads();
  for (int j = 1; j + 1 < NT; j += 2) {
    SBAR(); qkt(pB0, pB1, (bf16*)((char*)K_lds + SHM_K), qr, r32, hi);
    finishSM(pA0, pA1, l_reg, pa0, pa1, pa2, pa3); SBAR();
    SLOAD(SO, (j + SDEPTH) * KVBLK); SBAR();
    pv_d0(o, vb0, pa0, pa1, pa2, pa3); partialSM(pB0, pB1, mC);
    __syncthreads(); SWAIT(); SWRITE(0, SE);
    __syncthreads();
    SBAR(); qkt(pA0, pA1, K_lds, qr, r32, hi);
    finishSM(pB0, pB1, l_reg, pa0, pa1, pa2, pa3); SBAR();
    if (SDEPTH == 1 || j + 3 < NT) SLOAD(SE, (j + 1 + SDEPTH) * KVBLK); SBAR();
    pv_d0(o, vb0 + (int)SHM_V, pa0, pa1, pa2, pa3); partialSM(pA0, pA1, mC);
    __syncthreads(); SWAIT(); SWRITE(1, SO);
    __syncthreads();
  }
  SBAR(); qkt(pB0, pB1, (bf16*)((char*)K_lds + SHM_K), qr, r32, hi);
  finishSM(pA0, pA1, l_reg, pa0, pa1, pa2, pa3); SBAR();
  pv_d0(o, vb0, pa0, pa1, pa2, pa3); partialSM(pB0, pB1, mC);
  __syncthreads();
  finishSM(pB0, pB1, l_reg, pa0, pa1, pa2, pa3); SBAR();
  pv_d0(o, vb0 + (int)SHM_V, pa0, pa1, pa2, pa3);
  { auto rr = __builtin_amdgcn_permlane32_swap(__float_as_uint(l_reg), __float_as_uint(l_reg), false, false); l_reg = __uint_as_float(rr[0]) + __uint_as_float(rr[1]); }
  if (hi == 0) li_l[r32] = l_reg; asm volatile("s_waitcnt lgkmcnt(0)" ::: "memory");
  float rli[16];
#pragma unroll
  for (int r = 0; r < 16; ++r) rli[r] = __builtin_amdgcn_rcpf(li_l[crow(r, hi)]);
  bf16* Ow = Ob + (long)(wid * QBLK) * LDO;
#pragma unroll
  for (int r = 0; r < 16; ++r) { int orow = crow(r, hi);
    for (int d0 = 0; d0 < 4; ++d0) Ow[(long)orow * LDO + d0 * 32 + r32] = __float2bfloat16(o[d0][r] * rli[r]); }
  __syncthreads();
#undef SLOAD
#undef SWRITE
#undef SWAIT
}
#undef KSWZ
#undef SBAR
}

struct Frame {
    LAS unsigned char* lds;
    char* ldsg;
    int tid, lane, wave, vcu, G;
    unsigned char* ws;
};
__device__ __forceinline__ const float* frame_in(const Frame& F, int i) {
    const LAS unsigned* p = (const LAS unsigned*)(F.lds + LDSCTL_OFF + 64) + 2 * i;
    const unsigned lo = __builtin_amdgcn_readfirstlane(p[0]), hi = __builtin_amdgcn_readfirstlane(p[1]);
    return (const float*)(const GAS float*)(((unsigned long long)hi << 32) | lo);
}
#define FIN(i) frame_in(F, (i))
#define FOUT() ((float*)frame_in(F, 17))
#define WSP(T, off) ((T*)(F.ws + (off)))

__device__ __forceinline__ void p0_transpose_item(const float* W, int K, int N, int Npad, bf16_t* WT, int row_off, LAS float* scr, int item, int lane) {
    const int nblk = Npad / 32, kb = item / nblk, nb = item % nblk, k0 = 64 * kb, n0 = 32 * nb;
    const int nn = n0 + (lane & 31);
#pragma unroll 8
    for (int i = 0; i < 32; ++i) { const int kk = 2 * i + (lane >> 5); scr[kk * 33 + (lane & 31)] = nn < N ? W[(size_t)(k0 + kk) * N + nn] : 0.f; }
    LDS_WAIT(); asm volatile("" ::: "memory");
    const int c = lane & 7;
#pragma unroll
    for (int j = 0; j < 4; ++j) { const int n = (lane >> 3) + 8 * j; const LAS float* s = scr + (8 * c) * 33 + n;
        u32x4 o; o.x = pk2(s[0 * 33], s[1 * 33]); o.y = pk2(s[2 * 33], s[3 * 33]); o.z = pk2(s[4 * 33], s[5 * 33]); o.w = pk2(s[6 * 33], s[7 * 33]);
        *(GAS u32x4*)(WT + (size_t)(row_off + n0 + n) * K + k0 + 8 * c) = o; }
    LDS_WAIT(); asm volatile("" ::: "memory");
}
__device__ __forceinline__ u32x4 cvt8(const float* p) {
    const f32x4 a = *(const f32x4*)p, b = *(const f32x4*)(p + 4);
    u32x4 o; o.x = pk2(a.x, a.y); o.y = pk2(a.z, a.w); o.z = pk2(b.x, b.y); o.w = pk2(b.z, b.w); return o;
}
__device__ __forceinline__ void rms_row_to_bf16(const float* xrow, const float* g, bf16_t* orow, int lane) {
    const f32x4* xr = (const f32x4*)xrow + lane;
    f32x4 v[8]; float s = 0.f;
#pragma unroll
    for (int j = 0; j < 8; ++j) { v[j] = xr[64 * j]; s += (v[j].x * v[j].x + v[j].y * v[j].y) + (v[j].z * v[j].z + v[j].w * v[j].w); }
    const float r = 1.0f / sqrtf(wave_sum(s) * (1.f / DM) + EPS);
    u32x2* o8 = (u32x2*)orow + lane;
#pragma unroll
    for (int j = 0; j < 8; ++j) { const f32x4 gg = ((const f32x4*)g)[lane + 64 * j]; u32x2 w; w.x = pk2(v[j].x * r * gg.x, v[j].y * r * gg.y); w.y = pk2(v[j].z * r * gg.z, v[j].w * r * gg.w); o8[64 * j] = w; }
}
__device__ __forceinline__ void ph_prologue(const Frame& F) {
    LAS float* scr = (LAS float*)(F.lds + F.wave * 16384);
    const int gw = F.vcu * NWAVES + F.wave, NGW = F.G * NWAVES;
#if TBL_FP4
    for (int row = gw; row < 4 * 16384; row += NGW) {
        const int tb = row >> 15, rr = row & 32767;
        const float* src = FIN(14 + tb) + (size_t)rr * DM + F.lane * 32;
        f32x4 v[8]; float am = 0.f;
#pragma unroll
        for (int q = 0; q < 8; ++q) { v[q] = *(const f32x4*)(src + 4 * q);
            am = fmaxf(am, fmaxf(fmaxf(fabsf(v[q].x), fabsf(v[q].y)), fmaxf(fabsf(v[q].z), fabsf(v[q].w)))); }
#pragma unroll
        for (int o = 1; o < 64; o <<= 1) am = fmaxf(am, __shfl_xor(am, o));
        const float sc = am > 0.f ? am * (1.f / 6.f) : 1.f, isc = 1.0f / sc;
        unsigned w[4];
#pragma unroll
        for (int q = 0; q < 4; ++q) { unsigned p = 0u;
            p = __builtin_amdgcn_cvt_scalef32_pk_fp4_f32(p, v[2 * q].x * isc, v[2 * q].y * isc, 1.0f, 0); p = __builtin_amdgcn_cvt_scalef32_pk_fp4_f32(p, v[2 * q].z * isc, v[2 * q].w * isc, 1.0f, 1);
            p = __builtin_amdgcn_cvt_scalef32_pk_fp4_f32(p, v[2 * q + 1].x * isc, v[2 * q + 1].y * isc, 1.0f, 2); p = __builtin_amdgcn_cvt_scalef32_pk_fp4_f32(p, v[2 * q + 1].z * isc, v[2 * q + 1].w * isc, 1.0f, 3); w[q] = p; }
        unsigned char* dst = F.ws + (tb ? WS_VB : WS_UB) + (size_t)(rr >> 14) * (16384 * 1024) + ((size_t)(F.lane >> 3) * 16384 + (rr & 16383)) * 128 + (F.lane & 7) * 16;
        *(u32x4*)dst = (u32x4){w[0], w[1], w[2], w[3]};
        if (F.lane == 0) ((float*)(F.ws + WS_TSC))[row] = sc;
    }
#else
    for (int row = gw; row < 4 * 16384; row += NGW) {
        const int tb = row >> 15, rr = row & 32767;
        const float* src = FIN(14 + tb) + (size_t)rr * DM + F.lane * 16;
        f32x4 v[8]; float am = 0.f;
#pragma unroll
        for (int q = 0; q < 8; ++q) { v[q] = *(const f32x4*)(src + (q >> 2) * 1024 + (q & 3) * 4);
            am = fmaxf(am, fmaxf(fmaxf(fabsf(v[q].x), fabsf(v[q].y)), fmaxf(fabsf(v[q].z), fabsf(v[q].w)))); }
#pragma unroll
        for (int o = 1; o < 64; o <<= 1) am = fmaxf(am, __shfl_xor(am, o));
        const float sc = am > 0.f ? am * (1.f / 448.f) : 1.f, isc = 1.0f / sc;
        unsigned w[8];
#pragma unroll
        for (int q = 0; q < 8; ++q) { unsigned p = __builtin_amdgcn_cvt_pk_fp8_f32(v[q].x * isc, v[q].y * isc, 0u, false); w[q] = __builtin_amdgcn_cvt_pk_fp8_f32(v[q].z * isc, v[q].w * isc, p, true); }
        unsigned char* dst = F.ws + (tb ? WS_VB : WS_UB) + (size_t)(rr >> 14) * (16384 * 2048) + ((size_t)(F.lane >> 3) * 16384 + (rr & 16383)) * 128 + (F.lane & 7) * 16;
        *(u32x4*)dst = (u32x4){w[0], w[1], w[2], w[3]}; *(u32x4*)(dst + (size_t)8 * 16384 * 128) = (u32x4){w[4], w[5], w[6], w[7]};
        if (F.lane == 0) ((float*)(F.ws + WS_TSC))[row] = sc;
    }
#endif
    {   constexpr int I_IN = (DM / 64) * (INP / 32), I_SQ = (DM / 64) * (DM / 32), I_PL = 4 * (512 / 64) * (512 / 32);
        constexpr int NIT = I_IN + 3 * I_SQ + I_PL;
        for (int it = gw; it < NIT; it += NGW) {
            int r = it;
            if (r < I_IN) { p0_transpose_item(FIN(3), DM, INW, INP, WSP(bf16_t, WS_WIN), 0, scr, r, F.lane); continue; } r -= I_IN;
            if (r < I_SQ) { p0_transpose_item(FIN(9), DM, DM, DM, WSP(bf16_t, WS_WOUT), 0, scr, r, F.lane); continue; } r -= I_SQ;
            if (r < I_SQ) { p0_transpose_item(FIN(12), DM, DM, DM, WSP(bf16_t, WS_WQ0), 0, scr, r, F.lane); continue; } r -= I_SQ;
            if (r < I_SQ) { p0_transpose_item(FIN(12) + (size_t)DM * DM, DM, DM, DM, WSP(bf16_t, WS_WQ1), 0, scr, r, F.lane); continue; } r -= I_SQ;
            const int grp = r / 128, ri = r % 128;
            p0_transpose_item(FIN(10) + (size_t)grp * 512 * 512, 512, 512, 512, WSP(bf16_t, WS_WPOOL), grp * 512, scr, ri, F.lane);
        }
    }
    for (int it = gw; it < 1024; it += NGW) *(u32x4*)(WSP(bf16_t, WS_KEYS) + (size_t)it * 512 + F.lane * 8) = cvt8(FIN(13) + (size_t)it * 512 + F.lane * 8);
    for (int m = gw; m < S; m += NGW) rms_row_to_bf16(FIN(0) + (size_t)m * DM, FIN(1), WSP(bf16_t, WS_XN) + (size_t)m * DM, F.lane);
}

__device__ __forceinline__ float silu_f(float z) { return z / (1.f + __expf(-z)); }
__device__ __forceinline__ void p2_qkv_token(const Frame& F, int t) {
    const int lane = F.lane, i8 = lane & 7;
    const bf16_t* pr = WSP(bf16_t, WS_PROJ) + (size_t)t * INP;
    const int axis = i8 >> 2, half = (i8 >> 1) & 1, f0 = (i8 & 1) * 16;
    const float pos = (float)(axis == 0 ? (t >> 6) : (t & 63));
    float cs[16], sn[16];
#pragma unroll
    for (int e = 0; e < 16; ++e) { const float inv = exp2f(-(float)(f0 + e) * (13.287712379549449f / 32.f));
        float rev = pos * inv * 0.15915494309189535f; rev -= rintf(rev);
        cs[e] = __builtin_amdgcn_cosf(rev); sn[e] = __builtin_amdgcn_sinf(rev); }
    const float sgn = half ? 1.f : -1.f;
    {   const u32x4 w0 = *(const u32x4*)(pr + C_AQ + lane * 16), w1 = *(const u32x4*)(pr + C_AQ + lane * 16 + 8);
        float v[16]; const unsigned ww[8] = {w0.x, w0.y, w0.z, w0.w, w1.x, w1.y, w1.z, w1.w};
#pragma unroll
        for (int e = 0; e < 8; ++e) { v[2 * e] = bflo(ww[e]); v[2 * e + 1] = bfhi(ww[e]); }
        float ss = 0.f;
#pragma unroll
        for (int e = 0; e < 16; ++e) ss += v[e] * v[e];
        ss += __shfl_xor(ss, 1); ss += __shfl_xor(ss, 2); ss += __shfl_xor(ss, 4);
        const float r = 1.0f / sqrtf(ss * (1.f / 128.f) + EPS);
        const float* gq = FIN(6) + i8 * 16;
        unsigned ow[8];
        float y[16];
#pragma unroll
        for (int e = 0; e < 16; ++e) y[e] = v[e] * r * gq[e];
#pragma unroll
        for (int e = 0; e < 16; ++e) { const float yp = __shfl_xor(y[e], 2); y[e] = y[e] * cs[e] + sgn * yp * sn[e]; }
#pragma unroll
        for (int e = 0; e < 8; ++e) ow[e] = pk2(y[2 * e], y[2 * e + 1]);
        bf16_t* dst = WSP(bf16_t, WS_QB) + (size_t)t * 1024 + lane * 16;
        *(u32x4*)dst = (u32x4){ow[0], ow[1], ow[2], ow[3]}; *(u32x4*)(dst + 8) = (u32x4){ow[4], ow[5], ow[6], ow[7]};
    }
    {   const int l16 = lane & 15;
        const u32x4 w0 = *(const u32x4*)(pr + C_AK + l16 * 16), w1 = *(const u32x4*)(pr + C_AK + l16 * 16 + 8);
        float v[16]; const unsigned ww[8] = {w0.x, w0.y, w0.z, w0.w, w1.x, w1.y, w1.z, w1.w};
#pragma unroll
        for (int e = 0; e < 8; ++e) { v[2 * e] = bflo(ww[e]); v[2 * e + 1] = bfhi(ww[e]); }
        float ss = 0.f;
#pragma unroll
        for (int e = 0; e < 16; ++e) ss += v[e] * v[e];
        ss += __shfl_xor(ss, 1); ss += __shfl_xor(ss, 2); ss += __shfl_xor(ss, 4);
        const float r = 1.0f / sqrtf(ss * (1.f / 128.f) + EPS);
        const float* gk = FIN(7) + i8 * 16;
        float y[16]; unsigned ow[8];
#pragma unroll
        for (int e = 0; e < 16; ++e) y[e] = v[e] * r * gk[e];
#pragma unroll
        for (int e = 0; e < 16; ++e) { const float yp = __shfl_xor(y[e], 2); y[e] = y[e] * cs[e] + sgn * yp * sn[e]; }
#pragma unroll
        for (int e = 0; e < 8; ++e) ow[e] = pk2(y[2 * e], y[2 * e + 1]);
        bf16_t* kv = WSP(bf16_t, WS_KVB) + (size_t)t * 512;
        if (lane < 16) { *(u32x4*)(kv + lane * 16) = (u32x4){ow[0], ow[1], ow[2], ow[3]}; *(u32x4*)(kv + lane * 16 + 8) = (u32x4){ow[4], ow[5], ow[6], ow[7]}; }
        else if (lane < 32) { const u32x4 a = *(const u32x4*)(pr + C_AV + l16 * 16), b = *(const u32x4*)(pr + C_AV + l16 * 16 + 8);
            *(u32x4*)(kv + 256 + l16 * 16) = a; *(u32x4*)(kv + 256 + l16 * 16 + 8) = b; }
    }
}
__device__ __forceinline__ void p2_conv_item(const Frame& F, int item) {
    const int tb = item >> 2, sl = item & 3, lane = F.lane, c = sl * 512 + lane * 8, t0 = tb * 16;
    float w[5][8];
#pragma unroll
    for (int j = 0; j < 5; ++j) { const f32x4 a = *(const f32x4*)(FIN(5) + j * 2048 + c), b = *(const f32x4*)(FIN(5) + j * 2048 + c + 4);
        w[j][0] = a.x; w[j][1] = a.y; w[j][2] = a.z; w[j][3] = a.w; w[j][4] = b.x; w[j][5] = b.y; w[j][6] = b.z; w[j][7] = b.w; }
    const bf16_t* src = WSP(bf16_t, WS_PROJ) + C_MQK + c;
    const float osc = (c >= 1024) ? 0.0625f : 1.f;
    bf16_t* dst = (c >= 1024) ? WSP(bf16_t, WS_MK) + (c - 1024) : WSP(bf16_t, WS_MQ) + c;
    u32x4 rows[5];
#pragma unroll
    for (int j = 0; j < 4; ++j) { const int tt = t0 - 2 + j; rows[j + 1] = (tt >= 0 && tt < S) ? *(const u32x4*)(src + (size_t)tt * INP) : (u32x4){0u, 0u, 0u, 0u}; }
#pragma unroll 1
    for (int q = 0; q < 16; ++q) {
        const int tn = t0 + q + 2;
        rows[0] = rows[1]; rows[1] = rows[2]; rows[2] = rows[3]; rows[3] = rows[4];
        rows[4] = (tn < S) ? *(const u32x4*)(src + (size_t)tn * INP) : (u32x4){0u, 0u, 0u, 0u};
        float acc[8];
#pragma unroll
        for (int e = 0; e < 8; ++e) acc[e] = 0.f;
#pragma unroll
        for (int j = 0; j < 5; ++j) { const unsigned ww[4] = {rows[j].x, rows[j].y, rows[j].z, rows[j].w};
#pragma unroll
            for (int e = 0; e < 4; ++e) { acc[2 * e] += bflo(ww[e]) * w[j][2 * e]; acc[2 * e + 1] += bfhi(ww[e]) * w[j][2 * e + 1]; } }
        u32x4 o; o.x = pk2(silu_f(acc[0]) * osc, silu_f(acc[1]) * osc); o.y = pk2(silu_f(acc[2]) * osc, silu_f(acc[3]) * osc);
        o.z = pk2(silu_f(acc[4]) * osc, silu_f(acc[5]) * osc); o.w = pk2(silu_f(acc[6]) * osc, silu_f(acc[7]) * osc);
        *(u32x4*)(dst + (size_t)(t0 + q) * 1024) = o;
    }
}
__device__ __forceinline__ float wave_incl_scan_add(float v, int lane) {
#pragma unroll
    for (int o = 1; o < 64; o <<= 1) { const float u = __shfl_up(v, o); if (lane >= o) v += u; }
    return v;
}
__device__ __forceinline__ float wave_incl_scan_max(float v, int lane) {
#pragma unroll
    for (int o = 1; o < 64; o <<= 1) { const float u = __shfl_up(v, o); if (lane >= o) v = fmaxf(v, u); }
    return v;
}
__device__ __forceinline__ float logsigmoid_f(float x) { return fminf(x, 0.f) - log1pf(__expf(-fabsf(x))); }
__device__ __forceinline__ void p2_gate_item(const Frame& F, int item) {
    const int dh = item >> 7, c = item & 127, dir = dh >> 2, h = dh & 3, lane = F.lane;
    const int p0 = 128 * c + 2 * lane, t0 = dir ? (S - 1 - p0) : p0, t1 = dir ? (t0 - 1) : (t0 + 1);
    const bf16_t* pg = WSP(bf16_t, WS_PROJ) + C_GATE + dir * 8 + h;
    const float bi = FIN(4)[dir * 8 + h], bf = FIN(4)[dir * 8 + 4 + h];
    const float i0 = bflo((unsigned)pg[(size_t)t0 * INP]) + bi, f0 = bflo((unsigned)pg[(size_t)t0 * INP + 4]) + bf;
    const float i1 = bflo((unsigned)pg[(size_t)t1 * INP]) + bi, f1 = bflo((unsigned)pg[(size_t)t1 * INP + 4]) + bf;
    const float lf0 = logsigmoid_f(f0), lf1 = logsigmoid_f(f1);
    const float incl = wave_incl_scan_add(lf0 + lf1, lane);
    const float b1 = incl, b0 = incl - lf1;
    const float u0 = i0 - b0, u1 = i1 - b1;
    const float mincl = wave_incl_scan_max(fmaxf(u0, u1), lane);
    float mprevl = __shfl_up(mincl, 1); if (lane == 0) mprevl = -INFINITY;
    const float pm0 = fmaxf(mprevl, u0), pm1 = mincl;
    float* GB = (float*)(F.ws + WS_GATES + GO_B) + (size_t)dh * S; float* GU = (float*)(F.ws + WS_GATES + GO_U) + (size_t)dh * S; float* GPM = (float*)(F.ws + WS_GATES + GO_PM) + (size_t)dh * S;
    GB[t0] = b0; GB[t1] = b1; GU[t0] = u0; GU[t1] = u1; GPM[t0] = pm0; GPM[t1] = pm1;
    if (lane == 63) { ((float*)(F.ws + WS_GATES + GO_G))[dh * 128 + c] = b1; ((float*)(F.ws + WS_GATES + GO_PML))[dh * 128 + c] = pm1; }
}
__device__ __forceinline__ void ph_post(const Frame& F) {
    const int gw = F.vcu * NWAVES + F.wave, NGW = F.G * NWAVES;
    for (int it = gw; it < 1024; it += NGW) p2_gate_item(F, it);
    for (int it = gw; it < 4096; it += NGW) p2_conv_item(F, it);
    for (int t = gw; t < S; t += NGW) p2_qkv_token(F, t);
}

#define MFMA16(a, b, c) __builtin_amdgcn_mfma_f32_16x16x32_bf16((a), (b), (c), 0, 0, 0)
__device__ __forceinline__ bf16x8 frag_tr(LAS const unsigned char* base, int pitch, int k0, int x0, int lane) {
    const int g = lane >> 4, i = lane & 15;
    LAS const unsigned char* p = base + (k0 + 8 * g + (i >> 2)) * pitch + (x0 + 4 * (i & 3)) * 2;
    const s16x4 lo = __builtin_bit_cast(s16x4, __builtin_amdgcn_ds_read_tr16_b64_v4i16((LAS v4i16_t*)p));
    const s16x4 hi = __builtin_bit_cast(s16x4, __builtin_amdgcn_ds_read_tr16_b64_v4i16((LAS v4i16_t*)(p + 4 * pitch)));
    return (bf16x8){lo[0], lo[1], lo[2], lo[3], hi[0], hi[1], hi[2], hi[3]};
}
__device__ __forceinline__ bf16x8 frag_kc(LAS const unsigned char* base, int pitch, int x0, int k0, int lane) {
    return *(LAS const bf16x8*)(base + (x0 + (lane & 15)) * pitch + (k0 + 8 * (lane >> 4)) * 2);
}

constexpr int MLA_PK = 544, MLA_PV = 288;
constexpr int MLA_OFF_V = 128 * MLA_PK;
__device__ __forceinline__ void ph_mla(const Frame& F) {
    const int tid = F.tid, lane = F.lane, wave = F.wave;
    LAS unsigned char* Kw = F.lds; LAS unsigned char* Vs = F.lds + MLA_OFF_V;
    const float* GU = (const float*)(F.ws + WS_GATES + GO_U); const float* GPML = (const float*)(F.ws + WS_GATES + GO_PML);
    for (int item = F.vcu; item < 2048; item += F.G) {
        const int hv = item & 1, c = (item >> 1) & 127, dh = item >> 8, dir = dh >> 2, head = dh & 3;
        const int tc = dir ? 127 - c : c, t0 = tc * 128;
        const float pml = GPML[dh * 128 + c];
        {   const bf16_t* mk = WSP(bf16_t, WS_MK) + (size_t)t0 * 1024 + head * 256;
#pragma unroll
            for (int j = 0; j < 8; ++j) { const int r = (tid >> 5) + 16 * j, c8 = (tid & 31) * 8;
                const u32x4 x = *(const u32x4*)(mk + (size_t)r * 1024 + c8); const float w = __expf(GU[(size_t)dh * S + t0 + r] - pml);
                u32x4 o; o.x = pk2(bflo(x.x) * w, bfhi(x.x) * w); o.y = pk2(bflo(x.y) * w, bfhi(x.y) * w); o.z = pk2(bflo(x.z) * w, bfhi(x.z) * w); o.w = pk2(bflo(x.w) * w, bfhi(x.w) * w);
                *(LAS u32x4*)(Kw + r * MLA_PK + c8 * 2) = o; }
            const bf16_t* mv = WSP(bf16_t, WS_PROJ) + (size_t)t0 * INP + C_MV + head * 256 + hv * 128;
#pragma unroll
            for (int j = 0; j < 4; ++j) { const int r = (tid >> 4) + 32 * j, c8 = (tid & 15) * 8;
                *(LAS u32x4*)(Vs + r * MLA_PV + c8 * 2) = *(const u32x4*)(mv + (size_t)r * INP + c8); }
        }
        __syncthreads();
        f32x4 acc[4][4];
#pragma unroll
        for (int a = 0; a < 4; ++a)
#pragma unroll
            for (int b = 0; b < 4; ++b) acc[a][b] = (f32x4){0.f, 0.f, 0.f, 0.f};
        const int mb = (wave & 3) * 64, nb = (wave >> 2) * 64;
#pragma unroll
        for (int ks = 0; ks < 4; ++ks) {
            bf16x8 af[4], bfr[4];
#pragma unroll
            for (int a = 0; a < 4; ++a) af[a] = frag_tr(Kw, MLA_PK, 32 * ks, mb + 16 * a, lane);
#pragma unroll
            for (int b = 0; b < 4; ++b) bfr[b] = frag_tr(Vs, MLA_PV, 32 * ks, nb + 16 * b, lane);
#pragma unroll
            for (int a = 0; a < 4; ++a)
#pragma unroll
                for (int b = 0; b < 4; ++b) acc[a][b] = MFMA16(af[a], bfr[b], acc[a][b]);
        }
        {   bf16_t* cst = WSP(bf16_t, WS_CST) + ((size_t)(dh * 128 + c) << 16);
            const int g = lane >> 4, i = lane & 15;
#pragma unroll
            for (int a = 0; a < 4; ++a)
#pragma unroll
                for (int b = 0; b < 4; ++b) { u32x2 o; o.x = pk2(acc[a][b][0], acc[a][b][1]); o.y = pk2(acc[a][b][2], acc[a][b][3]);
                    *(u32x2*)(cst + (size_t)(hv * 128 + nb + 16 * b + i) * 256 + mb + 16 * a + 4 * g) = o; }
        }
        if (hv == 0 && tid < 256) { float s = 0.f;
#pragma unroll 8
            for (int r = 0; r < 128; ++r) s += bflo((unsigned)*(LAS const bf16_t*)(Kw + r * MLA_PK + tid * 2));
            ((float*)(F.ws + WS_NST))[(size_t)(dh * 128 + c) * 256 + tid] = s; }
        __syncthreads();
    }
}

__device__ __forceinline__ void ph_scan(const Frame& F) {
    const float* GG = (const float*)(F.ws + WS_GATES + GO_G); const float* GPML = (const float*)(F.ws + WS_GATES + GO_PML); float* MPREV = (float*)(F.ws + WS_GATES + GO_MPREV);
    const int nthreads = F.G * NTHR;
    for (int gi = F.vcu * NTHR + F.tid; gi < 8 * 16384; gi += nthreads) {
        const int dh = gi >> 14, e4 = gi & 16383;
        bf16_t* base = WSP(bf16_t, WS_CST) + ((size_t)dh * 128 << 16) + e4 * 4;
        float st0 = 0.f, st1 = 0.f, st2 = 0.f, st3 = 0.f, m = 0.f;
#pragma unroll 1
        for (int c0 = 0; c0 < 128; c0 += 32) {
            u32x2 ld[32];
#pragma unroll
            for (int q = 0; q < 32; ++q) ld[q] = *(const u32x2*)(base + ((size_t)(c0 + q) << 16));
#pragma unroll
            for (int q = 0; q < 32; ++q) { const int c = c0 + q;
                const float g = GG[dh * 128 + c], amax = g + GPML[dh * 128 + c];
                const float mn = fmaxf(g + m, amax), dec = __expf(g + m - mn), add = __expf(amax - mn);
                if (e4 == 0) MPREV[dh * 128 + c] = m;
                u32x2 o; o.x = pk2(st0, st1); o.y = pk2(st2, st3);
                *(u32x2*)(base + ((size_t)c << 16)) = o;
                st0 = dec * st0 + add * bflo(ld[q].x); st1 = dec * st1 + add * bfhi(ld[q].x); st2 = dec * st2 + add * bflo(ld[q].y); st3 = dec * st3 + add * bfhi(ld[q].y);
                m = mn; }
        }
    }
    for (int gi = F.vcu * NTHR + F.tid; gi < 8 * 256; gi += nthreads) {
        const int dh = gi >> 8, e = gi & 255;
        float* base = (float*)(F.ws + WS_NST) + (size_t)dh * 128 * 256 + e;
        float st = 0.f, m = 0.f;
#pragma unroll 4
        for (int c = 0; c < 128; ++c) {
            const float g = GG[dh * 128 + c], amax = g + GPML[dh * 128 + c];
            const float mn = fmaxf(g + m, amax), dec = __expf(g + m - mn), add = __expf(amax - mn);
            const float ld = base[c * 256]; base[c * 256] = st; st = dec * st + add * ld; m = mn; }
    }
}

constexpr int MLB_PIECE = 34816;
constexpr int MLB_PKC = 528, MLB_PTR = 544, MLB_PP = 272;
constexpr int MLB_OFF_P = 2 * MLB_PIECE;
constexpr int MLB_OFF_N = MLB_OFF_P + 2 * 8 * 16 * MLB_PP;
static_assert(MLB_OFF_N + 2048 <= LDSCTL_OFF, "mLSTM-B LDS map");
__device__ __forceinline__ void ph_mlb(const Frame& F) {
    const int wave = F.wave;
    const float* GB = (const float*)(F.ws + WS_GATES + GO_B); const float* GU = (const float*)(F.ws + WS_GATES + GO_U); const float* GPM = (const float*)(F.ws + WS_GATES + GO_PM);
    const float* MPREV = (const float*)(F.ws + WS_GATES + GO_MPREV);
    LAS unsigned char* buf0 = F.lds; LAS unsigned char* buf1 = F.lds + MLB_PIECE;
    LAS float* nprev = (LAS float*)(F.lds + MLB_OFF_N);
    for (int unit = F.vcu; unit < 512; unit += F.G) {
        int tid = F.tid; asm volatile("" : "+v"(tid));
        const int lane = tid & 63, g = lane >> 4, i = lane & 15;
        const int head = unit >> 7, tc = unit & 127, t0 = tc * 128, j0 = 16 * wave;
        const bf16_t* mkp = WSP(bf16_t, WS_MK) + (size_t)t0 * 1024 + head * 256;
        const bf16_t* mvp = WSP(bf16_t, WS_PROJ) + (size_t)t0 * INP + C_MV + head * 256;
        const int c_f = tc, c_b = 127 - tc;
        u32x4 stg[4];
        const int sr = tid >> 5, sc8 = (tid & 31) * 8;
#define PIECE_LOAD(srcp, pitch_el) do { _Pragma("unroll") for (int q_ = 0; q_ < 4; ++q_) stg[q_] = *(const u32x4*)((srcp) + (size_t)(sr + 16 * q_) * (pitch_el) + sc8); } while (0)
#define PIECE_WRITE(dstbuf, pitchB) do { _Pragma("unroll") for (int q_ = 0; q_ < 4; ++q_) *(LAS u32x4*)((dstbuf) + (sr + 16 * q_) * (pitchB) + sc8 * 2) = stg[q_]; } while (0)
        { const int d = tid >> 8, e = tid & 255; nprev[d * 256 + e] = ((const float*)(F.ws + WS_NST))[(size_t)((d * 4 + head) * 128 + (d ? c_b : c_f)) * 256 + e]; }
        bf16x8 qa[8];
        {   const bf16_t* mq = WSP(bf16_t, WS_MQ) + (size_t)(t0 + j0 + i) * 1024 + head * 256 + 8 * g;
#pragma unroll
            for (int s = 0; s < 8; ++s) qa[s] = *(const bf16x8*)(mq + 32 * s); }
        f32x4 sacc[8];
#pragma unroll
        for (int n = 0; n < 8; ++n) sacc[n] = (f32x4){0.f, 0.f, 0.f, 0.f};
        PIECE_LOAD(mkp, 1024); PIECE_WRITE(buf0, MLB_PKC);
        PIECE_LOAD(mkp + (size_t)64 * 1024, 1024);
        __syncthreads();
#pragma unroll
        for (int n = 0; n < 4; ++n)
            { _Pragma("unroll") for (int s = 0; s < 8; ++s) sacc[n] = MFMA16(qa[s], frag_kc(buf0, MLB_PKC, 16 * n, 32 * s, lane), sacc[n]); __builtin_amdgcn_sched_barrier(0); }
        PIECE_WRITE(buf1, MLB_PKC);
        __syncthreads();
#pragma unroll
        for (int n = 0; n < 4; ++n)
            { _Pragma("unroll") for (int s = 0; s < 8; ++s) sacc[4 + n] = MFMA16(qa[s], frag_kc(buf1, MLB_PKC, 16 * n, 32 * s, lane), sacc[4 + n]); __builtin_amdgcn_sched_barrier(0); }
        const bf16_t* cst0 = WSP(bf16_t, WS_CST) + ((size_t)((0 * 4 + head) * 128 + c_f) << 16);
        const bf16_t* cst1 = WSP(bf16_t, WS_CST) + ((size_t)((1 * 4 + head) * 128 + c_b) << 16);
        PIECE_LOAD(cst0, 256);
        float qsc0, qsc1;
#pragma unroll
        for (int d = 0; d < 2; ++d) {
            const int dh = d * 4 + head; const float mp = MPREV[dh * 128 + (d ? c_b : c_f)];
            f32x4 dacc = (f32x4){0.f, 0.f, 0.f, 0.f};
#pragma unroll
            for (int s = 0; s < 8; ++s) { bf16x8 bn; const LAS float* np = nprev + d * 256 + 32 * s + 8 * g;
#pragma unroll
                for (int e = 0; e < 8; ++e) bn[e] = (i == 0) ? (short)f2bf(np[e]) : (short)0;
                dacc = MFMA16(qa[s], bn, dacc); }
            float ur[8];
#pragma unroll
            for (int n = 0; n < 8; ++n) ur[n] = GU[(size_t)dh * S + t0 + 16 * n + i];
            LAS unsigned char* pw = F.lds + MLB_OFF_P + (d * 8 + wave) * (16 * MLB_PP);
            float es[4];
#pragma unroll
            for (int rg = 0; rg < 4; ++rg) { const int jl = 4 * g + rg, j = j0 + jl;
                const float M = fmaxf(mp, GPM[(size_t)dh * S + t0 + j]), ej = __expf(mp - M), mj = GB[(size_t)dh * S + t0 + j] + M;
                float rs = 0.f;
#pragma unroll
                for (int n = 0; n < 8; ++n) { const int r = 16 * n + i; const bool keep = d ? (r >= j) : (r <= j); rs += keep ? sacc[n][rg] * __expf(ur[n] - M) : 0.f; }
                rs += __shfl_xor(rs, 1); rs += __shfl_xor(rs, 2); rs += __shfl_xor(rs, 4); rs += __shfl_xor(rs, 8);
                const float qn = __shfl(dacc[rg], lane & 48);
                const float den = ej * qn + rs, sj = 1.0f / fmaxf(fabsf(den), __expf(-mj));
                es[rg] = ej * sj;
#pragma unroll
                for (int n = 0; n < 8; ++n) { const int r = 16 * n + i; const bool keep = d ? (r >= j) : (r <= j);
                    const float p = keep ? sacc[n][rg] * __expf(ur[n] - M) * sj : 0.f;
                    *(LAS bf16_t*)(pw + jl * MLB_PP + r * 2) = (bf16_t)f2bf(p); } }
            const int srcl = (i >> 2) << 4;
            const float t0_ = __shfl(es[0], srcl), t1_ = __shfl(es[1], srcl), t2_ = __shfl(es[2], srcl), t3_ = __shfl(es[3], srcl);
            const float qs_ = (i & 3) == 0 ? t0_ : (i & 3) == 1 ? t1_ : (i & 3) == 2 ? t2_ : t3_;
            if (d == 0) qsc0 = qs_; else qsc1 = qs_;
        }
        __syncthreads();
        f32x4 hacc[16];
#pragma unroll
        for (int n = 0; n < 16; ++n) hacc[n] = (f32x4){0.f, 0.f, 0.f, 0.f};
#pragma unroll
        for (int d = 0; d < 2; ++d) {
            const bf16_t* cst = d ? cst1 : cst0; const float qsc = d ? qsc1 : qsc0;
            bf16x8 qs[8];
#pragma unroll
            for (int s = 0; s < 8; ++s) { const u32x4 w = __builtin_bit_cast(u32x4, qa[s]); u32x4 o;
                o.x = pk2(bflo(w.x) * qsc, bfhi(w.x) * qsc); o.y = pk2(bflo(w.y) * qsc, bfhi(w.y) * qsc); o.z = pk2(bflo(w.z) * qsc, bfhi(w.z) * qsc); o.w = pk2(bflo(w.w) * qsc, bfhi(w.w) * qsc);
                qs[s] = __builtin_bit_cast(bf16x8, o); }
#pragma unroll
            for (int cp = 0; cp < 4; ++cp) {
                LAS unsigned char* cur = (cp & 1) ? buf1 : buf0;
                PIECE_WRITE(cur, MLB_PKC);
                if (cp < 3) PIECE_LOAD(cst + (size_t)(64 * (cp + 1)) * 256, 256); else PIECE_LOAD(mvp, INP);
                __syncthreads();
#pragma unroll
                for (int n = 0; n < 4; ++n)
                    { _Pragma("unroll") for (int s = 0; s < 8; ++s) hacc[4 * cp + n] = MFMA16(qs[s], frag_kc(cur, MLB_PKC, 16 * n, 32 * s, lane), hacc[4 * cp + n]); __builtin_amdgcn_sched_barrier(0); }
            }
            LAS const unsigned char* pw = F.lds + MLB_OFF_P + (d * 8 + wave) * (16 * MLB_PP);
#pragma unroll
            for (int vp = 0; vp < 2; ++vp) {
                LAS unsigned char* cur = (vp & 1) ? buf1 : buf0;
                PIECE_WRITE(cur, MLB_PTR);
                if (vp == 0) PIECE_LOAD(mvp + (size_t)64 * INP, INP); else if (d == 0) PIECE_LOAD(cst1, 256);
                __syncthreads();
#pragma unroll
                for (int ks = 0; ks < 2; ++ks) { const bf16x8 a = *(LAS const bf16x8*)(pw + i * MLB_PP + (64 * vp + 32 * ks + 8 * g) * 2);
#pragma unroll
                    for (int n = 0; n < 16; ++n) { hacc[n] = MFMA16(a, frag_tr(cur, MLB_PTR, 32 * ks, 16 * n, lane), hacc[n]); if ((n & 3) == 3) __builtin_amdgcn_sched_barrier(0); } }
            }
            __syncthreads();
        }
        {   const float* mg = FIN(8) + head * 256;
            const bf16_t* mo = WSP(bf16_t, WS_PROJ) + C_MO + head * 256; bf16_t* y = WSP(bf16_t, WS_Y) + 1024 + head * 256;
#pragma unroll
            for (int rg = 0; rg < 4; ++rg) { float ss = 0.f;
#pragma unroll
                for (int n = 0; n < 16; ++n) ss += hacc[n][rg] * hacc[n][rg];
                ss += __shfl_xor(ss, 1); ss += __shfl_xor(ss, 2); ss += __shfl_xor(ss, 4); ss += __shfl_xor(ss, 8);
                const float r = 1.0f / sqrtf(ss * (1.f / 256.f) + EPS); const size_t t = (size_t)(t0 + j0 + 4 * g + rg);
#pragma unroll
                for (int n = 0; n < 16; ++n) { const int col = 16 * n + i; const float o = bflo((unsigned)mo[t * INP + col]);
                    #if defined(DBG_ZERO_ML)
                    y[t * DM + col] = 0;
#else
                    y[t * DM + col] = (bf16_t)f2bf(hacc[n][rg] * r * mg[col] * (1.f / (1.f + __expf(-o))));
#endif
                    } }
        }
#undef PIECE_LOAD
#undef PIECE_WRITE
    }
}

#define MFMA32(a, b, c) __builtin_amdgcn_mfma_f32_32x32x16_bf16((a), (b), (c), 0, 0, 0)
__device__ __forceinline__ int fkey(float x) { const int b = __builtin_bit_cast(int, x); return b ^ ((b >> 31) & 0x7fffffff); }
__device__ __forceinline__ float kval(int k) { return __builtin_bit_cast(float, k ^ ((k >> 31) & 0x7fffffff)); }
#define TOP_INS(top, x) do { int x_ = (x); _Pragma("unroll") for (int k_ = 0; k_ < 16; ++k_) { const int hi_ = max(top[k_], x_); x_ = min(top[k_], x_); top[k_] = hi_; } } while (0)
__device__ __forceinline__ int pick4(int sel, int a, int b, int c, int d) { return sel == 0 ? a : sel == 1 ? b : sel == 2 ? c : d; }
__device__ __forceinline__ void topk_item(const Frame& F, int layer, int item) {
    const int tile = item >> 3, h = item & 7, lane = F.lane, r32 = lane & 31, hi = lane >> 5;
    const int t = tile * 32 + r32;
    const bf16_t* qrow = WSP(bf16_t, WS_QP) + (size_t)t * DM + h * 256 + 8 * hi;
    int tops[2][16];
#pragma unroll
    for (int p = 0; p < 2; ++p) {
        const bf16_t* keys = WSP(bf16_t, WS_KEYS) + (size_t)(((layer * 8 + h) * 2 + p) * 128) * 128 + 8 * hi;
        bf16x8 bq[8];
#pragma unroll
        for (int s = 0; s < 8; ++s) bq[s] = *(const bf16x8*)(qrow + p * 128 + 16 * s);
        int top[16];
#pragma unroll
        for (int k = 0; k < 16; ++k) top[k] = (int)0x80000000;
#pragma unroll
        for (int kt = 0; kt < 4; ++kt) {
            f32x16 acc = {};
#pragma unroll
            for (int s = 0; s < 8; ++s) { const bf16x8 a = *(const bf16x8*)(keys + (size_t)(32 * kt + r32) * 128 + 16 * s); acc = MFMA32(a, bq[s], acc); }
#pragma unroll
            for (int r = 0; r < 16; ++r) { const int idx = 32 * kt + (r & 3) + 8 * (r >> 2) + 4 * hi; TOP_INS(top, (fkey(acc[r]) & ~127) | idx); }
        }
        int pt[16];
#pragma unroll
        for (int k = 0; k < 16; ++k) pt[k] = __shfl_xor(top[k], 32);
#pragma unroll
        for (int k = 0; k < 16; ++k) TOP_INS(top, pt[k]);
#pragma unroll
        for (int k = 0; k < 16; ++k) tops[p][k] = top[k];
    }
    float af[16], bfv[16];
#pragma unroll
    for (int k = 0; k < 16; ++k) { af[k] = kval(tops[0][k] & ~127); bfv[k] = kval(tops[1][k] & ~127); }
    int top2[16];
#pragma unroll
    for (int k = 0; k < 16; ++k) top2[k] = (int)0x80000000;
#pragma unroll
    for (int i = 0; i < 16; ++i)
#pragma unroll
        for (int j = 0; j < 16; ++j) if ((i + 1) * (j + 1) <= 16) TOP_INS(top2, (fkey(af[i] + bfv[j]) & ~255) | (i << 4) | j);
    int pa[4], pb[4];
#pragma unroll
    for (int q = 0; q < 4; ++q) { pa[q] = (tops[0][4 * q] & 127) | ((tops[0][4 * q + 1] & 127) << 8) | ((tops[0][4 * q + 2] & 127) << 16) | ((tops[0][4 * q + 3] & 127) << 24);
                                  pb[q] = (tops[1][4 * q] & 127) | ((tops[1][4 * q + 1] & 127) << 8) | ((tops[1][4 * q + 2] & 127) << 16) | ((tops[1][4 * q + 3] & 127) << 24); }
    int ex[16]; float sc[16];
#pragma unroll
    for (int k = 0; k < 16; ++k) { const int code = top2[k] & 255, ii = code >> 4, jj = code & 15;
        const int ea = (pick4(ii >> 2, pa[0], pa[1], pa[2], pa[3]) >> ((ii & 3) * 8)) & 127, eb = (pick4(jj >> 2, pb[0], pb[1], pb[2], pb[3]) >> ((jj & 3) * 8)) & 127;
        ex[k] = ea * 128 + eb; sc[k] = kval(top2[k] & ~255); }
    const float mx = sc[0]; float sum = 0.f;
#pragma unroll
    for (int k = 0; k < 16; ++k) { sc[k] = __expf(sc[k] - mx); sum += sc[k]; }
    const float inv = 1.0f / sum;
    if (hi == 0) { int* d = WSP(int, WS_EIDX) + (size_t)t * 128 + h * 16;
#pragma unroll
        for (int q = 0; q < 4; ++q) *(u32x4*)(d + 4 * q) = (u32x4){(unsigned)ex[4 * q], (unsigned)ex[4 * q + 1], (unsigned)ex[4 * q + 2], (unsigned)ex[4 * q + 3]}; }
    else { float* d = WSP(float, WS_EGATE) + (size_t)t * 128 + h * 16;
#pragma unroll
        for (int q = 0; q < 4; ++q) *(f32x4*)(d + 4 * q) = (f32x4){sc[4 * q] * inv, sc[4 * q + 1] * inv, sc[4 * q + 2] * inv, sc[4 * q + 3] * inv}; }
}
__device__ __forceinline__ void ph_topk(const Frame& F, int layer) {
    const int gw = F.vcu * NWAVES + F.wave, NGW = F.G * NWAVES;
    for (int it = gw; it < 4096; it += NGW) topk_item(F, layer, it);
}

typedef __bf16 bf2 __attribute__((ext_vector_type(2)));
__device__ __forceinline__ float dot2bf(bf2 a, unsigned b, float c) { return __builtin_amdgcn_fdot2_f32_bf16(a, __builtin_bit_cast(bf2, b), c, false); }
__device__ __forceinline__ float dot4_fp8(unsigned w, unsigned xlo, unsigned xhi, float c) {
    c = dot2bf(__builtin_amdgcn_cvt_scalef32_pk_bf16_fp8(w, 1.0f, false), xlo, c);
    return dot2bf(__builtin_amdgcn_cvt_scalef32_pk_bf16_fp8(w, 1.0f, true), xhi, c);
}
#if TBL_FP4
constexpr int NSL = 8;
constexpr size_t WS_PART = WS_CST;
constexpr size_t WS_W = WS_KVB;
__device__ __forceinline__ float dot8_fp4(unsigned w, u32x4 x, float c) {
    c = dot2bf(__builtin_amdgcn_cvt_scalef32_pk_bf16_fp4(w, 1.0f, 0), x.x, c); c = dot2bf(__builtin_amdgcn_cvt_scalef32_pk_bf16_fp4(w, 1.0f, 1), x.y, c);
    c = dot2bf(__builtin_amdgcn_cvt_scalef32_pk_bf16_fp4(w, 1.0f, 2), x.z, c); return dot2bf(__builtin_amdgcn_cvt_scalef32_pk_bf16_fp4(w, 1.0f, 3), x.w, c);
}
__device__ __forceinline__ void ph_gu(const Frame& F, int layer) {
    const int lane = F.lane, r8 = lane >> 3, c16 = lane & 7;
    const int nper = F.G >> 3, xl = F.vcu / nper, wx = (F.vcu % nper) * NWAVES + F.wave, nwx = nper * NWAVES;
    const int s = xl;
    const unsigned char* Us = F.ws + WS_UB + (size_t)layer * (16384 * 1024) + (size_t)s * (16384 * 128);
    const unsigned char* eb = F.ws + WS_EIDX; unsigned char* pb = F.ws + WS_PART + (size_t)s * S * 512; const unsigned char* xb = F.ws + WS_XN + s * 512;
    const unsigned eo = 64u * r8, po = 8u * lane, xo = 64u * c16, uo = 16u * c16;
#define LDU(T, base, off) (*(const T*)((base) + (unsigned)(off)))
    u32x4 ia[2][4];
#pragma unroll
    for (int q = 0; q < 4; ++q) { ia[0][q] = LDU(u32x4, eb, (unsigned)wx * 512u + eo + 16u * q); ia[1][q] = LDU(u32x4, eb, (unsigned)(wx + nwx) * 512u + eo + 16u * q); }
#pragma unroll 1
    for (int t = wx; t < S; t += 2 * nwx) {
        const int t1 = t + nwx;
        u32x4 ur[2][16];
#pragma unroll
        for (int z = 0; z < 2; ++z)
#pragma unroll
            for (int q = 0; q < 16; ++q) { const unsigned id = ia[z][q >> 2][q & 3]; ur[z][q] = LDU(u32x4, Us, id * 128u + uo); }
        { const int tn = (t + 2 * nwx < S) ? t + 2 * nwx : t;
#pragma unroll
          for (int q = 0; q < 4; ++q) { ia[0][q] = LDU(u32x4, eb, (unsigned)tn * 512u + eo + 16u * q); ia[1][q] = LDU(u32x4, eb, (unsigned)(tn + nwx) * 512u + eo + 16u * q); } }
#pragma unroll
        for (int z = 0; z < 2; ++z) {
            const unsigned xoff = (unsigned)(z ? t1 : t) * 4096u + xo; const u32x4 x0 = LDU(u32x4, xb, xoff), x1 = LDU(u32x4, xb, xoff + 16u), x2 = LDU(u32x4, xb, xoff + 32u), x3 = LDU(u32x4, xb, xoff + 48u);
            float v[16];
#pragma unroll
            for (int q = 0; q < 16; ++q) { const u32x4 w = ur[z][q]; float a = dot8_fp4(w.x, x0, 0.f); a = dot8_fp4(w.y, x1, a); a = dot8_fp4(w.z, x2, a); v[q] = dot8_fp4(w.w, x3, a); }
            float r8v[8], r4v[4], r2v[2];
            { const bool up = lane & 4;
#pragma unroll
              for (int q = 0; q < 8; ++q) { const float keep = up ? v[q + 8] : v[q], give = up ? v[q] : v[q + 8]; r8v[q] = keep + __shfl_xor(give, 4); } }
            { const bool up = lane & 2;
#pragma unroll
              for (int q = 0; q < 4; ++q) { const float keep = up ? r8v[q + 4] : r8v[q], give = up ? r8v[q] : r8v[q + 4]; r4v[q] = keep + __shfl_xor(give, 2); } }
            { const bool up = lane & 1;
#pragma unroll
              for (int q = 0; q < 2; ++q) { const float keep = up ? r4v[q + 2] : r4v[q], give = up ? r4v[q] : r4v[q + 2]; r2v[q] = keep + __shfl_xor(give, 1); } }
            *(f32x2*)(pb + ((unsigned)(z ? t1 : t) * 512u + po)) = (f32x2){r2v[0], r2v[1]};
        }
    }
}
__device__ __forceinline__ void ph_act(const Frame& F, int layer) {
    const int lane = F.lane, gw = F.vcu * NWAVES + F.wave, NGW = F.G * NWAVES;
    const float* su = (const float*)(F.ws + WS_TSC) + layer * 16384; const float* sv = su + 32768;
    for (int t = gw; t < S; t += NGW) {
        const float* part = WSP(float, WS_PART) + (size_t)t * 128 + 2 * lane;
        f32x2 a = {0.f, 0.f};
#pragma unroll
        for (int s = 0; s < NSL; ++s) a += *(const f32x2*)(part + (size_t)s * S * 128);
        const u32x2 id = *(const u32x2*)(WSP(int, WS_EIDX) + (size_t)t * 128 + 2 * lane); const f32x2 g = *(const f32x2*)(WSP(float, WS_EGATE) + (size_t)t * 128 + 2 * lane);
        const float a0 = a.x * su[id.x], a1 = a.y * su[id.y];
        const float w0 = 0.5f * a0 * (1.f + erff(a0 * 0.70710678118654752f)) * g.x * sv[id.x], w1 = 0.5f * a1 * (1.f + erff(a1 * 0.70710678118654752f)) * g.y * sv[id.y];
        *(f32x2*)(WSP(float, WS_W) + (size_t)t * 128 + 2 * lane) = (f32x2){w0, w1};
    }
}
__device__ __forceinline__ void ph_gv(const Frame& F, int layer) {
    const int lane = F.lane, r8 = lane >> 3, c16 = lane & 7;
    const int nper = F.G >> 3, xl = F.vcu / nper, wx = (F.vcu % nper) * NWAVES + F.wave, nwx = nper * NWAVES;
    const int s = xl;
    const unsigned char* Vs = F.ws + WS_VB + (size_t)layer * (16384 * 1024) + (size_t)s * (16384 * 128);
    const unsigned char* eb = F.ws + WS_EIDX; const unsigned char* wb = F.ws + WS_W; unsigned char* hb = F.ws + WS_H + s * 1024;
    const unsigned eo = 64u * r8, ho = 128u * c16 + 16u * r8, vo = 16u * c16;
    u32x4 ia[2][4];
#pragma unroll
    for (int q = 0; q < 4; ++q) { ia[0][q] = LDU(u32x4, eb, (unsigned)wx * 512u + eo + 16u * q); ia[1][q] = LDU(u32x4, eb, (unsigned)(wx + nwx) * 512u + eo + 16u * q); }
#pragma unroll 1
    for (int t = wx; t < S; t += 2 * nwx) {
        const int t1 = t + nwx;
        u32x4 vr[2][16];
#pragma unroll
        for (int z = 0; z < 2; ++z)
#pragma unroll
            for (int q = 0; q < 16; ++q) { const unsigned id = ia[z][q >> 2][q & 3]; vr[z][q] = LDU(u32x4, Vs, id * 128u + vo); }
        { const int tn = (t + 2 * nwx < S) ? t + 2 * nwx : t;
#pragma unroll
          for (int q = 0; q < 4; ++q) { ia[0][q] = LDU(u32x4, eb, (unsigned)tn * 512u + eo + 16u * q); ia[1][q] = LDU(u32x4, eb, (unsigned)(tn + nwx) * 512u + eo + 16u * q); } }
        f32x4 wqa[2][4]; f32x4 hold[2];
#pragma unroll
        for (int z = 0; z < 2; ++z) { const unsigned tt = (unsigned)(z ? t1 : t);
#pragma unroll
            for (int q = 0; q < 4; ++q) wqa[z][q] = LDU(f32x4, wb, tt * 512u + eo + 16u * q);
            hold[z] = LDU(f32x4, hb, tt * 8192u + ho); }
#pragma unroll
        for (int z = 0; z < 2; ++z) {
            const unsigned tt = (unsigned)(z ? t1 : t);
            f32x2 acc[16];
#pragma unroll
            for (int e = 0; e < 16; ++e) acc[e] = (f32x2){0.f, 0.f};
#pragma unroll
            for (int q = 0; q < 16; ++q) { const float w = wqa[z][q >> 2][q & 3]; const f32x2 ww = {w, w}; const unsigned d4[4] = {vr[z][q].x, vr[z][q].y, vr[z][q].z, vr[z][q].w};
#pragma unroll
                for (int e = 0; e < 4; ++e) { acc[4 * e] += ww * __builtin_amdgcn_cvt_scalef32_pk_f32_fp4(d4[e], 1.0f, 0); acc[4 * e + 1] += ww * __builtin_amdgcn_cvt_scalef32_pk_f32_fp4(d4[e], 1.0f, 1);
                    acc[4 * e + 2] += ww * __builtin_amdgcn_cvt_scalef32_pk_f32_fp4(d4[e], 1.0f, 2); acc[4 * e + 3] += ww * __builtin_amdgcn_cvt_scalef32_pk_f32_fp4(d4[e], 1.0f, 3); } }
            f32x2 b8[8], b4[4], b2[2];
            { const bool up = lane & 32;
#pragma unroll
              for (int e = 0; e < 8; ++e) { const f32x2 keep = up ? acc[e + 8] : acc[e], give = up ? acc[e] : acc[e + 8]; b8[e] = keep + (f32x2){__shfl_xor(give.x, 32), __shfl_xor(give.y, 32)}; } }
            { const bool up = lane & 16;
#pragma unroll
              for (int e = 0; e < 4; ++e) { const f32x2 keep = up ? b8[e + 4] : b8[e], give = up ? b8[e] : b8[e + 4]; b4[e] = keep + (f32x2){__shfl_xor(give.x, 16), __shfl_xor(give.y, 16)}; } }
            { const bool up = lane & 8;
#pragma unroll
              for (int e = 0; e < 2; ++e) { const f32x2 keep = up ? b4[e + 2] : b4[e], give = up ? b4[e] : b4[e + 2]; b2[e] = keep + (f32x2){__shfl_xor(give.x, 8), __shfl_xor(give.y, 8)}; } }
#if defined(DBG_ZERO_PEER)
            b2[0] = (f32x2){0.f, 0.f}; b2[1] = b2[0];
#endif
            *(f32x4*)(hb + (tt * 8192u + ho)) = hold[z] + (f32x4){b2[0].x, b2[0].y, b2[1].x, b2[1].y};
        }
    }
}
#else
constexpr int NSL = 16;
constexpr size_t WS_PART = WS_CST;
constexpr size_t WS_W = WS_KVB;
__device__ __forceinline__ void ph_gu(const Frame& F, int layer) {
    const int lane = F.lane, r8 = lane >> 3, c16 = lane & 7;
    const int nper = F.G >> 3, xl = F.vcu / nper, wx = (F.vcu % nper) * NWAVES + F.wave, nwx = nper * NWAVES;
    const unsigned char* U = F.ws + WS_UB + (size_t)layer * 16384 * 2048 + c16 * 16;
    const int* eidx = WSP(int, WS_EIDX) + 16 * r8;
#pragma unroll 1
    for (int p = 0; p < 2; ++p) {
        const int s = xl + 8 * p;
        const unsigned char* Us = U + (size_t)s * (16384 * 128);
        float* part = WSP(float, WS_PART) + (size_t)s * S * 128 + 2 * lane;
        const bf16_t* xs = WSP(bf16_t, WS_XN) + s * 128 + c16 * 16;
        u32x4 ia[2][4];
#pragma unroll
        for (int q = 0; q < 4; ++q) { ia[0][q] = *(const u32x4*)(eidx + (size_t)wx * 128 + 4 * q); ia[1][q] = *(const u32x4*)(eidx + (size_t)(wx + nwx) * 128 + 4 * q); }
#pragma unroll 1
        for (int t = wx; t < S; t += 2 * nwx) {
            const int t1 = t + nwx;
            u32x4 ur[2][16];
#pragma unroll
            for (int z = 0; z < 2; ++z)
#pragma unroll
                for (int q = 0; q < 16; ++q) { const unsigned id = ia[z][q >> 2][q & 3]; ur[z][q] = *(const u32x4*)(Us + (size_t)id * 128); }
            { const int tn = (t + 2 * nwx < S) ? t + 2 * nwx : t;
#pragma unroll
              for (int q = 0; q < 4; ++q) { ia[0][q] = *(const u32x4*)(eidx + (size_t)tn * 128 + 4 * q); ia[1][q] = *(const u32x4*)(eidx + (size_t)(tn + nwx) * 128 + 4 * q); } }
#pragma unroll
            for (int z = 0; z < 2; ++z) {
                const bf16_t* xr = xs + (size_t)(z ? t1 : t) * DM; const u32x4 x0 = *(const u32x4*)xr, x1 = *(const u32x4*)(xr + 8);
                float v[16];
#pragma unroll
                for (int q = 0; q < 16; ++q) { const u32x4 w = ur[z][q]; float a = dot4_fp8(w.x, x0.x, x0.y, 0.f); a = dot4_fp8(w.y, x0.z, x0.w, a); a = dot4_fp8(w.z, x1.x, x1.y, a); v[q] = dot4_fp8(w.w, x1.z, x1.w, a); }
                float r8v[8], r4v[4], r2v[2];
                { const bool up = lane & 4;
#pragma unroll
                  for (int q = 0; q < 8; ++q) { const float keep = up ? v[q + 8] : v[q], give = up ? v[q] : v[q + 8]; r8v[q] = keep + __shfl_xor(give, 4); } }
                { const bool up = lane & 2;
#pragma unroll
                  for (int q = 0; q < 4; ++q) { const float keep = up ? r8v[q + 4] : r8v[q], give = up ? r8v[q] : r8v[q + 4]; r4v[q] = keep + __shfl_xor(give, 2); } }
                { const bool up = lane & 1;
#pragma unroll
                  for (int q = 0; q < 2; ++q) { const float keep = up ? r4v[q + 2] : r4v[q], give = up ? r4v[q] : r4v[q + 2]; r2v[q] = keep + __shfl_xor(give, 1); } }
                *(f32x2*)(part + (size_t)(z ? t1 : t) * 128) = (f32x2){r2v[0], r2v[1]};
            }
        }
    }
}
__device__ __forceinline__ void ph_act(const Frame& F, int layer) {
    const int lane = F.lane, gw = F.vcu * NWAVES + F.wave, NGW = F.G * NWAVES;
    const float* su = (const float*)(F.ws + WS_TSC) + layer * 16384; const float* sv = su + 32768;
    for (int t = gw; t < S; t += NGW) {
        const float* part = WSP(float, WS_PART) + (size_t)t * 128 + 2 * lane;
        f32x2 a = {0.f, 0.f};
#pragma unroll
        for (int s = 0; s < NSL; ++s) a += *(const f32x2*)(part + (size_t)s * S * 128);
        const u32x2 id = *(const u32x2*)(WSP(int, WS_EIDX) + (size_t)t * 128 + 2 * lane); const f32x2 g = *(const f32x2*)(WSP(float, WS_EGATE) + (size_t)t * 128 + 2 * lane);
        const float a0 = a.x * su[id.x], a1 = a.y * su[id.y];
        const float w0 = 0.5f * a0 * (1.f + erff(a0 * 0.70710678118654752f)) * g.x * sv[id.x], w1 = 0.5f * a1 * (1.f + erff(a1 * 0.70710678118654752f)) * g.y * sv[id.y];
        *(f32x2*)(WSP(float, WS_W) + (size_t)t * 128 + 2 * lane) = (f32x2){w0, w1};
    }
}
__device__ __forceinline__ void ph_gv(const Frame& F, int layer) {
    const int lane = F.lane, r8 = lane >> 3, c16 = lane & 7;
    const int nper = F.G >> 3, xl = F.vcu / nper, wx = (F.vcu % nper) * NWAVES + F.wave, nwx = nper * NWAVES;
    const unsigned char* V = F.ws + WS_VB + (size_t)layer * 16384 * 2048 + c16 * 16;
    const int* eidx = WSP(int, WS_EIDX) + 16 * r8; const float* wv = WSP(float, WS_W) + 16 * r8;
#pragma unroll 1
    for (int p = 0; p < 2; ++p) {
        const int s = xl + 8 * p;
        const unsigned char* Vs = V + (size_t)s * (16384 * 128);
        float* hs = WSP(float, WS_H) + s * 128 + 16 * c16 + 2 * r8;
        u32x4 ia[2][4];
#pragma unroll
        for (int q = 0; q < 4; ++q) { ia[0][q] = *(const u32x4*)(eidx + (size_t)wx * 128 + 4 * q); ia[1][q] = *(const u32x4*)(eidx + (size_t)(wx + nwx) * 128 + 4 * q); }
#pragma unroll 1
        for (int t = wx; t < S; t += 2 * nwx) {
            const int t1 = t + nwx;
            u32x4 vr[2][16];
#pragma unroll
            for (int z = 0; z < 2; ++z)
#pragma unroll
                for (int q = 0; q < 16; ++q) { const unsigned id = ia[z][q >> 2][q & 3]; vr[z][q] = *(const u32x4*)(Vs + (size_t)id * 128); }
            { const int tn = (t + 2 * nwx < S) ? t + 2 * nwx : t;
#pragma unroll
              for (int q = 0; q < 4; ++q) { ia[0][q] = *(const u32x4*)(eidx + (size_t)tn * 128 + 4 * q); ia[1][q] = *(const u32x4*)(eidx + (size_t)(tn + nwx) * 128 + 4 * q); } }
            f32x4 wqa[2][4]; f32x2 hold[2];
#pragma unroll
            for (int z = 0; z < 2; ++z) { const size_t tt = (size_t)(z ? t1 : t);
#pragma unroll
                for (int q = 0; q < 4; ++q) wqa[z][q] = *(const f32x4*)(wv + tt * 128 + 4 * q);
                hold[z] = *(const f32x2*)(hs + tt * DM); }
#pragma unroll
            for (int z = 0; z < 2; ++z) {
                const size_t tt = (size_t)(z ? t1 : t);
                f32x4 wq[4];
#pragma unroll
                for (int q = 0; q < 4; ++q) wq[q] = wqa[z][q];
                f32x2 acc[8];
#pragma unroll
                for (int e = 0; e < 8; ++e) acc[e] = (f32x2){0.f, 0.f};
#pragma unroll
                for (int q = 0; q < 16; ++q) { const float w = wq[q >> 2][q & 3]; const f32x2 ww = {w, w}; const unsigned d4[4] = {vr[z][q].x, vr[z][q].y, vr[z][q].z, vr[z][q].w};
#pragma unroll
                    for (int e = 0; e < 4; ++e) { acc[2 * e] += ww * __builtin_amdgcn_cvt_pk_f32_fp8(d4[e], false); acc[2 * e + 1] += ww * __builtin_amdgcn_cvt_pk_f32_fp8(d4[e], true); } }
                f32x2 b4[4], b2[2], b1;
                { const bool up = lane & 32;
#pragma unroll
                  for (int e = 0; e < 4; ++e) { const f32x2 keep = up ? acc[e + 4] : acc[e], give = up ? acc[e] : acc[e + 4]; b4[e] = keep + (f32x2){__shfl_xor(give.x, 32), __shfl_xor(give.y, 32)}; } }
                { const bool up = lane & 16;
#pragma unroll
                  for (int e = 0; e < 2; ++e) { const f32x2 keep = up ? b4[e + 2] : b4[e], give = up ? b4[e] : b4[e + 2]; b2[e] = keep + (f32x2){__shfl_xor(give.x, 16), __shfl_xor(give.y, 16)}; } }
                { const bool up = lane & 8; const f32x2 keep = up ? b2[1] : b2[0], give = up ? b2[0] : b2[1]; b1 = keep + (f32x2){__shfl_xor(give.x, 8), __shfl_xor(give.y, 8)}; }
#if defined(DBG_ZERO_PEER)
                b1 = (f32x2){0.f, 0.f};
#endif
                *(f32x2*)(hs + tt * DM) = hold[z] + b1;
            }
        }
    }
}
#endif
__device__ __forceinline__ void ph_normg(const Frame& F, bool final_layer) {
    const int gw = F.vcu * NWAVES + F.wave, NGW = F.G * NWAVES, lane = F.lane;
    if (!final_layer) { for (int m = gw; m < S; m += NGW) rms_row_to_bf16(WSP(float, WS_H) + (size_t)m * DM, FIN(1) + DM, WSP(bf16_t, WS_XN) + (size_t)m * DM, lane); return; }
    const float* g = FIN(16); float* out = FOUT();
    for (int m = gw; m < S; m += NGW) {
        const f32x4* xr = (const f32x4*)(WSP(float, WS_H) + (size_t)m * DM) + lane;
        f32x4 v[8]; float s = 0.f;
#pragma unroll
        for (int j = 0; j < 8; ++j) { v[j] = xr[64 * j]; s += (v[j].x * v[j].x + v[j].y * v[j].y) + (v[j].z * v[j].z + v[j].w * v[j].w); }
        const float r = 1.0f / sqrtf(wave_sum(s) * (1.f / DM) + EPS);
        f32x4* o = (f32x4*)(out + (size_t)m * DM) + lane;
#pragma unroll
        for (int j = 0; j < 8; ++j) { const f32x4 gg = ((const f32x4*)g)[lane + 64 * j]; o[64 * j] = v[j] * r * gg; }
    }
}

__device__ __forceinline__ void ph_poolprep(const Frame& F) {
    const int lane = F.lane, gw = F.vcu * NWAVES + F.wave, NGW = F.G * NWAVES;
    const bf16_t* xn = WSP(bf16_t, WS_XN);
    for (int t = gw; t < S; t += NGW) {
        u32x4 o4[4];
#pragma unroll
        for (int j = 0; j < 4; ++j) {
            constexpr int dummy = 0; (void)dummy;
            const int half = 1 << j, lo = max(t - half, 0), hi = min(t + half, S), c0 = (lane + 64 * j) * 8;
            u32x4 xr[16];
#pragma unroll
            for (int q = 0; q < 16; ++q) if (q < 2 * half) { const int r = t - half + q; xr[q] = (r >= 0 && r < S) ? *(const u32x4*)(xn + (size_t)r * DM + c0) : (u32x4){0u, 0u, 0u, 0u}; }
            float a[8];
#pragma unroll
            for (int q = 0; q < 8; ++q) a[q] = 0.f;
#pragma unroll
            for (int q = 0; q < 16; ++q) if (q < 2 * half) { const u32x4 x = xr[q];
                a[0] += bflo(x.x); a[1] += bfhi(x.x); a[2] += bflo(x.y); a[3] += bfhi(x.y); a[4] += bflo(x.z); a[5] += bfhi(x.z); a[6] += bflo(x.w); a[7] += bfhi(x.w); }
            const u32x4 x = xr[half]; const float ic = 1.0f / (float)(hi - lo);
            o4[j].x = pk2(a[0] * ic - bflo(x.x), a[1] * ic - bfhi(x.x)); o4[j].y = pk2(a[2] * ic - bflo(x.y), a[3] * ic - bfhi(x.y));
            o4[j].z = pk2(a[4] * ic - bflo(x.z), a[5] * ic - bfhi(x.z)); o4[j].w = pk2(a[6] * ic - bflo(x.w), a[7] * ic - bfhi(x.w));
        }
#pragma unroll
        for (int j = 0; j < 4; ++j) *(u32x4*)(WSP(bf16_t, WS_POOLED) + (size_t)t * DM + (lane + 64 * j) * 8) = o4[j];
    }
}
__device__ __forceinline__ void ph_norm(const Frame& F, int layer) {
    const int gw = F.vcu * NWAVES + F.wave, NGW = F.G * NWAVES;
    for (int m = gw; m < S; m += NGW) rms_row_to_bf16(WSP(float, WS_H) + (size_t)m * DM, FIN(2) + layer * DM, WSP(bf16_t, WS_XN) + (size_t)m * DM, F.lane);
}

__device__ __forceinline__ void ph_attn(const Frame& F) {
    const int nunits = 8 * 64;
    float gq = fabsf(FIN(6)[F.lane]), gk = fabsf(FIN(7)[F.lane]); gq = fmaxf(gq, fabsf(FIN(6)[64 + F.lane])); gk = fmaxf(gk, fabsf(FIN(7)[64 + F.lane]));
#pragma unroll
    for (int o = 1; o < 64; o <<= 1) { gq = fmaxf(gq, __shfl_xor(gq, o)); gk = fmaxf(gk, __shfl_xor(gk, o)); }
    const float mC = -fminf(11.313708498984761f * gq * gk * 1.01f, 60.f) * 1.4426950408889634f;
    for (int u = F.vcu * 2; u < nunits; u += F.G * 2)
#pragma unroll 1
        for (int k = 0; k < 2; ++k) { const int unit = u + k, head = unit >> 6, qb = unit & 63, kvh = head >> 2;
            att::attn_dense_body<att::bf16>(WSP(att::bf16, WS_QB) + (size_t)(qb * 256) * 1024 + head * 128, WSP(att::bf16, WS_KVB) + kvh * 128, WSP(att::bf16, WS_KVB) + 256 + kvh * 128,
                                 WSP(att::bf16, WS_Y) + (size_t)(qb * 256) * DM + head * 128, S, F.ldsg, mC); }
}

#if defined(DBG_ATTN_CHECK)
constexpr int CW_DBG = 2048;
__device__ __forceinline__ void dbg_attn_check(const Frame& F) {
    __syncthreads();
    LAS float* sc = (LAS float*)F.lds; LAS float* red = sc + 16384; LAS float* po = red + 64;
    const int tid = F.tid, lane = F.lane, wave = F.wave;
    for (int chk = 0; chk < 4; ++chk) {
        const int unit = F.vcu * 2 + (chk & 1), head = unit >> 6, qb = unit & 63, kvh = head >> 2;
        const int t = qb * 256 + ((F.vcu * 37 + chk * 101 + 5) & 255);
        const bf16_t* q = WSP(bf16_t, WS_QB) + (size_t)t * 1024 + head * 128; const bf16_t* K = WSP(bf16_t, WS_KVB) + kvh * 128; const bf16_t* V = WSP(bf16_t, WS_KVB) + 256 + kvh * 128;
        float mx = -1e30f;
        for (int j = 0; j < 32; ++j) { const int key = tid + 512 * j; float s = 0.f;
            for (int d = 0; d < 128; ++d) s += bflo((unsigned)q[d]) * bflo((unsigned)K[(size_t)key * 512 + d]);
            s *= 0.088388347648318440f; sc[key] = s; mx = fmaxf(mx, s); }
        for (int o = 1; o < 64; o <<= 1) mx = fmaxf(mx, __shfl_xor(mx, o));
        if (lane == 0) red[wave] = mx;
        __syncthreads();
        mx = red[0]; for (int w = 1; w < 8; ++w) mx = fmaxf(mx, red[w]);
        __syncthreads();
        float sm = 0.f;
        for (int j = 0; j < 32; ++j) { const int key = tid + 512 * j; const float p = expf(sc[key] - mx); sc[key] = p; sm += p; }
        sm = wave_sum(sm);
        if (lane == 0) red[8 + wave] = sm;
        __syncthreads();
        sm = 0.f; for (int w = 0; w < 8; ++w) sm += red[8 + w];
        const int d = tid & 127, part = tid >> 7; float acc = 0.f;
        for (int kk = 0; kk < 4096; ++kk) { const int key = part * 4096 + kk; acc += sc[key] * bflo((unsigned)V[(size_t)key * 512 + d]); }
        po[part * 128 + d] = acc;
        __syncthreads();
        if (tid < 128) { const float o = (po[d] + po[128 + d] + po[256 + d] + po[384 + d]) / sm;
            const float y = bflo((unsigned)WSP(bf16_t, WS_Y)[(size_t)t * DM + head * 128 + d]);
            float ma = fabsf(o); for (int x = 1; x < 64; x <<= 1) ma = fmaxf(ma, __shfl_xor(ma, x));
            if (lane == 0) red[16 + wave] = ma;
            asm volatile("s_waitcnt lgkmcnt(0)" ::: "memory");
            const float mall = fmaxf(red[16], red[17]);
            const float mown = red[16 + wave]; (void)mall;
            const bool bad = !(fabsf(o - y) <= 0.03f * mown + 1e-5f);
            if (bad) atomicAdd((unsigned*)(F.ws + WS_CTL) + CW_DBG, 1u); }
        __syncthreads();
    }
}
#endif
#ifndef PHASE_MASK
#define PHASE_MASK 0xffffff
#endif
#define PH_ON(k) (((PHASE_MASK) >> (k)) & 1)
struct Args { const float* in[17]; float* out; unsigned char* ws; int ph_lo, ph_hi; };
static_assert(sizeof(Args) == 17 * 8 + 8 + 8 + 8, "Args has no padding");
__global__ void __launch_bounds__(NTHR, 2) fwd_kernel(Args args) {
    extern __shared__ __attribute__((aligned(16))) unsigned char lds[];
    Frame F;
    F.lds = (LAS unsigned char*)lds; F.ldsg = (char*)lds;
    F.tid = threadIdx.x; F.lane = F.tid & 63; F.wave = __builtin_amdgcn_readfirstlane(F.tid >> 6);
    F.G = gridDim.x; { const int bx = blockIdx.x; F.vcu = (F.G % 8 == 0) ? (bx % 8) * (F.G / 8) + bx / 8 : bx; }
    F.ws = args.ws;
    volatile LAS unsigned* MISC = (volatile LAS unsigned*)(F.lds + LDSCTL_OFF);
    if (F.tid < 16) ((LAS unsigned*)(F.lds + LDSCTL_OFF))[F.tid] = 0u;
    if (F.tid >= 64 && F.tid < 64 + 36) ((LAS unsigned*)(F.lds + LDSCTL_OFF + 64))[F.tid - 64] = ((const unsigned*)&args)[F.tid - 64];
    __syncthreads();
    const int lo = args.ph_lo, hi = args.ph_hi;
    XcdBarrier bar; bar.bar = (unsigned*)(F.ws + WS_CTL) + CW_BAR; bar.x = 0; bar.st = nullptr;
    if (hi - lo > 1) bar = xcd_barrier_post((unsigned*)(F.ws + WS_CTL) + CW_BAR, MISC + 8);
#pragma unroll 1
    for (int ph = lo; ph < hi; ++ph) {
        if (ph > lo) xcd_barrier(bar);
#if defined(PROBE_PH)
        unsigned long long tprobe0 = 0; if (ph == PROBE_PH) tprobe0 = __builtin_amdgcn_s_memrealtime();
        if (ph == PROBE_PH + 1 || (PROBE_PH == NPH - 1 && false)) { }
#endif
        switch (ph) {
#define PHM(n) do { asm volatile("; PHASE_MARK " #n ::: "memory"); int t_ = threadIdx.x; asm volatile("" : "+v"(t_)); F.tid = t_; F.lane = t_ & 63; F.wave = __builtin_amdgcn_readfirstlane(t_ >> 6); \
    unsigned long long z_ = 0; asm volatile("" : "+s"(z_)); F.ws = args.ws + z_; } while (0)
        case PH_PRO: if constexpr (PH_ON(PH_PRO)) { PHM(PH_PRO); ph_prologue(F); } break;
        case PH_GEMM_IN: if constexpr (PH_ON(PH_GEMM_IN)) { PHM(PH_GEMM_IN);  pg8::Gemm g{WSP(bf16_t, WS_XN), WSP(bf16_t, WS_WIN), S, INP, DM, DM, DM, 0, 0}; pg8::StaticOrder So; So.init(S, INP, F.G, (int)blockIdx.x);
            pg8::EpiBf16<0> E{WSP(bf16_t, WS_PROJ), INP, nullptr, 0, 0, 1.f};
            pg8::gemm_phase<pg8::EpiBf16<0>, pg8::StaticOrder, true, true>(F.lds, g, So, E); } break;
        case PH_POST: if constexpr (PH_ON(PH_POST)) { PHM(PH_POST); ph_post(F); } break;
        case PH_ATTN: if constexpr (PH_ON(PH_ATTN)) { PHM(PH_ATTN); ph_attn(F);
#if defined(DBG_ATTN_CHECK)
            dbg_attn_check(F);
#endif
            } break;
        case PH_MLA: if constexpr (PH_ON(PH_MLA)) { PHM(PH_MLA); ph_mla(F); } break;
        case PH_SCAN: if constexpr (PH_ON(PH_SCAN)) { PHM(PH_SCAN); ph_scan(F); } break;
        case PH_MLB: if constexpr (PH_ON(PH_MLB)) { PHM(PH_MLB); ph_mlb(F); } break;
        case PH_GEMM_OUT: if constexpr (PH_ON(PH_GEMM_OUT)) { PHM(PH_GEMM_OUT);  pg8::Gemm g{WSP(bf16_t, WS_Y), WSP(bf16_t, WS_WOUT), S, DM, DM, DM, DM, 0, 0}; pg8::StaticOrder So; So.init(S, DM, F.G, (int)blockIdx.x);
            pg8::EpiResF32 E{FIN(0), WSP(float, WS_H), DM, nullptr};
            pg8::gemm_phase<pg8::EpiResF32, pg8::StaticOrder, true, true>(F.lds, g, So, E); } break;
        case PH_NORM0: if constexpr (PH_ON(PH_NORM0)) { PHM(PH_NORM0); ph_norm(F, 0); } break;
        case PH_NORM1: if constexpr (PH_ON(PH_NORM1)) { PHM(PH_NORM1); ph_norm(F, 1); } break;
        case PH_GEMM_Q0: case PH_GEMM_Q1: if constexpr (PH_ON(PH_GEMM_Q0)) { PHM(PH_GEMM_Q0);  pg8::Gemm g{WSP(bf16_t, WS_XN), WSP(bf16_t, ph == PH_GEMM_Q0 ? WS_WQ0 : WS_WQ1), S, DM, DM, DM, DM, 0, 0}; pg8::StaticOrder So; So.init(S, DM, F.G, (int)blockIdx.x);
            pg8::EpiBf16<0> E{WSP(bf16_t, WS_QP), DM, nullptr, 0, 0, 1.f};
            pg8::gemm_phase<pg8::EpiBf16<0>, pg8::StaticOrder, true, true>(F.lds, g, So, E); } break;
        case PH_TOPK0: if constexpr (PH_ON(PH_TOPK0)) { PHM(PH_TOPK0); ph_topk(F, 0); } break;
        case PH_TOPK1: if constexpr (PH_ON(PH_TOPK1)) { PHM(PH_TOPK1); ph_topk(F, 1); } break;
        case PH_GU0: if constexpr (PH_ON(PH_GU0)) { PHM(PH_GU0); ph_gu(F, 0); } break;
        case PH_GU1: if constexpr (PH_ON(PH_GU1)) { PHM(PH_GU1); ph_gu(F, 1); } break;
        case PH_ACT0: if constexpr (PH_ON(PH_ACT0)) { PHM(PH_ACT0); ph_act(F, 0); } break;
        case PH_ACT1: if constexpr (PH_ON(PH_ACT1)) { PHM(PH_ACT1); ph_act(F, 1); } break;
        case PH_GV0: if constexpr (PH_ON(PH_GV0)) { PHM(PH_GV0); ph_gv(F, 0); } break;
        case PH_GV1: if constexpr (PH_ON(PH_GV1)) { PHM(PH_GV1); ph_gv(F, 1); } break;
        case PH_NORMP: if constexpr (PH_ON(PH_NORMP)) { PHM(PH_NORMP); ph_normg(F, false); } break;
        case PH_NORMF: if constexpr (PH_ON(PH_NORMF)) { PHM(PH_NORMF); ph_normg(F, true);
#if defined(DBG_ATTN_CHECK)
            { const unsigned nb = __hip_atomic_load((unsigned*)(F.ws + WS_CTL) + CW_DBG, __ATOMIC_RELAXED, __HIP_MEMORY_SCOPE_AGENT);
              if (nb != 0u) { float* o = FOUT(); for (int i = F.vcu * NTHR + F.tid; i < 4096; i += F.G * NTHR) o[(size_t)i * 8192 + 7] += (DBG_ATTN_CHECK == 2 ? 0.f : 1000.f); } }
#endif
            } break;
        case PH_POOLPREP: if constexpr (PH_ON(PH_POOLPREP)) { PHM(PH_POOLPREP); ph_poolprep(F); } break;
        case PH_GEMM_POOL: if constexpr (PH_ON(PH_GEMM_POOL)) { PHM(PH_GEMM_POOL);  pg8::Gemm g{WSP(bf16_t, WS_POOLED), WSP(bf16_t, WS_WPOOL), S, DM, 512, DM, 512, 1, 512 * 2}; pg8::StaticOrder So; So.init(S, DM, F.G, (int)blockIdx.x);
            pg8::EpiResF32 E{WSP(float, WS_H), WSP(float, WS_H), DM, FIN(11)};
            pg8::gemm_phase<pg8::EpiResF32, pg8::StaticOrder, true, true>(F.lds, g, So, E); } break;
        default: break;
        }
#if defined(PROBE_PH)
        if (ph == PROBE_PH) { __syncthreads(); const unsigned long long t1 = __builtin_amdgcn_s_memrealtime(), dt = t1 - tprobe0;
            while (__builtin_amdgcn_s_memrealtime() - t1 < 4ull * dt) __builtin_amdgcn_s_sleep(8); }
#endif
    }
}

#ifndef N_LAUNCH_MODE
#define N_LAUNCH_MODE 1
#endif
extern "C" void kernel_launch(void* const* d_in, const int* in_sizes, int n_in, void* d_out, int out_size, void* d_ws, size_t ws_size, hipStream_t stream) {
    static int grid = 0;
    if (grid == 0) {
        if (n_in != 17 || in_sizes[0] != S * DM || out_size != S * DM || ws_size < WS_END) { fprintf(stderr, "kernel_launch: unexpected shapes (n_in %d, in0 %d, out %d, ws %zu; need ws >= %zu)\n", n_in, n_in > 0 ? in_sizes[0] : -1, out_size, ws_size, (size_t)WS_END); grid = -1; return; }
        int dev = 0, cus = 0;
        if (hipGetDevice(&dev) != hipSuccess || hipDeviceGetAttribute(&cus, hipDeviceAttributeMultiprocessorCount, dev) != hipSuccess) { grid = -1; return; }
        if (hipFuncSetAttribute((const void*)fwd_kernel, hipFuncAttributeMaxDynamicSharedMemorySize, LDS_BYTES) != hipSuccess) { fprintf(stderr, "kernel_launch: hipFuncSetAttribute failed\n"); grid = -1; return; }
        int per_cu = 0;
        if (hipOccupancyMaxActiveBlocksPerMultiprocessor(&per_cu, (const void*)fwd_kernel, NTHR, LDS_BYTES) != hipSuccess || per_cu < 1) fprintf(stderr, "kernel_launch: occupancy query reports %d\n", per_cu);
        (void)hipGetLastError();
        grid = cus;
        if (grid != 256) { fprintf(stderr, "kernel_launch: built for a 256-CU device (got %d CUs)\n", grid); grid = -1; return; }
    }
    if (grid < 0) return;
    (void)hipMemsetAsync((char*)d_ws + WS_CTL, 0, CTL_ZERO_BYTES, stream);
    Args a{};
    for (int i = 0; i < 17; ++i) a.in[i] = (const float*)d_in[i];
    a.out = (float*)d_out; a.ws = (unsigned char*)d_ws;
#if N_LAUNCH_MODE == 1
    a.ph_lo = 0; a.ph_hi = NPH;
    hipLaunchKernelGGL(fwd_kernel, dim3(grid), dim3(NTHR), LDS_BYTES, stream, a);
#else
    for (int ph = 0; ph < NPH; ++ph) { a.ph_lo = ph; a.ph_hi = ph + 1; hipLaunchKernelGGL(fwd_kernel, dim3(grid), dim3(NTHR), LDS_BYTES, stream, a); }
#endif
    const hipError_t le = hipPeekAtLastError();
    if (le != hipSuccess) fprintf(stderr, "kernel_launch: launch failed: %s\n", hipGetErrorName(le));
}
```

```cpp
#include <hip/hip_runtime.h>
#include <hip/hip_bf16.h>
#include <cstdio>
#include <cstdint>
#include <cmath>

#ifndef TBL_FP4
#define TBL_FP4 1
#endif
constexpr int S = 16384, DM = 2048, NWAVES = 8, NTHR = 512;
constexpr int INW = 5648, INP = 5888;
constexpr int C_AQ = 0, C_AK = 1024, C_AV = 1280, C_MQK = 1536, C_MV = 3584, C_MO = 4608, C_GATE = 5632;
constexpr float EPS = 1e-6f;
constexpr int NPH = 21;
enum { PH_PRO = 0, PH_GEMM_IN, PH_POST, PH_ATTN, PH_MLA, PH_SCAN, PH_MLB, PH_GEMM_OUT, PH_GEMM_Q0, PH_TOPK0, PH_GU0, PH_ACT0, PH_GV0,
       PH_POOLPREP, PH_GEMM_POOL, PH_GEMM_Q1, PH_TOPK1, PH_GU1, PH_ACT1, PH_GV1, PH_NORMF };

constexpr size_t MiB = 1u << 20;
constexpr size_t WS_CTL = 0, CTL_ZERO_BYTES = 1 * MiB;
constexpr size_t WS_WIN = 1 * MiB, WS_WOUT = 24 * MiB, WS_WQ0 = 32 * MiB, WS_WQ1 = 40 * MiB, WS_WPOOL = 48 * MiB, WS_KEYS = 50 * MiB;
constexpr size_t WS_TSC = 52 * MiB + 768 * 1024  , WS_GATES = 51 * MiB, WS_NST = 53 * MiB, WS_EIDX = 54 * MiB, WS_EGATE = 62 * MiB;
constexpr size_t WS_UB = 70 * MiB, WS_VB = 198 * MiB, WS_XN = 326 * MiB, WS_PROJ = 390 * MiB, WS_QP = WS_PROJ;
constexpr size_t WS_QB = 574 * MiB, WS_KVB = 606 * MiB, WS_MQ = 622 * MiB, WS_MK = 654 * MiB, WS_CST = 686 * MiB, WS_Y = 814 * MiB, WS_POOLED = WS_Y;
constexpr size_t WS_H = 878 * MiB, WS_END = 1006 * MiB;
constexpr size_t CTL_SSQ = 256 * 1024;
constexpr int CW_BAR = 4096;
constexpr size_t GO_B = 0, GO_U = 8 * S * 4, GO_PM = 2 * 8 * S * 4, GO_G = 3 * 8 * S * 4, GO_PML = GO_G + 4096, GO_MPREV = GO_PML + 4096;

constexpr int LDS_BYTES = 147456, LDSCTL_OFF = 146944;

#define GAS __attribute__((address_space(1)))
#define LAS __attribute__((address_space(3)))
typedef unsigned short bf16_t;
typedef short bf16x8 __attribute__((ext_vector_type(8)));
typedef short s16x4 __attribute__((ext_vector_type(4)));
typedef short v4i16_t __attribute__((ext_vector_type(4)));
typedef float f32x4 __attribute__((ext_vector_type(4)));
typedef float f32x2 __attribute__((ext_vector_type(2)));
typedef float f32x16 __attribute__((ext_vector_type(16)));
typedef unsigned u32x4 __attribute__((ext_vector_type(4)));
typedef unsigned u32x2 __attribute__((ext_vector_type(2)));
typedef __bf16 bf16x2_t __attribute__((ext_vector_type(2)));
typedef GAS unsigned gu32;
#define RLX_AGENT __ATOMIC_RELAXED, __HIP_MEMORY_SCOPE_AGENT
#define LDS_WAIT() asm volatile("s_waitcnt lgkmcnt(0)" ::: "memory")
__device__ __forceinline__ unsigned f2bf(float f) { unsigned u = __builtin_bit_cast(unsigned, f); return (u + 0x7fffu + ((u >> 16) & 1u)) >> 16; }
__device__ __forceinline__ unsigned pk2(float lo, float hi) { f32x2 v = {lo, hi}; bf16x2_t b = __builtin_convertvector(v, bf16x2_t); return __builtin_bit_cast(unsigned, b); }
__device__ __forceinline__ float bflo(unsigned w) { return __builtin_bit_cast(float, w << 16); }
__device__ __forceinline__ float bfhi(unsigned w) { return __builtin_bit_cast(float, w & 0xffff0000u); }
__device__ __forceinline__ float rstd_of(unsigned long long ss) { return 1.0f / sqrtf((float)ss * (1.0f / (1048576.0f * 2048.0f)) + 1e-6f); }
__device__ __forceinline__ float wave_sum(float v) {
#pragma unroll
    for (int o = 1; o < 64; o <<= 1) v += __shfl_xor(v, o);
    return v;
}

namespace pg8 {
#define PG8_LAS __attribute__((address_space(3)))
typedef unsigned short bf16_t;
typedef short bf16x8 __attribute__((ext_vector_type(8)));
typedef float f32x4 __attribute__((ext_vector_type(4)));
typedef unsigned u32x4 __attribute__((ext_vector_type(4)));
constexpr int BM = 256, BK = 64, HALF = 128, HTB = HALF * BK * 2  , STAGE_BYTES = 8 * HTB, NXCD = 8, WGM = 8;

__host__ __device__ __forceinline__ int lds_byte(int r, int c) { const int st = (r >> 4) * 2 + (c >> 5), rr = r & 15, cc = c & 31, ob = rr * 64 + cc * 2; return st * 1024 + (ob ^ (((ob >> 9) & 1) << 5)); }
__host__ __device__ __forceinline__ void stage_rc(int b, int& R, int& C) { const int st = b / 1024, sb = b % 1024, swz = sb ^ (((sb >> 9) & 1) << 5); R = (st >> 1) * 16 + swz / 64; C = (st & 1) * 32 + (swz % 64) / 2; }
__host__ __device__ __forceinline__ int perm32(int rho) { const int n = rho >> 4, i = rho & 15; return 8 * (i >> 2) + 4 * n + (i & 3); }

struct Unit { int pm, pn; };
struct Gemm { const bf16_t* A; const bf16_t* Bt; int M, N, K, lda, ldb, agrp_shift; size_t agrp_bytes; };

struct StaticOrder {
    int nM, nN, nwg, G, c;
    __host__ __device__ void init(int M, int N, int G_, int c_) { nM = M / BM; nN = N / BM; nwg = nM * nN; G = G_; c = c_; }
    __host__ __device__ bool next(int i, Unit& u) const {
        const long L = (long)i * G + c; if (L >= nwg) return false;
        int wgid = (int)L; { const int q = nwg / NXCD, r = nwg % NXCD, xcd = wgid % NXCD, off = wgid / NXCD; wgid = (xcd < r ? xcd * (q + 1) : r * (q + 1) + (xcd - r) * q) + off; }
        const int nig = WGM * nN, gid = wgid / nig, fm = gid * WGM, gsz = (nM - fm) < WGM ? (nM - fm) : WGM;
        u.pm = fm + ((wgid % nig) % gsz); u.pn = (wgid % nig) / gsz; return true;
    }
    __device__ __forceinline__ void a_ready(const Unit&) const {}
    __device__ __forceinline__ void done(const Unit&) const {}
};

__device__ __forceinline__ unsigned cvt_pk_bf16(float lo, float hi) { unsigned r; asm volatile("v_cvt_pk_bf16_f32 %0, %1, %2" : "=v"(r) : "v"(lo), "v"(hi)); return r; }
typedef float f32x2 __attribute__((ext_vector_type(2)));
__device__ __forceinline__ f32x2 gelu_pk(f32x2 v) {
    const f32x2 av = __builtin_elementwise_abs(v), d = av * 0.2316418882f + 1.0f;
    f32x2 t; t.x = __builtin_amdgcn_rcpf(d.x); t.y = __builtin_amdgcn_rcpf(d.y);
    f32x2 q = t * 0.5307027145f + (-0.7265760135f); q = q * t + 0.7107068705f; q = q * t + (-0.142248368f); q = q * t + 0.127414796f; q = q * t;
    const f32x2 s = (v * v) * (-0.72134752044f);
    f32x2 e; e.x = __builtin_amdgcn_exp2f(s.x); e.y = __builtin_amdgcn_exp2f(s.y);
    const f32x2 m = v * (q * e), r = v - m;
    f32x2 o; o.x = v.x < 0.f ? m.x : r.x; o.y = v.y < 0.f ? m.y : r.y; return o;
}
template <int ACT  > struct EpiBf16 {
    static constexpr bool PERM = true, AFTER_DRAIN = false; static_assert(ACT == 0 || ACT == 1, "EpiBf16: ACT is 0 (none) or 1 (gelu_pk)");
    bf16_t* O; int ldc; const float* bias; int split_cols; size_t split_stride; float scale0;
    __device__ __forceinline__ void operator()(const f32x4 (&acc)[2][2][4][2], const Unit& u, int wr, int wc, int fr, int fq) const {
        const int row0 = u.pm * BM + wr * 64 + fr; int colt = u.pn * BM; bf16_t* base = O;
        float sc = 1.f; if (split_cols) { const int t = colt / split_cols; base += (size_t)t * split_stride; colt -= t * split_cols; if (t == 0) sc = scale0; }
        const int col0 = colt + wc * 32 + 8 * fq, bcol0 = u.pn * BM + wc * 32 + 8 * fq;
        f32x4 bv[2][2];
#pragma unroll
        for (int bj = 0; bj < 2; ++bj)
#pragma unroll
            for (int n = 0; n < 2; ++n) bv[bj][n] = bias ? *(const f32x4*)(bias + bcol0 + bj * HALF + 4 * n) : (f32x4){0.f, 0.f, 0.f, 0.f};
#pragma unroll
        for (int ai = 0; ai < 2; ++ai)
#pragma unroll
            for (int m = 0; m < 4; ++m) { bf16_t* rowp = base + (size_t)(row0 + ai * HALF + m * 16) * ldc + col0;
#pragma unroll
                for (int bj = 0; bj < 2; ++bj) { f32x4 v0 = acc[ai][bj][m][0] + bv[bj][0], v1 = acc[ai][bj][m][1] + bv[bj][1];
                    if (ACT == 1) { f32x2 a = gelu_pk((f32x2){v0[0], v0[1]}), b = gelu_pk((f32x2){v0[2], v0[3]}), c = gelu_pk((f32x2){v1[0], v1[1]}), d = gelu_pk((f32x2){v1[2], v1[3]});
                        v0 = (f32x4){a.x, a.y, b.x, b.y}; v1 = (f32x4){c.x, c.y, d.x, d.y}; }
                    v0 = v0 * sc; v1 = v1 * sc; u32x4 w; w.x = cvt_pk_bf16(v0[0], v0[1]); w.y = cvt_pk_bf16(v0[2], v0[3]); w.z = cvt_pk_bf16(v1[0], v1[1]); w.w = cvt_pk_bf16(v1[2], v1[3]);
                    *(u32x4*)(rowp + bj * HALF) = w; } }
    }
};
struct EpiResF32 {
    static constexpr bool PERM = false, AFTER_DRAIN = false;
    const float* base; float* out; int ldc; const float* colscale; bf16_t* hb; unsigned long long* ssq;
    __device__ __forceinline__ void operator()(const f32x4 (&acc)[2][2][4][2], const Unit& u, int wr, int wc, int fr, int fq) const {
        const int row0 = u.pm * BM + wr * 64 + fr, col0 = u.pn * BM + wc * 32 + 4 * fq;
        f32x4 cs[2][2];
#pragma unroll
        for (int bj = 0; bj < 2; ++bj)
#pragma unroll
            for (int n = 0; n < 2; ++n) cs[bj][n] = colscale ? *(const f32x4*)(colscale + col0 + bj * HALF + n * 16) : (f32x4){1.f, 1.f, 1.f, 1.f};
#pragma unroll
        for (int ai = 0; ai < 2; ++ai)
#pragma unroll
            for (int m = 0; m < 4; ++m) { const size_t off = (size_t)(row0 + ai * HALF + m * 16) * ldc + col0;
                float ssum = 0.f;
#pragma unroll
                for (int bj = 0; bj < 2; ++bj)
#pragma unroll
                    for (int n = 0; n < 2; ++n) { const f32x4 b = *(const f32x4*)(base + off + bj * HALF + n * 16);
                        const f32x4 h = b + acc[ai][bj][m][n] * cs[bj][n];
                        *(f32x4*)(out + off + bj * HALF + n * 16) = h;
                        if (hb) { typedef unsigned u32x2v __attribute__((ext_vector_type(2))); u32x2v w; w.x = cvt_pk_bf16(h[0], h[1]); w.y = cvt_pk_bf16(h[2], h[3]); *(u32x2v*)(hb + off + bj * HALF + n * 16) = w; }
                        ssum += (h[0] * h[0] + h[1] * h[1]) + (h[2] * h[2] + h[3] * h[3]); }
                if (ssq) { ssum += __shfl_xor(ssum, 16); ssum += __shfl_xor(ssum, 32);
                    if (fq == 0) atomicAdd(ssq + (row0 + ai * HALF + m * 16), (unsigned long long)(ssum * 1048576.0f)); }
                asm volatile("" ::: "memory"); }
    }
};

struct EpiBf16Row {
    static constexpr bool PERM = true, AFTER_DRAIN = false;
    bf16_t* O; int ldc; const unsigned long long* ssq; float inv_ncol, eps;
    __device__ __forceinline__ void operator()(const f32x4 (&acc)[2][2][4][2], const Unit& u, int wr, int wc, int fr, int fq) const {
        const int row0 = u.pm * BM + wr * 64 + fr, col0 = u.pn * BM + wc * 32 + 8 * fq;
#pragma unroll
        for (int ai = 0; ai < 2; ++ai)
#pragma unroll
            for (int m = 0; m < 4; ++m) { const int row = row0 + ai * HALF + m * 16; bf16_t* rowp = O + (size_t)row * ldc + col0;
                const float sc = ssq ? 1.0f / sqrtf((float)ssq[row] * (inv_ncol * (1.0f / 1048576.0f)) + eps) : 1.f;
#pragma unroll
                for (int bj = 0; bj < 2; ++bj) { const f32x4 v0 = acc[ai][bj][m][0] * sc, v1 = acc[ai][bj][m][1] * sc;
                    u32x4 w; w.x = cvt_pk_bf16(v0[0], v0[1]); w.y = cvt_pk_bf16(v0[2], v0[3]); w.z = cvt_pk_bf16(v1[0], v1[1]); w.w = cvt_pk_bf16(v1[2], v1[3]);
                    *(u32x4*)(rowp + bj * HALF) = w; } }
    }
};

template <class Epi, class Sched, bool ALIGN_EPI = false, bool SP2 = false>
__device__ __forceinline__ void gemm_phase(PG8_LAS unsigned char* lds, const Gemm g, const Sched& S, const Epi& E) {
    int tid_ = threadIdx.x; asm volatile("" : "+v"(tid_));
    const int tid = tid_, wid = __builtin_amdgcn_readfirstlane(tid >> 6), lane = tid & 63, wr = wid >> 2, wc = wid & 3, fr = lane & 15, fq = lane >> 4;
    const int K = g.K, nt = K / BK;
    unsigned voffA[2], voffB[2];
#pragma unroll
    for (int i = 0; i < 2; ++i) { int R, C; stage_rc(tid * 16 + i * 8192, R, C); const int Rb = Epi::PERM ? ((R & ~31) + perm32(R & 31)) : R;
        voffA[i] = (unsigned)(R * g.lda + C) * 2u; voffB[i] = (unsigned)(Rb * g.ldb + C) * 2u; }
    const size_t kstep = (size_t)(BK * 2);
    const size_t hstepA = (size_t)HALF * g.lda * 2, hstepB = (size_t)HALF * g.ldb * 2;
    const size_t tstepA = 2 * hstepA, tstepB = 2 * hstepB;
    const unsigned ldsw = (unsigned)wid * 1024u;
    const int aoff = lds_byte(wr * 64 + fr, fq * 8), boff = lds_byte(wc * 32 + fr, fq * 8);
#define PG8_SA(b, h) (((b) * 2 + (h)) * HTB)
#define PG8_SB(b, h) ((4 + (b) * 2 + (h)) * HTB)
#define PG8_STAGE(bufoff, gbase, voff) do { _Pragma("unroll") for (int _i = 0; _i < 2; ++_i) \
        __builtin_amdgcn_global_load_lds((const unsigned*)((const char*)(gbase) + (voff)[_i]), (PG8_LAS unsigned*)(lds + (bufoff) + ldsw + _i * 8192), 16, 0, 0); } while (0)
#define PG8_LDA(dst, b, h) do { _Pragma("unroll") for (int m = 0; m < 4; ++m) _Pragma("unroll") for (int k = 0; k < 2; ++k) dst[m][k] = *(const PG8_LAS bf16x8*)(lds + PG8_SA(b, h) + aoff + m * 2048 + k * 1024); } while (0)
#define PG8_LDB(dst, b, h) do { _Pragma("unroll") for (int n = 0; n < 2; ++n) _Pragma("unroll") for (int k = 0; k < 2; ++k) dst[n][k] = *(const PG8_LAS bf16x8*)(lds + PG8_SB(b, h) + boff + n * 2048 + k * 1024); } while (0)
#define PG8_MMA(ai, bj, At, Bt) do { __builtin_amdgcn_s_setprio(1); _Pragma("unroll") for (int m = 0; m < 4; ++m) _Pragma("unroll") for (int n = 0; n < 2; ++n) _Pragma("unroll") for (int k = 0; k < 2; ++k) \
        acc[ai][bj][m][n] = __builtin_amdgcn_mfma_f32_16x16x32_bf16(Bt[n][k], At[m][k], acc[ai][bj][m][n], 0, 0, 0); __builtin_amdgcn_s_setprio(0); } while (0)
#define PG8_WAIT_V(n) asm volatile("s_waitcnt vmcnt(" #n ")" ::: "memory")
#define PG8_WAIT_L(n) asm volatile("s_waitcnt lgkmcnt(" #n ")" ::: "memory")
#define PG8_BAR __builtin_amdgcn_s_barrier()
#define PG8_SCHED __builtin_amdgcn_sched_barrier(0)
    Unit cur, nxt; int ui = 0;
    if (!S.next(0, cur)) return;
    f32x4 acc[2][2][4][2];
#pragma unroll
    for (int a = 0; a < 2; ++a)
#pragma unroll
        for (int b = 0; b < 2; ++b)
#pragma unroll
            for (int m = 0; m < 4; ++m)
#pragma unroll
                for (int n = 0; n < 2; ++n) acc[a][b][m][n] = (f32x4){0.f, 0.f, 0.f, 0.f};
    bf16x8 At[4][2], B0[2][2], B1[2][2];
    const char* cA = (const char*)g.A + (size_t)cur.pm * tstepA + (size_t)(cur.pn >> g.agrp_shift) * g.agrp_bytes; const char* cB = (const char*)g.Bt + (size_t)cur.pn * tstepB;
    S.a_ready(cur);
    if constexpr (SP2) {
        PG8_STAGE(PG8_SB(0, 0), cB, voffB); PG8_STAGE(PG8_SB(0, 1), cB + hstepB, voffB); PG8_STAGE(PG8_SA(0, 0), cA, voffA); PG8_STAGE(PG8_SA(0, 1), cA + hstepA, voffA);
        if (wr == 1) PG8_BAR;
        PG8_WAIT_V(2); PG8_BAR;
        PG8_STAGE(PG8_SB(1, 0), cB + kstep, voffB); PG8_STAGE(PG8_SA(1, 0), cA + kstep, voffA); PG8_STAGE(PG8_SB(1, 1), cB + hstepB + kstep, voffB);
        PG8_WAIT_V(6); PG8_BAR;
    } else {
        PG8_STAGE(PG8_SB(0, 0), cB, voffB); PG8_STAGE(PG8_SA(0, 0), cA, voffA); PG8_STAGE(PG8_SB(0, 1), cB + hstepB, voffB); PG8_STAGE(PG8_SA(0, 1), cA + hstepA, voffA);
        if (wr == 1) PG8_BAR;
        PG8_WAIT_V(4); PG8_BAR;
        PG8_STAGE(PG8_SB(1, 0), cB + kstep, voffB); PG8_STAGE(PG8_SA(1, 0), cA + kstep, voffA); PG8_STAGE(PG8_SB(1, 1), cB + hstepB + kstep, voffB);
        PG8_WAIT_V(6); PG8_BAR;
    }
    for (;;) {
        const bool has_next = S.next(ui + 1, nxt);
        const char* nA = has_next ? (const char*)g.A + (size_t)nxt.pm * tstepA + (size_t)(nxt.pn >> g.agrp_shift) * g.agrp_bytes : cA; const char* nB = has_next ? (const char*)g.Bt + (size_t)nxt.pn * tstepB : cB;
        for (int t = 0; t < nt; t += 2) {
            const bool last = (t == nt - 2);
            const char* a1 = cA + (size_t)(t + 1) * kstep;
            const char* a2 = last ? nA : cA + (size_t)(t + 2) * kstep; const char* b2 = last ? nB : cB + (size_t)(t + 2) * kstep;
            const char* a3 = a2 + kstep; const char* b3 = b2 + kstep;
            if (last && has_next) S.a_ready(nxt);
            if constexpr (SP2) {
            PG8_LDB(B0, 0, 0); PG8_LDB(B1, 0, 1); PG8_SCHED; PG8_LDA(At, 0, 0); PG8_STAGE(PG8_SA(1, 1), a1 + hstepA, voffA);
            PG8_WAIT_V(8); PG8_WAIT_L(0); PG8_BAR; PG8_MMA(0, 0, At, B0); PG8_MMA(0, 1, At, B1); PG8_BAR; PG8_SCHED;
            PG8_LDA(At, 0, 1); PG8_STAGE(PG8_SB(0, 0), b2, voffB); PG8_STAGE(PG8_SB(0, 1), b2 + hstepB, voffB); PG8_STAGE(PG8_SA(0, 0), a2, voffA);
            PG8_WAIT_V(8); PG8_WAIT_L(0); PG8_BAR; PG8_MMA(1, 0, At, B0); PG8_MMA(1, 1, At, B1); PG8_BAR; PG8_SCHED;
            PG8_LDB(B0, 1, 0); PG8_LDB(B1, 1, 1); PG8_SCHED; PG8_LDA(At, 1, 0); PG8_STAGE(PG8_SA(0, 1), a2 + hstepA, voffA);
            PG8_WAIT_V(8); PG8_WAIT_L(0); PG8_BAR; PG8_MMA(0, 0, At, B0); PG8_MMA(0, 1, At, B1); PG8_BAR; PG8_SCHED;
            PG8_LDA(At, 1, 1); PG8_STAGE(PG8_SB(1, 0), b3, voffB); PG8_STAGE(PG8_SB(1, 1), b3 + hstepB, voffB); PG8_STAGE(PG8_SA(1, 0), a3, voffA);
            PG8_WAIT_V(8); PG8_WAIT_L(0); PG8_BAR; PG8_MMA(1, 0, At, B0); PG8_MMA(1, 1, At, B1); PG8_BAR; PG8_SCHED;
            } else {
            PG8_LDB(B0, 0, 0); PG8_SCHED; PG8_LDA(At, 0, 0); PG8_STAGE(PG8_SA(1, 1), a1 + hstepA, voffA);
            PG8_WAIT_L(8); PG8_BAR; PG8_WAIT_L(0); PG8_MMA(0, 0, At, B0); PG8_BAR; PG8_SCHED;
            PG8_LDB(B1, 0, 1); PG8_STAGE(PG8_SB(0, 0), b2, voffB);
            PG8_BAR; PG8_WAIT_L(0); PG8_MMA(0, 1, At, B1); PG8_BAR;
            PG8_LDA(At, 0, 1); PG8_STAGE(PG8_SA(0, 0), a2, voffA);
            PG8_BAR; PG8_WAIT_L(0); PG8_MMA(1, 0, At, B0); PG8_BAR; PG8_SCHED;
            PG8_STAGE(PG8_SB(0, 1), b2 + hstepB, voffB);
            PG8_WAIT_V(6); PG8_BAR; PG8_MMA(1, 1, At, B1); PG8_BAR;
            PG8_LDB(B0, 1, 0); PG8_SCHED; PG8_LDA(At, 1, 0); PG8_STAGE(PG8_SA(0, 1), a2 + hstepA, voffA);
            PG8_WAIT_L(8); PG8_BAR; PG8_WAIT_L(0); PG8_MMA(0, 0, At, B0); PG8_BAR; PG8_SCHED;
            PG8_LDB(B1, 1, 1); PG8_STAGE(PG8_SB(1, 0), b3, voffB);
            PG8_BAR; PG8_WAIT_L(0); PG8_MMA(0, 1, At, B1); PG8_BAR;
            PG8_LDA(At, 1, 1); PG8_STAGE(PG8_SA(1, 0), a3, voffA);
            PG8_BAR; PG8_WAIT_L(0); PG8_MMA(1, 0, At, B0); PG8_BAR; PG8_SCHED;
            PG8_STAGE(PG8_SB(1, 1), b3 + hstepB, voffB);
            PG8_WAIT_V(6); PG8_BAR; PG8_MMA(1, 1, At, B1); PG8_BAR;
            }
        }
        if constexpr (ALIGN_EPI) { if (wr == 0) PG8_BAR; }
        if constexpr (!Epi::AFTER_DRAIN) { E(acc, cur, wr, wc, fr, fq); S.done(cur); }
        if (!has_next) break;
#pragma unroll
        for (int a = 0; a < 2; ++a)
#pragma unroll
            for (int b = 0; b < 2; ++b)
#pragma unroll
                for (int m = 0; m < 4; ++m)
#pragma unroll
                    for (int n = 0; n < 2; ++n) acc[a][b][m][n] = (f32x4){0.f, 0.f, 0.f, 0.f};
        cur = nxt; cA = nA; cB = nB; ++ui;
        if constexpr (ALIGN_EPI) { if (wr == 1) PG8_BAR; }
    }
    PG8_WAIT_V(0);
    if constexpr (!ALIGN_EPI) { if (wr == 0) PG8_BAR; }
    PG8_BAR;
    if constexpr (Epi::AFTER_DRAIN) { E.fused(acc, cur, wr, wc, fr, fq, lds, wid, lane); S.done(cur); }
#undef PG8_SA
#undef PG8_SB
#undef PG8_STAGE
#undef PG8_LDA
#undef PG8_LDB
#undef PG8_MMA
#undef PG8_WAIT_V
#undef PG8_WAIT_L
#undef PG8_BAR
#undef PG8_SCHED
}
}
#define XB_TMO      128
#define XB_XCNT(j)  (256  + 64 * (j))
#define XB_XSUB(j)  (1280 + 64 * (j))
#define XB_XGEN(j)  (2304 + 64 * (j))
#define XB_TOP      3328
#define XB_TOPGEN   3392
#define XCD_BAR_WORDS 3456
#define XB_SPIN_CAP (1u << 18)

__device__ __forceinline__ unsigned xb_ld(unsigned* p)              { return __hip_atomic_load(p, __ATOMIC_RELAXED, __HIP_MEMORY_SCOPE_AGENT); }
__device__ __forceinline__ unsigned xb_add(unsigned* p, unsigned v) { return __hip_atomic_fetch_add(p, v, __ATOMIC_RELAXED, __HIP_MEMORY_SCOPE_AGENT); }
__device__ __forceinline__ unsigned xb_xcc_id() { return (unsigned)__builtin_amdgcn_s_getreg((3 << 11) | 20) & 0xFu; }
#define XB_SPIN(cond, bar) do { unsigned _sp = 0; while (cond) { __builtin_amdgcn_s_sleep(1); \
    if ((++_sp & 255u) == 0u) { if (xb_ld(&(bar)[XB_TMO])) break; if (_sp > XB_SPIN_CAP) { atomicAdd(&(bar)[XB_TMO], 1u); break; } } } } while (0)

struct XcdBarrier {
    unsigned* bar; unsigned x;
    volatile LAS unsigned* st;
};

__device__ __forceinline__ XcdBarrier xcd_barrier_post(unsigned* bar, volatile LAS unsigned* st) {
    XcdBarrier b; b.bar = bar; b.x = xb_xcc_id(); b.st = st;
    if (threadIdx.x == 0) (void)xb_add(&bar[XB_XCNT(b.x)], 1u);
    return b;
}
__device__ __forceinline__ void xcd_barrier_complete(unsigned* bar, unsigned x, unsigned& nloc, unsigned& nx) {
    const unsigned G = gridDim.x * gridDim.y * gridDim.z;
    unsigned sum, cnt, mine, sp = 0u;
    for (;;) {
        sum = 0u; cnt = 0u; mine = 0u;
#pragma unroll
        for (unsigned j = 0; j < 16; ++j) { const unsigned c = xb_ld(&bar[XB_XCNT(j)]); sum += c; cnt += (c > 0u) ? 1u : 0u; mine = (j == x) ? c : mine; }
        if (sum == G) break;
        __builtin_amdgcn_s_sleep(1);
        if ((++sp & 255u) == 0u) { if (xb_ld(&bar[XB_TMO])) break; if (sp > XB_SPIN_CAP) { atomicAdd(&bar[XB_TMO], 1u); break; } }
    }
    nloc = mine > 0u ? mine : 1u; nx = cnt > 0u ? cnt : 1u;
}

__device__ __forceinline__ void xcd_barrier(const XcdBarrier& b) {
    asm volatile("s_waitcnt vmcnt(0)" ::: "memory");
    __syncthreads();
    if (threadIdx.x == 0) {
        unsigned* bar = b.bar;
        __builtin_amdgcn_s_waitcnt(0);
        unsigned nloc = b.st[0], nx = b.st[1];
        if (nloc == 0u) { xcd_barrier_complete(bar, b.x, nloc, nx); b.st[0] = nloc; b.st[1] = nx; }
        const unsigned old = xb_add(&bar[XB_XSUB(b.x)], 1u);
        const unsigned gen = old / nloc;
        if (old + 1u == (gen + 1u) * nloc) {
            __builtin_amdgcn_fence(__ATOMIC_RELEASE, "agent");
            asm volatile("s_waitcnt vmcnt(0)" ::: "memory");
            const unsigned og = xb_add(&bar[XB_TOP], 1u);
            const unsigned tg = og / nx;
            if (og + 1u == (tg + 1u) * nx) xb_add(&bar[XB_TOPGEN], 1u);
            else XB_SPIN(xb_ld(&bar[XB_TOPGEN]) == tg, bar);
            __builtin_amdgcn_fence(__ATOMIC_ACQUIRE, "agent");
            xb_add(&bar[XB_XGEN(b.x)], 1u);
            asm volatile("s_waitcnt vmcnt(0)" ::: "memory");
        } else {
            XB_SPIN(xb_ld(&bar[XB_XGEN(b.x)]) == gen, bar);
            __builtin_amdgcn_fence(__ATOMIC_ACQUIRE, "agent");
            asm volatile("s_waitcnt vmcnt(0)" ::: "memory");
        }
    }
    __syncthreads();
}
namespace att {
using bf16 = __hip_bfloat16;
constexpr int   D = 128, NW = 8, QBLK = 32, KVBLK = 64;
constexpr float SCALE = 0.088388347648318440f;
constexpr float THR = 8.f;
constexpr int SDEPTH = 1;
constexpr int LDQ = 1024, LDK = 512, LDO = 2048;
constexpr size_t SHM_V = KVBLK * D * 2, SHM_K = KVBLK * D * 2, SHM_ATTN = 2 * SHM_V + 2 * SHM_K + NW * 64 * 4;
using bf16x8 = __attribute__((ext_vector_type(8))) short;
using s16x4  = __attribute__((ext_vector_type(4))) short;
using f32x16 = __attribute__((ext_vector_type(16))) float;
using f32x8  = __attribute__((ext_vector_type(8))) float;
using u32x4  = __attribute__((ext_vector_type(4))) unsigned;
#define KSWZ(row, colB) ((row) * 256 + ((colB) ^ (((row) & 7) << 4)))
#define SBAR() __builtin_amdgcn_sched_barrier(0)
__device__ __forceinline__ int crow(int r, int hi) { return (r & 3) + 8 * (r >> 2) + 4 * hi; }
__device__ __forceinline__ unsigned cvtpk(float lo, float hi) {
  unsigned r; asm volatile("v_cvt_pk_bf16_f32 %0, %1, %2" : "=v"(r) : "v"(lo), "v"(hi)); return r;
}
template <typename TIn> struct Stage;
template <> struct Stage<bf16>  { using T = bf16x8;
  __device__ static __forceinline__ T ld8(const bf16* p) { return *reinterpret_cast<const bf16x8*>(p); }
  __device__ static __forceinline__ bf16x8 tobf(T x) { return x; } };
template <> struct Stage<float> { using T = f32x8;
  __device__ static __forceinline__ T ld8(const float* p) { return *reinterpret_cast<const f32x8*>(p); }
  __device__ static __forceinline__ bf16x8 tobf(T x) {
    u32x4 w = {cvtpk(x[0], x[1]), cvtpk(x[2], x[3]), cvtpk(x[4], x[5]), cvtpk(x[6], x[7])}; return *reinterpret_cast<bf16x8*>(&w); } };

__device__ __forceinline__ void partialSM(f32x16& p0, f32x16& p1, float mC) {
  constexpr float C = SCALE * 1.4426950408889634f;
  for (int r = 0; r < 16; ++r) p0[r] = fmaf(p0[r], C, mC); for (int r = 0; r < 16; ++r) p1[r] = fmaf(p1[r], C, mC);
  for (int r = 0; r < 16; ++r) p0[r] = __builtin_amdgcn_exp2f(p0[r]);
}
__device__ __forceinline__ void finishSM(f32x16& p0, f32x16& p1, float& l_reg, bf16x8& pa0, bf16x8& pa1, bf16x8& pa2, bf16x8& pa3) {
  for (int r = 0; r < 16; ++r) p1[r] = __builtin_amdgcn_exp2f(p1[r]);
  float ps = 0; for (int r = 0; r < 16; ++r) ps += p0[r]; for (int r = 0; r < 16; ++r) ps += p1[r];
  l_reg += ps;
#define PK4(P, BASE, OUT) do { unsigned a0 = cvtpk(P[BASE + 0], P[BASE + 1]), a1 = cvtpk(P[BASE + 2], P[BASE + 3]);   \
    unsigned b0 = cvtpk(P[BASE + 4], P[BASE + 5]), b1 = cvtpk(P[BASE + 6], P[BASE + 7]);                              \
    auto r0 = __builtin_amdgcn_permlane32_swap(a0, b0, false, false); auto r1 = __builtin_amdgcn_permlane32_swap(a1, b1, false, false); \
    u32x4 w = {r0[0], r1[0], r0[1], r1[1]}; OUT = *reinterpret_cast<bf16x8*>(&w); } while (0)
  PK4(p0, 0, pa0); PK4(p0, 8, pa1); PK4(p1, 0, pa2); PK4(p1, 8, pa3);
#undef PK4
}
__device__ __forceinline__ void qkt(f32x16& p0, f32x16& p1, const bf16* Ks, const bf16x8* qr, int r32, int hi) {
  p0 = f32x16{}; p1 = f32x16{};
  for (int d0 = 0; d0 < 8; ++d0) { int cb = (d0 * 16 + hi * 8) * 2;
    bf16x8 b0 = *reinterpret_cast<const bf16x8*>((const char*)Ks + KSWZ(r32, cb));
    bf16x8 b1 = *reinterpret_cast<const bf16x8*>((const char*)Ks + KSWZ(32 + r32, cb));
    p0 = __builtin_amdgcn_mfma_f32_32x32x16_bf16(b0, qr[d0], p0, 0, 0, 0);
    p1 = __builtin_amdgcn_mfma_f32_32x32x16_bf16(b1, qr[d0], p1, 0, 0, 0); }
}
__device__ __forceinline__ int v_st(int k, int c) { const int kk = (k & ~0xC) | ((k & 4) << 1) | ((k & 8) >> 1); return ((kk >> 3) * 4 + (c >> 5)) * 512 + ((kk & 7) * 32 + (c & 31)) * 2; }
__device__ __forceinline__ int v_rd_base(int lane) { return ((lane & 3) << 3) | (((lane >> 2) & 3) << 6) | (((lane >> 4) & 1) << 5) | (((lane >> 5) & 1) << 8); }
constexpr int v_rd_off(int d0, int ks, int half) { return d0 * 512 + ks * 4096 + half * 2048; }
template <int OFF> __device__ __forceinline__ s16x4 tr_read(int vb) {
  s16x4 r; asm volatile("ds_read_b64_tr_b16 %0, %1 offset:%2" : "=&v"(r) : "v"(vb), "i"(OFF) : "memory"); return r;
}
template <int D0> __device__ __forceinline__ void pv_one(f32x16& od, int vb, bf16x8 pa0, bf16x8 pa1, bf16x8 pa2, bf16x8 pa3) {
  const s16x4 l0 = tr_read<v_rd_off(D0, 0, 0)>(vb), h0 = tr_read<v_rd_off(D0, 0, 1)>(vb), l1 = tr_read<v_rd_off(D0, 1, 0)>(vb), h1 = tr_read<v_rd_off(D0, 1, 1)>(vb);
  const s16x4 l2 = tr_read<v_rd_off(D0, 2, 0)>(vb), h2 = tr_read<v_rd_off(D0, 2, 1)>(vb), l3 = tr_read<v_rd_off(D0, 3, 0)>(vb), h3 = tr_read<v_rd_off(D0, 3, 1)>(vb);
  asm volatile("s_waitcnt lgkmcnt(0)" ::: "memory"); SBAR();
#define PK(L, H) (bf16x8){L[0], L[1], L[2], L[3], H[0], H[1], H[2], H[3]}
  od = __builtin_amdgcn_mfma_f32_32x32x16_bf16(pa0, PK(l0, h0), od, 0, 0, 0);
  od = __builtin_amdgcn_mfma_f32_32x32x16_bf16(pa1, PK(l1, h1), od, 0, 0, 0);
  od = __builtin_amdgcn_mfma_f32_32x32x16_bf16(pa2, PK(l2, h2), od, 0, 0, 0);
  od = __builtin_amdgcn_mfma_f32_32x32x16_bf16(pa3, PK(l3, h3), od, 0, 0, 0);
#undef PK
}
__device__ __forceinline__ void pv_d0(f32x16* o, int vb, bf16x8 pa0, bf16x8 pa1, bf16x8 pa2, bf16x8 pa3) {
  pv_one<0>(o[0], vb, pa0, pa1, pa2, pa3); pv_one<1>(o[1], vb, pa0, pa1, pa2, pa3); pv_one<2>(o[2], vb, pa0, pa1, pa2, pa3); pv_one<3>(o[3], vb, pa0, pa1, pa2, pa3);
}

template <typename TQ>
__device__ __forceinline__ void attn_dense_body(const TQ* __restrict__ Qb, const bf16* __restrict__ Kh, const bf16* __restrict__ Vh,
                                                bf16* __restrict__ Ob, int seq, char* lds, float mC) {
  using St = Stage<bf16>; using SQ = Stage<TQ>;
  int tid_ = threadIdx.x; asm volatile("" : "+v"(tid_));
  const int tid = tid_, wid = tid >> 6, lane = tid & 63, r32 = lane & 31, hi = lane >> 5;
  bf16* V_lds = (bf16*)lds; bf16* K_lds = (bf16*)(lds + 2 * SHM_V);
  float* ws = (float*)(lds + 2 * SHM_V + 2 * SHM_K) + wid * 64; float* li_l = ws;
  float l_reg = 0; f32x16 o[4] = {}; bf16x8 qr[8];
  const TQ* Qw = Qb + (long)(wid * QBLK + r32) * LDQ + hi * 8;
#pragma unroll
  for (int d0 = 0; d0 < 8; ++d0) qr[d0] = SQ::tobf(SQ::ld8(Qw + d0 * 16));
  const int sr = tid >> 4, sc = (tid & 15) * 8, vst0 = v_st(sr, sc), vst1 = v_st(32 + sr, sc);
  const int vb0 = (int)(uintptr_t)V_lds + v_rd_base(lane);
  struct { typename St::T vs0, vs1, ks0, ks1; } sr_[SDEPTH];
#define SLOAD(i, k0) do { sr_[i].vs0 = St::ld8(&Vh[(long)((k0) + sr) * LDK + sc]); sr_[i].vs1 = St::ld8(&Vh[(long)((k0) + 32 + sr) * LDK + sc]); \
    sr_[i].ks0 = St::ld8(&Kh[(long)((k0) + sr) * LDK + sc]); sr_[i].ks1 = St::ld8(&Kh[(long)((k0) + 32 + sr) * LDK + sc]); } while (0)
#define SWRITE(b, i) do { *(bf16x8*)((char*)V_lds + (b) * SHM_V + vst0) = St::tobf(sr_[i].vs0);          \
    *(bf16x8*)((char*)V_lds + (b) * SHM_V + vst1) = St::tobf(sr_[i].vs1); int kc = sc * 2;               \
    *(bf16x8*)((char*)K_lds + (b) * SHM_K + KSWZ(sr, kc)) = St::tobf(sr_[i].ks0);                       \
    *(bf16x8*)((char*)K_lds + (b) * SHM_K + KSWZ(32 + sr, kc)) = St::tobf(sr_[i].ks1); } while (0)
#define SWAIT() do { if constexpr (SDEPTH == 2) asm volatile("s_waitcnt vmcnt(4)" ::: "memory"); else asm volatile("s_waitcnt vmcnt(0)" ::: "memory"); } while (0)
  f32x16 pA0, pA1, pB0, pB1; bf16x8 pa0, pa1, pa2, pa3; const int NT = seq / KVBLK;
  constexpr int SE = 0, SO = SDEPTH - 1;
  SLOAD(SE, 0); asm volatile("s_waitcnt vmcnt(0)" ::: "memory"); SWRITE(0, SE); __syncthreads();
  qkt(pA0, pA1, K_lds, qr, r32, hi); partialSM(pA0, pA1, mC);
  SLOAD(SO, KVBLK); if constexpr (SDEPTH == 2) { if (2 < NT) SLOAD(SE, 2 * KVBLK); }
  SWAIT(); SWRITE(1, SO); __syncthreads();
  for (int j = 1; j + 1 < NT; j += 2) {
    SBAR(); qkt(pB0, pB1, (bf16*)((char*)K_lds + SHM_K), qr, r32, hi);
    finishSM(pA0, pA1, l_reg, pa0, pa1, pa2, pa3); SBAR();
    SLOAD(SO, (j + SDEPTH) * KVBLK); SBAR();
    pv_d0(o, vb0, pa0, pa1, pa2, pa3); partialSM(pB0, pB1, mC);
    __syncthreads(); SWAIT(); SWRITE(0, SE);
    __syncthreads();
    SBAR(); qkt(pA0, pA1, K_lds, qr, r32, hi);
    finishSM(pB0, pB1, l_reg, pa0, pa1, pa2, pa3); SBAR();
    if (SDEPTH == 1 || j + 3 < NT) SLOAD(SE, (j + 1 + SDEPTH) * KVBLK); SBAR();
    pv_d0(o, vb0 + (int)SHM_V, pa0, pa1, pa2, pa3); partialSM(pA0, pA1, mC);
    __syncthreads(); SWAIT(); SWRITE(1, SO);
    __syncthreads();
  }
  SBAR(); qkt(pB0, pB1, (bf16*)((char*)K_lds + SHM_K), qr, r32, hi);
  finishSM(pA0, pA1, l_reg, pa0, pa1, pa2, pa3); SBAR();
  pv_d0(o, vb0, pa0, pa1, pa2, pa3); partialSM(pB0, pB1, mC);
  __syncthreads();
  finishSM(pB0, pB1, l_reg, pa0, pa1, pa2, pa3); SBAR();
  pv_d0(o, vb0 + (int)SHM_V, pa0, pa1, pa2, pa3);
  { auto rr = __builtin_amdgcn_permlane32_swap(__float_as_uint(l_reg), __float_as_uint(l_reg), false, false); l_reg = __uint_as_float(rr[0]) + __uint_as_float(rr[1]); }
  if (hi == 0) li_l[r32] = l_reg; asm volatile("s_waitcnt lgkmcnt(0)" ::: "memory");
  float rli[16];
#pragma unroll
  for (int r = 0; r < 16; ++r) rli[r] = __builtin_amdgcn_rcpf(li_l[crow(r, hi)]);
  bf16* Ow = Ob + (long)(wid * QBLK) * LDO;
#pragma unroll
  for (int r = 0; r < 16; ++r) { int orow = crow(r, hi);
    for (int d0 = 0; d0 < 4; ++d0) Ow[(long)orow * LDO + d0 * 32 + r32] = __float2bfloat16(o[d0][r] * rli[r]); }
  __syncthreads();
#undef SLOAD
#undef SWRITE
#undef SWAIT
}
#undef KSWZ
#undef SBAR
}

struct Frame {
    LAS unsigned char* lds;
    char* ldsg;
    int tid, lane, wave, vcu, G;
    unsigned char* ws;
};
__device__ __forceinline__ const float* frame_in(const Frame& F, int i) {
    const LAS unsigned* p = (const LAS unsigned*)(F.lds + LDSCTL_OFF + 64) + 2 * i;
    const unsigned lo = __builtin_amdgcn_readfirstlane(p[0]), hi = __builtin_amdgcn_readfirstlane(p[1]);
    return (const float*)(const GAS float*)(((unsigned long long)hi << 32) | lo);
}
#define FIN(i) frame_in(F, (i))
#define FOUT() ((float*)frame_in(F, 17))
#define WSP(T, off) ((T*)(F.ws + (off)))

__device__ __forceinline__ void p0_transpose_item(const float* W, int K, int N, int Npad, bf16_t* WT, int row_off, LAS float* scr, int item, int lane, const float* kscale = nullptr) {
    const int nblk = Npad / 32, kb = item / nblk, nb = item % nblk, k0 = 64 * kb, n0 = 32 * nb;
    const int nn = n0 + 4 * (lane & 7);
    f32x4 v[8];
#pragma unroll
    for (int i = 0; i < 8; ++i) { const int kk = 8 * i + (lane >> 3); v[i] = nn < N ? *(const f32x4*)(W + (size_t)(k0 + kk) * N + nn) : (f32x4){0.f, 0.f, 0.f, 0.f}; }
#pragma unroll
    for (int i = 0; i < 8; ++i) { const int kk = 8 * i + (lane >> 3); *(LAS f32x4*)(scr + kk * 36 + 4 * (lane & 7)) = v[i]; }
    LDS_WAIT(); asm volatile("" ::: "memory");
    const int c = lane & 7;
    f32x4 ka = {1.f, 1.f, 1.f, 1.f}, kc = ka; if (kscale) { ka = *(const f32x4*)(kscale + k0 + 8 * c); kc = *(const f32x4*)(kscale + k0 + 8 * c + 4); }
#pragma unroll
    for (int j = 0; j < 4; ++j) { const int n = (lane >> 3) + 8 * j; const LAS float* s = scr + (8 * c) * 36 + n;
        u32x4 o; o.x = pk2(s[0 * 36] * ka.x, s[1 * 36] * ka.y); o.y = pk2(s[2 * 36] * ka.z, s[3 * 36] * ka.w); o.z = pk2(s[4 * 36] * kc.x, s[5 * 36] * kc.y); o.w = pk2(s[6 * 36] * kc.z, s[7 * 36] * kc.w);
        *(GAS u32x4*)(WT + (size_t)(row_off + n0 + n) * K + k0 + 8 * c) = o; }
    LDS_WAIT(); asm volatile("" ::: "memory");
}
__device__ __forceinline__ u32x4 cvt8(const float* p) {
    const f32x4 a = *(const f32x4*)p, b = *(const f32x4*)(p + 4);
    u32x4 o; o.x = pk2(a.x, a.y); o.y = pk2(a.z, a.w); o.z = pk2(b.x, b.y); o.w = pk2(b.z, b.w); return o;
}
__device__ __forceinline__ void rms_row_to_bf16(const float* xrow, const float* g, bf16_t* orow, int lane) {
    const f32x4* xr = (const f32x4*)xrow + lane;
    f32x4 v[8]; float s = 0.f;
#pragma unroll
    for (int j = 0; j < 8; ++j) { v[j] = xr[64 * j]; s += (v[j].x * v[j].x + v[j].y * v[j].y) + (v[j].z * v[j].z + v[j].w * v[j].w); }
    const float r = 1.0f / sqrtf(wave_sum(s) * (1.f / DM) + EPS);
    u32x2* o8 = (u32x2*)orow + lane;
#pragma unroll
    for (int j = 0; j < 8; ++j) { const f32x4 gg = ((const f32x4*)g)[lane + 64 * j]; u32x2 w; w.x = pk2(v[j].x * r * gg.x, v[j].y * r * gg.y); w.y = pk2(v[j].z * r * gg.z, v[j].w * r * gg.w); o8[64 * j] = w; }
}
__device__ __forceinline__ void ph_prologue(const Frame& F) {
    LAS float* scr = (LAS float*)(F.lds + F.wave * 16384);
    const int gw = F.vcu * NWAVES + F.wave, NGW = F.G * NWAVES;
#if TBL_FP4
    const float* gff = FIN(2) + F.lane * 4; const float* tsrc0 = FIN(14) + F.lane * 4; const float* tsrc1 = FIN(15) + F.lane * 4;
    for (int row = gw; row < 4 * 16384; row += NGW) {
        const int tb = row >> 15, rr = row & 32767;
        const float* src = (tb ? tsrc1 : tsrc0) + (size_t)rr * DM;
        f32x4 v[8]; float am = 0.f;
#pragma unroll
        for (int q = 0; q < 8; ++q) v[q] = *(const f32x4*)(src + 256 * q);
        if (tb == 0) {
#pragma unroll
            for (int q = 0; q < 8; ++q) v[q] = v[q] * *(const f32x4*)(gff + (rr >> 14) * DM + 256 * q); }
#pragma unroll
        for (int q = 0; q < 8; ++q) am = fmaxf(am, fmaxf(fmaxf(fabsf(v[q].x), fabsf(v[q].y)), fmaxf(fabsf(v[q].z), fabsf(v[q].w))));
#pragma unroll
        for (int o = 1; o < 64; o <<= 1) am = fmaxf(am, __shfl_xor(am, o));
        const float sc = am > 0.f ? am * (1.f / 6.f) : 1.f, isc = 1.0f / sc;
        unsigned char* dst = F.ws + (tb ? WS_VB : WS_UB) + (size_t)(rr >> 14) * (16384 * 1024) + (size_t)(rr & 16383) * 128 + F.lane * 2;
#pragma unroll
        for (int q = 0; q < 8; ++q) { unsigned p = 0u;
            p = __builtin_amdgcn_cvt_scalef32_pk_fp4_f32(p, v[q].x * isc, v[q].y * isc, 1.0f, 0); p = __builtin_amdgcn_cvt_scalef32_pk_fp4_f32(p, v[q].z * isc, v[q].w * isc, 1.0f, 1);
            *(unsigned short*)(dst + (size_t)q * (16384 * 128)) = (unsigned short)p; }
        if (F.lane == 0) ((float*)(F.ws + WS_TSC))[row] = sc;
    }
#else
    for (int row = gw; row < 4 * 16384; row += NGW) {
        const int tb = row >> 15, rr = row & 32767;
        const float* src = FIN(14 + tb) + (size_t)rr * DM + F.lane * 16;
        f32x4 v[8]; float am = 0.f;
#pragma unroll
        for (int q = 0; q < 8; ++q) { v[q] = *(const f32x4*)(src + (q >> 2) * 1024 + (q & 3) * 4);
            am = fmaxf(am, fmaxf(fmaxf(fabsf(v[q].x), fabsf(v[q].y)), fmaxf(fabsf(v[q].z), fabsf(v[q].w)))); }
#pragma unroll
        for (int o = 1; o < 64; o <<= 1) am = fmaxf(am, __shfl_xor(am, o));
        const float sc = am > 0.f ? am * (1.f / 448.f) : 1.f, isc = 1.0f / sc;
        unsigned w[8];
#pragma unroll
        for (int q = 0; q < 8; ++q) { unsigned p = __builtin_amdgcn_cvt_pk_fp8_f32(v[q].x * isc, v[q].y * isc, 0u, false); w[q] = __builtin_amdgcn_cvt_pk_fp8_f32(v[q].z * isc, v[q].w * isc, p, true); }
        unsigned char* dst = F.ws + (tb ? WS_VB : WS_UB) + (size_t)(rr >> 14) * (16384 * 2048) + ((size_t)(F.lane >> 3) * 16384 + (rr & 16383)) * 128 + (F.lane & 7) * 16;
        *(u32x4*)dst = (u32x4){w[0], w[1], w[2], w[3]}; *(u32x4*)(dst + (size_t)8 * 16384 * 128) = (u32x4){w[4], w[5], w[6], w[7]};
        if (F.lane == 0) ((float*)(F.ws + WS_TSC))[row] = sc;
    }
#endif
    {   constexpr int I_IN = (DM / 64) * (INP / 32), I_SQ = (DM / 64) * (DM / 32), I_PL = 4 * (512 / 64) * (512 / 32);
        constexpr int NIT = I_IN + 3 * I_SQ + I_PL;
        for (int it = gw; it < NIT; it += NGW) {
            int r = it;
            if (r < I_IN) { p0_transpose_item(FIN(3), DM, INW, INP, WSP(bf16_t, WS_WIN), 0, scr, r, F.lane); continue; } r -= I_IN;
            if (r < I_SQ) { p0_transpose_item(FIN(9), DM, DM, DM, WSP(bf16_t, WS_WOUT), 0, scr, r, F.lane); continue; } r -= I_SQ;
            if (r < I_SQ) { p0_transpose_item(FIN(12), DM, DM, DM, WSP(bf16_t, WS_WQ0), 0, scr, r, F.lane, FIN(2)); continue; } r -= I_SQ;
            if (r < I_SQ) { p0_transpose_item(FIN(12) + (size_t)DM * DM, DM, DM, DM, WSP(bf16_t, WS_WQ1), 0, scr, r, F.lane, FIN(2) + DM); continue; } r -= I_SQ;
            const int grp = r / 128, ri = r % 128;
            p0_transpose_item(FIN(10) + (size_t)grp * 512 * 512, 512, 512, 512, WSP(bf16_t, WS_WPOOL), grp * 512, scr, ri, F.lane);
        }
    }
    for (int it = gw; it < 1024; it += NGW) *(u32x4*)(WSP(bf16_t, WS_KEYS) + (size_t)it * 512 + F.lane * 8) = cvt8(FIN(13) + (size_t)it * 512 + F.lane * 8);
    for (int m = gw; m < S; m += NGW) rms_row_to_bf16(FIN(0) + (size_t)m * DM, FIN(1), WSP(bf16_t, WS_XN) + (size_t)m * DM, F.lane);
}

__device__ __forceinline__ float silu_f(float z) { return z / (1.f + __expf(-z)); }
__device__ __forceinline__ void p2_qkv_token(const Frame& F, int t) {
    const int lane = F.lane, i8 = lane & 7;
    const bf16_t* pr = WSP(bf16_t, WS_PROJ) + (size_t)t * INP;
    const int axis = i8 >> 2, half = (i8 >> 1) & 1, f0 = (i8 & 1) * 16;
    const float pos = (float)(axis == 0 ? (t >> 6) : (t & 63));
    float cs[16], sn[16];
#pragma unroll
    for (int e = 0; e < 16; ++e) { const float inv = exp2f(-(float)(f0 + e) * (13.287712379549449f / 32.f));
        float rev = pos * inv * 0.15915494309189535f; rev -= rintf(rev);
        cs[e] = __builtin_amdgcn_cosf(rev); sn[e] = __builtin_amdgcn_sinf(rev); }
    const float sgn = half ? 1.f : -1.f;
    {   const u32x4 w0 = *(const u32x4*)(pr + C_AQ + lane * 16), w1 = *(const u32x4*)(pr + C_AQ + lane * 16 + 8);
        float v[16]; const unsigned ww[8] = {w0.x, w0.y, w0.z, w0.w, w1.x, w1.y, w1.z, w1.w};
#pragma unroll
        for (int e = 0; e < 8; ++e) { v[2 * e] = bflo(ww[e]); v[2 * e + 1] = bfhi(ww[e]); }
        float ss = 0.f;
#pragma unroll
        for (int e = 0; e < 16; ++e) ss += v[e] * v[e];
        ss += __shfl_xor(ss, 1); ss += __shfl_xor(ss, 2); ss += __shfl_xor(ss, 4);
        const float r = 1.0f / sqrtf(ss * (1.f / 128.f) + EPS);
        const float* gq = FIN(6) + i8 * 16;
        unsigned ow[8];
        float y[16];
#pragma unroll
        for (int e = 0; e < 16; ++e) y[e] = v[e] * r * gq[e];
#pragma unroll
        for (int e = 0; e < 16; ++e) { const float yp = __shfl_xor(y[e], 2); y[e] = y[e] * cs[e] + sgn * yp * sn[e]; }
#pragma unroll
        for (int e = 0; e < 8; ++e) ow[e] = pk2(y[2 * e], y[2 * e + 1]);
        bf16_t* dst = WSP(bf16_t, WS_QB) + (size_t)t * 1024 + lane * 16;
        *(u32x4*)dst = (u32x4){ow[0], ow[1], ow[2], ow[3]}; *(u32x4*)(dst + 8) = (u32x4){ow[4], ow[5], ow[6], ow[7]};
    }
    {   const int l16 = lane & 15;
        const u32x4 w0 = *(const u32x4*)(pr + C_AK + l16 * 16), w1 = *(const u32x4*)(pr + C_AK + l16 * 16 + 8);
        float v[16]; const unsigned ww[8] = {w0.x, w0.y, w0.z, w0.w, w1.x, w1.y, w1.z, w1.w};
#pragma unroll
        for (int e = 0; e < 8; ++e) { v[2 * e] = bflo(ww[e]); v[2 * e + 1] = bfhi(ww[e]); }
        float ss = 0.f;
#pragma unroll
        for (int e = 0; e < 16; ++e) ss += v[e] * v[e];
        ss += __shfl_xor(ss, 1); ss += __shfl_xor(ss, 2); ss += __shfl_xor(ss, 4);
        const float r = 1.0f / sqrtf(ss * (1.f / 128.f) + EPS);
        const float* gk = FIN(7) + i8 * 16;
        float y[16]; unsigned ow[8];
#pragma unroll
        for (int e = 0; e < 16; ++e) y[e] = v[e] * r * gk[e];
#pragma unroll
        for (int e = 0; e < 16; ++e) { const float yp = __shfl_xor(y[e], 2); y[e] = y[e] * cs[e] + sgn * yp * sn[e]; }
#pragma unroll
        for (int e = 0; e < 8; ++e) ow[e] = pk2(y[2 * e], y[2 * e + 1]);
        bf16_t* kv = WSP(bf16_t, WS_KVB) + (size_t)t * 512;
        if (lane < 16) { *(u32x4*)(kv + lane * 16) = (u32x4){ow[0], ow[1], ow[2], ow[3]}; *(u32x4*)(kv + lane * 16 + 8) = (u32x4){ow[4], ow[5], ow[6], ow[7]}; }
        else if (lane < 32) { const u32x4 a = *(const u32x4*)(pr + C_AV + l16 * 16), b = *(const u32x4*)(pr + C_AV + l16 * 16 + 8);
            *(u32x4*)(kv + 256 + l16 * 16) = a; *(u32x4*)(kv + 256 + l16 * 16 + 8) = b; }
    }
}
__device__ __forceinline__ void p2_conv_item(const Frame& F, int item) {
    const int tb = item >> 2, sl = item & 3, lane = F.lane, c = sl * 512 + lane * 8, t0 = tb * 16;
    float w[5][8];
#pragma unroll
    for (int j = 0; j < 5; ++j) { const f32x4 a = *(const f32x4*)(FIN(5) + j * 2048 + c), b = *(const f32x4*)(FIN(5) + j * 2048 + c + 4);
        w[j][0] = a.x; w[j][1] = a.y; w[j][2] = a.z; w[j][3] = a.w; w[j][4] = b.x; w[j][5] = b.y; w[j][6] = b.z; w[j][7] = b.w; }
    const bf16_t* src = WSP(bf16_t, WS_PROJ) + C_MQK + c;
    const float osc = (c >= 1024) ? 0.0625f : 1.f;
    bf16_t* dst = (c >= 1024) ? WSP(bf16_t, WS_MK) + (c - 1024) : WSP(bf16_t, WS_MQ) + c;
    u32x4 rows[20];
#pragma unroll
    for (int j = 0; j < 20; ++j) { const int tt = t0 - 2 + j; rows[j] = (tt >= 0 && tt < S) ? *(const u32x4*)(src + (size_t)tt * INP) : (u32x4){0u, 0u, 0u, 0u}; }
#pragma unroll
    for (int q = 0; q < 16; ++q) {
        float acc[8];
#pragma unroll
        for (int e = 0; e < 8; ++e) acc[e] = 0.f;
#pragma unroll
        for (int j = 0; j < 5; ++j) { const unsigned ww[4] = {rows[q + j].x, rows[q + j].y, rows[q + j].z, rows[q + j].w};
#pragma unroll
            for (int e = 0; e < 4; ++e) { acc[2 * e] += bflo(ww[e]) * w[j][2 * e]; acc[2 * e + 1] += bfhi(ww[e]) * w[j][2 * e + 1]; } }
        u32x4 o; o.x = pk2(silu_f(acc[0]) * osc, silu_f(acc[1]) * osc); o.y = pk2(silu_f(acc[2]) * osc, silu_f(acc[3]) * osc);
        o.z = pk2(silu_f(acc[4]) * osc, silu_f(acc[5]) * osc); o.w = pk2(silu_f(acc[6]) * osc, silu_f(acc[7]) * osc);
        *(u32x4*)(dst + (size_t)(t0 + q) * 1024) = o;
    }
}
__device__ __forceinline__ float wave_incl_scan_add(float v, int lane) {
#pragma unroll
    for (int o = 1; o < 64; o <<= 1) { const float u = __shfl_up(v, o); if (lane >= o) v += u; }
    return v;
}
__device__ __forceinline__ float wave_incl_scan_max(float v, int lane) {
#pragma unroll
    for (int o = 1; o < 64; o <<= 1) { const float u = __shfl_up(v, o); if (lane >= o) v = fmaxf(v, u); }
    return v;
}
__device__ __forceinline__ float logsigmoid_f(float x) { return fminf(x, 0.f) - log1pf(__expf(-fabsf(x))); }
__device__ __forceinline__ void p2_gate_item(const Frame& F, int item) {
    const int dh = item >> 7, c = item & 127, dir = dh >> 2, h = dh & 3, lane = F.lane;
    const int p0 = 128 * c + 2 * lane, t0 = dir ? (S - 1 - p0) : p0, t1 = dir ? (t0 - 1) : (t0 + 1);
    const bf16_t* pg = WSP(bf16_t, WS_PROJ) + C_GATE + dir * 8 + h;
    const float bi = FIN(4)[dir * 8 + h], bf = FIN(4)[dir * 8 + 4 + h];
    const float i0 = bflo((unsigned)pg[(size_t)t0 * INP]) + bi, f0 = bflo((unsigned)pg[(size_t)t0 * INP + 4]) + bf;
    const float i1 = bflo((unsigned)pg[(size_t)t1 * INP]) + bi, f1 = bflo((unsigned)pg[(size_t)t1 * INP + 4]) + bf;
    const float lf0 = logsigmoid_f(f0), lf1 = logsigmoid_f(f1);
    const float incl = wave_incl_scan_add(lf0 + lf1, lane);
    const float b1 = incl, b0 = incl - lf1;
    const float u0 = i0 - b0, u1 = i1 - b1;
    const float mincl = wave_incl_scan_max(fmaxf(u0, u1), lane);
    float mprevl = __shfl_up(mincl, 1); if (lane == 0) mprevl = -INFINITY;
    const float pm0 = fmaxf(mprevl, u0), pm1 = mincl;
    float* GB = (float*)(F.ws + WS_GATES + GO_B) + (size_t)dh * S; float* GU = (float*)(F.ws + WS_GATES + GO_U) + (size_t)dh * S; float* GPM = (float*)(F.ws + WS_GATES + GO_PM) + (size_t)dh * S;
    GB[t0] = b0; GB[t1] = b1; GU[t0] = u0; GU[t1] = u1; GPM[t0] = pm0; GPM[t1] = pm1;
    if (lane == 63) { ((float*)(F.ws + WS_GATES + GO_G))[dh * 128 + c] = b1; ((float*)(F.ws + WS_GATES + GO_PML))[dh * 128 + c] = pm1; }
}
__device__ __forceinline__ void ph_post(const Frame& F) {
    const int gw = F.vcu * NWAVES + F.wave, NGW = F.G * NWAVES;
    for (int it = gw; it < 1024; it += NGW) p2_gate_item(F, it);
    for (int it = gw; it < 4096; it += NGW) p2_conv_item(F, it);
    for (int t = gw; t < S; t += NGW) p2_qkv_token(F, t);
}

#define MFMA16(a, b, c) __builtin_amdgcn_mfma_f32_16x16x32_bf16((a), (b), (c), 0, 0, 0)
__device__ __forceinline__ bf16x8 frag_tr(LAS const unsigned char* base, int pitch, int k0, int x0, int lane) {
    const int g = lane >> 4, i = lane & 15;
    LAS const unsigned char* p = base + (k0 + 8 * g + (i >> 2)) * pitch + (x0 + 4 * (i & 3)) * 2;
    const s16x4 lo = __builtin_bit_cast(s16x4, __builtin_amdgcn_ds_read_tr16_b64_v4i16((LAS v4i16_t*)p));
    const s16x4 hi = __builtin_bit_cast(s16x4, __builtin_amdgcn_ds_read_tr16_b64_v4i16((LAS v4i16_t*)(p + 4 * pitch)));
    return (bf16x8){lo[0], lo[1], lo[2], lo[3], hi[0], hi[1], hi[2], hi[3]};
}
__device__ __forceinline__ bf16x8 frag_kc(LAS const unsigned char* base, int pitch, int x0, int k0, int lane) {
    return *(LAS const bf16x8*)(base + (x0 + (lane & 15)) * pitch + (k0 + 8 * (lane >> 4)) * 2);
}

constexpr int MLA_PK = 544, MLA_PV = 288;
constexpr int MLA_OFF_V = 128 * MLA_PK;
__device__ __forceinline__ void ph_mla(const Frame& F) {
    const int tid = F.tid, lane = F.lane, wave = F.wave;
    LAS unsigned char* Kw = F.lds; LAS unsigned char* Vs = F.lds + MLA_OFF_V;
    const float* GU = (const float*)(F.ws + WS_GATES + GO_U); const float* GPML = (const float*)(F.ws + WS_GATES + GO_PML);
    for (int item = F.vcu; item < 2048; item += F.G) {
        const int hv = item & 1, c = (item >> 1) & 127, dh = item >> 8, dir = dh >> 2, head = dh & 3;
        const int tc = dir ? 127 - c : c, t0 = tc * 128;
        const float pml = GPML[dh * 128 + c];
        {   const bf16_t* mk = WSP(bf16_t, WS_MK) + (size_t)t0 * 1024 + head * 256;
#pragma unroll
            for (int j = 0; j < 8; ++j) { const int r = (tid >> 5) + 16 * j, c8 = (tid & 31) * 8;
                const u32x4 x = *(const u32x4*)(mk + (size_t)r * 1024 + c8); const float w = __expf(GU[(size_t)dh * S + t0 + r] - pml);
                u32x4 o; o.x = pk2(bflo(x.x) * w, bfhi(x.x) * w); o.y = pk2(bflo(x.y) * w, bfhi(x.y) * w); o.z = pk2(bflo(x.z) * w, bfhi(x.z) * w); o.w = pk2(bflo(x.w) * w, bfhi(x.w) * w);
                *(LAS u32x4*)(Kw + r * MLA_PK + c8 * 2) = o; }
            const bf16_t* mv = WSP(bf16_t, WS_PROJ) + (size_t)t0 * INP + C_MV + head * 256 + hv * 128;
#pragma unroll
            for (int j = 0; j < 4; ++j) { const int r = (tid >> 4) + 32 * j, c8 = (tid & 15) * 8;
                *(LAS u32x4*)(Vs + r * MLA_PV + c8 * 2) = *(const u32x4*)(mv + (size_t)r * INP + c8); }
        }
        __syncthreads();
        f32x4 acc[4][4];
#pragma unroll
        for (int a = 0; a < 4; ++a)
#pragma unroll
            for (int b = 0; b < 4; ++b) acc[a][b] = (f32x4){0.f, 0.f, 0.f, 0.f};
        const int mb = (wave & 3) * 64, nb = (wave >> 2) * 64;
#pragma unroll
        for (int ks = 0; ks < 4; ++ks) {
            bf16x8 af[4], bfr[4];
#pragma unroll
            for (int a = 0; a < 4; ++a) af[a] = frag_tr(Kw, MLA_PK, 32 * ks, mb + 16 * a, lane);
#pragma unroll
            for (int b = 0; b < 4; ++b) bfr[b] = frag_tr(Vs, MLA_PV, 32 * ks, nb + 16 * b, lane);
#pragma unroll
            for (int a = 0; a < 4; ++a)
#pragma unroll
                for (int b = 0; b < 4; ++b) acc[a][b] = MFMA16(af[a], bfr[b], acc[a][b]);
        }
        {   bf16_t* cst = WSP(bf16_t, WS_CST) + ((size_t)(dh * 128 + c) << 16);
            const int g = lane >> 4, i = lane & 15;
#pragma unroll
            for (int a = 0; a < 4; ++a)
#pragma unroll
                for (int b = 0; b < 4; ++b) { u32x2 o; o.x = pk2(acc[a][b][0], acc[a][b][1]); o.y = pk2(acc[a][b][2], acc[a][b][3]);
                    *(u32x2*)(cst + (size_t)(hv * 128 + nb + 16 * b + i) * 256 + mb + 16 * a + 4 * g) = o; }
        }
        if (hv == 0 && tid < 256) { float s = 0.f;
#pragma unroll 8
            for (int r = 0; r < 128; ++r) s += bflo((unsigned)*(LAS const bf16_t*)(Kw + r * MLA_PK + tid * 2));
            ((float*)(F.ws + WS_NST))[(size_t)(dh * 128 + c) * 256 + tid] = s; }
        __syncthreads();
    }
}

__device__ __forceinline__ void ph_scan(const Frame& F) {
    const float* GG = (const float*)(F.ws + WS_GATES + GO_G); const float* GPML = (const float*)(F.ws + WS_GATES + GO_PML); float* MPREV = (float*)(F.ws + WS_GATES + GO_MPREV);
    const int nthreads = F.G * NTHR;
    for (int gi = F.vcu * NTHR + F.tid; gi < 8 * 16384; gi += nthreads) {
        const int dh = gi >> 14, e4 = gi & 16383;
        bf16_t* base = WSP(bf16_t, WS_CST) + ((size_t)dh * 128 << 16) + e4 * 4;
        float st0 = 0.f, st1 = 0.f, st2 = 0.f, st3 = 0.f, m = 0.f;
#pragma unroll 1
        for (int c0 = 0; c0 < 128; c0 += 32) {
            u32x2 ld[32];
#pragma unroll
            for (int q = 0; q < 32; ++q) ld[q] = *(const u32x2*)(base + ((size_t)(c0 + q) << 16));
#pragma unroll
            for (int q = 0; q < 32; ++q) { const int c = c0 + q;
                const float g = GG[dh * 128 + c], amax = g + GPML[dh * 128 + c];
                const float mn = fmaxf(g + m, amax), dec = __expf(g + m - mn), add = __expf(amax - mn);
                if (e4 == 0) MPREV[dh * 128 + c] = m;
                u32x2 o; o.x = pk2(st0, st1); o.y = pk2(st2, st3);
                *(u32x2*)(base + ((size_t)c << 16)) = o;
                st0 = dec * st0 + add * bflo(ld[q].x); st1 = dec * st1 + add * bfhi(ld[q].x); st2 = dec * st2 + add * bflo(ld[q].y); st3 = dec * st3 + add * bfhi(ld[q].y);
                m = mn; }
        }
    }
    for (int gi = F.vcu * NTHR + F.tid; gi < 8 * 256; gi += nthreads) {
        const int dh = gi >> 8, e = gi & 255;
        float* base = (float*)(F.ws + WS_NST) + (size_t)dh * 128 * 256 + e;
        float st = 0.f, m = 0.f;
#pragma unroll 4
        for (int c = 0; c < 128; ++c) {
            const float g = GG[dh * 128 + c], amax = g + GPML[dh * 128 + c];
            const float mn = fmaxf(g + m, amax), dec = __expf(g + m - mn), add = __expf(amax - mn);
            const float ld = base[c * 256]; base[c * 256] = st; st = dec * st + add * ld; m = mn; }
    }
}

constexpr int MLB_PIECE = 34816;
constexpr int MLB_PKC = 528, MLB_PTR = 544, MLB_PP = 272;
constexpr int MLB_OFF_P = 2 * MLB_PIECE;
constexpr int MLB_OFF_N = MLB_OFF_P + 2 * 8 * 16 * MLB_PP;
static_assert(MLB_OFF_N + 2048 <= LDSCTL_OFF, "mLSTM-B LDS map");
__device__ __forceinline__ void ph_mlb(const Frame& F) {
    const int wave = F.wave;
    const float* GB = (const float*)(F.ws + WS_GATES + GO_B); const float* GU = (const float*)(F.ws + WS_GATES + GO_U); const float* GPM = (const float*)(F.ws + WS_GATES + GO_PM);
    const float* MPREV = (const float*)(F.ws + WS_GATES + GO_MPREV);
    LAS unsigned char* buf0 = F.lds; LAS unsigned char* buf1 = F.lds + MLB_PIECE;
    LAS float* nprev = (LAS float*)(F.lds + MLB_OFF_N);
    for (int unit = F.vcu; unit < 512; unit += F.G) {
        int tid = F.tid; asm volatile("" : "+v"(tid));
        const int lane = tid & 63, g = lane >> 4, i = lane & 15;
        const int head = unit >> 7, tc = unit & 127, t0 = tc * 128, j0 = 16 * wave;
        const bf16_t* mkp = WSP(bf16_t, WS_MK) + (size_t)t0 * 1024 + head * 256;
        const bf16_t* mvp = WSP(bf16_t, WS_PROJ) + (size_t)t0 * INP + C_MV + head * 256;
        const int c_f = tc, c_b = 127 - tc;
        u32x4 stg[4];
        const int sr = tid >> 5, sc8 = (tid & 31) * 8;
#define PIECE_LOAD(srcp, pitch_el) do { _Pragma("unroll") for (int q_ = 0; q_ < 4; ++q_) stg[q_] = *(const u32x4*)((srcp) + (size_t)(sr + 16 * q_) * (pitch_el) + sc8); } while (0)
#define PIECE_WRITE(dstbuf, pitchB) do { _Pragma("unroll") for (int q_ = 0; q_ < 4; ++q_) *(LAS u32x4*)((dstbuf) + (sr + 16 * q_) * (pitchB) + sc8 * 2) = stg[q_]; } while (0)
        { const int d = tid >> 8, e = tid & 255; nprev[d * 256 + e] = ((const float*)(F.ws + WS_NST))[(size_t)((d * 4 + head) * 128 + (d ? c_b : c_f)) * 256 + e]; }
        bf16x8 qa[8];
        {   const bf16_t* mq = WSP(bf16_t, WS_MQ) + (size_t)(t0 + j0 + i) * 1024 + head * 256 + 8 * g;
#pragma unroll
            for (int s = 0; s < 8; ++s) qa[s] = *(const bf16x8*)(mq + 32 * s); }
        f32x4 sacc[8];
#pragma unroll
        for (int n = 0; n < 8; ++n) sacc[n] = (f32x4){0.f, 0.f, 0.f, 0.f};
        PIECE_LOAD(mkp, 1024); PIECE_WRITE(buf0, MLB_PKC);
        PIECE_LOAD(mkp + (size_t)64 * 1024, 1024);
        __syncthreads();
#pragma unroll
        for (int n = 0; n < 4; ++n)
            { _Pragma("unroll") for (int s = 0; s < 8; ++s) sacc[n] = MFMA16(qa[s], frag_kc(buf0, MLB_PKC, 16 * n, 32 * s, lane), sacc[n]); __builtin_amdgcn_sched_barrier(0); }
        PIECE_WRITE(buf1, MLB_PKC);
        __syncthreads();
#pragma unroll
        for (int n = 0; n < 4; ++n)
            { _Pragma("unroll") for (int s = 0; s < 8; ++s) sacc[4 + n] = MFMA16(qa[s], frag_kc(buf1, MLB_PKC, 16 * n, 32 * s, lane), sacc[4 + n]); __builtin_amdgcn_sched_barrier(0); }
        const bf16_t* cst0 = WSP(bf16_t, WS_CST) + ((size_t)((0 * 4 + head) * 128 + c_f) << 16);
        const bf16_t* cst1 = WSP(bf16_t, WS_CST) + ((size_t)((1 * 4 + head) * 128 + c_b) << 16);
        PIECE_LOAD(cst0, 256);
        float qsc0, qsc1;
#pragma unroll
        for (int d = 0; d < 2; ++d) {
            const int dh = d * 4 + head; const float mp = MPREV[dh * 128 + (d ? c_b : c_f)];
            f32x4 dacc = (f32x4){0.f, 0.f, 0.f, 0.f};
#pragma unroll
            for (int s = 0; s < 8; ++s) { bf16x8 bn; const LAS float* np = nprev + d * 256 + 32 * s + 8 * g;
#pragma unroll
                for (int e = 0; e < 8; ++e) bn[e] = (i == 0) ? (short)f2bf(np[e]) : (short)0;
                dacc = MFMA16(qa[s], bn, dacc); }
            float ur[8];
#pragma unroll
            for (int n = 0; n < 8; ++n) ur[n] = GU[(size_t)dh * S + t0 + 16 * n + i];
            LAS unsigned char* pw = F.lds + MLB_OFF_P + (d * 8 + wave) * (16 * MLB_PP);
            float es[4];
#pragma unroll
            for (int rg = 0; rg < 4; ++rg) { const int jl = 4 * g + rg, j = j0 + jl;
                const float M = fmaxf(mp, GPM[(size_t)dh * S + t0 + j]), ej = __expf(mp - M), mj = GB[(size_t)dh * S + t0 + j] + M;
                float rs = 0.f;
#pragma unroll
                for (int n = 0; n < 8; ++n) { const int r = 16 * n + i; const bool keep = d ? (r >= j) : (r <= j); rs += keep ? sacc[n][rg] * __expf(ur[n] - M) : 0.f; }
                rs += __shfl_xor(rs, 1); rs += __shfl_xor(rs, 2); rs += __shfl_xor(rs, 4); rs += __shfl_xor(rs, 8);
                const float qn = __shfl(dacc[rg], lane & 48);
                const float den = ej * qn + rs, sj = 1.0f / fmaxf(fabsf(den), __expf(-mj));
                es[rg] = ej * sj;
#pragma unroll
                for (int n = 0; n < 8; ++n) { const int r = 16 * n + i; const bool keep = d ? (r >= j) : (r <= j);
                    const float p = keep ? sacc[n][rg] * __expf(ur[n] - M) * sj : 0.f;
                    *(LAS bf16_t*)(pw + jl * MLB_PP + r * 2) = (bf16_t)f2bf(p); } }
            const int srcl = (i >> 2) << 4;
            const float t0_ = __shfl(es[0], srcl), t1_ = __shfl(es[1], srcl), t2_ = __shfl(es[2], srcl), t3_ = __shfl(es[3], srcl);
            const float qs_ = (i & 3) == 0 ? t0_ : (i & 3) == 1 ? t1_ : (i & 3) == 2 ? t2_ : t3_;
            if (d == 0) qsc0 = qs_; else qsc1 = qs_;
        }
        __syncthreads();
        f32x4 hacc[16];
#pragma unroll
        for (int n = 0; n < 16; ++n) hacc[n] = (f32x4){0.f, 0.f, 0.f, 0.f};
#pragma unroll
        for (int d = 0; d < 2; ++d) {
            const bf16_t* cst = d ? cst1 : cst0; const float qsc = d ? qsc1 : qsc0;
            bf16x8 qs[8];
#pragma unroll
            for (int s = 0; s < 8; ++s) { const u32x4 w = __builtin_bit_cast(u32x4, qa[s]); u32x4 o;
                o.x = pk2(bflo(w.x) * qsc, bfhi(w.x) * qsc); o.y = pk2(bflo(w.y) * qsc, bfhi(w.y) * qsc); o.z = pk2(bflo(w.z) * qsc, bfhi(w.z) * qsc); o.w = pk2(bflo(w.w) * qsc, bfhi(w.w) * qsc);
                qs[s] = __builtin_bit_cast(bf16x8, o); }
#pragma unroll
            for (int cp = 0; cp < 4; ++cp) {
                LAS unsigned char* cur = (cp & 1) ? buf1 : buf0;
                PIECE_WRITE(cur, MLB_PKC);
                if (cp < 3) PIECE_LOAD(cst + (size_t)(64 * (cp + 1)) * 256, 256); else PIECE_LOAD(mvp, INP);
                __syncthreads();
#pragma unroll
                for (int n = 0; n < 4; ++n)
                    { _Pragma("unroll") for (int s = 0; s < 8; ++s) hacc[4 * cp + n] = MFMA16(qs[s], frag_kc(cur, MLB_PKC, 16 * n, 32 * s, lane), hacc[4 * cp + n]); __builtin_amdgcn_sched_barrier(0); }
            }
            LAS const unsigned char* pw = F.lds + MLB_OFF_P + (d * 8 + wave) * (16 * MLB_PP);
#pragma unroll
            for (int vp = 0; vp < 2; ++vp) {
                LAS unsigned char* cur = (vp & 1) ? buf1 : buf0;
                PIECE_WRITE(cur, MLB_PTR);
                if (vp == 0) PIECE_LOAD(mvp + (size_t)64 * INP, INP); else if (d == 0) PIECE_LOAD(cst1, 256);
                __syncthreads();
#pragma unroll
                for (int ks = 0; ks < 2; ++ks) { const bf16x8 a = *(LAS const bf16x8*)(pw + i * MLB_PP + (64 * vp + 32 * ks + 8 * g) * 2);
#pragma unroll
                    for (int n = 0; n < 16; ++n) { hacc[n] = MFMA16(a, frag_tr(cur, MLB_PTR, 32 * ks, 16 * n, lane), hacc[n]); if ((n & 3) == 3) __builtin_amdgcn_sched_barrier(0); } }
            }
            __syncthreads();
        }
        {   const float* mg = FIN(8) + head * 256;
            const bf16_t* mo = WSP(bf16_t, WS_PROJ) + C_MO + head * 256; bf16_t* y = WSP(bf16_t, WS_Y) + 1024 + head * 256;
#pragma unroll
            for (int rg = 0; rg < 4; ++rg) { float ss = 0.f;
#pragma unroll
                for (int n = 0; n < 16; ++n) ss += hacc[n][rg] * hacc[n][rg];
                ss += __shfl_xor(ss, 1); ss += __shfl_xor(ss, 2); ss += __shfl_xor(ss, 4); ss += __shfl_xor(ss, 8);
                const float r = 1.0f / sqrtf(ss * (1.f / 256.f) + EPS); const size_t t = (size_t)(t0 + j0 + 4 * g + rg);
#pragma unroll
                for (int n = 0; n < 16; ++n) { const int col = 16 * n + i; const float o = bflo((unsigned)mo[t * INP + col]);
                    #if defined(DBG_ZERO_ML)
                    y[t * DM + col] = 0;
#else
                    y[t * DM + col] = (bf16_t)f2bf(hacc[n][rg] * r * mg[col] * (1.f / (1.f + __expf(-o))));
#endif
                    } }
        }
#undef PIECE_LOAD
#undef PIECE_WRITE
    }
}

#define MFMA32(a, b, c) __builtin_amdgcn_mfma_f32_32x32x16_bf16((a), (b), (c), 0, 0, 0)
__device__ __forceinline__ int fkey(float x) { const int b = __builtin_bit_cast(int, x); return b ^ ((b >> 31) & 0x7fffffff); }
__device__ __forceinline__ float kval(int k) { return __builtin_bit_cast(float, k ^ ((k >> 31) & 0x7fffffff)); }
#define CE_(a, i, j) { const int hi_ = max(a[i], a[j]); a[j] = min(a[i], a[j]); a[i] = hi_; }
#define SORT16(a) do { CE_(a,0,13) CE_(a,1,12) CE_(a,2,15) CE_(a,3,14) CE_(a,4,8) CE_(a,5,6) CE_(a,7,11) CE_(a,9,10) CE_(a,0,5) CE_(a,1,7) CE_(a,2,9) CE_(a,3,4) CE_(a,6,13) CE_(a,8,14) CE_(a,10,15) CE_(a,11,12) CE_(a,0,1) CE_(a,2,3) CE_(a,4,5) CE_(a,6,8) CE_(a,7,9) CE_(a,10,11) CE_(a,12,13) CE_(a,14,15) CE_(a,0,2) CE_(a,1,3) CE_(a,4,10) CE_(a,5,11) CE_(a,6,7) CE_(a,8,9) CE_(a,12,14) CE_(a,13,15) CE_(a,1,2) CE_(a,3,12) CE_(a,4,6) CE_(a,5,7) CE_(a,8,10) CE_(a,9,11) CE_(a,13,14) CE_(a,1,4) CE_(a,2,6) CE_(a,5,8) CE_(a,7,10) CE_(a,9,13) CE_(a,11,14) CE_(a,2,4) CE_(a,3,6) CE_(a,9,12) CE_(a,11,13) CE_(a,3,5) CE_(a,6,8) CE_(a,7,9) CE_(a,10,12) CE_(a,3,4) CE_(a,5,6) CE_(a,7,8) CE_(a,9,10) CE_(a,11,12) CE_(a,6,7) CE_(a,8,9) } while (0)
#define MERGE16(a, b) do { _Pragma("unroll") for (int k_ = 0; k_ < 16; ++k_) a[k_] = max(a[k_], b[15 - k_]); CE_(a,0,8) CE_(a,1,9) CE_(a,2,10) CE_(a,3,11) CE_(a,4,12) CE_(a,5,13) CE_(a,6,14) CE_(a,7,15) CE_(a,0,4) CE_(a,1,5) CE_(a,2,6) CE_(a,3,7) CE_(a,8,12) CE_(a,9,13) CE_(a,10,14) CE_(a,11,15) CE_(a,0,2) CE_(a,1,3) CE_(a,4,6) CE_(a,5,7) CE_(a,8,10) CE_(a,9,11) CE_(a,12,14) CE_(a,13,15) CE_(a,0,1) CE_(a,2,3) CE_(a,4,5) CE_(a,6,7) CE_(a,8,9) CE_(a,10,11) CE_(a,12,13) CE_(a,14,15) } while (0)
#define TOP_INS(top, x) do { int x_ = (x); _Pragma("unroll") for (int k_ = 0; k_ < 16; ++k_) { const int hi_ = max(top[k_], x_); x_ = min(top[k_], x_); top[k_] = hi_; } } while (0)
__device__ __forceinline__ int pick4(int sel, int a, int b, int c, int d) { return sel == 0 ? a : sel == 1 ? b : sel == 2 ? c : d; }
__device__ __forceinline__ void topk_item(const Frame& F, int layer, int item) {
    const int tile = item >> 3, h = item & 7, lane = F.lane, r32 = lane & 31, hi = lane >> 5;
    const int t = tile * 32 + r32;
    const bf16_t* qrow = WSP(bf16_t, WS_QP) + (size_t)t * DM + h * 256 + 8 * hi;
    int tops[2][16];
#pragma unroll
    for (int p = 0; p < 2; ++p) {
        const bf16_t* keys = WSP(bf16_t, WS_KEYS) + (size_t)(((layer * 8 + h) * 2 + p) * 128) * 128 + 8 * hi;
        bf16x8 bq[8];
#pragma unroll
        for (int s = 0; s < 8; ++s) bq[s] = *(const bf16x8*)(qrow + p * 128 + 16 * s);
        int top[16];
#pragma unroll
        for (int kt = 0; kt < 4; ++kt) {
            f32x16 acc = {};
#pragma unroll
            for (int s = 0; s < 8; ++s) { const bf16x8 a = *(const bf16x8*)(keys + (size_t)(32 * kt + r32) * 128 + 16 * s); acc = MFMA32(a, bq[s], acc); }
            int vals[16];
#pragma unroll
            for (int r = 0; r < 16; ++r) { const int idx = 32 * kt + (r & 3) + 8 * (r >> 2) + 4 * hi; vals[r] = (fkey(acc[r]) & ~127) | idx; }
            SORT16(vals);
            if (kt == 0) {
#pragma unroll
                for (int k = 0; k < 16; ++k) top[k] = vals[k]; }
            else MERGE16(top, vals);
        }
        int pt[16];
#pragma unroll
        for (int k = 0; k < 16; ++k) pt[k] = __shfl_xor(top[k], 32);
        MERGE16(top, pt);
#pragma unroll
        for (int k = 0; k < 16; ++k) tops[p][k] = top[k];
    }
    float af[16], bfv[16];
#pragma unroll
    for (int k = 0; k < 16; ++k) { af[k] = kval(tops[0][k] & ~127); bfv[k] = kval(tops[1][k] & ~127); }
#define CKEY(i, j) ((fkey(af[i] + bfv[j]) & ~255) | (255 - (((i) << 4) | (j))))
    int top2[16], aux[16];
#pragma unroll
    for (int j = 0; j < 16; ++j) top2[j] = CKEY(0, j);
#pragma unroll
    for (int j = 0; j < 16; ++j) aux[j] = j < 8 ? CKEY(1, j) : (int)0x80000000;
    MERGE16(top2, aux);
#pragma unroll
    for (int j = 0; j < 16; ++j) aux[j] = j < 8 ? CKEY(8 + j, 0) : (int)0x80000000;
    MERGE16(top2, aux);
    aux[0] = CKEY(2, 0); aux[1] = CKEY(2, 1); aux[2] = CKEY(2, 2); aux[3] = CKEY(2, 3); aux[4] = CKEY(2, 4); aux[5] = CKEY(3, 0); aux[6] = CKEY(3, 1); aux[7] = CKEY(3, 2);
    aux[8] = CKEY(3, 3); aux[9] = CKEY(4, 0); aux[10] = CKEY(4, 1); aux[11] = CKEY(4, 2); aux[12] = CKEY(5, 0); aux[13] = CKEY(5, 1); aux[14] = CKEY(6, 0); aux[15] = CKEY(6, 1);
    SORT16(aux); MERGE16(top2, aux);
    TOP_INS(top2, CKEY(7, 0)); TOP_INS(top2, CKEY(7, 1));
#undef CKEY
    int pa[4], pb[4];
#pragma unroll
    for (int q = 0; q < 4; ++q) { pa[q] = (tops[0][4 * q] & 127) | ((tops[0][4 * q + 1] & 127) << 8) | ((tops[0][4 * q + 2] & 127) << 16) | ((tops[0][4 * q + 3] & 127) << 24);
                                  pb[q] = (tops[1][4 * q] & 127) | ((tops[1][4 * q + 1] & 127) << 8) | ((tops[1][4 * q + 2] & 127) << 16) | ((tops[1][4 * q + 3] & 127) << 24); }
    int ex[16]; float sc[16];
#pragma unroll
    for (int k = 0; k < 16; ++k) { const int code = 255 - (top2[k] & 255), ii = code >> 4, jj = code & 15;
        const int ea = (pick4(ii >> 2, pa[0], pa[1], pa[2], pa[3]) >> ((ii & 3) * 8)) & 127, eb = (pick4(jj >> 2, pb[0], pb[1], pb[2], pb[3]) >> ((jj & 3) * 8)) & 127;
        ex[k] = ea * 128 + eb; sc[k] = kval(top2[k] & ~255); }
    const float mx = sc[0]; float sum = 0.f;
#pragma unroll
    for (int k = 0; k < 16; ++k) { sc[k] = __expf(sc[k] - mx); sum += sc[k]; }
    const float inv = 1.0f / sum;
    if (hi == 0) { int* d = WSP(int, WS_EIDX) + (size_t)t * 128 + h * 16;
#pragma unroll
        for (int q = 0; q < 4; ++q) *(u32x4*)(d + 4 * q) = (u32x4){(unsigned)ex[4 * q], (unsigned)ex[4 * q + 1], (unsigned)ex[4 * q + 2], (unsigned)ex[4 * q + 3]}; }
    else { float* d = WSP(float, WS_EGATE) + (size_t)t * 128 + h * 16;
#pragma unroll
        for (int q = 0; q < 4; ++q) *(f32x4*)(d + 4 * q) = (f32x4){sc[4 * q] * inv, sc[4 * q + 1] * inv, sc[4 * q + 2] * inv, sc[4 * q + 3] * inv}; }
}
__device__ __forceinline__ void ph_topk(const Frame& F, int layer) {
    const int gw = F.vcu * NWAVES + F.wave, NGW = F.G * NWAVES;
    for (int it = gw; it < 4096; it += NGW) topk_item(F, layer, it);
}

typedef __bf16 bf2 __attribute__((ext_vector_type(2)));
__device__ __forceinline__ float dot2bf(bf2 a, unsigned b, float c) { return __builtin_amdgcn_fdot2_f32_bf16(a, __builtin_bit_cast(bf2, b), c, false); }
__device__ __forceinline__ float dot4_fp8(unsigned w, unsigned xlo, unsigned xhi, float c) {
    c = dot2bf(__builtin_amdgcn_cvt_scalef32_pk_bf16_fp8(w, 1.0f, false), xlo, c);
    return dot2bf(__builtin_amdgcn_cvt_scalef32_pk_bf16_fp8(w, 1.0f, true), xhi, c);
}
#if TBL_FP4
constexpr int NSL = 8;
constexpr size_t WS_PART = WS_CST;
constexpr size_t WS_W = WS_KVB;
__device__ __forceinline__ float dot8_fp4(unsigned w, u32x4 x, float c) {
    c = dot2bf(__builtin_amdgcn_cvt_scalef32_pk_bf16_fp4(w, 1.0f, 0), x.x, c); c = dot2bf(__builtin_amdgcn_cvt_scalef32_pk_bf16_fp4(w, 1.0f, 1), x.y, c);
    c = dot2bf(__builtin_amdgcn_cvt_scalef32_pk_bf16_fp4(w, 1.0f, 2), x.z, c); return dot2bf(__builtin_amdgcn_cvt_scalef32_pk_bf16_fp4(w, 1.0f, 3), x.w, c);
}
__device__ __forceinline__ void ph_gu(const Frame& F, int layer) {
    const int lane = F.lane, r8 = lane >> 3, c16 = lane & 7;
    const int nper = F.G >> 3, xl = F.vcu / nper, wx = (F.vcu % nper) * NWAVES + F.wave, nwx = nper * NWAVES;
    const int s = xl;
    const unsigned char* Us = F.ws + WS_UB + (size_t)layer * (16384 * 1024) + (size_t)s * (16384 * 128);
    const unsigned char* eb = F.ws + WS_EIDX; unsigned char* pb = F.ws + WS_PART + (size_t)s * S * 512; const unsigned char* xb = F.ws + WS_XN + s * 512;
    const unsigned eo = 64u * r8, po = 8u * lane, xo = 64u * c16, uo = 16u * c16;
#define LDU(T, base, off) (*(const T*)((base) + (unsigned)(off)))
    u32x4 ia[2][4];
#pragma unroll
    for (int q = 0; q < 4; ++q) { ia[0][q] = LDU(u32x4, eb, (unsigned)wx * 512u + eo + 16u * q); ia[1][q] = LDU(u32x4, eb, (unsigned)(wx + nwx) * 512u + eo + 16u * q); }
#pragma unroll 1
    for (int t = wx; t < S; t += 2 * nwx) {
        const int t1 = t + nwx;
        u32x4 ur[2][16];
#pragma unroll
        for (int z = 0; z < 2; ++z)
#pragma unroll
            for (int q = 0; q < 16; ++q) { const unsigned id = ia[z][q >> 2][q & 3]; ur[z][q] = LDU(u32x4, Us, id * 128u + uo); }
        { const int tn = (t + 2 * nwx < S) ? t + 2 * nwx : t;
#pragma unroll
          for (int q = 0; q < 4; ++q) { ia[0][q] = LDU(u32x4, eb, (unsigned)tn * 512u + eo + 16u * q); ia[1][q] = LDU(u32x4, eb, (unsigned)(tn + nwx) * 512u + eo + 16u * q); } }
#pragma unroll
        for (int z = 0; z < 2; ++z) {
            const unsigned xoff = (unsigned)(z ? t1 : t) * 4096u + xo; const u32x4 x0 = LDU(u32x4, xb, xoff), x1 = LDU(u32x4, xb, xoff + 16u), x2 = LDU(u32x4, xb, xoff + 32u), x3 = LDU(u32x4, xb, xoff + 48u);
            float v[16];
#pragma unroll
            for (int q = 0; q < 16; ++q) { const u32x4 w = ur[z][q]; float a = dot8_fp4(w.x, x0, 0.f); a = dot8_fp4(w.y, x1, a); a = dot8_fp4(w.z, x2, a); v[q] = dot8_fp4(w.w, x3, a); }
            float r8v[8], r4v[4], r2v[2];
            { const bool up = lane & 4;
#pragma unroll
              for (int q = 0; q < 8; ++q) { const float keep = up ? v[q + 8] : v[q], give = up ? v[q] : v[q + 8]; r8v[q] = keep + __shfl_xor(give, 4); } }
            { const bool up = lane & 2;
#pragma unroll
              for (int q = 0; q < 4; ++q) { const float keep = up ? r8v[q + 4] : r8v[q], give = up ? r8v[q] : r8v[q + 4]; r4v[q] = keep + __shfl_xor(give, 2); } }
            { const bool up = lane & 1;
#pragma unroll
              for (int q = 0; q < 2; ++q) { const float keep = up ? r4v[q + 2] : r4v[q], give = up ? r4v[q] : r4v[q + 2]; r2v[q] = keep + __shfl_xor(give, 1); } }
            *(f32x2*)(pb + ((unsigned)(z ? t1 : t) * 512u + po)) = (f32x2){r2v[0], r2v[1]};
        }
    }
}
__device__ __forceinline__ void ph_act(const Frame& F, int layer) {
    const int lane = F.lane, gw = F.vcu * NWAVES + F.wave, NGW = F.G * NWAVES;
    const float* su = (const float*)(F.ws + WS_TSC) + layer * 16384; const float* sv = su + 32768;
    for (int t = gw; t < S; t += NGW) {
        const float* part = WSP(float, WS_PART) + (size_t)t * 128 + 2 * lane;
        f32x2 a = {0.f, 0.f};
#pragma unroll
        for (int s = 0; s < NSL; ++s) a += *(const f32x2*)(part + (size_t)s * S * 128);
        const u32x2 id = *(const u32x2*)(WSP(int, WS_EIDX) + (size_t)t * 128 + 2 * lane); const f32x2 g = *(const f32x2*)(WSP(float, WS_EGATE) + (size_t)t * 128 + 2 * lane);
        const float rs = rstd_of(((const unsigned long long*)(F.ws + WS_CTL + CTL_SSQ))[(layer ? 2 : 0) * S + t]);
        const float a0 = a.x * su[id.x] * rs, a1 = a.y * su[id.y] * rs;
        const float w0 = 0.5f * a0 * (1.f + erff(a0 * 0.70710678118654752f)) * g.x * sv[id.x], w1 = 0.5f * a1 * (1.f + erff(a1 * 0.70710678118654752f)) * g.y * sv[id.y];
        *(f32x2*)(WSP(float, WS_W) + (size_t)t * 128 + 2 * lane) = (f32x2){w0, w1};
    }
}
__device__ __forceinline__ void ph_gv(const Frame& F, int layer) {
    const int lane = F.lane, r8 = lane >> 3, c16 = lane & 7;
    const int nper = F.G >> 3, xl = F.vcu / nper, wx = (F.vcu % nper) * NWAVES + F.wave, nwx = nper * NWAVES;
    const int s = xl;
    const unsigned char* Vs = F.ws + WS_VB + (size_t)layer * (16384 * 1024) + (size_t)s * (16384 * 128);
    const unsigned char* eb = F.ws + WS_EIDX; const unsigned char* wb = F.ws + WS_W; unsigned char* hb = F.ws + WS_H + s * 1024;
    const unsigned eo = 64u * r8, ho = 128u * c16 + 16u * r8, vo = 16u * c16;
    u32x4 ia[2][4];
#pragma unroll
    for (int q = 0; q < 4; ++q) { ia[0][q] = LDU(u32x4, eb, (unsigned)wx * 512u + eo + 16u * q); ia[1][q] = LDU(u32x4, eb, (unsigned)(wx + nwx) * 512u + eo + 16u * q); }
#pragma unroll 1
    for (int t = wx; t < S; t += 2 * nwx) {
        const int t1 = t + nwx;
        u32x4 vr[2][16];
#pragma unroll
        for (int z = 0; z < 2; ++z)
#pragma unroll
            for (int q = 0; q < 16; ++q) { const unsigned id = ia[z][q >> 2][q & 3]; vr[z][q] = LDU(u32x4, Vs, id * 128u + vo); }
        { const int tn = (t + 2 * nwx < S) ? t + 2 * nwx : t;
#pragma unroll
          for (int q = 0; q < 4; ++q) { ia[0][q] = LDU(u32x4, eb, (unsigned)tn * 512u + eo + 16u * q); ia[1][q] = LDU(u32x4, eb, (unsigned)(tn + nwx) * 512u + eo + 16u * q); } }
        f32x4 wqa[2][4]; f32x4 hold[2];
#pragma unroll
        for (int z = 0; z < 2; ++z) { const unsigned tt = (unsigned)(z ? t1 : t);
#pragma unroll
            for (int q = 0; q < 4; ++q) wqa[z][q] = LDU(f32x4, wb, tt * 512u + eo + 16u * q);
            hold[z] = LDU(f32x4, hb, tt * 8192u + ho); }
#pragma unroll
        for (int z = 0; z < 2; ++z) {
            const unsigned tt = (unsigned)(z ? t1 : t);
            f32x2 acc[16];
#pragma unroll
            for (int e = 0; e < 16; ++e) acc[e] = (f32x2){0.f, 0.f};
#pragma unroll
            for (int q = 0; q < 16; ++q) { const float w = wqa[z][q >> 2][q & 3]; const f32x2 ww = {w, w}; const unsigned d4[4] = {vr[z][q].x, vr[z][q].y, vr[z][q].z, vr[z][q].w};
#pragma unroll
                for (int e = 0; e < 4; ++e) { acc[4 * e] += ww * __builtin_amdgcn_cvt_scalef32_pk_f32_fp4(d4[e], 1.0f, 0); acc[4 * e + 1] += ww * __builtin_amdgcn_cvt_scalef32_pk_f32_fp4(d4[e], 1.0f, 1);
                    acc[4 * e + 2] += ww * __builtin_amdgcn_cvt_scalef32_pk_f32_fp4(d4[e], 1.0f, 2); acc[4 * e + 3] += ww * __builtin_amdgcn_cvt_scalef32_pk_f32_fp4(d4[e], 1.0f, 3); } }
            f32x2 b8[8], b4[4], b2[2];
            { const bool up = lane & 32;
#pragma unroll
              for (int e = 0; e < 8; ++e) { const f32x2 keep = up ? acc[e + 8] : acc[e], give = up ? acc[e] : acc[e + 8]; b8[e] = keep + (f32x2){__shfl_xor(give.x, 32), __shfl_xor(give.y, 32)}; } }
            { const bool up = lane & 16;
#pragma unroll
              for (int e = 0; e < 4; ++e) { const f32x2 keep = up ? b8[e + 4] : b8[e], give = up ? b8[e] : b8[e + 4]; b4[e] = keep + (f32x2){__shfl_xor(give.x, 16), __shfl_xor(give.y, 16)}; } }
            { const bool up = lane & 8;
#pragma unroll
              for (int e = 0; e < 2; ++e) { const f32x2 keep = up ? b4[e + 2] : b4[e], give = up ? b4[e] : b4[e + 2]; b2[e] = keep + (f32x2){__shfl_xor(give.x, 8), __shfl_xor(give.y, 8)}; } }
#if defined(DBG_ZERO_PEER)
            b2[0] = (f32x2){0.f, 0.f}; b2[1] = b2[0];
#endif
            const f32x4 hn = hold[z] + (f32x4){b2[0].x, b2[0].y, b2[1].x, b2[1].y};
            *(f32x4*)(hb + (tt * 8192u + ho)) = hn;
            if (layer == 0) {
                u32x2 w; w.x = pk2(hn.x, hn.y); w.y = pk2(hn.z, hn.w); *(u32x2*)(F.ws + WS_XN + s * 512 + (tt * 4096u + (ho >> 1))) = w;
                const float sq = wave_sum((hn.x * hn.x + hn.y * hn.y) + (hn.z * hn.z + hn.w * hn.w));
                if (lane == 0) atomicAdd((unsigned long long*)(F.ws + WS_CTL + CTL_SSQ) + S + tt, (unsigned long long)(sq * 1048576.0f)); }
        }
    }
}
#else
constexpr int NSL = 16;
constexpr size_t WS_PART = WS_CST;
constexpr size_t WS_W = WS_KVB;
__device__ __forceinline__ void ph_gu(const Frame& F, int layer) {
    const int lane = F.lane, r8 = lane >> 3, c16 = lane & 7;
    const int nper = F.G >> 3, xl = F.vcu / nper, wx = (F.vcu % nper) * NWAVES + F.wave, nwx = nper * NWAVES;
    const unsigned char* U = F.ws + WS_UB + (size_t)layer * 16384 * 2048 + c16 * 16;
    const int* eidx = WSP(int, WS_EIDX) + 16 * r8;
#pragma unroll 1
    for (int p = 0; p < 2; ++p) {
        const int s = xl + 8 * p;
        const unsigned char* Us = U + (size_t)s * (16384 * 128);
        float* part = WSP(float, WS_PART) + (size_t)s * S * 128 + 2 * lane;
        const bf16_t* xs = WSP(bf16_t, WS_XN) + s * 128 + c16 * 16;
        u32x4 ia[2][4];
#pragma unroll
        for (int q = 0; q < 4; ++q) { ia[0][q] = *(const u32x4*)(eidx + (size_t)wx * 128 + 4 * q); ia[1][q] = *(const u32x4*)(eidx + (size_t)(wx + nwx) * 128 + 4 * q); }
#pragma unroll 1
        for (int t = wx; t < S; t += 2 * nwx) {
            const int t1 = t + nwx;
            u32x4 ur[2][16];
#pragma unroll
            for (int z = 0; z < 2; ++z)
#pragma unroll
                for (int q = 0; q < 16; ++q) { const unsigned id = ia[z][q >> 2][q & 3]; ur[z][q] = *(const u32x4*)(Us + (size_t)id * 128); }
            { const int tn = (t + 2 * nwx < S) ? t + 2 * nwx : t;
#pragma unroll
              for (int q = 0; q < 4; ++q) { ia[0][q] = *(const u32x4*)(eidx + (size_t)tn * 128 + 4 * q); ia[1][q] = *(const u32x4*)(eidx + (size_t)(tn + nwx) * 128 + 4 * q); } }
#pragma unroll
            for (int z = 0; z < 2; ++z) {
                const bf16_t* xr = xs + (size_t)(z ? t1 : t) * DM; const u32x4 x0 = *(const u32x4*)xr, x1 = *(const u32x4*)(xr + 8);
                float v[16];
#pragma unroll
                for (int q = 0; q < 16; ++q) { const u32x4 w = ur[z][q]; float a = dot4_fp8(w.x, x0.x, x0.y, 0.f); a = dot4_fp8(w.y, x0.z, x0.w, a); a = dot4_fp8(w.z, x1.x, x1.y, a); v[q] = dot4_fp8(w.w, x1.z, x1.w, a); }
                float r8v[8], r4v[4], r2v[2];
                { const bool up = lane & 4;
#pragma unroll
                  for (int q = 0; q < 8; ++q) { const float keep = up ? v[q + 8] : v[q], give = up ? v[q] : v[q + 8]; r8v[q] = keep + __shfl_xor(give, 4); } }
                { const bool up = lane & 2;
#pragma unroll
                  for (int q = 0; q < 4; ++q) { const float keep = up ? r8v[q + 4] : r8v[q], give = up ? r8v[q] : r8v[q + 4]; r4v[q] = keep + __shfl_xor(give, 2); } }
                { const bool up = lane & 1;
#pragma unroll
                  for (int q = 0; q < 2; ++q) { const float keep = up ? r4v[q + 2] : r4v[q], give = up ? r4v[q] : r4v[q + 2]; r2v[q] = keep + __shfl_xor(give, 1); } }
                *(f32x2*)(part + (size_t)(z ? t1 : t) * 128) = (f32x2){r2v[0], r2v[1]};
            }
        }
    }
}
__device__ __forceinline__ void ph_act(const Frame& F, int layer) {
    const int lane = F.lane, gw = F.vcu * NWAVES + F.wave, NGW = F.G * NWAVES;
    const float* su = (const float*)(F.ws + WS_TSC) + layer * 16384; const float* sv = su + 32768;
    for (int t = gw; t < S; t += NGW) {
        const float* part = WSP(float, WS_PART) + (size_t)t * 128 + 2 * lane;
        f32x2 a = {0.f, 0.f};
#pragma unroll
        for (int s = 0; s < NSL; ++s) a += *(const f32x2*)(part + (size_t)s * S * 128);
        const u32x2 id = *(const u32x2*)(WSP(int, WS_EIDX) + (size_t)t * 128 + 2 * lane); const f32x2 g = *(const f32x2*)(WSP(float, WS_EGATE) + (size_t)t * 128 + 2 * lane);
        const float a0 = a.x * su[id.x], a1 = a.y * su[id.y];
        const float w0 = 0.5f * a0 * (1.f + erff(a0 * 0.70710678118654752f)) * g.x * sv[id.x], w1 = 0.5f * a1 * (1.f + erff(a1 * 0.70710678118654752f)) * g.y * sv[id.y];
        *(f32x2*)(WSP(float, WS_W) + (size_t)t * 128 + 2 * lane) = (f32x2){w0, w1};
    }
}
__device__ __forceinline__ void ph_gv(const Frame& F, int layer) {
    const int lane = F.lane, r8 = lane >> 3, c16 = lane & 7;
    const int nper = F.G >> 3, xl = F.vcu / nper, wx = (F.vcu % nper) * NWAVES + F.wave, nwx = nper * NWAVES;
    const unsigned char* V = F.ws + WS_VB + (size_t)layer * 16384 * 2048 + c16 * 16;
    const int* eidx = WSP(int, WS_EIDX) + 16 * r8; const float* wv = WSP(float, WS_W) + 16 * r8;
#pragma unroll 1
    for (int p = 0; p < 2; ++p) {
        const int s = xl + 8 * p;
        const unsigned char* Vs = V + (size_t)s * (16384 * 128);
        float* hs = WSP(float, WS_H) + s * 128 + 16 * c16 + 2 * r8;
        u32x4 ia[2][4];
#pragma unroll
        for (int q = 0; q < 4; ++q) { ia[0][q] = *(const u32x4*)(eidx + (size_t)wx * 128 + 4 * q); ia[1][q] = *(const u32x4*)(eidx + (size_t)(wx + nwx) * 128 + 4 * q); }
#pragma unroll 1
        for (int t = wx; t < S; t += 2 * nwx) {
            const int t1 = t + nwx;
            u32x4 vr[2][16];
#pragma unroll
            for (int z = 0; z < 2; ++z)
#pragma unroll
                for (int q = 0; q < 16; ++q) { const unsigned id = ia[z][q >> 2][q & 3]; vr[z][q] = *(const u32x4*)(Vs + (size_t)id * 128); }
            { const int tn = (t + 2 * nwx < S) ? t + 2 * nwx : t;
#pragma unroll
              for (int q = 0; q < 4; ++q) { ia[0][q] = *(const u32x4*)(eidx + (size_t)tn * 128 + 4 * q); ia[1][q] = *(const u32x4*)(eidx + (size_t)(tn + nwx) * 128 + 4 * q); } }
            f32x4 wqa[2][4]; f32x2 hold[2];
#pragma unroll
            for (int z = 0; z < 2; ++z) { const size_t tt = (size_t)(z ? t1 : t);
#pragma unroll
                for (int q = 0; q < 4; ++q) wqa[z][q] = *(const f32x4*)(wv + tt * 128 + 4 * q);
                hold[z] = *(const f32x2*)(hs + tt * DM); }
#pragma unroll
            for (int z = 0; z < 2; ++z) {
                const size_t tt = (size_t)(z ? t1 : t);
                f32x4 wq[4];
#pragma unroll
                for (int q = 0; q < 4; ++q) wq[q] = wqa[z][q];
                f32x2 acc[8];
#pragma unroll
                for (int e = 0; e < 8; ++e) acc[e] = (f32x2){0.f, 0.f};
#pragma unroll
                for (int q = 0; q < 16; ++q) { const float w = wq[q >> 2][q & 3]; const f32x2 ww = {w, w}; const unsigned d4[4] = {vr[z][q].x, vr[z][q].y, vr[z][q].z, vr[z][q].w};
#pragma unroll
                    for (int e = 0; e < 4; ++e) { acc[2 * e] += ww * __builtin_amdgcn_cvt_pk_f32_fp8(d4[e], false); acc[2 * e + 1] += ww * __builtin_amdgcn_cvt_pk_f32_fp8(d4[e], true); } }
                f32x2 b4[4], b2[2], b1;
                { const bool up = lane & 32;
#pragma unroll
                  for (int e = 0; e < 4; ++e) { const f32x2 keep = up ? acc[e + 4] : acc[e], give = up ? acc[e] : acc[e + 4]; b4[e] = keep + (f32x2){__shfl_xor(give.x, 32), __shfl_xor(give.y, 32)}; } }
                { const bool up = lane & 16;
#pragma unroll
                  for (int e = 0; e < 2; ++e) { const f32x2 keep = up ? b4[e + 2] : b4[e], give = up ? b4[e] : b4[e + 2]; b2[e] = keep + (f32x2){__shfl_xor(give.x, 16), __shfl_xor(give.y, 16)}; } }
                { const bool up = lane & 8; const f32x2 keep = up ? b2[1] : b2[0], give = up ? b2[0] : b2[1]; b1 = keep + (f32x2){__shfl_xor(give.x, 8), __shfl_xor(give.y, 8)}; }
#if defined(DBG_ZERO_PEER)
                b1 = (f32x2){0.f, 0.f};
#endif
                *(f32x2*)(hs + tt * DM) = hold[z] + b1;
            }
        }
    }
}
#endif
__device__ __forceinline__ void ph_normg(const Frame& F, bool final_layer) {
    const int gw = F.vcu * NWAVES + F.wave, NGW = F.G * NWAVES, lane = F.lane;
    if (!final_layer) { for (int m = gw; m < S; m += NGW) rms_row_to_bf16(WSP(float, WS_H) + (size_t)m * DM, FIN(1) + DM, WSP(bf16_t, WS_XN) + (size_t)m * DM, lane); return; }
    const float* g = FIN(16); float* out = FOUT();
    for (int m = gw; m < S; m += NGW) {
        const f32x4* xr = (const f32x4*)(WSP(float, WS_H) + (size_t)m * DM) + lane;
        f32x4 v[8]; float s = 0.f;
#pragma unroll
        for (int j = 0; j < 8; ++j) { v[j] = xr[64 * j]; s += (v[j].x * v[j].x + v[j].y * v[j].y) + (v[j].z * v[j].z + v[j].w * v[j].w); }
        const float r = 1.0f / sqrtf(wave_sum(s) * (1.f / DM) + EPS);
        f32x4* o = (f32x4*)(out + (size_t)m * DM) + lane;
#pragma unroll
        for (int j = 0; j < 8; ++j) { const f32x4 gg = ((const f32x4*)g)[lane + 64 * j]; o[64 * j] = v[j] * r * gg; }
    }
}

__device__ __forceinline__ void ph_poolprep(const Frame& F) {
    const int lane = F.lane, gw = F.vcu * NWAVES + F.wave, NGW = F.G * NWAVES;
    const bf16_t* xn = WSP(bf16_t, WS_XN); const unsigned long long* ss = (const unsigned long long*)(F.ws + WS_CTL + CTL_SSQ) + S; const float* g = FIN(1) + DM;
    for (int t = gw; t < S; t += NGW) {
        const int rl = t - 8 + (lane & 15); const float rsl = (rl >= 0 && rl < S) ? rstd_of(ss[rl]) : 0.f;
        float rs[16];
#pragma unroll
        for (int q = 0; q < 16; ++q) rs[q] = __builtin_bit_cast(float, __builtin_amdgcn_readlane(__builtin_bit_cast(int, rsl), q));
        u32x4 o4[4];
#pragma unroll
        for (int j = 0; j < 4; ++j) {
            const int half = 1 << j, lo = max(t - half, 0), hi = min(t + half, S), c0 = (lane + 64 * j) * 8;
            u32x4 xr[16];
#pragma unroll
            for (int q = 0; q < 16; ++q) if (q < 2 * half) { const int r = t - half + q; xr[q] = (r >= 0 && r < S) ? *(const u32x4*)(xn + (size_t)r * DM + c0) : (u32x4){0u, 0u, 0u, 0u}; }
            float a[8];
#pragma unroll
            for (int q = 0; q < 8; ++q) a[q] = 0.f;
#pragma unroll
            for (int q = 0; q < 16; ++q) if (q < 2 * half) { const u32x4 x = xr[q]; const float r1 = rs[8 - half + q];
                a[0] += bflo(x.x) * r1; a[1] += bfhi(x.x) * r1; a[2] += bflo(x.y) * r1; a[3] += bfhi(x.y) * r1; a[4] += bflo(x.z) * r1; a[5] += bfhi(x.z) * r1; a[6] += bflo(x.w) * r1; a[7] += bfhi(x.w) * r1; }
            const u32x4 x = xr[half]; const float ic = 1.0f / (float)(hi - lo), rt = rs[8];
            const f32x4 g0 = *(const f32x4*)(g + c0), g1 = *(const f32x4*)(g + c0 + 4);
            o4[j].x = pk2((a[0] * ic - bflo(x.x) * rt) * g0.x, (a[1] * ic - bfhi(x.x) * rt) * g0.y); o4[j].y = pk2((a[2] * ic - bflo(x.y) * rt) * g0.z, (a[3] * ic - bfhi(x.y) * rt) * g0.w);
            o4[j].z = pk2((a[4] * ic - bflo(x.z) * rt) * g1.x, (a[5] * ic - bfhi(x.z) * rt) * g1.y); o4[j].w = pk2((a[6] * ic - bflo(x.w) * rt) * g1.z, (a[7] * ic - bfhi(x.w) * rt) * g1.w);
        }
#pragma unroll
        for (int j = 0; j < 4; ++j) *(u32x4*)(WSP(bf16_t, WS_POOLED) + (size_t)t * DM + (lane + 64 * j) * 8) = o4[j];
    }
}
__device__ __forceinline__ void ph_norm(const Frame& F, int layer) {
    const int gw = F.vcu * NWAVES + F.wave, NGW = F.G * NWAVES;
    for (int m = gw; m < S; m += NGW) rms_row_to_bf16(WSP(float, WS_H) + (size_t)m * DM, FIN(2) + layer * DM, WSP(bf16_t, WS_XN) + (size_t)m * DM, F.lane);
}

__device__ __forceinline__ void ph_attn(const Frame& F) {
    const int nunits = 8 * 64;
    float gq = fabsf(FIN(6)[F.lane]), gk = fabsf(FIN(7)[F.lane]); gq = fmaxf(gq, fabsf(FIN(6)[64 + F.lane])); gk = fmaxf(gk, fabsf(FIN(7)[64 + F.lane]));
#pragma unroll
    for (int o = 1; o < 64; o <<= 1) { gq = fmaxf(gq, __shfl_xor(gq, o)); gk = fmaxf(gk, __shfl_xor(gk, o)); }
    const float mC = -fminf(11.313708498984761f * gq * gk * 1.01f, 60.f) * 1.4426950408889634f;
    for (int u = F.vcu * 2; u < nunits; u += F.G * 2)
#pragma unroll 1
        for (int k = 0; k < 2; ++k) { const int unit = u + k, head = unit >> 6, qb = unit & 63, kvh = head >> 2;
            att::attn_dense_body<att::bf16>(WSP(att::bf16, WS_QB) + (size_t)(qb * 256) * 1024 + head * 128, WSP(att::bf16, WS_KVB) + kvh * 128, WSP(att::bf16, WS_KVB) + 256 + kvh * 128,
                                 WSP(att::bf16, WS_Y) + (size_t)(qb * 256) * DM + head * 128, S, F.ldsg, mC); }
}

#if defined(DBG_ATTN_CHECK)
constexpr int CW_DBG = 2048;
__device__ __forceinline__ void dbg_attn_check(const Frame& F) {
    __syncthreads();
    LAS float* sc = (LAS float*)F.lds; LAS float* red = sc + 16384; LAS float* po = red + 64;
    const int tid = F.tid, lane = F.lane, wave = F.wave;
    for (int chk = 0; chk < 4; ++chk) {
        const int unit = F.vcu * 2 + (chk & 1), head = unit >> 6, qb = unit & 63, kvh = head >> 2;
        const int t = qb * 256 + ((F.vcu * 37 + chk * 101 + 5) & 255);
        const bf16_t* q = WSP(bf16_t, WS_QB) + (size_t)t * 1024 + head * 128; const bf16_t* K = WSP(bf16_t, WS_KVB) + kvh * 128; const bf16_t* V = WSP(bf16_t, WS_KVB) + 256 + kvh * 128;
        float mx = -1e30f;
        for (int j = 0; j < 32; ++j) { const int key = tid + 512 * j; float s = 0.f;
            for (int d = 0; d < 128; ++d) s += bflo((unsigned)q[d]) * bflo((unsigned)K[(size_t)key * 512 + d]);
            s *= 0.088388347648318440f; sc[key] = s; mx = fmaxf(mx, s); }
        for (int o = 1; o < 64; o <<= 1) mx = fmaxf(mx, __shfl_xor(mx, o));
        if (lane == 0) red[wave] = mx;
        __syncthreads();
        mx = red[0]; for (int w = 1; w < 8; ++w) mx = fmaxf(mx, red[w]);
        __syncthreads();
        float sm = 0.f;
        for (int j = 0; j < 32; ++j) { const int key = tid + 512 * j; const float p = expf(sc[key] - mx); sc[key] = p; sm += p; }
        sm = wave_sum(sm);
        if (lane == 0) red[8 + wave] = sm;
        __syncthreads();
        sm = 0.f; for (int w = 0; w < 8; ++w) sm += red[8 + w];
        const int d = tid & 127, part = tid >> 7; float acc = 0.f;
        for (int kk = 0; kk < 4096; ++kk) { const int key = part * 4096 + kk; acc += sc[key] * bflo((unsigned)V[(size_t)key * 512 + d]); }
        po[part * 128 + d] = acc;
        __syncthreads();
        if (tid < 128) { const float o = (po[d] + po[128 + d] + po[256 + d] + po[384 + d]) / sm;
            const float y = bflo((unsigned)WSP(bf16_t, WS_Y)[(size_t)t * DM + head * 128 + d]);
            float ma = fabsf(o); for (int x = 1; x < 64; x <<= 1) ma = fmaxf(ma, __shfl_xor(ma, x));
            if (lane == 0) red[16 + wave] = ma;
            asm volatile("s_waitcnt lgkmcnt(0)" ::: "memory");
            const float mall = fmaxf(red[16], red[17]);
            const float mown = red[16 + wave]; (void)mall;
            const bool bad = !(fabsf(o - y) <= 0.03f * mown + 1e-5f);
            if (bad) atomicAdd((unsigned*)(F.ws + WS_CTL) + CW_DBG, 1u); }
        __syncthreads();
    }
}
#endif
#ifndef PHASE_MASK
#define PHASE_MASK 0x1fffff
#endif
#define PH_ON(k) (((PHASE_MASK) >> (k)) & 1)
struct Args { const float* in[17]; float* out; unsigned char* ws; int ph_lo, ph_hi; };
static_assert(sizeof(Args) == 17 * 8 + 8 + 8 + 8, "Args has no padding");
__global__ void __launch_bounds__(NTHR, 2) fwd_kernel(Args args) {
    extern __shared__ __attribute__((aligned(16))) unsigned char lds[];
    Frame F;
    F.lds = (LAS unsigned char*)lds; F.ldsg = (char*)lds;
    F.tid = threadIdx.x; F.lane = F.tid & 63; F.wave = __builtin_amdgcn_readfirstlane(F.tid >> 6);
    F.G = gridDim.x; { const int bx = blockIdx.x; F.vcu = (F.G % 8 == 0) ? (bx % 8) * (F.G / 8) + bx / 8 : bx; }
    F.ws = args.ws;
    volatile LAS unsigned* MISC = (volatile LAS unsigned*)(F.lds + LDSCTL_OFF);
    if (F.tid < 16) ((LAS unsigned*)(F.lds + LDSCTL_OFF))[F.tid] = 0u;
    if (F.tid >= 64 && F.tid < 64 + 36) ((LAS unsigned*)(F.lds + LDSCTL_OFF + 64))[F.tid - 64] = ((const unsigned*)&args)[F.tid - 64];
    __syncthreads();
    const int lo = args.ph_lo, hi = args.ph_hi;
    XcdBarrier bar; bar.bar = (unsigned*)(F.ws + WS_CTL) + CW_BAR; bar.x = 0; bar.st = nullptr;
    if (hi - lo > 1) bar = xcd_barrier_post((unsigned*)(F.ws + WS_CTL) + CW_BAR, MISC + 8);
#pragma unroll 1
    for (int ph = lo; ph < hi; ++ph) {
        if (ph > lo) xcd_barrier(bar);
#if defined(PROBE_PH)
        unsigned long long tprobe0 = 0; if (ph == PROBE_PH) tprobe0 = __builtin_amdgcn_s_memrealtime();
        if (ph == PROBE_PH + 1 || (PROBE_PH == NPH - 1 && false)) { }
#endif
        switch (ph) {
#define PHM(n) do { asm volatile("; PHASE_MARK " #n ::: "memory"); int t_ = threadIdx.x; asm volatile("" : "+v"(t_)); F.tid = t_; F.lane = t_ & 63; F.wave = __builtin_amdgcn_readfirstlane(t_ >> 6); \
    unsigned long long z_ = 0; asm volatile("" : "+s"(z_)); F.ws = args.ws + z_; } while (0)
        case PH_PRO: if constexpr (PH_ON(PH_PRO)) { PHM(PH_PRO); ph_prologue(F); } break;
        case PH_GEMM_IN: if constexpr (PH_ON(PH_GEMM_IN)) { PHM(PH_GEMM_IN);  pg8::Gemm g{WSP(bf16_t, WS_XN), WSP(bf16_t, WS_WIN), S, INP, DM, DM, DM, 0, 0}; pg8::StaticOrder So; So.init(S, INP, F.G, (int)blockIdx.x);
            pg8::EpiBf16<0> E{WSP(bf16_t, WS_PROJ), INP, nullptr, 0, 0, 1.f};
            pg8::gemm_phase<pg8::EpiBf16<0>, pg8::StaticOrder, true, true>(F.lds, g, So, E); } break;
        case PH_POST: if constexpr (PH_ON(PH_POST)) { PHM(PH_POST); ph_post(F); } break;
        case PH_ATTN: if constexpr (PH_ON(PH_ATTN)) { PHM(PH_ATTN); ph_attn(F);
#if defined(DBG_ATTN_CHECK)
            dbg_attn_check(F);
#endif
            } break;
        case PH_MLA: if constexpr (PH_ON(PH_MLA)) { PHM(PH_MLA); ph_mla(F); } break;
        case PH_SCAN: if constexpr (PH_ON(PH_SCAN)) { PHM(PH_SCAN); ph_scan(F); } break;
        case PH_MLB: if constexpr (PH_ON(PH_MLB)) { PHM(PH_MLB); ph_mlb(F); } break;
        case PH_GEMM_OUT: if constexpr (PH_ON(PH_GEMM_OUT)) { PHM(PH_GEMM_OUT);  pg8::Gemm g{WSP(bf16_t, WS_Y), WSP(bf16_t, WS_WOUT), S, DM, DM, DM, DM, 0, 0}; pg8::StaticOrder So; So.init(S, DM, F.G, (int)blockIdx.x);
            pg8::EpiResF32 E{FIN(0), WSP(float, WS_H), DM, nullptr, WSP(bf16_t, WS_XN), (unsigned long long*)(F.ws + WS_CTL + CTL_SSQ)};
            pg8::gemm_phase<pg8::EpiResF32, pg8::StaticOrder, true, true>(F.lds, g, So, E); } break;
        case PH_GEMM_Q0: case PH_GEMM_Q1: if constexpr (PH_ON(PH_GEMM_Q0)) { PHM(PH_GEMM_Q0);  pg8::Gemm g{WSP(bf16_t, WS_XN), WSP(bf16_t, ph == PH_GEMM_Q0 ? WS_WQ0 : WS_WQ1), S, DM, DM, DM, DM, 0, 0}; pg8::StaticOrder So; So.init(S, DM, F.G, (int)blockIdx.x);
            pg8::EpiBf16Row E{WSP(bf16_t, WS_QP), DM, (const unsigned long long*)(F.ws + WS_CTL + CTL_SSQ) + (ph == PH_GEMM_Q0 ? 0 : 2 * S), 1.0f / DM, EPS};
            pg8::gemm_phase<pg8::EpiBf16Row, pg8::StaticOrder, true, true>(F.lds, g, So, E); } break;
        case PH_TOPK0: if constexpr (PH_ON(PH_TOPK0)) { PHM(PH_TOPK0); ph_topk(F, 0); } break;
        case PH_TOPK1: if constexpr (PH_ON(PH_TOPK1)) { PHM(PH_TOPK1); ph_topk(F, 1); } break;
        case PH_GU0: if constexpr (PH_ON(PH_GU0)) { PHM(PH_GU0); ph_gu(F, 0); } break;
        case PH_GU1: if constexpr (PH_ON(PH_GU1)) { PHM(PH_GU1); ph_gu(F, 1); } break;
        case PH_ACT0: if constexpr (PH_ON(PH_ACT0)) { PHM(PH_ACT0); ph_act(F, 0); } break;
        case PH_ACT1: if constexpr (PH_ON(PH_ACT1)) { PHM(PH_ACT1); ph_act(F, 1); } break;
        case PH_GV0: if constexpr (PH_ON(PH_GV0)) { PHM(PH_GV0); ph_gv(F, 0); } break;
        case PH_GV1: if constexpr (PH_ON(PH_GV1)) { PHM(PH_GV1); ph_gv(F, 1); } break;
        case PH_NORMF: if constexpr (PH_ON(PH_NORMF)) { PHM(PH_NORMF); ph_normg(F, true);
#if defined(DBG_ATTN_CHECK)
            { const unsigned nb = __hip_atomic_load((unsigned*)(F.ws + WS_CTL) + CW_DBG, __ATOMIC_RELAXED, __HIP_MEMORY_SCOPE_AGENT);
              if (nb != 0u) { float* o = FOUT(); for (int i = F.vcu * NTHR + F.tid; i < 4096; i += F.G * NTHR) o[(size_t)i * 8192 + 7] += (DBG_ATTN_CHECK == 2 ? 0.f : 1000.f); } }
#endif
            } break;
        case PH_POOLPREP: if constexpr (PH_ON(PH_POOLPREP)) { PHM(PH_POOLPREP); ph_poolprep(F); } break;
        case PH_GEMM_POOL: if constexpr (PH_ON(PH_GEMM_POOL)) { PHM(PH_GEMM_POOL);  pg8::Gemm g{WSP(bf16_t, WS_POOLED), WSP(bf16_t, WS_WPOOL), S, DM, 512, DM, 512, 1, 512 * 2}; pg8::StaticOrder So; So.init(S, DM, F.G, (int)blockIdx.x);
            pg8::EpiResF32 E{WSP(float, WS_H), WSP(float, WS_H), DM, FIN(11), WSP(bf16_t, WS_XN), (unsigned long long*)(F.ws + WS_CTL + CTL_SSQ) + 2 * S};
            pg8::gemm_phase<pg8::EpiResF32, pg8::StaticOrder, true, true>(F.lds, g, So, E); } break;
        default: break;
        }
#if defined(PROBE_PH)
        if (ph == PROBE_PH) { __syncthreads(); const unsigned long long t1 = __builtin_amdgcn_s_memrealtime(), dt = t1 - tprobe0;
            while (__builtin_amdgcn_s_memrealtime() - t1 < 4ull * dt) __builtin_amdgcn_s_sleep(8); }
#endif
    }
}

#ifndef N_LAUNCH_MODE
#define N_LAUNCH_MODE 1
#endif
extern "C" void kernel_launch(void* const* d_in, const int* in_sizes, int n_in, void* d_out, int out_size, void* d_ws, size_t ws_size, hipStream_t stream) {
    static int grid = 0;
    if (grid == 0) {
        if (n_in != 17 || in_sizes[0] != S * DM || out_size != S * DM || ws_size < WS_END) { fprintf(stderr, "kernel_launch: unexpected shapes (n_in %d, in0 %d, out %d, ws %zu; need ws >= %zu)\n", n_in, n_in > 0 ? in_sizes[0] : -1, out_size, ws_size, (size_t)WS_END); grid = -1; return; }
        int dev = 0, cus = 0;
        if (hipGetDevice(&dev) != hipSuccess || hipDeviceGetAttribute(&cus, hipDeviceAttributeMultiprocessorCount, dev) != hipSuccess) { grid = -1; return; }
        if (hipFuncSetAttribute((const void*)fwd_kernel, hipFuncAttributeMaxDynamicSharedMemorySize, LDS_BYTES) != hipSuccess) { fprintf(stderr, "kernel_launch: hipFuncSetAttribute failed\n"); grid = -1; return; }
        int per_cu = 0;
        if (hipOccupancyMaxActiveBlocksPerMultiprocessor(&per_cu, (const void*)fwd_kernel, NTHR, LDS_BYTES) != hipSuccess || per_cu < 1) fprintf(stderr, "kernel_launch: occupancy query reports %d\n", per_cu);
        (void)hipGetLastError();
        grid = cus;
        if (grid != 256) { fprintf(stderr, "kernel_launch: built for a 256-CU device (got %d CUs)\n", grid); grid = -1; return; }
    }
    if (grid < 0) return;
    (void)hipMemsetAsync((char*)d_ws + WS_CTL, 0, CTL_ZERO_BYTES, stream);
    Args a{};
    for (int i = 0; i < 17; ++i) a.in[i] = (const float*)d_in[i];
    a.out = (float*)d_out; a.ws = (unsigned char*)d_ws;
#if N_LAUNCH_MODE == 1
    a.ph_lo = 0; a.ph_hi = NPH;
    hipLaunchKernelGGL(fwd_kernel, dim3(grid), dim3(NTHR), LDS_BYTES, stream, a);
#else
    for (int ph = 0; ph < NPH; ++ph) { a.ph_lo = ph; a.ph_hi = ph + 1; hipLaunchKernelGGL(fwd_kernel, dim3(grid), dim3(NTHR), LDS_BYTES, stream, a); }
#endif
    const hipError_t le = hipPeekAtLastError();
    if (le != hipSuccess) fprintf(stderr, "kernel_launch: launch failed: %s\n", hipGetErrorName(le));
}
```

```cpp
#include <hip/hip_runtime.h>
#include <hip/hip_bf16.h>
#include <cstdio>
#include <cstdint>
#include <cmath>

#ifndef TBL_FP4
#define TBL_FP4 1
#endif
constexpr int S = 16384, DM = 2048, NWAVES = 8, NTHR = 512;
constexpr int INW = 5648, INP = 5888;
constexpr int C_AQ = 0, C_AK = 1024, C_AV = 1280, C_MQK = 1536, C_MV = 3584, C_MO = 4608, C_GATE = 5632;
constexpr float EPS = 1e-6f;
constexpr int NPH = 21;
enum { PH_PRO = 0, PH_GEMM_IN, PH_POST, PH_ATTN, PH_MLA, PH_SCAN, PH_MLB, PH_GEMM_OUT, PH_GEMM_Q0, PH_TOPK0, PH_GU0, PH_ACT0, PH_GV0,
       PH_POOLPREP, PH_GEMM_POOL, PH_GEMM_Q1, PH_TOPK1, PH_GU1, PH_ACT1, PH_GV1, PH_NORMF };

constexpr size_t MiB = 1u << 20;
constexpr size_t WS_CTL = 0, CTL_ZERO_BYTES = 1 * MiB;
constexpr size_t WS_WIN = 1 * MiB, WS_WOUT = 24 * MiB, WS_WQ0 = 32 * MiB, WS_WQ1 = 40 * MiB, WS_WPOOL = 48 * MiB, WS_KEYS = 50 * MiB;
constexpr size_t WS_TSC = 52 * MiB + 768 * 1024  , WS_GATES = 51 * MiB, WS_NST = 53 * MiB, WS_EIDX = 54 * MiB, WS_EGATE = 62 * MiB;
constexpr size_t WS_UB = 70 * MiB, WS_VB = 198 * MiB, WS_XN = 326 * MiB, WS_PROJ = 390 * MiB, WS_QP = WS_PROJ;
constexpr size_t WS_QB = 574 * MiB, WS_KVB = 606 * MiB, WS_MQ = 622 * MiB, WS_MK = 654 * MiB, WS_CST = 686 * MiB, WS_Y = 814 * MiB, WS_POOLED = WS_Y;
constexpr size_t WS_H = 878 * MiB, WS_END = 1006 * MiB;
constexpr size_t CTL_SSQ = 256 * 1024;
constexpr int CW_BAR = 4096;
constexpr size_t GO_B = 0, GO_U = 8 * S * 4, GO_PM = 2 * 8 * S * 4, GO_G = 3 * 8 * S * 4, GO_PML = GO_G + 4096, GO_MPREV = GO_PML + 4096;

constexpr int LDS_BYTES = 147456, LDSCTL_OFF = 146944;

#define GAS __attribute__((address_space(1)))
#define LAS __attribute__((address_space(3)))
typedef unsigned short bf16_t;
typedef short bf16x8 __attribute__((ext_vector_type(8)));
typedef short s16x4 __attribute__((ext_vector_type(4)));
typedef short v4i16_t __attribute__((ext_vector_type(4)));
typedef float f32x4 __attribute__((ext_vector_type(4)));
typedef float f32x2 __attribute__((ext_vector_type(2)));
typedef float f32x16 __attribute__((ext_vector_type(16)));
typedef unsigned u32x4 __attribute__((ext_vector_type(4)));
typedef unsigned u32x2 __attribute__((ext_vector_type(2)));
typedef __bf16 bf16x2_t __attribute__((ext_vector_type(2)));
typedef GAS unsigned gu32;
#define RLX_AGENT __ATOMIC_RELAXED, __HIP_MEMORY_SCOPE_AGENT
#define LDS_WAIT() asm volatile("s_waitcnt lgkmcnt(0)" ::: "memory")
__device__ __forceinline__ unsigned f2bf(float f) { unsigned u = __builtin_bit_cast(unsigned, f); return (u + 0x7fffu + ((u >> 16) & 1u)) >> 16; }
__device__ __forceinline__ unsigned pk2(float lo, float hi) { f32x2 v = {lo, hi}; bf16x2_t b = __builtin_convertvector(v, bf16x2_t); return __builtin_bit_cast(unsigned, b); }
__device__ __forceinline__ float bflo(unsigned w) { return __builtin_bit_cast(float, w << 16); }
__device__ __forceinline__ float bfhi(unsigned w) { return __builtin_bit_cast(float, w & 0xffff0000u); }
__device__ __forceinline__ float rstd_of(unsigned long long ss) { return 1.0f / sqrtf((float)ss * (1.0f / (1048576.0f * 2048.0f)) + 1e-6f); }
__device__ __forceinline__ void st_wt8(void* p, u32x2 v) { __hip_atomic_store((unsigned long long*)p, ((unsigned long long)v.y << 32) | v.x, __ATOMIC_RELAXED, __HIP_MEMORY_SCOPE_AGENT); }
__device__ __forceinline__ void st_wt8f(void* p, f32x2 v) { st_wt8(p, __builtin_bit_cast(u32x2, v)); }
__device__ __forceinline__ void st_wt16(void* p, u32x4 v) { asm volatile("global_store_dwordx4 %0, %1, off sc1" :: "v"(p), "v"(v) : "memory"); }
__device__ __forceinline__ void st_wt16f(void* p, f32x4 v) { st_wt16(p, __builtin_bit_cast(u32x4, v)); }
__device__ __forceinline__ float wave_sum(float v) {
#pragma unroll
    for (int o = 1; o < 64; o <<= 1) v += __shfl_xor(v, o);
    return v;
}

namespace pg8 {
#define PG8_LAS __attribute__((address_space(3)))
typedef unsigned short bf16_t;
typedef short bf16x8 __attribute__((ext_vector_type(8)));
typedef float f32x4 __attribute__((ext_vector_type(4)));
typedef unsigned u32x4 __attribute__((ext_vector_type(4)));
constexpr int BM = 256, BK = 64, HALF = 128, HTB = HALF * BK * 2  , STAGE_BYTES = 8 * HTB, NXCD = 8, WGM = 8;

__host__ __device__ __forceinline__ int lds_byte(int r, int c) { const int st = (r >> 4) * 2 + (c >> 5), rr = r & 15, cc = c & 31, ob = rr * 64 + cc * 2; return st * 1024 + (ob ^ (((ob >> 9) & 1) << 5)); }
__host__ __device__ __forceinline__ void stage_rc(int b, int& R, int& C) { const int st = b / 1024, sb = b % 1024, swz = sb ^ (((sb >> 9) & 1) << 5); R = (st >> 1) * 16 + swz / 64; C = (st & 1) * 32 + (swz % 64) / 2; }
__host__ __device__ __forceinline__ int perm32(int rho) { const int n = rho >> 4, i = rho & 15; return 8 * (i >> 2) + 4 * n + (i & 3); }

struct Unit { int pm, pn; };
struct Gemm { const bf16_t* A; const bf16_t* Bt; int M, N, K, lda, ldb, agrp_shift; size_t agrp_bytes; };

struct StaticOrder {
    int nM, nN, nwg, G, c;
    __host__ __device__ void init(int M, int N, int G_, int c_) { nM = M / BM; nN = N / BM; nwg = nM * nN; G = G_; c = c_; }
    __host__ __device__ bool next(int i, Unit& u) const {
        const long L = (long)i * G + c; if (L >= nwg) return false;
        int wgid = (int)L; { const int q = nwg / NXCD, r = nwg % NXCD, xcd = wgid % NXCD, off = wgid / NXCD; wgid = (xcd < r ? xcd * (q + 1) : r * (q + 1) + (xcd - r) * q) + off; }
        const int nig = WGM * nN, gid = wgid / nig, fm = gid * WGM, gsz = (nM - fm) < WGM ? (nM - fm) : WGM;
        u.pm = fm + ((wgid % nig) % gsz); u.pn = (wgid % nig) / gsz; return true;
    }
    __device__ __forceinline__ void a_ready(const Unit&) const {}
    __device__ __forceinline__ void done(const Unit&) const {}
};

__device__ __forceinline__ unsigned cvt_pk_bf16(float lo, float hi) { unsigned r; asm volatile("v_cvt_pk_bf16_f32 %0, %1, %2" : "=v"(r) : "v"(lo), "v"(hi)); return r; }
typedef float f32x2 __attribute__((ext_vector_type(2)));
__device__ __forceinline__ f32x2 gelu_pk(f32x2 v) {
    const f32x2 av = __builtin_elementwise_abs(v), d = av * 0.2316418882f + 1.0f;
    f32x2 t; t.x = __builtin_amdgcn_rcpf(d.x); t.y = __builtin_amdgcn_rcpf(d.y);
    f32x2 q = t * 0.5307027145f + (-0.7265760135f); q = q * t + 0.7107068705f; q = q * t + (-0.142248368f); q = q * t + 0.127414796f; q = q * t;
    const f32x2 s = (v * v) * (-0.72134752044f);
    f32x2 e; e.x = __builtin_amdgcn_exp2f(s.x); e.y = __builtin_amdgcn_exp2f(s.y);
    const f32x2 m = v * (q * e), r = v - m;
    f32x2 o; o.x = v.x < 0.f ? m.x : r.x; o.y = v.y < 0.f ? m.y : r.y; return o;
}
template <int ACT  > struct EpiBf16 {
    static constexpr bool PERM = true, AFTER_DRAIN = false; static_assert(ACT == 0 || ACT == 1, "EpiBf16: ACT is 0 (none) or 1 (gelu_pk)");
    bf16_t* O; int ldc; const float* bias; int split_cols; size_t split_stride; float scale0;
    __device__ __forceinline__ void operator()(const f32x4 (&acc)[2][2][4][2], const Unit& u, int wr, int wc, int fr, int fq) const {
        const int row0 = u.pm * BM + wr * 64 + fr; int colt = u.pn * BM; bf16_t* base = O;
        float sc = 1.f; if (split_cols) { const int t = colt / split_cols; base += (size_t)t * split_stride; colt -= t * split_cols; if (t == 0) sc = scale0; }
        const int col0 = colt + wc * 32 + 8 * fq, bcol0 = u.pn * BM + wc * 32 + 8 * fq;
        f32x4 bv[2][2];
#pragma unroll
        for (int bj = 0; bj < 2; ++bj)
#pragma unroll
            for (int n = 0; n < 2; ++n) bv[bj][n] = bias ? *(const f32x4*)(bias + bcol0 + bj * HALF + 4 * n) : (f32x4){0.f, 0.f, 0.f, 0.f};
#pragma unroll
        for (int ai = 0; ai < 2; ++ai)
#pragma unroll
            for (int m = 0; m < 4; ++m) { bf16_t* rowp = base + (size_t)(row0 + ai * HALF + m * 16) * ldc + col0;
#pragma unroll
                for (int bj = 0; bj < 2; ++bj) { f32x4 v0 = acc[ai][bj][m][0] + bv[bj][0], v1 = acc[ai][bj][m][1] + bv[bj][1];
                    if (ACT == 1) { f32x2 a = gelu_pk((f32x2){v0[0], v0[1]}), b = gelu_pk((f32x2){v0[2], v0[3]}), c = gelu_pk((f32x2){v1[0], v1[1]}), d = gelu_pk((f32x2){v1[2], v1[3]});
                        v0 = (f32x4){a.x, a.y, b.x, b.y}; v1 = (f32x4){c.x, c.y, d.x, d.y}; }
                    v0 = v0 * sc; v1 = v1 * sc; u32x4 w; w.x = cvt_pk_bf16(v0[0], v0[1]); w.y = cvt_pk_bf16(v0[2], v0[3]); w.z = cvt_pk_bf16(v1[0], v1[1]); w.w = cvt_pk_bf16(v1[2], v1[3]);
                    *(u32x4*)(rowp + bj * HALF) = w; } }
    }
};
struct EpiResF32 {
    static constexpr bool PERM = false, AFTER_DRAIN = false;
    const float* base; float* out; int ldc; const float* colscale; bf16_t* hb; unsigned long long* ssq;
    __device__ __forceinline__ void operator()(const f32x4 (&acc)[2][2][4][2], const Unit& u, int wr, int wc, int fr, int fq) const {
        const int row0 = u.pm * BM + wr * 64 + fr, col0 = u.pn * BM + wc * 32 + 4 * fq;
        f32x4 cs[2][2];
#pragma unroll
        for (int bj = 0; bj < 2; ++bj)
#pragma unroll
            for (int n = 0; n < 2; ++n) cs[bj][n] = colscale ? *(const f32x4*)(colscale + col0 + bj * HALF + n * 16) : (f32x4){1.f, 1.f, 1.f, 1.f};
#pragma unroll
        for (int ai = 0; ai < 2; ++ai)
#pragma unroll
            for (int m = 0; m < 4; ++m) { const size_t off = (size_t)(row0 + ai * HALF + m * 16) * ldc + col0;
                float ssum = 0.f;
#pragma unroll
                for (int bj = 0; bj < 2; ++bj)
#pragma unroll
                    for (int n = 0; n < 2; ++n) { const f32x4 b = *(const f32x4*)(base + off + bj * HALF + n * 16);
                        const f32x4 h = b + acc[ai][bj][m][n] * cs[bj][n];
                        *(f32x4*)(out + off + bj * HALF + n * 16) = h;
                        if (hb) { typedef unsigned u32x2v __attribute__((ext_vector_type(2))); u32x2v w; w.x = cvt_pk_bf16(h[0], h[1]); w.y = cvt_pk_bf16(h[2], h[3]); *(u32x2v*)(hb + off + bj * HALF + n * 16) = w; }
                        ssum += (h[0] * h[0] + h[1] * h[1]) + (h[2] * h[2] + h[3] * h[3]); }
                if (ssq) { ssum += __shfl_xor(ssum, 16); ssum += __shfl_xor(ssum, 32);
                    if (fq == 0) atomicAdd(ssq + (row0 + ai * HALF + m * 16), (unsigned long long)(ssum * 1048576.0f)); }
                asm volatile("" ::: "memory"); }
    }
};

struct EpiBf16Row {
    static constexpr bool PERM = true, AFTER_DRAIN = false;
    bf16_t* O; int ldc; const unsigned long long* ssq; float inv_ncol, eps;
    __device__ __forceinline__ void operator()(const f32x4 (&acc)[2][2][4][2], const Unit& u, int wr, int wc, int fr, int fq) const {
        const int row0 = u.pm * BM + wr * 64 + fr, col0 = u.pn * BM + wc * 32 + 8 * fq;
#pragma unroll
        for (int ai = 0; ai < 2; ++ai)
#pragma unroll
            for (int m = 0; m < 4; ++m) { const int row = row0 + ai * HALF + m * 16; bf16_t* rowp = O + (size_t)row * ldc + col0;
                const float sc = ssq ? 1.0f / sqrtf((float)ssq[row] * (inv_ncol * (1.0f / 1048576.0f)) + eps) : 1.f;
#pragma unroll
                for (int bj = 0; bj < 2; ++bj) { const f32x4 v0 = acc[ai][bj][m][0] * sc, v1 = acc[ai][bj][m][1] * sc;
                    u32x4 w; w.x = cvt_pk_bf16(v0[0], v0[1]); w.y = cvt_pk_bf16(v0[2], v0[3]); w.z = cvt_pk_bf16(v1[0], v1[1]); w.w = cvt_pk_bf16(v1[2], v1[3]);
                    *(u32x4*)(rowp + bj * HALF) = w; } }
    }
};

template <class Epi, class Sched, bool ALIGN_EPI = false, bool SP2 = false>
__device__ __forceinline__ void gemm_phase(PG8_LAS unsigned char* lds, const Gemm g, const Sched& S, const Epi& E) {
    int tid_ = threadIdx.x; asm volatile("" : "+v"(tid_));
    const int tid = tid_, wid = __builtin_amdgcn_readfirstlane(tid >> 6), lane = tid & 63, wr = wid >> 2, wc = wid & 3, fr = lane & 15, fq = lane >> 4;
    const int K = g.K, nt = K / BK;
    unsigned voffA[2], voffB[2];
#pragma unroll
    for (int i = 0; i < 2; ++i) { int R, C; stage_rc(tid * 16 + i * 8192, R, C); const int Rb = Epi::PERM ? ((R & ~31) + perm32(R & 31)) : R;
        voffA[i] = (unsigned)(R * g.lda + C) * 2u; voffB[i] = (unsigned)(Rb * g.ldb + C) * 2u; }
    const size_t kstep = (size_t)(BK * 2);
    const size_t hstepA = (size_t)HALF * g.lda * 2, hstepB = (size_t)HALF * g.ldb * 2;
    const size_t tstepA = 2 * hstepA, tstepB = 2 * hstepB;
    const unsigned ldsw = (unsigned)wid * 1024u;
    const int aoff = lds_byte(wr * 64 + fr, fq * 8), boff = lds_byte(wc * 32 + fr, fq * 8);
#define PG8_SA(b, h) (((b) * 2 + (h)) * HTB)
#define PG8_SB(b, h) ((4 + (b) * 2 + (h)) * HTB)
#define PG8_STAGE(bufoff, gbase, voff) do { _Pragma("unroll") for (int _i = 0; _i < 2; ++_i) \
        __builtin_amdgcn_global_load_lds((const unsigned*)((const char*)(gbase) + (voff)[_i]), (PG8_LAS unsigned*)(lds + (bufoff) + ldsw + _i * 8192), 16, 0, 0); } while (0)
#define PG8_LDA(dst, b, h) do { _Pragma("unroll") for (int m = 0; m < 4; ++m) _Pragma("unroll") for (int k = 0; k < 2; ++k) dst[m][k] = *(const PG8_LAS bf16x8*)(lds + PG8_SA(b, h) + aoff + m * 2048 + k * 1024); } while (0)
#define PG8_LDB(dst, b, h) do { _Pragma("unroll") for (int n = 0; n < 2; ++n) _Pragma("unroll") for (int k = 0; k < 2; ++k) dst[n][k] = *(const PG8_LAS bf16x8*)(lds + PG8_SB(b, h) + boff + n * 2048 + k * 1024); } while (0)
#define PG8_MMA(ai, bj, At, Bt) do { __builtin_amdgcn_s_setprio(1); _Pragma("unroll") for (int m = 0; m < 4; ++m) _Pragma("unroll") for (int n = 0; n < 2; ++n) _Pragma("unroll") for (int k = 0; k < 2; ++k) \
        acc[ai][bj][m][n] = __builtin_amdgcn_mfma_f32_16x16x32_bf16(Bt[n][k], At[m][k], acc[ai][bj][m][n], 0, 0, 0); __builtin_amdgcn_s_setprio(0); } while (0)
#define PG8_WAIT_V(n) asm volatile("s_waitcnt vmcnt(" #n ")" ::: "memory")
#define PG8_WAIT_L(n) asm volatile("s_waitcnt lgkmcnt(" #n ")" ::: "memory")
#define PG8_BAR __builtin_amdgcn_s_barrier()
#define PG8_SCHED __builtin_amdgcn_sched_barrier(0)
    Unit cur, nxt; int ui = 0;
    if (!S.next(0, cur)) return;
    f32x4 acc[2][2][4][2];
#pragma unroll
    for (int a = 0; a < 2; ++a)
#pragma unroll
        for (int b = 0; b < 2; ++b)
#pragma unroll
            for (int m = 0; m < 4; ++m)
#pragma unroll
                for (int n = 0; n < 2; ++n) acc[a][b][m][n] = (f32x4){0.f, 0.f, 0.f, 0.f};
    bf16x8 At[4][2], B0[2][2], B1[2][2];
    const char* cA = (const char*)g.A + (size_t)cur.pm * tstepA + (size_t)(cur.pn >> g.agrp_shift) * g.agrp_bytes; const char* cB = (const char*)g.Bt + (size_t)cur.pn * tstepB;
    S.a_ready(cur);
    if constexpr (SP2) {
        PG8_STAGE(PG8_SB(0, 0), cB, voffB); PG8_STAGE(PG8_SB(0, 1), cB + hstepB, voffB); PG8_STAGE(PG8_SA(0, 0), cA, voffA); PG8_STAGE(PG8_SA(0, 1), cA + hstepA, voffA);
        if (wr == 1) PG8_BAR;
        PG8_WAIT_V(2); PG8_BAR;
        PG8_STAGE(PG8_SB(1, 0), cB + kstep, voffB); PG8_STAGE(PG8_SA(1, 0), cA + kstep, voffA); PG8_STAGE(PG8_SB(1, 1), cB + hstepB + kstep, voffB);
        PG8_WAIT_V(6); PG8_BAR;
    } else {
        PG8_STAGE(PG8_SB(0, 0), cB, voffB); PG8_STAGE(PG8_SA(0, 0), cA, voffA); PG8_STAGE(PG8_SB(0, 1), cB + hstepB, voffB); PG8_STAGE(PG8_SA(0, 1), cA + hstepA, voffA);
        if (wr == 1) PG8_BAR;
        PG8_WAIT_V(4); PG8_BAR;
        PG8_STAGE(PG8_SB(1, 0), cB + kstep, voffB); PG8_STAGE(PG8_SA(1, 0), cA + kstep, voffA); PG8_STAGE(PG8_SB(1, 1), cB + hstepB + kstep, voffB);
        PG8_WAIT_V(6); PG8_BAR;
    }
    for (;;) {
        const bool has_next = S.next(ui + 1, nxt);
        const char* nA = has_next ? (const char*)g.A + (size_t)nxt.pm * tstepA + (size_t)(nxt.pn >> g.agrp_shift) * g.agrp_bytes : cA; const char* nB = has_next ? (const char*)g.Bt + (size_t)nxt.pn * tstepB : cB;
        for (int t = 0; t < nt; t += 2) {
            const bool last = (t == nt - 2);
            const char* a1 = cA + (size_t)(t + 1) * kstep;
            const char* a2 = last ? nA : cA + (size_t)(t + 2) * kstep; const char* b2 = last ? nB : cB + (size_t)(t + 2) * kstep;
            const char* a3 = a2 + kstep; const char* b3 = b2 + kstep;
            if (last && has_next) S.a_ready(nxt);
            if constexpr (SP2) {
            PG8_LDB(B0, 0, 0); PG8_LDB(B1, 0, 1); PG8_SCHED; PG8_LDA(At, 0, 0); PG8_STAGE(PG8_SA(1, 1), a1 + hstepA, voffA);
            PG8_WAIT_V(8); PG8_WAIT_L(0); PG8_BAR; PG8_MMA(0, 0, At, B0); PG8_MMA(0, 1, At, B1); PG8_BAR; PG8_SCHED;
            PG8_LDA(At, 0, 1); PG8_STAGE(PG8_SB(0, 0), b2, voffB); PG8_STAGE(PG8_SB(0, 1), b2 + hstepB, voffB); PG8_STAGE(PG8_SA(0, 0), a2, voffA);
            PG8_WAIT_V(8); PG8_WAIT_L(0); PG8_BAR; PG8_MMA(1, 0, At, B0); PG8_MMA(1, 1, At, B1); PG8_BAR; PG8_SCHED;
            PG8_LDB(B0, 1, 0); PG8_LDB(B1, 1, 1); PG8_SCHED; PG8_LDA(At, 1, 0); PG8_STAGE(PG8_SA(0, 1), a2 + hstepA, voffA);
            PG8_WAIT_V(8); PG8_WAIT_L(0); PG8_BAR; PG8_MMA(0, 0, At, B0); PG8_MMA(0, 1, At, B1); PG8_BAR; PG8_SCHED;
            PG8_LDA(At, 1, 1); PG8_STAGE(PG8_SB(1, 0), b3, voffB); PG8_STAGE(PG8_SB(1, 1), b3 + hstepB, voffB); PG8_STAGE(PG8_SA(1, 0), a3, voffA);
            PG8_WAIT_V(8); PG8_WAIT_L(0); PG8_BAR; PG8_MMA(1, 0, At, B0); PG8_MMA(1, 1, At, B1); PG8_BAR; PG8_SCHED;
            } else {
            PG8_LDB(B0, 0, 0); PG8_SCHED; PG8_LDA(At, 0, 0); PG8_STAGE(PG8_SA(1, 1), a1 + hstepA, voffA);
            PG8_WAIT_L(8); PG8_BAR; PG8_WAIT_L(0); PG8_MMA(0, 0, At, B0); PG8_BAR; PG8_SCHED;
            PG8_LDB(B1, 0, 1); PG8_STAGE(PG8_SB(0, 0), b2, voffB);
            PG8_BAR; PG8_WAIT_L(0); PG8_MMA(0, 1, At, B1); PG8_BAR;
            PG8_LDA(At, 0, 1); PG8_STAGE(PG8_SA(0, 0), a2, voffA);
            PG8_BAR; PG8_WAIT_L(0); PG8_MMA(1, 0, At, B0); PG8_BAR; PG8_SCHED;
            PG8_STAGE(PG8_SB(0, 1), b2 + hstepB, voffB);
            PG8_WAIT_V(6); PG8_BAR; PG8_MMA(1, 1, At, B1); PG8_BAR;
            PG8_LDB(B0, 1, 0); PG8_SCHED; PG8_LDA(At, 1, 0); PG8_STAGE(PG8_SA(0, 1), a2 + hstepA, voffA);
            PG8_WAIT_L(8); PG8_BAR; PG8_WAIT_L(0); PG8_MMA(0, 0, At, B0); PG8_BAR; PG8_SCHED;
            PG8_LDB(B1, 1, 1); PG8_STAGE(PG8_SB(1, 0), b3, voffB);
            PG8_BAR; PG8_WAIT_L(0); PG8_MMA(0, 1, At, B1); PG8_BAR;
            PG8_LDA(At, 1, 1); PG8_STAGE(PG8_SA(1, 0), a3, voffA);
            PG8_BAR; PG8_WAIT_L(0); PG8_MMA(1, 0, At, B0); PG8_BAR; PG8_SCHED;
            PG8_STAGE(PG8_SB(1, 1), b3 + hstepB, voffB);
            PG8_WAIT_V(6); PG8_BAR; PG8_MMA(1, 1, At, B1); PG8_BAR;
            }
        }
        if constexpr (ALIGN_EPI) { if (wr == 0) PG8_BAR; }
        if constexpr (!Epi::AFTER_DRAIN) { E(acc, cur, wr, wc, fr, fq); S.done(cur); }
        if (!has_next) break;
#pragma unroll
        for (int a = 0; a < 2; ++a)
#pragma unroll
            for (int b = 0; b < 2; ++b)
#pragma unroll
                for (int m = 0; m < 4; ++m)
#pragma unroll
                    for (int n = 0; n < 2; ++n) acc[a][b][m][n] = (f32x4){0.f, 0.f, 0.f, 0.f};
        cur = nxt; cA = nA; cB = nB; ++ui;
        if constexpr (ALIGN_EPI) { if (wr == 1) PG8_BAR; }
    }
    PG8_WAIT_V(0);
    if constexpr (!ALIGN_EPI) { if (wr == 0) PG8_BAR; }
    PG8_BAR;
    if constexpr (Epi::AFTER_DRAIN) { E.fused(acc, cur, wr, wc, fr, fq, lds, wid, lane); S.done(cur); }
#undef PG8_SA
#undef PG8_SB
#undef PG8_STAGE
#undef PG8_LDA
#undef PG8_LDB
#undef PG8_MMA
#undef PG8_WAIT_V
#undef PG8_WAIT_L
#undef PG8_BAR
#undef PG8_SCHED
}
}
#define XB_TMO      128
#define XB_XCNT(j)  (256  + 64 * (j))
#define XB_XSUB(j)  (1280 + 64 * (j))
#define XB_XGEN(j)  (2304 + 64 * (j))
#define XB_TOP      3328
#define XB_TOPGEN   3392
#define XCD_BAR_WORDS 3456
#define XB_SPIN_CAP (1u << 18)

__device__ __forceinline__ unsigned xb_ld(unsigned* p)              { return __hip_atomic_load(p, __ATOMIC_RELAXED, __HIP_MEMORY_SCOPE_AGENT); }
__device__ __forceinline__ unsigned xb_add(unsigned* p, unsigned v) { return __hip_atomic_fetch_add(p, v, __ATOMIC_RELAXED, __HIP_MEMORY_SCOPE_AGENT); }
__device__ __forceinline__ unsigned xb_xcc_id() { return (unsigned)__builtin_amdgcn_s_getreg((3 << 11) | 20) & 0xFu; }
#define XB_SPIN(cond, bar) do { unsigned _sp = 0; while (cond) { __builtin_amdgcn_s_sleep(1); \
    if ((++_sp & 255u) == 0u) { if (xb_ld(&(bar)[XB_TMO])) break; if (_sp > XB_SPIN_CAP) { atomicAdd(&(bar)[XB_TMO], 1u); break; } } } } while (0)

struct XcdBarrier {
    unsigned* bar; unsigned x;
    volatile LAS unsigned* st;
};

__device__ __forceinline__ XcdBarrier xcd_barrier_post(unsigned* bar, volatile LAS unsigned* st) {
    XcdBarrier b; b.bar = bar; b.x = xb_xcc_id(); b.st = st;
    if (threadIdx.x == 0) (void)xb_add(&bar[XB_XCNT(b.x)], 1u);
    return b;
}
__device__ __forceinline__ void xcd_barrier_complete(unsigned* bar, unsigned x, unsigned& nloc, unsigned& nx) {
    const unsigned G = gridDim.x * gridDim.y * gridDim.z;
    unsigned sum, cnt, mine, sp = 0u;
    for (;;) {
        sum = 0u; cnt = 0u; mine = 0u;
#pragma unroll
        for (unsigned j = 0; j < 16; ++j) { const unsigned c = xb_ld(&bar[XB_XCNT(j)]); sum += c; cnt += (c > 0u) ? 1u : 0u; mine = (j == x) ? c : mine; }
        if (sum == G) break;
        __builtin_amdgcn_s_sleep(1);
        if ((++sp & 255u) == 0u) { if (xb_ld(&bar[XB_TMO])) break; if (sp > XB_SPIN_CAP) { atomicAdd(&bar[XB_TMO], 1u); break; } }
    }
    nloc = mine > 0u ? mine : 1u; nx = cnt > 0u ? cnt : 1u;
}

__device__ __forceinline__ void xcd_barrier(const XcdBarrier& b) {
    asm volatile("s_waitcnt vmcnt(0)" ::: "memory");
    __syncthreads();
    if (threadIdx.x == 0) {
        unsigned* bar = b.bar;
        __builtin_amdgcn_s_waitcnt(0);
        unsigned nloc = b.st[0], nx = b.st[1];
        if (nloc == 0u) { xcd_barrier_complete(bar, b.x, nloc, nx); b.st[0] = nloc; b.st[1] = nx; }
        const unsigned old = xb_add(&bar[XB_XSUB(b.x)], 1u);
        const unsigned gen = old / nloc;
        if (old + 1u == (gen + 1u) * nloc) {
            __builtin_amdgcn_fence(__ATOMIC_RELEASE, "agent");
            asm volatile("s_waitcnt vmcnt(0)" ::: "memory");
            const unsigned og = xb_add(&bar[XB_TOP], 1u);
            const unsigned tg = og / nx;
            if (og + 1u == (tg + 1u) * nx) xb_add(&bar[XB_TOPGEN], 1u);
            else XB_SPIN(xb_ld(&bar[XB_TOPGEN]) == tg, bar);
            __builtin_amdgcn_fence(__ATOMIC_ACQUIRE, "agent");
            xb_add(&bar[XB_XGEN(b.x)], 1u);
            asm volatile("s_waitcnt vmcnt(0)" ::: "memory");
        } else {
            XB_SPIN(xb_ld(&bar[XB_XGEN(b.x)]) == gen, bar);
            __builtin_amdgcn_fence(__ATOMIC_ACQUIRE, "agent");
            asm volatile("s_waitcnt vmcnt(0)" ::: "memory");
        }
    }
    __syncthreads();
}
namespace att {
using bf16 = __hip_bfloat16;
constexpr int   D = 128, NW = 8, QBLK = 32, KVBLK = 64;
constexpr float SCALE = 0.088388347648318440f;
constexpr float THR = 8.f;
constexpr int SDEPTH = 1;
constexpr int LDQ = 1024, LDK = 512, LDO = 2048;
constexpr size_t SHM_V = KVBLK * D * 2, SHM_K = KVBLK * D * 2, SHM_ATTN = 2 * SHM_V + 2 * SHM_K + NW * 64 * 4;
using bf16x8 = __attribute__((ext_vector_type(8))) short;
using s16x4  = __attribute__((ext_vector_type(4))) short;
using f32x16 = __attribute__((ext_vector_type(16))) float;
using f32x8  = __attribute__((ext_vector_type(8))) float;
using u32x4  = __attribute__((ext_vector_type(4))) unsigned;
#define KSWZ(row, colB) ((row) * 256 + ((colB) ^ (((row) & 7) << 4)))
#define SBAR() __builtin_amdgcn_sched_barrier(0)
__device__ __forceinline__ int crow(int r, int hi) { return (r & 3) + 8 * (r >> 2) + 4 * hi; }
__device__ __forceinline__ unsigned cvtpk(float lo, float hi) {
  unsigned r; asm volatile("v_cvt_pk_bf16_f32 %0, %1, %2" : "=v"(r) : "v"(lo), "v"(hi)); return r;
}
template <typename TIn> struct Stage;
template <> struct Stage<bf16>  { using T = bf16x8;
  __device__ static __forceinline__ T ld8(const bf16* p) { return *reinterpret_cast<const bf16x8*>(p); }
  __device__ static __forceinline__ bf16x8 tobf(T x) { return x; } };
template <> struct Stage<float> { using T = f32x8;
  __device__ static __forceinline__ T ld8(const float* p) { return *reinterpret_cast<const f32x8*>(p); }
  __device__ static __forceinline__ bf16x8 tobf(T x) {
    u32x4 w = {cvtpk(x[0], x[1]), cvtpk(x[2], x[3]), cvtpk(x[4], x[5]), cvtpk(x[6], x[7])}; return *reinterpret_cast<bf16x8*>(&w); } };

__device__ __forceinline__ void partialSM(f32x16& p0, f32x16& p1, float mC) {
  constexpr float C = SCALE * 1.4426950408889634f;
  for (int r = 0; r < 16; ++r) p0[r] = fmaf(p0[r], C, mC); for (int r = 0; r < 16; ++r) p1[r] = fmaf(p1[r], C, mC);
  for (int r = 0; r < 16; ++r) p0[r] = __builtin_amdgcn_exp2f(p0[r]);
}
__device__ __forceinline__ void finishSM(f32x16& p0, f32x16& p1, float& l_reg, bf16x8& pa0, bf16x8& pa1, bf16x8& pa2, bf16x8& pa3) {
  for (int r = 0; r < 16; ++r) p1[r] = __builtin_amdgcn_exp2f(p1[r]);
  float ps = 0; for (int r = 0; r < 16; ++r) ps += p0[r]; for (int r = 0; r < 16; ++r) ps += p1[r];
  l_reg += ps;
#define PK4(P, BASE, OUT) do { unsigned a0 = cvtpk(P[BASE + 0], P[BASE + 1]), a1 = cvtpk(P[BASE + 2], P[BASE + 3]);   \
    unsigned b0 = cvtpk(P[BASE + 4], P[BASE + 5]), b1 = cvtpk(P[BASE + 6], P[BASE + 7]);                              \
    auto r0 = __builtin_amdgcn_permlane32_swap(a0, b0, false, false); auto r1 = __builtin_amdgcn_permlane32_swap(a1, b1, false, false); \
    u32x4 w = {r0[0], r1[0], r0[1], r1[1]}; OUT = *reinterpret_cast<bf16x8*>(&w); } while (0)
  PK4(p0, 0, pa0); PK4(p0, 8, pa1); PK4(p1, 0, pa2); PK4(p1, 8, pa3);
#undef PK4
}
__device__ __forceinline__ void qkt(f32x16& p0, f32x16& p1, const bf16* Ks, const bf16x8* qr, int r32, int hi) {
  p0 = f32x16{}; p1 = f32x16{};
  for (int d0 = 0; d0 < 8; ++d0) { int cb = (d0 * 16 + hi * 8) * 2;
    bf16x8 b0 = *reinterpret_cast<const bf16x8*>((const char*)Ks + KSWZ(r32, cb));
    bf16x8 b1 = *reinterpret_cast<const bf16x8*>((const char*)Ks + KSWZ(32 + r32, cb));
    p0 = __builtin_amdgcn_mfma_f32_32x32x16_bf16(b0, qr[d0], p0, 0, 0, 0);
    p1 = __builtin_amdgcn_mfma_f32_32x32x16_bf16(b1, qr[d0], p1, 0, 0, 0); }
}
__device__ __forceinline__ int v_st(int k, int c) { const int kk = (k & ~0xC) | ((k & 4) << 1) | ((k & 8) >> 1); return ((kk >> 3) * 4 + (c >> 5)) * 512 + ((kk & 7) * 32 + (c & 31)) * 2; }
__device__ __forceinline__ int v_rd_base(int lane) { return ((lane & 3) << 3) | (((lane >> 2) & 3) << 6) | (((lane >> 4) & 1) << 5) | (((lane >> 5) & 1) << 8); }
constexpr int v_rd_off(int d0, int ks, int half) { return d0 * 512 + ks * 4096 + half * 2048; }
template <int OFF> __device__ __forceinline__ s16x4 tr_read(int vb) {
  s16x4 r; asm volatile("ds_read_b64_tr_b16 %0, %1 offset:%2" : "=&v"(r) : "v"(vb), "i"(OFF) : "memory"); return r;
}
template <int D0> __device__ __forceinline__ void pv_one(f32x16& od, int vb, bf16x8 pa0, bf16x8 pa1, bf16x8 pa2, bf16x8 pa3) {
  const s16x4 l0 = tr_read<v_rd_off(D0, 0, 0)>(vb), h0 = tr_read<v_rd_off(D0, 0, 1)>(vb), l1 = tr_read<v_rd_off(D0, 1, 0)>(vb), h1 = tr_read<v_rd_off(D0, 1, 1)>(vb);
  const s16x4 l2 = tr_read<v_rd_off(D0, 2, 0)>(vb), h2 = tr_read<v_rd_off(D0, 2, 1)>(vb), l3 = tr_read<v_rd_off(D0, 3, 0)>(vb), h3 = tr_read<v_rd_off(D0, 3, 1)>(vb);
  asm volatile("s_waitcnt lgkmcnt(0)" ::: "memory"); SBAR();
#define PK(L, H) (bf16x8){L[0], L[1], L[2], L[3], H[0], H[1], H[2], H[3]}
  od = __builtin_amdgcn_mfma_f32_32x32x16_bf16(pa0, PK(l0, h0), od, 0, 0, 0);
  od = __builtin_amdgcn_mfma_f32_32x32x16_bf16(pa1, PK(l1, h1), od, 0, 0, 0);
  od = __builtin_amdgcn_mfma_f32_32x32x16_bf16(pa2, PK(l2, h2), od, 0, 0, 0);
  od = __builtin_amdgcn_mfma_f32_32x32x16_bf16(pa3, PK(l3, h3), od, 0, 0, 0);
#undef PK
}
__device__ __forceinline__ void pv_d0(f32x16* o, int vb, bf16x8 pa0, bf16x8 pa1, bf16x8 pa2, bf16x8 pa3) {
  pv_one<0>(o[0], vb, pa0, pa1, pa2, pa3); pv_one<1>(o[1], vb, pa0, pa1, pa2, pa3); pv_one<2>(o[2], vb, pa0, pa1, pa2, pa3); pv_one<3>(o[3], vb, pa0, pa1, pa2, pa3);
}

template <typename TQ>
__device__ __forceinline__ void attn_dense_body(const TQ* __restrict__ Qb, const bf16* __restrict__ Kh, const bf16* __restrict__ Vh,
                                                bf16* __restrict__ Ob, int seq, char* lds, float mC) {
  using St = Stage<bf16>; using SQ = Stage<TQ>;
  int tid_ = threadIdx.x; asm volatile("" : "+v"(tid_));
  const int tid = tid_, wid = tid >> 6, lane = tid & 63, r32 = lane & 31, hi = lane >> 5;
  bf16* V_lds = (bf16*)lds; bf16* K_lds = (bf16*)(lds + 2 * SHM_V);
  float* ws = (float*)(lds + 2 * SHM_V + 2 * SHM_K) + wid * 64; float* li_l = ws;
  float l_reg = 0; f32x16 o[4] = {}; bf16x8 qr[8];
  const TQ* Qw = Qb + (long)(wid * QBLK + r32) * LDQ + hi * 8;
#pragma unroll
  for (int d0 = 0; d0 < 8; ++d0) qr[d0] = SQ::tobf(SQ::ld8(Qw + d0 * 16));
  const int sr = tid >> 4, sc = (tid & 15) * 8, vst0 = v_st(sr, sc), vst1 = v_st(32 + sr, sc);
  const int vb0 = (int)(uintptr_t)V_lds + v_rd_base(lane);
  struct { typename St::T vs0, vs1, ks0, ks1; } sr_[SDEPTH];
#define SLOAD(i, k0) do { sr_[i].vs0 = St::ld8(&Vh[(long)((k0) + sr) * LDK + sc]); sr_[i].vs1 = St::ld8(&Vh[(long)((k0) + 32 + sr) * LDK + sc]); \
    sr_[i].ks0 = St::ld8(&Kh[(long)((k0) + sr) * LDK + sc]); sr_[i].ks1 = St::ld8(&Kh[(long)((k0) + 32 + sr) * LDK + sc]); } while (0)
#define SWRITE(b, i) do { *(bf16x8*)((char*)V_lds + (b) * SHM_V + vst0) = St::tobf(sr_[i].vs0);          \
    *(bf16x8*)((char*)V_lds + (b) * SHM_V + vst1) = St::tobf(sr_[i].vs1); int kc = sc * 2;               \
    *(bf16x8*)((char*)K_lds + (b) * SHM_K + KSWZ(sr, kc)) = St::tobf(sr_[i].ks0);                       \
    *(bf16x8*)((char*)K_lds + (b) * SHM_K + KSWZ(32 + sr, kc)) = St::tobf(sr_[i].ks1); } while (0)
#define SWAIT() do { if constexpr (SDEPTH == 2) asm volatile("s_waitcnt vmcnt(4)" ::: "memory"); else asm volatile("s_waitcnt vmcnt(0)" ::: "memory"); } while (0)
  f32x16 pA0, pA1, pB0, pB1; bf16x8 pa0, pa1, pa2, pa3; const int NT = seq / KVBLK;
  constexpr int SE = 0, SO = SDEPTH - 1;
  SLOAD(SE, 0); asm volatile("s_waitcnt vmcnt(0)" ::: "memory"); SWRITE(0, SE); __syncthreads();
  qkt(pA0, pA1, K_lds, qr, r32, hi); partialSM(pA0, pA1, mC);
  SLOAD(SO, KVBLK); if constexpr (SDEPTH == 2) { if (2 < NT) SLOAD(SE, 2 * KVBLK); }
  SWAIT(); SWRITE(1, SO); __syncthreads();
  for (int j = 1; j + 1 < NT; j += 2) {
    SBAR(); qkt(pB0, pB1, (bf16*)((char*)K_lds + SHM_K), qr, r32, hi);
    finishSM(pA0, pA1, l_reg, pa0, pa1, pa2, pa3); SBAR();
    SLOAD(SO, (j + SDEPTH) * KVBLK); SBAR();
    pv_d0(o, vb0, pa0, pa1, pa2, pa3); partialSM(pB0, pB1, mC);
    __syncthreads(); SWAIT(); SWRITE(0, SE);
    __syncthreads();
    SBAR(); qkt(pA0, pA1, K_lds, qr, r32, hi);
    finishSM(pB0, pB1, l_reg, pa0, pa1, pa2, pa3); SBAR();
    if (SDEPTH == 1 || j + 3 < NT) SLOAD(SE, (j + 1 + SDEPTH) * KVBLK); SBAR();
    pv_d0(o, vb0 + (int)SHM_V, pa0, pa1, pa2, pa3); partialSM(pA0, pA1, mC);
    __syncthreads(); SWAIT(); SWRITE(1, SO);
    __syncthreads();
  }
  SBAR(); qkt(pB0, pB1, (bf16*)((char*)K_lds + SHM_K), qr, r32, hi);
  finishSM(pA0, pA1, l_reg, pa0, pa1, pa2, pa3); SBAR();
  pv_d0(o, vb0, pa0, pa1, pa2, pa3); partialSM(pB0, pB1, mC);
  __syncthreads();
  finishSM(pB0, pB1, l_reg, pa0, pa1, pa2, pa3); SBAR();
  pv_d0(o, vb0 + (int)SHM_V, pa0, pa1, pa2, pa3);
  { auto rr = __builtin_amdgcn_permlane32_swap(__float_as_uint(l_reg), __float_as_uint(l_reg), false, false); l_reg = __uint_as_float(rr[0]) + __uint_as_float(rr[1]); }
  if (hi == 0) li_l[r32] = l_reg; asm volatile("s_waitcnt lgkmcnt(0)" ::: "memory");
  float rli[16];
#pragma unroll
  for (int r = 0; r < 16; ++r) rli[r] = __builtin_amdgcn_rcpf(li_l[crow(r, hi)]);
  bf16* Ow = Ob + (long)(wid * QBLK) * LDO;
#pragma unroll
  for (int r = 0; r < 16; ++r) { int orow = crow(r, hi);
    for (int d0 = 0; d0 < 4; ++d0) Ow[(long)orow * LDO + d0 * 32 + r32] = __float2bfloat16(o[d0][r] * rli[r]); }
  __syncthreads();
#undef SLOAD
#undef SWRITE
#undef SWAIT
}
#undef KSWZ
#undef SBAR
}

struct Frame {
    LAS unsigned char* lds;
    char* ldsg;
    int tid, lane, wave, vcu, G;
    unsigned char* ws;
};
__device__ __forceinline__ const float* frame_in(const Frame& F, int i) {
    const LAS unsigned* p = (const LAS unsigned*)(F.lds + LDSCTL_OFF + 64) + 2 * i;
    const unsigned lo = __builtin_amdgcn_readfirstlane(p[0]), hi = __builtin_amdgcn_readfirstlane(p[1]);
    return (const float*)(const GAS float*)(((unsigned long long)hi << 32) | lo);
}
#define FIN(i) frame_in(F, (i))
#define FOUT() ((float*)frame_in(F, 17))
#define WSP(T, off) ((T*)(F.ws + (off)))

__device__ __forceinline__ void p0_transpose_item(const float* W, int K, int N, int Npad, bf16_t* WT, int row_off, LAS float* scr, int item, int lane, const float* kscale = nullptr) {
    const int nblk = Npad / 32, kb = item / nblk, nb = item % nblk, k0 = 64 * kb, n0 = 32 * nb;
    const int nn = n0 + 4 * (lane & 7);
    f32x4 v[8];
#pragma unroll
    for (int i = 0; i < 8; ++i) { const int kk = 8 * i + (lane >> 3); v[i] = nn < N ? *(const f32x4*)(W + (size_t)(k0 + kk) * N + nn) : (f32x4){0.f, 0.f, 0.f, 0.f}; }
#pragma unroll
    for (int i = 0; i < 8; ++i) { const int kk = 8 * i + (lane >> 3); *(LAS f32x4*)(scr + kk * 36 + 4 * (lane & 7)) = v[i]; }
    LDS_WAIT(); asm volatile("" ::: "memory");
    const int c = lane & 7;
    f32x4 ka = {1.f, 1.f, 1.f, 1.f}, kc = ka; if (kscale) { ka = *(const f32x4*)(kscale + k0 + 8 * c); kc = *(const f32x4*)(kscale + k0 + 8 * c + 4); }
#pragma unroll
    for (int j = 0; j < 4; ++j) { const int n = (lane >> 3) + 8 * j; const LAS float* s = scr + (8 * c) * 36 + n;
        u32x4 o; o.x = pk2(s[0 * 36] * ka.x, s[1 * 36] * ka.y); o.y = pk2(s[2 * 36] * ka.z, s[3 * 36] * ka.w); o.z = pk2(s[4 * 36] * kc.x, s[5 * 36] * kc.y); o.w = pk2(s[6 * 36] * kc.z, s[7 * 36] * kc.w);
        *(GAS u32x4*)(WT + (size_t)(row_off + n0 + n) * K + k0 + 8 * c) = o; }
    LDS_WAIT(); asm volatile("" ::: "memory");
}
__device__ __forceinline__ u32x4 cvt8(const float* p) {
    const f32x4 a = *(const f32x4*)p, b = *(const f32x4*)(p + 4);
    u32x4 o; o.x = pk2(a.x, a.y); o.y = pk2(a.z, a.w); o.z = pk2(b.x, b.y); o.w = pk2(b.z, b.w); return o;
}
__device__ __forceinline__ void rms_row_to_bf16(const float* xrow, const float* g, bf16_t* orow, int lane) {
    const f32x4* xr = (const f32x4*)xrow + lane;
    f32x4 v[8]; float s = 0.f;
#pragma unroll
    for (int j = 0; j < 8; ++j) { v[j] = xr[64 * j]; s += (v[j].x * v[j].x + v[j].y * v[j].y) + (v[j].z * v[j].z + v[j].w * v[j].w); }
    const float r = 1.0f / sqrtf(wave_sum(s) * (1.f / DM) + EPS);
    u32x2* o8 = (u32x2*)orow + lane;
#pragma unroll
    for (int j = 0; j < 8; ++j) { const f32x4 gg = ((const f32x4*)g)[lane + 64 * j]; u32x2 w; w.x = pk2(v[j].x * r * gg.x, v[j].y * r * gg.y); w.y = pk2(v[j].z * r * gg.z, v[j].w * r * gg.w); o8[64 * j] = w; }
}
__device__ __forceinline__ void ph_prologue(const Frame& F) {
    LAS float* scr = (LAS float*)(F.lds + F.wave * 16384);
    const int gw = F.vcu * NWAVES + F.wave, NGW = F.G * NWAVES;
#if TBL_FP4
    const float* gff = FIN(2) + F.lane * 4; const float* tsrc0 = FIN(14) + F.lane * 4; const float* tsrc1 = FIN(15) + F.lane * 4;
    for (int row = gw; row < 4 * 16384; row += NGW) {
        const int tb = row >> 15, rr = row & 32767;
        const float* src = (tb ? tsrc1 : tsrc0) + (size_t)rr * DM;
        f32x4 v[8]; float am = 0.f;
#pragma unroll
        for (int q = 0; q < 8; ++q) v[q] = *(const f32x4*)(src + 256 * q);
        if (tb == 0) {
#pragma unroll
            for (int q = 0; q < 8; ++q) v[q] = v[q] * *(const f32x4*)(gff + (rr >> 14) * DM + 256 * q); }
#pragma unroll
        for (int q = 0; q < 8; ++q) am = fmaxf(am, fmaxf(fmaxf(fabsf(v[q].x), fabsf(v[q].y)), fmaxf(fabsf(v[q].z), fabsf(v[q].w))));
#pragma unroll
        for (int o = 1; o < 64; o <<= 1) am = fmaxf(am, __shfl_xor(am, o));
        unsigned char* dst = F.ws + (tb ? WS_VB : WS_UB) + (size_t)(rr >> 14) * (16384 * 1024) + (size_t)(rr & 16383) * 128 + F.lane * 2;
        float sc;
        if (tb == 0) {
            float sq = 0.f;
#pragma unroll
            for (int q = 0; q < 8; ++q) sq += (v[q].x * v[q].x + v[q].y * v[q].y) + (v[q].z * v[q].z + v[q].w * v[q].w);
            sq = wave_sum(sq); sc = sq > 0.f ? 0.36f * sqrtf(sq * (1.f / DM)) : 1.f; const float isc = 1.0f / sc;
#pragma unroll
            for (int q = 0; q < 8; ++q) { const f32x4 z = v[q] * isc; int n[4];
#pragma unroll
                for (int e = 0; e < 4; ++e) n[e] = (int)fminf(fmaxf(rintf(z[e]), -7.f), 7.f) & 15;
                *(unsigned short*)(dst + (size_t)q * (16384 * 128)) = (unsigned short)(n[0] | (n[1] << 4) | (n[2] << 8) | (n[3] << 12)); }
        } else {
            sc = am > 0.f ? am * (1.f / 6.f) : 1.f; const float isc = 1.0f / sc;
#pragma unroll
            for (int q = 0; q < 8; ++q) { unsigned p = 0u;
                p = __builtin_amdgcn_cvt_scalef32_pk_fp4_f32(p, v[q].x * isc, v[q].y * isc, 1.0f, 0); p = __builtin_amdgcn_cvt_scalef32_pk_fp4_f32(p, v[q].z * isc, v[q].w * isc, 1.0f, 1);
                *(unsigned short*)(dst + (size_t)q * (16384 * 128)) = (unsigned short)p; }
        }
        if (F.lane == 0) ((float*)(F.ws + WS_TSC))[row] = sc;
    }
#else
    for (int row = gw; row < 4 * 16384; row += NGW) {
        const int tb = row >> 15, rr = row & 32767;
        const float* src = FIN(14 + tb) + (size_t)rr * DM + F.lane * 16;
        f32x4 v[8]; float am = 0.f;
#pragma unroll
        for (int q = 0; q < 8; ++q) { v[q] = *(const f32x4*)(src + (q >> 2) * 1024 + (q & 3) * 4);
            am = fmaxf(am, fmaxf(fmaxf(fabsf(v[q].x), fabsf(v[q].y)), fmaxf(fabsf(v[q].z), fabsf(v[q].w)))); }
#pragma unroll
        for (int o = 1; o < 64; o <<= 1) am = fmaxf(am, __shfl_xor(am, o));
        const float sc = am > 0.f ? am * (1.f / 448.f) : 1.f, isc = 1.0f / sc;
        unsigned w[8];
#pragma unroll
        for (int q = 0; q < 8; ++q) { unsigned p = __builtin_amdgcn_cvt_pk_fp8_f32(v[q].x * isc, v[q].y * isc, 0u, false); w[q] = __builtin_amdgcn_cvt_pk_fp8_f32(v[q].z * isc, v[q].w * isc, p, true); }
        unsigned char* dst = F.ws + (tb ? WS_VB : WS_UB) + (size_t)(rr >> 14) * (16384 * 2048) + ((size_t)(F.lane >> 3) * 16384 + (rr & 16383)) * 128 + (F.lane & 7) * 16;
        *(u32x4*)dst = (u32x4){w[0], w[1], w[2], w[3]}; *(u32x4*)(dst + (size_t)8 * 16384 * 128) = (u32x4){w[4], w[5], w[6], w[7]};
        if (F.lane == 0) ((float*)(F.ws + WS_TSC))[row] = sc;
    }
#endif
    {   constexpr int I_IN = (DM / 64) * (INP / 32), I_SQ = (DM / 64) * (DM / 32), I_PL = 4 * (512 / 64) * (512 / 32);
        constexpr int NIT = I_IN + 3 * I_SQ + I_PL;
        for (int it = gw; it < NIT; it += NGW) {
            int r = it;
            if (r < I_IN) { p0_transpose_item(FIN(3), DM, INW, INP, WSP(bf16_t, WS_WIN), 0, scr, r, F.lane); continue; } r -= I_IN;
            if (r < I_SQ) { p0_transpose_item(FIN(9), DM, DM, DM, WSP(bf16_t, WS_WOUT), 0, scr, r, F.lane); continue; } r -= I_SQ;
            if (r < I_SQ) { p0_transpose_item(FIN(12), DM, DM, DM, WSP(bf16_t, WS_WQ0), 0, scr, r, F.lane, FIN(2)); continue; } r -= I_SQ;
            if (r < I_SQ) { p0_transpose_item(FIN(12) + (size_t)DM * DM, DM, DM, DM, WSP(bf16_t, WS_WQ1), 0, scr, r, F.lane, FIN(2) + DM); continue; } r -= I_SQ;
            const int grp = r / 128, ri = r % 128;
            p0_transpose_item(FIN(10) + (size_t)grp * 512 * 512, 512, 512, 512, WSP(bf16_t, WS_WPOOL), grp * 512, scr, ri, F.lane);
        }
    }
    for (int it = gw; it < 1024; it += NGW) *(u32x4*)(WSP(bf16_t, WS_KEYS) + (size_t)it * 512 + F.lane * 8) = cvt8(FIN(13) + (size_t)it * 512 + F.lane * 8);
    for (int m = gw; m < S; m += NGW) rms_row_to_bf16(FIN(0) + (size_t)m * DM, FIN(1), WSP(bf16_t, WS_XN) + (size_t)m * DM, F.lane);
}

__device__ __forceinline__ float silu_f(float z) { return z / (1.f + __expf(-z)); }
__device__ __forceinline__ void p2_qkv_token(const Frame& F, int t) {
    const int lane = F.lane, i8 = lane & 7;
    const bf16_t* pr = WSP(bf16_t, WS_PROJ) + (size_t)t * INP;
    const int axis = i8 >> 2, half = (i8 >> 1) & 1, f0 = (i8 & 1) * 16;
    const float pos = (float)(axis == 0 ? (t >> 6) : (t & 63));
    float cs[16], sn[16];
#pragma unroll
    for (int e = 0; e < 16; ++e) { const float inv = exp2f(-(float)(f0 + e) * (13.287712379549449f / 32.f));
        float rev = pos * inv * 0.15915494309189535f; rev -= rintf(rev);
        cs[e] = __builtin_amdgcn_cosf(rev); sn[e] = __builtin_amdgcn_sinf(rev); }
    const float sgn = half ? 1.f : -1.f;
    {   const u32x4 w0 = *(const u32x4*)(pr + C_AQ + lane * 16), w1 = *(const u32x4*)(pr + C_AQ + lane * 16 + 8);
        float v[16]; const unsigned ww[8] = {w0.x, w0.y, w0.z, w0.w, w1.x, w1.y, w1.z, w1.w};
#pragma unroll
        for (int e = 0; e < 8; ++e) { v[2 * e] = bflo(ww[e]); v[2 * e + 1] = bfhi(ww[e]); }
        float ss = 0.f;
#pragma unroll
        for (int e = 0; e < 16; ++e) ss += v[e] * v[e];
        ss += __shfl_xor(ss, 1); ss += __shfl_xor(ss, 2); ss += __shfl_xor(ss, 4);
        const float r = 1.0f / sqrtf(ss * (1.f / 128.f) + EPS);
        const float* gq = FIN(6) + i8 * 16;
        unsigned ow[8];
        float y[16];
#pragma unroll
        for (int e = 0; e < 16; ++e) y[e] = v[e] * r * gq[e];
#pragma unroll
        for (int e = 0; e < 16; ++e) { const float yp = __shfl_xor(y[e], 2); y[e] = y[e] * cs[e] + sgn * yp * sn[e]; }
#pragma unroll
        for (int e = 0; e < 8; ++e) ow[e] = pk2(y[2 * e], y[2 * e + 1]);
        bf16_t* dst = WSP(bf16_t, WS_QB) + (size_t)t * 1024 + lane * 16;
        *(u32x4*)dst = (u32x4){ow[0], ow[1], ow[2], ow[3]}; *(u32x4*)(dst + 8) = (u32x4){ow[4], ow[5], ow[6], ow[7]};
    }
    {   const int l16 = lane & 15;
        const u32x4 w0 = *(const u32x4*)(pr + C_AK + l16 * 16), w1 = *(const u32x4*)(pr + C_AK + l16 * 16 + 8);
        float v[16]; const unsigned ww[8] = {w0.x, w0.y, w0.z, w0.w, w1.x, w1.y, w1.z, w1.w};
#pragma unroll
        for (int e = 0; e < 8; ++e) { v[2 * e] = bflo(ww[e]); v[2 * e + 1] = bfhi(ww[e]); }
        float ss = 0.f;
#pragma unroll
        for (int e = 0; e < 16; ++e) ss += v[e] * v[e];
        ss += __shfl_xor(ss, 1); ss += __shfl_xor(ss, 2); ss += __shfl_xor(ss, 4);
        const float r = 1.0f / sqrtf(ss * (1.f / 128.f) + EPS);
        const float* gk = FIN(7) + i8 * 16;
        float y[16]; unsigned ow[8];
#pragma unroll
        for (int e = 0; e < 16; ++e) y[e] = v[e] * r * gk[e];
#pragma unroll
        for (int e = 0; e < 16; ++e) { const float yp = __shfl_xor(y[e], 2); y[e] = y[e] * cs[e] + sgn * yp * sn[e]; }
#pragma unroll
        for (int e = 0; e < 8; ++e) ow[e] = pk2(y[2 * e], y[2 * e + 1]);
        bf16_t* kv = WSP(bf16_t, WS_KVB) + (size_t)t * 512;
        if (lane < 16) { *(u32x4*)(kv + lane * 16) = (u32x4){ow[0], ow[1], ow[2], ow[3]}; *(u32x4*)(kv + lane * 16 + 8) = (u32x4){ow[4], ow[5], ow[6], ow[7]}; }
        else if (lane < 32) { const u32x4 a = *(const u32x4*)(pr + C_AV + l16 * 16), b = *(const u32x4*)(pr + C_AV + l16 * 16 + 8);
            *(u32x4*)(kv + 256 + l16 * 16) = a; *(u32x4*)(kv + 256 + l16 * 16 + 8) = b; }
    }
}
__device__ __forceinline__ void p2_conv_item(const Frame& F, int item) {
    const int tb = item >> 2, sl = item & 3, lane = F.lane, c = sl * 512 + lane * 8, t0 = tb * 16;
    float w[5][8];
#pragma unroll
    for (int j = 0; j < 5; ++j) { const f32x4 a = *(const f32x4*)(FIN(5) + j * 2048 + c), b = *(const f32x4*)(FIN(5) + j * 2048 + c + 4);
        w[j][0] = a.x; w[j][1] = a.y; w[j][2] = a.z; w[j][3] = a.w; w[j][4] = b.x; w[j][5] = b.y; w[j][6] = b.z; w[j][7] = b.w; }
    const bf16_t* src = WSP(bf16_t, WS_PROJ) + C_MQK + c;
    const float osc = (c >= 1024) ? 0.0625f : 1.f;
    bf16_t* dst = (c >= 1024) ? WSP(bf16_t, WS_MK) + (c - 1024) : WSP(bf16_t, WS_MQ) + c;
    u32x4 rows[20];
#pragma unroll
    for (int j = 0; j < 20; ++j) { const int tt = t0 - 2 + j; rows[j] = (tt >= 0 && tt < S) ? *(const u32x4*)(src + (size_t)tt * INP) : (u32x4){0u, 0u, 0u, 0u}; }
#pragma unroll
    for (int q = 0; q < 16; ++q) {
        float acc[8];
#pragma unroll
        for (int e = 0; e < 8; ++e) acc[e] = 0.f;
#pragma unroll
        for (int j = 0; j < 5; ++j) { const unsigned ww[4] = {rows[q + j].x, rows[q + j].y, rows[q + j].z, rows[q + j].w};
#pragma unroll
            for (int e = 0; e < 4; ++e) { acc[2 * e] += bflo(ww[e]) * w[j][2 * e]; acc[2 * e + 1] += bfhi(ww[e]) * w[j][2 * e + 1]; } }
        u32x4 o; o.x = pk2(silu_f(acc[0]) * osc, silu_f(acc[1]) * osc); o.y = pk2(silu_f(acc[2]) * osc, silu_f(acc[3]) * osc);
        o.z = pk2(silu_f(acc[4]) * osc, silu_f(acc[5]) * osc); o.w = pk2(silu_f(acc[6]) * osc, silu_f(acc[7]) * osc);
        *(u32x4*)(dst + (size_t)(t0 + q) * 1024) = o;
    }
}
__device__ __forceinline__ float wave_incl_scan_add(float v, int lane) {
#pragma unroll
    for (int o = 1; o < 64; o <<= 1) { const float u = __shfl_up(v, o); if (lane >= o) v += u; }
    return v;
}
__device__ __forceinline__ float wave_incl_scan_max(float v, int lane) {
#pragma unroll
    for (int o = 1; o < 64; o <<= 1) { const float u = __shfl_up(v, o); if (lane >= o) v = fmaxf(v, u); }
    return v;
}
__device__ __forceinline__ float logsigmoid_f(float x) { return fminf(x, 0.f) - log1pf(__expf(-fabsf(x))); }
__device__ __forceinline__ void p2_gate_item(const Frame& F, int item) {
    const int dh = item >> 7, c = item & 127, dir = dh >> 2, h = dh & 3, lane = F.lane;
    const int p0 = 128 * c + 2 * lane, t0 = dir ? (S - 1 - p0) : p0, t1 = dir ? (t0 - 1) : (t0 + 1);
    const bf16_t* pg = WSP(bf16_t, WS_PROJ) + C_GATE + dir * 8 + h;
    const float bi = FIN(4)[dir * 8 + h], bf = FIN(4)[dir * 8 + 4 + h];
    const float i0 = bflo((unsigned)pg[(size_t)t0 * INP]) + bi, f0 = bflo((unsigned)pg[(size_t)t0 * INP + 4]) + bf;
    const float i1 = bflo((unsigned)pg[(size_t)t1 * INP]) + bi, f1 = bflo((unsigned)pg[(size_t)t1 * INP + 4]) + bf;
    const float lf0 = logsigmoid_f(f0), lf1 = logsigmoid_f(f1);
    const float incl = wave_incl_scan_add(lf0 + lf1, lane);
    const float b1 = incl, b0 = incl - lf1;
    const float u0 = i0 - b0, u1 = i1 - b1;
    const float mincl = wave_incl_scan_max(fmaxf(u0, u1), lane);
    float mprevl = __shfl_up(mincl, 1); if (lane == 0) mprevl = -INFINITY;
    const float pm0 = fmaxf(mprevl, u0), pm1 = mincl;
    float* GB = (float*)(F.ws + WS_GATES + GO_B) + (size_t)dh * S; float* GU = (float*)(F.ws + WS_GATES + GO_U) + (size_t)dh * S; float* GPM = (float*)(F.ws + WS_GATES + GO_PM) + (size_t)dh * S;
    GB[t0] = b0; GB[t1] = b1; GU[t0] = u0; GU[t1] = u1; GPM[t0] = pm0; GPM[t1] = pm1;
    if (lane == 63) { ((float*)(F.ws + WS_GATES + GO_G))[dh * 128 + c] = b1; ((float*)(F.ws + WS_GATES + GO_PML))[dh * 128 + c] = pm1; }
}
__device__ __forceinline__ void ph_post(const Frame& F) {
    const int gw = F.vcu * NWAVES + F.wave, NGW = F.G * NWAVES;
    for (int it = gw; it < 1024; it += NGW) p2_gate_item(F, it);
    for (int it = gw; it < 4096; it += NGW) p2_conv_item(F, it);
    for (int t = gw; t < S; t += NGW) p2_qkv_token(F, t);
}

#define MFMA16(a, b, c) __builtin_amdgcn_mfma_f32_16x16x32_bf16((a), (b), (c), 0, 0, 0)
__device__ __forceinline__ bf16x8 frag_tr(LAS const unsigned char* base, int pitch, int k0, int x0, int lane) {
    const int g = lane >> 4, i = lane & 15;
    LAS const unsigned char* p = base + (k0 + 8 * g + (i >> 2)) * pitch + (x0 + 4 * (i & 3)) * 2;
    const s16x4 lo = __builtin_bit_cast(s16x4, __builtin_amdgcn_ds_read_tr16_b64_v4i16((LAS v4i16_t*)p));
    const s16x4 hi = __builtin_bit_cast(s16x4, __builtin_amdgcn_ds_read_tr16_b64_v4i16((LAS v4i16_t*)(p + 4 * pitch)));
    return (bf16x8){lo[0], lo[1], lo[2], lo[3], hi[0], hi[1], hi[2], hi[3]};
}
__device__ __forceinline__ bf16x8 frag_kc(LAS const unsigned char* base, int pitch, int x0, int k0, int lane) {
    return *(LAS const bf16x8*)(base + (x0 + (lane & 15)) * pitch + (k0 + 8 * (lane >> 4)) * 2);
}

constexpr int MLA_PK = 544, MLA_PV = 288;
constexpr int MLA_OFF_V = 128 * MLA_PK;
__device__ __forceinline__ void ph_mla(const Frame& F) {
    const int tid = F.tid, lane = F.lane, wave = F.wave;
    LAS unsigned char* Kw = F.lds; LAS unsigned char* Vs = F.lds + MLA_OFF_V;
    const float* GU = (const float*)(F.ws + WS_GATES + GO_U); const float* GPML = (const float*)(F.ws + WS_GATES + GO_PML);
    for (int item = F.vcu; item < 2048; item += F.G) {
        const int hv = item & 1, c = (item >> 1) & 127, dh = item >> 8, dir = dh >> 2, head = dh & 3;
        const int tc = dir ? 127 - c : c, t0 = tc * 128;
        const float pml = GPML[dh * 128 + c];
        {   const bf16_t* mk = WSP(bf16_t, WS_MK) + (size_t)t0 * 1024 + head * 256;
#pragma unroll
            for (int j = 0; j < 8; ++j) { const int r = (tid >> 5) + 16 * j, c8 = (tid & 31) * 8;
                const u32x4 x = *(const u32x4*)(mk + (size_t)r * 1024 + c8); const float w = __expf(GU[(size_t)dh * S + t0 + r] - pml);
                u32x4 o; o.x = pk2(bflo(x.x) * w, bfhi(x.x) * w); o.y = pk2(bflo(x.y) * w, bfhi(x.y) * w); o.z = pk2(bflo(x.z) * w, bfhi(x.z) * w); o.w = pk2(bflo(x.w) * w, bfhi(x.w) * w);
                *(LAS u32x4*)(Kw + r * MLA_PK + c8 * 2) = o; }
            const bf16_t* mv = WSP(bf16_t, WS_PROJ) + (size_t)t0 * INP + C_MV + head * 256 + hv * 128;
#pragma unroll
            for (int j = 0; j < 4; ++j) { const int r = (tid >> 4) + 32 * j, c8 = (tid & 15) * 8;
                *(LAS u32x4*)(Vs + r * MLA_PV + c8 * 2) = *(const u32x4*)(mv + (size_t)r * INP + c8); }
        }
        __syncthreads();
        f32x4 acc[4][4];
#pragma unroll
        for (int a = 0; a < 4; ++a)
#pragma unroll
            for (int b = 0; b < 4; ++b) acc[a][b] = (f32x4){0.f, 0.f, 0.f, 0.f};
        const int mb = (wave & 3) * 64, nb = (wave >> 2) * 64;
#pragma unroll
        for (int ks = 0; ks < 4; ++ks) {
            bf16x8 af[4], bfr[4];
#pragma unroll
            for (int a = 0; a < 4; ++a) af[a] = frag_tr(Kw, MLA_PK, 32 * ks, mb + 16 * a, lane);
#pragma unroll
            for (int b = 0; b < 4; ++b) bfr[b] = frag_tr(Vs, MLA_PV, 32 * ks, nb + 16 * b, lane);
#pragma unroll
            for (int a = 0; a < 4; ++a)
#pragma unroll
                for (int b = 0; b < 4; ++b) acc[a][b] = MFMA16(af[a], bfr[b], acc[a][b]);
        }
        {   bf16_t* cst = WSP(bf16_t, WS_CST) + ((size_t)(dh * 128 + c) << 16);
            const int g = lane >> 4, i = lane & 15;
#pragma unroll
            for (int a = 0; a < 4; ++a)
#pragma unroll
                for (int b = 0; b < 4; ++b) { u32x2 o; o.x = pk2(acc[a][b][0], acc[a][b][1]); o.y = pk2(acc[a][b][2], acc[a][b][3]);
                    *(u32x2*)(cst + (size_t)(hv * 128 + nb + 16 * b + i) * 256 + mb + 16 * a + 4 * g) = o; }
        }
        if (hv == 0 && tid < 256) { float s = 0.f;
#pragma unroll 8
            for (int r = 0; r < 128; ++r) s += bflo((unsigned)*(LAS const bf16_t*)(Kw + r * MLA_PK + tid * 2));
            ((float*)(F.ws + WS_NST))[(size_t)(dh * 128 + c) * 256 + tid] = s; }
        __syncthreads();
    }
}

__device__ __forceinline__ void ph_scan(const Frame& F) {
    const float* GG = (const float*)(F.ws + WS_GATES + GO_G); const float* GPML = (const float*)(F.ws + WS_GATES + GO_PML); float* MPREV = (float*)(F.ws + WS_GATES + GO_MPREV);
    const int nthreads = F.G * NTHR;
    for (int gi = F.vcu * NTHR + F.tid; gi < 8 * 16384; gi += nthreads) {
        const int dh = gi >> 14, e4 = gi & 16383;
        bf16_t* base = WSP(bf16_t, WS_CST) + ((size_t)dh * 128 << 16) + e4 * 4;
        float st0 = 0.f, st1 = 0.f, st2 = 0.f, st3 = 0.f, m = 0.f;
#pragma unroll 1
        for (int c0 = 0; c0 < 128; c0 += 32) {
            u32x2 ld[32];
#pragma unroll
            for (int q = 0; q < 32; ++q) ld[q] = *(const u32x2*)(base + ((size_t)(c0 + q) << 16));
#pragma unroll
            for (int q = 0; q < 32; ++q) { const int c = c0 + q;
                const float g = GG[dh * 128 + c], amax = g + GPML[dh * 128 + c];
                const float mn = fmaxf(g + m, amax), dec = __expf(g + m - mn), add = __expf(amax - mn);
                if (e4 == 0) MPREV[dh * 128 + c] = m;
                u32x2 o; o.x = pk2(st0, st1); o.y = pk2(st2, st3);
                *(u32x2*)(base + ((size_t)c << 16)) = o;
                st0 = dec * st0 + add * bflo(ld[q].x); st1 = dec * st1 + add * bfhi(ld[q].x); st2 = dec * st2 + add * bflo(ld[q].y); st3 = dec * st3 + add * bfhi(ld[q].y);
                m = mn; }
        }
    }
    for (int gi = F.vcu * NTHR + F.tid; gi < 8 * 256; gi += nthreads) {
        const int dh = gi >> 8, e = gi & 255;
        float* base = (float*)(F.ws + WS_NST) + (size_t)dh * 128 * 256 + e;
        float st = 0.f, m = 0.f;
#pragma unroll 4
        for (int c = 0; c < 128; ++c) {
            const float g = GG[dh * 128 + c], amax = g + GPML[dh * 128 + c];
            const float mn = fmaxf(g + m, amax), dec = __expf(g + m - mn), add = __expf(amax - mn);
            const float ld = base[c * 256]; base[c * 256] = st; st = dec * st + add * ld; m = mn; }
    }
}

constexpr int MLB_PIECE = 34816;
constexpr int MLB_PKC = 528, MLB_PTR = 544, MLB_PP = 272;
constexpr int MLB_OFF_P = 2 * MLB_PIECE;
constexpr int MLB_OFF_N = MLB_OFF_P + 2 * 8 * 16 * MLB_PP;
static_assert(MLB_OFF_N + 2048 <= LDSCTL_OFF, "mLSTM-B LDS map");
__device__ __forceinline__ void ph_mlb(const Frame& F) {
    const int wave = F.wave;
    const float* GB = (const float*)(F.ws + WS_GATES + GO_B); const float* GU = (const float*)(F.ws + WS_GATES + GO_U); const float* GPM = (const float*)(F.ws + WS_GATES + GO_PM);
    const float* MPREV = (const float*)(F.ws + WS_GATES + GO_MPREV);
    LAS unsigned char* buf0 = F.lds; LAS unsigned char* buf1 = F.lds + MLB_PIECE;
    LAS float* nprev = (LAS float*)(F.lds + MLB_OFF_N);
    for (int unit = F.vcu; unit < 512; unit += F.G) {
        int tid = F.tid; asm volatile("" : "+v"(tid));
        const int lane = tid & 63, g = lane >> 4, i = lane & 15;
        const int head = unit >> 7, tc = unit & 127, t0 = tc * 128, j0 = 16 * wave;
        const bf16_t* mkp = WSP(bf16_t, WS_MK) + (size_t)t0 * 1024 + head * 256;
        const bf16_t* mvp = WSP(bf16_t, WS_PROJ) + (size_t)t0 * INP + C_MV + head * 256;
        const int c_f = tc, c_b = 127 - tc;
        u32x4 stg[4];
        const int sr = tid >> 5, sc8 = (tid & 31) * 8;
#define PIECE_LOAD(srcp, pitch_el) do { _Pragma("unroll") for (int q_ = 0; q_ < 4; ++q_) stg[q_] = *(const u32x4*)((srcp) + (size_t)(sr + 16 * q_) * (pitch_el) + sc8); } while (0)
#define PIECE_WRITE(dstbuf, pitchB) do { _Pragma("unroll") for (int q_ = 0; q_ < 4; ++q_) *(LAS u32x4*)((dstbuf) + (sr + 16 * q_) * (pitchB) + sc8 * 2) = stg[q_]; } while (0)
        { const int d = tid >> 8, e = tid & 255; nprev[d * 256 + e] = ((const float*)(F.ws + WS_NST))[(size_t)((d * 4 + head) * 128 + (d ? c_b : c_f)) * 256 + e]; }
        bf16x8 qa[8];
        {   const bf16_t* mq = WSP(bf16_t, WS_MQ) + (size_t)(t0 + j0 + i) * 1024 + head * 256 + 8 * g;
#pragma unroll
            for (int s = 0; s < 8; ++s) qa[s] = *(const bf16x8*)(mq + 32 * s); }
        f32x4 sacc[8];
#pragma unroll
        for (int n = 0; n < 8; ++n) sacc[n] = (f32x4){0.f, 0.f, 0.f, 0.f};
        PIECE_LOAD(mkp, 1024); PIECE_WRITE(buf0, MLB_PKC);
        PIECE_LOAD(mkp + (size_t)64 * 1024, 1024);
        __syncthreads();
#pragma unroll
        for (int n = 0; n < 4; ++n)
            { _Pragma("unroll") for (int s = 0; s < 8; ++s) sacc[n] = MFMA16(qa[s], frag_kc(buf0, MLB_PKC, 16 * n, 32 * s, lane), sacc[n]); __builtin_amdgcn_sched_barrier(0); }
        PIECE_WRITE(buf1, MLB_PKC);
        __syncthreads();
#pragma unroll
        for (int n = 0; n < 4; ++n)
            { _Pragma("unroll") for (int s = 0; s < 8; ++s) sacc[4 + n] = MFMA16(qa[s], frag_kc(buf1, MLB_PKC, 16 * n, 32 * s, lane), sacc[4 + n]); __builtin_amdgcn_sched_barrier(0); }
        const bf16_t* cst0 = WSP(bf16_t, WS_CST) + ((size_t)((0 * 4 + head) * 128 + c_f) << 16);
        const bf16_t* cst1 = WSP(bf16_t, WS_CST) + ((size_t)((1 * 4 + head) * 128 + c_b) << 16);
        PIECE_LOAD(cst0, 256);
        float qsc0, qsc1;
#pragma unroll
        for (int d = 0; d < 2; ++d) {
            const int dh = d * 4 + head; const float mp = MPREV[dh * 128 + (d ? c_b : c_f)];
            f32x4 dacc = (f32x4){0.f, 0.f, 0.f, 0.f};
#pragma unroll
            for (int s = 0; s < 8; ++s) { bf16x8 bn; const LAS float* np = nprev + d * 256 + 32 * s + 8 * g;
#pragma unroll
                for (int e = 0; e < 8; ++e) bn[e] = (i == 0) ? (short)f2bf(np[e]) : (short)0;
                dacc = MFMA16(qa[s], bn, dacc); }
            float ur[8];
#pragma unroll
            for (int n = 0; n < 8; ++n) ur[n] = GU[(size_t)dh * S + t0 + 16 * n + i];
            LAS unsigned char* pw = F.lds + MLB_OFF_P + (d * 8 + wave) * (16 * MLB_PP);
            float es[4];
#pragma unroll
            for (int rg = 0; rg < 4; ++rg) { const int jl = 4 * g + rg, j = j0 + jl;
                const float M = fmaxf(mp, GPM[(size_t)dh * S + t0 + j]), ej = __expf(mp - M), mj = GB[(size_t)dh * S + t0 + j] + M;
                float rs = 0.f;
#pragma unroll
                for (int n = 0; n < 8; ++n) { const int r = 16 * n + i; const bool keep = d ? (r >= j) : (r <= j); rs += keep ? sacc[n][rg] * __expf(ur[n] - M) : 0.f; }
                rs += __shfl_xor(rs, 1); rs += __shfl_xor(rs, 2); rs += __shfl_xor(rs, 4); rs += __shfl_xor(rs, 8);
                const float qn = __shfl(dacc[rg], lane & 48);
                const float den = ej * qn + rs, sj = 1.0f / fmaxf(fabsf(den), __expf(-mj));
                es[rg] = ej * sj;
#pragma unroll
                for (int n = 0; n < 8; ++n) { const int r = 16 * n + i; const bool keep = d ? (r >= j) : (r <= j);
                    const float p = keep ? sacc[n][rg] * __expf(ur[n] - M) * sj : 0.f;
                    *(LAS bf16_t*)(pw + jl * MLB_PP + r * 2) = (bf16_t)f2bf(p); } }
            const int srcl = (i >> 2) << 4;
            const float t0_ = __shfl(es[0], srcl), t1_ = __shfl(es[1], srcl), t2_ = __shfl(es[2], srcl), t3_ = __shfl(es[3], srcl);
            const float qs_ = (i & 3) == 0 ? t0_ : (i & 3) == 1 ? t1_ : (i & 3) == 2 ? t2_ : t3_;
            if (d == 0) qsc0 = qs_; else qsc1 = qs_;
        }
        __syncthreads();
        f32x4 hacc[16];
#pragma unroll
        for (int n = 0; n < 16; ++n) hacc[n] = (f32x4){0.f, 0.f, 0.f, 0.f};
#pragma unroll
        for (int d = 0; d < 2; ++d) {
            const bf16_t* cst = d ? cst1 : cst0; const float qsc = d ? qsc1 : qsc0;
            bf16x8 qs[8];
#pragma unroll
            for (int s = 0; s < 8; ++s) { const u32x4 w = __builtin_bit_cast(u32x4, qa[s]); u32x4 o;
                o.x = pk2(bflo(w.x) * qsc, bfhi(w.x) * qsc); o.y = pk2(bflo(w.y) * qsc, bfhi(w.y) * qsc); o.z = pk2(bflo(w.z) * qsc, bfhi(w.z) * qsc); o.w = pk2(bflo(w.w) * qsc, bfhi(w.w) * qsc);
                qs[s] = __builtin_bit_cast(bf16x8, o); }
#pragma unroll
            for (int cp = 0; cp < 4; ++cp) {
                LAS unsigned char* cur = (cp & 1) ? buf1 : buf0;
                PIECE_WRITE(cur, MLB_PKC);
                if (cp < 3) PIECE_LOAD(cst + (size_t)(64 * (cp + 1)) * 256, 256); else PIECE_LOAD(mvp, INP);
                __syncthreads();
#pragma unroll
                for (int n = 0; n < 4; ++n)
                    { _Pragma("unroll") for (int s = 0; s < 8; ++s) hacc[4 * cp + n] = MFMA16(qs[s], frag_kc(cur, MLB_PKC, 16 * n, 32 * s, lane), hacc[4 * cp + n]); __builtin_amdgcn_sched_barrier(0); }
            }
            LAS const unsigned char* pw = F.lds + MLB_OFF_P + (d * 8 + wave) * (16 * MLB_PP);
#pragma unroll
            for (int vp = 0; vp < 2; ++vp) {
                LAS unsigned char* cur = (vp & 1) ? buf1 : buf0;
                PIECE_WRITE(cur, MLB_PTR);
                if (vp == 0) PIECE_LOAD(mvp + (size_t)64 * INP, INP); else if (d == 0) PIECE_LOAD(cst1, 256);
                __syncthreads();
#pragma unroll
                for (int ks = 0; ks < 2; ++ks) { const bf16x8 a = *(LAS const bf16x8*)(pw + i * MLB_PP + (64 * vp + 32 * ks + 8 * g) * 2);
#pragma unroll
                    for (int n = 0; n < 16; ++n) { hacc[n] = MFMA16(a, frag_tr(cur, MLB_PTR, 32 * ks, 16 * n, lane), hacc[n]); if ((n & 3) == 3) __builtin_amdgcn_sched_barrier(0); } }
            }
            __syncthreads();
        }
        {   const float* mg = FIN(8) + head * 256;
            const bf16_t* mo = WSP(bf16_t, WS_PROJ) + C_MO + head * 256; bf16_t* y = WSP(bf16_t, WS_Y) + 1024 + head * 256;
#pragma unroll
            for (int rg = 0; rg < 4; ++rg) { float ss = 0.f;
#pragma unroll
                for (int n = 0; n < 16; ++n) ss += hacc[n][rg] * hacc[n][rg];
                ss += __shfl_xor(ss, 1); ss += __shfl_xor(ss, 2); ss += __shfl_xor(ss, 4); ss += __shfl_xor(ss, 8);
                const float r = 1.0f / sqrtf(ss * (1.f / 256.f) + EPS); const size_t t = (size_t)(t0 + j0 + 4 * g + rg);
#pragma unroll
                for (int n = 0; n < 16; ++n) { const int col = 16 * n + i; const float o = bflo((unsigned)mo[t * INP + col]);
                    #if defined(DBG_ZERO_ML)
                    y[t * DM + col] = 0;
#else
                    y[t * DM + col] = (bf16_t)f2bf(hacc[n][rg] * r * mg[col] * (1.f / (1.f + __expf(-o))));
#endif
                    } }
        }
#undef PIECE_LOAD
#undef PIECE_WRITE
    }
}

#define MFMA32(a, b, c) __builtin_amdgcn_mfma_f32_32x32x16_bf16((a), (b), (c), 0, 0, 0)
__device__ __forceinline__ int fkey(float x) { const int b = __builtin_bit_cast(int, x); return b ^ ((b >> 31) & 0x7fffffff); }
__device__ __forceinline__ float kval(int k) { return __builtin_bit_cast(float, k ^ ((k >> 31) & 0x7fffffff)); }
#define CE_(a, i, j) { const int hi_ = max(a[i], a[j]); a[j] = min(a[i], a[j]); a[i] = hi_; }
#define SORT16(a) do { CE_(a,0,13) CE_(a,1,12) CE_(a,2,15) CE_(a,3,14) CE_(a,4,8) CE_(a,5,6) CE_(a,7,11) CE_(a,9,10) CE_(a,0,5) CE_(a,1,7) CE_(a,2,9) CE_(a,3,4) CE_(a,6,13) CE_(a,8,14) CE_(a,10,15) CE_(a,11,12) CE_(a,0,1) CE_(a,2,3) CE_(a,4,5) CE_(a,6,8) CE_(a,7,9) CE_(a,10,11) CE_(a,12,13) CE_(a,14,15) CE_(a,0,2) CE_(a,1,3) CE_(a,4,10) CE_(a,5,11) CE_(a,6,7) CE_(a,8,9) CE_(a,12,14) CE_(a,13,15) CE_(a,1,2) CE_(a,3,12) CE_(a,4,6) CE_(a,5,7) CE_(a,8,10) CE_(a,9,11) CE_(a,13,14) CE_(a,1,4) CE_(a,2,6) CE_(a,5,8) CE_(a,7,10) CE_(a,9,13) CE_(a,11,14) CE_(a,2,4) CE_(a,3,6) CE_(a,9,12) CE_(a,11,13) CE_(a,3,5) CE_(a,6,8) CE_(a,7,9) CE_(a,10,12) CE_(a,3,4) CE_(a,5,6) CE_(a,7,8) CE_(a,9,10) CE_(a,11,12) CE_(a,6,7) CE_(a,8,9) } while (0)
#define MERGE16(a, b) do { _Pragma("unroll") for (int k_ = 0; k_ < 16; ++k_) a[k_] = max(a[k_], b[15 - k_]); CE_(a,0,8) CE_(a,1,9) CE_(a,2,10) CE_(a,3,11) CE_(a,4,12) CE_(a,5,13) CE_(a,6,14) CE_(a,7,15) CE_(a,0,4) CE_(a,1,5) CE_(a,2,6) CE_(a,3,7) CE_(a,8,12) CE_(a,9,13) CE_(a,10,14) CE_(a,11,15) CE_(a,0,2) CE_(a,1,3) CE_(a,4,6) CE_(a,5,7) CE_(a,8,10) CE_(a,9,11) CE_(a,12,14) CE_(a,13,15) CE_(a,0,1) CE_(a,2,3) CE_(a,4,5) CE_(a,6,7) CE_(a,8,9) CE_(a,10,11) CE_(a,12,13) CE_(a,14,15) } while (0)
#define TOP_INS(top, x) do { int x_ = (x); _Pragma("unroll") for (int k_ = 0; k_ < 16; ++k_) { const int hi_ = max(top[k_], x_); x_ = min(top[k_], x_); top[k_] = hi_; } } while (0)
__device__ __forceinline__ int pick4(int sel, int a, int b, int c, int d) { return sel == 0 ? a : sel == 1 ? b : sel == 2 ? c : d; }
__device__ __forceinline__ void topk_item(const Frame& F, int layer, int item) {
    const int tile = item >> 3, h = item & 7, lane = F.lane, r32 = lane & 31, hi = lane >> 5;
    const int t = tile * 32 + r32;
    const bf16_t* qrow = WSP(bf16_t, WS_QP) + (size_t)t * DM + h * 256 + 8 * hi;
    int tops[2][16];
#pragma unroll
    for (int p = 0; p < 2; ++p) {
        const bf16_t* keys = WSP(bf16_t, WS_KEYS) + (size_t)(((layer * 8 + h) * 2 + p) * 128) * 128 + 8 * hi;
        bf16x8 bq[8];
#pragma unroll
        for (int s = 0; s < 8; ++s) bq[s] = *(const bf16x8*)(qrow + p * 128 + 16 * s);
        int top[16];
#pragma unroll
        for (int kt = 0; kt < 4; ++kt) {
            f32x16 acc = {};
#pragma unroll
            for (int s = 0; s < 8; ++s) { const bf16x8 a = *(const bf16x8*)(keys + (size_t)(32 * kt + r32) * 128 + 16 * s); acc = MFMA32(a, bq[s], acc); }
            int vals[16];
#pragma unroll
            for (int r = 0; r < 16; ++r) { const int idx = 32 * kt + (r & 3) + 8 * (r >> 2) + 4 * hi; vals[r] = (fkey(acc[r]) & ~127) | idx; }
            SORT16(vals);
            if (kt == 0) {
#pragma unroll
                for (int k = 0; k < 16; ++k) top[k] = vals[k]; }
            else MERGE16(top, vals);
        }
        int pt[16];
#pragma unroll
        for (int k = 0; k < 16; ++k) pt[k] = __shfl_xor(top[k], 32);
        MERGE16(top, pt);
#pragma unroll
        for (int k = 0; k < 16; ++k) tops[p][k] = top[k];
    }
    float af[16], bfv[16];
#pragma unroll
    for (int k = 0; k < 16; ++k) { af[k] = kval(tops[0][k] & ~127); bfv[k] = kval(tops[1][k] & ~127); }
#define CKEY(i, j) ((fkey(af[i] + bfv[j]) & ~255) | (255 - (((i) << 4) | (j))))
    int top2[16], aux[16];
#pragma unroll
    for (int j = 0; j < 16; ++j) top2[j] = CKEY(0, j);
#pragma unroll
    for (int j = 0; j < 16; ++j) aux[j] = j < 8 ? CKEY(1, j) : (int)0x80000000;
    MERGE16(top2, aux);
#pragma unroll
    for (int j = 0; j < 16; ++j) aux[j] = j < 8 ? CKEY(8 + j, 0) : (int)0x80000000;
    MERGE16(top2, aux);
    aux[0] = CKEY(2, 0); aux[1] = CKEY(2, 1); aux[2] = CKEY(2, 2); aux[3] = CKEY(2, 3); aux[4] = CKEY(2, 4); aux[5] = CKEY(3, 0); aux[6] = CKEY(3, 1); aux[7] = CKEY(3, 2);
    aux[8] = CKEY(3, 3); aux[9] = CKEY(4, 0); aux[10] = CKEY(4, 1); aux[11] = CKEY(4, 2); aux[12] = CKEY(5, 0); aux[13] = CKEY(5, 1); aux[14] = CKEY(6, 0); aux[15] = CKEY(6, 1);
    SORT16(aux); MERGE16(top2, aux);
    TOP_INS(top2, CKEY(7, 0)); TOP_INS(top2, CKEY(7, 1));
#undef CKEY
    int pa[4], pb[4];
#pragma unroll
    for (int q = 0; q < 4; ++q) { pa[q] = (tops[0][4 * q] & 127) | ((tops[0][4 * q + 1] & 127) << 8) | ((tops[0][4 * q + 2] & 127) << 16) | ((tops[0][4 * q + 3] & 127) << 24);
                                  pb[q] = (tops[1][4 * q] & 127) | ((tops[1][4 * q + 1] & 127) << 8) | ((tops[1][4 * q + 2] & 127) << 16) | ((tops[1][4 * q + 3] & 127) << 24); }
    int ex[16]; float sc[16];
#pragma unroll
    for (int k = 0; k < 16; ++k) { const int code = 255 - (top2[k] & 255), ii = code >> 4, jj = code & 15;
        const int ea = (pick4(ii >> 2, pa[0], pa[1], pa[2], pa[3]) >> ((ii & 3) * 8)) & 127, eb = (pick4(jj >> 2, pb[0], pb[1], pb[2], pb[3]) >> ((jj & 3) * 8)) & 127;
        ex[k] = ea * 128 + eb; sc[k] = kval(top2[k] & ~255); }
    const float mx = sc[0]; float sum = 0.f;
#pragma unroll
    for (int k = 0; k < 16; ++k) { sc[k] = __expf(sc[k] - mx); sum += sc[k]; }
    const float inv = 1.0f / sum;
    if (hi == 0) { int* d = WSP(int, WS_EIDX) + (size_t)t * 128 + h * 16;
#pragma unroll
        for (int q = 0; q < 4; ++q) *(u32x4*)(d + 4 * q) = (u32x4){(unsigned)ex[4 * q], (unsigned)ex[4 * q + 1], (unsigned)ex[4 * q + 2], (unsigned)ex[4 * q + 3]}; }
    else { float* d = WSP(float, WS_EGATE) + (size_t)t * 128 + h * 16;
#pragma unroll
        for (int q = 0; q < 4; ++q) *(f32x4*)(d + 4 * q) = (f32x4){sc[4 * q] * inv, sc[4 * q + 1] * inv, sc[4 * q + 2] * inv, sc[4 * q + 3] * inv}; }
}
constexpr size_t WS_XH = WS_QB, WS_XL = WS_QB + 16 * MiB;
__device__ __forceinline__ void xq_item(const Frame& F, int layer, int t) {
    const int lane = F.lane;
    const float rs = rstd_of(((const unsigned long long*)(F.ws + WS_CTL + CTL_SSQ))[(layer ? 2 : 0) * S + t]) * 16.f;
    const bf16_t* xr = WSP(bf16_t, WS_XN) + (size_t)t * DM + lane * 32;
    unsigned hw[4], lw[4];
#pragma unroll
    for (int d = 0; d < 4; ++d) { const u32x4 x = *(const u32x4*)(xr + 8 * d); const unsigned ww[4] = {x.x, x.y, x.z, x.w}; unsigned h = 0u, l = 0u;
#pragma unroll
        for (int e = 0; e < 8; ++e) { const float f = ((e & 1) ? bfhi(ww[e >> 1]) : bflo(ww[e >> 1])) * rs;
            const int x8 = (int)fminf(fmaxf(rintf(f), -119.f), 119.f), hi = (x8 + 8) >> 4, lo = x8 - 16 * hi;
            h |= (unsigned)(hi & 15) << (4 * e); l |= (unsigned)(lo & 15) << (4 * e); }
        hw[d] = h; lw[d] = l; }
    *(u32x4*)(F.ws + WS_XH + (size_t)t * 1024 + lane * 16) = (u32x4){hw[0], hw[1], hw[2], hw[3]};
    *(u32x4*)(F.ws + WS_XL + (size_t)t * 1024 + lane * 16) = (u32x4){lw[0], lw[1], lw[2], lw[3]};
}
__device__ __forceinline__ void ph_topk(const Frame& F, int layer) {
    const int gw = F.vcu * NWAVES + F.wave, NGW = F.G * NWAVES;
    for (int it = gw; it < 4096; it += NGW) topk_item(F, layer, it);
    for (int t = gw; t < S; t += NGW) xq_item(F, layer, t);
}

typedef __bf16 bf2 __attribute__((ext_vector_type(2)));
__device__ __forceinline__ float dot2bf(bf2 a, unsigned b, float c) { return __builtin_amdgcn_fdot2_f32_bf16(a, __builtin_bit_cast(bf2, b), c, false); }
__device__ __forceinline__ float dot4_fp8(unsigned w, unsigned xlo, unsigned xhi, float c) {
    c = dot2bf(__builtin_amdgcn_cvt_scalef32_pk_bf16_fp8(w, 1.0f, false), xlo, c);
    return dot2bf(__builtin_amdgcn_cvt_scalef32_pk_bf16_fp8(w, 1.0f, true), xhi, c);
}
#if TBL_FP4
constexpr int NSL = 8;
constexpr size_t WS_PART = WS_CST;
constexpr size_t WS_W = WS_KVB;
__device__ __forceinline__ float dot8_fp4(unsigned w, u32x4 x, float c) {
    c = dot2bf(__builtin_amdgcn_cvt_scalef32_pk_bf16_fp4(w, 1.0f, 0), x.x, c); c = dot2bf(__builtin_amdgcn_cvt_scalef32_pk_bf16_fp4(w, 1.0f, 1), x.y, c);
    c = dot2bf(__builtin_amdgcn_cvt_scalef32_pk_bf16_fp4(w, 1.0f, 2), x.z, c); return dot2bf(__builtin_amdgcn_cvt_scalef32_pk_bf16_fp4(w, 1.0f, 3), x.w, c);
}
__device__ __forceinline__ void ph_gu(const Frame& F, int layer) {
    const int lane = F.lane, r8 = lane >> 3, c16 = lane & 7;
    const int nper = F.G >> 3, xl = F.vcu / nper, wx = (F.vcu % nper) * NWAVES + F.wave, nwx = nper * NWAVES;
    const int s = xl;
    const unsigned char* Us = F.ws + WS_UB + (size_t)layer * (16384 * 1024) + (size_t)s * (16384 * 128);
    const unsigned char* eb = F.ws + WS_EIDX; unsigned char* pb = F.ws + WS_PART + (size_t)s * S * 512; const unsigned char* xhb = F.ws + WS_XH + s * 128; const unsigned char* xlb = F.ws + WS_XL + s * 128;
    const unsigned eo = 64u * r8, po = 8u * lane, xo = 16u * c16, uo = 16u * c16;
#define LDU(T, base, off) (*(const T*)((base) + (unsigned)(off)))
    u32x4 ia[2][4];
#pragma unroll
    for (int q = 0; q < 4; ++q) { ia[0][q] = LDU(u32x4, eb, (unsigned)wx * 512u + eo + 16u * q); ia[1][q] = LDU(u32x4, eb, (unsigned)(wx + nwx) * 512u + eo + 16u * q); }
#pragma unroll 1
    for (int t = wx; t < S; t += 2 * nwx) {
        const int t1 = t + nwx;
        u32x4 ur[2][16];
#pragma unroll
        for (int z = 0; z < 2; ++z)
#pragma unroll
            for (int q = 0; q < 16; ++q) { const unsigned id = ia[z][q >> 2][q & 3]; ur[z][q] = LDU(u32x4, Us, id * 128u + uo); }
        { const int tn = (t + 2 * nwx < S) ? t + 2 * nwx : t;
#pragma unroll
          for (int q = 0; q < 4; ++q) { ia[0][q] = LDU(u32x4, eb, (unsigned)tn * 512u + eo + 16u * q); ia[1][q] = LDU(u32x4, eb, (unsigned)(tn + nwx) * 512u + eo + 16u * q); } }
#pragma unroll
        for (int z = 0; z < 2; ++z) {
            const unsigned xoff = (unsigned)(z ? t1 : t) * 1024u + xo; const u32x4 xh = LDU(u32x4, xhb, xoff), xl = LDU(u32x4, xlb, xoff);
            float v[16];
#pragma unroll
            for (int q = 0; q < 16; ++q) { const u32x4 w = ur[z][q]; int ah = 0, al = 0;
                ah = __builtin_amdgcn_sdot8((int)w.x, (int)xh.x, ah, false); al = __builtin_amdgcn_sdot8((int)w.x, (int)xl.x, al, false);
                ah = __builtin_amdgcn_sdot8((int)w.y, (int)xh.y, ah, false); al = __builtin_amdgcn_sdot8((int)w.y, (int)xl.y, al, false);
                ah = __builtin_amdgcn_sdot8((int)w.z, (int)xh.z, ah, false); al = __builtin_amdgcn_sdot8((int)w.z, (int)xl.z, al, false);
                ah = __builtin_amdgcn_sdot8((int)w.w, (int)xh.w, ah, false); al = __builtin_amdgcn_sdot8((int)w.w, (int)xl.w, al, false);
                v[q] = (float)(16 * ah + al); }
            float r8v[8], r4v[4], r2v[2];
            { const bool up = lane & 4;
#pragma unroll
              for (int q = 0; q < 8; ++q) { const float keep = up ? v[q + 8] : v[q], give = up ? v[q] : v[q + 8]; r8v[q] = keep + __shfl_xor(give, 4); } }
            { const bool up = lane & 2;
#pragma unroll
              for (int q = 0; q < 4; ++q) { const float keep = up ? r8v[q + 4] : r8v[q], give = up ? r8v[q] : r8v[q + 4]; r4v[q] = keep + __shfl_xor(give, 2); } }
            { const bool up = lane & 1;
#pragma unroll
              for (int q = 0; q < 2; ++q) { const float keep = up ? r4v[q + 2] : r4v[q], give = up ? r4v[q] : r4v[q + 2]; r2v[q] = keep + __shfl_xor(give, 1); } }
            *(f32x2*)(pb + ((unsigned)(z ? t1 : t) * 512u + po)) = (f32x2){r2v[0], r2v[1]};
        }
    }
}
__device__ __forceinline__ void ph_act(const Frame& F, int layer) {
    const int lane = F.lane, gw = F.vcu * NWAVES + F.wave, NGW = F.G * NWAVES;
    const float* su = (const float*)(F.ws + WS_TSC) + layer * 16384; const float* sv = su + 32768;
    for (int t = gw; t < S; t += NGW) {
        const float* part = WSP(float, WS_PART) + (size_t)t * 128 + 2 * lane;
        f32x2 a = {0.f, 0.f};
#pragma unroll
        for (int s = 0; s < NSL; ++s) a += *(const f32x2*)(part + (size_t)s * S * 128);
        const u32x2 id = *(const u32x2*)(WSP(int, WS_EIDX) + (size_t)t * 128 + 2 * lane); const f32x2 g = *(const f32x2*)(WSP(float, WS_EGATE) + (size_t)t * 128 + 2 * lane);
        const float a0 = a.x * su[id.x] * (1.f / 16.f), a1 = a.y * su[id.y] * (1.f / 16.f);
        const float w0 = 0.5f * a0 * (1.f + erff(a0 * 0.70710678118654752f)) * g.x * sv[id.x], w1 = 0.5f * a1 * (1.f + erff(a1 * 0.70710678118654752f)) * g.y * sv[id.y];
        *(f32x2*)(WSP(float, WS_W) + (size_t)t * 128 + 2 * lane) = (f32x2){w0, w1};
    }
}
__device__ __forceinline__ void ph_gv(const Frame& F, int layer) {
    const int lane = F.lane, r8 = lane >> 3, c16 = lane & 7;
    const int nper = F.G >> 3, xl = F.vcu / nper, wx = (F.vcu % nper) * NWAVES + F.wave, nwx = nper * NWAVES;
    const int s = xl;
    const unsigned char* Vs = F.ws + WS_VB + (size_t)layer * (16384 * 1024) + (size_t)s * (16384 * 128);
    const unsigned char* eb = F.ws + WS_EIDX; const unsigned char* wb = F.ws + WS_W; unsigned char* hb = F.ws + WS_H + s * 1024;
    const unsigned eo = 64u * r8, ho = 128u * c16 + 16u * r8, vo = 16u * c16;
    u32x4 ia[2][4];
#pragma unroll
    for (int q = 0; q < 4; ++q) { ia[0][q] = LDU(u32x4, eb, (unsigned)wx * 512u + eo + 16u * q); ia[1][q] = LDU(u32x4, eb, (unsigned)(wx + nwx) * 512u + eo + 16u * q); }
#pragma unroll 1
    for (int t = wx; t < S; t += 2 * nwx) {
        const int t1 = t + nwx;
        u32x4 vr[2][16];
#pragma unroll
        for (int z = 0; z < 2; ++z)
#pragma unroll
            for (int q = 0; q < 16; ++q) { const unsigned id = ia[z][q >> 2][q & 3]; vr[z][q] = LDU(u32x4, Vs, id * 128u + vo); }
        { const int tn = (t + 2 * nwx < S) ? t + 2 * nwx : t;
#pragma unroll
          for (int q = 0; q < 4; ++q) { ia[0][q] = LDU(u32x4, eb, (unsigned)tn * 512u + eo + 16u * q); ia[1][q] = LDU(u32x4, eb, (unsigned)(tn + nwx) * 512u + eo + 16u * q); } }
        f32x4 wqa[2][4]; f32x4 hold[2];
#pragma unroll
        for (int z = 0; z < 2; ++z) { const unsigned tt = (unsigned)(z ? t1 : t);
#pragma unroll
            for (int q = 0; q < 4; ++q) wqa[z][q] = LDU(f32x4, wb, tt * 512u + eo + 16u * q);
            hold[z] = LDU(f32x4, hb, tt * 8192u + ho); }
#pragma unroll
        for (int z = 0; z < 2; ++z) {
            const unsigned tt = (unsigned)(z ? t1 : t);
            f32x2 acc[16];
#pragma unroll
            for (int e = 0; e < 16; ++e) acc[e] = (f32x2){0.f, 0.f};
#pragma unroll
            for (int q = 0; q < 16; ++q) { const float w = wqa[z][q >> 2][q & 3]; const f32x2 ww = {w, w}; const unsigned d4[4] = {vr[z][q].x, vr[z][q].y, vr[z][q].z, vr[z][q].w};
#pragma unroll
                for (int e = 0; e < 4; ++e) { acc[4 * e] += ww * __builtin_amdgcn_cvt_scalef32_pk_f32_fp4(d4[e], 1.0f, 0); acc[4 * e + 1] += ww * __builtin_amdgcn_cvt_scalef32_pk_f32_fp4(d4[e], 1.0f, 1);
                    acc[4 * e + 2] += ww * __builtin_amdgcn_cvt_scalef32_pk_f32_fp4(d4[e], 1.0f, 2); acc[4 * e + 3] += ww * __builtin_amdgcn_cvt_scalef32_pk_f32_fp4(d4[e], 1.0f, 3); } }
            f32x2 b8[8], b4[4], b2[2];
            { const bool up = lane & 32;
#pragma unroll
              for (int e = 0; e < 8; ++e) { const f32x2 keep = up ? acc[e + 8] : acc[e], give = up ? acc[e] : acc[e + 8]; b8[e] = keep + (f32x2){__shfl_xor(give.x, 32), __shfl_xor(give.y, 32)}; } }
            { const bool up = lane & 16;
#pragma unroll
              for (int e = 0; e < 4; ++e) { const f32x2 keep = up ? b8[e + 4] : b8[e], give = up ? b8[e] : b8[e + 4]; b4[e] = keep + (f32x2){__shfl_xor(give.x, 16), __shfl_xor(give.y, 16)}; } }
            { const bool up = lane & 8;
#pragma unroll
              for (int e = 0; e < 2; ++e) { const f32x2 keep = up ? b4[e + 2] : b4[e], give = up ? b4[e] : b4[e + 2]; b2[e] = keep + (f32x2){__shfl_xor(give.x, 8), __shfl_xor(give.y, 8)}; } }
#if defined(DBG_ZERO_PEER)
            b2[0] = (f32x2){0.f, 0.f}; b2[1] = b2[0];
#endif
            const f32x4 hn = hold[z] + (f32x4){b2[0].x, b2[0].y, b2[1].x, b2[1].y};
            *(f32x4*)(hb + (tt * 8192u + ho)) = hn;
            if (layer == 0) {
                u32x2 w; w.x = pk2(hn.x, hn.y); w.y = pk2(hn.z, hn.w); *(u32x2*)(F.ws + WS_XN + s * 512 + (tt * 4096u + (ho >> 1))) = w;
                const float sq = wave_sum((hn.x * hn.x + hn.y * hn.y) + (hn.z * hn.z + hn.w * hn.w));
                if (lane == 0) atomicAdd((unsigned long long*)(F.ws + WS_CTL + CTL_SSQ) + S + tt, (unsigned long long)(sq * 1048576.0f)); }
        }
    }
}
#else
constexpr int NSL = 16;
constexpr size_t WS_PART = WS_CST;
constexpr size_t WS_W = WS_KVB;
__device__ __forceinline__ void ph_gu(const Frame& F, int layer) {
    const int lane = F.lane, r8 = lane >> 3, c16 = lane & 7;
    const int nper = F.G >> 3, xl = F.vcu / nper, wx = (F.vcu % nper) * NWAVES + F.wave, nwx = nper * NWAVES;
    const unsigned char* U = F.ws + WS_UB + (size_t)layer * 16384 * 2048 + c16 * 16;
    const int* eidx = WSP(int, WS_EIDX) + 16 * r8;
#pragma unroll 1
    for (int p = 0; p < 2; ++p) {
        const int s = xl + 8 * p;
        const unsigned char* Us = U + (size_t)s * (16384 * 128);
        float* part = WSP(float, WS_PART) + (size_t)s * S * 128 + 2 * lane;
        const bf16_t* xs = WSP(bf16_t, WS_XN) + s * 128 + c16 * 16;
        u32x4 ia[2][4];
#pragma unroll
        for (int q = 0; q < 4; ++q) { ia[0][q] = *(const u32x4*)(eidx + (size_t)wx * 128 + 4 * q); ia[1][q] = *(const u32x4*)(eidx + (size_t)(wx + nwx) * 128 + 4 * q); }
#pragma unroll 1
        for (int t = wx; t < S; t += 2 * nwx) {
            const int t1 = t + nwx;
            u32x4 ur[2][16];
#pragma unroll
            for (int z = 0; z < 2; ++z)
#pragma unroll
                for (int q = 0; q < 16; ++q) { const unsigned id = ia[z][q >> 2][q & 3]; ur[z][q] = *(const u32x4*)(Us + (size_t)id * 128); }
            { const int tn = (t + 2 * nwx < S) ? t + 2 * nwx : t;
#pragma unroll
              for (int q = 0; q < 4; ++q) { ia[0][q] = *(const u32x4*)(eidx + (size_t)tn * 128 + 4 * q); ia[1][q] = *(const u32x4*)(eidx + (size_t)(tn + nwx) * 128 + 4 * q); } }
#pragma unroll
            for (int z = 0; z < 2; ++z) {
                const bf16_t* xr = xs + (size_t)(z ? t1 : t) * DM; const u32x4 x0 = *(const u32x4*)xr, x1 = *(const u32x4*)(xr + 8);
                float v[16];
#pragma unroll
                for (int q = 0; q < 16; ++q) { const u32x4 w = ur[z][q]; float a = dot4_fp8(w.x, x0.x, x0.y, 0.f); a = dot4_fp8(w.y, x0.z, x0.w, a); a = dot4_fp8(w.z, x1.x, x1.y, a); v[q] = dot4_fp8(w.w, x1.z, x1.w, a); }
                float r8v[8], r4v[4], r2v[2];
                { const bool up = lane & 4;
#pragma unroll
                  for (int q = 0; q < 8; ++q) { const float keep = up ? v[q + 8] : v[q], give = up ? v[q] : v[q + 8]; r8v[q] = keep + __shfl_xor(give, 4); } }
                { const bool up = lane & 2;
#pragma unroll
                  for (int q = 0; q < 4; ++q) { const float keep = up ? r8v[q + 4] : r8v[q], give = up ? r8v[q] : r8v[q + 4]; r4v[q] = keep + __shfl_xor(give, 2); } }
                { const bool up = lane & 1;
#pragma unroll
                  for (int q = 0; q < 2; ++q) { const float keep = up ? r4v[q + 2] : r4v[q], give = up ? r4v[q] : r4v[q + 2]; r2v[q] = keep + __shfl_xor(give, 1); } }
                *(f32x2*)(part + (size_t)(z ? t1 : t) * 128) = (f32x2){r2v[0], r2v[1]};
            }
        }
    }
}
__device__ __forceinline__ void ph_act(const Frame& F, int layer) {
    const int lane = F.lane, gw = F.vcu * NWAVES + F.wave, NGW = F.G * NWAVES;
    const float* su = (const float*)(F.ws + WS_TSC) + layer * 16384; const float* sv = su + 32768;
    for (int t = gw; t < S; t += NGW) {
        const float* part = WSP(float, WS_PART) + (size_t)t * 128 + 2 * lane;
        f32x2 a = {0.f, 0.f};
#pragma unroll
        for (int s = 0; s < NSL; ++s) a += *(const f32x2*)(part + (size_t)s * S * 128);
        const u32x2 id = *(const u32x2*)(WSP(int, WS_EIDX) + (size_t)t * 128 + 2 * lane); const f32x2 g = *(const f32x2*)(WSP(float, WS_EGATE) + (size_t)t * 128 + 2 * lane);
        const float a0 = a.x * su[id.x], a1 = a.y * su[id.y];
        const float w0 = 0.5f * a0 * (1.f + erff(a0 * 0.70710678118654752f)) * g.x * sv[id.x], w1 = 0.5f * a1 * (1.f + erff(a1 * 0.70710678118654752f)) * g.y * sv[id.y];
        *(f32x2*)(WSP(float, WS_W) + (size_t)t * 128 + 2 * lane) = (f32x2){w0, w1};
    }
}
__device__ __forceinline__ void ph_gv(const Frame& F, int layer) {
    const int lane = F.lane, r8 = lane >> 3, c16 = lane & 7;
    const int nper = F.G >> 3, xl = F.vcu / nper, wx = (F.vcu % nper) * NWAVES + F.wave, nwx = nper * NWAVES;
    const unsigned char* V = F.ws + WS_VB + (size_t)layer * 16384 * 2048 + c16 * 16;
    const int* eidx = WSP(int, WS_EIDX) + 16 * r8; const float* wv = WSP(float, WS_W) + 16 * r8;
#pragma unroll 1
    for (int p = 0; p < 2; ++p) {
        const int s = xl + 8 * p;
        const unsigned char* Vs = V + (size_t)s * (16384 * 128);
        float* hs = WSP(float, WS_H) + s * 128 + 16 * c16 + 2 * r8;
        u32x4 ia[2][4];
#pragma unroll
        for (int q = 0; q < 4; ++q) { ia[0][q] = *(const u32x4*)(eidx + (size_t)wx * 128 + 4 * q); ia[1][q] = *(const u32x4*)(eidx + (size_t)(wx + nwx) * 128 + 4 * q); }
#pragma unroll 1
        for (int t = wx; t < S; t += 2 * nwx) {
            const int t1 = t + nwx;
            u32x4 vr[2][16];
#pragma unroll
            for (int z = 0; z < 2; ++z)
#pragma unroll
                for (int q = 0; q < 16; ++q) { const unsigned id = ia[z][q >> 2][q & 3]; vr[z][q] = *(const u32x4*)(Vs + (size_t)id * 128); }
            { const int tn = (t + 2 * nwx < S) ? t + 2 * nwx : t;
#pragma unroll
              for (int q = 0; q < 4; ++q) { ia[0][q] = *(const u32x4*)(eidx + (size_t)tn * 128 + 4 * q); ia[1][q] = *(const u32x4*)(eidx + (size_t)(tn + nwx) * 128 + 4 * q); } }
            f32x4 wqa[2][4]; f32x2 hold[2];
#pragma unroll
            for (int z = 0; z < 2; ++z) { const size_t tt = (size_t)(z ? t1 : t);
#pragma unroll
                for (int q = 0; q < 4; ++q) wqa[z][q] = *(const f32x4*)(wv + tt * 128 + 4 * q);
                hold[z] = *(const f32x2*)(hs + tt * DM); }
#pragma unroll
            for (int z = 0; z < 2; ++z) {
                const size_t tt = (size_t)(z ? t1 : t);
                f32x4 wq[4];
#pragma unroll
                for (int q = 0; q < 4; ++q) wq[q] = wqa[z][q];
                f32x2 acc[8];
#pragma unroll
                for (int e = 0; e < 8; ++e) acc[e] = (f32x2){0.f, 0.f};
#pragma unroll
                for (int q = 0; q < 16; ++q) { const float w = wq[q >> 2][q & 3]; const f32x2 ww = {w, w}; const unsigned d4[4] = {vr[z][q].x, vr[z][q].y, vr[z][q].z, vr[z][q].w};
#pragma unroll
                    for (int e = 0; e < 4; ++e) { acc[2 * e] += ww * __builtin_amdgcn_cvt_pk_f32_fp8(d4[e], false); acc[2 * e + 1] += ww * __builtin_amdgcn_cvt_pk_f32_fp8(d4[e], true); } }
                f32x2 b4[4], b2[2], b1;
                { const bool up = lane & 32;
#pragma unroll
                  for (int e = 0; e < 4; ++e) { const f32x2 keep = up ? acc[e + 4] : acc[e], give = up ? acc[e] : acc[e + 4]; b4[e] = keep + (f32x2){__shfl_xor(give.x, 32), __shfl_xor(give.y, 32)}; } }
                { const bool up = lane & 16;
#pragma unroll
                  for (int e = 0; e < 2; ++e) { const f32x2 keep = up ? b4[e + 2] : b4[e], give = up ? b4[e] : b4[e + 2]; b2[e] = keep + (f32x2){__shfl_xor(give.x, 16), __shfl_xor(give.y, 16)}; } }
                { const bool up = lane & 8; const f32x2 keep = up ? b2[1] : b2[0], give = up ? b2[0] : b2[1]; b1 = keep + (f32x2){__shfl_xor(give.x, 8), __shfl_xor(give.y, 8)}; }
#if defined(DBG_ZERO_PEER)
                b1 = (f32x2){0.f, 0.f};
#endif
                *(f32x2*)(hs + tt * DM) = hold[z] + b1;
            }
        }
    }
}
#endif
__device__ __forceinline__ void ph_normg(const Frame& F, bool final_layer) {
    const int gw = F.vcu * NWAVES + F.wave, NGW = F.G * NWAVES, lane = F.lane;
    if (!final_layer) { for (int m = gw; m < S; m += NGW) rms_row_to_bf16(WSP(float, WS_H) + (size_t)m * DM, FIN(1) + DM, WSP(bf16_t, WS_XN) + (size_t)m * DM, lane); return; }
    const float* g = FIN(16); float* out = FOUT();
    for (int m = gw; m < S; m += NGW) {
        const f32x4* xr = (const f32x4*)(WSP(float, WS_H) + (size_t)m * DM) + lane;
        f32x4 v[8]; float s = 0.f;
#pragma unroll
        for (int j = 0; j < 8; ++j) { v[j] = xr[64 * j]; s += (v[j].x * v[j].x + v[j].y * v[j].y) + (v[j].z * v[j].z + v[j].w * v[j].w); }
        const float r = 1.0f / sqrtf(wave_sum(s) * (1.f / DM) + EPS);
        f32x4* o = (f32x4*)(out + (size_t)m * DM) + lane;
#pragma unroll
        for (int j = 0; j < 8; ++j) { const f32x4 gg = ((const f32x4*)g)[lane + 64 * j]; o[64 * j] = v[j] * r * gg; }
    }
}

__device__ __forceinline__ void ph_poolprep(const Frame& F) {
    const int lane = F.lane, gw = F.vcu * NWAVES + F.wave, NGW = F.G * NWAVES;
    const bf16_t* xn = WSP(bf16_t, WS_XN); const unsigned long long* ss = (const unsigned long long*)(F.ws + WS_CTL + CTL_SSQ) + S; const float* g = FIN(1) + DM;
    for (int t = gw; t < S; t += NGW) {
        const int rl = t - 8 + (lane & 15); const float rsl = (rl >= 0 && rl < S) ? rstd_of(ss[rl]) : 0.f;
        float rs[16];
#pragma unroll
        for (int q = 0; q < 16; ++q) rs[q] = __builtin_bit_cast(float, __builtin_amdgcn_readlane(__builtin_bit_cast(int, rsl), q));
        u32x4 o4[4];
#pragma unroll
        for (int j = 0; j < 4; ++j) {
            const int half = 1 << j, lo = max(t - half, 0), hi = min(t + half, S), c0 = (lane + 64 * j) * 8;
            u32x4 xr[16];
#pragma unroll
            for (int q = 0; q < 16; ++q) if (q < 2 * half) { const int r = t - half + q; xr[q] = (r >= 0 && r < S) ? *(const u32x4*)(xn + (size_t)r * DM + c0) : (u32x4){0u, 0u, 0u, 0u}; }
            float a[8];
#pragma unroll
            for (int q = 0; q < 8; ++q) a[q] = 0.f;
#pragma unroll
            for (int q = 0; q < 16; ++q) if (q < 2 * half) { const u32x4 x = xr[q]; const float r1 = rs[8 - half + q];
                a[0] += bflo(x.x) * r1; a[1] += bfhi(x.x) * r1; a[2] += bflo(x.y) * r1; a[3] += bfhi(x.y) * r1; a[4] += bflo(x.z) * r1; a[5] += bfhi(x.z) * r1; a[6] += bflo(x.w) * r1; a[7] += bfhi(x.w) * r1; }
            const u32x4 x = xr[half]; const float ic = 1.0f / (float)(hi - lo), rt = rs[8];
            const f32x4 g0 = *(const f32x4*)(g + c0), g1 = *(const f32x4*)(g + c0 + 4);
            o4[j].x = pk2((a[0] * ic - bflo(x.x) * rt) * g0.x, (a[1] * ic - bfhi(x.x) * rt) * g0.y); o4[j].y = pk2((a[2] * ic - bflo(x.y) * rt) * g0.z, (a[3] * ic - bfhi(x.y) * rt) * g0.w);
            o4[j].z = pk2((a[4] * ic - bflo(x.z) * rt) * g1.x, (a[5] * ic - bfhi(x.z) * rt) * g1.y); o4[j].w = pk2((a[6] * ic - bflo(x.w) * rt) * g1.z, (a[7] * ic - bfhi(x.w) * rt) * g1.w);
        }
#pragma unroll
        for (int j = 0; j < 4; ++j) *(u32x4*)(WSP(bf16_t, WS_POOLED) + (size_t)t * DM + (lane + 64 * j) * 8) = o4[j];
    }
}
__device__ __forceinline__ void ph_norm(const Frame& F, int layer) {
    const int gw = F.vcu * NWAVES + F.wave, NGW = F.G * NWAVES;
    for (int m = gw; m < S; m += NGW) rms_row_to_bf16(WSP(float, WS_H) + (size_t)m * DM, FIN(2) + layer * DM, WSP(bf16_t, WS_XN) + (size_t)m * DM, F.lane);
}


__device__ __forceinline__ void ph_attn(const Frame& F) {
    const int nunits = 8 * 64;
    float gq = fabsf(FIN(6)[F.lane]), gk = fabsf(FIN(7)[F.lane]); gq = fmaxf(gq, fabsf(FIN(6)[64 + F.lane])); gk = fmaxf(gk, fabsf(FIN(7)[64 + F.lane]));
#pragma unroll
    for (int o = 1; o < 64; o <<= 1) { gq = fmaxf(gq, __shfl_xor(gq, o)); gk = fmaxf(gk, __shfl_xor(gk, o)); }
    const float mC = -fminf(11.313708498984761f * gq * gk * 1.01f, 60.f) * 1.4426950408889634f;
    for (int u = F.vcu * 2; u < nunits; u += F.G * 2)
#pragma unroll 1
        for (int k = 0; k < 2; ++k) { const int unit = u + k, head = unit >> 6, qb = unit & 63, kvh = head >> 2;
            att::attn_dense_body<att::bf16>(WSP(att::bf16, WS_QB) + (size_t)(qb * 256) * 1024 + head * 128, WSP(att::bf16, WS_KVB) + kvh * 128, WSP(att::bf16, WS_KVB) + 256 + kvh * 128,
                                 WSP(att::bf16, WS_Y) + (size_t)(qb * 256) * DM + head * 128, S, F.ldsg, mC); }
}

#if defined(DBG_ATTN_CHECK)
constexpr int CW_DBG = 2048;
__device__ __forceinline__ void dbg_attn_check(const Frame& F) {
    __syncthreads();
    LAS float* sc = (LAS float*)F.lds; LAS float* red = sc + 16384; LAS float* po = red + 64;
    const int tid = F.tid, lane = F.lane, wave = F.wave;
    for (int chk = 0; chk < 4; ++chk) {
        const int unit = F.vcu * 2 + (chk & 1), head = unit >> 6, qb = unit & 63, kvh = head >> 2;
        const int t = qb * 256 + ((F.vcu * 37 + chk * 101 + 5) & 255);
        const bf16_t* q = WSP(bf16_t, WS_QB) + (size_t)t * 1024 + head * 128; const bf16_t* K = WSP(bf16_t, WS_KVB) + kvh * 128; const bf16_t* V = WSP(bf16_t, WS_KVB) + 256 + kvh * 128;
        float mx = -1e30f;
        for (int j = 0; j < 32; ++j) { const int key = tid + 512 * j; float s = 0.f;
            for (int d = 0; d < 128; ++d) s += bflo((unsigned)q[d]) * bflo((unsigned)K[(size_t)key * 512 + d]);
            s *= 0.088388347648318440f; sc[key] = s; mx = fmaxf(mx, s); }
        for (int o = 1; o < 64; o <<= 1) mx = fmaxf(mx, __shfl_xor(mx, o));
        if (lane == 0) red[wave] = mx;
        __syncthreads();
        mx = red[0]; for (int w = 1; w < 8; ++w) mx = fmaxf(mx, red[w]);
        __syncthreads();
        float sm = 0.f;
        for (int j = 0; j < 32; ++j) { const int key = tid + 512 * j; const float p = expf(sc[key] - mx); sc[key] = p; sm += p; }
        sm = wave_sum(sm);
        if (lane == 0) red[8 + wave] = sm;
        __syncthreads();
        sm = 0.f; for (int w = 0; w < 8; ++w) sm += red[8 + w];
        const int d = tid & 127, part = tid >> 7; float acc = 0.f;
        for (int kk = 0; kk < 4096; ++kk) { const int key = part * 4096 + kk; acc += sc[key] * bflo((unsigned)V[(size_t)key * 512 + d]); }
        po[part * 128 + d] = acc;
        __syncthreads();
        if (tid < 128) { const float o = (po[d] + po[128 + d] + po[256 + d] + po[384 + d]) / sm;
            const float y = bflo((unsigned)WSP(bf16_t, WS_Y)[(size_t)t * DM + head * 128 + d]);
            float ma = fabsf(o); for (int x = 1; x < 64; x <<= 1) ma = fmaxf(ma, __shfl_xor(ma, x));
            if (lane == 0) red[16 + wave] = ma;
            asm volatile("s_waitcnt lgkmcnt(0)" ::: "memory");
            const float mall = fmaxf(red[16], red[17]);
            const float mown = red[16 + wave]; (void)mall;
            const bool bad = !(fabsf(o - y) <= 0.03f * mown + 1e-5f);
            if (bad) atomicAdd((unsigned*)(F.ws + WS_CTL) + CW_DBG, 1u); }
        __syncthreads();
    }
}
#endif
#if defined(PROBE_MX)
typedef int v8i32p __attribute__((ext_vector_type(8)));
__device__ __forceinline__ unsigned probe_mx(int lane, int ra, int rb) {
    const int i = lane & 15, g = lane >> 4;
    v8i32p A = {0, 0, 0, 0, 0, 0, 0, 0}, B = {0, 0, 0, 0, 0, 0, 0, 0};
    if (g == PROBE_MX_G && i < 6) { const int j0 = (i == 0 ? 1 : i == 1 ? 2 : i == 2 ? 4 : i == 3 ? 8 : i == 4 ? 16 : 0);
#pragma unroll
        for (int d = 0; d < 4; ++d) if ((j0 >> 3) == d) A[d] = 0x2 << (4 * (j0 & 7)); }
    if (g == PROBE_MX_GB) {
#pragma unroll
        for (int d = 0; d < 8; ++d) { unsigned w = 0;
#pragma unroll
            for (int bb = 0; bb < 4; ++bb) { const int b = 4 * d + bb; const unsigned code = (unsigned)(((7 + (b >> 3)) << 3) | (b & 7)); w |= code << (8 * bb); }
            B[d] = (int)w; } }

    f32x4 c = {0.f, 0.f, 0.f, 0.f};
    c = __builtin_amdgcn_mfma_scale_f32_16x16x128_f8f6f4(A, B, c, 4, 0, 0, 0x7f7f7f7f, 0, 0x7f7f7f7f);
    float va = 0.f, vb = 0.f;
#pragma unroll
    for (int r = 0; r < 4; ++r) { const float x = __shfl(c[r], 16 * (ra >> 2)); if ((ra & 3) == r) va = x; const float y = __shfl(c[r], 16 * (rb >> 2)); if ((rb & 3) == r) vb = y; }
    auto dec = [](float v) -> unsigned { if (!(v >= 1.f)) return 33u; int e = 0; while (v >= 2.f && e < 8) { v *= 0.5f; ++e; } return (unsigned)(e * 8) + (unsigned)((v - 1.f) * 8.f + 0.5f); };
    return dec(va) + 40u * dec(vb);
}
#endif
#ifndef PHASE_MASK
#define PHASE_MASK 0x1fffff
#endif
#define PH_ON(k) (((PHASE_MASK) >> (k)) & 1)
struct Args { const float* in[17]; float* out; unsigned char* ws; int ph_lo, ph_hi; };
static_assert(sizeof(Args) == 17 * 8 + 8 + 8 + 8, "Args has no padding");
__global__ void __launch_bounds__(NTHR, 2) fwd_kernel(Args args) {
    extern __shared__ __attribute__((aligned(16))) unsigned char lds[];
    Frame F;
    F.lds = (LAS unsigned char*)lds; F.ldsg = (char*)lds;
    F.tid = threadIdx.x; F.lane = F.tid & 63; F.wave = __builtin_amdgcn_readfirstlane(F.tid >> 6);
    F.G = gridDim.x; { const int bx = blockIdx.x; F.vcu = (F.G % 8 == 0) ? (bx % 8) * (F.G / 8) + bx / 8 : bx; }
    F.ws = args.ws;
    volatile LAS unsigned* MISC = (volatile LAS unsigned*)(F.lds + LDSCTL_OFF);
    if (F.tid < 16) ((LAS unsigned*)(F.lds + LDSCTL_OFF))[F.tid] = 0u;
    if (F.tid >= 64 && F.tid < 64 + 36) ((LAS unsigned*)(F.lds + LDSCTL_OFF + 64))[F.tid - 64] = ((const unsigned*)&args)[F.tid - 64];
    __syncthreads();
    const int lo = args.ph_lo, hi = args.ph_hi;
    XcdBarrier bar; bar.bar = (unsigned*)(F.ws + WS_CTL) + CW_BAR; bar.x = 0; bar.st = nullptr;
    if (hi - lo > 1) bar = xcd_barrier_post((unsigned*)(F.ws + WS_CTL) + CW_BAR, MISC + 8);
#if defined(PROBE_BAR)
    unsigned long long tbar_total = 0;
#endif
#pragma unroll 1
    for (int ph = lo; ph < hi; ++ph) {
#if defined(PROBE_BAR)
        if (ph > lo) { const unsigned long long tb0 = __builtin_amdgcn_s_memrealtime(); xcd_barrier(bar); if (PROBE_BAR == 100 || ph == PROBE_BAR) tbar_total += __builtin_amdgcn_s_memrealtime() - tb0; }
#else
        if (ph > lo) xcd_barrier(bar);
#endif
#if defined(PROBE_PH)
        unsigned long long tprobe0 = 0; if (ph == PROBE_PH) tprobe0 = __builtin_amdgcn_s_memrealtime();
        if (ph == PROBE_PH + 1 || (PROBE_PH == NPH - 1 && false)) { }
#endif
        switch (ph) {
#define PHM(n) do { asm volatile("; PHASE_MARK " #n ::: "memory"); int t_ = threadIdx.x; asm volatile("" : "+v"(t_)); F.tid = t_; F.lane = t_ & 63; F.wave = __builtin_amdgcn_readfirstlane(t_ >> 6); \
    unsigned long long z_ = 0; asm volatile("" : "+s"(z_)); F.ws = args.ws + z_; } while (0)
        case PH_PRO: if constexpr (PH_ON(PH_PRO)) { PHM(PH_PRO); ph_prologue(F); } break;
        case PH_GEMM_IN: if constexpr (PH_ON(PH_GEMM_IN)) { PHM(PH_GEMM_IN);  pg8::Gemm g{WSP(bf16_t, WS_XN), WSP(bf16_t, WS_WIN), S, INP, DM, DM, DM, 0, 0}; pg8::StaticOrder So; So.init(S, INP, F.G, (int)blockIdx.x);
            pg8::EpiBf16<0> E{WSP(bf16_t, WS_PROJ), INP, nullptr, 0, 0, 1.f};
            pg8::gemm_phase<pg8::EpiBf16<0>, pg8::StaticOrder, true, true>(F.lds, g, So, E); } break;
        case PH_POST: if constexpr (PH_ON(PH_POST)) { PHM(PH_POST); ph_post(F); } break;
        case PH_ATTN: if constexpr (PH_ON(PH_ATTN)) { PHM(PH_ATTN); ph_attn(F);
#if defined(DBG_ATTN_CHECK)
            dbg_attn_check(F);
#endif
            } break;
        case PH_MLA: if constexpr (PH_ON(PH_MLA)) { PHM(PH_MLA); ph_mla(F); } break;
        case PH_SCAN: if constexpr (PH_ON(PH_SCAN)) { PHM(PH_SCAN); ph_scan(F); } break;
        case PH_MLB: if constexpr (PH_ON(PH_MLB)) { PHM(PH_MLB); ph_mlb(F); } break;
        case PH_GEMM_OUT: if constexpr (PH_ON(PH_GEMM_OUT)) { PHM(PH_GEMM_OUT);  pg8::Gemm g{WSP(bf16_t, WS_Y), WSP(bf16_t, WS_WOUT), S, DM, DM, DM, DM, 0, 0}; pg8::StaticOrder So; So.init(S, DM, F.G, (int)blockIdx.x);
            pg8::EpiResF32 E{FIN(0), WSP(float, WS_H), DM, nullptr, WSP(bf16_t, WS_XN), (unsigned long long*)(F.ws + WS_CTL + CTL_SSQ)};
            pg8::gemm_phase<pg8::EpiResF32, pg8::StaticOrder, true, true>(F.lds, g, So, E); } break;
        case PH_GEMM_Q0: case PH_GEMM_Q1: if constexpr (PH_ON(PH_GEMM_Q0)) { PHM(PH_GEMM_Q0);  pg8::Gemm g{WSP(bf16_t, WS_XN), WSP(bf16_t, ph == PH_GEMM_Q0 ? WS_WQ0 : WS_WQ1), S, DM, DM, DM, DM, 0, 0}; pg8::StaticOrder So; So.init(S, DM, F.G, (int)blockIdx.x);
            pg8::EpiBf16Row E{WSP(bf16_t, WS_QP), DM, (const unsigned long long*)(F.ws + WS_CTL + CTL_SSQ) + (ph == PH_GEMM_Q0 ? 0 : 2 * S), 1.0f / DM, EPS};
            pg8::gemm_phase<pg8::EpiBf16Row, pg8::StaticOrder, true, true>(F.lds, g, So, E); } break;
        case PH_TOPK0: if constexpr (PH_ON(PH_TOPK0)) { PHM(PH_TOPK0); ph_topk(F, 0); } break;
        case PH_TOPK1: if constexpr (PH_ON(PH_TOPK1)) { PHM(PH_TOPK1); ph_topk(F, 1); } break;
        case PH_GU0: if constexpr (PH_ON(PH_GU0)) { PHM(PH_GU0); ph_gu(F, 0); } break;
        case PH_GU1: if constexpr (PH_ON(PH_GU1)) { PHM(PH_GU1); ph_gu(F, 1); } break;
        case PH_ACT0: if constexpr (PH_ON(PH_ACT0)) { PHM(PH_ACT0); ph_act(F, 0); } break;
        case PH_ACT1: if constexpr (PH_ON(PH_ACT1)) { PHM(PH_ACT1); ph_act(F, 1); } break;
        case PH_GV0: if constexpr (PH_ON(PH_GV0)) { PHM(PH_GV0); ph_gv(F, 0); } break;
        case PH_GV1: if constexpr (PH_ON(PH_GV1)) { PHM(PH_GV1); ph_gv(F, 1); } break;
        case PH_NORMF: if constexpr (PH_ON(PH_NORMF)) { PHM(PH_NORMF); ph_normg(F, true);
#if defined(DBG_ATTN_CHECK)
            { const unsigned nb = __hip_atomic_load((unsigned*)(F.ws + WS_CTL) + CW_DBG, __ATOMIC_RELAXED, __HIP_MEMORY_SCOPE_AGENT);
              if (nb != 0u) { float* o = FOUT(); for (int i = F.vcu * NTHR + F.tid; i < 4096; i += F.G * NTHR) o[(size_t)i * 8192 + 7] += (DBG_ATTN_CHECK == 2 ? 0.f : 1000.f); } }
#endif
            } break;
        case PH_POOLPREP: if constexpr (PH_ON(PH_POOLPREP)) { PHM(PH_POOLPREP); ph_poolprep(F); } break;
        case PH_GEMM_POOL: if constexpr (PH_ON(PH_GEMM_POOL)) { PHM(PH_GEMM_POOL);  pg8::Gemm g{WSP(bf16_t, WS_POOLED), WSP(bf16_t, WS_WPOOL), S, DM, 512, DM, 512, 1, 512 * 2}; pg8::StaticOrder So; So.init(S, DM, F.G, (int)blockIdx.x);
            pg8::EpiResF32 E{WSP(float, WS_H), WSP(float, WS_H), DM, FIN(11), WSP(bf16_t, WS_XN), (unsigned long long*)(F.ws + WS_CTL + CTL_SSQ) + 2 * S};
            pg8::gemm_phase<pg8::EpiResF32, pg8::StaticOrder, true, true>(F.lds, g, So, E); } break;
        default: break;
        }
#if defined(PROBE_BAR)
        if (ph == hi - 1 && F.vcu == PROBE_BAR_VCU) { __syncthreads(); const unsigned long long t1 = __builtin_amdgcn_s_memrealtime(); while (__builtin_amdgcn_s_memrealtime() - t1 < 16ull * tbar_total) __builtin_amdgcn_s_sleep(8); }
#endif
#if defined(PROBE_PH)
#ifndef PROBE_VCU
#define PROBE_VCU -1
#endif
        if (ph == PROBE_PH && (PROBE_VCU < 0 || F.vcu == PROBE_VCU)) { __syncthreads(); const unsigned long long t1 = __builtin_amdgcn_s_memrealtime(), dt = t1 - tprobe0;
            while (__builtin_amdgcn_s_memrealtime() - t1 < 4ull * dt) __builtin_amdgcn_s_sleep(8); }
#endif
    }
}

#if defined(PROBE_MX)
__global__ void __launch_bounds__(64) probe_mx_kernel(int dummy) {
    const unsigned code = probe_mx((int)threadIdx.x, PROBE_MX_RA, PROBE_MX_RB); const unsigned long long t1 = __builtin_amdgcn_s_memrealtime();
    while (__builtin_amdgcn_s_memrealtime() - t1 < 1000ull * code + (unsigned long long)dummy) __builtin_amdgcn_s_sleep(8);
}
#endif
#ifndef N_LAUNCH_MODE
#define N_LAUNCH_MODE 1
#endif
extern "C" void kernel_launch(void* const* d_in, const int* in_sizes, int n_in, void* d_out, int out_size, void* d_ws, size_t ws_size, hipStream_t stream) {
    static int grid = 0;
    if (grid == 0) {
        if (n_in != 17 || in_sizes[0] != S * DM || out_size != S * DM || ws_size < WS_END) { fprintf(stderr, "kernel_launch: unexpected shapes (n_in %d, in0 %d, out %d, ws %zu; need ws >= %zu)\n", n_in, n_in > 0 ? in_sizes[0] : -1, out_size, ws_size, (size_t)WS_END); grid = -1; return; }
        int dev = 0, cus = 0;
        if (hipGetDevice(&dev) != hipSuccess || hipDeviceGetAttribute(&cus, hipDeviceAttributeMultiprocessorCount, dev) != hipSuccess) { grid = -1; return; }
        if (hipFuncSetAttribute((const void*)fwd_kernel, hipFuncAttributeMaxDynamicSharedMemorySize, LDS_BYTES) != hipSuccess) { fprintf(stderr, "kernel_launch: hipFuncSetAttribute failed\n"); grid = -1; return; }
        int per_cu = 0;
        if (hipOccupancyMaxActiveBlocksPerMultiprocessor(&per_cu, (const void*)fwd_kernel, NTHR, LDS_BYTES) != hipSuccess || per_cu < 1) fprintf(stderr, "kernel_launch: occupancy query reports %d\n", per_cu);
        (void)hipGetLastError();
        grid = cus;
        if (grid != 256) { fprintf(stderr, "kernel_launch: built for a 256-CU device (got %d CUs)\n", grid); grid = -1; return; }
    }
    if (grid < 0) return;
    (void)hipMemsetAsync((char*)d_ws + WS_CTL, 0, CTL_ZERO_BYTES, stream);
    Args a{};
    for (int i = 0; i < 17; ++i) a.in[i] = (const float*)d_in[i];
    a.out = (float*)d_out; a.ws = (unsigned char*)d_ws;
#if N_LAUNCH_MODE == 1
    a.ph_lo = 0; a.ph_hi = NPH;
    hipLaunchKernelGGL(fwd_kernel, dim3(grid), dim3(NTHR), LDS_BYTES, stream, a);
#else
    for (int ph = 0; ph < NPH; ++ph) { a.ph_lo = ph; a.ph_hi = ph + 1; hipLaunchKernelGGL(fwd_kernel, dim3(grid), dim3(NTHR), LDS_BYTES, stream, a); }
#endif
#if defined(PROBE_MX)
    hipLaunchKernelGGL(probe_mx_kernel, dim3(1), dim3(64), 0, stream, 0);
#endif
    const hipError_t le = hipPeekAtLastError();
    if (le != hipSuccess) fprintf(stderr, "kernel_launch: launch failed: %s\n", hipGetErrorName(le));
}
```

```cpp
#include <hip/hip_runtime.h>
#include <hip/hip_bf16.h>
#include <cstdio>
#include <cstdint>
#include <cmath>

#ifndef TBL_FP4
#define TBL_FP4 1
#endif
constexpr int S = 16384, DM = 2048, NWAVES = 8, NTHR = 512;
constexpr int INW = 5648, INP = 5888;
constexpr int C_AQ = 0, C_AK = 1024, C_AV = 1280, C_MQK = 1536, C_MV = 3584, C_MO = 4608, C_GATE = 5632;
constexpr float EPS = 1e-6f;
constexpr int NPH = 20;
enum { PH_PRO = 0, PH_GEMM_IN, PH_POST, PH_ATTN  , PH_SCAN, PH_MLB, PH_GEMM_OUT, PH_GEMM_Q0, PH_TOPK0, PH_GU0, PH_ACT0, PH_GV0,
       PH_POOLPREP, PH_GEMM_POOL, PH_GEMM_Q1, PH_TOPK1, PH_GU1, PH_ACT1, PH_GV1, PH_NORMF };

constexpr size_t MiB = 1u << 20;
constexpr size_t WS_CTL = 0, CTL_ZERO_BYTES = 1 * MiB;
constexpr size_t WS_WIN = 1 * MiB, WS_WOUT = 24 * MiB, WS_WQ0 = 32 * MiB, WS_WQ1 = 40 * MiB, WS_WPOOL = 48 * MiB, WS_KEYS = 50 * MiB;
constexpr size_t WS_TSC = 52 * MiB + 768 * 1024  , WS_GATES = 51 * MiB, WS_NST = 53 * MiB, WS_EIDX = 54 * MiB, WS_EGATE = 62 * MiB;
constexpr size_t WS_UB = 70 * MiB, WS_VB = 198 * MiB, WS_XN = 326 * MiB, WS_PROJ = 390 * MiB, WS_QP = WS_PROJ;
constexpr size_t WS_QB = 574 * MiB, WS_KVB = 606 * MiB, WS_MQ = 622 * MiB, WS_MK = 654 * MiB, WS_CST = 686 * MiB, WS_Y = 814 * MiB, WS_POOLED = WS_Y;
constexpr size_t WS_H = 878 * MiB, WS_END = 1006 * MiB;
constexpr size_t CTL_SSQ = 256 * 1024;
constexpr int CW_BAR = 4096;
constexpr size_t GO_B = 0, GO_U = 8 * S * 4, GO_PM = 2 * 8 * S * 4, GO_G = 3 * 8 * S * 4, GO_PML = GO_G + 4096, GO_MPREV = GO_PML + 4096;

constexpr int LDS_BYTES = 147456, LDSCTL_OFF = 146944;

#define GAS __attribute__((address_space(1)))
#define LAS __attribute__((address_space(3)))
typedef unsigned short bf16_t;
typedef short bf16x8 __attribute__((ext_vector_type(8)));
typedef short s16x4 __attribute__((ext_vector_type(4)));
typedef short v4i16_t __attribute__((ext_vector_type(4)));
typedef float f32x4 __attribute__((ext_vector_type(4)));
typedef float f32x2 __attribute__((ext_vector_type(2)));
typedef float f32x16 __attribute__((ext_vector_type(16)));
typedef unsigned u32x4 __attribute__((ext_vector_type(4)));
typedef unsigned u32x2 __attribute__((ext_vector_type(2)));
typedef __bf16 bf16x2_t __attribute__((ext_vector_type(2)));
typedef GAS unsigned gu32;
#define RLX_AGENT __ATOMIC_RELAXED, __HIP_MEMORY_SCOPE_AGENT
#define LDS_WAIT() asm volatile("s_waitcnt lgkmcnt(0)" ::: "memory")
__device__ __forceinline__ unsigned f2bf(float f) { unsigned u = __builtin_bit_cast(unsigned, f); return (u + 0x7fffu + ((u >> 16) & 1u)) >> 16; }
__device__ __forceinline__ unsigned pk2(float lo, float hi) { f32x2 v = {lo, hi}; bf16x2_t b = __builtin_convertvector(v, bf16x2_t); return __builtin_bit_cast(unsigned, b); }
__device__ __forceinline__ float bflo(unsigned w) { return __builtin_bit_cast(float, w << 16); }
__device__ __forceinline__ float bfhi(unsigned w) { return __builtin_bit_cast(float, w & 0xffff0000u); }
__device__ __forceinline__ float rstd_of(unsigned long long ss) { return 1.0f / sqrtf((float)ss * (1.0f / (1048576.0f * 2048.0f)) + 1e-6f); }
__device__ __forceinline__ void st_wt8(void* p, u32x2 v) { __hip_atomic_store((unsigned long long*)p, ((unsigned long long)v.y << 32) | v.x, __ATOMIC_RELAXED, __HIP_MEMORY_SCOPE_AGENT); }
__device__ __forceinline__ void st_wt8f(void* p, f32x2 v) { st_wt8(p, __builtin_bit_cast(u32x2, v)); }
__device__ __forceinline__ void st_wt16(void* p, u32x4 v) { asm volatile("global_store_dwordx4 %0, %1, off sc1" :: "v"(p), "v"(v) : "memory"); }
__device__ __forceinline__ void st_wt16f(void* p, f32x4 v) { st_wt16(p, __builtin_bit_cast(u32x4, v)); }
__device__ __forceinline__ float wave_sum(float v) {
#pragma unroll
    for (int o = 1; o < 64; o <<= 1) v += __shfl_xor(v, o);
    return v;
}

namespace pg8 {
#define PG8_LAS __attribute__((address_space(3)))
typedef unsigned short bf16_t;
typedef short bf16x8 __attribute__((ext_vector_type(8)));
typedef float f32x4 __attribute__((ext_vector_type(4)));
typedef unsigned u32x4 __attribute__((ext_vector_type(4)));
constexpr int BM = 256, BK = 64, HALF = 128, HTB = HALF * BK * 2  , STAGE_BYTES = 8 * HTB, NXCD = 8, WGM = 8;

__host__ __device__ __forceinline__ int lds_byte(int r, int c) { const int st = (r >> 4) * 2 + (c >> 5), rr = r & 15, cc = c & 31, ob = rr * 64 + cc * 2; return st * 1024 + (ob ^ (((ob >> 9) & 1) << 5)); }
__host__ __device__ __forceinline__ void stage_rc(int b, int& R, int& C) { const int st = b / 1024, sb = b % 1024, swz = sb ^ (((sb >> 9) & 1) << 5); R = (st >> 1) * 16 + swz / 64; C = (st & 1) * 32 + (swz % 64) / 2; }
__host__ __device__ __forceinline__ int perm32(int rho) { const int n = rho >> 4, i = rho & 15; return 8 * (i >> 2) + 4 * n + (i & 3); }

struct Unit { int pm, pn; };
struct Gemm { const bf16_t* A; const bf16_t* Bt; int M, N, K, lda, ldb, agrp_shift; size_t agrp_bytes; };

struct StaticOrder {
    int nM, nN, nwg, G, c;
    __host__ __device__ void init(int M, int N, int G_, int c_) { nM = M / BM; nN = N / BM; nwg = nM * nN; G = G_; c = c_; }
    __host__ __device__ bool next(int i, Unit& u) const {
        const long L = (long)i * G + c; if (L >= nwg) return false;
        int wgid = (int)L; { const int q = nwg / NXCD, r = nwg % NXCD, xcd = wgid % NXCD, off = wgid / NXCD; wgid = (xcd < r ? xcd * (q + 1) : r * (q + 1) + (xcd - r) * q) + off; }
        const int nig = WGM * nN, gid = wgid / nig, fm = gid * WGM, gsz = (nM - fm) < WGM ? (nM - fm) : WGM;
        u.pm = fm + ((wgid % nig) % gsz); u.pn = (wgid % nig) / gsz; return true;
    }
    __device__ __forceinline__ void a_ready(const Unit&) const {}
    __device__ __forceinline__ void done(const Unit&) const {}
};

__device__ __forceinline__ unsigned cvt_pk_bf16(float lo, float hi) { unsigned r; asm volatile("v_cvt_pk_bf16_f32 %0, %1, %2" : "=v"(r) : "v"(lo), "v"(hi)); return r; }
typedef float f32x2 __attribute__((ext_vector_type(2)));
__device__ __forceinline__ f32x2 gelu_pk(f32x2 v) {
    const f32x2 av = __builtin_elementwise_abs(v), d = av * 0.2316418882f + 1.0f;
    f32x2 t; t.x = __builtin_amdgcn_rcpf(d.x); t.y = __builtin_amdgcn_rcpf(d.y);
    f32x2 q = t * 0.5307027145f + (-0.7265760135f); q = q * t + 0.7107068705f; q = q * t + (-0.142248368f); q = q * t + 0.127414796f; q = q * t;
    const f32x2 s = (v * v) * (-0.72134752044f);
    f32x2 e; e.x = __builtin_amdgcn_exp2f(s.x); e.y = __builtin_amdgcn_exp2f(s.y);
    const f32x2 m = v * (q * e), r = v - m;
    f32x2 o; o.x = v.x < 0.f ? m.x : r.x; o.y = v.y < 0.f ? m.y : r.y; return o;
}
template <int ACT  > struct EpiBf16 {
    static constexpr bool PERM = true, AFTER_DRAIN = false; static_assert(ACT == 0 || ACT == 1, "EpiBf16: ACT is 0 (none) or 1 (gelu_pk)");
    bf16_t* O; int ldc; const float* bias; int split_cols; size_t split_stride; float scale0;
    __device__ __forceinline__ void operator()(const f32x4 (&acc)[2][2][4][2], const Unit& u, int wr, int wc, int fr, int fq) const {
        const int row0 = u.pm * BM + wr * 64 + fr; int colt = u.pn * BM; bf16_t* base = O;
        float sc = 1.f; if (split_cols) { const int t = colt / split_cols; base += (size_t)t * split_stride; colt -= t * split_cols; if (t == 0) sc = scale0; }
        const int col0 = colt + wc * 32 + 8 * fq, bcol0 = u.pn * BM + wc * 32 + 8 * fq;
        f32x4 bv[2][2];
#pragma unroll
        for (int bj = 0; bj < 2; ++bj)
#pragma unroll
            for (int n = 0; n < 2; ++n) bv[bj][n] = bias ? *(const f32x4*)(bias + bcol0 + bj * HALF + 4 * n) : (f32x4){0.f, 0.f, 0.f, 0.f};
#pragma unroll
        for (int ai = 0; ai < 2; ++ai)
#pragma unroll
            for (int m = 0; m < 4; ++m) { bf16_t* rowp = base + (size_t)(row0 + ai * HALF + m * 16) * ldc + col0;
#pragma unroll
                for (int bj = 0; bj < 2; ++bj) { f32x4 v0 = acc[ai][bj][m][0] + bv[bj][0], v1 = acc[ai][bj][m][1] + bv[bj][1];
                    if (ACT == 1) { f32x2 a = gelu_pk((f32x2){v0[0], v0[1]}), b = gelu_pk((f32x2){v0[2], v0[3]}), c = gelu_pk((f32x2){v1[0], v1[1]}), d = gelu_pk((f32x2){v1[2], v1[3]});
                        v0 = (f32x4){a.x, a.y, b.x, b.y}; v1 = (f32x4){c.x, c.y, d.x, d.y}; }
                    v0 = v0 * sc; v1 = v1 * sc; u32x4 w; w.x = cvt_pk_bf16(v0[0], v0[1]); w.y = cvt_pk_bf16(v0[2], v0[3]); w.z = cvt_pk_bf16(v1[0], v1[1]); w.w = cvt_pk_bf16(v1[2], v1[3]);
                    *(u32x4*)(rowp + bj * HALF) = w; } }
    }
};
template <bool BASE_BF16> struct EpiRes {
    static constexpr bool PERM = false, AFTER_DRAIN = false;
    const void* base; bf16_t* hb; int ldc; const float* colscale; unsigned long long* ssq;
    __device__ __forceinline__ void operator()(const f32x4 (&acc)[2][2][4][2], const Unit& u, int wr, int wc, int fr, int fq) const {
        typedef unsigned u32x2v __attribute__((ext_vector_type(2)));
        const int row0 = u.pm * BM + wr * 64 + fr, col0 = u.pn * BM + wc * 32 + 4 * fq;
        f32x4 cs[2][2];
#pragma unroll
        for (int bj = 0; bj < 2; ++bj)
#pragma unroll
            for (int n = 0; n < 2; ++n) cs[bj][n] = colscale ? *(const f32x4*)(colscale + col0 + bj * HALF + n * 16) : (f32x4){1.f, 1.f, 1.f, 1.f};
#pragma unroll
        for (int ai = 0; ai < 2; ++ai)
#pragma unroll
            for (int m = 0; m < 4; ++m) { const size_t off = (size_t)(row0 + ai * HALF + m * 16) * ldc + col0;
                float ssum = 0.f;
#pragma unroll
                for (int bj = 0; bj < 2; ++bj)
#pragma unroll
                    for (int n = 0; n < 2; ++n) { f32x4 b;
                        if (BASE_BF16) { const u32x2v w = *(const u32x2v*)((const bf16_t*)base + off + bj * HALF + n * 16);
                            b = (f32x4){__builtin_bit_cast(float, w.x << 16), __builtin_bit_cast(float, w.x & 0xffff0000u), __builtin_bit_cast(float, w.y << 16), __builtin_bit_cast(float, w.y & 0xffff0000u)}; }
                        else b = *(const f32x4*)((const float*)base + off + bj * HALF + n * 16);
                        const f32x4 h = b + acc[ai][bj][m][n] * cs[bj][n];
                        u32x2v w; w.x = cvt_pk_bf16(h[0], h[1]); w.y = cvt_pk_bf16(h[2], h[3]); *(u32x2v*)(hb + off + bj * HALF + n * 16) = w;
                        ssum += (h[0] * h[0] + h[1] * h[1]) + (h[2] * h[2] + h[3] * h[3]); }
                if (ssq) { ssum += __shfl_xor(ssum, 16); ssum += __shfl_xor(ssum, 32);
                    if (fq == 0) atomicAdd(ssq + (row0 + ai * HALF + m * 16), (unsigned long long)(ssum * 1048576.0f)); }
                asm volatile("" ::: "memory"); }
    }
};

struct EpiBf16Row {
    static constexpr bool PERM = true, AFTER_DRAIN = false;
    bf16_t* O; int ldc; const unsigned long long* ssq; float inv_ncol, eps;
    __device__ __forceinline__ void operator()(const f32x4 (&acc)[2][2][4][2], const Unit& u, int wr, int wc, int fr, int fq) const {
        const int row0 = u.pm * BM + wr * 64 + fr, col0 = u.pn * BM + wc * 32 + 8 * fq;
#pragma unroll
        for (int ai = 0; ai < 2; ++ai)
#pragma unroll
            for (int m = 0; m < 4; ++m) { const int row = row0 + ai * HALF + m * 16; bf16_t* rowp = O + (size_t)row * ldc + col0;
                const float sc = ssq ? 1.0f / sqrtf((float)ssq[row] * (inv_ncol * (1.0f / 1048576.0f)) + eps) : 1.f;
#pragma unroll
                for (int bj = 0; bj < 2; ++bj) { const f32x4 v0 = acc[ai][bj][m][0] * sc, v1 = acc[ai][bj][m][1] * sc;
                    u32x4 w; w.x = cvt_pk_bf16(v0[0], v0[1]); w.y = cvt_pk_bf16(v0[2], v0[3]); w.z = cvt_pk_bf16(v1[0], v1[1]); w.w = cvt_pk_bf16(v1[2], v1[3]);
                    *(u32x4*)(rowp + bj * HALF) = w; } }
    }
};

template <class Epi, class Sched, bool ALIGN_EPI = false, bool SP2 = false>
__device__ __forceinline__ void gemm_phase(PG8_LAS unsigned char* lds, const Gemm g, const Sched& S, const Epi& E) {
    int tid_ = threadIdx.x; asm volatile("" : "+v"(tid_));
    const int tid = tid_, wid = __builtin_amdgcn_readfirstlane(tid >> 6), lane = tid & 63, wr = wid >> 2, wc = wid & 3, fr = lane & 15, fq = lane >> 4;
    const int K = g.K, nt = K / BK;
    unsigned voffA[2], voffB[2];
#pragma unroll
    for (int i = 0; i < 2; ++i) { int R, C; stage_rc(tid * 16 + i * 8192, R, C); const int Rb = Epi::PERM ? ((R & ~31) + perm32(R & 31)) : R;
        voffA[i] = (unsigned)(R * g.lda + C) * 2u; voffB[i] = (unsigned)(Rb * g.ldb + C) * 2u; }
    const size_t kstep = (size_t)(BK * 2);
    const size_t hstepA = (size_t)HALF * g.lda * 2, hstepB = (size_t)HALF * g.ldb * 2;
    const size_t tstepA = 2 * hstepA, tstepB = 2 * hstepB;
    const unsigned ldsw = (unsigned)wid * 1024u;
    const int aoff = lds_byte(wr * 64 + fr, fq * 8), boff = lds_byte(wc * 32 + fr, fq * 8);
#define PG8_SA(b, h) (((b) * 2 + (h)) * HTB)
#define PG8_SB(b, h) ((4 + (b) * 2 + (h)) * HTB)
#define PG8_STAGE(bufoff, gbase, voff) do { _Pragma("unroll") for (int _i = 0; _i < 2; ++_i) \
        __builtin_amdgcn_global_load_lds((const unsigned*)((const char*)(gbase) + (voff)[_i]), (PG8_LAS unsigned*)(lds + (bufoff) + ldsw + _i * 8192), 16, 0, 0); } while (0)
#define PG8_LDA(dst, b, h) do { _Pragma("unroll") for (int m = 0; m < 4; ++m) _Pragma("unroll") for (int k = 0; k < 2; ++k) dst[m][k] = *(const PG8_LAS bf16x8*)(lds + PG8_SA(b, h) + aoff + m * 2048 + k * 1024); } while (0)
#define PG8_LDB(dst, b, h) do { _Pragma("unroll") for (int n = 0; n < 2; ++n) _Pragma("unroll") for (int k = 0; k < 2; ++k) dst[n][k] = *(const PG8_LAS bf16x8*)(lds + PG8_SB(b, h) + boff + n * 2048 + k * 1024); } while (0)
#define PG8_MMA(ai, bj, At, Bt) do { __builtin_amdgcn_s_setprio(1); _Pragma("unroll") for (int m = 0; m < 4; ++m) _Pragma("unroll") for (int n = 0; n < 2; ++n) _Pragma("unroll") for (int k = 0; k < 2; ++k) \
        acc[ai][bj][m][n] = __builtin_amdgcn_mfma_f32_16x16x32_bf16(Bt[n][k], At[m][k], acc[ai][bj][m][n], 0, 0, 0); __builtin_amdgcn_s_setprio(0); } while (0)
#define PG8_WAIT_V(n) asm volatile("s_waitcnt vmcnt(" #n ")" ::: "memory")
#define PG8_WAIT_L(n) asm volatile("s_waitcnt lgkmcnt(" #n ")" ::: "memory")
#define PG8_BAR __builtin_amdgcn_s_barrier()
#define PG8_SCHED __builtin_amdgcn_sched_barrier(0)
    Unit cur, nxt; int ui = 0;
    if (!S.next(0, cur)) return;
    f32x4 acc[2][2][4][2];
#pragma unroll
    for (int a = 0; a < 2; ++a)
#pragma unroll
        for (int b = 0; b < 2; ++b)
#pragma unroll
            for (int m = 0; m < 4; ++m)
#pragma unroll
                for (int n = 0; n < 2; ++n) acc[a][b][m][n] = (f32x4){0.f, 0.f, 0.f, 0.f};
    bf16x8 At[4][2], B0[2][2], B1[2][2];
    const char* cA = (const char*)g.A + (size_t)cur.pm * tstepA + (size_t)(cur.pn >> g.agrp_shift) * g.agrp_bytes; const char* cB = (const char*)g.Bt + (size_t)cur.pn * tstepB;
    S.a_ready(cur);
    if constexpr (SP2) {
        PG8_STAGE(PG8_SB(0, 0), cB, voffB); PG8_STAGE(PG8_SB(0, 1), cB + hstepB, voffB); PG8_STAGE(PG8_SA(0, 0), cA, voffA); PG8_STAGE(PG8_SA(0, 1), cA + hstepA, voffA);
        if (wr == 1) PG8_BAR;
        PG8_WAIT_V(2); PG8_BAR;
        PG8_STAGE(PG8_SB(1, 0), cB + kstep, voffB); PG8_STAGE(PG8_SA(1, 0), cA + kstep, voffA); PG8_STAGE(PG8_SB(1, 1), cB + hstepB + kstep, voffB);
        PG8_WAIT_V(6); PG8_BAR;
    } else {
        PG8_STAGE(PG8_SB(0, 0), cB, voffB); PG8_STAGE(PG8_SA(0, 0), cA, voffA); PG8_STAGE(PG8_SB(0, 1), cB + hstepB, voffB); PG8_STAGE(PG8_SA(0, 1), cA + hstepA, voffA);
        if (wr == 1) PG8_BAR;
        PG8_WAIT_V(4); PG8_BAR;
        PG8_STAGE(PG8_SB(1, 0), cB + kstep, voffB); PG8_STAGE(PG8_SA(1, 0), cA + kstep, voffA); PG8_STAGE(PG8_SB(1, 1), cB + hstepB + kstep, voffB);
        PG8_WAIT_V(6); PG8_BAR;
    }
    for (;;) {
        const bool has_next = S.next(ui + 1, nxt);
        const char* nA = has_next ? (const char*)g.A + (size_t)nxt.pm * tstepA + (size_t)(nxt.pn >> g.agrp_shift) * g.agrp_bytes : cA; const char* nB = has_next ? (const char*)g.Bt + (size_t)nxt.pn * tstepB : cB;
        for (int t = 0; t < nt; t += 2) {
            const bool last = (t == nt - 2);
            const char* a1 = cA + (size_t)(t + 1) * kstep;
            const char* a2 = last ? nA : cA + (size_t)(t + 2) * kstep; const char* b2 = last ? nB : cB + (size_t)(t + 2) * kstep;
            const char* a3 = a2 + kstep; const char* b3 = b2 + kstep;
            if (last && has_next) S.a_ready(nxt);
            if constexpr (SP2) {
            PG8_LDB(B0, 0, 0); PG8_LDB(B1, 0, 1); PG8_SCHED; PG8_LDA(At, 0, 0); PG8_STAGE(PG8_SA(1, 1), a1 + hstepA, voffA);
            PG8_WAIT_V(8); PG8_WAIT_L(0); PG8_BAR; PG8_MMA(0, 0, At, B0); PG8_MMA(0, 1, At, B1); PG8_BAR; PG8_SCHED;
            PG8_LDA(At, 0, 1); PG8_STAGE(PG8_SB(0, 0), b2, voffB); PG8_STAGE(PG8_SB(0, 1), b2 + hstepB, voffB); PG8_STAGE(PG8_SA(0, 0), a2, voffA);
            PG8_WAIT_V(8); PG8_WAIT_L(0); PG8_BAR; PG8_MMA(1, 0, At, B0); PG8_MMA(1, 1, At, B1); PG8_BAR; PG8_SCHED;
            PG8_LDB(B0, 1, 0); PG8_LDB(B1, 1, 1); PG8_SCHED; PG8_LDA(At, 1, 0); PG8_STAGE(PG8_SA(0, 1), a2 + hstepA, voffA);
            PG8_WAIT_V(8); PG8_WAIT_L(0); PG8_BAR; PG8_MMA(0, 0, At, B0); PG8_MMA(0, 1, At, B1); PG8_BAR; PG8_SCHED;
            PG8_LDA(At, 1, 1); PG8_STAGE(PG8_SB(1, 0), b3, voffB); PG8_STAGE(PG8_SB(1, 1), b3 + hstepB, voffB); PG8_STAGE(PG8_SA(1, 0), a3, voffA);
            PG8_WAIT_V(8); PG8_WAIT_L(0); PG8_BAR; PG8_MMA(1, 0, At, B0); PG8_MMA(1, 1, At, B1); PG8_BAR; PG8_SCHED;
            } else {
            PG8_LDB(B0, 0, 0); PG8_SCHED; PG8_LDA(At, 0, 0); PG8_STAGE(PG8_SA(1, 1), a1 + hstepA, voffA);
            PG8_WAIT_L(8); PG8_BAR; PG8_WAIT_L(0); PG8_MMA(0, 0, At, B0); PG8_BAR; PG8_SCHED;
            PG8_LDB(B1, 0, 1); PG8_STAGE(PG8_SB(0, 0), b2, voffB);
            PG8_BAR; PG8_WAIT_L(0); PG8_MMA(0, 1, At, B1); PG8_BAR;
            PG8_LDA(At, 0, 1); PG8_STAGE(PG8_SA(0, 0), a2, voffA);
            PG8_BAR; PG8_WAIT_L(0); PG8_MMA(1, 0, At, B0); PG8_BAR; PG8_SCHED;
            PG8_STAGE(PG8_SB(0, 1), b2 + hstepB, voffB);
            PG8_WAIT_V(6); PG8_BAR; PG8_MMA(1, 1, At, B1); PG8_BAR;
            PG8_LDB(B0, 1, 0); PG8_SCHED; PG8_LDA(At, 1, 0); PG8_STAGE(PG8_SA(0, 1), a2 + hstepA, voffA);
            PG8_WAIT_L(8); PG8_BAR; PG8_WAIT_L(0); PG8_MMA(0, 0, At, B0); PG8_BAR; PG8_SCHED;
            PG8_LDB(B1, 1, 1); PG8_STAGE(PG8_SB(1, 0), b3, voffB);
            PG8_BAR; PG8_WAIT_L(0); PG8_MMA(0, 1, At, B1); PG8_BAR;
            PG8_LDA(At, 1, 1); PG8_STAGE(PG8_SA(1, 0), a3, voffA);
            PG8_BAR; PG8_WAIT_L(0); PG8_MMA(1, 0, At, B0); PG8_BAR; PG8_SCHED;
            PG8_STAGE(PG8_SB(1, 1), b3 + hstepB, voffB);
            PG8_WAIT_V(6); PG8_BAR; PG8_MMA(1, 1, At, B1); PG8_BAR;
            }
        }
        if constexpr (ALIGN_EPI) { if (wr == 0) PG8_BAR; }
        if constexpr (!Epi::AFTER_DRAIN) { E(acc, cur, wr, wc, fr, fq); S.done(cur); }
        if (!has_next) break;
#pragma unroll
        for (int a = 0; a < 2; ++a)
#pragma unroll
            for (int b = 0; b < 2; ++b)
#pragma unroll
                for (int m = 0; m < 4; ++m)
#pragma unroll
                    for (int n = 0; n < 2; ++n) acc[a][b][m][n] = (f32x4){0.f, 0.f, 0.f, 0.f};
        cur = nxt; cA = nA; cB = nB; ++ui;
        if constexpr (ALIGN_EPI) { if (wr == 1) PG8_BAR; }
    }
    PG8_WAIT_V(0);
    if constexpr (!ALIGN_EPI) { if (wr == 0) PG8_BAR; }
    PG8_BAR;
    if constexpr (Epi::AFTER_DRAIN) { E.fused(acc, cur, wr, wc, fr, fq, lds, wid, lane); S.done(cur); }
#undef PG8_SA
#undef PG8_SB
#undef PG8_STAGE
#undef PG8_LDA
#undef PG8_LDB
#undef PG8_MMA
#undef PG8_WAIT_V
#undef PG8_WAIT_L
#undef PG8_BAR
#undef PG8_SCHED
}
}
#define XB_TMO      128
#define XB_XCNT(j)  (256  + 64 * (j))
#define XB_XSUB(j)  (1280 + 64 * (j))
#define XB_XGEN(j)  (2304 + 64 * (j))
#define XB_TOP      3328
#define XB_TOPGEN   3392
#define XCD_BAR_WORDS 3456
#define XB_SPIN_CAP (1u << 18)

__device__ __forceinline__ unsigned xb_ld(unsigned* p)              { return __hip_atomic_load(p, __ATOMIC_RELAXED, __HIP_MEMORY_SCOPE_AGENT); }
__device__ __forceinline__ unsigned xb_add(unsigned* p, unsigned v) { return __hip_atomic_fetch_add(p, v, __ATOMIC_RELAXED, __HIP_MEMORY_SCOPE_AGENT); }
__device__ __forceinline__ unsigned xb_xcc_id() { return (unsigned)__builtin_amdgcn_s_getreg((3 << 11) | 20) & 0xFu; }
#define XB_SPIN(cond, bar) do { unsigned _sp = 0; while (cond) { __builtin_amdgcn_s_sleep(1); \
    if ((++_sp & 255u) == 0u) { if (xb_ld(&(bar)[XB_TMO])) break; if (_sp > XB_SPIN_CAP) { atomicAdd(&(bar)[XB_TMO], 1u); break; } } } } while (0)

struct XcdBarrier {
    unsigned* bar; unsigned x;
    volatile LAS unsigned* st;
};

__device__ __forceinline__ XcdBarrier xcd_barrier_post(unsigned* bar, volatile LAS unsigned* st) {
    XcdBarrier b; b.bar = bar; b.x = xb_xcc_id(); b.st = st;
    if (threadIdx.x == 0) (void)xb_add(&bar[XB_XCNT(b.x)], 1u);
    return b;
}
__device__ __forceinline__ void xcd_barrier_complete(unsigned* bar, unsigned x, unsigned& nloc, unsigned& nx) {
    const unsigned G = gridDim.x * gridDim.y * gridDim.z;
    unsigned sum, cnt, mine, sp = 0u;
    for (;;) {
        sum = 0u; cnt = 0u; mine = 0u;
#pragma unroll
        for (unsigned j = 0; j < 16; ++j) { const unsigned c = xb_ld(&bar[XB_XCNT(j)]); sum += c; cnt += (c > 0u) ? 1u : 0u; mine = (j == x) ? c : mine; }
        if (sum == G) break;
        __builtin_amdgcn_s_sleep(1);
        if ((++sp & 255u) == 0u) { if (xb_ld(&bar[XB_TMO])) break; if (sp > XB_SPIN_CAP) { atomicAdd(&bar[XB_TMO], 1u); break; } }
    }
    nloc = mine > 0u ? mine : 1u; nx = cnt > 0u ? cnt : 1u;
}

__device__ __forceinline__ void xcd_barrier(const XcdBarrier& b) {
    asm volatile("s_waitcnt vmcnt(0)" ::: "memory");
    __syncthreads();
    if (threadIdx.x == 0) {
        unsigned* bar = b.bar;
        __builtin_amdgcn_s_waitcnt(0);
        unsigned nloc = b.st[0], nx = b.st[1];
        if (nloc == 0u) { xcd_barrier_complete(bar, b.x, nloc, nx); b.st[0] = nloc; b.st[1] = nx; }
        const unsigned old = xb_add(&bar[XB_XSUB(b.x)], 1u);
        const unsigned gen = old / nloc;
        if (old + 1u == (gen + 1u) * nloc) {
            __builtin_amdgcn_fence(__ATOMIC_RELEASE, "agent");
            asm volatile("s_waitcnt vmcnt(0)" ::: "memory");
            const unsigned og = xb_add(&bar[XB_TOP], 1u);
            const unsigned tg = og / nx;
            if (og + 1u == (tg + 1u) * nx) xb_add(&bar[XB_TOPGEN], 1u);
            else XB_SPIN(xb_ld(&bar[XB_TOPGEN]) == tg, bar);
            __builtin_amdgcn_fence(__ATOMIC_ACQUIRE, "agent");
            xb_add(&bar[XB_XGEN(b.x)], 1u);
            asm volatile("s_waitcnt vmcnt(0)" ::: "memory");
        } else {
            XB_SPIN(xb_ld(&bar[XB_XGEN(b.x)]) == gen, bar);
            __builtin_amdgcn_fence(__ATOMIC_ACQUIRE, "agent");
            asm volatile("s_waitcnt vmcnt(0)" ::: "memory");
        }
    }
    __syncthreads();
}
namespace att {
using bf16 = __hip_bfloat16;
constexpr int   D = 128, NW = 8, QBLK = 32, KVBLK = 64;
constexpr float SCALE = 0.088388347648318440f;
constexpr float THR = 8.f;
constexpr int SDEPTH = 1;
constexpr int LDQ = 1024, LDK = 512, LDO = 2048;
constexpr size_t SHM_V = KVBLK * D * 2, SHM_K = KVBLK * D * 2, SHM_ATTN = 2 * SHM_V + 2 * SHM_K + NW * 64 * 4;
using bf16x8 = __attribute__((ext_vector_type(8))) short;
using s16x4  = __attribute__((ext_vector_type(4))) short;
using f32x16 = __attribute__((ext_vector_type(16))) float;
using f32x8  = __attribute__((ext_vector_type(8))) float;
using u32x4  = __attribute__((ext_vector_type(4))) unsigned;
#define KSWZ(row, colB) ((row) * 256 + ((colB) ^ (((row) & 7) << 4)))
#define SBAR() __builtin_amdgcn_sched_barrier(0)
__device__ __forceinline__ int crow(int r, int hi) { return (r & 3) + 8 * (r >> 2) + 4 * hi; }
__device__ __forceinline__ unsigned cvtpk(float lo, float hi) {
  unsigned r; asm volatile("v_cvt_pk_bf16_f32 %0, %1, %2" : "=v"(r) : "v"(lo), "v"(hi)); return r;
}
template <typename TIn> struct Stage;
template <> struct Stage<bf16>  { using T = bf16x8;
  __device__ static __forceinline__ T ld8(const bf16* p) { return *reinterpret_cast<const bf16x8*>(p); }
  __device__ static __forceinline__ bf16x8 tobf(T x) { return x; } };
template <> struct Stage<float> { using T = f32x8;
  __device__ static __forceinline__ T ld8(const float* p) { return *reinterpret_cast<const f32x8*>(p); }
  __device__ static __forceinline__ bf16x8 tobf(T x) {
    u32x4 w = {cvtpk(x[0], x[1]), cvtpk(x[2], x[3]), cvtpk(x[4], x[5]), cvtpk(x[6], x[7])}; return *reinterpret_cast<bf16x8*>(&w); } };

__device__ __forceinline__ void partialSM(f32x16& p0, f32x16& p1, float mC) {
  constexpr float C = SCALE * 1.4426950408889634f;
  for (int r = 0; r < 16; ++r) p0[r] = fmaf(p0[r], C, mC); for (int r = 0; r < 16; ++r) p1[r] = fmaf(p1[r], C, mC);
  for (int r = 0; r < 16; ++r) p0[r] = __builtin_amdgcn_exp2f(p0[r]);
}
__device__ __forceinline__ void finishSM(f32x16& p0, f32x16& p1, float& l_reg, bf16x8& pa0, bf16x8& pa1, bf16x8& pa2, bf16x8& pa3) {
  for (int r = 0; r < 16; ++r) p1[r] = __builtin_amdgcn_exp2f(p1[r]);
  float ps = 0; for (int r = 0; r < 16; ++r) ps += p0[r]; for (int r = 0; r < 16; ++r) ps += p1[r];
  l_reg += ps;
#define PK4(P, BASE, OUT) do { unsigned a0 = cvtpk(P[BASE + 0], P[BASE + 1]), a1 = cvtpk(P[BASE + 2], P[BASE + 3]);   \
    unsigned b0 = cvtpk(P[BASE + 4], P[BASE + 5]), b1 = cvtpk(P[BASE + 6], P[BASE + 7]);                              \
    auto r0 = __builtin_amdgcn_permlane32_swap(a0, b0, false, false); auto r1 = __builtin_amdgcn_permlane32_swap(a1, b1, false, false); \
    u32x4 w = {r0[0], r1[0], r0[1], r1[1]}; OUT = *reinterpret_cast<bf16x8*>(&w); } while (0)
  PK4(p0, 0, pa0); PK4(p0, 8, pa1); PK4(p1, 0, pa2); PK4(p1, 8, pa3);
#undef PK4
}
__device__ __forceinline__ void qkt(f32x16& p0, f32x16& p1, const bf16* Ks, const bf16x8* qr, int r32, int hi) {
  p0 = f32x16{}; p1 = f32x16{};
  for (int d0 = 0; d0 < 8; ++d0) { int cb = (d0 * 16 + hi * 8) * 2;
    bf16x8 b0 = *reinterpret_cast<const bf16x8*>((const char*)Ks + KSWZ(r32, cb));
    bf16x8 b1 = *reinterpret_cast<const bf16x8*>((const char*)Ks + KSWZ(32 + r32, cb));
    p0 = __builtin_amdgcn_mfma_f32_32x32x16_bf16(b0, qr[d0], p0, 0, 0, 0);
    p1 = __builtin_amdgcn_mfma_f32_32x32x16_bf16(b1, qr[d0], p1, 0, 0, 0); }
}
__device__ __forceinline__ int v_st(int k, int c) { const int kk = (k & ~0xC) | ((k & 4) << 1) | ((k & 8) >> 1); return ((kk >> 3) * 4 + (c >> 5)) * 512 + ((kk & 7) * 32 + (c & 31)) * 2; }
__device__ __forceinline__ int v_rd_base(int lane) { return ((lane & 3) << 3) | (((lane >> 2) & 3) << 6) | (((lane >> 4) & 1) << 5) | (((lane >> 5) & 1) << 8); }
constexpr int v_rd_off(int d0, int ks, int half) { return d0 * 512 + ks * 4096 + half * 2048; }
template <int OFF> __device__ __forceinline__ s16x4 tr_read(int vb) {
  s16x4 r; asm volatile("ds_read_b64_tr_b16 %0, %1 offset:%2" : "=&v"(r) : "v"(vb), "i"(OFF) : "memory"); return r;
}
template <int D0> __device__ __forceinline__ void pv_one(f32x16& od, int vb, bf16x8 pa0, bf16x8 pa1, bf16x8 pa2, bf16x8 pa3) {
  const s16x4 l0 = tr_read<v_rd_off(D0, 0, 0)>(vb), h0 = tr_read<v_rd_off(D0, 0, 1)>(vb), l1 = tr_read<v_rd_off(D0, 1, 0)>(vb), h1 = tr_read<v_rd_off(D0, 1, 1)>(vb);
  const s16x4 l2 = tr_read<v_rd_off(D0, 2, 0)>(vb), h2 = tr_read<v_rd_off(D0, 2, 1)>(vb), l3 = tr_read<v_rd_off(D0, 3, 0)>(vb), h3 = tr_read<v_rd_off(D0, 3, 1)>(vb);
  asm volatile("s_waitcnt lgkmcnt(0)" ::: "memory"); SBAR();
#define PK(L, H) (bf16x8){L[0], L[1], L[2], L[3], H[0], H[1], H[2], H[3]}
  od = __builtin_amdgcn_mfma_f32_32x32x16_bf16(pa0, PK(l0, h0), od, 0, 0, 0);
  od = __builtin_amdgcn_mfma_f32_32x32x16_bf16(pa1, PK(l1, h1), od, 0, 0, 0);
  od = __builtin_amdgcn_mfma_f32_32x32x16_bf16(pa2, PK(l2, h2), od, 0, 0, 0);
  od = __builtin_amdgcn_mfma_f32_32x32x16_bf16(pa3, PK(l3, h3), od, 0, 0, 0);
#undef PK
}
__device__ __forceinline__ void pv_d0(f32x16* o, int vb, bf16x8 pa0, bf16x8 pa1, bf16x8 pa2, bf16x8 pa3) {
  pv_one<0>(o[0], vb, pa0, pa1, pa2, pa3); pv_one<1>(o[1], vb, pa0, pa1, pa2, pa3); pv_one<2>(o[2], vb, pa0, pa1, pa2, pa3); pv_one<3>(o[3], vb, pa0, pa1, pa2, pa3);
}

template <typename TQ>
__device__ __forceinline__ void attn_dense_body(const TQ* __restrict__ Qb, const bf16* __restrict__ Kh, const bf16* __restrict__ Vh,
                                                bf16* __restrict__ Ob, int seq, char* lds, float mC) {
  using St = Stage<bf16>; using SQ = Stage<TQ>;
  int tid_ = threadIdx.x; asm volatile("" : "+v"(tid_));
  const int tid = tid_, wid = tid >> 6, lane = tid & 63, r32 = lane & 31, hi = lane >> 5;
  bf16* V_lds = (bf16*)lds; bf16* K_lds = (bf16*)(lds + 2 * SHM_V);
  float* ws = (float*)(lds + 2 * SHM_V + 2 * SHM_K) + wid * 64; float* li_l = ws;
  float l_reg = 0; f32x16 o[4] = {}; bf16x8 qr[8];
  const TQ* Qw = Qb + (long)(wid * QBLK + r32) * LDQ + hi * 8;
#pragma unroll
  for (int d0 = 0; d0 < 8; ++d0) qr[d0] = SQ::tobf(SQ::ld8(Qw + d0 * 16));
  const int sr = tid >> 4, sc = (tid & 15) * 8, vst0 = v_st(sr, sc), vst1 = v_st(32 + sr, sc);
  const int vb0 = (int)(uintptr_t)V_lds + v_rd_base(lane);
  struct { typename St::T vs0, vs1, ks0, ks1; } sr_[SDEPTH];
#define SLOAD(i, k0) do { sr_[i].vs0 = St::ld8(&Vh[(long)((k0) + sr) * LDK + sc]); sr_[i].vs1 = St::ld8(&Vh[(long)((k0) + 32 + sr) * LDK + sc]); \
    sr_[i].ks0 = St::ld8(&Kh[(long)((k0) + sr) * LDK + sc]); sr_[i].ks1 = St::ld8(&Kh[(long)((k0) + 32 + sr) * LDK + sc]); } while (0)
#define SWRITE(b, i) do { *(bf16x8*)((char*)V_lds + (b) * SHM_V + vst0) = St::tobf(sr_[i].vs0);          \
    *(bf16x8*)((char*)V_lds + (b) * SHM_V + vst1) = St::tobf(sr_[i].vs1); int kc = sc * 2;               \
    *(bf16x8*)((char*)K_lds + (b) * SHM_K + KSWZ(sr, kc)) = St::tobf(sr_[i].ks0);                       \
    *(bf16x8*)((char*)K_lds + (b) * SHM_K + KSWZ(32 + sr, kc)) = St::tobf(sr_[i].ks1); } while (0)
#define SWAIT() do { if constexpr (SDEPTH == 2) asm volatile("s_waitcnt vmcnt(4)" ::: "memory"); else asm volatile("s_waitcnt vmcnt(0)" ::: "memory"); } while (0)
  f32x16 pA0, pA1, pB0, pB1; bf16x8 pa0, pa1, pa2, pa3; const int NT = seq / KVBLK;
  constexpr int SE = 0, SO = SDEPTH - 1;
  SLOAD(SE, 0); asm volatile("s_waitcnt vmcnt(0)" ::: "memory"); SWRITE(0, SE); __syncthreads();
  qkt(pA0, pA1, K_lds, qr, r32, hi); partialSM(pA0, pA1, mC);
  SLOAD(SO, KVBLK); if constexpr (SDEPTH == 2) { if (2 < NT) SLOAD(SE, 2 * KVBLK); }
  SWAIT(); SWRITE(1, SO); __syncthreads();
  for (int j = 1; j + 1 < NT; j += 2) {
    SBAR(); qkt(pB0, pB1, (bf16*)((char*)K_lds + SHM_K), qr, r32, hi);
    finishSM(pA0, pA1, l_reg, pa0, pa1, pa2, pa3); SBAR();
    SLOAD(SO, (j + SDEPTH) * KVBLK); SBAR();
    pv_d0(o, vb0, pa0, pa1, pa2, pa3); partialSM(pB0, pB1, mC);
    __syncthreads(); SWAIT(); SWRITE(0, SE);
    __syncthreads();
    SBAR(); qkt(pA0, pA1, K_lds, qr, r32, hi);
    finishSM(pB0, pB1, l_reg, pa0, pa1, pa2, pa3); SBAR();
    if (SDEPTH == 1 || j + 3 < NT) SLOAD(SE, (j + 1 + SDEPTH) * KVBLK); SBAR();
    pv_d0(o, vb0 + (int)SHM_V, pa0, pa1, pa2, pa3); partialSM(pA0, pA1, mC);
    __syncthreads(); SWAIT(); SWRITE(1, SO);
    __syncthreads();
  }
  SBAR(); qkt(pB0, pB1, (bf16*)((char*)K_lds + SHM_K), qr, r32, hi);
  finishSM(pA0, pA1, l_reg, pa0, pa1, pa2, pa3); SBAR();
  pv_d0(o, vb0, pa0, pa1, pa2, pa3); partialSM(pB0, pB1, mC);
  __syncthreads();
  finishSM(pB0, pB1, l_reg, pa0, pa1, pa2, pa3); SBAR();
  pv_d0(o, vb0 + (int)SHM_V, pa0, pa1, pa2, pa3);
  { auto rr = __builtin_amdgcn_permlane32_swap(__float_as_uint(l_reg), __float_as_uint(l_reg), false, false); l_reg = __uint_as_float(rr[0]) + __uint_as_float(rr[1]); }
  if (hi == 0) li_l[r32] = l_reg; asm volatile("s_waitcnt lgkmcnt(0)" ::: "memory");
  float rli[16];
#pragma unroll
  for (int r = 0; r < 16; ++r) rli[r] = __builtin_amdgcn_rcpf(li_l[crow(r, hi)]);
  bf16* Ow = Ob + (long)(wid * QBLK) * LDO;
#pragma unroll
  for (int r = 0; r < 16; ++r) { int orow = crow(r, hi);
    for (int d0 = 0; d0 < 4; ++d0) Ow[(long)orow * LDO + d0 * 32 + r32] = __float2bfloat16(o[d0][r] * rli[r]); }
  __syncthreads();
#undef SLOAD
#undef SWRITE
#undef SWAIT
}
#undef KSWZ
#undef SBAR
}

struct Frame {
    LAS unsigned char* lds;
    char* ldsg;
    int tid, lane, wave, vcu, G;
    unsigned char* ws;
};
__device__ __forceinline__ const float* frame_in(const Frame& F, int i) {
    const LAS unsigned* p = (const LAS unsigned*)(F.lds + LDSCTL_OFF + 64) + 2 * i;
    const unsigned lo = __builtin_amdgcn_readfirstlane(p[0]), hi = __builtin_amdgcn_readfirstlane(p[1]);
    return (const float*)(const GAS float*)(((unsigned long long)hi << 32) | lo);
}
#define FIN(i) frame_in(F, (i))
#define FOUT() ((float*)frame_in(F, 17))
#define WSP(T, off) ((T*)(F.ws + (off)))

__device__ __forceinline__ void p0_transpose_item(const float* W, int K, int N, int Npad, bf16_t* WT, int row_off, LAS float* scr, int item, int lane, const float* kscale = nullptr) {
    const int nblk = Npad / 32, kb = item / nblk, nb = item % nblk, k0 = 64 * kb, n0 = 32 * nb;
    const int nn = n0 + 4 * (lane & 7);
    f32x4 v[8];
#pragma unroll
    for (int i = 0; i < 8; ++i) { const int kk = 8 * i + (lane >> 3); v[i] = nn < N ? *(const f32x4*)(W + (size_t)(k0 + kk) * N + nn) : (f32x4){0.f, 0.f, 0.f, 0.f}; }
#pragma unroll
    for (int i = 0; i < 8; ++i) { const int kk = 8 * i + (lane >> 3); *(LAS f32x4*)(scr + kk * 36 + 4 * (lane & 7)) = v[i]; }
    LDS_WAIT(); asm volatile("" ::: "memory");
    const int c = lane & 7;
    f32x4 ka = {1.f, 1.f, 1.f, 1.f}, kc = ka; if (kscale) { ka = *(const f32x4*)(kscale + k0 + 8 * c); kc = *(const f32x4*)(kscale + k0 + 8 * c + 4); }
#pragma unroll
    for (int j = 0; j < 4; ++j) { const int n = (lane >> 3) + 8 * j; const LAS float* s = scr + (8 * c) * 36 + n;
        u32x4 o; o.x = pk2(s[0 * 36] * ka.x, s[1 * 36] * ka.y); o.y = pk2(s[2 * 36] * ka.z, s[3 * 36] * ka.w); o.z = pk2(s[4 * 36] * kc.x, s[5 * 36] * kc.y); o.w = pk2(s[6 * 36] * kc.z, s[7 * 36] * kc.w);
        *(GAS u32x4*)(WT + (size_t)(row_off + n0 + n) * K + k0 + 8 * c) = o; }
    LDS_WAIT(); asm volatile("" ::: "memory");
}
__device__ __forceinline__ u32x4 cvt8(const float* p) {
    const f32x4 a = *(const f32x4*)p, b = *(const f32x4*)(p + 4);
    u32x4 o; o.x = pk2(a.x, a.y); o.y = pk2(a.z, a.w); o.z = pk2(b.x, b.y); o.w = pk2(b.z, b.w); return o;
}
__device__ __forceinline__ void rms_row_to_bf16(const float* xrow, const float* g, bf16_t* orow, int lane) {
    const f32x4* xr = (const f32x4*)xrow + lane;
    f32x4 v[8]; float s = 0.f;
#pragma unroll
    for (int j = 0; j < 8; ++j) { v[j] = xr[64 * j]; s += (v[j].x * v[j].x + v[j].y * v[j].y) + (v[j].z * v[j].z + v[j].w * v[j].w); }
    const float r = 1.0f / sqrtf(wave_sum(s) * (1.f / DM) + EPS);
    u32x2* o8 = (u32x2*)orow + lane;
#pragma unroll
    for (int j = 0; j < 8; ++j) { const f32x4 gg = ((const f32x4*)g)[lane + 64 * j]; u32x2 w; w.x = pk2(v[j].x * r * gg.x, v[j].y * r * gg.y); w.y = pk2(v[j].z * r * gg.z, v[j].w * r * gg.w); o8[64 * j] = w; }
}
__device__ __forceinline__ void ph_prologue(const Frame& F) {
    LAS float* scr = (LAS float*)(F.lds + F.wave * 16384);
    const int gw = F.vcu * NWAVES + F.wave, NGW = F.G * NWAVES;
#if TBL_FP4
    const float* gff = FIN(2) + F.lane * 4; const float* tsrc0 = FIN(14) + F.lane * 4; const float* tsrc1 = FIN(15) + F.lane * 4;
    for (int row = gw; row < 4 * 16384; row += NGW) {
        const int tb = row >> 15, rr = row & 32767;
        const float* src = (tb ? tsrc1 : tsrc0) + (size_t)rr * DM;
        f32x4 v[8]; float am = 0.f;
#pragma unroll
        for (int q = 0; q < 8; ++q) v[q] = *(const f32x4*)(src + 256 * q);
        if (tb == 0) {
#pragma unroll
            for (int q = 0; q < 8; ++q) v[q] = v[q] * *(const f32x4*)(gff + (rr >> 14) * DM + 256 * q); }
#pragma unroll
        for (int q = 0; q < 8; ++q) am = fmaxf(am, fmaxf(fmaxf(fabsf(v[q].x), fabsf(v[q].y)), fmaxf(fabsf(v[q].z), fabsf(v[q].w))));
#pragma unroll
        for (int o = 1; o < 64; o <<= 1) am = fmaxf(am, __shfl_xor(am, o));
        unsigned char* dst = F.ws + (tb ? WS_VB : WS_UB) + (size_t)(rr >> 14) * (16384 * 1024) + (size_t)(rr & 16383) * 128 + F.lane * 2;
        float sc;
        if (tb == 0) {
            float sq = 0.f;
#pragma unroll
            for (int q = 0; q < 8; ++q) sq += (v[q].x * v[q].x + v[q].y * v[q].y) + (v[q].z * v[q].z + v[q].w * v[q].w);
            sq = wave_sum(sq); sc = sq > 0.f ? 0.36f * sqrtf(sq * (1.f / DM)) : 1.f; const float isc = 1.0f / sc;
#pragma unroll
            for (int q = 0; q < 8; ++q) { const f32x4 z = v[q] * isc; int n[4];
#pragma unroll
                for (int e = 0; e < 4; ++e) n[e] = (int)fminf(fmaxf(rintf(z[e]), -7.f), 7.f) & 15;
                *(unsigned short*)(dst + (size_t)q * (16384 * 128)) = (unsigned short)(n[0] | (n[1] << 4) | (n[2] << 8) | (n[3] << 12)); }
        } else {
            sc = am > 0.f ? am * (1.f / 6.f) : 1.f; const float isc = 1.0f / sc;
#pragma unroll
            for (int q = 0; q < 8; ++q) { unsigned p = 0u;
                p = __builtin_amdgcn_cvt_scalef32_pk_fp4_f32(p, v[q].x * isc, v[q].y * isc, 1.0f, 0); p = __builtin_amdgcn_cvt_scalef32_pk_fp4_f32(p, v[q].z * isc, v[q].w * isc, 1.0f, 1);
                *(unsigned short*)(dst + (size_t)q * (16384 * 128)) = (unsigned short)p; }
        }
        if (F.lane == 0) ((float*)(F.ws + WS_TSC))[row] = sc;
    }
#else
    for (int row = gw; row < 4 * 16384; row += NGW) {
        const int tb = row >> 15, rr = row & 32767;
        const float* src = FIN(14 + tb) + (size_t)rr * DM + F.lane * 16;
        f32x4 v[8]; float am = 0.f;
#pragma unroll
        for (int q = 0; q < 8; ++q) { v[q] = *(const f32x4*)(src + (q >> 2) * 1024 + (q & 3) * 4);
            am = fmaxf(am, fmaxf(fmaxf(fabsf(v[q].x), fabsf(v[q].y)), fmaxf(fabsf(v[q].z), fabsf(v[q].w)))); }
#pragma unroll
        for (int o = 1; o < 64; o <<= 1) am = fmaxf(am, __shfl_xor(am, o));
        const float sc = am > 0.f ? am * (1.f / 448.f) : 1.f, isc = 1.0f / sc;
        unsigned w[8];
#pragma unroll
        for (int q = 0; q < 8; ++q) { unsigned p = __builtin_amdgcn_cvt_pk_fp8_f32(v[q].x * isc, v[q].y * isc, 0u, false); w[q] = __builtin_amdgcn_cvt_pk_fp8_f32(v[q].z * isc, v[q].w * isc, p, true); }
        unsigned char* dst = F.ws + (tb ? WS_VB : WS_UB) + (size_t)(rr >> 14) * (16384 * 2048) + ((size_t)(F.lane >> 3) * 16384 + (rr & 16383)) * 128 + (F.lane & 7) * 16;
        *(u32x4*)dst = (u32x4){w[0], w[1], w[2], w[3]}; *(u32x4*)(dst + (size_t)8 * 16384 * 128) = (u32x4){w[4], w[5], w[6], w[7]};
        if (F.lane == 0) ((float*)(F.ws + WS_TSC))[row] = sc;
    }
#endif
    {   constexpr int I_IN = (DM / 64) * (INP / 32), I_SQ = (DM / 64) * (DM / 32), I_PL = 4 * (512 / 64) * (512 / 32);
        constexpr int NIT = I_IN + 3 * I_SQ + I_PL;
        for (int it = gw; it < NIT; it += NGW) {
            int r = it;
            if (r < I_IN) { p0_transpose_item(FIN(3), DM, INW, INP, WSP(bf16_t, WS_WIN), 0, scr, r, F.lane); continue; } r -= I_IN;
            if (r < I_SQ) { p0_transpose_item(FIN(9), DM, DM, DM, WSP(bf16_t, WS_WOUT), 0, scr, r, F.lane); continue; } r -= I_SQ;
            if (r < I_SQ) { p0_transpose_item(FIN(12), DM, DM, DM, WSP(bf16_t, WS_WQ0), 0, scr, r, F.lane, FIN(2)); continue; } r -= I_SQ;
            if (r < I_SQ) { p0_transpose_item(FIN(12) + (size_t)DM * DM, DM, DM, DM, WSP(bf16_t, WS_WQ1), 0, scr, r, F.lane, FIN(2) + DM); continue; } r -= I_SQ;
            const int grp = r / 128, ri = r % 128;
            p0_transpose_item(FIN(10) + (size_t)grp * 512 * 512, 512, 512, 512, WSP(bf16_t, WS_WPOOL), grp * 512, scr, ri, F.lane);
        }
    }
    for (int it = gw; it < 1024; it += NGW) *(u32x4*)(WSP(bf16_t, WS_KEYS) + (size_t)it * 512 + F.lane * 8) = cvt8(FIN(13) + (size_t)it * 512 + F.lane * 8);
    for (int m = gw; m < S; m += NGW) rms_row_to_bf16(FIN(0) + (size_t)m * DM, FIN(1), WSP(bf16_t, WS_XN) + (size_t)m * DM, F.lane);
}

__device__ __forceinline__ float silu_f(float z) { return z / (1.f + __expf(-z)); }
__device__ __forceinline__ void p2_qkv_token(const Frame& F, int t) {
    const int lane = F.lane, i8 = lane & 7;
    const bf16_t* pr = WSP(bf16_t, WS_PROJ) + (size_t)t * INP;
    const int axis = i8 >> 2, half = (i8 >> 1) & 1, f0 = (i8 & 1) * 16;
    const float pos = (float)(axis == 0 ? (t >> 6) : (t & 63));
    float cs[16], sn[16];
#pragma unroll
    for (int e = 0; e < 16; ++e) { const float inv = exp2f(-(float)(f0 + e) * (13.287712379549449f / 32.f));
        float rev = pos * inv * 0.15915494309189535f; rev -= rintf(rev);
        cs[e] = __builtin_amdgcn_cosf(rev); sn[e] = __builtin_amdgcn_sinf(rev); }
    const float sgn = half ? 1.f : -1.f;
    {   const u32x4 w0 = *(const u32x4*)(pr + C_AQ + lane * 16), w1 = *(const u32x4*)(pr + C_AQ + lane * 16 + 8);
        float v[16]; const unsigned ww[8] = {w0.x, w0.y, w0.z, w0.w, w1.x, w1.y, w1.z, w1.w};
#pragma unroll
        for (int e = 0; e < 8; ++e) { v[2 * e] = bflo(ww[e]); v[2 * e + 1] = bfhi(ww[e]); }
        float ss = 0.f;
#pragma unroll
        for (int e = 0; e < 16; ++e) ss += v[e] * v[e];
        ss += __shfl_xor(ss, 1); ss += __shfl_xor(ss, 2); ss += __shfl_xor(ss, 4);
        const float r = 1.0f / sqrtf(ss * (1.f / 128.f) + EPS);
        const float* gq = FIN(6) + i8 * 16;
        unsigned ow[8];
        float y[16];
#pragma unroll
        for (int e = 0; e < 16; ++e) y[e] = v[e] * r * gq[e];
#pragma unroll
        for (int e = 0; e < 16; ++e) { const float yp = __shfl_xor(y[e], 2); y[e] = y[e] * cs[e] + sgn * yp * sn[e]; }
#pragma unroll
        for (int e = 0; e < 8; ++e) ow[e] = pk2(y[2 * e], y[2 * e + 1]);
        bf16_t* dst = WSP(bf16_t, WS_QB) + (size_t)t * 1024 + lane * 16;
        *(u32x4*)dst = (u32x4){ow[0], ow[1], ow[2], ow[3]}; *(u32x4*)(dst + 8) = (u32x4){ow[4], ow[5], ow[6], ow[7]};
    }
    {   const int l16 = lane & 15;
        const u32x4 w0 = *(const u32x4*)(pr + C_AK + l16 * 16), w1 = *(const u32x4*)(pr + C_AK + l16 * 16 + 8);
        float v[16]; const unsigned ww[8] = {w0.x, w0.y, w0.z, w0.w, w1.x, w1.y, w1.z, w1.w};
#pragma unroll
        for (int e = 0; e < 8; ++e) { v[2 * e] = bflo(ww[e]); v[2 * e + 1] = bfhi(ww[e]); }
        float ss = 0.f;
#pragma unroll
        for (int e = 0; e < 16; ++e) ss += v[e] * v[e];
        ss += __shfl_xor(ss, 1); ss += __shfl_xor(ss, 2); ss += __shfl_xor(ss, 4);
        const float r = 1.0f / sqrtf(ss * (1.f / 128.f) + EPS);
        const float* gk = FIN(7) + i8 * 16;
        float y[16]; unsigned ow[8];
#pragma unroll
        for (int e = 0; e < 16; ++e) y[e] = v[e] * r * gk[e];
#pragma unroll
        for (int e = 0; e < 16; ++e) { const float yp = __shfl_xor(y[e], 2); y[e] = y[e] * cs[e] + sgn * yp * sn[e]; }
#pragma unroll
        for (int e = 0; e < 8; ++e) ow[e] = pk2(y[2 * e], y[2 * e + 1]);
        bf16_t* kv = WSP(bf16_t, WS_KVB) + (size_t)t * 512;
        if (lane < 16) { *(u32x4*)(kv + lane * 16) = (u32x4){ow[0], ow[1], ow[2], ow[3]}; *(u32x4*)(kv + lane * 16 + 8) = (u32x4){ow[4], ow[5], ow[6], ow[7]}; }
        else if (lane < 32) { const u32x4 a = *(const u32x4*)(pr + C_AV + l16 * 16), b = *(const u32x4*)(pr + C_AV + l16 * 16 + 8);
            *(u32x4*)(kv + 256 + l16 * 16) = a; *(u32x4*)(kv + 256 + l16 * 16 + 8) = b; }
    }
}
__device__ __forceinline__ void p2_conv_item(const Frame& F, int item) {
    const int tb = item >> 2, sl = item & 3, lane = F.lane, c = sl * 512 + lane * 8, t0 = tb * 16;
    float w[5][8];
#pragma unroll
    for (int j = 0; j < 5; ++j) { const f32x4 a = *(const f32x4*)(FIN(5) + j * 2048 + c), b = *(const f32x4*)(FIN(5) + j * 2048 + c + 4);
        w[j][0] = a.x; w[j][1] = a.y; w[j][2] = a.z; w[j][3] = a.w; w[j][4] = b.x; w[j][5] = b.y; w[j][6] = b.z; w[j][7] = b.w; }
    const bf16_t* src = WSP(bf16_t, WS_PROJ) + C_MQK + c;
    const float osc = (c >= 1024) ? 0.0625f : 1.f;
    bf16_t* dst = (c >= 1024) ? WSP(bf16_t, WS_MK) + (c - 1024) : WSP(bf16_t, WS_MQ) + c;
    u32x4 rows[20];
#pragma unroll
    for (int j = 0; j < 20; ++j) { const int tt = t0 - 2 + j; rows[j] = (tt >= 0 && tt < S) ? *(const u32x4*)(src + (size_t)tt * INP) : (u32x4){0u, 0u, 0u, 0u}; }
#pragma unroll
    for (int q = 0; q < 16; ++q) {
        float acc[8];
#pragma unroll
        for (int e = 0; e < 8; ++e) acc[e] = 0.f;
#pragma unroll
        for (int j = 0; j < 5; ++j) { const unsigned ww[4] = {rows[q + j].x, rows[q + j].y, rows[q + j].z, rows[q + j].w};
#pragma unroll
            for (int e = 0; e < 4; ++e) { acc[2 * e] += bflo(ww[e]) * w[j][2 * e]; acc[2 * e + 1] += bfhi(ww[e]) * w[j][2 * e + 1]; } }
        u32x4 o; o.x = pk2(silu_f(acc[0]) * osc, silu_f(acc[1]) * osc); o.y = pk2(silu_f(acc[2]) * osc, silu_f(acc[3]) * osc);
        o.z = pk2(silu_f(acc[4]) * osc, silu_f(acc[5]) * osc); o.w = pk2(silu_f(acc[6]) * osc, silu_f(acc[7]) * osc);
        *(u32x4*)(dst + (size_t)(t0 + q) * 1024) = o;
    }
}
__device__ __forceinline__ float wave_incl_scan_add(float v, int lane) {
#pragma unroll
    for (int o = 1; o < 64; o <<= 1) { const float u = __shfl_up(v, o); if (lane >= o) v += u; }
    return v;
}
__device__ __forceinline__ float wave_incl_scan_max(float v, int lane) {
#pragma unroll
    for (int o = 1; o < 64; o <<= 1) { const float u = __shfl_up(v, o); if (lane >= o) v = fmaxf(v, u); }
    return v;
}
__device__ __forceinline__ float logsigmoid_f(float x) { return fminf(x, 0.f) - log1pf(__expf(-fabsf(x))); }
__device__ __forceinline__ void p2_gate_item(const Frame& F, int item) {
    const int dh = item >> 7, c = item & 127, dir = dh >> 2, h = dh & 3, lane = F.lane;
    const int p0 = 128 * c + 2 * lane, t0 = dir ? (S - 1 - p0) : p0, t1 = dir ? (t0 - 1) : (t0 + 1);
    const bf16_t* pg = WSP(bf16_t, WS_PROJ) + C_GATE + dir * 8 + h;
    const float bi = FIN(4)[dir * 8 + h], bf = FIN(4)[dir * 8 + 4 + h];
    const float i0 = bflo((unsigned)pg[(size_t)t0 * INP]) + bi, f0 = bflo((unsigned)pg[(size_t)t0 * INP + 4]) + bf;
    const float i1 = bflo((unsigned)pg[(size_t)t1 * INP]) + bi, f1 = bflo((unsigned)pg[(size_t)t1 * INP + 4]) + bf;
    const float lf0 = logsigmoid_f(f0), lf1 = logsigmoid_f(f1);
    const float incl = wave_incl_scan_add(lf0 + lf1, lane);
    const float b1 = incl, b0 = incl - lf1;
    const float u0 = i0 - b0, u1 = i1 - b1;
    const float mincl = wave_incl_scan_max(fmaxf(u0, u1), lane);
    float mprevl = __shfl_up(mincl, 1); if (lane == 0) mprevl = -INFINITY;
    const float pm0 = fmaxf(mprevl, u0), pm1 = mincl;
    float* GB = (float*)(F.ws + WS_GATES + GO_B) + (size_t)dh * S; float* GU = (float*)(F.ws + WS_GATES + GO_U) + (size_t)dh * S; float* GPM = (float*)(F.ws + WS_GATES + GO_PM) + (size_t)dh * S;
    GB[t0] = b0; GB[t1] = b1; GU[t0] = u0; GU[t1] = u1; GPM[t0] = pm0; GPM[t1] = pm1;
    if (lane == 63) { ((float*)(F.ws + WS_GATES + GO_G))[dh * 128 + c] = b1; ((float*)(F.ws + WS_GATES + GO_PML))[dh * 128 + c] = pm1; }
}
__device__ __forceinline__ void ph_post(const Frame& F) {
    const int gw = F.vcu * NWAVES + F.wave, NGW = F.G * NWAVES;
    for (int it = gw; it < 1024; it += NGW) p2_gate_item(F, it);
    for (int it = gw; it < 4096; it += NGW) p2_conv_item(F, it);
    for (int t = gw; t < S; t += NGW) p2_qkv_token(F, t);
}

#define MFMA16(a, b, c) __builtin_amdgcn_mfma_f32_16x16x32_bf16((a), (b), (c), 0, 0, 0)
__device__ __forceinline__ bf16x8 frag_tr(LAS const unsigned char* base, int pitch, int k0, int x0, int lane) {
    const int g = lane >> 4, i = lane & 15;
    LAS const unsigned char* p = base + (k0 + 8 * g + (i >> 2)) * pitch + (x0 + 4 * (i & 3)) * 2;
    const s16x4 lo = __builtin_bit_cast(s16x4, __builtin_amdgcn_ds_read_tr16_b64_v4i16((LAS v4i16_t*)p));
    const s16x4 hi = __builtin_bit_cast(s16x4, __builtin_amdgcn_ds_read_tr16_b64_v4i16((LAS v4i16_t*)(p + 4 * pitch)));
    return (bf16x8){lo[0], lo[1], lo[2], lo[3], hi[0], hi[1], hi[2], hi[3]};
}
__device__ __forceinline__ bf16x8 frag_kc(LAS const unsigned char* base, int pitch, int x0, int k0, int lane) {
    return *(LAS const bf16x8*)(base + (x0 + (lane & 15)) * pitch + (k0 + 8 * (lane >> 4)) * 2);
}

constexpr int MLA_PK = 544, MLA_PV = 288;
constexpr int MLA_OFF_V = 128 * MLA_PK;
__device__ __forceinline__ void ph_mla(const Frame& F) {
    const int tid = F.tid, lane = F.lane, wave = F.wave;
    LAS unsigned char* Kw = F.lds; LAS unsigned char* Vs = F.lds + MLA_OFF_V;
    const float* GU = (const float*)(F.ws + WS_GATES + GO_U); const float* GPML = (const float*)(F.ws + WS_GATES + GO_PML);
    for (int item = F.vcu; item < 2048; item += F.G) {
        const int hv = item & 1, c = (item >> 1) & 127, dh = item >> 8, dir = dh >> 2, head = dh & 3;
        const int tc = dir ? 127 - c : c, t0 = tc * 128;
        const float pml = GPML[dh * 128 + c];
        {   const bf16_t* mk = WSP(bf16_t, WS_MK) + (size_t)t0 * 1024 + head * 256;
#pragma unroll
            for (int j = 0; j < 8; ++j) { const int r = (tid >> 5) + 16 * j, c8 = (tid & 31) * 8;
                const u32x4 x = *(const u32x4*)(mk + (size_t)r * 1024 + c8); const float w = __expf(GU[(size_t)dh * S + t0 + r] - pml);
                u32x4 o; o.x = pk2(bflo(x.x) * w, bfhi(x.x) * w); o.y = pk2(bflo(x.y) * w, bfhi(x.y) * w); o.z = pk2(bflo(x.z) * w, bfhi(x.z) * w); o.w = pk2(bflo(x.w) * w, bfhi(x.w) * w);
                *(LAS u32x4*)(Kw + r * MLA_PK + c8 * 2) = o; }
            const bf16_t* mv = WSP(bf16_t, WS_PROJ) + (size_t)t0 * INP + C_MV + head * 256 + hv * 128;
#pragma unroll
            for (int j = 0; j < 4; ++j) { const int r = (tid >> 4) + 32 * j, c8 = (tid & 15) * 8;
                *(LAS u32x4*)(Vs + r * MLA_PV + c8 * 2) = *(const u32x4*)(mv + (size_t)r * INP + c8); }
        }
        __syncthreads();
        f32x4 acc[4][4];
#pragma unroll
        for (int a = 0; a < 4; ++a)
#pragma unroll
            for (int b = 0; b < 4; ++b) acc[a][b] = (f32x4){0.f, 0.f, 0.f, 0.f};
        const int mb = (wave & 3) * 64, nb = (wave >> 2) * 64;
#pragma unroll
        for (int ks = 0; ks < 4; ++ks) {
            bf16x8 af[4], bfr[4];
#pragma unroll
            for (int a = 0; a < 4; ++a) af[a] = frag_tr(Kw, MLA_PK, 32 * ks, mb + 16 * a, lane);
#pragma unroll
            for (int b = 0; b < 4; ++b) bfr[b] = frag_tr(Vs, MLA_PV, 32 * ks, nb + 16 * b, lane);
#pragma unroll
            for (int a = 0; a < 4; ++a)
#pragma unroll
                for (int b = 0; b < 4; ++b) acc[a][b] = MFMA16(af[a], bfr[b], acc[a][b]);
        }
        {   bf16_t* cst = WSP(bf16_t, WS_CST) + ((size_t)(dh * 128 + c) << 16);
            const int g = lane >> 4, i = lane & 15;
#pragma unroll
            for (int a = 0; a < 4; ++a)
#pragma unroll
                for (int b = 0; b < 4; ++b) { u32x2 o; o.x = pk2(acc[a][b][0], acc[a][b][1]); o.y = pk2(acc[a][b][2], acc[a][b][3]);
                    *(u32x2*)(cst + (size_t)(hv * 128 + nb + 16 * b + i) * 256 + mb + 16 * a + 4 * g) = o; }
        }
        if (hv == 0 && tid < 256) { float s = 0.f;
#pragma unroll 8
            for (int r = 0; r < 128; ++r) s += bflo((unsigned)*(LAS const bf16_t*)(Kw + r * MLA_PK + tid * 2));
            ((float*)(F.ws + WS_NST))[(size_t)(dh * 128 + c) * 256 + tid] = s; }
        __syncthreads();
    }
}

__device__ __forceinline__ void ph_scan(const Frame& F) {
    const float* GG = (const float*)(F.ws + WS_GATES + GO_G); const float* GPML = (const float*)(F.ws + WS_GATES + GO_PML); float* MPREV = (float*)(F.ws + WS_GATES + GO_MPREV);
    const int nthreads = F.G * NTHR;
    for (int gi = F.vcu * NTHR + F.tid; gi < 8 * 16384; gi += nthreads) {
        const int dh = gi >> 14, e4 = gi & 16383;
        bf16_t* base = WSP(bf16_t, WS_CST) + ((size_t)dh * 128 << 16) + e4 * 4;
        float st0 = 0.f, st1 = 0.f, st2 = 0.f, st3 = 0.f, m = 0.f;
#pragma unroll 1
        for (int c0 = 0; c0 < 128; c0 += 32) {
            u32x2 ld[32];
#pragma unroll
            for (int q = 0; q < 32; ++q) ld[q] = *(const u32x2*)(base + ((size_t)(c0 + q) << 16));
#pragma unroll
            for (int q = 0; q < 32; ++q) { const int c = c0 + q;
                const float g = GG[dh * 128 + c], amax = g + GPML[dh * 128 + c];
                const float mn = fmaxf(g + m, amax), dec = __expf(g + m - mn), add = __expf(amax - mn);
                if (e4 == 0) MPREV[dh * 128 + c] = m;
                u32x2 o; o.x = pk2(st0, st1); o.y = pk2(st2, st3);
                *(u32x2*)(base + ((size_t)c << 16)) = o;
                st0 = dec * st0 + add * bflo(ld[q].x); st1 = dec * st1 + add * bfhi(ld[q].x); st2 = dec * st2 + add * bflo(ld[q].y); st3 = dec * st3 + add * bfhi(ld[q].y);
                m = mn; }
        }
    }
    for (int gi = F.vcu * NTHR + F.tid; gi < 8 * 256; gi += nthreads) {
        const int dh = gi >> 8, e = gi & 255;
        float* base = (float*)(F.ws + WS_NST) + (size_t)dh * 128 * 256 + e;
        float st = 0.f, m = 0.f;
#pragma unroll 4
        for (int c = 0; c < 128; ++c) {
            const float g = GG[dh * 128 + c], amax = g + GPML[dh * 128 + c];
            const float mn = fmaxf(g + m, amax), dec = __expf(g + m - mn), add = __expf(amax - mn);
            const float ld = base[c * 256]; base[c * 256] = st; st = dec * st + add * ld; m = mn; }
    }
}

constexpr int MLB_PIECE = 34816;
constexpr int MLB_PKC = 528, MLB_PTR = 544, MLB_PP = 272;
constexpr int MLB_OFF_P = 2 * MLB_PIECE;
constexpr int MLB_OFF_N = MLB_OFF_P + 2 * 8 * 16 * MLB_PP;
static_assert(MLB_OFF_N + 2048 <= LDSCTL_OFF, "mLSTM-B LDS map");
__device__ __forceinline__ void ph_mlb(const Frame& F) {
    const int wave = F.wave;
    const float* GB = (const float*)(F.ws + WS_GATES + GO_B); const float* GU = (const float*)(F.ws + WS_GATES + GO_U); const float* GPM = (const float*)(F.ws + WS_GATES + GO_PM);
    const float* MPREV = (const float*)(F.ws + WS_GATES + GO_MPREV);
    LAS unsigned char* buf0 = F.lds; LAS unsigned char* buf1 = F.lds + MLB_PIECE;
    LAS float* nprev = (LAS float*)(F.lds + MLB_OFF_N);
    for (int unit = F.vcu; unit < 512; unit += F.G) {
        int tid = F.tid; asm volatile("" : "+v"(tid));
        const int lane = tid & 63, g = lane >> 4, i = lane & 15;
        const int head = unit >> 7, tc = unit & 127, t0 = tc * 128, j0 = 16 * wave;
        const bf16_t* mkp = WSP(bf16_t, WS_MK) + (size_t)t0 * 1024 + head * 256;
        const bf16_t* mvp = WSP(bf16_t, WS_PROJ) + (size_t)t0 * INP + C_MV + head * 256;
        const int c_f = tc, c_b = 127 - tc;
        u32x4 stg[4];
        const int sr = tid >> 5, sc8 = (tid & 31) * 8;
#define PIECE_LOAD(srcp, pitch_el) do { _Pragma("unroll") for (int q_ = 0; q_ < 4; ++q_) stg[q_] = *(const u32x4*)((srcp) + (size_t)(sr + 16 * q_) * (pitch_el) + sc8); } while (0)
#define PIECE_WRITE(dstbuf, pitchB) do { _Pragma("unroll") for (int q_ = 0; q_ < 4; ++q_) *(LAS u32x4*)((dstbuf) + (sr + 16 * q_) * (pitchB) + sc8 * 2) = stg[q_]; } while (0)
        { const int d = tid >> 8, e = tid & 255; nprev[d * 256 + e] = ((const float*)(F.ws + WS_NST))[(size_t)((d * 4 + head) * 128 + (d ? c_b : c_f)) * 256 + e]; }
        bf16x8 qa[8];
        {   const bf16_t* mq = WSP(bf16_t, WS_MQ) + (size_t)(t0 + j0 + i) * 1024 + head * 256 + 8 * g;
#pragma unroll
            for (int s = 0; s < 8; ++s) qa[s] = *(const bf16x8*)(mq + 32 * s); }
        f32x4 sacc[8];
#pragma unroll
        for (int n = 0; n < 8; ++n) sacc[n] = (f32x4){0.f, 0.f, 0.f, 0.f};
        PIECE_LOAD(mkp, 1024); PIECE_WRITE(buf0, MLB_PKC);
        PIECE_LOAD(mkp + (size_t)64 * 1024, 1024);
        __syncthreads();
#pragma unroll
        for (int n = 0; n < 4; ++n)
            { _Pragma("unroll") for (int s = 0; s < 8; ++s) sacc[n] = MFMA16(qa[s], frag_kc(buf0, MLB_PKC, 16 * n, 32 * s, lane), sacc[n]); __builtin_amdgcn_sched_barrier(0); }
        PIECE_WRITE(buf1, MLB_PKC);
        __syncthreads();
#pragma unroll
        for (int n = 0; n < 4; ++n)
            { _Pragma("unroll") for (int s = 0; s < 8; ++s) sacc[4 + n] = MFMA16(qa[s], frag_kc(buf1, MLB_PKC, 16 * n, 32 * s, lane), sacc[4 + n]); __builtin_amdgcn_sched_barrier(0); }
        const bf16_t* cst0 = WSP(bf16_t, WS_CST) + ((size_t)((0 * 4 + head) * 128 + c_f) << 16);
        const bf16_t* cst1 = WSP(bf16_t, WS_CST) + ((size_t)((1 * 4 + head) * 128 + c_b) << 16);
        PIECE_LOAD(cst0, 256);
        float qsc0, qsc1;
#pragma unroll
        for (int d = 0; d < 2; ++d) {
            const int dh = d * 4 + head; const float mp = MPREV[dh * 128 + (d ? c_b : c_f)];
            f32x4 dacc = (f32x4){0.f, 0.f, 0.f, 0.f};
#pragma unroll
            for (int s = 0; s < 8; ++s) { bf16x8 bn; const LAS float* np = nprev + d * 256 + 32 * s + 8 * g;
#pragma unroll
                for (int e = 0; e < 8; ++e) bn[e] = (i == 0) ? (short)f2bf(np[e]) : (short)0;
                dacc = MFMA16(qa[s], bn, dacc); }
            float ur[8];
#pragma unroll
            for (int n = 0; n < 8; ++n) ur[n] = GU[(size_t)dh * S + t0 + 16 * n + i];
            LAS unsigned char* pw = F.lds + MLB_OFF_P + (d * 8 + wave) * (16 * MLB_PP);
            float es[4];
#pragma unroll
            for (int rg = 0; rg < 4; ++rg) { const int jl = 4 * g + rg, j = j0 + jl;
                const float M = fmaxf(mp, GPM[(size_t)dh * S + t0 + j]), ej = __expf(mp - M), mj = GB[(size_t)dh * S + t0 + j] + M;
                float rs = 0.f;
#pragma unroll
                for (int n = 0; n < 8; ++n) { const int r = 16 * n + i; const bool keep = d ? (r >= j) : (r <= j); rs += keep ? sacc[n][rg] * __expf(ur[n] - M) : 0.f; }
                rs += __shfl_xor(rs, 1); rs += __shfl_xor(rs, 2); rs += __shfl_xor(rs, 4); rs += __shfl_xor(rs, 8);
                const float qn = __shfl(dacc[rg], lane & 48);
                const float den = ej * qn + rs, sj = 1.0f / fmaxf(fabsf(den), __expf(-mj));
                es[rg] = ej * sj;
#pragma unroll
                for (int n = 0; n < 8; ++n) { const int r = 16 * n + i; const bool keep = d ? (r >= j) : (r <= j);
                    const float p = keep ? sacc[n][rg] * __expf(ur[n] - M) * sj : 0.f;
                    *(LAS bf16_t*)(pw + jl * MLB_PP + r * 2) = (bf16_t)f2bf(p); } }
            const int srcl = (i >> 2) << 4;
            const float t0_ = __shfl(es[0], srcl), t1_ = __shfl(es[1], srcl), t2_ = __shfl(es[2], srcl), t3_ = __shfl(es[3], srcl);
            const float qs_ = (i & 3) == 0 ? t0_ : (i & 3) == 1 ? t1_ : (i & 3) == 2 ? t2_ : t3_;
            if (d == 0) qsc0 = qs_; else qsc1 = qs_;
        }
        __syncthreads();
        f32x4 hacc[16];
#pragma unroll
        for (int n = 0; n < 16; ++n) hacc[n] = (f32x4){0.f, 0.f, 0.f, 0.f};
#pragma unroll
        for (int d = 0; d < 2; ++d) {
            const bf16_t* cst = d ? cst1 : cst0; const float qsc = d ? qsc1 : qsc0;
            bf16x8 qs[8];
#pragma unroll
            for (int s = 0; s < 8; ++s) { const u32x4 w = __builtin_bit_cast(u32x4, qa[s]); u32x4 o;
                o.x = pk2(bflo(w.x) * qsc, bfhi(w.x) * qsc); o.y = pk2(bflo(w.y) * qsc, bfhi(w.y) * qsc); o.z = pk2(bflo(w.z) * qsc, bfhi(w.z) * qsc); o.w = pk2(bflo(w.w) * qsc, bfhi(w.w) * qsc);
                qs[s] = __builtin_bit_cast(bf16x8, o); }
#pragma unroll
            for (int cp = 0; cp < 4; ++cp) {
                LAS unsigned char* cur = (cp & 1) ? buf1 : buf0;
                PIECE_WRITE(cur, MLB_PKC);
                if (cp < 3) PIECE_LOAD(cst + (size_t)(64 * (cp + 1)) * 256, 256); else PIECE_LOAD(mvp, INP);
                __syncthreads();
#pragma unroll
                for (int n = 0; n < 4; ++n)
                    { _Pragma("unroll") for (int s = 0; s < 8; ++s) hacc[4 * cp + n] = MFMA16(qs[s], frag_kc(cur, MLB_PKC, 16 * n, 32 * s, lane), hacc[4 * cp + n]); __builtin_amdgcn_sched_barrier(0); }
            }
            LAS const unsigned char* pw = F.lds + MLB_OFF_P + (d * 8 + wave) * (16 * MLB_PP);
#pragma unroll
            for (int vp = 0; vp < 2; ++vp) {
                LAS unsigned char* cur = (vp & 1) ? buf1 : buf0;
                PIECE_WRITE(cur, MLB_PTR);
                if (vp == 0) PIECE_LOAD(mvp + (size_t)64 * INP, INP); else if (d == 0) PIECE_LOAD(cst1, 256);
                __syncthreads();
#pragma unroll
                for (int ks = 0; ks < 2; ++ks) { const bf16x8 a = *(LAS const bf16x8*)(pw + i * MLB_PP + (64 * vp + 32 * ks + 8 * g) * 2);
#pragma unroll
                    for (int n = 0; n < 16; ++n) { hacc[n] = MFMA16(a, frag_tr(cur, MLB_PTR, 32 * ks, 16 * n, lane), hacc[n]); if ((n & 3) == 3) __builtin_amdgcn_sched_barrier(0); } }
            }
            __syncthreads();
        }
        {   const float* mg = FIN(8) + head * 256;
            const bf16_t* mo = WSP(bf16_t, WS_PROJ) + C_MO + head * 256; bf16_t* y = WSP(bf16_t, WS_Y) + 1024 + head * 256;
#pragma unroll
            for (int rg = 0; rg < 4; ++rg) { float ss = 0.f;
#pragma unroll
                for (int n = 0; n < 16; ++n) ss += hacc[n][rg] * hacc[n][rg];
                ss += __shfl_xor(ss, 1); ss += __shfl_xor(ss, 2); ss += __shfl_xor(ss, 4); ss += __shfl_xor(ss, 8);
                const float r = 1.0f / sqrtf(ss * (1.f / 256.f) + EPS); const size_t t = (size_t)(t0 + j0 + 4 * g + rg);
#pragma unroll
                for (int n = 0; n < 16; ++n) { const int col = 16 * n + i; const float o = bflo((unsigned)mo[t * INP + col]);
                    #if defined(DBG_ZERO_ML)
                    y[t * DM + col] = 0;
#else
                    y[t * DM + col] = (bf16_t)f2bf(hacc[n][rg] * r * mg[col] * (1.f / (1.f + __expf(-o))));
#endif
                    } }
        }
#undef PIECE_LOAD
#undef PIECE_WRITE
    }
}

#define MFMA32(a, b, c) __builtin_amdgcn_mfma_f32_32x32x16_bf16((a), (b), (c), 0, 0, 0)
__device__ __forceinline__ int fkey(float x) { const int b = __builtin_bit_cast(int, x); return b ^ ((b >> 31) & 0x7fffffff); }
__device__ __forceinline__ float kval(int k) { return __builtin_bit_cast(float, k ^ ((k >> 31) & 0x7fffffff)); }
#define CE_(a, i, j) { const int hi_ = max(a[i], a[j]); a[j] = min(a[i], a[j]); a[i] = hi_; }
#define SORT16(a) do { CE_(a,0,13) CE_(a,1,12) CE_(a,2,15) CE_(a,3,14) CE_(a,4,8) CE_(a,5,6) CE_(a,7,11) CE_(a,9,10) CE_(a,0,5) CE_(a,1,7) CE_(a,2,9) CE_(a,3,4) CE_(a,6,13) CE_(a,8,14) CE_(a,10,15) CE_(a,11,12) CE_(a,0,1) CE_(a,2,3) CE_(a,4,5) CE_(a,6,8) CE_(a,7,9) CE_(a,10,11) CE_(a,12,13) CE_(a,14,15) CE_(a,0,2) CE_(a,1,3) CE_(a,4,10) CE_(a,5,11) CE_(a,6,7) CE_(a,8,9) CE_(a,12,14) CE_(a,13,15) CE_(a,1,2) CE_(a,3,12) CE_(a,4,6) CE_(a,5,7) CE_(a,8,10) CE_(a,9,11) CE_(a,13,14) CE_(a,1,4) CE_(a,2,6) CE_(a,5,8) CE_(a,7,10) CE_(a,9,13) CE_(a,11,14) CE_(a,2,4) CE_(a,3,6) CE_(a,9,12) CE_(a,11,13) CE_(a,3,5) CE_(a,6,8) CE_(a,7,9) CE_(a,10,12) CE_(a,3,4) CE_(a,5,6) CE_(a,7,8) CE_(a,9,10) CE_(a,11,12) CE_(a,6,7) CE_(a,8,9) } while (0)
#define MERGE16(a, b) do { _Pragma("unroll") for (int k_ = 0; k_ < 16; ++k_) a[k_] = max(a[k_], b[15 - k_]); CE_(a,0,8) CE_(a,1,9) CE_(a,2,10) CE_(a,3,11) CE_(a,4,12) CE_(a,5,13) CE_(a,6,14) CE_(a,7,15) CE_(a,0,4) CE_(a,1,5) CE_(a,2,6) CE_(a,3,7) CE_(a,8,12) CE_(a,9,13) CE_(a,10,14) CE_(a,11,15) CE_(a,0,2) CE_(a,1,3) CE_(a,4,6) CE_(a,5,7) CE_(a,8,10) CE_(a,9,11) CE_(a,12,14) CE_(a,13,15) CE_(a,0,1) CE_(a,2,3) CE_(a,4,5) CE_(a,6,7) CE_(a,8,9) CE_(a,10,11) CE_(a,12,13) CE_(a,14,15) } while (0)
#define TOP_INS(top, x) do { int x_ = (x); _Pragma("unroll") for (int k_ = 0; k_ < 16; ++k_) { const int hi_ = max(top[k_], x_); x_ = min(top[k_], x_); top[k_] = hi_; } } while (0)
__device__ __forceinline__ int pick4(int sel, int a, int b, int c, int d) { return sel == 0 ? a : sel == 1 ? b : sel == 2 ? c : d; }
__device__ __forceinline__ void topk_item(const Frame& F, int layer, int item) {
    const int tile = item >> 3, h = item & 7, lane = F.lane, r32 = lane & 31, hi = lane >> 5;
    const int t = tile * 32 + r32;
    const bf16_t* qrow = WSP(bf16_t, WS_QP) + (size_t)t * DM + h * 256 + 8 * hi;
    int tops[2][16];
#pragma unroll
    for (int p = 0; p < 2; ++p) {
        const bf16_t* keys = WSP(bf16_t, WS_KEYS) + (size_t)(((layer * 8 + h) * 2 + p) * 128) * 128 + 8 * hi;
        bf16x8 bq[8];
#pragma unroll
        for (int s = 0; s < 8; ++s) bq[s] = *(const bf16x8*)(qrow + p * 128 + 16 * s);
        int top[16];
#pragma unroll
        for (int kt = 0; kt < 4; ++kt) {
            f32x16 acc = {};
#pragma unroll
            for (int s = 0; s < 8; ++s) { const bf16x8 a = *(const bf16x8*)(keys + (size_t)(32 * kt + r32) * 128 + 16 * s); acc = MFMA32(a, bq[s], acc); }
            int vals[16];
#pragma unroll
            for (int r = 0; r < 16; ++r) { const int idx = 32 * kt + (r & 3) + 8 * (r >> 2) + 4 * hi; vals[r] = (fkey(acc[r]) & ~127) | idx; }
            SORT16(vals);
            if (kt == 0) {
#pragma unroll
                for (int k = 0; k < 16; ++k) top[k] = vals[k]; }
            else MERGE16(top, vals);
        }
        int pt[16];
#pragma unroll
        for (int k = 0; k < 16; ++k) pt[k] = __shfl_xor(top[k], 32);
        MERGE16(top, pt);
#pragma unroll
        for (int k = 0; k < 16; ++k) tops[p][k] = top[k];
    }
    float af[16], bfv[16];
#pragma unroll
    for (int k = 0; k < 16; ++k) { af[k] = kval(tops[0][k] & ~127); bfv[k] = kval(tops[1][k] & ~127); }
#define CKEY(i, j) ((fkey(af[i] + bfv[j]) & ~255) | (255 - (((i) << 4) | (j))))
    int top2[16], aux[16];
#pragma unroll
    for (int j = 0; j < 16; ++j) top2[j] = CKEY(0, j);
#pragma unroll
    for (int j = 0; j < 16; ++j) aux[j] = j < 8 ? CKEY(1, j) : (int)0x80000000;
    MERGE16(top2, aux);
#pragma unroll
    for (int j = 0; j < 16; ++j) aux[j] = j < 8 ? CKEY(8 + j, 0) : (int)0x80000000;
    MERGE16(top2, aux);
    aux[0] = CKEY(2, 0); aux[1] = CKEY(2, 1); aux[2] = CKEY(2, 2); aux[3] = CKEY(2, 3); aux[4] = CKEY(2, 4); aux[5] = CKEY(3, 0); aux[6] = CKEY(3, 1); aux[7] = CKEY(3, 2);
    aux[8] = CKEY(3, 3); aux[9] = CKEY(4, 0); aux[10] = CKEY(4, 1); aux[11] = CKEY(4, 2); aux[12] = CKEY(5, 0); aux[13] = CKEY(5, 1); aux[14] = CKEY(6, 0); aux[15] = CKEY(6, 1);
    SORT16(aux); MERGE16(top2, aux);
    TOP_INS(top2, CKEY(7, 0)); TOP_INS(top2, CKEY(7, 1));
#undef CKEY
    int pa[4], pb[4];
#pragma unroll
    for (int q = 0; q < 4; ++q) { pa[q] = (tops[0][4 * q] & 127) | ((tops[0][4 * q + 1] & 127) << 8) | ((tops[0][4 * q + 2] & 127) << 16) | ((tops[0][4 * q + 3] & 127) << 24);
                                  pb[q] = (tops[1][4 * q] & 127) | ((tops[1][4 * q + 1] & 127) << 8) | ((tops[1][4 * q + 2] & 127) << 16) | ((tops[1][4 * q + 3] & 127) << 24); }
    int ex[16]; float sc[16];
#pragma unroll
    for (int k = 0; k < 16; ++k) { const int code = 255 - (top2[k] & 255), ii = code >> 4, jj = code & 15;
        const int ea = (pick4(ii >> 2, pa[0], pa[1], pa[2], pa[3]) >> ((ii & 3) * 8)) & 127, eb = (pick4(jj >> 2, pb[0], pb[1], pb[2], pb[3]) >> ((jj & 3) * 8)) & 127;
        ex[k] = ea * 128 + eb; sc[k] = kval(top2[k] & ~255); }
    const float mx = sc[0]; float sum = 0.f;
#pragma unroll
    for (int k = 0; k < 16; ++k) { sc[k] = __expf(sc[k] - mx); sum += sc[k]; }
    const float inv = 1.0f / sum;
    if (hi == 0) { int* d = WSP(int, WS_EIDX) + (size_t)t * 128 + h * 16;
#pragma unroll
        for (int q = 0; q < 4; ++q) *(u32x4*)(d + 4 * q) = (u32x4){(unsigned)ex[4 * q], (unsigned)ex[4 * q + 1], (unsigned)ex[4 * q + 2], (unsigned)ex[4 * q + 3]}; }
    else { float* d = WSP(float, WS_EGATE) + (size_t)t * 128 + h * 16;
#pragma unroll
        for (int q = 0; q < 4; ++q) *(f32x4*)(d + 4 * q) = (f32x4){sc[4 * q] * inv, sc[4 * q + 1] * inv, sc[4 * q + 2] * inv, sc[4 * q + 3] * inv}; }
}
constexpr size_t WS_XH = WS_QB, WS_XL = WS_QB + 16 * MiB;
__device__ __forceinline__ void xq_item(const Frame& F, int layer, int t) {
    const int lane = F.lane;
    const float rs = rstd_of(((const unsigned long long*)(F.ws + WS_CTL + CTL_SSQ))[(layer ? 2 : 0) * S + t]) * 16.f;
    const bf16_t* xr = WSP(bf16_t, WS_XN) + (size_t)t * DM + lane * 32;
    unsigned hw[4], lw[4];
#pragma unroll
    for (int d = 0; d < 4; ++d) { const u32x4 x = *(const u32x4*)(xr + 8 * d); const unsigned ww[4] = {x.x, x.y, x.z, x.w}; unsigned h = 0u, l = 0u;
#pragma unroll
        for (int e = 0; e < 8; ++e) { const float f = ((e & 1) ? bfhi(ww[e >> 1]) : bflo(ww[e >> 1])) * rs;
            const int x8 = (int)fminf(fmaxf(rintf(f), -119.f), 119.f), hi = (x8 + 8) >> 4, lo = x8 - 16 * hi;
            h |= (unsigned)(hi & 15) << (4 * e); l |= (unsigned)(lo & 15) << (4 * e); }
        hw[d] = h; lw[d] = l; }
    *(u32x4*)(F.ws + WS_XH + (size_t)t * 1024 + lane * 16) = (u32x4){hw[0], hw[1], hw[2], hw[3]};
    *(u32x4*)(F.ws + WS_XL + (size_t)t * 1024 + lane * 16) = (u32x4){lw[0], lw[1], lw[2], lw[3]};
}
__device__ __forceinline__ void ph_topk(const Frame& F, int layer) {
    const int gw = F.vcu * NWAVES + F.wave, NGW = F.G * NWAVES;
    for (int it = gw; it < 4096; it += NGW) topk_item(F, layer, it);
    for (int t = gw; t < S; t += NGW) xq_item(F, layer, t);
}

typedef __bf16 bf2 __attribute__((ext_vector_type(2)));
__device__ __forceinline__ float dot2bf(bf2 a, unsigned b, float c) { return __builtin_amdgcn_fdot2_f32_bf16(a, __builtin_bit_cast(bf2, b), c, false); }
__device__ __forceinline__ float dot4_fp8(unsigned w, unsigned xlo, unsigned xhi, float c) {
    c = dot2bf(__builtin_amdgcn_cvt_scalef32_pk_bf16_fp8(w, 1.0f, false), xlo, c);
    return dot2bf(__builtin_amdgcn_cvt_scalef32_pk_bf16_fp8(w, 1.0f, true), xhi, c);
}
#if TBL_FP4
constexpr int NSL = 8;
constexpr size_t WS_PART = WS_CST;
constexpr size_t WS_W = WS_KVB;
__device__ __forceinline__ float dot8_fp4(unsigned w, u32x4 x, float c) {
    c = dot2bf(__builtin_amdgcn_cvt_scalef32_pk_bf16_fp4(w, 1.0f, 0), x.x, c); c = dot2bf(__builtin_amdgcn_cvt_scalef32_pk_bf16_fp4(w, 1.0f, 1), x.y, c);
    c = dot2bf(__builtin_amdgcn_cvt_scalef32_pk_bf16_fp4(w, 1.0f, 2), x.z, c); return dot2bf(__builtin_amdgcn_cvt_scalef32_pk_bf16_fp4(w, 1.0f, 3), x.w, c);
}
__device__ __forceinline__ void ph_gu(const Frame& F, int layer) {
    const int lane = F.lane, r8 = lane >> 3, c16 = lane & 7;
    const int nper = F.G >> 3, xl = F.vcu / nper, wx = (F.vcu % nper) * NWAVES + F.wave, nwx = nper * NWAVES;
    const int s = xl;
    const unsigned char* Us = F.ws + WS_UB + (size_t)layer * (16384 * 1024) + (size_t)s * (16384 * 128);
    const unsigned char* eb = F.ws + WS_EIDX; unsigned char* pb = F.ws + WS_PART + (size_t)s * S * 512; const unsigned char* xhb = F.ws + WS_XH + s * 128; const unsigned char* xlb = F.ws + WS_XL + s * 128;
    const unsigned eo = 64u * r8, po = 8u * lane, xo = 16u * c16, uo = 16u * c16;
#define LDU(T, base, off) (*(const T*)((base) + (unsigned)(off)))
    u32x4 ia[2][4];
#pragma unroll
    for (int q = 0; q < 4; ++q) { ia[0][q] = LDU(u32x4, eb, (unsigned)wx * 512u + eo + 16u * q); ia[1][q] = LDU(u32x4, eb, (unsigned)(wx + nwx) * 512u + eo + 16u * q); }
#pragma unroll 1
    for (int t = wx; t < S; t += 2 * nwx) {
        const int t1 = t + nwx;
        u32x4 ur[2][16];
#pragma unroll
        for (int z = 0; z < 2; ++z)
#pragma unroll
            for (int q = 0; q < 16; ++q) { const unsigned id = ia[z][q >> 2][q & 3]; ur[z][q] = LDU(u32x4, Us, id * 128u + uo); }
        { const int tn = (t + 2 * nwx < S) ? t + 2 * nwx : t;
#pragma unroll
          for (int q = 0; q < 4; ++q) { ia[0][q] = LDU(u32x4, eb, (unsigned)tn * 512u + eo + 16u * q); ia[1][q] = LDU(u32x4, eb, (unsigned)(tn + nwx) * 512u + eo + 16u * q); } }
#pragma unroll
        for (int z = 0; z < 2; ++z) {
            const unsigned xoff = (unsigned)(z ? t1 : t) * 1024u + xo; const u32x4 xh = LDU(u32x4, xhb, xoff), xl = LDU(u32x4, xlb, xoff);
            float v[16];
#pragma unroll
            for (int q = 0; q < 16; ++q) { const u32x4 w = ur[z][q]; int ah = 0, al = 0;
                ah = __builtin_amdgcn_sdot8((int)w.x, (int)xh.x, ah, false); al = __builtin_amdgcn_sdot8((int)w.x, (int)xl.x, al, false);
                ah = __builtin_amdgcn_sdot8((int)w.y, (int)xh.y, ah, false); al = __builtin_amdgcn_sdot8((int)w.y, (int)xl.y, al, false);
                ah = __builtin_amdgcn_sdot8((int)w.z, (int)xh.z, ah, false); al = __builtin_amdgcn_sdot8((int)w.z, (int)xl.z, al, false);
                ah = __builtin_amdgcn_sdot8((int)w.w, (int)xh.w, ah, false); al = __builtin_amdgcn_sdot8((int)w.w, (int)xl.w, al, false);
                v[q] = (float)(16 * ah + al); }
            float r8v[8], r4v[4], r2v[2];
            { const bool up = lane & 4;
#pragma unroll
              for (int q = 0; q < 8; ++q) { const float keep = up ? v[q + 8] : v[q], give = up ? v[q] : v[q + 8]; r8v[q] = keep + __shfl_xor(give, 4); } }
            { const bool up = lane & 2;
#pragma unroll
              for (int q = 0; q < 4; ++q) { const float keep = up ? r8v[q + 4] : r8v[q], give = up ? r8v[q] : r8v[q + 4]; r4v[q] = keep + __shfl_xor(give, 2); } }
            { const bool up = lane & 1;
#pragma unroll
              for (int q = 0; q < 2; ++q) { const float keep = up ? r4v[q + 2] : r4v[q], give = up ? r4v[q] : r4v[q + 2]; r2v[q] = keep + __shfl_xor(give, 1); } }
            *(f32x2*)(pb + ((unsigned)(z ? t1 : t) * 512u + po)) = (f32x2){r2v[0], r2v[1]};
        }
    }
}
__device__ __forceinline__ void ph_act(const Frame& F, int layer) {
    const int lane = F.lane, gw = F.vcu * NWAVES + F.wave, NGW = F.G * NWAVES;
    const float* su = (const float*)(F.ws + WS_TSC) + layer * 16384; const float* sv = su + 32768;
    for (int t = gw; t < S; t += NGW) {
        const float* part = WSP(float, WS_PART) + (size_t)t * 128 + 2 * lane;
        f32x2 a = {0.f, 0.f};
#pragma unroll
        for (int s = 0; s < NSL; ++s) a += *(const f32x2*)(part + (size_t)s * S * 128);
        const u32x2 id = *(const u32x2*)(WSP(int, WS_EIDX) + (size_t)t * 128 + 2 * lane); const f32x2 g = *(const f32x2*)(WSP(float, WS_EGATE) + (size_t)t * 128 + 2 * lane);
        const float a0 = a.x * su[id.x] * (1.f / 16.f), a1 = a.y * su[id.y] * (1.f / 16.f);
        const float w0 = 0.5f * a0 * (1.f + erff(a0 * 0.70710678118654752f)) * g.x * sv[id.x], w1 = 0.5f * a1 * (1.f + erff(a1 * 0.70710678118654752f)) * g.y * sv[id.y];
        *(f32x2*)(WSP(float, WS_W) + (size_t)t * 128 + 2 * lane) = (f32x2){w0, w1};
    }
}
__device__ __forceinline__ void ph_gv(const Frame& F, int layer) {
    const int lane = F.lane, r8 = lane >> 3, c16 = lane & 7;
    const int nper = F.G >> 3, xl = F.vcu / nper, wx = (F.vcu % nper) * NWAVES + F.wave, nwx = nper * NWAVES;
    const int s = xl;
    const unsigned char* Vs = F.ws + WS_VB + (size_t)layer * (16384 * 1024) + (size_t)s * (16384 * 128);
    const unsigned char* eb = F.ws + WS_EIDX; const unsigned char* wb = F.ws + WS_W; unsigned char* hb = F.ws + WS_XN + s * 512;
    const unsigned eo = 64u * r8, ho = 64u * c16 + 8u * r8, vo = 16u * c16;
    u32x4 ia[2][4];
#pragma unroll
    for (int q = 0; q < 4; ++q) { ia[0][q] = LDU(u32x4, eb, (unsigned)wx * 512u + eo + 16u * q); ia[1][q] = LDU(u32x4, eb, (unsigned)(wx + nwx) * 512u + eo + 16u * q); }
#pragma unroll 1
    for (int t = wx; t < S; t += 2 * nwx) {
        const int t1 = t + nwx;
        u32x4 vr[2][16];
#pragma unroll
        for (int z = 0; z < 2; ++z)
#pragma unroll
            for (int q = 0; q < 16; ++q) { const unsigned id = ia[z][q >> 2][q & 3]; vr[z][q] = LDU(u32x4, Vs, id * 128u + vo); }
        { const int tn = (t + 2 * nwx < S) ? t + 2 * nwx : t;
#pragma unroll
          for (int q = 0; q < 4; ++q) { ia[0][q] = LDU(u32x4, eb, (unsigned)tn * 512u + eo + 16u * q); ia[1][q] = LDU(u32x4, eb, (unsigned)(tn + nwx) * 512u + eo + 16u * q); } }
        f32x4 wqa[2][4]; u32x2 hold[2];
#pragma unroll
        for (int z = 0; z < 2; ++z) { const unsigned tt = (unsigned)(z ? t1 : t);
#pragma unroll
            for (int q = 0; q < 4; ++q) wqa[z][q] = LDU(f32x4, wb, tt * 512u + eo + 16u * q);
            hold[z] = LDU(u32x2, hb, tt * 4096u + ho); }
#pragma unroll
        for (int z = 0; z < 2; ++z) {
            const unsigned tt = (unsigned)(z ? t1 : t);
            f32x2 acc[16];
#pragma unroll
            for (int e = 0; e < 16; ++e) acc[e] = (f32x2){0.f, 0.f};
#pragma unroll
            for (int q = 0; q < 16; ++q) { const float w = wqa[z][q >> 2][q & 3]; const f32x2 ww = {w, w}; const unsigned d4[4] = {vr[z][q].x, vr[z][q].y, vr[z][q].z, vr[z][q].w};
#pragma unroll
                for (int e = 0; e < 4; ++e) { acc[4 * e] += ww * __builtin_amdgcn_cvt_scalef32_pk_f32_fp4(d4[e], 1.0f, 0); acc[4 * e + 1] += ww * __builtin_amdgcn_cvt_scalef32_pk_f32_fp4(d4[e], 1.0f, 1);
                    acc[4 * e + 2] += ww * __builtin_amdgcn_cvt_scalef32_pk_f32_fp4(d4[e], 1.0f, 2); acc[4 * e + 3] += ww * __builtin_amdgcn_cvt_scalef32_pk_f32_fp4(d4[e], 1.0f, 3); } }
            f32x2 b8[8], b4[4], b2[2];
            { const bool up = lane & 32;
#pragma unroll
              for (int e = 0; e < 8; ++e) { const f32x2 keep = up ? acc[e + 8] : acc[e], give = up ? acc[e] : acc[e + 8]; b8[e] = keep + (f32x2){__shfl_xor(give.x, 32), __shfl_xor(give.y, 32)}; } }
            { const bool up = lane & 16;
#pragma unroll
              for (int e = 0; e < 4; ++e) { const f32x2 keep = up ? b8[e + 4] : b8[e], give = up ? b8[e] : b8[e + 4]; b4[e] = keep + (f32x2){__shfl_xor(give.x, 16), __shfl_xor(give.y, 16)}; } }
            { const bool up = lane & 8;
#pragma unroll
              for (int e = 0; e < 2; ++e) { const f32x2 keep = up ? b4[e + 2] : b4[e], give = up ? b4[e] : b4[e + 2]; b2[e] = keep + (f32x2){__shfl_xor(give.x, 8), __shfl_xor(give.y, 8)}; } }
#if defined(DBG_ZERO_PEER)
            b2[0] = (f32x2){0.f, 0.f}; b2[1] = b2[0];
#endif
            const f32x4 hn = (f32x4){bflo(hold[z].x), bfhi(hold[z].x), bflo(hold[z].y), bfhi(hold[z].y)} + (f32x4){b2[0].x, b2[0].y, b2[1].x, b2[1].y};
            u32x2 w; w.x = pk2(hn.x, hn.y); w.y = pk2(hn.z, hn.w); *(u32x2*)(hb + (tt * 4096u + ho)) = w;
            if (layer == 0) {
                const float sq = wave_sum((hn.x * hn.x + hn.y * hn.y) + (hn.z * hn.z + hn.w * hn.w));
                if (lane == 0) atomicAdd((unsigned long long*)(F.ws + WS_CTL + CTL_SSQ) + S + tt, (unsigned long long)(sq * 1048576.0f)); }
        }
    }
}
#else
constexpr int NSL = 16;
constexpr size_t WS_PART = WS_CST;
constexpr size_t WS_W = WS_KVB;
__device__ __forceinline__ void ph_gu(const Frame& F, int layer) {
    const int lane = F.lane, r8 = lane >> 3, c16 = lane & 7;
    const int nper = F.G >> 3, xl = F.vcu / nper, wx = (F.vcu % nper) * NWAVES + F.wave, nwx = nper * NWAVES;
    const unsigned char* U = F.ws + WS_UB + (size_t)layer * 16384 * 2048 + c16 * 16;
    const int* eidx = WSP(int, WS_EIDX) + 16 * r8;
#pragma unroll 1
    for (int p = 0; p < 2; ++p) {
        const int s = xl + 8 * p;
        const unsigned char* Us = U + (size_t)s * (16384 * 128);
        float* part = WSP(float, WS_PART) + (size_t)s * S * 128 + 2 * lane;
        const bf16_t* xs = WSP(bf16_t, WS_XN) + s * 128 + c16 * 16;
        u32x4 ia[2][4];
#pragma unroll
        for (int q = 0; q < 4; ++q) { ia[0][q] = *(const u32x4*)(eidx + (size_t)wx * 128 + 4 * q); ia[1][q] = *(const u32x4*)(eidx + (size_t)(wx + nwx) * 128 + 4 * q); }
#pragma unroll 1
        for (int t = wx; t < S; t += 2 * nwx) {
            const int t1 = t + nwx;
            u32x4 ur[2][16];
#pragma unroll
            for (int z = 0; z < 2; ++z)
#pragma unroll
                for (int q = 0; q < 16; ++q) { const unsigned id = ia[z][q >> 2][q & 3]; ur[z][q] = *(const u32x4*)(Us + (size_t)id * 128); }
            { const int tn = (t + 2 * nwx < S) ? t + 2 * nwx : t;
#pragma unroll
              for (int q = 0; q < 4; ++q) { ia[0][q] = *(const u32x4*)(eidx + (size_t)tn * 128 + 4 * q); ia[1][q] = *(const u32x4*)(eidx + (size_t)(tn + nwx) * 128 + 4 * q); } }
#pragma unroll
            for (int z = 0; z < 2; ++z) {
                const bf16_t* xr = xs + (size_t)(z ? t1 : t) * DM; const u32x4 x0 = *(const u32x4*)xr, x1 = *(const u32x4*)(xr + 8);
                float v[16];
#pragma unroll
                for (int q = 0; q < 16; ++q) { const u32x4 w = ur[z][q]; float a = dot4_fp8(w.x, x0.x, x0.y, 0.f); a = dot4_fp8(w.y, x0.z, x0.w, a); a = dot4_fp8(w.z, x1.x, x1.y, a); v[q] = dot4_fp8(w.w, x1.z, x1.w, a); }
                float r8v[8], r4v[4], r2v[2];
                { const bool up = lane & 4;
#pragma unroll
                  for (int q = 0; q < 8; ++q) { const float keep = up ? v[q + 8] : v[q], give = up ? v[q] : v[q + 8]; r8v[q] = keep + __shfl_xor(give, 4); } }
                { const bool up = lane & 2;
#pragma unroll
                  for (int q = 0; q < 4; ++q) { const float keep = up ? r8v[q + 4] : r8v[q], give = up ? r8v[q] : r8v[q + 4]; r4v[q] = keep + __shfl_xor(give, 2); } }
                { const bool up = lane & 1;
#pragma unroll
                  for (int q = 0; q < 2; ++q) { const float keep = up ? r4v[q + 2] : r4v[q], give = up ? r4v[q] : r4v[q + 2]; r2v[q] = keep + __shfl_xor(give, 1); } }
                *(f32x2*)(part + (size_t)(z ? t1 : t) * 128) = (f32x2){r2v[0], r2v[1]};
            }
        }
    }
}
__device__ __forceinline__ void ph_act(const Frame& F, int layer) {
    const int lane = F.lane, gw = F.vcu * NWAVES + F.wave, NGW = F.G * NWAVES;
    const float* su = (const float*)(F.ws + WS_TSC) + layer * 16384; const float* sv = su + 32768;
    for (int t = gw; t < S; t += NGW) {
        const float* part = WSP(float, WS_PART) + (size_t)t * 128 + 2 * lane;
        f32x2 a = {0.f, 0.f};
#pragma unroll
        for (int s = 0; s < NSL; ++s) a += *(const f32x2*)(part + (size_t)s * S * 128);
        const u32x2 id = *(const u32x2*)(WSP(int, WS_EIDX) + (size_t)t * 128 + 2 * lane); const f32x2 g = *(const f32x2*)(WSP(float, WS_EGATE) + (size_t)t * 128 + 2 * lane);
        const float a0 = a.x * su[id.x], a1 = a.y * su[id.y];
        const float w0 = 0.5f * a0 * (1.f + erff(a0 * 0.70710678118654752f)) * g.x * sv[id.x], w1 = 0.5f * a1 * (1.f + erff(a1 * 0.70710678118654752f)) * g.y * sv[id.y];
        *(f32x2*)(WSP(float, WS_W) + (size_t)t * 128 + 2 * lane) = (f32x2){w0, w1};
    }
}
__device__ __forceinline__ void ph_gv(const Frame& F, int layer) {
    const int lane = F.lane, r8 = lane >> 3, c16 = lane & 7;
    const int nper = F.G >> 3, xl = F.vcu / nper, wx = (F.vcu % nper) * NWAVES + F.wave, nwx = nper * NWAVES;
    const unsigned char* V = F.ws + WS_VB + (size_t)layer * 16384 * 2048 + c16 * 16;
    const int* eidx = WSP(int, WS_EIDX) + 16 * r8; const float* wv = WSP(float, WS_W) + 16 * r8;
#pragma unroll 1
    for (int p = 0; p < 2; ++p) {
        const int s = xl + 8 * p;
        const unsigned char* Vs = V + (size_t)s * (16384 * 128);
        float* hs = WSP(float, WS_H) + s * 128 + 16 * c16 + 2 * r8;
        u32x4 ia[2][4];
#pragma unroll
        for (int q = 0; q < 4; ++q) { ia[0][q] = *(const u32x4*)(eidx + (size_t)wx * 128 + 4 * q); ia[1][q] = *(const u32x4*)(eidx + (size_t)(wx + nwx) * 128 + 4 * q); }
#pragma unroll 1
        for (int t = wx; t < S; t += 2 * nwx) {
            const int t1 = t + nwx;
            u32x4 vr[2][16];
#pragma unroll
            for (int z = 0; z < 2; ++z)
#pragma unroll
                for (int q = 0; q < 16; ++q) { const unsigned id = ia[z][q >> 2][q & 3]; vr[z][q] = *(const u32x4*)(Vs + (size_t)id * 128); }
            { const int tn = (t + 2 * nwx < S) ? t + 2 * nwx : t;
#pragma unroll
              for (int q = 0; q < 4; ++q) { ia[0][q] = *(const u32x4*)(eidx + (size_t)tn * 128 + 4 * q); ia[1][q] = *(const u32x4*)(eidx + (size_t)(tn + nwx) * 128 + 4 * q); } }
            f32x4 wqa[2][4]; f32x2 hold[2];
#pragma unroll
            for (int z = 0; z < 2; ++z) { const size_t tt = (size_t)(z ? t1 : t);
#pragma unroll
                for (int q = 0; q < 4; ++q) wqa[z][q] = *(const f32x4*)(wv + tt * 128 + 4 * q);
                hold[z] = *(const f32x2*)(hs + tt * DM); }
#pragma unroll
            for (int z = 0; z < 2; ++z) {
                const size_t tt = (size_t)(z ? t1 : t);
                f32x4 wq[4];
#pragma unroll
                for (int q = 0; q < 4; ++q) wq[q] = wqa[z][q];
                f32x2 acc[8];
#pragma unroll
                for (int e = 0; e < 8; ++e) acc[e] = (f32x2){0.f, 0.f};
#pragma unroll
                for (int q = 0; q < 16; ++q) { const float w = wq[q >> 2][q & 3]; const f32x2 ww = {w, w}; const unsigned d4[4] = {vr[z][q].x, vr[z][q].y, vr[z][q].z, vr[z][q].w};
#pragma unroll
                    for (int e = 0; e < 4; ++e) { acc[2 * e] += ww * __builtin_amdgcn_cvt_pk_f32_fp8(d4[e], false); acc[2 * e + 1] += ww * __builtin_amdgcn_cvt_pk_f32_fp8(d4[e], true); } }
                f32x2 b4[4], b2[2], b1;
                { const bool up = lane & 32;
#pragma unroll
                  for (int e = 0; e < 4; ++e) { const f32x2 keep = up ? acc[e + 4] : acc[e], give = up ? acc[e] : acc[e + 4]; b4[e] = keep + (f32x2){__shfl_xor(give.x, 32), __shfl_xor(give.y, 32)}; } }
                { const bool up = lane & 16;
#pragma unroll
                  for (int e = 0; e < 2; ++e) { const f32x2 keep = up ? b4[e + 2] : b4[e], give = up ? b4[e] : b4[e + 2]; b2[e] = keep + (f32x2){__shfl_xor(give.x, 16), __shfl_xor(give.y, 16)}; } }
                { const bool up = lane & 8; const f32x2 keep = up ? b2[1] : b2[0], give = up ? b2[0] : b2[1]; b1 = keep + (f32x2){__shfl_xor(give.x, 8), __shfl_xor(give.y, 8)}; }
#if defined(DBG_ZERO_PEER)
                b1 = (f32x2){0.f, 0.f};
#endif
                *(f32x2*)(hs + tt * DM) = hold[z] + b1;
            }
        }
    }
}
#endif
__device__ __forceinline__ void ph_normg(const Frame& F, bool final_layer) {
    const int gw = F.vcu * NWAVES + F.wave, NGW = F.G * NWAVES, lane = F.lane; (void)final_layer;
    const float* g = FIN(16); float* out = FOUT();
    for (int m = gw; m < S; m += NGW) {
        const bf16_t* xr = WSP(bf16_t, WS_XN) + (size_t)m * DM + lane * 8;
        u32x4 v[4]; float s = 0.f;
#pragma unroll
        for (int j = 0; j < 4; ++j) { v[j] = *(const u32x4*)(xr + 512 * j); const unsigned ww[4] = {v[j].x, v[j].y, v[j].z, v[j].w};
#pragma unroll
            for (int e = 0; e < 4; ++e) s += bflo(ww[e]) * bflo(ww[e]) + bfhi(ww[e]) * bfhi(ww[e]); }
        const float r = 1.0f / sqrtf(wave_sum(s) * (1.f / DM) + EPS);
#pragma unroll
        for (int j = 0; j < 4; ++j) { const int c0 = lane * 8 + 512 * j; const f32x4 g0 = *(const f32x4*)(g + c0), g1 = *(const f32x4*)(g + c0 + 4);
            *(f32x4*)(out + (size_t)m * DM + c0) = (f32x4){bflo(v[j].x) * r * g0.x, bfhi(v[j].x) * r * g0.y, bflo(v[j].y) * r * g0.z, bfhi(v[j].y) * r * g0.w};
            *(f32x4*)(out + (size_t)m * DM + c0 + 4) = (f32x4){bflo(v[j].z) * r * g1.x, bfhi(v[j].z) * r * g1.y, bflo(v[j].w) * r * g1.z, bfhi(v[j].w) * r * g1.w}; }
    }
}

__device__ __forceinline__ void ph_poolprep(const Frame& F) {
    const int lane = F.lane, gw = F.vcu * NWAVES + F.wave, NGW = F.G * NWAVES;
    const bf16_t* xn = WSP(bf16_t, WS_XN); const unsigned long long* ss = (const unsigned long long*)(F.ws + WS_CTL + CTL_SSQ) + S; const float* g = FIN(1) + DM;
    for (int t = gw; t < S; t += NGW) {
        const int rl = t - 8 + (lane & 15); const float rsl = (rl >= 0 && rl < S) ? rstd_of(ss[rl]) : 0.f;
        float rs[16];
#pragma unroll
        for (int q = 0; q < 16; ++q) rs[q] = __builtin_bit_cast(float, __builtin_amdgcn_readlane(__builtin_bit_cast(int, rsl), q));
        u32x4 o4[4];
#pragma unroll
        for (int j = 0; j < 4; ++j) {
            const int half = 1 << j, lo = max(t - half, 0), hi = min(t + half, S), c0 = (lane + 64 * j) * 8;
            u32x4 xr[16];
#pragma unroll
            for (int q = 0; q < 16; ++q) if (q < 2 * half) { const int r = t - half + q; xr[q] = (r >= 0 && r < S) ? *(const u32x4*)(xn + (size_t)r * DM + c0) : (u32x4){0u, 0u, 0u, 0u}; }
            float a[8];
#pragma unroll
            for (int q = 0; q < 8; ++q) a[q] = 0.f;
#pragma unroll
            for (int q = 0; q < 16; ++q) if (q < 2 * half) { const u32x4 x = xr[q]; const float r1 = rs[8 - half + q];
                a[0] += bflo(x.x) * r1; a[1] += bfhi(x.x) * r1; a[2] += bflo(x.y) * r1; a[3] += bfhi(x.y) * r1; a[4] += bflo(x.z) * r1; a[5] += bfhi(x.z) * r1; a[6] += bflo(x.w) * r1; a[7] += bfhi(x.w) * r1; }
            const u32x4 x = xr[half]; const float ic = 1.0f / (float)(hi - lo), rt = rs[8];
            const f32x4 g0 = *(const f32x4*)(g + c0), g1 = *(const f32x4*)(g + c0 + 4);
            o4[j].x = pk2((a[0] * ic - bflo(x.x) * rt) * g0.x, (a[1] * ic - bfhi(x.x) * rt) * g0.y); o4[j].y = pk2((a[2] * ic - bflo(x.y) * rt) * g0.z, (a[3] * ic - bfhi(x.y) * rt) * g0.w);
            o4[j].z = pk2((a[4] * ic - bflo(x.z) * rt) * g1.x, (a[5] * ic - bfhi(x.z) * rt) * g1.y); o4[j].w = pk2((a[6] * ic - bflo(x.w) * rt) * g1.z, (a[7] * ic - bfhi(x.w) * rt) * g1.w);
        }
#pragma unroll
        for (int j = 0; j < 4; ++j) *(u32x4*)(WSP(bf16_t, WS_POOLED) + (size_t)t * DM + (lane + 64 * j) * 8) = o4[j];
    }
}
__device__ __forceinline__ void ph_norm(const Frame& F, int layer) {
    const int gw = F.vcu * NWAVES + F.wave, NGW = F.G * NWAVES;
    for (int m = gw; m < S; m += NGW) rms_row_to_bf16(WSP(float, WS_H) + (size_t)m * DM, FIN(2) + layer * DM, WSP(bf16_t, WS_XN) + (size_t)m * DM, F.lane);
}


__device__ __forceinline__ void ph_attn(const Frame& F) {
    const int nunits = 8 * 64;
    float gq = fabsf(FIN(6)[F.lane]), gk = fabsf(FIN(7)[F.lane]); gq = fmaxf(gq, fabsf(FIN(6)[64 + F.lane])); gk = fmaxf(gk, fabsf(FIN(7)[64 + F.lane]));
#pragma unroll
    for (int o = 1; o < 64; o <<= 1) { gq = fmaxf(gq, __shfl_xor(gq, o)); gk = fmaxf(gk, __shfl_xor(gk, o)); }
    const float mC = -fminf(11.313708498984761f * gq * gk * 1.01f, 60.f) * 1.4426950408889634f;
    for (int u = F.vcu * 2; u < nunits; u += F.G * 2)
#pragma unroll 1
        for (int k = 0; k < 2; ++k) { const int unit = u + k, head = unit >> 6, qb = unit & 63, kvh = head >> 2;
            att::attn_dense_body<att::bf16>(WSP(att::bf16, WS_QB) + (size_t)(qb * 256) * 1024 + head * 128, WSP(att::bf16, WS_KVB) + kvh * 128, WSP(att::bf16, WS_KVB) + 256 + kvh * 128,
                                 WSP(att::bf16, WS_Y) + (size_t)(qb * 256) * DM + head * 128, S, F.ldsg, mC); }
}

#if defined(DBG_ATTN_CHECK)
constexpr int CW_DBG = 2048;
__device__ __forceinline__ void dbg_attn_check(const Frame& F) {
    __syncthreads();
    LAS float* sc = (LAS float*)F.lds; LAS float* red = sc + 16384; LAS float* po = red + 64;
    const int tid = F.tid, lane = F.lane, wave = F.wave;
    for (int chk = 0; chk < 4; ++chk) {
        const int unit = F.vcu * 2 + (chk & 1), head = unit >> 6, qb = unit & 63, kvh = head >> 2;
        const int t = qb * 256 + ((F.vcu * 37 + chk * 101 + 5) & 255);
        const bf16_t* q = WSP(bf16_t, WS_QB) + (size_t)t * 1024 + head * 128; const bf16_t* K = WSP(bf16_t, WS_KVB) + kvh * 128; const bf16_t* V = WSP(bf16_t, WS_KVB) + 256 + kvh * 128;
        float mx = -1e30f;
        for (int j = 0; j < 32; ++j) { const int key = tid + 512 * j; float s = 0.f;
            for (int d = 0; d < 128; ++d) s += bflo((unsigned)q[d]) * bflo((unsigned)K[(size_t)key * 512 + d]);
            s *= 0.088388347648318440f; sc[key] = s; mx = fmaxf(mx, s); }
        for (int o = 1; o < 64; o <<= 1) mx = fmaxf(mx, __shfl_xor(mx, o));
        if (lane == 0) red[wave] = mx;
        __syncthreads();
        mx = red[0]; for (int w = 1; w < 8; ++w) mx = fmaxf(mx, red[w]);
        __syncthreads();
        float sm = 0.f;
        for (int j = 0; j < 32; ++j) { const int key = tid + 512 * j; const float p = expf(sc[key] - mx); sc[key] = p; sm += p; }
        sm = wave_sum(sm);
        if (lane == 0) red[8 + wave] = sm;
        __syncthreads();
        sm = 0.f; for (int w = 0; w < 8; ++w) sm += red[8 + w];
        const int d = tid & 127, part = tid >> 7; float acc = 0.f;
        for (int kk = 0; kk < 4096; ++kk) { const int key = part * 4096 + kk; acc += sc[key] * bflo((unsigned)V[(size_t)key * 512 + d]); }
        po[part * 128 + d] = acc;
        __syncthreads();
        if (tid < 128) { const float o = (po[d] + po[128 + d] + po[256 + d] + po[384 + d]) / sm;
            const float y = bflo((unsigned)WSP(bf16_t, WS_Y)[(size_t)t * DM + head * 128 + d]);
            float ma = fabsf(o); for (int x = 1; x < 64; x <<= 1) ma = fmaxf(ma, __shfl_xor(ma, x));
            if (lane == 0) red[16 + wave] = ma;
            asm volatile("s_waitcnt lgkmcnt(0)" ::: "memory");
            const float mall = fmaxf(red[16], red[17]);
            const float mown = red[16 + wave]; (void)mall;
            const bool bad = !(fabsf(o - y) <= 0.03f * mown + 1e-5f);
            if (bad) atomicAdd((unsigned*)(F.ws + WS_CTL) + CW_DBG, 1u); }
        __syncthreads();
    }
}
#endif
#if defined(PROBE_MX)
typedef int v8i32p __attribute__((ext_vector_type(8)));
__device__ __forceinline__ unsigned probe_mx(int lane, int ra, int rb) {
    const int i = lane & 15, g = lane >> 4;
    v8i32p A = {0, 0, 0, 0, 0, 0, 0, 0}, B = {0, 0, 0, 0, 0, 0, 0, 0};
    if (g == PROBE_MX_G && i < 6) { const int j0 = (i == 0 ? 1 : i == 1 ? 2 : i == 2 ? 4 : i == 3 ? 8 : i == 4 ? 16 : 0);
#pragma unroll
        for (int d = 0; d < 4; ++d) if ((j0 >> 3) == d) A[d] = 0x2 << (4 * (j0 & 7)); }
    if (g == PROBE_MX_GB) {
#pragma unroll
        for (int d = 0; d < 8; ++d) { unsigned w = 0;
#pragma unroll
            for (int bb = 0; bb < 4; ++bb) { const int b = 4 * d + bb; const unsigned code = (unsigned)(((7 + (b >> 3)) << 3) | (b & 7)); w |= code << (8 * bb); }
            B[d] = (int)w; } }

    f32x4 c = {0.f, 0.f, 0.f, 0.f};
    c = __builtin_amdgcn_mfma_scale_f32_16x16x128_f8f6f4(A, B, c, 4, 0, 0, 0x7f7f7f7f, 0, 0x7f7f7f7f);
    float va = 0.f, vb = 0.f;
#pragma unroll
    for (int r = 0; r < 4; ++r) { const float x = __shfl(c[r], 16 * (ra >> 2)); if ((ra & 3) == r) va = x; const float y = __shfl(c[r], 16 * (rb >> 2)); if ((rb & 3) == r) vb = y; }
    auto dec = [](float v) -> unsigned { if (!(v >= 1.f)) return 33u; int e = 0; while (v >= 2.f && e < 8) { v *= 0.5f; ++e; } return (unsigned)(e * 8) + (unsigned)((v - 1.f) * 8.f + 0.5f); };
    return dec(va) + 40u * dec(vb);
}
#endif
#ifndef PHASE_MASK
#define PHASE_MASK 0xfffff
#endif
#define PH_ON(k) (((PHASE_MASK) >> (k)) & 1)
struct Args { const float* in[17]; float* out; unsigned char* ws; int ph_lo, ph_hi; };
static_assert(sizeof(Args) == 17 * 8 + 8 + 8 + 8, "Args has no padding");
__global__ void __launch_bounds__(NTHR, 2) fwd_kernel(Args args) {
    extern __shared__ __attribute__((aligned(16))) unsigned char lds[];
    Frame F;
    F.lds = (LAS unsigned char*)lds; F.ldsg = (char*)lds;
    F.tid = threadIdx.x; F.lane = F.tid & 63; F.wave = __builtin_amdgcn_readfirstlane(F.tid >> 6);
    F.G = gridDim.x; { const int bx = blockIdx.x; F.vcu = (F.G % 8 == 0) ? (bx % 8) * (F.G / 8) + bx / 8 : bx; }
    F.ws = args.ws;
    volatile LAS unsigned* MISC = (volatile LAS unsigned*)(F.lds + LDSCTL_OFF);
    if (F.tid < 16) ((LAS unsigned*)(F.lds + LDSCTL_OFF))[F.tid] = 0u;
    if (F.tid >= 64 && F.tid < 64 + 36) ((LAS unsigned*)(F.lds + LDSCTL_OFF + 64))[F.tid - 64] = ((const unsigned*)&args)[F.tid - 64];
    __syncthreads();
    const int lo = args.ph_lo, hi = args.ph_hi;
    XcdBarrier bar; bar.bar = (unsigned*)(F.ws + WS_CTL) + CW_BAR; bar.x = 0; bar.st = nullptr;
    if (hi - lo > 1) bar = xcd_barrier_post((unsigned*)(F.ws + WS_CTL) + CW_BAR, MISC + 8);
#if defined(PROBE_BAR)
    unsigned long long tbar_total = 0;
#endif
#pragma unroll 1
    for (int ph = lo; ph < hi; ++ph) {
#if defined(PROBE_BAR)
        if (ph > lo) { const unsigned long long tb0 = __builtin_amdgcn_s_memrealtime(); xcd_barrier(bar); if (PROBE_BAR == 100 || ph == PROBE_BAR) tbar_total += __builtin_amdgcn_s_memrealtime() - tb0; }
#else
        if (ph > lo) xcd_barrier(bar);
#endif
#if defined(PROBE_PH)
        unsigned long long tprobe0 = 0; if (ph == PROBE_PH) tprobe0 = __builtin_amdgcn_s_memrealtime();
        if (ph == PROBE_PH + 1 || (PROBE_PH == NPH - 1 && false)) { }
#endif
        switch (ph) {
#define PHM(n) do { asm volatile("; PHASE_MARK " #n ::: "memory"); int t_ = threadIdx.x; asm volatile("" : "+v"(t_)); F.tid = t_; F.lane = t_ & 63; F.wave = __builtin_amdgcn_readfirstlane(t_ >> 6); \
    unsigned long long z_ = 0; asm volatile("" : "+s"(z_)); F.ws = args.ws + z_; } while (0)
        case PH_PRO: if constexpr (PH_ON(PH_PRO)) { PHM(PH_PRO); ph_prologue(F); } break;
        case PH_GEMM_IN: if constexpr (PH_ON(PH_GEMM_IN)) { PHM(PH_GEMM_IN);  pg8::Gemm g{WSP(bf16_t, WS_XN), WSP(bf16_t, WS_WIN), S, INP, DM, DM, DM, 0, 0}; pg8::StaticOrder So; So.init(S, INP, F.G, (int)blockIdx.x);
            pg8::EpiBf16<0> E{WSP(bf16_t, WS_PROJ), INP, nullptr, 0, 0, 1.f};
            pg8::gemm_phase<pg8::EpiBf16<0>, pg8::StaticOrder, true, true>(F.lds, g, So, E); } break;
        case PH_POST: if constexpr (PH_ON(PH_POST)) { PHM(PH_POST); ph_post(F); } break;
        case PH_ATTN: if constexpr (PH_ON(PH_ATTN)) { PHM(PH_ATTN); ph_attn(F); ph_mla(F);
#if defined(DBG_ATTN_CHECK)
            dbg_attn_check(F);
#endif
            } break;
        case PH_SCAN: if constexpr (PH_ON(PH_SCAN)) { PHM(PH_SCAN); ph_scan(F); } break;
        case PH_MLB: if constexpr (PH_ON(PH_MLB)) { PHM(PH_MLB); ph_mlb(F); } break;
        case PH_GEMM_OUT: if constexpr (PH_ON(PH_GEMM_OUT)) { PHM(PH_GEMM_OUT);  pg8::Gemm g{WSP(bf16_t, WS_Y), WSP(bf16_t, WS_WOUT), S, DM, DM, DM, DM, 0, 0}; pg8::StaticOrder So; So.init(S, DM, F.G, (int)blockIdx.x);
            pg8::EpiRes<false> E{FIN(0), WSP(bf16_t, WS_XN), DM, nullptr, (unsigned long long*)(F.ws + WS_CTL + CTL_SSQ)};
            pg8::gemm_phase<pg8::EpiRes<false>, pg8::StaticOrder, true, true>(F.lds, g, So, E); } break;
        case PH_GEMM_Q0: case PH_GEMM_Q1: if constexpr (PH_ON(PH_GEMM_Q0)) { PHM(PH_GEMM_Q0);  pg8::Gemm g{WSP(bf16_t, WS_XN), WSP(bf16_t, ph == PH_GEMM_Q0 ? WS_WQ0 : WS_WQ1), S, DM, DM, DM, DM, 0, 0}; pg8::StaticOrder So; So.init(S, DM, F.G, (int)blockIdx.x);
            pg8::EpiBf16Row E{WSP(bf16_t, WS_QP), DM, (const unsigned long long*)(F.ws + WS_CTL + CTL_SSQ) + (ph == PH_GEMM_Q0 ? 0 : 2 * S), 1.0f / DM, EPS};
            pg8::gemm_phase<pg8::EpiBf16Row, pg8::StaticOrder, true, true>(F.lds, g, So, E); } break;
        case PH_TOPK0: if constexpr (PH_ON(PH_TOPK0)) { PHM(PH_TOPK0); ph_topk(F, 0); } break;
        case PH_TOPK1: if constexpr (PH_ON(PH_TOPK1)) { PHM(PH_TOPK1); ph_topk(F, 1); } break;
        case PH_GU0: if constexpr (PH_ON(PH_GU0)) { PHM(PH_GU0); ph_gu(F, 0); } break;
        case PH_GU1: if constexpr (PH_ON(PH_GU1)) { PHM(PH_GU1); ph_gu(F, 1); } break;
        case PH_ACT0: if constexpr (PH_ON(PH_ACT0)) { PHM(PH_ACT0); ph_act(F, 0); } break;
        case PH_ACT1: if constexpr (PH_ON(PH_ACT1)) { PHM(PH_ACT1); ph_act(F, 1); } break;
        case PH_GV0: if constexpr (PH_ON(PH_GV0)) { PHM(PH_GV0); ph_gv(F, 0); } break;
        case PH_GV1: if constexpr (PH_ON(PH_GV1)) { PHM(PH_GV1); ph_gv(F, 1); } break;
        case PH_NORMF: if constexpr (PH_ON(PH_NORMF)) { PHM(PH_NORMF); ph_normg(F, true);
#if defined(DBG_ATTN_CHECK)
            { const unsigned nb = __hip_atomic_load((unsigned*)(F.ws + WS_CTL) + CW_DBG, __ATOMIC_RELAXED, __HIP_MEMORY_SCOPE_AGENT);
              if (nb != 0u) { float* o = FOUT(); for (int i = F.vcu * NTHR + F.tid; i < 4096; i += F.G * NTHR) o[(size_t)i * 8192 + 7] += (DBG_ATTN_CHECK == 2 ? 0.f : 1000.f); } }
#endif
            } break;
        case PH_POOLPREP: if constexpr (PH_ON(PH_POOLPREP)) { PHM(PH_POOLPREP); ph_poolprep(F); } break;
        case PH_GEMM_POOL: if constexpr (PH_ON(PH_GEMM_POOL)) { PHM(PH_GEMM_POOL);  pg8::Gemm g{WSP(bf16_t, WS_POOLED), WSP(bf16_t, WS_WPOOL), S, DM, 512, DM, 512, 1, 512 * 2}; pg8::StaticOrder So; So.init(S, DM, F.G, (int)blockIdx.x);
            pg8::EpiRes<true> E{WSP(bf16_t, WS_XN), WSP(bf16_t, WS_XN), DM, FIN(11), (unsigned long long*)(F.ws + WS_CTL + CTL_SSQ) + 2 * S};
            pg8::gemm_phase<pg8::EpiRes<true>, pg8::StaticOrder, true, true>(F.lds, g, So, E); } break;
        default: break;
        }
#if defined(PROBE_BAR)
        if (ph == hi - 1 && F.vcu == PROBE_BAR_VCU) { __syncthreads(); const unsigned long long t1 = __builtin_amdgcn_s_memrealtime(); while (__builtin_amdgcn_s_memrealtime() - t1 < 16ull * tbar_total) __builtin_amdgcn_s_sleep(8); }
#endif
#if defined(PROBE_PH)
#ifndef PROBE_VCU
#define PROBE_VCU -1
#endif
        if (ph == PROBE_PH && (PROBE_VCU < 0 || F.vcu == PROBE_VCU)) { __syncthreads(); const unsigned long long t1 = __builtin_amdgcn_s_memrealtime(), dt = t1 - tprobe0;
            while (__builtin_amdgcn_s_memrealtime() - t1 < 4ull * dt) __builtin_amdgcn_s_sleep(8); }
#endif
    }
}

#if defined(PROBE_MX)
__global__ void __launch_bounds__(64) probe_mx_kernel(int dummy) {
    const unsigned code = probe_mx((int)threadIdx.x, PROBE_MX_RA, PROBE_MX_RB); const unsigned long long t1 = __builtin_amdgcn_s_memrealtime();
    while (__builtin_amdgcn_s_memrealtime() - t1 < 1000ull * code + (unsigned long long)dummy) __builtin_amdgcn_s_sleep(8);
}
#endif
#ifndef N_LAUNCH_MODE
#define N_LAUNCH_MODE 1
#endif
extern "C" void kernel_launch(void* const* d_in, const int* in_sizes, int n_in, void* d_out, int out_size, void* d_ws, size_t ws_size, hipStream_t stream) {
    static int grid = 0;
    if (grid == 0) {
        if (n_in != 17 || in_sizes[0] != S * DM || out_size != S * DM || ws_size < WS_END) { fprintf(stderr, "kernel_launch: unexpected shapes (n_in %d, in0 %d, out %d, ws %zu; need ws >= %zu)\n", n_in, n_in > 0 ? in_sizes[0] : -1, out_size, ws_size, (size_t)WS_END); grid = -1; return; }
        int dev = 0, cus = 0;
        if (hipGetDevice(&dev) != hipSuccess || hipDeviceGetAttribute(&cus, hipDeviceAttributeMultiprocessorCount, dev) != hipSuccess) { grid = -1; return; }
        if (hipFuncSetAttribute((const void*)fwd_kernel, hipFuncAttributeMaxDynamicSharedMemorySize, LDS_BYTES) != hipSuccess) { fprintf(stderr, "kernel_launch: hipFuncSetAttribute failed\n"); grid = -1; return; }
        int per_cu = 0;
        if (hipOccupancyMaxActiveBlocksPerMultiprocessor(&per_cu, (const void*)fwd_kernel, NTHR, LDS_BYTES) != hipSuccess || per_cu < 1) fprintf(stderr, "kernel_launch: occupancy query reports %d\n", per_cu);
        (void)hipGetLastError();
        grid = cus;
        if (grid != 256) { fprintf(stderr, "kernel_launch: built for a 256-CU device (got %d CUs)\n", grid); grid = -1; return; }
    }
    if (grid < 0) return;
    (void)hipMemsetAsync((char*)d_ws + WS_CTL, 0, CTL_ZERO_BYTES, stream);
    Args a{};
    for (int i = 0; i < 17; ++i) a.in[i] = (const float*)d_in[i];
    a.out = (float*)d_out; a.ws = (unsigned char*)d_ws;
#if N_LAUNCH_MODE == 1
    a.ph_lo = 0; a.ph_hi = NPH;
    hipLaunchKernelGGL(fwd_kernel, dim3(grid), dim3(NTHR), LDS_BYTES, stream, a);
#else
    for (int ph = 0; ph < NPH; ++ph) { a.ph_lo = ph; a.ph_hi = ph + 1; hipLaunchKernelGGL(fwd_kernel, dim3(grid), dim3(NTHR), LDS_BYTES, stream, a); }
#endif
#if defined(PROBE_MX)
    hipLaunchKernelGGL(probe_mx_kernel, dim3(1), dim3(64), 0, stream, 0);
#endif
    const hipError_t le = hipPeekAtLastError();
    if (le != hipSuccess) fprintf(stderr, "kernel_launch: launch failed: %s\n", hipGetErrorName(le));
}
```

```cpp
#include <hip/hip_runtime.h>
#include <hip/hip_bf16.h>
#include <cstdio>
#include <cstdint>
#include <cmath>

#ifndef TBL_FP4
#define TBL_FP4 1
#endif
constexpr int S = 16384, DM = 2048, NWAVES = 8, NTHR = 512;
constexpr int INW = 5648, INP = 5888;
constexpr int C_AQ = 0, C_AK = 1024, C_AV = 1280, C_MQK = 1536, C_MV = 3584, C_MO = 4608, C_GATE = 5632;
constexpr float EPS = 1e-6f;
constexpr int NPH = 20;
enum { PH_PRO = 0, PH_GEMM_IN, PH_POST, PH_ATTN  , PH_SCAN, PH_MLB, PH_GEMM_OUT, PH_GEMM_Q0, PH_TOPK0, PH_GU0, PH_ACT0, PH_GV0,
       PH_POOLPREP, PH_GEMM_POOL, PH_GEMM_Q1, PH_TOPK1, PH_GU1, PH_ACT1, PH_GV1, PH_NORMF };

constexpr size_t MiB = 1u << 20;
constexpr size_t WS_CTL = 0, CTL_ZERO_BYTES = 1 * MiB;
constexpr size_t WS_WIN = 1 * MiB, WS_WOUT = 24 * MiB, WS_WQ0 = 32 * MiB, WS_WQ1 = 40 * MiB, WS_WPOOL = 48 * MiB, WS_KEYS = 50 * MiB;
constexpr size_t WS_TSC = 52 * MiB + 768 * 1024  , WS_GATES = 51 * MiB, WS_NST = 53 * MiB, WS_EIDX = 54 * MiB, WS_EGATE = 62 * MiB;
constexpr size_t WS_UB = 70 * MiB, WS_VB = 198 * MiB, WS_XN = 326 * MiB, WS_PROJ = 390 * MiB, WS_QP = WS_PROJ;
constexpr size_t WS_QB = 574 * MiB, WS_KVB = 606 * MiB, WS_MQ = 622 * MiB, WS_MK = 654 * MiB, WS_CST = 686 * MiB, WS_Y = 814 * MiB, WS_POOLED = WS_Y;
constexpr size_t WS_H = 878 * MiB, WS_END = 1006 * MiB;
constexpr size_t CTL_SSQ = 256 * 1024;
constexpr int CW_BAR = 4096;
constexpr size_t GO_B = 0, GO_U = 8 * S * 4, GO_PM = 2 * 8 * S * 4, GO_G = 3 * 8 * S * 4, GO_PML = GO_G + 4096, GO_MPREV = GO_PML + 4096;

constexpr int LDS_BYTES = 147456, LDSCTL_OFF = 146944;

#define GAS __attribute__((address_space(1)))
#define LAS __attribute__((address_space(3)))
typedef unsigned short bf16_t;
typedef short bf16x8 __attribute__((ext_vector_type(8)));
typedef short s16x4 __attribute__((ext_vector_type(4)));
typedef short v4i16_t __attribute__((ext_vector_type(4)));
typedef float f32x4 __attribute__((ext_vector_type(4)));
typedef float f32x2 __attribute__((ext_vector_type(2)));
typedef float f32x16 __attribute__((ext_vector_type(16)));
typedef unsigned u32x4 __attribute__((ext_vector_type(4)));
typedef unsigned u32x2 __attribute__((ext_vector_type(2)));
typedef __bf16 bf16x2_t __attribute__((ext_vector_type(2)));
typedef GAS unsigned gu32;
#define RLX_AGENT __ATOMIC_RELAXED, __HIP_MEMORY_SCOPE_AGENT
#define LDS_WAIT() asm volatile("s_waitcnt lgkmcnt(0)" ::: "memory")
__device__ __forceinline__ unsigned f2bf(float f) { unsigned u = __builtin_bit_cast(unsigned, f); return (u + 0x7fffu + ((u >> 16) & 1u)) >> 16; }
__device__ __forceinline__ unsigned pk2(float lo, float hi) { f32x2 v = {lo, hi}; bf16x2_t b = __builtin_convertvector(v, bf16x2_t); return __builtin_bit_cast(unsigned, b); }
__device__ __forceinline__ float bflo(unsigned w) { return __builtin_bit_cast(float, w << 16); }
__device__ __forceinline__ float bfhi(unsigned w) { return __builtin_bit_cast(float, w & 0xffff0000u); }
__device__ __forceinline__ float rstd_of(unsigned long long ss) { return 1.0f / sqrtf((float)ss * (1.0f / (1048576.0f * 2048.0f)) + 1e-6f); }
__device__ __forceinline__ void st_wt8(void* p, u32x2 v) { __hip_atomic_store((unsigned long long*)p, ((unsigned long long)v.y << 32) | v.x, __ATOMIC_RELAXED, __HIP_MEMORY_SCOPE_AGENT); }
__device__ __forceinline__ void st_wt8f(void* p, f32x2 v) { st_wt8(p, __builtin_bit_cast(u32x2, v)); }
__device__ __forceinline__ void st_wt16(void* p, u32x4 v) { asm volatile("global_store_dwordx4 %0, %1, off sc1" :: "v"(p), "v"(v) : "memory"); }
__device__ __forceinline__ void st_wt16f(void* p, f32x4 v) { st_wt16(p, __builtin_bit_cast(u32x4, v)); }
__device__ __forceinline__ float wave_sum(float v) {
#pragma unroll
    for (int o = 1; o < 64; o <<= 1) v += __shfl_xor(v, o);
    return v;
}

namespace pg8 {
#define PG8_LAS __attribute__((address_space(3)))
typedef unsigned short bf16_t;
typedef short bf16x8 __attribute__((ext_vector_type(8)));
typedef float f32x4 __attribute__((ext_vector_type(4)));
typedef unsigned u32x4 __attribute__((ext_vector_type(4)));
constexpr int BM = 256, BK = 64, HALF = 128, HTB = HALF * BK * 2  , STAGE_BYTES = 8 * HTB, NXCD = 8, WGM = 8;

__host__ __device__ __forceinline__ int lds_byte(int r, int c) { const int st = (r >> 4) * 2 + (c >> 5), rr = r & 15, cc = c & 31, ob = rr * 64 + cc * 2; return st * 1024 + (ob ^ (((ob >> 9) & 1) << 5)); }
__host__ __device__ __forceinline__ void stage_rc(int b, int& R, int& C) { const int st = b / 1024, sb = b % 1024, swz = sb ^ (((sb >> 9) & 1) << 5); R = (st >> 1) * 16 + swz / 64; C = (st & 1) * 32 + (swz % 64) / 2; }
__host__ __device__ __forceinline__ int perm32(int rho) { const int n = rho >> 4, i = rho & 15; return 8 * (i >> 2) + 4 * n + (i & 3); }

struct Unit { int pm, pn; };
struct Gemm { const bf16_t* A; const bf16_t* Bt; int M, N, K, lda, ldb, agrp_shift; size_t agrp_bytes; };

struct StaticOrder {
    int nM, nN, nwg, G, c;
    __host__ __device__ void init(int M, int N, int G_, int c_) { nM = M / BM; nN = N / BM; nwg = nM * nN; G = G_; c = c_; }
    __host__ __device__ bool next(int i, Unit& u) const {
        const long L = (long)i * G + c; if (L >= nwg) return false;
        int wgid = (int)L; { const int q = nwg / NXCD, r = nwg % NXCD, xcd = wgid % NXCD, off = wgid / NXCD; wgid = (xcd < r ? xcd * (q + 1) : r * (q + 1) + (xcd - r) * q) + off; }
        const int nig = WGM * nN, gid = wgid / nig, fm = gid * WGM, gsz = (nM - fm) < WGM ? (nM - fm) : WGM;
        u.pm = fm + ((wgid % nig) % gsz); u.pn = (wgid % nig) / gsz; return true;
    }
    __device__ __forceinline__ void a_ready(const Unit&) const {}
    __device__ __forceinline__ void done(const Unit&) const {}
};

__device__ __forceinline__ unsigned cvt_pk_bf16(float lo, float hi) { unsigned r; asm volatile("v_cvt_pk_bf16_f32 %0, %1, %2" : "=v"(r) : "v"(lo), "v"(hi)); return r; }
typedef float f32x2 __attribute__((ext_vector_type(2)));
__device__ __forceinline__ f32x2 gelu_pk(f32x2 v) {
    const f32x2 av = __builtin_elementwise_abs(v), d = av * 0.2316418882f + 1.0f;
    f32x2 t; t.x = __builtin_amdgcn_rcpf(d.x); t.y = __builtin_amdgcn_rcpf(d.y);
    f32x2 q = t * 0.5307027145f + (-0.7265760135f); q = q * t + 0.7107068705f; q = q * t + (-0.142248368f); q = q * t + 0.127414796f; q = q * t;
    const f32x2 s = (v * v) * (-0.72134752044f);
    f32x2 e; e.x = __builtin_amdgcn_exp2f(s.x); e.y = __builtin_amdgcn_exp2f(s.y);
    const f32x2 m = v * (q * e), r = v - m;
    f32x2 o; o.x = v.x < 0.f ? m.x : r.x; o.y = v.y < 0.f ? m.y : r.y; return o;
}
template <int ACT  > struct EpiBf16 {
    static constexpr bool PERM = true, AFTER_DRAIN = false; static_assert(ACT == 0 || ACT == 1, "EpiBf16: ACT is 0 (none) or 1 (gelu_pk)");
    bf16_t* O; int ldc; const float* bias; int split_cols; size_t split_stride; float scale0;
    __device__ __forceinline__ void operator()(const f32x4 (&acc)[2][2][4][2], const Unit& u, int wr, int wc, int fr, int fq) const {
        const int row0 = u.pm * BM + wr * 64 + fr; int colt = u.pn * BM; bf16_t* base = O;
        float sc = 1.f; if (split_cols) { const int t = colt / split_cols; base += (size_t)t * split_stride; colt -= t * split_cols; if (t == 0) sc = scale0; }
        const int col0 = colt + wc * 32 + 8 * fq, bcol0 = u.pn * BM + wc * 32 + 8 * fq;
        f32x4 bv[2][2];
#pragma unroll
        for (int bj = 0; bj < 2; ++bj)
#pragma unroll
            for (int n = 0; n < 2; ++n) bv[bj][n] = bias ? *(const f32x4*)(bias + bcol0 + bj * HALF + 4 * n) : (f32x4){0.f, 0.f, 0.f, 0.f};
#pragma unroll
        for (int ai = 0; ai < 2; ++ai)
#pragma unroll
            for (int m = 0; m < 4; ++m) { bf16_t* rowp = base + (size_t)(row0 + ai * HALF + m * 16) * ldc + col0;
#pragma unroll
                for (int bj = 0; bj < 2; ++bj) { f32x4 v0 = acc[ai][bj][m][0] + bv[bj][0], v1 = acc[ai][bj][m][1] + bv[bj][1];
                    if (ACT == 1) { f32x2 a = gelu_pk((f32x2){v0[0], v0[1]}), b = gelu_pk((f32x2){v0[2], v0[3]}), c = gelu_pk((f32x2){v1[0], v1[1]}), d = gelu_pk((f32x2){v1[2], v1[3]});
                        v0 = (f32x4){a.x, a.y, b.x, b.y}; v1 = (f32x4){c.x, c.y, d.x, d.y}; }
                    v0 = v0 * sc; v1 = v1 * sc; u32x4 w; w.x = cvt_pk_bf16(v0[0], v0[1]); w.y = cvt_pk_bf16(v0[2], v0[3]); w.z = cvt_pk_bf16(v1[0], v1[1]); w.w = cvt_pk_bf16(v1[2], v1[3]);
                    *(u32x4*)(rowp + bj * HALF) = w; } }
    }
};
template <bool BASE_BF16> struct EpiRes {
    static constexpr bool PERM = false, AFTER_DRAIN = false;
    const void* base; bf16_t* hb; int ldc; const float* colscale; unsigned long long* ssq;
    __device__ __forceinline__ void operator()(const f32x4 (&acc)[2][2][4][2], const Unit& u, int wr, int wc, int fr, int fq) const {
        typedef unsigned u32x2v __attribute__((ext_vector_type(2)));
        const int row0 = u.pm * BM + wr * 64 + fr, col0 = u.pn * BM + wc * 32 + 4 * fq;
        f32x4 cs[2][2];
#pragma unroll
        for (int bj = 0; bj < 2; ++bj)
#pragma unroll
            for (int n = 0; n < 2; ++n) cs[bj][n] = colscale ? *(const f32x4*)(colscale + col0 + bj * HALF + n * 16) : (f32x4){1.f, 1.f, 1.f, 1.f};
#pragma unroll
        for (int ai = 0; ai < 2; ++ai)
#pragma unroll
            for (int m = 0; m < 4; ++m) { const size_t off = (size_t)(row0 + ai * HALF + m * 16) * ldc + col0;
                float ssum = 0.f;
#pragma unroll
                for (int bj = 0; bj < 2; ++bj)
#pragma unroll
                    for (int n = 0; n < 2; ++n) { f32x4 b;
                        if (BASE_BF16) { const u32x2v w = *(const u32x2v*)((const bf16_t*)base + off + bj * HALF + n * 16);
                            b = (f32x4){__builtin_bit_cast(float, w.x << 16), __builtin_bit_cast(float, w.x & 0xffff0000u), __builtin_bit_cast(float, w.y << 16), __builtin_bit_cast(float, w.y & 0xffff0000u)}; }
                        else b = *(const f32x4*)((const float*)base + off + bj * HALF + n * 16);
                        const f32x4 h = b + acc[ai][bj][m][n] * cs[bj][n];
                        u32x2v w; w.x = cvt_pk_bf16(h[0], h[1]); w.y = cvt_pk_bf16(h[2], h[3]); *(u32x2v*)(hb + off + bj * HALF + n * 16) = w;
                        ssum += (h[0] * h[0] + h[1] * h[1]) + (h[2] * h[2] + h[3] * h[3]); }
                if (ssq) { ssum += __shfl_xor(ssum, 16); ssum += __shfl_xor(ssum, 32);
                    if (fq == 0) atomicAdd(ssq + (row0 + ai * HALF + m * 16), (unsigned long long)(ssum * 1048576.0f)); }
                asm volatile("" ::: "memory"); }
    }
};

struct EpiBf16Row {
    static constexpr bool PERM = true, AFTER_DRAIN = false;
    bf16_t* O; int ldc; const unsigned long long* ssq; float inv_ncol, eps;
    __device__ __forceinline__ void operator()(const f32x4 (&acc)[2][2][4][2], const Unit& u, int wr, int wc, int fr, int fq) const {
        const int row0 = u.pm * BM + wr * 64 + fr, col0 = u.pn * BM + wc * 32 + 8 * fq;
#pragma unroll
        for (int ai = 0; ai < 2; ++ai)
#pragma unroll
            for (int m = 0; m < 4; ++m) { const int row = row0 + ai * HALF + m * 16; bf16_t* rowp = O + (size_t)row * ldc + col0;
                const float sc = ssq ? 1.0f / sqrtf((float)ssq[row] * (inv_ncol * (1.0f / 1048576.0f)) + eps) : 1.f;
#pragma unroll
                for (int bj = 0; bj < 2; ++bj) { const f32x4 v0 = acc[ai][bj][m][0] * sc, v1 = acc[ai][bj][m][1] * sc;
                    u32x4 w; w.x = cvt_pk_bf16(v0[0], v0[1]); w.y = cvt_pk_bf16(v0[2], v0[3]); w.z = cvt_pk_bf16(v1[0], v1[1]); w.w = cvt_pk_bf16(v1[2], v1[3]);
                    *(u32x4*)(rowp + bj * HALF) = w; } }
    }
};

template <class Epi, class Sched, bool ALIGN_EPI = false, bool SP2 = false>
__device__ __forceinline__ void gemm_phase(PG8_LAS unsigned char* lds, const Gemm g, const Sched& S, const Epi& E) {
    int tid_ = threadIdx.x; asm volatile("" : "+v"(tid_));
    const int tid = tid_, wid = __builtin_amdgcn_readfirstlane(tid >> 6), lane = tid & 63, wr = wid >> 2, wc = wid & 3, fr = lane & 15, fq = lane >> 4;
    const int K = g.K, nt = K / BK;
    unsigned voffA[2], voffB[2];
#pragma unroll
    for (int i = 0; i < 2; ++i) { int R, C; stage_rc(tid * 16 + i * 8192, R, C); const int Rb = Epi::PERM ? ((R & ~31) + perm32(R & 31)) : R;
        voffA[i] = (unsigned)(R * g.lda + C) * 2u; voffB[i] = (unsigned)(Rb * g.ldb + C) * 2u; }
    const size_t kstep = (size_t)(BK * 2);
    const size_t hstepA = (size_t)HALF * g.lda * 2, hstepB = (size_t)HALF * g.ldb * 2;
    const size_t tstepA = 2 * hstepA, tstepB = 2 * hstepB;
    const unsigned ldsw = (unsigned)wid * 1024u;
    const int aoff = lds_byte(wr * 64 + fr, fq * 8), boff = lds_byte(wc * 32 + fr, fq * 8);
#define PG8_SA(b, h) (((b) * 2 + (h)) * HTB)
#define PG8_SB(b, h) ((4 + (b) * 2 + (h)) * HTB)
#define PG8_STAGE(bufoff, gbase, voff) do { _Pragma("unroll") for (int _i = 0; _i < 2; ++_i) \
        __builtin_amdgcn_global_load_lds((const unsigned*)((const char*)(gbase) + (voff)[_i]), (PG8_LAS unsigned*)(lds + (bufoff) + ldsw + _i * 8192), 16, 0, 0); } while (0)
#define PG8_LDA(dst, b, h) do { _Pragma("unroll") for (int m = 0; m < 4; ++m) _Pragma("unroll") for (int k = 0; k < 2; ++k) dst[m][k] = *(const PG8_LAS bf16x8*)(lds + PG8_SA(b, h) + aoff + m * 2048 + k * 1024); } while (0)
#define PG8_LDB(dst, b, h) do { _Pragma("unroll") for (int n = 0; n < 2; ++n) _Pragma("unroll") for (int k = 0; k < 2; ++k) dst[n][k] = *(const PG8_LAS bf16x8*)(lds + PG8_SB(b, h) + boff + n * 2048 + k * 1024); } while (0)
#define PG8_MMA(ai, bj, At, Bt) do { __builtin_amdgcn_s_setprio(1); _Pragma("unroll") for (int m = 0; m < 4; ++m) _Pragma("unroll") for (int n = 0; n < 2; ++n) _Pragma("unroll") for (int k = 0; k < 2; ++k) \
        acc[ai][bj][m][n] = __builtin_amdgcn_mfma_f32_16x16x32_bf16(Bt[n][k], At[m][k], acc[ai][bj][m][n], 0, 0, 0); __builtin_amdgcn_s_setprio(0); } while (0)
#define PG8_WAIT_V(n) asm volatile("s_waitcnt vmcnt(" #n ")" ::: "memory")
#define PG8_WAIT_L(n) asm volatile("s_waitcnt lgkmcnt(" #n ")" ::: "memory")
#define PG8_BAR __builtin_amdgcn_s_barrier()
#define PG8_SCHED __builtin_amdgcn_sched_barrier(0)
    Unit cur, nxt; int ui = 0;
    if (!S.next(0, cur)) return;
    f32x4 acc[2][2][4][2];
#pragma unroll
    for (int a = 0; a < 2; ++a)
#pragma unroll
        for (int b = 0; b < 2; ++b)
#pragma unroll
            for (int m = 0; m < 4; ++m)
#pragma unroll
                for (int n = 0; n < 2; ++n) acc[a][b][m][n] = (f32x4){0.f, 0.f, 0.f, 0.f};
    bf16x8 At[4][2], B0[2][2], B1[2][2];
    const char* cA = (const char*)g.A + (size_t)cur.pm * tstepA + (size_t)(cur.pn >> g.agrp_shift) * g.agrp_bytes; const char* cB = (const char*)g.Bt + (size_t)cur.pn * tstepB;
    S.a_ready(cur);
    if constexpr (SP2) {
        PG8_STAGE(PG8_SB(0, 0), cB, voffB); PG8_STAGE(PG8_SB(0, 1), cB + hstepB, voffB); PG8_STAGE(PG8_SA(0, 0), cA, voffA); PG8_STAGE(PG8_SA(0, 1), cA + hstepA, voffA);
        if (wr == 1) PG8_BAR;
        PG8_WAIT_V(2); PG8_BAR;
        PG8_STAGE(PG8_SB(1, 0), cB + kstep, voffB); PG8_STAGE(PG8_SA(1, 0), cA + kstep, voffA); PG8_STAGE(PG8_SB(1, 1), cB + hstepB + kstep, voffB);
        PG8_WAIT_V(6); PG8_BAR;
    } else {
        PG8_STAGE(PG8_SB(0, 0), cB, voffB); PG8_STAGE(PG8_SA(0, 0), cA, voffA); PG8_STAGE(PG8_SB(0, 1), cB + hstepB, voffB); PG8_STAGE(PG8_SA(0, 1), cA + hstepA, voffA);
        if (wr == 1) PG8_BAR;
        PG8_WAIT_V(4); PG8_BAR;
        PG8_STAGE(PG8_SB(1, 0), cB + kstep, voffB); PG8_STAGE(PG8_SA(1, 0), cA + kstep, voffA); PG8_STAGE(PG8_SB(1, 1), cB + hstepB + kstep, voffB);
        PG8_WAIT_V(6); PG8_BAR;
    }
    for (;;) {
        const bool has_next = S.next(ui + 1, nxt);
        const char* nA = has_next ? (const char*)g.A + (size_t)nxt.pm * tstepA + (size_t)(nxt.pn >> g.agrp_shift) * g.agrp_bytes : cA; const char* nB = has_next ? (const char*)g.Bt + (size_t)nxt.pn * tstepB : cB;
        for (int t = 0; t < nt; t += 2) {
            const bool last = (t == nt - 2);
            const char* a1 = cA + (size_t)(t + 1) * kstep;
            const char* a2 = last ? nA : cA + (size_t)(t + 2) * kstep; const char* b2 = last ? nB : cB + (size_t)(t + 2) * kstep;
            const char* a3 = a2 + kstep; const char* b3 = b2 + kstep;
            if (last && has_next) S.a_ready(nxt);
            if constexpr (SP2) {
            PG8_LDB(B0, 0, 0); PG8_LDB(B1, 0, 1); PG8_SCHED; PG8_LDA(At, 0, 0); PG8_STAGE(PG8_SA(1, 1), a1 + hstepA, voffA);
            PG8_WAIT_V(8); PG8_WAIT_L(0); PG8_BAR; PG8_MMA(0, 0, At, B0); PG8_MMA(0, 1, At, B1); PG8_BAR; PG8_SCHED;
            PG8_LDA(At, 0, 1); PG8_STAGE(PG8_SB(0, 0), b2, voffB); PG8_STAGE(PG8_SB(0, 1), b2 + hstepB, voffB); PG8_STAGE(PG8_SA(0, 0), a2, voffA);
            PG8_WAIT_V(8); PG8_WAIT_L(0); PG8_BAR; PG8_MMA(1, 0, At, B0); PG8_MMA(1, 1, At, B1); PG8_BAR; PG8_SCHED;
            PG8_LDB(B0, 1, 0); PG8_LDB(B1, 1, 1); PG8_SCHED; PG8_LDA(At, 1, 0); PG8_STAGE(PG8_SA(0, 1), a2 + hstepA, voffA);
            PG8_WAIT_V(8); PG8_WAIT_L(0); PG8_BAR; PG8_MMA(0, 0, At, B0); PG8_MMA(0, 1, At, B1); PG8_BAR; PG8_SCHED;
            PG8_LDA(At, 1, 1); PG8_STAGE(PG8_SB(1, 0), b3, voffB); PG8_STAGE(PG8_SB(1, 1), b3 + hstepB, voffB); PG8_STAGE(PG8_SA(1, 0), a3, voffA);
            PG8_WAIT_V(8); PG8_WAIT_L(0); PG8_BAR; PG8_MMA(1, 0, At, B0); PG8_MMA(1, 1, At, B1); PG8_BAR; PG8_SCHED;
            } else {
            PG8_LDB(B0, 0, 0); PG8_SCHED; PG8_LDA(At, 0, 0); PG8_STAGE(PG8_SA(1, 1), a1 + hstepA, voffA);
            PG8_WAIT_L(8); PG8_BAR; PG8_WAIT_L(0); PG8_MMA(0, 0, At, B0); PG8_BAR; PG8_SCHED;
            PG8_LDB(B1, 0, 1); PG8_STAGE(PG8_SB(0, 0), b2, voffB);
            PG8_BAR; PG8_WAIT_L(0); PG8_MMA(0, 1, At, B1); PG8_BAR;
            PG8_LDA(At, 0, 1); PG8_STAGE(PG8_SA(0, 0), a2, voffA);
            PG8_BAR; PG8_WAIT_L(0); PG8_MMA(1, 0, At, B0); PG8_BAR; PG8_SCHED;
            PG8_STAGE(PG8_SB(0, 1), b2 + hstepB, voffB);
            PG8_WAIT_V(6); PG8_BAR; PG8_MMA(1, 1, At, B1); PG8_BAR;
            PG8_LDB(B0, 1, 0); PG8_SCHED; PG8_LDA(At, 1, 0); PG8_STAGE(PG8_SA(0, 1), a2 + hstepA, voffA);
            PG8_WAIT_L(8); PG8_BAR; PG8_WAIT_L(0); PG8_MMA(0, 0, At, B0); PG8_BAR; PG8_SCHED;
            PG8_LDB(B1, 1, 1); PG8_STAGE(PG8_SB(1, 0), b3, voffB);
            PG8_BAR; PG8_WAIT_L(0); PG8_MMA(0, 1, At, B1); PG8_BAR;
            PG8_LDA(At, 1, 1); PG8_STAGE(PG8_SA(1, 0), a3, voffA);
            PG8_BAR; PG8_WAIT_L(0); PG8_MMA(1, 0, At, B0); PG8_BAR; PG8_SCHED;
            PG8_STAGE(PG8_SB(1, 1), b3 + hstepB, voffB);
            PG8_WAIT_V(6); PG8_BAR; PG8_MMA(1, 1, At, B1); PG8_BAR;
            }
        }
        if constexpr (ALIGN_EPI) { if (wr == 0) PG8_BAR; }
        if constexpr (!Epi::AFTER_DRAIN) { E(acc, cur, wr, wc, fr, fq); S.done(cur); }
        if (!has_next) break;
#pragma unroll
        for (int a = 0; a < 2; ++a)
#pragma unroll
            for (int b = 0; b < 2; ++b)
#pragma unroll
                for (int m = 0; m < 4; ++m)
#pragma unroll
                    for (int n = 0; n < 2; ++n) acc[a][b][m][n] = (f32x4){0.f, 0.f, 0.f, 0.f};
        cur = nxt; cA = nA; cB = nB; ++ui;
        if constexpr (ALIGN_EPI) { if (wr == 1) PG8_BAR; }
    }
    PG8_WAIT_V(0);
    if constexpr (!ALIGN_EPI) { if (wr == 0) PG8_BAR; }
    PG8_BAR;
    if constexpr (Epi::AFTER_DRAIN) { E.fused(acc, cur, wr, wc, fr, fq, lds, wid, lane); S.done(cur); }
#undef PG8_SA
#undef PG8_SB
#undef PG8_STAGE
#undef PG8_LDA
#undef PG8_LDB
#undef PG8_MMA
#undef PG8_WAIT_V
#undef PG8_WAIT_L
#undef PG8_BAR
#undef PG8_SCHED
}
}
#define XB_TMO      128
#define XB_XCNT(j)  (256  + 64 * (j))
#define XB_XSUB(j)  (1280 + 64 * (j))
#define XB_XGEN(j)  (2304 + 64 * (j))
#define XB_TOP      3328
#define XB_TOPGEN   3392
#define XCD_BAR_WORDS 3456
#define XB_SPIN_CAP (1u << 18)

__device__ __forceinline__ unsigned xb_ld(unsigned* p)              { return __hip_atomic_load(p, __ATOMIC_RELAXED, __HIP_MEMORY_SCOPE_AGENT); }
__device__ __forceinline__ unsigned xb_add(unsigned* p, unsigned v) { return __hip_atomic_fetch_add(p, v, __ATOMIC_RELAXED, __HIP_MEMORY_SCOPE_AGENT); }
__device__ __forceinline__ unsigned xb_xcc_id() { return (unsigned)__builtin_amdgcn_s_getreg((3 << 11) | 20) & 0xFu; }
#define XB_SPIN(cond, bar) do { unsigned _sp = 0; while (cond) { __builtin_amdgcn_s_sleep(1); \
    if ((++_sp & 255u) == 0u) { if (xb_ld(&(bar)[XB_TMO])) break; if (_sp > XB_SPIN_CAP) { atomicAdd(&(bar)[XB_TMO], 1u); break; } } } } while (0)

struct XcdBarrier {
    unsigned* bar; unsigned x;
    volatile LAS unsigned* st;
};

__device__ __forceinline__ XcdBarrier xcd_barrier_post(unsigned* bar, volatile LAS unsigned* st) {
    XcdBarrier b; b.bar = bar; b.x = xb_xcc_id(); b.st = st;
    if (threadIdx.x == 0) (void)xb_add(&bar[XB_XCNT(b.x)], 1u);
    return b;
}
__device__ __forceinline__ void xcd_barrier_complete(unsigned* bar, unsigned x, unsigned& nloc, unsigned& nx) {
    const unsigned G = gridDim.x * gridDim.y * gridDim.z;
    unsigned sum, cnt, mine, sp = 0u;
    for (;;) {
        sum = 0u; cnt = 0u; mine = 0u;
#pragma unroll
        for (unsigned j = 0; j < 16; ++j) { const unsigned c = xb_ld(&bar[XB_XCNT(j)]); sum += c; cnt += (c > 0u) ? 1u : 0u; mine = (j == x) ? c : mine; }
        if (sum == G) break;
        __builtin_amdgcn_s_sleep(1);
        if ((++sp & 255u) == 0u) { if (xb_ld(&bar[XB_TMO])) break; if (sp > XB_SPIN_CAP) { atomicAdd(&bar[XB_TMO], 1u); break; } }
    }
    nloc = mine > 0u ? mine : 1u; nx = cnt > 0u ? cnt : 1u;
}

__device__ __forceinline__ void xcd_barrier(const XcdBarrier& b) {
    asm volatile("s_waitcnt vmcnt(0)" ::: "memory");
    __syncthreads();
    if (threadIdx.x == 0) {
        unsigned* bar = b.bar;
        __builtin_amdgcn_s_waitcnt(0);
        unsigned nloc = b.st[0], nx = b.st[1];
        if (nloc == 0u) { xcd_barrier_complete(bar, b.x, nloc, nx); b.st[0] = nloc; b.st[1] = nx; }
        const unsigned old = xb_add(&bar[XB_XSUB(b.x)], 1u);
        const unsigned gen = old / nloc;
        if (old + 1u == (gen + 1u) * nloc) {
            __builtin_amdgcn_fence(__ATOMIC_RELEASE, "agent");
            asm volatile("s_waitcnt vmcnt(0)" ::: "memory");
            const unsigned og = xb_add(&bar[XB_TOP], 1u);
            const unsigned tg = og / nx;
            if (og + 1u == (tg + 1u) * nx) xb_add(&bar[XB_TOPGEN], 1u);
            else XB_SPIN(xb_ld(&bar[XB_TOPGEN]) == tg, bar);
            __builtin_amdgcn_fence(__ATOMIC_ACQUIRE, "agent");
            xb_add(&bar[XB_XGEN(b.x)], 1u);
            asm volatile("s_waitcnt vmcnt(0)" ::: "memory");
        } else {
            XB_SPIN(xb_ld(&bar[XB_XGEN(b.x)]) == gen, bar);
            __builtin_amdgcn_fence(__ATOMIC_ACQUIRE, "agent");
            asm volatile("s_waitcnt vmcnt(0)" ::: "memory");
        }
    }
    __syncthreads();
}
namespace att {
using bf16 = __hip_bfloat16;
constexpr int   D = 128, NW = 8, QBLK = 32, KVBLK = 64;
constexpr float SCALE = 0.088388347648318440f;
constexpr float THR = 8.f;
constexpr int SDEPTH = 1;
constexpr int LDQ = 1024, LDK = 512, LDO = 2048;
constexpr size_t SHM_V = KVBLK * D * 2, SHM_K = KVBLK * D * 2, SHM_ATTN = 2 * SHM_V + 2 * SHM_K + NW * 64 * 4;
using bf16x8 = __attribute__((ext_vector_type(8))) short;
using s16x4  = __attribute__((ext_vector_type(4))) short;
using f32x16 = __attribute__((ext_vector_type(16))) float;
using f32x8  = __attribute__((ext_vector_type(8))) float;
using u32x4  = __attribute__((ext_vector_type(4))) unsigned;
#define KSWZ(row, colB) ((row) * 256 + ((colB) ^ (((row) & 7) << 4)))
#define SBAR() __builtin_amdgcn_sched_barrier(0)
__device__ __forceinline__ int crow(int r, int hi) { return (r & 3) + 8 * (r >> 2) + 4 * hi; }
__device__ __forceinline__ unsigned cvtpk(float lo, float hi) {
  unsigned r; asm volatile("v_cvt_pk_bf16_f32 %0, %1, %2" : "=v"(r) : "v"(lo), "v"(hi)); return r;
}
template <typename TIn> struct Stage;
template <> struct Stage<bf16>  { using T = bf16x8;
  __device__ static __forceinline__ T ld8(const bf16* p) { return *reinterpret_cast<const bf16x8*>(p); }
  __device__ static __forceinline__ bf16x8 tobf(T x) { return x; } };
template <> struct Stage<float> { using T = f32x8;
  __device__ static __forceinline__ T ld8(const float* p) { return *reinterpret_cast<const f32x8*>(p); }
  __device__ static __forceinline__ bf16x8 tobf(T x) {
    u32x4 w = {cvtpk(x[0], x[1]), cvtpk(x[2], x[3]), cvtpk(x[4], x[5]), cvtpk(x[6], x[7])}; return *reinterpret_cast<bf16x8*>(&w); } };

__device__ __forceinline__ void partialSM(f32x16& p0, f32x16& p1, float mC) {
  constexpr float C = SCALE * 1.4426950408889634f;
  for (int r = 0; r < 16; ++r) p0[r] = fmaf(p0[r], C, mC); for (int r = 0; r < 16; ++r) p1[r] = fmaf(p1[r], C, mC);
  for (int r = 0; r < 16; ++r) p0[r] = __builtin_amdgcn_exp2f(p0[r]);
}
__device__ __forceinline__ void finishSM(f32x16& p0, f32x16& p1, float& l_reg, bf16x8& pa0, bf16x8& pa1, bf16x8& pa2, bf16x8& pa3) {
  for (int r = 0; r < 16; ++r) p1[r] = __builtin_amdgcn_exp2f(p1[r]);
  float ps = 0; for (int r = 0; r < 16; ++r) ps += p0[r]; for (int r = 0; r < 16; ++r) ps += p1[r];
  l_reg += ps;
#define PK4(P, BASE, OUT) do { unsigned a0 = cvtpk(P[BASE + 0], P[BASE + 1]), a1 = cvtpk(P[BASE + 2], P[BASE + 3]);   \
    unsigned b0 = cvtpk(P[BASE + 4], P[BASE + 5]), b1 = cvtpk(P[BASE + 6], P[BASE + 7]);                              \
    auto r0 = __builtin_amdgcn_permlane32_swap(a0, b0, false, false); auto r1 = __builtin_amdgcn_permlane32_swap(a1, b1, false, false); \
    u32x4 w = {r0[0], r1[0], r0[1], r1[1]}; OUT = *reinterpret_cast<bf16x8*>(&w); } while (0)
  PK4(p0, 0, pa0); PK4(p0, 8, pa1); PK4(p1, 0, pa2); PK4(p1, 8, pa3);
#undef PK4
}
__device__ __forceinline__ void qkt(f32x16& p0, f32x16& p1, const bf16* Ks, const bf16x8* qr, int r32, int hi) {
  p0 = f32x16{}; p1 = f32x16{};
  for (int d0 = 0; d0 < 8; ++d0) { int cb = (d0 * 16 + hi * 8) * 2;
    bf16x8 b0 = *reinterpret_cast<const bf16x8*>((const char*)Ks + KSWZ(r32, cb));
    bf16x8 b1 = *reinterpret_cast<const bf16x8*>((const char*)Ks + KSWZ(32 + r32, cb));
    p0 = __builtin_amdgcn_mfma_f32_32x32x16_bf16(b0, qr[d0], p0, 0, 0, 0);
    p1 = __builtin_amdgcn_mfma_f32_32x32x16_bf16(b1, qr[d0], p1, 0, 0, 0); }
}
__device__ __forceinline__ int v_st(int k, int c) { const int kk = (k & ~0xC) | ((k & 4) << 1) | ((k & 8) >> 1); return ((kk >> 3) * 4 + (c >> 5)) * 512 + ((kk & 7) * 32 + (c & 31)) * 2; }
__device__ __forceinline__ int v_rd_base(int lane) { return ((lane & 3) << 3) | (((lane >> 2) & 3) << 6) | (((lane >> 4) & 1) << 5) | (((lane >> 5) & 1) << 8); }
constexpr int v_rd_off(int d0, int ks, int half) { return d0 * 512 + ks * 4096 + half * 2048; }
template <int OFF> __device__ __forceinline__ s16x4 tr_read(int vb) {
  s16x4 r; asm volatile("ds_read_b64_tr_b16 %0, %1 offset:%2" : "=&v"(r) : "v"(vb), "i"(OFF) : "memory"); return r;
}
template <int D0> __device__ __forceinline__ void pv_one(f32x16& od, int vb, bf16x8 pa0, bf16x8 pa1, bf16x8 pa2, bf16x8 pa3) {
  const s16x4 l0 = tr_read<v_rd_off(D0, 0, 0)>(vb), h0 = tr_read<v_rd_off(D0, 0, 1)>(vb), l1 = tr_read<v_rd_off(D0, 1, 0)>(vb), h1 = tr_read<v_rd_off(D0, 1, 1)>(vb);
  const s16x4 l2 = tr_read<v_rd_off(D0, 2, 0)>(vb), h2 = tr_read<v_rd_off(D0, 2, 1)>(vb), l3 = tr_read<v_rd_off(D0, 3, 0)>(vb), h3 = tr_read<v_rd_off(D0, 3, 1)>(vb);
  asm volatile("s_waitcnt lgkmcnt(0)" ::: "memory"); SBAR();
#define PK(L, H) (bf16x8){L[0], L[1], L[2], L[3], H[0], H[1], H[2], H[3]}
  od = __builtin_amdgcn_mfma_f32_32x32x16_bf16(pa0, PK(l0, h0), od, 0, 0, 0);
  od = __builtin_amdgcn_mfma_f32_32x32x16_bf16(pa1, PK(l1, h1), od, 0, 0, 0);
  od = __builtin_amdgcn_mfma_f32_32x32x16_bf16(pa2, PK(l2, h2), od, 0, 0, 0);
  od = __builtin_amdgcn_mfma_f32_32x32x16_bf16(pa3, PK(l3, h3), od, 0, 0, 0);
#undef PK
}
__device__ __forceinline__ void pv_d0(f32x16* o, int vb, bf16x8 pa0, bf16x8 pa1, bf16x8 pa2, bf16x8 pa3) {
  pv_one<0>(o[0], vb, pa0, pa1, pa2, pa3); pv_one<1>(o[1], vb, pa0, pa1, pa2, pa3); pv_one<2>(o[2], vb, pa0, pa1, pa2, pa3); pv_one<3>(o[3], vb, pa0, pa1, pa2, pa3);
}

template <typename TQ>
__device__ __forceinline__ void attn_dense_body(const TQ* __restrict__ Qb, const bf16* __restrict__ Kh, const bf16* __restrict__ Vh,
                                                bf16* __restrict__ Ob, int seq, char* lds, float mC) {
  using St = Stage<bf16>; using SQ = Stage<TQ>;
  int tid_ = threadIdx.x; asm volatile("" : "+v"(tid_));
  const int tid = tid_, wid = tid >> 6, lane = tid & 63, r32 = lane & 31, hi = lane >> 5;
  bf16* V_lds = (bf16*)lds; bf16* K_lds = (bf16*)(lds + 2 * SHM_V);
  float* ws = (float*)(lds + 2 * SHM_V + 2 * SHM_K) + wid * 64; float* li_l = ws;
  float l_reg = 0; f32x16 o[4] = {}; bf16x8 qr[8];
  const TQ* Qw = Qb + (long)(wid * QBLK + r32) * LDQ + hi * 8;
#pragma unroll
  for (int d0 = 0; d0 < 8; ++d0) qr[d0] = SQ::tobf(SQ::ld8(Qw + d0 * 16));
  const int sr = tid >> 4, sc = (tid & 15) * 8, vst0 = v_st(sr, sc), vst1 = v_st(32 + sr, sc);
  const int vb0 = (int)(uintptr_t)V_lds + v_rd_base(lane);
  struct { typename St::T vs0, vs1, ks0, ks1; } sr_[SDEPTH];
#define SLOAD(i, k0) do { sr_[i].vs0 = St::ld8(&Vh[(long)((k0) + sr) * LDK + sc]); sr_[i].vs1 = St::ld8(&Vh[(long)((k0) + 32 + sr) * LDK + sc]); \
    sr_[i].ks0 = St::ld8(&Kh[(long)((k0) + sr) * LDK + sc]); sr_[i].ks1 = St::ld8(&Kh[(long)((k0) + 32 + sr) * LDK + sc]); } while (0)
#define SWRITE(b, i) do { *(bf16x8*)((char*)V_lds + (b) * SHM_V + vst0) = St::tobf(sr_[i].vs0);          \
    *(bf16x8*)((char*)V_lds + (b) * SHM_V + vst1) = St::tobf(sr_[i].vs1); int kc = sc * 2;               \
    *(bf16x8*)((char*)K_lds + (b) * SHM_K + KSWZ(sr, kc)) = St::tobf(sr_[i].ks0);                       \
    *(bf16x8*)((char*)K_lds + (b) * SHM_K + KSWZ(32 + sr, kc)) = St::tobf(sr_[i].ks1); } while (0)
#define SWAIT() do { if constexpr (SDEPTH == 2) asm volatile("s_waitcnt vmcnt(4)" ::: "memory"); else asm volatile("s_waitcnt vmcnt(0)" ::: "memory"); } while (0)
  f32x16 pA0, pA1, pB0, pB1; bf16x8 pa0, pa1, pa2, pa3; const int NT = seq / KVBLK;
  constexpr int SE = 0, SO = SDEPTH - 1;
  SLOAD(SE, 0); asm volatile("s_waitcnt vmcnt(0)" ::: "memory"); SWRITE(0, SE); __syncthreads();
  qkt(pA0, pA1, K_lds, qr, r32, hi); partialSM(pA0, pA1, mC);
  SLOAD(SO, KVBLK); if constexpr (SDEPTH == 2) { if (2 < NT) SLOAD(SE, 2 * KVBLK); }
  SWAIT(); SWRITE(1, SO); __syncthreads();
  for (int j = 1; j + 1 < NT; j += 2) {
    SBAR(); qkt(pB0, pB1, (bf16*)((char*)K_lds + SHM_K), qr, r32, hi);
    finishSM(pA0, pA1, l_reg, pa0, pa1, pa2, pa3); SBAR();
    SLOAD(SO, (j + SDEPTH) * KVBLK); SBAR();
    pv_d0(o, vb0, pa0, pa1, pa2, pa3); partialSM(pB0, pB1, mC);
    __syncthreads(); SWAIT(); SWRITE(0, SE);
    __syncthreads();
    SBAR(); qkt(pA0, pA1, K_lds, qr, r32, hi);
    finishSM(pB0, pB1, l_reg, pa0, pa1, pa2, pa3); SBAR();
    if (SDEPTH == 1 || j + 3 < NT) SLOAD(SE, (j + 1 + SDEPTH) * KVBLK); SBAR();
    pv_d0(o, vb0 + (int)SHM_V, pa0, pa1, pa2, pa3); partialSM(pA0, pA1, mC);
    __syncthreads(); SWAIT(); SWRITE(1, SO);
    __syncthreads();
  }
  SBAR(); qkt(pB0, pB1, (bf16*)((char*)K_lds + SHM_K), qr, r32, hi);
  finishSM(pA0, pA1, l_reg, pa0, pa1, pa2, pa3); SBAR();
  pv_d0(o, vb0, pa0, pa1, pa2, pa3); partialSM(pB0, pB1, mC);
  __syncthreads();
  finishSM(pB0, pB1, l_reg, pa0, pa1, pa2, pa3); SBAR();
  pv_d0(o, vb0 + (int)SHM_V, pa0, pa1, pa2, pa3);
  { auto rr = __builtin_amdgcn_permlane32_swap(__float_as_uint(l_reg), __float_as_uint(l_reg), false, false); l_reg = __uint_as_float(rr[0]) + __uint_as_float(rr[1]); }
  if (hi == 0) li_l[r32] = l_reg; asm volatile("s_waitcnt lgkmcnt(0)" ::: "memory");
  float rli[16];
#pragma unroll
  for (int r = 0; r < 16; ++r) rli[r] = __builtin_amdgcn_rcpf(li_l[crow(r, hi)]);
  bf16* Ow = Ob + (long)(wid * QBLK) * LDO;
#pragma unroll
  for (int r = 0; r < 16; ++r) { int orow = crow(r, hi);
    for (int d0 = 0; d0 < 4; ++d0) Ow[(long)orow * LDO + d0 * 32 + r32] = __float2bfloat16(o[d0][r] * rli[r]); }
  __syncthreads();
#undef SLOAD
#undef SWRITE
#undef SWAIT
}
#undef KSWZ
#undef SBAR
}

struct Frame {
    LAS unsigned char* lds;
    char* ldsg;
    int tid, lane, wave, vcu, G;
    unsigned char* ws;
};
__device__ __forceinline__ const float* frame_in(const Frame& F, int i) {
    const LAS unsigned* p = (const LAS unsigned*)(F.lds + LDSCTL_OFF + 64) + 2 * i;
    const unsigned lo = __builtin_amdgcn_readfirstlane(p[0]), hi = __builtin_amdgcn_readfirstlane(p[1]);
    return (const float*)(const GAS float*)(((unsigned long long)hi << 32) | lo);
}
#define FIN(i) frame_in(F, (i))
#define FOUT() ((float*)frame_in(F, 17))
#define WSP(T, off) ((T*)(F.ws + (off)))

__device__ __forceinline__ void p0_transpose_item(const float* W, int K, int N, int Npad, bf16_t* WT, int row_off, LAS float* scr, int item, int lane, const float* kscale = nullptr) {
    const int nblk = Npad / 32, kb = item / nblk, nb = item % nblk, k0 = 64 * kb, n0 = 32 * nb;
    const int nn = n0 + 4 * (lane & 7);
    f32x4 v[8];
#pragma unroll
    for (int i = 0; i < 8; ++i) { const int kk = 8 * i + (lane >> 3); v[i] = nn < N ? *(const f32x4*)(W + (size_t)(k0 + kk) * N + nn) : (f32x4){0.f, 0.f, 0.f, 0.f}; }
#pragma unroll
    for (int i = 0; i < 8; ++i) { const int kk = 8 * i + (lane >> 3); *(LAS f32x4*)(scr + kk * 36 + 4 * (lane & 7)) = v[i]; }
    LDS_WAIT(); asm volatile("" ::: "memory");
    const int c = lane & 7;
    f32x4 ka = {1.f, 1.f, 1.f, 1.f}, kc = ka; if (kscale) { ka = *(const f32x4*)(kscale + k0 + 8 * c); kc = *(const f32x4*)(kscale + k0 + 8 * c + 4); }
#pragma unroll
    for (int j = 0; j < 4; ++j) { const int n = (lane >> 3) + 8 * j; const LAS float* s = scr + (8 * c) * 36 + n;
        u32x4 o; o.x = pk2(s[0 * 36] * ka.x, s[1 * 36] * ka.y); o.y = pk2(s[2 * 36] * ka.z, s[3 * 36] * ka.w); o.z = pk2(s[4 * 36] * kc.x, s[5 * 36] * kc.y); o.w = pk2(s[6 * 36] * kc.z, s[7 * 36] * kc.w);
        *(GAS u32x4*)(WT + (size_t)(row_off + n0 + n) * K + k0 + 8 * c) = o; }
    LDS_WAIT(); asm volatile("" ::: "memory");
}
__device__ __forceinline__ u32x4 cvt8(const float* p) {
    const f32x4 a = *(const f32x4*)p, b = *(const f32x4*)(p + 4);
    u32x4 o; o.x = pk2(a.x, a.y); o.y = pk2(a.z, a.w); o.z = pk2(b.x, b.y); o.w = pk2(b.z, b.w); return o;
}
__device__ __forceinline__ void rms_row_to_bf16(const float* xrow, const float* g, bf16_t* orow, int lane) {
    const f32x4* xr = (const f32x4*)xrow + lane;
    f32x4 v[8]; float s = 0.f;
#pragma unroll
    for (int j = 0; j < 8; ++j) { v[j] = xr[64 * j]; s += (v[j].x * v[j].x + v[j].y * v[j].y) + (v[j].z * v[j].z + v[j].w * v[j].w); }
    const float r = 1.0f / sqrtf(wave_sum(s) * (1.f / DM) + EPS);
    u32x2* o8 = (u32x2*)orow + lane;
#pragma unroll
    for (int j = 0; j < 8; ++j) { const f32x4 gg = ((const f32x4*)g)[lane + 64 * j]; u32x2 w; w.x = pk2(v[j].x * r * gg.x, v[j].y * r * gg.y); w.y = pk2(v[j].z * r * gg.z, v[j].w * r * gg.w); o8[64 * j] = w; }
}
__device__ __forceinline__ void ph_prologue(const Frame& F) {
    LAS float* scr = (LAS float*)(F.lds + F.wave * 16384);
    const int gw = F.vcu * NWAVES + F.wave, NGW = F.G * NWAVES;
#if TBL_FP4
    const float* gff = FIN(2) + F.lane * 4; const float* tsrc0 = FIN(14) + F.lane * 4; const float* tsrc1 = FIN(15) + F.lane * 4;
    for (int row = gw; row < 4 * 16384; row += NGW) {
        const int tb = row >> 15, rr = row & 32767;
        const float* src = (tb ? tsrc1 : tsrc0) + (size_t)rr * DM;
        f32x4 v[8]; float am = 0.f;
#pragma unroll
        for (int q = 0; q < 8; ++q) v[q] = *(const f32x4*)(src + 256 * q);
        if (tb == 0) {
#pragma unroll
            for (int q = 0; q < 8; ++q) v[q] = v[q] * *(const f32x4*)(gff + (rr >> 14) * DM + 256 * q); }
#pragma unroll
        for (int q = 0; q < 8; ++q) am = fmaxf(am, fmaxf(fmaxf(fabsf(v[q].x), fabsf(v[q].y)), fmaxf(fabsf(v[q].z), fabsf(v[q].w))));
#pragma unroll
        for (int o = 1; o < 64; o <<= 1) am = fmaxf(am, __shfl_xor(am, o));
        unsigned char* dst = F.ws + (tb ? WS_VB : WS_UB) + (size_t)(rr >> 14) * (16384 * 1024) + (size_t)(rr & 16383) * 128 + F.lane * 2;
        float sc;
        if (tb == 0) {
            float sq = 0.f;
#pragma unroll
            for (int q = 0; q < 8; ++q) sq += (v[q].x * v[q].x + v[q].y * v[q].y) + (v[q].z * v[q].z + v[q].w * v[q].w);
            sq = wave_sum(sq); sc = sq > 0.f ? 0.36f * sqrtf(sq * (1.f / DM)) : 1.f; const float isc = 1.0f / sc;
#pragma unroll
            for (int q = 0; q < 8; ++q) { const f32x4 z = v[q] * isc; int n[4];
#pragma unroll
                for (int e = 0; e < 4; ++e) n[e] = (int)fminf(fmaxf(rintf(z[e]), -7.f), 7.f) & 15;
                *(unsigned short*)(dst + (size_t)q * (16384 * 128)) = (unsigned short)(n[0] | (n[1] << 4) | (n[2] << 8) | (n[3] << 12)); }
        } else {
            sc = am > 0.f ? am * (1.f / 6.f) : 1.f; const float isc = 1.0f / sc;
#pragma unroll
            for (int q = 0; q < 8; ++q) { unsigned p = 0u;
                p = __builtin_amdgcn_cvt_scalef32_pk_fp4_f32(p, v[q].x * isc, v[q].y * isc, 1.0f, 0); p = __builtin_amdgcn_cvt_scalef32_pk_fp4_f32(p, v[q].z * isc, v[q].w * isc, 1.0f, 1);
                *(unsigned short*)(dst + (size_t)q * (16384 * 128)) = (unsigned short)p; }
        }
        if (F.lane == 0) ((float*)(F.ws + WS_TSC))[row] = sc;
    }
#else
    for (int row = gw; row < 4 * 16384; row += NGW) {
        const int tb = row >> 15, rr = row & 32767;
        const float* src = FIN(14 + tb) + (size_t)rr * DM + F.lane * 16;
        f32x4 v[8]; float am = 0.f;
#pragma unroll
        for (int q = 0; q < 8; ++q) { v[q] = *(const f32x4*)(src + (q >> 2) * 1024 + (q & 3) * 4);
            am = fmaxf(am, fmaxf(fmaxf(fabsf(v[q].x), fabsf(v[q].y)), fmaxf(fabsf(v[q].z), fabsf(v[q].w)))); }
#pragma unroll
        for (int o = 1; o < 64; o <<= 1) am = fmaxf(am, __shfl_xor(am, o));
        const float sc = am > 0.f ? am * (1.f / 448.f) : 1.f, isc = 1.0f / sc;
        unsigned w[8];
#pragma unroll
        for (int q = 0; q < 8; ++q) { unsigned p = __builtin_amdgcn_cvt_pk_fp8_f32(v[q].x * isc, v[q].y * isc, 0u, false); w[q] = __builtin_amdgcn_cvt_pk_fp8_f32(v[q].z * isc, v[q].w * isc, p, true); }
        unsigned char* dst = F.ws + (tb ? WS_VB : WS_UB) + (size_t)(rr >> 14) * (16384 * 2048) + ((size_t)(F.lane >> 3) * 16384 + (rr & 16383)) * 128 + (F.lane & 7) * 16;
        *(u32x4*)dst = (u32x4){w[0], w[1], w[2], w[3]}; *(u32x4*)(dst + (size_t)8 * 16384 * 128) = (u32x4){w[4], w[5], w[6], w[7]};
        if (F.lane == 0) ((float*)(F.ws + WS_TSC))[row] = sc;
    }
#endif
    {   constexpr int I_IN = (DM / 64) * (INP / 32), I_SQ = (DM / 64) * (DM / 32), I_PL = 4 * (512 / 64) * (512 / 32);
        constexpr int NIT = I_IN + 3 * I_SQ + I_PL;
        for (int it = gw; it < NIT; it += NGW) {
            int r = it;
            if (r < I_IN) { p0_transpose_item(FIN(3), DM, INW, INP, WSP(bf16_t, WS_WIN), 0, scr, r, F.lane); continue; } r -= I_IN;
            if (r < I_SQ) { p0_transpose_item(FIN(9), DM, DM, DM, WSP(bf16_t, WS_WOUT), 0, scr, r, F.lane); continue; } r -= I_SQ;
            if (r < I_SQ) { p0_transpose_item(FIN(12), DM, DM, DM, WSP(bf16_t, WS_WQ0), 0, scr, r, F.lane, FIN(2)); continue; } r -= I_SQ;
            if (r < I_SQ) { p0_transpose_item(FIN(12) + (size_t)DM * DM, DM, DM, DM, WSP(bf16_t, WS_WQ1), 0, scr, r, F.lane, FIN(2) + DM); continue; } r -= I_SQ;
            const int grp = r / 128, ri = r % 128;
            p0_transpose_item(FIN(10) + (size_t)grp * 512 * 512, 512, 512, 512, WSP(bf16_t, WS_WPOOL), grp * 512, scr, ri, F.lane);
        }
    }
    for (int it = gw; it < 1024; it += NGW) *(u32x4*)(WSP(bf16_t, WS_KEYS) + (size_t)it * 512 + F.lane * 8) = cvt8(FIN(13) + (size_t)it * 512 + F.lane * 8);
    {   const float* x0 = FIN(0); const float* g0 = FIN(1);
        for (int m = gw; m < S; m += 2 * NGW) {
            const int lane = F.lane; f32x4 v[2][8]; float s[2] = {0.f, 0.f};
#pragma unroll
            for (int z = 0; z < 2; ++z)
#pragma unroll
                for (int j = 0; j < 8; ++j) v[z][j] = ((const f32x4*)(x0 + (size_t)(m + z * NGW) * DM))[lane + 64 * j];
#pragma unroll
            for (int z = 0; z < 2; ++z)
#pragma unroll
                for (int j = 0; j < 8; ++j) s[z] += (v[z][j].x * v[z][j].x + v[z][j].y * v[z][j].y) + (v[z][j].z * v[z][j].z + v[z][j].w * v[z][j].w);
#pragma unroll
            for (int z = 0; z < 2; ++z) { const float r = 1.0f / sqrtf(wave_sum(s[z]) * (1.f / DM) + EPS); u32x2* o8 = (u32x2*)(WSP(bf16_t, WS_XN) + (size_t)(m + z * NGW) * DM) + lane;
#pragma unroll
                for (int j = 0; j < 8; ++j) { const f32x4 gg = ((const f32x4*)g0)[lane + 64 * j]; u32x2 w; w.x = pk2(v[z][j].x * r * gg.x, v[z][j].y * r * gg.y); w.y = pk2(v[z][j].z * r * gg.z, v[z][j].w * r * gg.w); o8[64 * j] = w; } }
        }
    }
}

__device__ __forceinline__ float silu_f(float z) { return z / (1.f + __expf(-z)); }
__device__ __forceinline__ void p2_qkv_token(const Frame& F, int t) {
    const int lane = F.lane, i8 = lane & 7;
    const bf16_t* pr = WSP(bf16_t, WS_PROJ) + (size_t)t * INP;
    const int axis = i8 >> 2, half = (i8 >> 1) & 1, f0 = (i8 & 1) * 16;
    const float pos = (float)(axis == 0 ? (t >> 6) : (t & 63));
    float cs[16], sn[16];
#pragma unroll
    for (int e = 0; e < 16; ++e) { const float inv = exp2f(-(float)(f0 + e) * (13.287712379549449f / 32.f));
        float rev = pos * inv * 0.15915494309189535f; rev -= rintf(rev);
        cs[e] = __builtin_amdgcn_cosf(rev); sn[e] = __builtin_amdgcn_sinf(rev); }
    const float sgn = half ? 1.f : -1.f;
    {   const u32x4 w0 = *(const u32x4*)(pr + C_AQ + lane * 16), w1 = *(const u32x4*)(pr + C_AQ + lane * 16 + 8);
        float v[16]; const unsigned ww[8] = {w0.x, w0.y, w0.z, w0.w, w1.x, w1.y, w1.z, w1.w};
#pragma unroll
        for (int e = 0; e < 8; ++e) { v[2 * e] = bflo(ww[e]); v[2 * e + 1] = bfhi(ww[e]); }
        float ss = 0.f;
#pragma unroll
        for (int e = 0; e < 16; ++e) ss += v[e] * v[e];
        ss += __shfl_xor(ss, 1); ss += __shfl_xor(ss, 2); ss += __shfl_xor(ss, 4);
        const float r = 1.0f / sqrtf(ss * (1.f / 128.f) + EPS);
        const float* gq = FIN(6) + i8 * 16;
        unsigned ow[8];
        float y[16];
#pragma unroll
        for (int e = 0; e < 16; ++e) y[e] = v[e] * r * gq[e];
#pragma unroll
        for (int e = 0; e < 16; ++e) { const float yp = __shfl_xor(y[e], 2); y[e] = y[e] * cs[e] + sgn * yp * sn[e]; }
#pragma unroll
        for (int e = 0; e < 8; ++e) ow[e] = pk2(y[2 * e], y[2 * e + 1]);
        bf16_t* dst = WSP(bf16_t, WS_QB) + (size_t)t * 1024 + lane * 16;
        *(u32x4*)dst = (u32x4){ow[0], ow[1], ow[2], ow[3]}; *(u32x4*)(dst + 8) = (u32x4){ow[4], ow[5], ow[6], ow[7]};
    }
    {   const int l16 = lane & 15;
        const u32x4 w0 = *(const u32x4*)(pr + C_AK + l16 * 16), w1 = *(const u32x4*)(pr + C_AK + l16 * 16 + 8);
        float v[16]; const unsigned ww[8] = {w0.x, w0.y, w0.z, w0.w, w1.x, w1.y, w1.z, w1.w};
#pragma unroll
        for (int e = 0; e < 8; ++e) { v[2 * e] = bflo(ww[e]); v[2 * e + 1] = bfhi(ww[e]); }
        float ss = 0.f;
#pragma unroll
        for (int e = 0; e < 16; ++e) ss += v[e] * v[e];
        ss += __shfl_xor(ss, 1); ss += __shfl_xor(ss, 2); ss += __shfl_xor(ss, 4);
        const float r = 1.0f / sqrtf(ss * (1.f / 128.f) + EPS);
        const float* gk = FIN(7) + i8 * 16;
        float y[16]; unsigned ow[8];
#pragma unroll
        for (int e = 0; e < 16; ++e) y[e] = v[e] * r * gk[e];
#pragma unroll
        for (int e = 0; e < 16; ++e) { const float yp = __shfl_xor(y[e], 2); y[e] = y[e] * cs[e] + sgn * yp * sn[e]; }
#pragma unroll
        for (int e = 0; e < 8; ++e) ow[e] = pk2(y[2 * e], y[2 * e + 1]);
        bf16_t* kv = WSP(bf16_t, WS_KVB) + (size_t)t * 512;
        if (lane < 16) { *(u32x4*)(kv + lane * 16) = (u32x4){ow[0], ow[1], ow[2], ow[3]}; *(u32x4*)(kv + lane * 16 + 8) = (u32x4){ow[4], ow[5], ow[6], ow[7]}; }
        else if (lane < 32) { const u32x4 a = *(const u32x4*)(pr + C_AV + l16 * 16), b = *(const u32x4*)(pr + C_AV + l16 * 16 + 8);
            *(u32x4*)(kv + 256 + l16 * 16) = a; *(u32x4*)(kv + 256 + l16 * 16 + 8) = b; }
    }
}
__device__ __forceinline__ void p2_conv_item(const Frame& F, int item) {
    const int tb = item >> 2, sl = item & 3, lane = F.lane, c = sl * 512 + lane * 8, t0 = tb * 16;
    float w[5][8];
#pragma unroll
    for (int j = 0; j < 5; ++j) { const f32x4 a = *(const f32x4*)(FIN(5) + j * 2048 + c), b = *(const f32x4*)(FIN(5) + j * 2048 + c + 4);
        w[j][0] = a.x; w[j][1] = a.y; w[j][2] = a.z; w[j][3] = a.w; w[j][4] = b.x; w[j][5] = b.y; w[j][6] = b.z; w[j][7] = b.w; }
    const bf16_t* src = WSP(bf16_t, WS_PROJ) + C_MQK + c;
    const float osc = (c >= 1024) ? 0.0625f : 1.f;
    bf16_t* dst = (c >= 1024) ? WSP(bf16_t, WS_MK) + (c - 1024) : WSP(bf16_t, WS_MQ) + c;
    u32x4 rows[20];
#pragma unroll
    for (int j = 0; j < 20; ++j) { const int tt = t0 - 2 + j; rows[j] = (tt >= 0 && tt < S) ? *(const u32x4*)(src + (size_t)tt * INP) : (u32x4){0u, 0u, 0u, 0u}; }
#pragma unroll
    for (int q = 0; q < 16; ++q) {
        float acc[8];
#pragma unroll
        for (int e = 0; e < 8; ++e) acc[e] = 0.f;
#pragma unroll
        for (int j = 0; j < 5; ++j) { const unsigned ww[4] = {rows[q + j].x, rows[q + j].y, rows[q + j].z, rows[q + j].w};
#pragma unroll
            for (int e = 0; e < 4; ++e) { acc[2 * e] += bflo(ww[e]) * w[j][2 * e]; acc[2 * e + 1] += bfhi(ww[e]) * w[j][2 * e + 1]; } }
        u32x4 o; o.x = pk2(silu_f(acc[0]) * osc, silu_f(acc[1]) * osc); o.y = pk2(silu_f(acc[2]) * osc, silu_f(acc[3]) * osc);
        o.z = pk2(silu_f(acc[4]) * osc, silu_f(acc[5]) * osc); o.w = pk2(silu_f(acc[6]) * osc, silu_f(acc[7]) * osc);
        *(u32x4*)(dst + (size_t)(t0 + q) * 1024) = o;
    }
}
__device__ __forceinline__ float wave_incl_scan_add(float v, int lane) {
#pragma unroll
    for (int o = 1; o < 64; o <<= 1) { const float u = __shfl_up(v, o); if (lane >= o) v += u; }
    return v;
}
__device__ __forceinline__ float wave_incl_scan_max(float v, int lane) {
#pragma unroll
    for (int o = 1; o < 64; o <<= 1) { const float u = __shfl_up(v, o); if (lane >= o) v = fmaxf(v, u); }
    return v;
}
__device__ __forceinline__ float logsigmoid_f(float x) { return fminf(x, 0.f) - log1pf(__expf(-fabsf(x))); }
__device__ __forceinline__ void p2_gate_item(const Frame& F, int item) {
    const int dh = item >> 7, c = item & 127, dir = dh >> 2, h = dh & 3, lane = F.lane;
    const int p0 = 128 * c + 2 * lane, t0 = dir ? (S - 1 - p0) : p0, t1 = dir ? (t0 - 1) : (t0 + 1);
    const bf16_t* pg = WSP(bf16_t, WS_PROJ) + C_GATE + dir * 8 + h;
    const float bi = FIN(4)[dir * 8 + h], bf = FIN(4)[dir * 8 + 4 + h];
    const float i0 = bflo((unsigned)pg[(size_t)t0 * INP]) + bi, f0 = bflo((unsigned)pg[(size_t)t0 * INP + 4]) + bf;
    const float i1 = bflo((unsigned)pg[(size_t)t1 * INP]) + bi, f1 = bflo((unsigned)pg[(size_t)t1 * INP + 4]) + bf;
    const float lf0 = logsigmoid_f(f0), lf1 = logsigmoid_f(f1);
    const float incl = wave_incl_scan_add(lf0 + lf1, lane);
    const float b1 = incl, b0 = incl - lf1;
    const float u0 = i0 - b0, u1 = i1 - b1;
    const float mincl = wave_incl_scan_max(fmaxf(u0, u1), lane);
    float mprevl = __shfl_up(mincl, 1); if (lane == 0) mprevl = -INFINITY;
    const float pm0 = fmaxf(mprevl, u0), pm1 = mincl;
    float* GB = (float*)(F.ws + WS_GATES + GO_B) + (size_t)dh * S; float* GU = (float*)(F.ws + WS_GATES + GO_U) + (size_t)dh * S; float* GPM = (float*)(F.ws + WS_GATES + GO_PM) + (size_t)dh * S;
    GB[t0] = b0; GB[t1] = b1; GU[t0] = u0; GU[t1] = u1; GPM[t0] = pm0; GPM[t1] = pm1;
    if (lane == 63) { ((float*)(F.ws + WS_GATES + GO_G))[dh * 128 + c] = b1; ((float*)(F.ws + WS_GATES + GO_PML))[dh * 128 + c] = pm1; }
}
__device__ __forceinline__ void ph_post(const Frame& F) {
    const int gw = F.vcu * NWAVES + F.wave, NGW = F.G * NWAVES;
    for (int it = gw; it < 1024; it += NGW) p2_gate_item(F, it);
    for (int it = gw; it < 4096; it += NGW) p2_conv_item(F, it);
    for (int t = gw; t < S; t += NGW) p2_qkv_token(F, t);
}

#define MFMA16(a, b, c) __builtin_amdgcn_mfma_f32_16x16x32_bf16((a), (b), (c), 0, 0, 0)
__device__ __forceinline__ bf16x8 frag_tr(LAS const unsigned char* base, int pitch, int k0, int x0, int lane) {
    const int g = lane >> 4, i = lane & 15;
    LAS const unsigned char* p = base + (k0 + 8 * g + (i >> 2)) * pitch + (x0 + 4 * (i & 3)) * 2;
    const s16x4 lo = __builtin_bit_cast(s16x4, __builtin_amdgcn_ds_read_tr16_b64_v4i16((LAS v4i16_t*)p));
    const s16x4 hi = __builtin_bit_cast(s16x4, __builtin_amdgcn_ds_read_tr16_b64_v4i16((LAS v4i16_t*)(p + 4 * pitch)));
    return (bf16x8){lo[0], lo[1], lo[2], lo[3], hi[0], hi[1], hi[2], hi[3]};
}
__device__ __forceinline__ bf16x8 frag_kc(LAS const unsigned char* base, int pitch, int x0, int k0, int lane) {
    return *(LAS const bf16x8*)(base + (x0 + (lane & 15)) * pitch + (k0 + 8 * (lane >> 4)) * 2);
}

constexpr int MLA_PK = 544, MLA_PV = 288;
constexpr int MLA_OFF_V = 128 * MLA_PK;
__device__ __forceinline__ void ph_mla(const Frame& F) {
    const int tid = F.tid, lane = F.lane, wave = F.wave;
    LAS unsigned char* Kw = F.lds; LAS unsigned char* Vs = F.lds + MLA_OFF_V;
    const float* GU = (const float*)(F.ws + WS_GATES + GO_U); const float* GPML = (const float*)(F.ws + WS_GATES + GO_PML);
    for (int item = F.vcu; item < 2048; item += F.G) {
        const int hv = item & 1, c = (item >> 1) & 127, dh = item >> 8, dir = dh >> 2, head = dh & 3;
        const int tc = dir ? 127 - c : c, t0 = tc * 128;
        const float pml = GPML[dh * 128 + c];
        {   const bf16_t* mk = WSP(bf16_t, WS_MK) + (size_t)t0 * 1024 + head * 256;
#pragma unroll
            for (int j = 0; j < 8; ++j) { const int r = (tid >> 5) + 16 * j, c8 = (tid & 31) * 8;
                const u32x4 x = *(const u32x4*)(mk + (size_t)r * 1024 + c8); const float w = __expf(GU[(size_t)dh * S + t0 + r] - pml);
                u32x4 o; o.x = pk2(bflo(x.x) * w, bfhi(x.x) * w); o.y = pk2(bflo(x.y) * w, bfhi(x.y) * w); o.z = pk2(bflo(x.z) * w, bfhi(x.z) * w); o.w = pk2(bflo(x.w) * w, bfhi(x.w) * w);
                *(LAS u32x4*)(Kw + r * MLA_PK + c8 * 2) = o; }
            const bf16_t* mv = WSP(bf16_t, WS_PROJ) + (size_t)t0 * INP + C_MV + head * 256 + hv * 128;
#pragma unroll
            for (int j = 0; j < 4; ++j) { const int r = (tid >> 4) + 32 * j, c8 = (tid & 15) * 8;
                *(LAS u32x4*)(Vs + r * MLA_PV + c8 * 2) = *(const u32x4*)(mv + (size_t)r * INP + c8); }
        }
        __syncthreads();
        f32x4 acc[4][4];
#pragma unroll
        for (int a = 0; a < 4; ++a)
#pragma unroll
            for (int b = 0; b < 4; ++b) acc[a][b] = (f32x4){0.f, 0.f, 0.f, 0.f};
        const int mb = (wave & 3) * 64, nb = (wave >> 2) * 64;
#pragma unroll
        for (int ks = 0; ks < 4; ++ks) {
            bf16x8 af[4], bfr[4];
#pragma unroll
            for (int a = 0; a < 4; ++a) af[a] = frag_tr(Kw, MLA_PK, 32 * ks, mb + 16 * a, lane);
#pragma unroll
            for (int b = 0; b < 4; ++b) bfr[b] = frag_tr(Vs, MLA_PV, 32 * ks, nb + 16 * b, lane);
#pragma unroll
            for (int a = 0; a < 4; ++a)
#pragma unroll
                for (int b = 0; b < 4; ++b) acc[a][b] = MFMA16(af[a], bfr[b], acc[a][b]);
        }
        {   bf16_t* cst = WSP(bf16_t, WS_CST) + ((size_t)(dh * 128 + c) << 16);
            const int g = lane >> 4, i = lane & 15;
#pragma unroll
            for (int a = 0; a < 4; ++a)
#pragma unroll
                for (int b = 0; b < 4; ++b) { u32x2 o; o.x = pk2(acc[a][b][0], acc[a][b][1]); o.y = pk2(acc[a][b][2], acc[a][b][3]);
                    *(u32x2*)(cst + (size_t)(hv * 128 + nb + 16 * b + i) * 256 + mb + 16 * a + 4 * g) = o; }
        }
        if (hv == 0 && tid < 256) { float s = 0.f;
#pragma unroll 8
            for (int r = 0; r < 128; ++r) s += bflo((unsigned)*(LAS const bf16_t*)(Kw + r * MLA_PK + tid * 2));
            ((float*)(F.ws + WS_NST))[(size_t)(dh * 128 + c) * 256 + tid] = s; }
        __syncthreads();
    }
}

__device__ __forceinline__ void ph_scan(const Frame& F) {
    const float* GG = (const float*)(F.ws + WS_GATES + GO_G); const float* GPML = (const float*)(F.ws + WS_GATES + GO_PML); float* MPREV = (float*)(F.ws + WS_GATES + GO_MPREV);
    const int nthreads = F.G * NTHR;
    for (int gi = F.vcu * NTHR + F.tid; gi < 8 * 16384; gi += nthreads) {
        const int dh = gi >> 14, e4 = gi & 16383;
        bf16_t* base = WSP(bf16_t, WS_CST) + ((size_t)dh * 128 << 16) + e4 * 4;
        float st0 = 0.f, st1 = 0.f, st2 = 0.f, st3 = 0.f, m = 0.f;
#pragma unroll 1
        for (int c0 = 0; c0 < 128; c0 += 32) {
            u32x2 ld[32];
#pragma unroll
            for (int q = 0; q < 32; ++q) ld[q] = *(const u32x2*)(base + ((size_t)(c0 + q) << 16));
#pragma unroll
            for (int q = 0; q < 32; ++q) { const int c = c0 + q;
                const float g = GG[dh * 128 + c], amax = g + GPML[dh * 128 + c];
                const float mn = fmaxf(g + m, amax), dec = __expf(g + m - mn), add = __expf(amax - mn);
                if (e4 == 0) MPREV[dh * 128 + c] = m;
                u32x2 o; o.x = pk2(st0, st1); o.y = pk2(st2, st3);
                *(u32x2*)(base + ((size_t)c << 16)) = o;
                st0 = dec * st0 + add * bflo(ld[q].x); st1 = dec * st1 + add * bfhi(ld[q].x); st2 = dec * st2 + add * bflo(ld[q].y); st3 = dec * st3 + add * bfhi(ld[q].y);
                m = mn; }
        }
    }
    for (int gi = F.vcu * NTHR + F.tid; gi < 8 * 256; gi += nthreads) {
        const int dh = gi >> 8, e = gi & 255;
        float* base = (float*)(F.ws + WS_NST) + (size_t)dh * 128 * 256 + e;
        float st = 0.f, m = 0.f;
#pragma unroll 1
        for (int c0 = 0; c0 < 128; c0 += 32) {
            float ld[32];
#pragma unroll
            for (int q = 0; q < 32; ++q) ld[q] = base[(c0 + q) * 256];
#pragma unroll
            for (int q = 0; q < 32; ++q) { const int c = c0 + q;
                const float g = GG[dh * 128 + c], amax = g + GPML[dh * 128 + c];
                const float mn = fmaxf(g + m, amax), dec = __expf(g + m - mn), add = __expf(amax - mn);
                base[c * 256] = st; st = dec * st + add * ld[q]; m = mn; }
        }
    }
}

constexpr int MLB_PIECE = 34816;
constexpr int MLB_PKC = 528, MLB_PTR = 544, MLB_PP = 272;
constexpr int MLB_OFF_P = 2 * MLB_PIECE;
constexpr int MLB_OFF_N = MLB_OFF_P + 2 * 8 * 16 * MLB_PP;
static_assert(MLB_OFF_N + 2048 <= LDSCTL_OFF, "mLSTM-B LDS map");
__device__ __forceinline__ void ph_mlb(const Frame& F) {
    const int wave = F.wave;
    const float* GB = (const float*)(F.ws + WS_GATES + GO_B); const float* GU = (const float*)(F.ws + WS_GATES + GO_U); const float* GPM = (const float*)(F.ws + WS_GATES + GO_PM);
    const float* MPREV = (const float*)(F.ws + WS_GATES + GO_MPREV);
    LAS unsigned char* buf0 = F.lds; LAS unsigned char* buf1 = F.lds + MLB_PIECE;
    LAS float* nprev = (LAS float*)(F.lds + MLB_OFF_N);
    for (int unit = F.vcu; unit < 512; unit += F.G) {
        int tid = F.tid; asm volatile("" : "+v"(tid));
        const int lane = tid & 63, g = lane >> 4, i = lane & 15;
        const int head = unit >> 7, tc = unit & 127, t0 = tc * 128, j0 = 16 * wave;
        const bf16_t* mkp = WSP(bf16_t, WS_MK) + (size_t)t0 * 1024 + head * 256;
        const bf16_t* mvp = WSP(bf16_t, WS_PROJ) + (size_t)t0 * INP + C_MV + head * 256;
        const int c_f = tc, c_b = 127 - tc;
        u32x4 stg[4];
        const int sr = tid >> 5, sc8 = (tid & 31) * 8;
#define PIECE_LOAD(srcp, pitch_el) do { _Pragma("unroll") for (int q_ = 0; q_ < 4; ++q_) stg[q_] = *(const u32x4*)((srcp) + (size_t)(sr + 16 * q_) * (pitch_el) + sc8); } while (0)
#define PIECE_WRITE(dstbuf, pitchB) do { _Pragma("unroll") for (int q_ = 0; q_ < 4; ++q_) *(LAS u32x4*)((dstbuf) + (sr + 16 * q_) * (pitchB) + sc8 * 2) = stg[q_]; } while (0)
        { const int d = tid >> 8, e = tid & 255; nprev[d * 256 + e] = ((const float*)(F.ws + WS_NST))[(size_t)((d * 4 + head) * 128 + (d ? c_b : c_f)) * 256 + e]; }
        bf16x8 qa[8];
        {   const bf16_t* mq = WSP(bf16_t, WS_MQ) + (size_t)(t0 + j0 + i) * 1024 + head * 256 + 8 * g;
#pragma unroll
            for (int s = 0; s < 8; ++s) qa[s] = *(const bf16x8*)(mq + 32 * s); }
        f32x4 sacc[8];
#pragma unroll
        for (int n = 0; n < 8; ++n) sacc[n] = (f32x4){0.f, 0.f, 0.f, 0.f};
        PIECE_LOAD(mkp, 1024); PIECE_WRITE(buf0, MLB_PKC);
        PIECE_LOAD(mkp + (size_t)64 * 1024, 1024);
        __syncthreads();
#pragma unroll
        for (int n = 0; n < 4; ++n)
            { _Pragma("unroll") for (int s = 0; s < 8; ++s) sacc[n] = MFMA16(qa[s], frag_kc(buf0, MLB_PKC, 16 * n, 32 * s, lane), sacc[n]); __builtin_amdgcn_sched_barrier(0); }
        PIECE_WRITE(buf1, MLB_PKC);
        __syncthreads();
#pragma unroll
        for (int n = 0; n < 4; ++n)
            { _Pragma("unroll") for (int s = 0; s < 8; ++s) sacc[4 + n] = MFMA16(qa[s], frag_kc(buf1, MLB_PKC, 16 * n, 32 * s, lane), sacc[4 + n]); __builtin_amdgcn_sched_barrier(0); }
        const bf16_t* cst0 = WSP(bf16_t, WS_CST) + ((size_t)((0 * 4 + head) * 128 + c_f) << 16);
        const bf16_t* cst1 = WSP(bf16_t, WS_CST) + ((size_t)((1 * 4 + head) * 128 + c_b) << 16);
        PIECE_LOAD(cst0, 256);
        float qsc0, qsc1;
#pragma unroll
        for (int d = 0; d < 2; ++d) {
            const int dh = d * 4 + head; const float mp = MPREV[dh * 128 + (d ? c_b : c_f)];
            f32x4 dacc = (f32x4){0.f, 0.f, 0.f, 0.f};
#pragma unroll
            for (int s = 0; s < 8; ++s) { bf16x8 bn; const LAS float* np = nprev + d * 256 + 32 * s + 8 * g;
#pragma unroll
                for (int e = 0; e < 8; ++e) bn[e] = (i == 0) ? (short)f2bf(np[e]) : (short)0;
                dacc = MFMA16(qa[s], bn, dacc); }
            float ur[8];
#pragma unroll
            for (int n = 0; n < 8; ++n) ur[n] = GU[(size_t)dh * S + t0 + 16 * n + i];
            LAS unsigned char* pw = F.lds + MLB_OFF_P + (d * 8 + wave) * (16 * MLB_PP);
            float es[4];
#pragma unroll
            for (int rg = 0; rg < 4; ++rg) { const int jl = 4 * g + rg, j = j0 + jl;
                const float M = fmaxf(mp, GPM[(size_t)dh * S + t0 + j]), ej = __expf(mp - M), mj = GB[(size_t)dh * S + t0 + j] + M;
                float rs = 0.f;
#pragma unroll
                for (int n = 0; n < 8; ++n) { const int r = 16 * n + i; const bool keep = d ? (r >= j) : (r <= j); rs += keep ? sacc[n][rg] * __expf(ur[n] - M) : 0.f; }
                rs += __shfl_xor(rs, 1); rs += __shfl_xor(rs, 2); rs += __shfl_xor(rs, 4); rs += __shfl_xor(rs, 8);
                const float qn = __shfl(dacc[rg], lane & 48);
                const float den = ej * qn + rs, sj = 1.0f / fmaxf(fabsf(den), __expf(-mj));
                es[rg] = ej * sj;
#pragma unroll
                for (int n = 0; n < 8; ++n) { const int r = 16 * n + i; const bool keep = d ? (r >= j) : (r <= j);
                    const float p = keep ? sacc[n][rg] * __expf(ur[n] - M) * sj : 0.f;
                    *(LAS bf16_t*)(pw + jl * MLB_PP + r * 2) = (bf16_t)f2bf(p); } }
            const int srcl = (i >> 2) << 4;
            const float t0_ = __shfl(es[0], srcl), t1_ = __shfl(es[1], srcl), t2_ = __shfl(es[2], srcl), t3_ = __shfl(es[3], srcl);
            const float qs_ = (i & 3) == 0 ? t0_ : (i & 3) == 1 ? t1_ : (i & 3) == 2 ? t2_ : t3_;
            if (d == 0) qsc0 = qs_; else qsc1 = qs_;
        }
        __syncthreads();
        f32x4 hacc[16];
#pragma unroll
        for (int n = 0; n < 16; ++n) hacc[n] = (f32x4){0.f, 0.f, 0.f, 0.f};
#pragma unroll
        for (int d = 0; d < 2; ++d) {
            const bf16_t* cst = d ? cst1 : cst0; const float qsc = d ? qsc1 : qsc0;
            bf16x8 qs[8];
#pragma unroll
            for (int s = 0; s < 8; ++s) { const u32x4 w = __builtin_bit_cast(u32x4, qa[s]); u32x4 o;
                o.x = pk2(bflo(w.x) * qsc, bfhi(w.x) * qsc); o.y = pk2(bflo(w.y) * qsc, bfhi(w.y) * qsc); o.z = pk2(bflo(w.z) * qsc, bfhi(w.z) * qsc); o.w = pk2(bflo(w.w) * qsc, bfhi(w.w) * qsc);
                qs[s] = __builtin_bit_cast(bf16x8, o); }
#pragma unroll
            for (int cp = 0; cp < 4; ++cp) {
                LAS unsigned char* cur = (cp & 1) ? buf1 : buf0;
                PIECE_WRITE(cur, MLB_PKC);
                if (cp < 3) PIECE_LOAD(cst + (size_t)(64 * (cp + 1)) * 256, 256); else PIECE_LOAD(mvp, INP);
                __syncthreads();
#pragma unroll
                for (int n = 0; n < 4; ++n)
                    { _Pragma("unroll") for (int s = 0; s < 8; ++s) hacc[4 * cp + n] = MFMA16(qs[s], frag_kc(cur, MLB_PKC, 16 * n, 32 * s, lane), hacc[4 * cp + n]); __builtin_amdgcn_sched_barrier(0); }
            }
            LAS const unsigned char* pw = F.lds + MLB_OFF_P + (d * 8 + wave) * (16 * MLB_PP);
#pragma unroll
            for (int vp = 0; vp < 2; ++vp) {
                LAS unsigned char* cur = (vp & 1) ? buf1 : buf0;
                PIECE_WRITE(cur, MLB_PTR);
                if (vp == 0) PIECE_LOAD(mvp + (size_t)64 * INP, INP); else if (d == 0) PIECE_LOAD(cst1, 256);
                __syncthreads();
#pragma unroll
                for (int ks = 0; ks < 2; ++ks) { const bf16x8 a = *(LAS const bf16x8*)(pw + i * MLB_PP + (64 * vp + 32 * ks + 8 * g) * 2);
#pragma unroll
                    for (int n = 0; n < 16; ++n) { hacc[n] = MFMA16(a, frag_tr(cur, MLB_PTR, 32 * ks, 16 * n, lane), hacc[n]); if ((n & 3) == 3) __builtin_amdgcn_sched_barrier(0); } }
            }
            __syncthreads();
        }
        {   const float* mg = FIN(8) + head * 256;
            const bf16_t* mo = WSP(bf16_t, WS_PROJ) + C_MO + head * 256; bf16_t* y = WSP(bf16_t, WS_Y) + 1024 + head * 256;
#pragma unroll
            for (int rg = 0; rg < 4; ++rg) { float ss = 0.f;
#pragma unroll
                for (int n = 0; n < 16; ++n) ss += hacc[n][rg] * hacc[n][rg];
                ss += __shfl_xor(ss, 1); ss += __shfl_xor(ss, 2); ss += __shfl_xor(ss, 4); ss += __shfl_xor(ss, 8);
                const float r = 1.0f / sqrtf(ss * (1.f / 256.f) + EPS); const size_t t = (size_t)(t0 + j0 + 4 * g + rg);
#pragma unroll
                for (int n = 0; n < 16; ++n) { const int col = 16 * n + i; const float o = bflo((unsigned)mo[t * INP + col]);
                    #if defined(DBG_ZERO_ML)
                    y[t * DM + col] = 0;
#else
                    y[t * DM + col] = (bf16_t)f2bf(hacc[n][rg] * r * mg[col] * (1.f / (1.f + __expf(-o))));
#endif
                    } }
        }
#undef PIECE_LOAD
#undef PIECE_WRITE
    }
}

#define MFMA32(a, b, c) __builtin_amdgcn_mfma_f32_32x32x16_bf16((a), (b), (c), 0, 0, 0)
__device__ __forceinline__ int fkey(float x) { const int b = __builtin_bit_cast(int, x); return b ^ ((b >> 31) & 0x7fffffff); }
__device__ __forceinline__ float kval(int k) { return __builtin_bit_cast(float, k ^ ((k >> 31) & 0x7fffffff)); }
#define CE_(a, i, j) { const int hi_ = max(a[i], a[j]); a[j] = min(a[i], a[j]); a[i] = hi_; }
#define SORT16(a) do { CE_(a,0,13) CE_(a,1,12) CE_(a,2,15) CE_(a,3,14) CE_(a,4,8) CE_(a,5,6) CE_(a,7,11) CE_(a,9,10) CE_(a,0,5) CE_(a,1,7) CE_(a,2,9) CE_(a,3,4) CE_(a,6,13) CE_(a,8,14) CE_(a,10,15) CE_(a,11,12) CE_(a,0,1) CE_(a,2,3) CE_(a,4,5) CE_(a,6,8) CE_(a,7,9) CE_(a,10,11) CE_(a,12,13) CE_(a,14,15) CE_(a,0,2) CE_(a,1,3) CE_(a,4,10) CE_(a,5,11) CE_(a,6,7) CE_(a,8,9) CE_(a,12,14) CE_(a,13,15) CE_(a,1,2) CE_(a,3,12) CE_(a,4,6) CE_(a,5,7) CE_(a,8,10) CE_(a,9,11) CE_(a,13,14) CE_(a,1,4) CE_(a,2,6) CE_(a,5,8) CE_(a,7,10) CE_(a,9,13) CE_(a,11,14) CE_(a,2,4) CE_(a,3,6) CE_(a,9,12) CE_(a,11,13) CE_(a,3,5) CE_(a,6,8) CE_(a,7,9) CE_(a,10,12) CE_(a,3,4) CE_(a,5,6) CE_(a,7,8) CE_(a,9,10) CE_(a,11,12) CE_(a,6,7) CE_(a,8,9) } while (0)
#define MERGE16(a, b) do { _Pragma("unroll") for (int k_ = 0; k_ < 16; ++k_) a[k_] = max(a[k_], b[15 - k_]); CE_(a,0,8) CE_(a,1,9) CE_(a,2,10) CE_(a,3,11) CE_(a,4,12) CE_(a,5,13) CE_(a,6,14) CE_(a,7,15) CE_(a,0,4) CE_(a,1,5) CE_(a,2,6) CE_(a,3,7) CE_(a,8,12) CE_(a,9,13) CE_(a,10,14) CE_(a,11,15) CE_(a,0,2) CE_(a,1,3) CE_(a,4,6) CE_(a,5,7) CE_(a,8,10) CE_(a,9,11) CE_(a,12,14) CE_(a,13,15) CE_(a,0,1) CE_(a,2,3) CE_(a,4,5) CE_(a,6,7) CE_(a,8,9) CE_(a,10,11) CE_(a,12,13) CE_(a,14,15) } while (0)
#define TOP_INS(top, x) do { int x_ = (x); _Pragma("unroll") for (int k_ = 0; k_ < 16; ++k_) { const int hi_ = max(top[k_], x_); x_ = min(top[k_], x_); top[k_] = hi_; } } while (0)
__device__ __forceinline__ int pick4(int sel, int a, int b, int c, int d) { return sel == 0 ? a : sel == 1 ? b : sel == 2 ? c : d; }
__device__ __forceinline__ void topk_item(const Frame& F, int layer, int item) {
    const int tile = item >> 3, h = item & 7, lane = F.lane, r32 = lane & 31, hi = lane >> 5;
    const int t = tile * 32 + r32;
    const bf16_t* qrow = WSP(bf16_t, WS_QP) + (size_t)t * DM + h * 256 + 8 * hi;
    int tops[2][16];
#pragma unroll
    for (int p = 0; p < 2; ++p) {
        const bf16_t* keys = WSP(bf16_t, WS_KEYS) + (size_t)(((layer * 8 + h) * 2 + p) * 128) * 128 + 8 * hi;
        bf16x8 bq[8];
#pragma unroll
        for (int s = 0; s < 8; ++s) bq[s] = *(const bf16x8*)(qrow + p * 128 + 16 * s);
        int top[16];
#pragma unroll
        for (int kt = 0; kt < 4; ++kt) {
            f32x16 acc = {};
#pragma unroll
            for (int s = 0; s < 8; ++s) { const bf16x8 a = *(const bf16x8*)(keys + (size_t)(32 * kt + r32) * 128 + 16 * s); acc = MFMA32(a, bq[s], acc); }
            int vals[16];
#pragma unroll
            for (int r = 0; r < 16; ++r) { const int idx = 32 * kt + (r & 3) + 8 * (r >> 2) + 4 * hi; vals[r] = (fkey(acc[r]) & ~127) | idx; }
            SORT16(vals);
            if (kt == 0) {
#pragma unroll
                for (int k = 0; k < 16; ++k) top[k] = vals[k]; }
            else MERGE16(top, vals);
        }
        int pt[16];
#pragma unroll
        for (int k = 0; k < 16; ++k) pt[k] = __shfl_xor(top[k], 32);
        MERGE16(top, pt);
#pragma unroll
        for (int k = 0; k < 16; ++k) tops[p][k] = top[k];
    }
    float af[16], bfv[16];
#pragma unroll
    for (int k = 0; k < 16; ++k) { af[k] = kval(tops[0][k] & ~127); bfv[k] = kval(tops[1][k] & ~127); }
#define CKEY(i, j) ((fkey(af[i] + bfv[j]) & ~255) | (255 - (((i) << 4) | (j))))
    int top2[16], aux[16];
#pragma unroll
    for (int j = 0; j < 16; ++j) top2[j] = CKEY(0, j);
#pragma unroll
    for (int j = 0; j < 16; ++j) aux[j] = j < 8 ? CKEY(1, j) : (int)0x80000000;
    MERGE16(top2, aux);
#pragma unroll
    for (int j = 0; j < 16; ++j) aux[j] = j < 8 ? CKEY(8 + j, 0) : (int)0x80000000;
    MERGE16(top2, aux);
    aux[0] = CKEY(2, 0); aux[1] = CKEY(2, 1); aux[2] = CKEY(2, 2); aux[3] = CKEY(2, 3); aux[4] = CKEY(2, 4); aux[5] = CKEY(3, 0); aux[6] = CKEY(3, 1); aux[7] = CKEY(3, 2);
    aux[8] = CKEY(3, 3); aux[9] = CKEY(4, 0); aux[10] = CKEY(4, 1); aux[11] = CKEY(4, 2); aux[12] = CKEY(5, 0); aux[13] = CKEY(5, 1); aux[14] = CKEY(6, 0); aux[15] = CKEY(6, 1);
    SORT16(aux); MERGE16(top2, aux);
    TOP_INS(top2, CKEY(7, 0)); TOP_INS(top2, CKEY(7, 1));
#undef CKEY
    int pa[4], pb[4];
#pragma unroll
    for (int q = 0; q < 4; ++q) { pa[q] = (tops[0][4 * q] & 127) | ((tops[0][4 * q + 1] & 127) << 8) | ((tops[0][4 * q + 2] & 127) << 16) | ((tops[0][4 * q + 3] & 127) << 24);
                                  pb[q] = (tops[1][4 * q] & 127) | ((tops[1][4 * q + 1] & 127) << 8) | ((tops[1][4 * q + 2] & 127) << 16) | ((tops[1][4 * q + 3] & 127) << 24); }
    int ex[16]; float sc[16];
#pragma unroll
    for (int k = 0; k < 16; ++k) { const int code = 255 - (top2[k] & 255), ii = code >> 4, jj = code & 15;
        const int ea = (pick4(ii >> 2, pa[0], pa[1], pa[2], pa[3]) >> ((ii & 3) * 8)) & 127, eb = (pick4(jj >> 2, pb[0], pb[1], pb[2], pb[3]) >> ((jj & 3) * 8)) & 127;
        ex[k] = ea * 128 + eb; sc[k] = kval(top2[k] & ~255); }
    const float mx = sc[0]; float sum = 0.f;
#pragma unroll
    for (int k = 0; k < 16; ++k) { sc[k] = __expf(sc[k] - mx); sum += sc[k]; }
    const float inv = 1.0f / sum;
    if (hi == 0) { int* d = WSP(int, WS_EIDX) + (size_t)t * 128 + h * 16;
#pragma unroll
        for (int q = 0; q < 4; ++q) *(u32x4*)(d + 4 * q) = (u32x4){(unsigned)ex[4 * q], (unsigned)ex[4 * q + 1], (unsigned)ex[4 * q + 2], (unsigned)ex[4 * q + 3]}; }
    else { float* d = WSP(float, WS_EGATE) + (size_t)t * 128 + h * 16;
#pragma unroll
        for (int q = 0; q < 4; ++q) *(f32x4*)(d + 4 * q) = (f32x4){sc[4 * q] * inv, sc[4 * q + 1] * inv, sc[4 * q + 2] * inv, sc[4 * q + 3] * inv}; }
}
constexpr size_t WS_XH = WS_QB, WS_XL = WS_QB + 16 * MiB;
__device__ __forceinline__ void xq_item2(const Frame& F, int layer, int ta, int tb) {
    const int lane = F.lane;
    const unsigned long long* ssq = (const unsigned long long*)(F.ws + WS_CTL + CTL_SSQ) + (layer ? 2 : 0) * S;
    const float rs[2] = {rstd_of(ssq[ta]) * 16.f, rstd_of(ssq[tb]) * 16.f};
    u32x4 xv[2][4];
#pragma unroll
    for (int z = 0; z < 2; ++z) { const bf16_t* xr = WSP(bf16_t, WS_XN) + (size_t)(z ? tb : ta) * DM + lane * 32;
#pragma unroll
        for (int d = 0; d < 4; ++d) xv[z][d] = *(const u32x4*)(xr + 8 * d); }
#pragma unroll
    for (int z = 0; z < 2; ++z) { unsigned hw[4], lw[4];
#pragma unroll
        for (int d = 0; d < 4; ++d) { const unsigned ww[4] = {xv[z][d].x, xv[z][d].y, xv[z][d].z, xv[z][d].w}; unsigned h = 0u, l = 0u;
#pragma unroll
            for (int e = 0; e < 8; ++e) { const float f = ((e & 1) ? bfhi(ww[e >> 1]) : bflo(ww[e >> 1])) * rs[z];
                const int x8 = (int)fminf(fmaxf(rintf(f), -119.f), 119.f), hi = (x8 + 8) >> 4, lo = x8 - 16 * hi;
                h |= (unsigned)(hi & 15) << (4 * e); l |= (unsigned)(lo & 15) << (4 * e); }
            hw[d] = h; lw[d] = l; }
        const size_t t = (size_t)(z ? tb : ta);
        *(u32x4*)(F.ws + WS_XH + t * 1024 + lane * 16) = (u32x4){hw[0], hw[1], hw[2], hw[3]};
        *(u32x4*)(F.ws + WS_XL + t * 1024 + lane * 16) = (u32x4){lw[0], lw[1], lw[2], lw[3]}; }
}
__device__ __forceinline__ void ph_topk(const Frame& F, int layer) {
    const int gw = F.vcu * NWAVES + F.wave, NGW = F.G * NWAVES;
    for (int it = gw; it < 4096; it += NGW) topk_item(F, layer, it);
    for (int t = gw; t < S; t += 2 * NGW) xq_item2(F, layer, t, t + NGW);
}

typedef __bf16 bf2 __attribute__((ext_vector_type(2)));
__device__ __forceinline__ float dot2bf(bf2 a, unsigned b, float c) { return __builtin_amdgcn_fdot2_f32_bf16(a, __builtin_bit_cast(bf2, b), c, false); }
__device__ __forceinline__ float dot4_fp8(unsigned w, unsigned xlo, unsigned xhi, float c) {
    c = dot2bf(__builtin_amdgcn_cvt_scalef32_pk_bf16_fp8(w, 1.0f, false), xlo, c);
    return dot2bf(__builtin_amdgcn_cvt_scalef32_pk_bf16_fp8(w, 1.0f, true), xhi, c);
}
#if TBL_FP4
constexpr int NSL = 8;
constexpr size_t WS_PART = WS_CST;
constexpr size_t WS_W = WS_KVB;
__device__ __forceinline__ float dot8_fp4(unsigned w, u32x4 x, float c) {
    c = dot2bf(__builtin_amdgcn_cvt_scalef32_pk_bf16_fp4(w, 1.0f, 0), x.x, c); c = dot2bf(__builtin_amdgcn_cvt_scalef32_pk_bf16_fp4(w, 1.0f, 1), x.y, c);
    c = dot2bf(__builtin_amdgcn_cvt_scalef32_pk_bf16_fp4(w, 1.0f, 2), x.z, c); return dot2bf(__builtin_amdgcn_cvt_scalef32_pk_bf16_fp4(w, 1.0f, 3), x.w, c);
}
__device__ __forceinline__ void ph_gu(const Frame& F, int layer) {
    const int lane = F.lane, r8 = lane >> 3, c16 = lane & 7;
    const int nper = F.G >> 3, xl = F.vcu / nper, wx = (F.vcu % nper) * NWAVES + F.wave, nwx = nper * NWAVES;
    const int s = xl;
    const unsigned char* Us = F.ws + WS_UB + (size_t)layer * (16384 * 1024) + (size_t)s * (16384 * 128);
    const unsigned char* eb = F.ws + WS_EIDX; unsigned char* pb = F.ws + WS_PART + (size_t)s * S * 512; const unsigned char* xhb = F.ws + WS_XH + s * 128; const unsigned char* xlb = F.ws + WS_XL + s * 128;
    const unsigned eo = 64u * r8, po = 8u * lane, xo = 16u * c16, uo = 16u * c16;
#define LDU(T, base, off) (*(const T*)((base) + (unsigned)(off)))
    u32x4 ia[2][4];
#pragma unroll
    for (int q = 0; q < 4; ++q) { ia[0][q] = LDU(u32x4, eb, (unsigned)wx * 512u + eo + 16u * q); ia[1][q] = LDU(u32x4, eb, (unsigned)(wx + nwx) * 512u + eo + 16u * q); }
#pragma unroll 1
    for (int t = wx; t < S; t += 2 * nwx) {
        const int t1 = t + nwx;
        u32x4 ur[2][16];
#pragma unroll
        for (int z = 0; z < 2; ++z)
#pragma unroll
            for (int q = 0; q < 16; ++q) { const unsigned id = ia[z][q >> 2][q & 3]; ur[z][q] = LDU(u32x4, Us, id * 128u + uo); }
        { const int tn = (t + 2 * nwx < S) ? t + 2 * nwx : t;
#pragma unroll
          for (int q = 0; q < 4; ++q) { ia[0][q] = LDU(u32x4, eb, (unsigned)tn * 512u + eo + 16u * q); ia[1][q] = LDU(u32x4, eb, (unsigned)(tn + nwx) * 512u + eo + 16u * q); } }
#pragma unroll
        for (int z = 0; z < 2; ++z) {
            const unsigned xoff = (unsigned)(z ? t1 : t) * 1024u + xo; const u32x4 xh = LDU(u32x4, xhb, xoff), xl = LDU(u32x4, xlb, xoff);
            float v[16];
#pragma unroll
            for (int q = 0; q < 16; ++q) { const u32x4 w = ur[z][q]; int ah = 0, al = 0;
                ah = __builtin_amdgcn_sdot8((int)w.x, (int)xh.x, ah, false); al = __builtin_amdgcn_sdot8((int)w.x, (int)xl.x, al, false);
                ah = __builtin_amdgcn_sdot8((int)w.y, (int)xh.y, ah, false); al = __builtin_amdgcn_sdot8((int)w.y, (int)xl.y, al, false);
                ah = __builtin_amdgcn_sdot8((int)w.z, (int)xh.z, ah, false); al = __builtin_amdgcn_sdot8((int)w.z, (int)xl.z, al, false);
                ah = __builtin_amdgcn_sdot8((int)w.w, (int)xh.w, ah, false); al = __builtin_amdgcn_sdot8((int)w.w, (int)xl.w, al, false);
                v[q] = (float)(16 * ah + al); }
            float r8v[8], r4v[4], r2v[2];
            { const bool up = lane & 4;
#pragma unroll
              for (int q = 0; q < 8; ++q) { const float keep = up ? v[q + 8] : v[q], give = up ? v[q] : v[q + 8]; r8v[q] = keep + __shfl_xor(give, 4); } }
            { const bool up = lane & 2;
#pragma unroll
              for (int q = 0; q < 4; ++q) { const float keep = up ? r8v[q + 4] : r8v[q], give = up ? r8v[q] : r8v[q + 4]; r4v[q] = keep + __shfl_xor(give, 2); } }
            { const bool up = lane & 1;
#pragma unroll
              for (int q = 0; q < 2; ++q) { const float keep = up ? r4v[q + 2] : r4v[q], give = up ? r4v[q] : r4v[q + 2]; r2v[q] = keep + __shfl_xor(give, 1); } }
            *(f32x2*)(pb + ((unsigned)(z ? t1 : t) * 512u + po)) = (f32x2){r2v[0], r2v[1]};
        }
    }
}
__device__ __forceinline__ void ph_act(const Frame& F, int layer) {
    const int lane = F.lane, gw = F.vcu * NWAVES + F.wave, NGW = F.G * NWAVES;
    const float* su = (const float*)(F.ws + WS_TSC) + layer * 16384; const float* sv = su + 32768;
    for (int t0 = gw; t0 < S; t0 += 4 * NGW) {
        f32x2 a[4]; u32x2 id[4]; f32x2 g[4];
#pragma unroll
        for (int z = 0; z < 4; ++z) { const int t = t0 + z * NGW;
            id[z] = *(const u32x2*)(WSP(int, WS_EIDX) + (size_t)t * 128 + 2 * lane); g[z] = *(const f32x2*)(WSP(float, WS_EGATE) + (size_t)t * 128 + 2 * lane);
            const float* part = WSP(float, WS_PART) + (size_t)t * 128 + 2 * lane; a[z] = (f32x2){0.f, 0.f};
#pragma unroll
            for (int s = 0; s < NSL; ++s) a[z] += *(const f32x2*)(part + (size_t)s * S * 128); }
        float sx[4][4];
#pragma unroll
        for (int z = 0; z < 4; ++z) { sx[z][0] = su[id[z].x]; sx[z][1] = su[id[z].y]; sx[z][2] = sv[id[z].x]; sx[z][3] = sv[id[z].y]; }
#pragma unroll
        for (int z = 0; z < 4; ++z) { const int t = t0 + z * NGW;
            const float a0 = a[z].x * sx[z][0] * (1.f / 16.f), a1 = a[z].y * sx[z][1] * (1.f / 16.f);
            const float w0 = 0.5f * a0 * (1.f + erff(a0 * 0.70710678118654752f)) * g[z].x * sx[z][2], w1 = 0.5f * a1 * (1.f + erff(a1 * 0.70710678118654752f)) * g[z].y * sx[z][3];
            *(f32x2*)(WSP(float, WS_W) + (size_t)t * 128 + 2 * lane) = (f32x2){w0, w1}; }
    }
}
__device__ __forceinline__ void ph_gv(const Frame& F, int layer) {
    const int lane = F.lane, r8 = lane >> 3, c16 = lane & 7;
    const int nper = F.G >> 3, xl = F.vcu / nper, wx = (F.vcu % nper) * NWAVES + F.wave, nwx = nper * NWAVES;
    const int s = xl;
    const unsigned char* Vs = F.ws + WS_VB + (size_t)layer * (16384 * 1024) + (size_t)s * (16384 * 128);
    const unsigned char* eb = F.ws + WS_EIDX; const unsigned char* wb = F.ws + WS_W; unsigned char* hb = F.ws + WS_XN + s * 512;
    const unsigned eo = 64u * r8, ho = 64u * c16 + 8u * r8, vo = 16u * c16;
    u32x4 ia[2][4];
#pragma unroll
    for (int q = 0; q < 4; ++q) { ia[0][q] = LDU(u32x4, eb, (unsigned)wx * 512u + eo + 16u * q); ia[1][q] = LDU(u32x4, eb, (unsigned)(wx + nwx) * 512u + eo + 16u * q); }
#pragma unroll 1
    for (int t = wx; t < S; t += 2 * nwx) {
        const int t1 = t + nwx;
        u32x4 vr[2][16];
#pragma unroll
        for (int z = 0; z < 2; ++z)
#pragma unroll
            for (int q = 0; q < 16; ++q) { const unsigned id = ia[z][q >> 2][q & 3]; vr[z][q] = LDU(u32x4, Vs, id * 128u + vo); }
        { const int tn = (t + 2 * nwx < S) ? t + 2 * nwx : t;
#pragma unroll
          for (int q = 0; q < 4; ++q) { ia[0][q] = LDU(u32x4, eb, (unsigned)tn * 512u + eo + 16u * q); ia[1][q] = LDU(u32x4, eb, (unsigned)(tn + nwx) * 512u + eo + 16u * q); } }
        f32x4 wqa[2][4]; u32x2 hold[2];
#pragma unroll
        for (int z = 0; z < 2; ++z) { const unsigned tt = (unsigned)(z ? t1 : t);
#pragma unroll
            for (int q = 0; q < 4; ++q) wqa[z][q] = LDU(f32x4, wb, tt * 512u + eo + 16u * q);
            hold[z] = LDU(u32x2, hb, tt * 4096u + ho); }
#pragma unroll
        for (int z = 0; z < 2; ++z) {
            const unsigned tt = (unsigned)(z ? t1 : t);
            f32x2 acc[16];
#pragma unroll
            for (int e = 0; e < 16; ++e) acc[e] = (f32x2){0.f, 0.f};
#pragma unroll
            for (int q = 0; q < 16; ++q) { const float w = wqa[z][q >> 2][q & 3]; const f32x2 ww = {w, w}; const unsigned d4[4] = {vr[z][q].x, vr[z][q].y, vr[z][q].z, vr[z][q].w};
#pragma unroll
                for (int e = 0; e < 4; ++e) { acc[4 * e] += ww * __builtin_amdgcn_cvt_scalef32_pk_f32_fp4(d4[e], 1.0f, 0); acc[4 * e + 1] += ww * __builtin_amdgcn_cvt_scalef32_pk_f32_fp4(d4[e], 1.0f, 1);
                    acc[4 * e + 2] += ww * __builtin_amdgcn_cvt_scalef32_pk_f32_fp4(d4[e], 1.0f, 2); acc[4 * e + 3] += ww * __builtin_amdgcn_cvt_scalef32_pk_f32_fp4(d4[e], 1.0f, 3); } }
            f32x2 b8[8], b4[4], b2[2];
            { const bool up = lane & 32;
#pragma unroll
              for (int e = 0; e < 8; ++e) { const f32x2 keep = up ? acc[e + 8] : acc[e], give = up ? acc[e] : acc[e + 8]; b8[e] = keep + (f32x2){__shfl_xor(give.x, 32), __shfl_xor(give.y, 32)}; } }
            { const bool up = lane & 16;
#pragma unroll
              for (int e = 0; e < 4; ++e) { const f32x2 keep = up ? b8[e + 4] : b8[e], give = up ? b8[e] : b8[e + 4]; b4[e] = keep + (f32x2){__shfl_xor(give.x, 16), __shfl_xor(give.y, 16)}; } }
            { const bool up = lane & 8;
#pragma unroll
              for (int e = 0; e < 2; ++e) { const f32x2 keep = up ? b4[e + 2] : b4[e], give = up ? b4[e] : b4[e + 2]; b2[e] = keep + (f32x2){__shfl_xor(give.x, 8), __shfl_xor(give.y, 8)}; } }
#if defined(DBG_ZERO_PEER)
            b2[0] = (f32x2){0.f, 0.f}; b2[1] = b2[0];
#endif
            const f32x4 hn = (f32x4){bflo(hold[z].x), bfhi(hold[z].x), bflo(hold[z].y), bfhi(hold[z].y)} + (f32x4){b2[0].x, b2[0].y, b2[1].x, b2[1].y};
            u32x2 w; w.x = pk2(hn.x, hn.y); w.y = pk2(hn.z, hn.w); *(u32x2*)(hb + (tt * 4096u + ho)) = w;
            if (layer == 0) {
                const float sq = wave_sum((hn.x * hn.x + hn.y * hn.y) + (hn.z * hn.z + hn.w * hn.w));
                if (lane == 0) atomicAdd((unsigned long long*)(F.ws + WS_CTL + CTL_SSQ) + S + tt, (unsigned long long)(sq * 1048576.0f)); }
        }
    }
}
#else
constexpr int NSL = 16;
constexpr size_t WS_PART = WS_CST;
constexpr size_t WS_W = WS_KVB;
__device__ __forceinline__ void ph_gu(const Frame& F, int layer) {
    const int lane = F.lane, r8 = lane >> 3, c16 = lane & 7;
    const int nper = F.G >> 3, xl = F.vcu / nper, wx = (F.vcu % nper) * NWAVES + F.wave, nwx = nper * NWAVES;
    const unsigned char* U = F.ws + WS_UB + (size_t)layer * 16384 * 2048 + c16 * 16;
    const int* eidx = WSP(int, WS_EIDX) + 16 * r8;
#pragma unroll 1
    for (int p = 0; p < 2; ++p) {
        const int s = xl + 8 * p;
        const unsigned char* Us = U + (size_t)s * (16384 * 128);
        float* part = WSP(float, WS_PART) + (size_t)s * S * 128 + 2 * lane;
        const bf16_t* xs = WSP(bf16_t, WS_XN) + s * 128 + c16 * 16;
        u32x4 ia[2][4];
#pragma unroll
        for (int q = 0; q < 4; ++q) { ia[0][q] = *(const u32x4*)(eidx + (size_t)wx * 128 + 4 * q); ia[1][q] = *(const u32x4*)(eidx + (size_t)(wx + nwx) * 128 + 4 * q); }
#pragma unroll 1
        for (int t = wx; t < S; t += 2 * nwx) {
            const int t1 = t + nwx;
            u32x4 ur[2][16];
#pragma unroll
            for (int z = 0; z < 2; ++z)
#pragma unroll
                for (int q = 0; q < 16; ++q) { const unsigned id = ia[z][q >> 2][q & 3]; ur[z][q] = *(const u32x4*)(Us + (size_t)id * 128); }
            { const int tn = (t + 2 * nwx < S) ? t + 2 * nwx : t;
#pragma unroll
              for (int q = 0; q < 4; ++q) { ia[0][q] = *(const u32x4*)(eidx + (size_t)tn * 128 + 4 * q); ia[1][q] = *(const u32x4*)(eidx + (size_t)(tn + nwx) * 128 + 4 * q); } }
#pragma unroll
            for (int z = 0; z < 2; ++z) {
                const bf16_t* xr = xs + (size_t)(z ? t1 : t) * DM; const u32x4 x0 = *(const u32x4*)xr, x1 = *(const u32x4*)(xr + 8);
                float v[16];
#pragma unroll
                for (int q = 0; q < 16; ++q) { const u32x4 w = ur[z][q]; float a = dot4_fp8(w.x, x0.x, x0.y, 0.f); a = dot4_fp8(w.y, x0.z, x0.w, a); a = dot4_fp8(w.z, x1.x, x1.y, a); v[q] = dot4_fp8(w.w, x1.z, x1.w, a); }
                float r8v[8], r4v[4], r2v[2];
                { const bool up = lane & 4;
#pragma unroll
                  for (int q = 0; q < 8; ++q) { const float keep = up ? v[q + 8] : v[q], give = up ? v[q] : v[q + 8]; r8v[q] = keep + __shfl_xor(give, 4); } }
                { const bool up = lane & 2;
#pragma unroll
                  for (int q = 0; q < 4; ++q) { const float keep = up ? r8v[q + 4] : r8v[q], give = up ? r8v[q] : r8v[q + 4]; r4v[q] = keep + __shfl_xor(give, 2); } }
                { const bool up = lane & 1;
#pragma unroll
                  for (int q = 0; q < 2; ++q) { const float keep = up ? r4v[q + 2] : r4v[q], give = up ? r4v[q] : r4v[q + 2]; r2v[q] = keep + __shfl_xor(give, 1); } }
                *(f32x2*)(part + (size_t)(z ? t1 : t) * 128) = (f32x2){r2v[0], r2v[1]};
            }
        }
    }
}
__device__ __forceinline__ void ph_act(const Frame& F, int layer) {
    const int lane = F.lane, gw = F.vcu * NWAVES + F.wave, NGW = F.G * NWAVES;
    const float* su = (const float*)(F.ws + WS_TSC) + layer * 16384; const float* sv = su + 32768;
    for (int t = gw; t < S; t += NGW) {
        const float* part = WSP(float, WS_PART) + (size_t)t * 128 + 2 * lane;
        f32x2 a = {0.f, 0.f};
#pragma unroll
        for (int s = 0; s < NSL; ++s) a += *(const f32x2*)(part + (size_t)s * S * 128);
        const u32x2 id = *(const u32x2*)(WSP(int, WS_EIDX) + (size_t)t * 128 + 2 * lane); const f32x2 g = *(const f32x2*)(WSP(float, WS_EGATE) + (size_t)t * 128 + 2 * lane);
        const float a0 = a.x * su[id.x], a1 = a.y * su[id.y];
        const float w0 = 0.5f * a0 * (1.f + erff(a0 * 0.70710678118654752f)) * g.x * sv[id.x], w1 = 0.5f * a1 * (1.f + erff(a1 * 0.70710678118654752f)) * g.y * sv[id.y];
        *(f32x2*)(WSP(float, WS_W) + (size_t)t * 128 + 2 * lane) = (f32x2){w0, w1};
    }
}
__device__ __forceinline__ void ph_gv(const Frame& F, int layer) {
    const int lane = F.lane, r8 = lane >> 3, c16 = lane & 7;
    const int nper = F.G >> 3, xl = F.vcu / nper, wx = (F.vcu % nper) * NWAVES + F.wave, nwx = nper * NWAVES;
    const unsigned char* V = F.ws + WS_VB + (size_t)layer * 16384 * 2048 + c16 * 16;
    const int* eidx = WSP(int, WS_EIDX) + 16 * r8; const float* wv = WSP(float, WS_W) + 16 * r8;
#pragma unroll 1
    for (int p = 0; p < 2; ++p) {
        const int s = xl + 8 * p;
        const unsigned char* Vs = V + (size_t)s * (16384 * 128);
        float* hs = WSP(float, WS_H) + s * 128 + 16 * c16 + 2 * r8;
        u32x4 ia[2][4];
#pragma unroll
        for (int q = 0; q < 4; ++q) { ia[0][q] = *(const u32x4*)(eidx + (size_t)wx * 128 + 4 * q); ia[1][q] = *(const u32x4*)(eidx + (size_t)(wx + nwx) * 128 + 4 * q); }
#pragma unroll 1
        for (int t = wx; t < S; t += 2 * nwx) {
            const int t1 = t + nwx;
            u32x4 vr[2][16];
#pragma unroll
            for (int z = 0; z < 2; ++z)
#pragma unroll
                for (int q = 0; q < 16; ++q) { const unsigned id = ia[z][q >> 2][q & 3]; vr[z][q] = *(const u32x4*)(Vs + (size_t)id * 128); }
            { const int tn = (t + 2 * nwx < S) ? t + 2 * nwx : t;
#pragma unroll
              for (int q = 0; q < 4; ++q) { ia[0][q] = *(const u32x4*)(eidx + (size_t)tn * 128 + 4 * q); ia[1][q] = *(const u32x4*)(eidx + (size_t)(tn + nwx) * 128 + 4 * q); } }
            f32x4 wqa[2][4]; f32x2 hold[2];
#pragma unroll
            for (int z = 0; z < 2; ++z) { const size_t tt = (size_t)(z ? t1 : t);
#pragma unroll
                for (int q = 0; q < 4; ++q) wqa[z][q] = *(const f32x4*)(wv + tt * 128 + 4 * q);
                hold[z] = *(const f32x2*)(hs + tt * DM); }
#pragma unroll
            for (int z = 0; z < 2; ++z) {
                const size_t tt = (size_t)(z ? t1 : t);
                f32x4 wq[4];
#pragma unroll
                for (int q = 0; q < 4; ++q) wq[q] = wqa[z][q];
                f32x2 acc[8];
#pragma unroll
                for (int e = 0; e < 8; ++e) acc[e] = (f32x2){0.f, 0.f};
#pragma unroll
                for (int q = 0; q < 16; ++q) { const float w = wq[q >> 2][q & 3]; const f32x2 ww = {w, w}; const unsigned d4[4] = {vr[z][q].x, vr[z][q].y, vr[z][q].z, vr[z][q].w};
#pragma unroll
                    for (int e = 0; e < 4; ++e) { acc[2 * e] += ww * __builtin_amdgcn_cvt_pk_f32_fp8(d4[e], false); acc[2 * e + 1] += ww * __builtin_amdgcn_cvt_pk_f32_fp8(d4[e], true); } }
                f32x2 b4[4], b2[2], b1;
                { const bool up = lane & 32;
#pragma unroll
                  for (int e = 0; e < 4; ++e) { const f32x2 keep = up ? acc[e + 4] : acc[e], give = up ? acc[e] : acc[e + 4]; b4[e] = keep + (f32x2){__shfl_xor(give.x, 32), __shfl_xor(give.y, 32)}; } }
                { const bool up = lane & 16;
#pragma unroll
                  for (int e = 0; e < 2; ++e) { const f32x2 keep = up ? b4[e + 2] : b4[e], give = up ? b4[e] : b4[e + 2]; b2[e] = keep + (f32x2){__shfl_xor(give.x, 16), __shfl_xor(give.y, 16)}; } }
                { const bool up = lane & 8; const f32x2 keep = up ? b2[1] : b2[0], give = up ? b2[0] : b2[1]; b1 = keep + (f32x2){__shfl_xor(give.x, 8), __shfl_xor(give.y, 8)}; }
#if defined(DBG_ZERO_PEER)
                b1 = (f32x2){0.f, 0.f};
#endif
                *(f32x2*)(hs + tt * DM) = hold[z] + b1;
            }
        }
    }
}
#endif
__device__ __forceinline__ void ph_normg(const Frame& F, bool final_layer) {
    const int gw = F.vcu * NWAVES + F.wave, NGW = F.G * NWAVES, lane = F.lane; (void)final_layer;
    const float* g = FIN(16); float* out = FOUT();
    for (int m0 = gw; m0 < S; m0 += 2 * NGW) {
        u32x4 v[2][4]; float s[2] = {0.f, 0.f};
#pragma unroll
        for (int z = 0; z < 2; ++z) { const bf16_t* xr = WSP(bf16_t, WS_XN) + (size_t)(m0 + z * NGW) * DM + lane * 8;
#pragma unroll
            for (int j = 0; j < 4; ++j) v[z][j] = *(const u32x4*)(xr + 512 * j); }
#pragma unroll
        for (int z = 0; z < 2; ++z)
#pragma unroll
            for (int j = 0; j < 4; ++j) { const unsigned ww[4] = {v[z][j].x, v[z][j].y, v[z][j].z, v[z][j].w};
#pragma unroll
                for (int e = 0; e < 4; ++e) s[z] += bflo(ww[e]) * bflo(ww[e]) + bfhi(ww[e]) * bfhi(ww[e]); }
#pragma unroll
        for (int z = 0; z < 2; ++z) { const size_t m = (size_t)(m0 + z * NGW); const float r = 1.0f / sqrtf(wave_sum(s[z]) * (1.f / DM) + EPS);
#pragma unroll
            for (int j = 0; j < 4; ++j) { const int c0 = lane * 8 + 512 * j; const f32x4 g0 = *(const f32x4*)(g + c0), g1 = *(const f32x4*)(g + c0 + 4); const u32x4 x = v[z][j];
                *(f32x4*)(out + m * DM + c0) = (f32x4){bflo(x.x) * r * g0.x, bfhi(x.x) * r * g0.y, bflo(x.y) * r * g0.z, bfhi(x.y) * r * g0.w};
                *(f32x4*)(out + m * DM + c0 + 4) = (f32x4){bflo(x.z) * r * g1.x, bfhi(x.z) * r * g1.y, bflo(x.w) * r * g1.z, bfhi(x.w) * r * g1.w}; } }
    }
}

__device__ __forceinline__ void ph_poolprep(const Frame& F) {
    const int lane = F.lane, gw = F.vcu * NWAVES + F.wave, NGW = F.G * NWAVES;
    const bf16_t* xn = WSP(bf16_t, WS_XN); const unsigned long long* ss = (const unsigned long long*)(F.ws + WS_CTL + CTL_SSQ) + S; const float* g = FIN(1) + DM;
    for (int t = gw; t < S; t += NGW) {
        const int rl = t - 8 + (lane & 15); const float rsl = (rl >= 0 && rl < S) ? rstd_of(ss[rl]) : 0.f;
        float rs[16];
#pragma unroll
        for (int q = 0; q < 16; ++q) rs[q] = __builtin_bit_cast(float, __builtin_amdgcn_readlane(__builtin_bit_cast(int, rsl), q));
        u32x4 o4[4];
#pragma unroll
        for (int j = 0; j < 4; ++j) {
            const int half = 1 << j, lo = max(t - half, 0), hi = min(t + half, S), c0 = (lane + 64 * j) * 8;
            u32x4 xr[16];
#pragma unroll
            for (int q = 0; q < 16; ++q) if (q < 2 * half) { const int r = t - half + q; xr[q] = (r >= 0 && r < S) ? *(const u32x4*)(xn + (size_t)r * DM + c0) : (u32x4){0u, 0u, 0u, 0u}; }
            float a[8];
#pragma unroll
            for (int q = 0; q < 8; ++q) a[q] = 0.f;
#pragma unroll
            for (int q = 0; q < 16; ++q) if (q < 2 * half) { const u32x4 x = xr[q]; const float r1 = rs[8 - half + q];
                a[0] += bflo(x.x) * r1; a[1] += bfhi(x.x) * r1; a[2] += bflo(x.y) * r1; a[3] += bfhi(x.y) * r1; a[4] += bflo(x.z) * r1; a[5] += bfhi(x.z) * r1; a[6] += bflo(x.w) * r1; a[7] += bfhi(x.w) * r1; }
            const u32x4 x = xr[half]; const float ic = 1.0f / (float)(hi - lo), rt = rs[8];
            const f32x4 g0 = *(const f32x4*)(g + c0), g1 = *(const f32x4*)(g + c0 + 4);
            o4[j].x = pk2((a[0] * ic - bflo(x.x) * rt) * g0.x, (a[1] * ic - bfhi(x.x) * rt) * g0.y); o4[j].y = pk2((a[2] * ic - bflo(x.y) * rt) * g0.z, (a[3] * ic - bfhi(x.y) * rt) * g0.w);
            o4[j].z = pk2((a[4] * ic - bflo(x.z) * rt) * g1.x, (a[5] * ic - bfhi(x.z) * rt) * g1.y); o4[j].w = pk2((a[6] * ic - bflo(x.w) * rt) * g1.z, (a[7] * ic - bfhi(x.w) * rt) * g1.w);
        }
#pragma unroll
        for (int j = 0; j < 4; ++j) *(u32x4*)(WSP(bf16_t, WS_POOLED) + (size_t)t * DM + (lane + 64 * j) * 8) = o4[j];
    }
}
__device__ __forceinline__ void ph_norm(const Frame& F, int layer) {
    const int gw = F.vcu * NWAVES + F.wave, NGW = F.G * NWAVES;
    for (int m = gw; m < S; m += NGW) rms_row_to_bf16(WSP(float, WS_H) + (size_t)m * DM, FIN(2) + layer * DM, WSP(bf16_t, WS_XN) + (size_t)m * DM, F.lane);
}


__device__ __forceinline__ void ph_attn(const Frame& F) {
    const int nunits = 8 * 64;
    float gq = fabsf(FIN(6)[F.lane]), gk = fabsf(FIN(7)[F.lane]); gq = fmaxf(gq, fabsf(FIN(6)[64 + F.lane])); gk = fmaxf(gk, fabsf(FIN(7)[64 + F.lane]));
#pragma unroll
    for (int o = 1; o < 64; o <<= 1) { gq = fmaxf(gq, __shfl_xor(gq, o)); gk = fmaxf(gk, __shfl_xor(gk, o)); }
    const float mC = -fminf(11.313708498984761f * gq * gk * 1.01f, 60.f) * 1.4426950408889634f;
    for (int u = F.vcu * 2; u < nunits; u += F.G * 2)
#pragma unroll 1
        for (int k = 0; k < 2; ++k) { const int unit = u + k, head = unit >> 6, qb = unit & 63, kvh = head >> 2;
            att::attn_dense_body<att::bf16>(WSP(att::bf16, WS_QB) + (size_t)(qb * 256) * 1024 + head * 128, WSP(att::bf16, WS_KVB) + kvh * 128, WSP(att::bf16, WS_KVB) + 256 + kvh * 128,
                                 WSP(att::bf16, WS_Y) + (size_t)(qb * 256) * DM + head * 128, S, F.ldsg, mC); }
}

#if defined(DBG_ATTN_CHECK)
constexpr int CW_DBG = 2048;
__device__ __forceinline__ void dbg_attn_check(const Frame& F) {
    __syncthreads();
    LAS float* sc = (LAS float*)F.lds; LAS float* red = sc + 16384; LAS float* po = red + 64;
    const int tid = F.tid, lane = F.lane, wave = F.wave;
    for (int chk = 0; chk < 4; ++chk) {
        const int unit = F.vcu * 2 + (chk & 1), head = unit >> 6, qb = unit & 63, kvh = head >> 2;
        const int t = qb * 256 + ((F.vcu * 37 + chk * 101 + 5) & 255);
        const bf16_t* q = WSP(bf16_t, WS_QB) + (size_t)t * 1024 + head * 128; const bf16_t* K = WSP(bf16_t, WS_KVB) + kvh * 128; const bf16_t* V = WSP(bf16_t, WS_KVB) + 256 + kvh * 128;
        float mx = -1e30f;
        for (int j = 0; j < 32; ++j) { const int key = tid + 512 * j; float s = 0.f;
            for (int d = 0; d < 128; ++d) s += bflo((unsigned)q[d]) * bflo((unsigned)K[(size_t)key * 512 + d]);
            s *= 0.088388347648318440f; sc[key] = s; mx = fmaxf(mx, s); }
        for (int o = 1; o < 64; o <<= 1) mx = fmaxf(mx, __shfl_xor(mx, o));
        if (lane == 0) red[wave] = mx;
        __syncthreads();
        mx = red[0]; for (int w = 1; w < 8; ++w) mx = fmaxf(mx, red[w]);
        __syncthreads();
        float sm = 0.f;
        for (int j = 0; j < 32; ++j) { const int key = tid + 512 * j; const float p = expf(sc[key] - mx); sc[key] = p; sm += p; }
        sm = wave_sum(sm);
        if (lane == 0) red[8 + wave] = sm;
        __syncthreads();
        sm = 0.f; for (int w = 0; w < 8; ++w) sm += red[8 + w];
        const int d = tid & 127, part = tid >> 7; float acc = 0.f;
        for (int kk = 0; kk < 4096; ++kk) { const int key = part * 4096 + kk; acc += sc[key] * bflo((unsigned)V[(size_t)key * 512 + d]); }
        po[part * 128 + d] = acc;
        __syncthreads();
        if (tid < 128) { const float o = (po[d] + po[128 + d] + po[256 + d] + po[384 + d]) / sm;
            const float y = bflo((unsigned)WSP(bf16_t, WS_Y)[(size_t)t * DM + head * 128 + d]);
            float ma = fabsf(o); for (int x = 1; x < 64; x <<= 1) ma = fmaxf(ma, __shfl_xor(ma, x));
            if (lane == 0) red[16 + wave] = ma;
            asm volatile("s_waitcnt lgkmcnt(0)" ::: "memory");
            const float mall = fmaxf(red[16], red[17]);
            const float mown = red[16 + wave]; (void)mall;
            const bool bad = !(fabsf(o - y) <= 0.03f * mown + 1e-5f);
            if (bad) atomicAdd((unsigned*)(F.ws + WS_CTL) + CW_DBG, 1u); }
        __syncthreads();
    }
}
#endif
#if defined(PROBE_MX)
typedef int v8i32p __attribute__((ext_vector_type(8)));
__device__ __forceinline__ unsigned probe_mx(int lane, int ra, int rb) {
    const int i = lane & 15, g = lane >> 4;
    v8i32p A = {0, 0, 0, 0, 0, 0, 0, 0}, B = {0, 0, 0, 0, 0, 0, 0, 0};
    if (g == PROBE_MX_G && i < 6) { const int j0 = (i == 0 ? 1 : i == 1 ? 2 : i == 2 ? 4 : i == 3 ? 8 : i == 4 ? 16 : 0);
#pragma unroll
        for (int d = 0; d < 4; ++d) if ((j0 >> 3) == d) A[d] = 0x2 << (4 * (j0 & 7)); }
    if (g == PROBE_MX_GB) {
#pragma unroll
        for (int d = 0; d < 8; ++d) { unsigned w = 0;
#pragma unroll
            for (int bb = 0; bb < 4; ++bb) { const int b = 4 * d + bb; const unsigned code = (unsigned)(((7 + (b >> 3)) << 3) | (b & 7)); w |= code << (8 * bb); }
            B[d] = (int)w; } }

    f32x4 c = {0.f, 0.f, 0.f, 0.f};
    c = __builtin_amdgcn_mfma_scale_f32_16x16x128_f8f6f4(A, B, c, 4, 0, 0, 0x7f7f7f7f, 0, 0x7f7f7f7f);
    float va = 0.f, vb = 0.f;
#pragma unroll
    for (int r = 0; r < 4; ++r) { const float x = __shfl(c[r], 16 * (ra >> 2)); if ((ra & 3) == r) va = x; const float y = __shfl(c[r], 16 * (rb >> 2)); if ((rb & 3) == r) vb = y; }
    auto dec = [](float v) -> unsigned { if (!(v >= 1.f)) return 33u; int e = 0; while (v >= 2.f && e < 8) { v *= 0.5f; ++e; } return (unsigned)(e * 8) + (unsigned)((v - 1.f) * 8.f + 0.5f); };
    return dec(va) + 40u * dec(vb);
}
#endif
#ifndef PHASE_MASK
#define PHASE_MASK 0xfffff
#endif
#define PH_ON(k) (((PHASE_MASK) >> (k)) & 1)
struct Args { const float* in[17]; float* out; unsigned char* ws; int ph_lo, ph_hi; };
static_assert(sizeof(Args) == 17 * 8 + 8 + 8 + 8, "Args has no padding");
__global__ void __launch_bounds__(NTHR, 2) fwd_kernel(Args args) {
    extern __shared__ __attribute__((aligned(16))) unsigned char lds[];
    Frame F;
    F.lds = (LAS unsigned char*)lds; F.ldsg = (char*)lds;
    F.tid = threadIdx.x; F.lane = F.tid & 63; F.wave = __builtin_amdgcn_readfirstlane(F.tid >> 6);
    F.G = gridDim.x; { const int bx = blockIdx.x; F.vcu = (F.G % 8 == 0) ? (bx % 8) * (F.G / 8) + bx / 8 : bx; }
    F.ws = args.ws;
    volatile LAS unsigned* MISC = (volatile LAS unsigned*)(F.lds + LDSCTL_OFF);
    if (F.tid < 16) ((LAS unsigned*)(F.lds + LDSCTL_OFF))[F.tid] = 0u;
    if (F.tid >= 64 && F.tid < 64 + 36) ((LAS unsigned*)(F.lds + LDSCTL_OFF + 64))[F.tid - 64] = ((const unsigned*)&args)[F.tid - 64];
    __syncthreads();
    const int lo = args.ph_lo, hi = args.ph_hi;
    XcdBarrier bar; bar.bar = (unsigned*)(F.ws + WS_CTL) + CW_BAR; bar.x = 0; bar.st = nullptr;
    if (hi - lo > 1) bar = xcd_barrier_post((unsigned*)(F.ws + WS_CTL) + CW_BAR, MISC + 8);
#if defined(PROBE_BAR)
    unsigned long long tbar_total = 0;
#endif
#pragma unroll 1
    for (int ph = lo; ph < hi; ++ph) {
#if defined(PROBE_BAR)
        if (ph > lo) { const unsigned long long tb0 = __builtin_amdgcn_s_memrealtime(); xcd_barrier(bar); if (PROBE_BAR == 100 || ph == PROBE_BAR) tbar_total += __builtin_amdgcn_s_memrealtime() - tb0; }
#else
        if (ph > lo) xcd_barrier(bar);
#endif
#if defined(PROBE_PH)
        unsigned long long tprobe0 = 0; if (ph == PROBE_PH) tprobe0 = __builtin_amdgcn_s_memrealtime();
        if (ph == PROBE_PH + 1 || (PROBE_PH == NPH - 1 && false)) { }
#endif
        switch (ph) {
#define PHM(n) do { asm volatile("; PHASE_MARK " #n ::: "memory"); int t_ = threadIdx.x; asm volatile("" : "+v"(t_)); F.tid = t_; F.lane = t_ & 63; F.wave = __builtin_amdgcn_readfirstlane(t_ >> 6); \
    unsigned long long z_ = 0; asm volatile("" : "+s"(z_)); F.ws = args.ws + z_; } while (0)
        case PH_PRO: if constexpr (PH_ON(PH_PRO)) { PHM(PH_PRO); ph_prologue(F); } break;
        case PH_GEMM_IN: if constexpr (PH_ON(PH_GEMM_IN)) { PHM(PH_GEMM_IN);  pg8::Gemm g{WSP(bf16_t, WS_XN), WSP(bf16_t, WS_WIN), S, INP, DM, DM, DM, 0, 0}; pg8::StaticOrder So; So.init(S, INP, F.G, (int)blockIdx.x);
            pg8::EpiBf16<0> E{WSP(bf16_t, WS_PROJ), INP, nullptr, 0, 0, 1.f};
            pg8::gemm_phase<pg8::EpiBf16<0>, pg8::StaticOrder, true, true>(F.lds, g, So, E); } break;
        case PH_POST: if constexpr (PH_ON(PH_POST)) { PHM(PH_POST); ph_post(F); } break;
        case PH_ATTN: if constexpr (PH_ON(PH_ATTN)) { PHM(PH_ATTN); ph_attn(F); ph_mla(F);
#if defined(DBG_ATTN_CHECK)
            dbg_attn_check(F);
#endif
            } break;
        case PH_SCAN: if constexpr (PH_ON(PH_SCAN)) { PHM(PH_SCAN); ph_scan(F); } break;
        case PH_MLB: if constexpr (PH_ON(PH_MLB)) { PHM(PH_MLB); ph_mlb(F); } break;
        case PH_GEMM_OUT: if constexpr (PH_ON(PH_GEMM_OUT)) { PHM(PH_GEMM_OUT);  pg8::Gemm g{WSP(bf16_t, WS_Y), WSP(bf16_t, WS_WOUT), S, DM, DM, DM, DM, 0, 0}; pg8::StaticOrder So; So.init(S, DM, F.G, (int)blockIdx.x);
            pg8::EpiRes<false> E{FIN(0), WSP(bf16_t, WS_XN), DM, nullptr, (unsigned long long*)(F.ws + WS_CTL + CTL_SSQ)};
            pg8::gemm_phase<pg8::EpiRes<false>, pg8::StaticOrder, true, true>(F.lds, g, So, E); } break;
        case PH_GEMM_Q0: case PH_GEMM_Q1: if constexpr (PH_ON(PH_GEMM_Q0)) { PHM(PH_GEMM_Q0);  pg8::Gemm g{WSP(bf16_t, WS_XN), WSP(bf16_t, ph == PH_GEMM_Q0 ? WS_WQ0 : WS_WQ1), S, DM, DM, DM, DM, 0, 0}; pg8::StaticOrder So; So.init(S, DM, F.G, (int)blockIdx.x);
            pg8::EpiBf16Row E{WSP(bf16_t, WS_QP), DM, (const unsigned long long*)(F.ws + WS_CTL + CTL_SSQ) + (ph == PH_GEMM_Q0 ? 0 : 2 * S), 1.0f / DM, EPS};
            pg8::gemm_phase<pg8::EpiBf16Row, pg8::StaticOrder, true, true>(F.lds, g, So, E); } break;
        case PH_TOPK0: if constexpr (PH_ON(PH_TOPK0)) { PHM(PH_TOPK0); ph_topk(F, 0); } break;
        case PH_TOPK1: if constexpr (PH_ON(PH_TOPK1)) { PHM(PH_TOPK1); ph_topk(F, 1); } break;
        case PH_GU0: if constexpr (PH_ON(PH_GU0)) { PHM(PH_GU0); ph_gu(F, 0); } break;
        case PH_GU1: if constexpr (PH_ON(PH_GU1)) { PHM(PH_GU1); ph_gu(F, 1); } break;
        case PH_ACT0: if constexpr (PH_ON(PH_ACT0)) { PHM(PH_ACT0); ph_act(F, 0); } break;
        case PH_ACT1: if constexpr (PH_ON(PH_ACT1)) { PHM(PH_ACT1); ph_act(F, 1); } break;
        case PH_GV0: if constexpr (PH_ON(PH_GV0)) { PHM(PH_GV0); ph_gv(F, 0); } break;
        case PH_GV1: if constexpr (PH_ON(PH_GV1)) { PHM(PH_GV1); ph_gv(F, 1); } break;
        case PH_NORMF: if constexpr (PH_ON(PH_NORMF)) { PHM(PH_NORMF); ph_normg(F, true);
#if defined(DBG_ATTN_CHECK)
            { const unsigned nb = __hip_atomic_load((unsigned*)(F.ws + WS_CTL) + CW_DBG, __ATOMIC_RELAXED, __HIP_MEMORY_SCOPE_AGENT);
              if (nb != 0u) { float* o = FOUT(); for (int i = F.vcu * NTHR + F.tid; i < 4096; i += F.G * NTHR) o[(size_t)i * 8192 + 7] += (DBG_ATTN_CHECK == 2 ? 0.f : 1000.f); } }
#endif
            } break;
        case PH_POOLPREP: if constexpr (PH_ON(PH_POOLPREP)) { PHM(PH_POOLPREP); ph_poolprep(F); } break;
        case PH_GEMM_POOL: if constexpr (PH_ON(PH_GEMM_POOL)) { PHM(PH_GEMM_POOL);  pg8::Gemm g{WSP(bf16_t, WS_POOLED), WSP(bf16_t, WS_WPOOL), S, DM, 512, DM, 512, 1, 512 * 2}; pg8::StaticOrder So; So.init(S, DM, F.G, (int)blockIdx.x);
            pg8::EpiRes<true> E{WSP(bf16_t, WS_XN), WSP(bf16_t, WS_XN), DM, FIN(11), (unsigned long long*)(F.ws + WS_CTL + CTL_SSQ) + 2 * S};
            pg8::gemm_phase<pg8::EpiRes<true>, pg8::StaticOrder, true, true>(F.lds, g, So, E); } break;
        default: break;
        }
#if defined(PROBE_BAR)
        if (ph == hi - 1 && F.vcu == PROBE_BAR_VCU) { __syncthreads(); const unsigned long long t1 = __builtin_amdgcn_s_memrealtime(); while (__builtin_amdgcn_s_memrealtime() - t1 < 16ull * tbar_total) __builtin_amdgcn_s_sleep(8); }
#endif
#if defined(PROBE_PH)
#ifndef PROBE_VCU
#define PROBE_VCU -1
#endif
        if (ph == PROBE_PH && (PROBE_VCU < 0 || F.vcu == PROBE_VCU)) { __syncthreads(); const unsigned long long t1 = __builtin_amdgcn_s_memrealtime(), dt = t1 - tprobe0;
            while (__builtin_amdgcn_s_memrealtime() - t1 < 4ull * dt) __builtin_amdgcn_s_sleep(8); }
#endif
    }
}

#if defined(PROBE_MX)
__global__ void __launch_bounds__(64) probe_mx_kernel(int dummy) {
    const unsigned code = probe_mx((int)threadIdx.x, PROBE_MX_RA, PROBE_MX_RB); const unsigned long long t1 = __builtin_amdgcn_s_memrealtime();
    while (__builtin_amdgcn_s_memrealtime() - t1 < 1000ull * code + (unsigned long long)dummy) __builtin_amdgcn_s_sleep(8);
}
#endif
#ifndef N_LAUNCH_MODE
#define N_LAUNCH_MODE 1
#endif
extern "C" void kernel_launch(void* const* d_in, const int* in_sizes, int n_in, void* d_out, int out_size, void* d_ws, size_t ws_size, hipStream_t stream) {
    static int grid = 0;
    if (grid == 0) {
        if (n_in != 17 || in_sizes[0] != S * DM || out_size != S * DM || ws_size < WS_END) { fprintf(stderr, "kernel_launch: unexpected shapes (n_in %d, in0 %d, out %d, ws %zu; need ws >= %zu)\n", n_in, n_in > 0 ? in_sizes[0] : -1, out_size, ws_size, (size_t)WS_END); grid = -1; return; }
        int dev = 0, cus = 0;
        if (hipGetDevice(&dev) != hipSuccess || hipDeviceGetAttribute(&cus, hipDeviceAttributeMultiprocessorCount, dev) != hipSuccess) { grid = -1; return; }
        if (hipFuncSetAttribute((const void*)fwd_kernel, hipFuncAttributeMaxDynamicSharedMemorySize, LDS_BYTES) != hipSuccess) { fprintf(stderr, "kernel_launch: hipFuncSetAttribute failed\n"); grid = -1; return; }
        int per_cu = 0;
        if (hipOccupancyMaxActiveBlocksPerMultiprocessor(&per_cu, (const void*)fwd_kernel, NTHR, LDS_BYTES) != hipSuccess || per_cu < 1) fprintf(stderr, "kernel_launch: occupancy query reports %d\n", per_cu);
        (void)hipGetLastError();
        grid = cus;
        if (grid != 256) { fprintf(stderr, "kernel_launch: built for a 256-CU device (got %d CUs)\n", grid); grid = -1; return; }
    }
    if (grid < 0) return;
    (void)hipMemsetAsync((char*)d_ws + WS_CTL, 0, CTL_ZERO_BYTES, stream);
    Args a{};
    for (int i = 0; i < 17; ++i) a.in[i] = (const float*)d_in[i];
    a.out = (float*)d_out; a.ws = (unsigned char*)d_ws;
#if N_LAUNCH_MODE == 1
    a.ph_lo = 0; a.ph_hi = NPH;
    hipLaunchKernelGGL(fwd_kernel, dim3(grid), dim3(NTHR), LDS_BYTES, stream, a);
#else
    for (int ph = 0; ph < NPH; ++ph) { a.ph_lo = ph; a.ph_hi = ph + 1; hipLaunchKernelGGL(fwd_kernel, dim3(grid), dim3(NTHR), LDS_BYTES, stream, a); }
#endif
#if defined(PROBE_MX)
    hipLaunchKernelGGL(probe_mx_kernel, dim3(1), dim3(64), 0, stream, 0);
#endif
    const hipError_t le = hipPeekAtLastError();
    if (le != hipSuccess) fprintf(stderr, "kernel_launch: launch failed: %s\n", hipGetErrorName(le));
}
```

```cpp
#include <hip/hip_runtime.h>
#include <hip/hip_bf16.h>
#include <cstdio>
#include <cstdint>
#include <cmath>

#ifndef TBL_FP4
#define TBL_FP4 1
#endif
constexpr int S = 16384, DM = 2048, NWAVES = 8, NTHR = 512;
constexpr int INW = 5648, INP = 5888;
constexpr int C_AQ = 0, C_AK = 1024, C_AV = 1280, C_MQK = 1536, C_MV = 3584, C_MO = 4608, C_GATE = 5632;
constexpr float EPS = 1e-6f;
constexpr int NPH = 18;
enum { PH_PRO = 0, PH_GEMM_IN, PH_POST, PH_ATTN  , PH_SCAN, PH_MLB, PH_GEMM_OUT, PH_GEMM_Q0  , PH_GU0, PH_ACT0, PH_GV0,
       PH_POOLPREP, PH_GEMM_POOL, PH_GEMM_Q1  , PH_GU1, PH_ACT1, PH_GV1, PH_NORMF };

constexpr size_t MiB = 1u << 20;
constexpr size_t WS_CTL = 0, CTL_ZERO_BYTES = 1 * MiB;
constexpr size_t WS_WIN = 1 * MiB, WS_WOUT = 24 * MiB, WS_WQ0 = 32 * MiB, WS_WQ1 = 40 * MiB, WS_WPOOL = 48 * MiB, WS_KEYS = 50 * MiB;
constexpr size_t WS_TSC = 52 * MiB + 768 * 1024  , WS_GATES = 51 * MiB, WS_NST = 53 * MiB, WS_EIDX = 54 * MiB, WS_EGATE = 62 * MiB;
constexpr size_t WS_UB = 70 * MiB, WS_VB = 198 * MiB, WS_XN = 326 * MiB, WS_PROJ = 390 * MiB, WS_QP = WS_PROJ;
constexpr size_t WS_QB = 574 * MiB, WS_KVB = 606 * MiB, WS_MQ = 622 * MiB, WS_MK = 654 * MiB, WS_CST = 686 * MiB, WS_Y = 814 * MiB, WS_POOLED = WS_Y;
constexpr size_t WS_H = 878 * MiB, WS_END = 1006 * MiB;
constexpr size_t CTL_SSQ = 256 * 1024;
constexpr int CW_BAR = 4096;
constexpr size_t GO_B = 0, GO_U = 8 * S * 4, GO_PM = 2 * 8 * S * 4, GO_G = 3 * 8 * S * 4, GO_PML = GO_G + 4096, GO_MPREV = GO_PML + 4096;

constexpr int LDS_BYTES = 147456, LDSCTL_OFF = 146944;

#define GAS __attribute__((address_space(1)))
#define LAS __attribute__((address_space(3)))
typedef unsigned short bf16_t;
typedef short bf16x8 __attribute__((ext_vector_type(8)));
typedef short s16x4 __attribute__((ext_vector_type(4)));
typedef short v4i16_t __attribute__((ext_vector_type(4)));
typedef float f32x4 __attribute__((ext_vector_type(4)));
typedef float f32x2 __attribute__((ext_vector_type(2)));
typedef float f32x16 __attribute__((ext_vector_type(16)));
typedef unsigned u32x4 __attribute__((ext_vector_type(4)));
typedef unsigned u32x2 __attribute__((ext_vector_type(2)));
typedef __bf16 bf16x2_t __attribute__((ext_vector_type(2)));
typedef GAS unsigned gu32;
#define RLX_AGENT __ATOMIC_RELAXED, __HIP_MEMORY_SCOPE_AGENT
#define LDS_WAIT() asm volatile("s_waitcnt lgkmcnt(0)" ::: "memory")
__device__ __forceinline__ unsigned f2bf(float f) { unsigned u = __builtin_bit_cast(unsigned, f); return (u + 0x7fffu + ((u >> 16) & 1u)) >> 16; }
__device__ __forceinline__ unsigned pk2(float lo, float hi) { f32x2 v = {lo, hi}; bf16x2_t b = __builtin_convertvector(v, bf16x2_t); return __builtin_bit_cast(unsigned, b); }
__device__ __forceinline__ float bflo(unsigned w) { return __builtin_bit_cast(float, w << 16); }
__device__ __forceinline__ float bfhi(unsigned w) { return __builtin_bit_cast(float, w & 0xffff0000u); }
__device__ __forceinline__ float rstd_of(unsigned long long ss) { return 1.0f / sqrtf((float)ss * (1.0f / (1048576.0f * 2048.0f)) + 1e-6f); }
__device__ __forceinline__ void st_wt8(void* p, u32x2 v) { __hip_atomic_store((unsigned long long*)p, ((unsigned long long)v.y << 32) | v.x, __ATOMIC_RELAXED, __HIP_MEMORY_SCOPE_AGENT); }
__device__ __forceinline__ void st_wt8f(void* p, f32x2 v) { st_wt8(p, __builtin_bit_cast(u32x2, v)); }
__device__ __forceinline__ void st_wt16(void* p, u32x4 v) { asm volatile("global_store_dwordx4 %0, %1, off sc1" :: "v"(p), "v"(v) : "memory"); }
__device__ __forceinline__ void st_wt16f(void* p, f32x4 v) { st_wt16(p, __builtin_bit_cast(u32x4, v)); }
__device__ __forceinline__ float wave_sum(float v) {
#pragma unroll
    for (int o = 1; o < 64; o <<= 1) v += __shfl_xor(v, o);
    return v;
}

namespace pg8 {
#define PG8_LAS __attribute__((address_space(3)))
typedef unsigned short bf16_t;
typedef short bf16x8 __attribute__((ext_vector_type(8)));
typedef float f32x4 __attribute__((ext_vector_type(4)));
typedef unsigned u32x4 __attribute__((ext_vector_type(4)));
constexpr int BM = 256, BK = 64, HALF = 128, HTB = HALF * BK * 2  , STAGE_BYTES = 8 * HTB, NXCD = 8, WGM = 8;

__host__ __device__ __forceinline__ int lds_byte(int r, int c) { const int st = (r >> 4) * 2 + (c >> 5), rr = r & 15, cc = c & 31, ob = rr * 64 + cc * 2; return st * 1024 + (ob ^ (((ob >> 9) & 1) << 5)); }
__host__ __device__ __forceinline__ void stage_rc(int b, int& R, int& C) { const int st = b / 1024, sb = b % 1024, swz = sb ^ (((sb >> 9) & 1) << 5); R = (st >> 1) * 16 + swz / 64; C = (st & 1) * 32 + (swz % 64) / 2; }
__host__ __device__ __forceinline__ int perm32(int rho) { const int n = rho >> 4, i = rho & 15; return 8 * (i >> 2) + 4 * n + (i & 3); }

struct Unit { int pm, pn; };
struct Gemm { const bf16_t* A; const bf16_t* Bt; int M, N, K, lda, ldb, agrp_shift; size_t agrp_bytes; };

struct StaticOrder {
    int nM, nN, nwg, G, c;
    __host__ __device__ void init(int M, int N, int G_, int c_) { nM = M / BM; nN = N / BM; nwg = nM * nN; G = G_; c = c_; }
    __host__ __device__ bool next(int i, Unit& u) const {
        const long L = (long)i * G + c; if (L >= nwg) return false;
        int wgid = (int)L; { const int q = nwg / NXCD, r = nwg % NXCD, xcd = wgid % NXCD, off = wgid / NXCD; wgid = (xcd < r ? xcd * (q + 1) : r * (q + 1) + (xcd - r) * q) + off; }
        const int nig = WGM * nN, gid = wgid / nig, fm = gid * WGM, gsz = (nM - fm) < WGM ? (nM - fm) : WGM;
        u.pm = fm + ((wgid % nig) % gsz); u.pn = (wgid % nig) / gsz; return true;
    }
    __device__ __forceinline__ void a_ready(const Unit&) const {}
    __device__ __forceinline__ void done(const Unit&) const {}
};

__device__ __forceinline__ unsigned cvt_pk_bf16(float lo, float hi) { unsigned r; asm volatile("v_cvt_pk_bf16_f32 %0, %1, %2" : "=v"(r) : "v"(lo), "v"(hi)); return r; }
typedef float f32x2 __attribute__((ext_vector_type(2)));
__device__ __forceinline__ f32x2 gelu_pk(f32x2 v) {
    const f32x2 av = __builtin_elementwise_abs(v), d = av * 0.2316418882f + 1.0f;
    f32x2 t; t.x = __builtin_amdgcn_rcpf(d.x); t.y = __builtin_amdgcn_rcpf(d.y);
    f32x2 q = t * 0.5307027145f + (-0.7265760135f); q = q * t + 0.7107068705f; q = q * t + (-0.142248368f); q = q * t + 0.127414796f; q = q * t;
    const f32x2 s = (v * v) * (-0.72134752044f);
    f32x2 e; e.x = __builtin_amdgcn_exp2f(s.x); e.y = __builtin_amdgcn_exp2f(s.y);
    const f32x2 m = v * (q * e), r = v - m;
    f32x2 o; o.x = v.x < 0.f ? m.x : r.x; o.y = v.y < 0.f ? m.y : r.y; return o;
}
template <int ACT  > struct EpiBf16 {
    static constexpr bool PERM = true, AFTER_DRAIN = false; static_assert(ACT == 0 || ACT == 1, "EpiBf16: ACT is 0 (none) or 1 (gelu_pk)");
    bf16_t* O; int ldc; const float* bias; int split_cols; size_t split_stride; float scale0;
    __device__ __forceinline__ void operator()(const f32x4 (&acc)[2][2][4][2], const Unit& u, int wr, int wc, int fr, int fq) const {
        const int row0 = u.pm * BM + wr * 64 + fr; int colt = u.pn * BM; bf16_t* base = O;
        float sc = 1.f; if (split_cols) { const int t = colt / split_cols; base += (size_t)t * split_stride; colt -= t * split_cols; if (t == 0) sc = scale0; }
        const int col0 = colt + wc * 32 + 8 * fq, bcol0 = u.pn * BM + wc * 32 + 8 * fq;
        f32x4 bv[2][2];
#pragma unroll
        for (int bj = 0; bj < 2; ++bj)
#pragma unroll
            for (int n = 0; n < 2; ++n) bv[bj][n] = bias ? *(const f32x4*)(bias + bcol0 + bj * HALF + 4 * n) : (f32x4){0.f, 0.f, 0.f, 0.f};
#pragma unroll
        for (int ai = 0; ai < 2; ++ai)
#pragma unroll
            for (int m = 0; m < 4; ++m) { bf16_t* rowp = base + (size_t)(row0 + ai * HALF + m * 16) * ldc + col0;
#pragma unroll
                for (int bj = 0; bj < 2; ++bj) { f32x4 v0 = acc[ai][bj][m][0] + bv[bj][0], v1 = acc[ai][bj][m][1] + bv[bj][1];
                    if (ACT == 1) { f32x2 a = gelu_pk((f32x2){v0[0], v0[1]}), b = gelu_pk((f32x2){v0[2], v0[3]}), c = gelu_pk((f32x2){v1[0], v1[1]}), d = gelu_pk((f32x2){v1[2], v1[3]});
                        v0 = (f32x4){a.x, a.y, b.x, b.y}; v1 = (f32x4){c.x, c.y, d.x, d.y}; }
                    v0 = v0 * sc; v1 = v1 * sc; u32x4 w; w.x = cvt_pk_bf16(v0[0], v0[1]); w.y = cvt_pk_bf16(v0[2], v0[3]); w.z = cvt_pk_bf16(v1[0], v1[1]); w.w = cvt_pk_bf16(v1[2], v1[3]);
                    *(u32x4*)(rowp + bj * HALF) = w; } }
    }
};
template <bool BASE_BF16> struct EpiRes {
    static constexpr bool PERM = false, AFTER_DRAIN = false;
    const void* base; bf16_t* hb; int ldc; const float* colscale; unsigned long long* ssq;
    __device__ __forceinline__ void operator()(const f32x4 (&acc)[2][2][4][2], const Unit& u, int wr, int wc, int fr, int fq) const {
        typedef unsigned u32x2v __attribute__((ext_vector_type(2)));
        const int row0 = u.pm * BM + wr * 64 + fr, col0 = u.pn * BM + wc * 32 + 4 * fq;
        f32x4 cs[2][2];
#pragma unroll
        for (int bj = 0; bj < 2; ++bj)
#pragma unroll
            for (int n = 0; n < 2; ++n) cs[bj][n] = colscale ? *(const f32x4*)(colscale + col0 + bj * HALF + n * 16) : (f32x4){1.f, 1.f, 1.f, 1.f};
#pragma unroll
        for (int ai = 0; ai < 2; ++ai)
#pragma unroll
            for (int m = 0; m < 4; ++m) { const size_t off = (size_t)(row0 + ai * HALF + m * 16) * ldc + col0;
                float ssum = 0.f;
#pragma unroll
                for (int bj = 0; bj < 2; ++bj)
#pragma unroll
                    for (int n = 0; n < 2; ++n) { f32x4 b;
                        if (BASE_BF16) { const u32x2v w = *(const u32x2v*)((const bf16_t*)base + off + bj * HALF + n * 16);
                            b = (f32x4){__builtin_bit_cast(float, w.x << 16), __builtin_bit_cast(float, w.x & 0xffff0000u), __builtin_bit_cast(float, w.y << 16), __builtin_bit_cast(float, w.y & 0xffff0000u)}; }
                        else b = *(const f32x4*)((const float*)base + off + bj * HALF + n * 16);
                        const f32x4 h = b + acc[ai][bj][m][n] * cs[bj][n];
                        u32x2v w; w.x = cvt_pk_bf16(h[0], h[1]); w.y = cvt_pk_bf16(h[2], h[3]); *(u32x2v*)(hb + off + bj * HALF + n * 16) = w;
                        ssum += (h[0] * h[0] + h[1] * h[1]) + (h[2] * h[2] + h[3] * h[3]); }
                if (ssq) { ssum += __shfl_xor(ssum, 16); ssum += __shfl_xor(ssum, 32);
                    if (fq == 0) atomicAdd(ssq + (row0 + ai * HALF + m * 16), (unsigned long long)(ssum * 1048576.0f)); }
                asm volatile("" ::: "memory"); }
    }
};

struct EpiBf16Row {
    static constexpr bool PERM = true, AFTER_DRAIN = false;
    bf16_t* O; int ldc; const unsigned long long* ssq; float inv_ncol, eps;
    __device__ __forceinline__ void operator()(const f32x4 (&acc)[2][2][4][2], const Unit& u, int wr, int wc, int fr, int fq) const {
        const int row0 = u.pm * BM + wr * 64 + fr, col0 = u.pn * BM + wc * 32 + 8 * fq;
#pragma unroll
        for (int ai = 0; ai < 2; ++ai)
#pragma unroll
            for (int m = 0; m < 4; ++m) { const int row = row0 + ai * HALF + m * 16; bf16_t* rowp = O + (size_t)row * ldc + col0;
                const float sc = ssq ? 1.0f / sqrtf((float)ssq[row] * (inv_ncol * (1.0f / 1048576.0f)) + eps) : 1.f;
#pragma unroll
                for (int bj = 0; bj < 2; ++bj) { const f32x4 v0 = acc[ai][bj][m][0] * sc, v1 = acc[ai][bj][m][1] * sc;
                    u32x4 w; w.x = cvt_pk_bf16(v0[0], v0[1]); w.y = cvt_pk_bf16(v0[2], v0[3]); w.z = cvt_pk_bf16(v1[0], v1[1]); w.w = cvt_pk_bf16(v1[2], v1[3]);
                    *(u32x4*)(rowp + bj * HALF) = w; } }
    }
};

template <class Epi, class Sched, bool ALIGN_EPI = false, bool SP2 = false>
__device__ __forceinline__ void gemm_phase(PG8_LAS unsigned char* lds, const Gemm g, const Sched& S, const Epi& E) {
    int tid_ = threadIdx.x; asm volatile("" : "+v"(tid_));
    const int tid = tid_, wid = __builtin_amdgcn_readfirstlane(tid >> 6), lane = tid & 63, wr = wid >> 2, wc = wid & 3, fr = lane & 15, fq = lane >> 4;
    const int K = g.K, nt = K / BK;
    unsigned voffA[2], voffB[2];
#pragma unroll
    for (int i = 0; i < 2; ++i) { int R, C; stage_rc(tid * 16 + i * 8192, R, C); const int Rb = Epi::PERM ? ((R & ~31) + perm32(R & 31)) : R;
        voffA[i] = (unsigned)(R * g.lda + C) * 2u; voffB[i] = (unsigned)(Rb * g.ldb + C) * 2u; }
    const size_t kstep = (size_t)(BK * 2);
    const size_t hstepA = (size_t)HALF * g.lda * 2, hstepB = (size_t)HALF * g.ldb * 2;
    const size_t tstepA = 2 * hstepA, tstepB = 2 * hstepB;
    const unsigned ldsw = (unsigned)wid * 1024u;
    const int aoff = lds_byte(wr * 64 + fr, fq * 8), boff = lds_byte(wc * 32 + fr, fq * 8);
#define PG8_SA(b, h) (((b) * 2 + (h)) * HTB)
#define PG8_SB(b, h) ((4 + (b) * 2 + (h)) * HTB)
#define PG8_STAGE(bufoff, gbase, voff) do { _Pragma("unroll") for (int _i = 0; _i < 2; ++_i) \
        __builtin_amdgcn_global_load_lds((const unsigned*)((const char*)(gbase) + (voff)[_i]), (PG8_LAS unsigned*)(lds + (bufoff) + ldsw + _i * 8192), 16, 0, 0); } while (0)
#define PG8_LDA(dst, b, h) do { _Pragma("unroll") for (int m = 0; m < 4; ++m) _Pragma("unroll") for (int k = 0; k < 2; ++k) dst[m][k] = *(const PG8_LAS bf16x8*)(lds + PG8_SA(b, h) + aoff + m * 2048 + k * 1024); } while (0)
#define PG8_LDB(dst, b, h) do { _Pragma("unroll") for (int n = 0; n < 2; ++n) _Pragma("unroll") for (int k = 0; k < 2; ++k) dst[n][k] = *(const PG8_LAS bf16x8*)(lds + PG8_SB(b, h) + boff + n * 2048 + k * 1024); } while (0)
#define PG8_MMA(ai, bj, At, Bt) do { __builtin_amdgcn_s_setprio(1); _Pragma("unroll") for (int m = 0; m < 4; ++m) _Pragma("unroll") for (int n = 0; n < 2; ++n) _Pragma("unroll") for (int k = 0; k < 2; ++k) \
        acc[ai][bj][m][n] = __builtin_amdgcn_mfma_f32_16x16x32_bf16(Bt[n][k], At[m][k], acc[ai][bj][m][n], 0, 0, 0); __builtin_amdgcn_s_setprio(0); } while (0)
#define PG8_WAIT_V(n) asm volatile("s_waitcnt vmcnt(" #n ")" ::: "memory")
#define PG8_WAIT_L(n) asm volatile("s_waitcnt lgkmcnt(" #n ")" ::: "memory")
#define PG8_BAR __builtin_amdgcn_s_barrier()
#define PG8_SCHED __builtin_amdgcn_sched_barrier(0)
    Unit cur, nxt; int ui = 0;
    if (!S.next(0, cur)) return;
    f32x4 acc[2][2][4][2];
#pragma unroll
    for (int a = 0; a < 2; ++a)
#pragma unroll
        for (int b = 0; b < 2; ++b)
#pragma unroll
            for (int m = 0; m < 4; ++m)
#pragma unroll
                for (int n = 0; n < 2; ++n) acc[a][b][m][n] = (f32x4){0.f, 0.f, 0.f, 0.f};
    bf16x8 At[4][2], B0[2][2], B1[2][2];
    const char* cA = (const char*)g.A + (size_t)cur.pm * tstepA + (size_t)(cur.pn >> g.agrp_shift) * g.agrp_bytes; const char* cB = (const char*)g.Bt + (size_t)cur.pn * tstepB;
    S.a_ready(cur);
    if constexpr (SP2) {
        PG8_STAGE(PG8_SB(0, 0), cB, voffB); PG8_STAGE(PG8_SB(0, 1), cB + hstepB, voffB); PG8_STAGE(PG8_SA(0, 0), cA, voffA); PG8_STAGE(PG8_SA(0, 1), cA + hstepA, voffA);
        if (wr == 1) PG8_BAR;
        PG8_WAIT_V(2); PG8_BAR;
        PG8_STAGE(PG8_SB(1, 0), cB + kstep, voffB); PG8_STAGE(PG8_SA(1, 0), cA + kstep, voffA); PG8_STAGE(PG8_SB(1, 1), cB + hstepB + kstep, voffB);
        PG8_WAIT_V(6); PG8_BAR;
    } else {
        PG8_STAGE(PG8_SB(0, 0), cB, voffB); PG8_STAGE(PG8_SA(0, 0), cA, voffA); PG8_STAGE(PG8_SB(0, 1), cB + hstepB, voffB); PG8_STAGE(PG8_SA(0, 1), cA + hstepA, voffA);
        if (wr == 1) PG8_BAR;
        PG8_WAIT_V(4); PG8_BAR;
        PG8_STAGE(PG8_SB(1, 0), cB + kstep, voffB); PG8_STAGE(PG8_SA(1, 0), cA + kstep, voffA); PG8_STAGE(PG8_SB(1, 1), cB + hstepB + kstep, voffB);
        PG8_WAIT_V(6); PG8_BAR;
    }
    for (;;) {
        const bool has_next = S.next(ui + 1, nxt);
        const char* nA = has_next ? (const char*)g.A + (size_t)nxt.pm * tstepA + (size_t)(nxt.pn >> g.agrp_shift) * g.agrp_bytes : cA; const char* nB = has_next ? (const char*)g.Bt + (size_t)nxt.pn * tstepB : cB;
        for (int t = 0; t < nt; t += 2) {
            const bool last = (t == nt - 2);
            const char* a1 = cA + (size_t)(t + 1) * kstep;
            const char* a2 = last ? nA : cA + (size_t)(t + 2) * kstep; const char* b2 = last ? nB : cB + (size_t)(t + 2) * kstep;
            const char* a3 = a2 + kstep; const char* b3 = b2 + kstep;
            if (last && has_next) S.a_ready(nxt);
            if constexpr (SP2) {
            PG8_LDB(B0, 0, 0); PG8_LDB(B1, 0, 1); PG8_SCHED; PG8_LDA(At, 0, 0); PG8_STAGE(PG8_SA(1, 1), a1 + hstepA, voffA);
            PG8_WAIT_V(8); PG8_WAIT_L(0); PG8_BAR; PG8_MMA(0, 0, At, B0); PG8_MMA(0, 1, At, B1); PG8_BAR; PG8_SCHED;
            PG8_LDA(At, 0, 1); PG8_STAGE(PG8_SB(0, 0), b2, voffB); PG8_STAGE(PG8_SB(0, 1), b2 + hstepB, voffB); PG8_STAGE(PG8_SA(0, 0), a2, voffA);
            PG8_WAIT_V(8); PG8_WAIT_L(0); PG8_BAR; PG8_MMA(1, 0, At, B0); PG8_MMA(1, 1, At, B1); PG8_BAR; PG8_SCHED;
            PG8_LDB(B0, 1, 0); PG8_LDB(B1, 1, 1); PG8_SCHED; PG8_LDA(At, 1, 0); PG8_STAGE(PG8_SA(0, 1), a2 + hstepA, voffA);
            PG8_WAIT_V(8); PG8_WAIT_L(0); PG8_BAR; PG8_MMA(0, 0, At, B0); PG8_MMA(0, 1, At, B1); PG8_BAR; PG8_SCHED;
            PG8_LDA(At, 1, 1); PG8_STAGE(PG8_SB(1, 0), b3, voffB); PG8_STAGE(PG8_SB(1, 1), b3 + hstepB, voffB); PG8_STAGE(PG8_SA(1, 0), a3, voffA);
            PG8_WAIT_V(8); PG8_WAIT_L(0); PG8_BAR; PG8_MMA(1, 0, At, B0); PG8_MMA(1, 1, At, B1); PG8_BAR; PG8_SCHED;
            } else {
            PG8_LDB(B0, 0, 0); PG8_SCHED; PG8_LDA(At, 0, 0); PG8_STAGE(PG8_SA(1, 1), a1 + hstepA, voffA);
            PG8_WAIT_L(8); PG8_BAR; PG8_WAIT_L(0); PG8_MMA(0, 0, At, B0); PG8_BAR; PG8_SCHED;
            PG8_LDB(B1, 0, 1); PG8_STAGE(PG8_SB(0, 0), b2, voffB);
            PG8_BAR; PG8_WAIT_L(0); PG8_MMA(0, 1, At, B1); PG8_BAR;
            PG8_LDA(At, 0, 1); PG8_STAGE(PG8_SA(0, 0), a2, voffA);
            PG8_BAR; PG8_WAIT_L(0); PG8_MMA(1, 0, At, B0); PG8_BAR; PG8_SCHED;
            PG8_STAGE(PG8_SB(0, 1), b2 + hstepB, voffB);
            PG8_WAIT_V(6); PG8_BAR; PG8_MMA(1, 1, At, B1); PG8_BAR;
            PG8_LDB(B0, 1, 0); PG8_SCHED; PG8_LDA(At, 1, 0); PG8_STAGE(PG8_SA(0, 1), a2 + hstepA, voffA);
            PG8_WAIT_L(8); PG8_BAR; PG8_WAIT_L(0); PG8_MMA(0, 0, At, B0); PG8_BAR; PG8_SCHED;
            PG8_LDB(B1, 1, 1); PG8_STAGE(PG8_SB(1, 0), b3, voffB);
            PG8_BAR; PG8_WAIT_L(0); PG8_MMA(0, 1, At, B1); PG8_BAR;
            PG8_LDA(At, 1, 1); PG8_STAGE(PG8_SA(1, 0), a3, voffA);
            PG8_BAR; PG8_WAIT_L(0); PG8_MMA(1, 0, At, B0); PG8_BAR; PG8_SCHED;
            PG8_STAGE(PG8_SB(1, 1), b3 + hstepB, voffB);
            PG8_WAIT_V(6); PG8_BAR; PG8_MMA(1, 1, At, B1); PG8_BAR;
            }
        }
        if constexpr (ALIGN_EPI) { if (wr == 0) PG8_BAR; }
        if constexpr (!Epi::AFTER_DRAIN) { E(acc, cur, wr, wc, fr, fq); S.done(cur); }
        if (!has_next) break;
#pragma unroll
        for (int a = 0; a < 2; ++a)
#pragma unroll
            for (int b = 0; b < 2; ++b)
#pragma unroll
                for (int m = 0; m < 4; ++m)
#pragma unroll
                    for (int n = 0; n < 2; ++n) acc[a][b][m][n] = (f32x4){0.f, 0.f, 0.f, 0.f};
        cur = nxt; cA = nA; cB = nB; ++ui;
        if constexpr (ALIGN_EPI) { if (wr == 1) PG8_BAR; }
    }
    PG8_WAIT_V(0);
    if constexpr (!ALIGN_EPI) { if (wr == 0) PG8_BAR; }
    PG8_BAR;
    if constexpr (Epi::AFTER_DRAIN) { E.fused(acc, cur, wr, wc, fr, fq, lds, wid, lane); S.done(cur); }
#undef PG8_SA
#undef PG8_SB
#undef PG8_STAGE
#undef PG8_LDA
#undef PG8_LDB
#undef PG8_MMA
#undef PG8_WAIT_V
#undef PG8_WAIT_L
#undef PG8_BAR
#undef PG8_SCHED
}
}
#define XB_TMO      128
#define XB_XCNT(j)  (256  + 64 * (j))
#define XB_XSUB(j)  (1280 + 64 * (j))
#define XB_XGEN(j)  (2304 + 64 * (j))
#define XB_TOP      3328
#define XB_TOPGEN   3392
#define XCD_BAR_WORDS 3456
#define XB_SPIN_CAP (1u << 18)

__device__ __forceinline__ unsigned xb_ld(unsigned* p)              { return __hip_atomic_load(p, __ATOMIC_RELAXED, __HIP_MEMORY_SCOPE_AGENT); }
__device__ __forceinline__ unsigned xb_add(unsigned* p, unsigned v) { return __hip_atomic_fetch_add(p, v, __ATOMIC_RELAXED, __HIP_MEMORY_SCOPE_AGENT); }
__device__ __forceinline__ unsigned xb_xcc_id() { return (unsigned)__builtin_amdgcn_s_getreg((3 << 11) | 20) & 0xFu; }
#define XB_SPIN(cond, bar) do { unsigned _sp = 0; while (cond) { __builtin_amdgcn_s_sleep(1); \
    if ((++_sp & 255u) == 0u) { if (xb_ld(&(bar)[XB_TMO])) break; if (_sp > XB_SPIN_CAP) { atomicAdd(&(bar)[XB_TMO], 1u); break; } } } } while (0)

struct XcdBarrier {
    unsigned* bar; unsigned x;
    volatile LAS unsigned* st;
};

__device__ __forceinline__ XcdBarrier xcd_barrier_post(unsigned* bar, volatile LAS unsigned* st) {
    XcdBarrier b; b.bar = bar; b.x = xb_xcc_id(); b.st = st;
    if (threadIdx.x == 0) (void)xb_add(&bar[XB_XCNT(b.x)], 1u);
    return b;
}
__device__ __forceinline__ void xcd_barrier_complete(unsigned* bar, unsigned x, unsigned& nloc, unsigned& nx) {
    const unsigned G = gridDim.x * gridDim.y * gridDim.z;
    unsigned sum, cnt, mine, sp = 0u;
    for (;;) {
        sum = 0u; cnt = 0u; mine = 0u;
#pragma unroll
        for (unsigned j = 0; j < 16; ++j) { const unsigned c = xb_ld(&bar[XB_XCNT(j)]); sum += c; cnt += (c > 0u) ? 1u : 0u; mine = (j == x) ? c : mine; }
        if (sum == G) break;
        __builtin_amdgcn_s_sleep(1);
        if ((++sp & 255u) == 0u) { if (xb_ld(&bar[XB_TMO])) break; if (sp > XB_SPIN_CAP) { atomicAdd(&bar[XB_TMO], 1u); break; } }
    }
    nloc = mine > 0u ? mine : 1u; nx = cnt > 0u ? cnt : 1u;
}

__device__ __forceinline__ void xcd_barrier(const XcdBarrier& b) {
    asm volatile("s_waitcnt vmcnt(0)" ::: "memory");
    __syncthreads();
    if (threadIdx.x == 0) {
        unsigned* bar = b.bar;
        __builtin_amdgcn_s_waitcnt(0);
        unsigned nloc = b.st[0], nx = b.st[1];
        if (nloc == 0u) { xcd_barrier_complete(bar, b.x, nloc, nx); b.st[0] = nloc; b.st[1] = nx; }
        const unsigned old = xb_add(&bar[XB_XSUB(b.x)], 1u);
        const unsigned gen = old / nloc;
        if (old + 1u == (gen + 1u) * nloc) {
            __builtin_amdgcn_fence(__ATOMIC_RELEASE, "agent");
            asm volatile("s_waitcnt vmcnt(0)" ::: "memory");
            const unsigned og = xb_add(&bar[XB_TOP], 1u);
            const unsigned tg = og / nx;
            if (og + 1u == (tg + 1u) * nx) xb_add(&bar[XB_TOPGEN], 1u);
            else XB_SPIN(xb_ld(&bar[XB_TOPGEN]) == tg, bar);
            __builtin_amdgcn_fence(__ATOMIC_ACQUIRE, "agent");
            xb_add(&bar[XB_XGEN(b.x)], 1u);
            asm volatile("s_waitcnt vmcnt(0)" ::: "memory");
        } else {
            XB_SPIN(xb_ld(&bar[XB_XGEN(b.x)]) == gen, bar);
            __builtin_amdgcn_fence(__ATOMIC_ACQUIRE, "agent");
            asm volatile("s_waitcnt vmcnt(0)" ::: "memory");
        }
    }
    __syncthreads();
}
namespace att {
using bf16 = __hip_bfloat16;
constexpr int   D = 128, NW = 8, QBLK = 32, KVBLK = 64;
constexpr float SCALE = 0.088388347648318440f;
constexpr float THR = 8.f;
constexpr int SDEPTH = 1;
constexpr int LDQ = 1024, LDK = 512, LDO = 2048;
constexpr size_t SHM_V = KVBLK * D * 2, SHM_K = KVBLK * D * 2, SHM_ATTN = 2 * SHM_V + 2 * SHM_K + NW * 64 * 4;
using bf16x8 = __attribute__((ext_vector_type(8))) short;
using s16x4  = __attribute__((ext_vector_type(4))) short;
using f32x16 = __attribute__((ext_vector_type(16))) float;
using f32x8  = __attribute__((ext_vector_type(8))) float;
using u32x4  = __attribute__((ext_vector_type(4))) unsigned;
#define KSWZ(row, colB) ((row) * 256 + ((colB) ^ (((row) & 7) << 4)))
#define SBAR() __builtin_amdgcn_sched_barrier(0)
__device__ __forceinline__ int crow(int r, int hi) { return (r & 3) + 8 * (r >> 2) + 4 * hi; }
__device__ __forceinline__ unsigned cvtpk(float lo, float hi) {
  unsigned r; asm volatile("v_cvt_pk_bf16_f32 %0, %1, %2" : "=v"(r) : "v"(lo), "v"(hi)); return r;
}
template <typename TIn> struct Stage;
template <> struct Stage<bf16>  { using T = bf16x8;
  __device__ static __forceinline__ T ld8(const bf16* p) { return *reinterpret_cast<const bf16x8*>(p); }
  __device__ static __forceinline__ bf16x8 tobf(T x) { return x; } };
template <> struct Stage<float> { using T = f32x8;
  __device__ static __forceinline__ T ld8(const float* p) { return *reinterpret_cast<const f32x8*>(p); }
  __device__ static __forceinline__ bf16x8 tobf(T x) {
    u32x4 w = {cvtpk(x[0], x[1]), cvtpk(x[2], x[3]), cvtpk(x[4], x[5]), cvtpk(x[6], x[7])}; return *reinterpret_cast<bf16x8*>(&w); } };

__device__ __forceinline__ void partialSM(f32x16& p0, f32x16& p1, float mC) {
  constexpr float C = SCALE * 1.4426950408889634f;
  for (int r = 0; r < 16; ++r) p0[r] = fmaf(p0[r], C, mC); for (int r = 0; r < 16; ++r) p1[r] = fmaf(p1[r], C, mC);
  for (int r = 0; r < 16; ++r) p0[r] = __builtin_amdgcn_exp2f(p0[r]);
}
__device__ __forceinline__ void finishSM(f32x16& p0, f32x16& p1, float& l_reg, bf16x8& pa0, bf16x8& pa1, bf16x8& pa2, bf16x8& pa3) {
  for (int r = 0; r < 16; ++r) p1[r] = __builtin_amdgcn_exp2f(p1[r]);
  float ps = 0; for (int r = 0; r < 16; ++r) ps += p0[r]; for (int r = 0; r < 16; ++r) ps += p1[r];
  l_reg += ps;
#define PK4(P, BASE, OUT) do { unsigned a0 = cvtpk(P[BASE + 0], P[BASE + 1]), a1 = cvtpk(P[BASE + 2], P[BASE + 3]);   \
    unsigned b0 = cvtpk(P[BASE + 4], P[BASE + 5]), b1 = cvtpk(P[BASE + 6], P[BASE + 7]);                              \
    auto r0 = __builtin_amdgcn_permlane32_swap(a0, b0, false, false); auto r1 = __builtin_amdgcn_permlane32_swap(a1, b1, false, false); \
    u32x4 w = {r0[0], r1[0], r0[1], r1[1]}; OUT = *reinterpret_cast<bf16x8*>(&w); } while (0)
  PK4(p0, 0, pa0); PK4(p0, 8, pa1); PK4(p1, 0, pa2); PK4(p1, 8, pa3);
#undef PK4
}
__device__ __forceinline__ void qkt(f32x16& p0, f32x16& p1, const bf16* Ks, const bf16x8* qr, int r32, int hi) {
  p0 = f32x16{}; p1 = f32x16{};
  for (int d0 = 0; d0 < 8; ++d0) { int cb = (d0 * 16 + hi * 8) * 2;
    bf16x8 b0 = *reinterpret_cast<const bf16x8*>((const char*)Ks + KSWZ(r32, cb));
    bf16x8 b1 = *reinterpret_cast<const bf16x8*>((const char*)Ks + KSWZ(32 + r32, cb));
    p0 = __builtin_amdgcn_mfma_f32_32x32x16_bf16(b0, qr[d0], p0, 0, 0, 0);
    p1 = __builtin_amdgcn_mfma_f32_32x32x16_bf16(b1, qr[d0], p1, 0, 0, 0); }
}
__device__ __forceinline__ int v_st(int k, int c) { const int kk = (k & ~0xC) | ((k & 4) << 1) | ((k & 8) >> 1); return ((kk >> 3) * 4 + (c >> 5)) * 512 + ((kk & 7) * 32 + (c & 31)) * 2; }
__device__ __forceinline__ int v_rd_base(int lane) { return ((lane & 3) << 3) | (((lane >> 2) & 3) << 6) | (((lane >> 4) & 1) << 5) | (((lane >> 5) & 1) << 8); }
constexpr int v_rd_off(int d0, int ks, int half) { return d0 * 512 + ks * 4096 + half * 2048; }
template <int OFF> __device__ __forceinline__ s16x4 tr_read(int vb) {
  s16x4 r; asm volatile("ds_read_b64_tr_b16 %0, %1 offset:%2" : "=&v"(r) : "v"(vb), "i"(OFF) : "memory"); return r;
}
template <int D0> __device__ __forceinline__ void pv_one(f32x16& od, int vb, bf16x8 pa0, bf16x8 pa1, bf16x8 pa2, bf16x8 pa3) {
  const s16x4 l0 = tr_read<v_rd_off(D0, 0, 0)>(vb), h0 = tr_read<v_rd_off(D0, 0, 1)>(vb), l1 = tr_read<v_rd_off(D0, 1, 0)>(vb), h1 = tr_read<v_rd_off(D0, 1, 1)>(vb);
  const s16x4 l2 = tr_read<v_rd_off(D0, 2, 0)>(vb), h2 = tr_read<v_rd_off(D0, 2, 1)>(vb), l3 = tr_read<v_rd_off(D0, 3, 0)>(vb), h3 = tr_read<v_rd_off(D0, 3, 1)>(vb);
  asm volatile("s_waitcnt lgkmcnt(0)" ::: "memory"); SBAR();
#define PK(L, H) (bf16x8){L[0], L[1], L[2], L[3], H[0], H[1], H[2], H[3]}
  od = __builtin_amdgcn_mfma_f32_32x32x16_bf16(pa0, PK(l0, h0), od, 0, 0, 0);
  od = __builtin_amdgcn_mfma_f32_32x32x16_bf16(pa1, PK(l1, h1), od, 0, 0, 0);
  od = __builtin_amdgcn_mfma_f32_32x32x16_bf16(pa2, PK(l2, h2), od, 0, 0, 0);
  od = __builtin_amdgcn_mfma_f32_32x32x16_bf16(pa3, PK(l3, h3), od, 0, 0, 0);
#undef PK
}
__device__ __forceinline__ void pv_d0(f32x16* o, int vb, bf16x8 pa0, bf16x8 pa1, bf16x8 pa2, bf16x8 pa3) {
  pv_one<0>(o[0], vb, pa0, pa1, pa2, pa3); pv_one<1>(o[1], vb, pa0, pa1, pa2, pa3); pv_one<2>(o[2], vb, pa0, pa1, pa2, pa3); pv_one<3>(o[3], vb, pa0, pa1, pa2, pa3);
}

template <typename TQ>
__device__ __forceinline__ void attn_dense_body(const TQ* __restrict__ Qb, const bf16* __restrict__ Kh, const bf16* __restrict__ Vh,
                                                bf16* __restrict__ Ob, int seq, char* lds, float mC) {
  using St = Stage<bf16>; using SQ = Stage<TQ>;
  int tid_ = threadIdx.x; asm volatile("" : "+v"(tid_));
  const int tid = tid_, wid = tid >> 6, lane = tid & 63, r32 = lane & 31, hi = lane >> 5;
  bf16* V_lds = (bf16*)lds; bf16* K_lds = (bf16*)(lds + 2 * SHM_V);
  float* ws = (float*)(lds + 2 * SHM_V + 2 * SHM_K) + wid * 64; float* li_l = ws;
  float l_reg = 0; f32x16 o[4] = {}; bf16x8 qr[8];
  const TQ* Qw = Qb + (long)(wid * QBLK + r32) * LDQ + hi * 8;
#pragma unroll
  for (int d0 = 0; d0 < 8; ++d0) qr[d0] = SQ::tobf(SQ::ld8(Qw + d0 * 16));
  const int sr = tid >> 4, sc = (tid & 15) * 8, vst0 = v_st(sr, sc), vst1 = v_st(32 + sr, sc);
  const int vb0 = (int)(uintptr_t)V_lds + v_rd_base(lane);
  struct { typename St::T vs0, vs1, ks0, ks1; } sr_[SDEPTH];
#define SLOAD(i, k0) do { sr_[i].vs0 = St::ld8(&Vh[(long)((k0) + sr) * LDK + sc]); sr_[i].vs1 = St::ld8(&Vh[(long)((k0) + 32 + sr) * LDK + sc]); \
    sr_[i].ks0 = St::ld8(&Kh[(long)((k0) + sr) * LDK + sc]); sr_[i].ks1 = St::ld8(&Kh[(long)((k0) + 32 + sr) * LDK + sc]); } while (0)
#define SWRITE(b, i) do { *(bf16x8*)((char*)V_lds + (b) * SHM_V + vst0) = St::tobf(sr_[i].vs0);          \
    *(bf16x8*)((char*)V_lds + (b) * SHM_V + vst1) = St::tobf(sr_[i].vs1); int kc = sc * 2;               \
    *(bf16x8*)((char*)K_lds + (b) * SHM_K + KSWZ(sr, kc)) = St::tobf(sr_[i].ks0);                       \
    *(bf16x8*)((char*)K_lds + (b) * SHM_K + KSWZ(32 + sr, kc)) = St::tobf(sr_[i].ks1); } while (0)
#define SWAIT() do { if constexpr (SDEPTH == 2) asm volatile("s_waitcnt vmcnt(4)" ::: "memory"); else asm volatile("s_waitcnt vmcnt(0)" ::: "memory"); } while (0)
  f32x16 pA0, pA1, pB0, pB1; bf16x8 pa0, pa1, pa2, pa3; const int NT = seq / KVBLK;
  constexpr int SE = 0, SO = SDEPTH - 1;
  SLOAD(SE, 0); asm volatile("s_waitcnt vmcnt(0)" ::: "memory"); SWRITE(0, SE); __syncthreads();
  qkt(pA0, pA1, K_lds, qr, r32, hi); partialSM(pA0, pA1, mC);
  SLOAD(SO, KVBLK); if constexpr (SDEPTH == 2) { if (2 < NT) SLOAD(SE, 2 * KVBLK); }
  SWAIT(); SWRITE(1, SO); __syncthreads();
  for (int j = 1; j + 1 < NT; j += 2) {
    SBAR(); qkt(pB0, pB1, (bf16*)((char*)K_lds + SHM_K), qr, r32, hi);
    finishSM(pA0, pA1, l_reg, pa0, pa1, pa2, pa3); SBAR();
    SLOAD(SO, (j + SDEPTH) * KVBLK); SBAR();
    pv_d0(o, vb0, pa0, pa1, pa2, pa3); partialSM(pB0, pB1, mC);
    __syncthreads(); SWAIT(); SWRITE(0, SE);
    __syncthreads();
    SBAR(); qkt(pA0, pA1, K_lds, qr, r32, hi);
    finishSM(pB0, pB1, l_reg, pa0, pa1, pa2, pa3); SBAR();
    if (SDEPTH == 1 || j + 3 < NT) SLOAD(SE, (j + 1 + SDEPTH) * KVBLK); SBAR();
    pv_d0(o, vb0 + (int)SHM_V, pa0, pa1, pa2, pa3); partialSM(pA0, pA1, mC);
    __syncthreads(); SWAIT(); SWRITE(1, SO);
    __syncthreads();
  }
  SBAR(); qkt(pB0, pB1, (bf16*)((char*)K_lds + SHM_K), qr, r32, hi);
  finishSM(pA0, pA1, l_reg, pa0, pa1, pa2, pa3); SBAR();
  pv_d0(o, vb0, pa0, pa1, pa2, pa3); partialSM(pB0, pB1, mC);
  __syncthreads();
  finishSM(pB0, pB1, l_reg, pa0, pa1, pa2, pa3); SBAR();
  pv_d0(o, vb0 + (int)SHM_V, pa0, pa1, pa2, pa3);
  { auto rr = __builtin_amdgcn_permlane32_swap(__float_as_uint(l_reg), __float_as_uint(l_reg), false, false); l_reg = __uint_as_float(rr[0]) + __uint_as_float(rr[1]); }
  if (hi == 0) li_l[r32] = l_reg; asm volatile("s_waitcnt lgkmcnt(0)" ::: "memory");
  float rli[16];
#pragma unroll
  for (int r = 0; r < 16; ++r) rli[r] = __builtin_amdgcn_rcpf(li_l[crow(r, hi)]);
  bf16* Ow = Ob + (long)(wid * QBLK) * LDO;
#pragma unroll
  for (int r = 0; r < 16; ++r) { int orow = crow(r, hi);
    for (int d0 = 0; d0 < 4; ++d0) Ow[(long)orow * LDO + d0 * 32 + r32] = __float2bfloat16(o[d0][r] * rli[r]); }
  __syncthreads();
#undef SLOAD
#undef SWRITE
#undef SWAIT
}
#undef KSWZ
#undef SBAR
}

struct Frame {
    LAS unsigned char* lds;
    char* ldsg;
    int tid, lane, wave, vcu, G;
    unsigned char* ws;
};
__device__ __forceinline__ const float* frame_in(const Frame& F, int i) {
    const LAS unsigned* p = (const LAS unsigned*)(F.lds + LDSCTL_OFF + 64) + 2 * i;
    const unsigned lo = __builtin_amdgcn_readfirstlane(p[0]), hi = __builtin_amdgcn_readfirstlane(p[1]);
    return (const float*)(const GAS float*)(((unsigned long long)hi << 32) | lo);
}
#define FIN(i) frame_in(F, (i))
#define FOUT() ((float*)frame_in(F, 17))
#define WSP(T, off) ((T*)(F.ws + (off)))

__device__ __forceinline__ void p0_transpose_item(const float* W, int K, int N, int Npad, bf16_t* WT, int row_off, LAS float* scr, int item, int lane, const float* kscale = nullptr) {
    const int nblk = Npad / 32, kb = item / nblk, nb = item % nblk, k0 = 64 * kb, n0 = 32 * nb;
    const int nn = n0 + 4 * (lane & 7);
    f32x4 v[8];
#pragma unroll
    for (int i = 0; i < 8; ++i) { const int kk = 8 * i + (lane >> 3); v[i] = nn < N ? *(const f32x4*)(W + (size_t)(k0 + kk) * N + nn) : (f32x4){0.f, 0.f, 0.f, 0.f}; }
#pragma unroll
    for (int i = 0; i < 8; ++i) { const int kk = 8 * i + (lane >> 3); *(LAS f32x4*)(scr + kk * 36 + 4 * (lane & 7)) = v[i]; }
    LDS_WAIT(); asm volatile("" ::: "memory");
    const int c = lane & 7;
    f32x4 ka = {1.f, 1.f, 1.f, 1.f}, kc = ka; if (kscale) { ka = *(const f32x4*)(kscale + k0 + 8 * c); kc = *(const f32x4*)(kscale + k0 + 8 * c + 4); }
#pragma unroll
    for (int j = 0; j < 4; ++j) { const int n = (lane >> 3) + 8 * j; const LAS float* s = scr + (8 * c) * 36 + n;
        u32x4 o; o.x = pk2(s[0 * 36] * ka.x, s[1 * 36] * ka.y); o.y = pk2(s[2 * 36] * ka.z, s[3 * 36] * ka.w); o.z = pk2(s[4 * 36] * kc.x, s[5 * 36] * kc.y); o.w = pk2(s[6 * 36] * kc.z, s[7 * 36] * kc.w);
        *(GAS u32x4*)(WT + (size_t)(row_off + n0 + n) * K + k0 + 8 * c) = o; }
    LDS_WAIT(); asm volatile("" ::: "memory");
}
__device__ __forceinline__ u32x4 cvt8(const float* p) {
    const f32x4 a = *(const f32x4*)p, b = *(const f32x4*)(p + 4);
    u32x4 o; o.x = pk2(a.x, a.y); o.y = pk2(a.z, a.w); o.z = pk2(b.x, b.y); o.w = pk2(b.z, b.w); return o;
}
__device__ __forceinline__ void rms_row_to_bf16(const float* xrow, const float* g, bf16_t* orow, int lane) {
    const f32x4* xr = (const f32x4*)xrow + lane;
    f32x4 v[8]; float s = 0.f;
#pragma unroll
    for (int j = 0; j < 8; ++j) { v[j] = xr[64 * j]; s += (v[j].x * v[j].x + v[j].y * v[j].y) + (v[j].z * v[j].z + v[j].w * v[j].w); }
    const float r = 1.0f / sqrtf(wave_sum(s) * (1.f / DM) + EPS);
    u32x2* o8 = (u32x2*)orow + lane;
#pragma unroll
    for (int j = 0; j < 8; ++j) { const f32x4 gg = ((const f32x4*)g)[lane + 64 * j]; u32x2 w; w.x = pk2(v[j].x * r * gg.x, v[j].y * r * gg.y); w.y = pk2(v[j].z * r * gg.z, v[j].w * r * gg.w); o8[64 * j] = w; }
}
__device__ __forceinline__ void ph_prologue(const Frame& F) {
    LAS float* scr = (LAS float*)(F.lds + F.wave * 16384);
    const int gw = F.vcu * NWAVES + F.wave, NGW = F.G * NWAVES;
#if TBL_FP4
    const float* gff = FIN(2) + F.lane * 4; const float* tsrc0 = FIN(14) + F.lane * 4; const float* tsrc1 = FIN(15) + F.lane * 4;
    for (int row = gw; row < 4 * 16384; row += NGW) {
        const int tb = row >> 15, rr = row & 32767;
        const float* src = (tb ? tsrc1 : tsrc0) + (size_t)rr * DM;
        f32x4 v[8]; float am = 0.f;
#pragma unroll
        for (int q = 0; q < 8; ++q) v[q] = *(const f32x4*)(src + 256 * q);
        if (tb == 0) {
#pragma unroll
            for (int q = 0; q < 8; ++q) v[q] = v[q] * *(const f32x4*)(gff + (rr >> 14) * DM + 256 * q); }
#pragma unroll
        for (int q = 0; q < 8; ++q) am = fmaxf(am, fmaxf(fmaxf(fabsf(v[q].x), fabsf(v[q].y)), fmaxf(fabsf(v[q].z), fabsf(v[q].w))));
#pragma unroll
        for (int o = 1; o < 64; o <<= 1) am = fmaxf(am, __shfl_xor(am, o));
        unsigned char* dst = F.ws + (tb ? WS_VB : WS_UB) + (size_t)(rr >> 14) * (16384 * 1024) + (size_t)(rr & 16383) * 128 + F.lane * 2;
        float sc;
        if (tb == 0) {
            float sq = 0.f;
#pragma unroll
            for (int q = 0; q < 8; ++q) sq += (v[q].x * v[q].x + v[q].y * v[q].y) + (v[q].z * v[q].z + v[q].w * v[q].w);
            sq = wave_sum(sq); sc = sq > 0.f ? 0.36f * sqrtf(sq * (1.f / DM)) : 1.f; const float isc = 1.0f / sc;
#pragma unroll
            for (int q = 0; q < 8; ++q) { const f32x4 z = v[q] * isc; int n[4];
#pragma unroll
                for (int e = 0; e < 4; ++e) n[e] = (int)fminf(fmaxf(rintf(z[e]), -7.f), 7.f) & 15;
                *(unsigned short*)(dst + (size_t)q * (16384 * 128)) = (unsigned short)(n[0] | (n[1] << 4) | (n[2] << 8) | (n[3] << 12)); }
        } else {
            sc = am > 0.f ? am * (1.f / 6.f) : 1.f; const float isc = 1.0f / sc;
#pragma unroll
            for (int q = 0; q < 8; ++q) { unsigned p = 0u;
                p = __builtin_amdgcn_cvt_scalef32_pk_fp4_f32(p, v[q].x * isc, v[q].y * isc, 1.0f, 0); p = __builtin_amdgcn_cvt_scalef32_pk_fp4_f32(p, v[q].z * isc, v[q].w * isc, 1.0f, 1);
                *(unsigned short*)(dst + (size_t)q * (16384 * 128)) = (unsigned short)p; }
        }
        if (F.lane == 0) ((float*)(F.ws + WS_TSC))[row] = sc;
    }
#else
    for (int row = gw; row < 4 * 16384; row += NGW) {
        const int tb = row >> 15, rr = row & 32767;
        const float* src = FIN(14 + tb) + (size_t)rr * DM + F.lane * 16;
        f32x4 v[8]; float am = 0.f;
#pragma unroll
        for (int q = 0; q < 8; ++q) { v[q] = *(const f32x4*)(src + (q >> 2) * 1024 + (q & 3) * 4);
            am = fmaxf(am, fmaxf(fmaxf(fabsf(v[q].x), fabsf(v[q].y)), fmaxf(fabsf(v[q].z), fabsf(v[q].w)))); }
#pragma unroll
        for (int o = 1; o < 64; o <<= 1) am = fmaxf(am, __shfl_xor(am, o));
        const float sc = am > 0.f ? am * (1.f / 448.f) : 1.f, isc = 1.0f / sc;
        unsigned w[8];
#pragma unroll
        for (int q = 0; q < 8; ++q) { unsigned p = __builtin_amdgcn_cvt_pk_fp8_f32(v[q].x * isc, v[q].y * isc, 0u, false); w[q] = __builtin_amdgcn_cvt_pk_fp8_f32(v[q].z * isc, v[q].w * isc, p, true); }
        unsigned char* dst = F.ws + (tb ? WS_VB : WS_UB) + (size_t)(rr >> 14) * (16384 * 2048) + ((size_t)(F.lane >> 3) * 16384 + (rr & 16383)) * 128 + (F.lane & 7) * 16;
        *(u32x4*)dst = (u32x4){w[0], w[1], w[2], w[3]}; *(u32x4*)(dst + (size_t)8 * 16384 * 128) = (u32x4){w[4], w[5], w[6], w[7]};
        if (F.lane == 0) ((float*)(F.ws + WS_TSC))[row] = sc;
    }
#endif
    {   constexpr int I_IN = (DM / 64) * (INP / 32), I_SQ = (DM / 64) * (DM / 32), I_PL = 4 * (512 / 64) * (512 / 32);
        constexpr int NIT = I_IN + 3 * I_SQ + I_PL;
        for (int it = gw; it < NIT; it += NGW) {
            int r = it;
            if (r < I_IN) { p0_transpose_item(FIN(3), DM, INW, INP, WSP(bf16_t, WS_WIN), 0, scr, r, F.lane); continue; } r -= I_IN;
            if (r < I_SQ) { p0_transpose_item(FIN(9), DM, DM, DM, WSP(bf16_t, WS_WOUT), 0, scr, r, F.lane); continue; } r -= I_SQ;
            if (r < I_SQ) { p0_transpose_item(FIN(12), DM, DM, DM, WSP(bf16_t, WS_WQ0), 0, scr, r, F.lane, FIN(2)); continue; } r -= I_SQ;
            if (r < I_SQ) { p0_transpose_item(FIN(12) + (size_t)DM * DM, DM, DM, DM, WSP(bf16_t, WS_WQ1), 0, scr, r, F.lane, FIN(2) + DM); continue; } r -= I_SQ;
            const int grp = r / 128, ri = r % 128;
            p0_transpose_item(FIN(10) + (size_t)grp * 512 * 512, 512, 512, 512, WSP(bf16_t, WS_WPOOL), grp * 512, scr, ri, F.lane);
        }
    }
    for (int it = gw; it < 1024; it += NGW) *(u32x4*)(WSP(bf16_t, WS_KEYS) + (size_t)it * 512 + F.lane * 8) = cvt8(FIN(13) + (size_t)it * 512 + F.lane * 8);
    {   const float* x0 = FIN(0); const float* g0 = FIN(1);
        for (int m = gw; m < S; m += 2 * NGW) {
            const int lane = F.lane; f32x4 v[2][8]; float s[2] = {0.f, 0.f};
#pragma unroll
            for (int z = 0; z < 2; ++z)
#pragma unroll
                for (int j = 0; j < 8; ++j) v[z][j] = ((const f32x4*)(x0 + (size_t)(m + z * NGW) * DM))[lane + 64 * j];
#pragma unroll
            for (int z = 0; z < 2; ++z)
#pragma unroll
                for (int j = 0; j < 8; ++j) s[z] += (v[z][j].x * v[z][j].x + v[z][j].y * v[z][j].y) + (v[z][j].z * v[z][j].z + v[z][j].w * v[z][j].w);
#pragma unroll
            for (int z = 0; z < 2; ++z) { const float r = 1.0f / sqrtf(wave_sum(s[z]) * (1.f / DM) + EPS); u32x2* o8 = (u32x2*)(WSP(bf16_t, WS_XN) + (size_t)(m + z * NGW) * DM) + lane;
#pragma unroll
                for (int j = 0; j < 8; ++j) { const f32x4 gg = ((const f32x4*)g0)[lane + 64 * j]; u32x2 w; w.x = pk2(v[z][j].x * r * gg.x, v[z][j].y * r * gg.y); w.y = pk2(v[z][j].z * r * gg.z, v[z][j].w * r * gg.w); o8[64 * j] = w; } }
        }
    }
}

__device__ __forceinline__ float silu_f(float z) { return z / (1.f + __expf(-z)); }
__device__ __forceinline__ void p2_qkv_token(const Frame& F, int t) {
    const int lane = F.lane, i8 = lane & 7;
    const bf16_t* pr = WSP(bf16_t, WS_PROJ) + (size_t)t * INP;
    const int axis = i8 >> 2, half = (i8 >> 1) & 1, f0 = (i8 & 1) * 16;
    const float pos = (float)(axis == 0 ? (t >> 6) : (t & 63));
    float cs[16], sn[16];
#pragma unroll
    for (int e = 0; e < 16; ++e) { const float inv = exp2f(-(float)(f0 + e) * (13.287712379549449f / 32.f));
        float rev = pos * inv * 0.15915494309189535f; rev -= rintf(rev);
        cs[e] = __builtin_amdgcn_cosf(rev); sn[e] = __builtin_amdgcn_sinf(rev); }
    const float sgn = half ? 1.f : -1.f;
    {   const u32x4 w0 = *(const u32x4*)(pr + C_AQ + lane * 16), w1 = *(const u32x4*)(pr + C_AQ + lane * 16 + 8);
        float v[16]; const unsigned ww[8] = {w0.x, w0.y, w0.z, w0.w, w1.x, w1.y, w1.z, w1.w};
#pragma unroll
        for (int e = 0; e < 8; ++e) { v[2 * e] = bflo(ww[e]); v[2 * e + 1] = bfhi(ww[e]); }
        float ss = 0.f;
#pragma unroll
        for (int e = 0; e < 16; ++e) ss += v[e] * v[e];
        ss += __shfl_xor(ss, 1); ss += __shfl_xor(ss, 2); ss += __shfl_xor(ss, 4);
        const float r = 1.0f / sqrtf(ss * (1.f / 128.f) + EPS);
        const float* gq = FIN(6) + i8 * 16;
        unsigned ow[8];
        float y[16];
#pragma unroll
        for (int e = 0; e < 16; ++e) y[e] = v[e] * r * gq[e];
#pragma unroll
        for (int e = 0; e < 16; ++e) { const float yp = __shfl_xor(y[e], 2); y[e] = y[e] * cs[e] + sgn * yp * sn[e]; }
#pragma unroll
        for (int e = 0; e < 8; ++e) ow[e] = pk2(y[2 * e], y[2 * e + 1]);
        bf16_t* dst = WSP(bf16_t, WS_QB) + (size_t)t * 1024 + lane * 16;
        *(u32x4*)dst = (u32x4){ow[0], ow[1], ow[2], ow[3]}; *(u32x4*)(dst + 8) = (u32x4){ow[4], ow[5], ow[6], ow[7]};
    }
    {   const int l16 = lane & 15;
        const u32x4 w0 = *(const u32x4*)(pr + C_AK + l16 * 16), w1 = *(const u32x4*)(pr + C_AK + l16 * 16 + 8);
        float v[16]; const unsigned ww[8] = {w0.x, w0.y, w0.z, w0.w, w1.x, w1.y, w1.z, w1.w};
#pragma unroll
        for (int e = 0; e < 8; ++e) { v[2 * e] = bflo(ww[e]); v[2 * e + 1] = bfhi(ww[e]); }
        float ss = 0.f;
#pragma unroll
        for (int e = 0; e < 16; ++e) ss += v[e] * v[e];
        ss += __shfl_xor(ss, 1); ss += __shfl_xor(ss, 2); ss += __shfl_xor(ss, 4);
        const float r = 1.0f / sqrtf(ss * (1.f / 128.f) + EPS);
        const float* gk = FIN(7) + i8 * 16;
        float y[16]; unsigned ow[8];
#pragma unroll
        for (int e = 0; e < 16; ++e) y[e] = v[e] * r * gk[e];
#pragma unroll
        for (int e = 0; e < 16; ++e) { const float yp = __shfl_xor(y[e], 2); y[e] = y[e] * cs[e] + sgn * yp * sn[e]; }
#pragma unroll
        for (int e = 0; e < 8; ++e) ow[e] = pk2(y[2 * e], y[2 * e + 1]);
        bf16_t* kv = WSP(bf16_t, WS_KVB) + (size_t)t * 512;
        if (lane < 16) { *(u32x4*)(kv + lane * 16) = (u32x4){ow[0], ow[1], ow[2], ow[3]}; *(u32x4*)(kv + lane * 16 + 8) = (u32x4){ow[4], ow[5], ow[6], ow[7]}; }
        else if (lane < 32) { const u32x4 a = *(const u32x4*)(pr + C_AV + l16 * 16), b = *(const u32x4*)(pr + C_AV + l16 * 16 + 8);
            *(u32x4*)(kv + 256 + l16 * 16) = a; *(u32x4*)(kv + 256 + l16 * 16 + 8) = b; }
    }
}
__device__ __forceinline__ void p2_conv_item(const Frame& F, int item) {
    const int tb = item >> 2, sl = item & 3, lane = F.lane, c = sl * 512 + lane * 8, t0 = tb * 16;
    float w[5][8];
#pragma unroll
    for (int j = 0; j < 5; ++j) { const f32x4 a = *(const f32x4*)(FIN(5) + j * 2048 + c), b = *(const f32x4*)(FIN(5) + j * 2048 + c + 4);
        w[j][0] = a.x; w[j][1] = a.y; w[j][2] = a.z; w[j][3] = a.w; w[j][4] = b.x; w[j][5] = b.y; w[j][6] = b.z; w[j][7] = b.w; }
    const bf16_t* src = WSP(bf16_t, WS_PROJ) + C_MQK + c;
    const float osc = (c >= 1024) ? 0.0625f : 1.f;
    bf16_t* dst = (c >= 1024) ? WSP(bf16_t, WS_MK) + (c - 1024) : WSP(bf16_t, WS_MQ) + c;
    u32x4 rows[20];
#pragma unroll
    for (int j = 0; j < 20; ++j) { const int tt = t0 - 2 + j; rows[j] = (tt >= 0 && tt < S) ? *(const u32x4*)(src + (size_t)tt * INP) : (u32x4){0u, 0u, 0u, 0u}; }
#pragma unroll
    for (int q = 0; q < 16; ++q) {
        float acc[8];
#pragma unroll
        for (int e = 0; e < 8; ++e) acc[e] = 0.f;
#pragma unroll
        for (int j = 0; j < 5; ++j) { const unsigned ww[4] = {rows[q + j].x, rows[q + j].y, rows[q + j].z, rows[q + j].w};
#pragma unroll
            for (int e = 0; e < 4; ++e) { acc[2 * e] += bflo(ww[e]) * w[j][2 * e]; acc[2 * e + 1] += bfhi(ww[e]) * w[j][2 * e + 1]; } }
        u32x4 o; o.x = pk2(silu_f(acc[0]) * osc, silu_f(acc[1]) * osc); o.y = pk2(silu_f(acc[2]) * osc, silu_f(acc[3]) * osc);
        o.z = pk2(silu_f(acc[4]) * osc, silu_f(acc[5]) * osc); o.w = pk2(silu_f(acc[6]) * osc, silu_f(acc[7]) * osc);
        *(u32x4*)(dst + (size_t)(t0 + q) * 1024) = o;
    }
}
__device__ __forceinline__ float wave_incl_scan_add(float v, int lane) {
#pragma unroll
    for (int o = 1; o < 64; o <<= 1) { const float u = __shfl_up(v, o); if (lane >= o) v += u; }
    return v;
}
__device__ __forceinline__ float wave_incl_scan_max(float v, int lane) {
#pragma unroll
    for (int o = 1; o < 64; o <<= 1) { const float u = __shfl_up(v, o); if (lane >= o) v = fmaxf(v, u); }
    return v;
}
__device__ __forceinline__ float logsigmoid_f(float x) { return fminf(x, 0.f) - log1pf(__expf(-fabsf(x))); }
__device__ __forceinline__ void p2_gate_item(const Frame& F, int item) {
    const int dh = item >> 7, c = item & 127, dir = dh >> 2, h = dh & 3, lane = F.lane;
    const int p0 = 128 * c + 2 * lane, t0 = dir ? (S - 1 - p0) : p0, t1 = dir ? (t0 - 1) : (t0 + 1);
    const bf16_t* pg = WSP(bf16_t, WS_PROJ) + C_GATE + dir * 8 + h;
    const float bi = FIN(4)[dir * 8 + h], bf = FIN(4)[dir * 8 + 4 + h];
    const float i0 = bflo((unsigned)pg[(size_t)t0 * INP]) + bi, f0 = bflo((unsigned)pg[(size_t)t0 * INP + 4]) + bf;
    const float i1 = bflo((unsigned)pg[(size_t)t1 * INP]) + bi, f1 = bflo((unsigned)pg[(size_t)t1 * INP + 4]) + bf;
    const float lf0 = logsigmoid_f(f0), lf1 = logsigmoid_f(f1);
    const float incl = wave_incl_scan_add(lf0 + lf1, lane);
    const float b1 = incl, b0 = incl - lf1;
    const float u0 = i0 - b0, u1 = i1 - b1;
    const float mincl = wave_incl_scan_max(fmaxf(u0, u1), lane);
    float mprevl = __shfl_up(mincl, 1); if (lane == 0) mprevl = -INFINITY;
    const float pm0 = fmaxf(mprevl, u0), pm1 = mincl;
    float* GB = (float*)(F.ws + WS_GATES + GO_B) + (size_t)dh * S; float* GU = (float*)(F.ws + WS_GATES + GO_U) + (size_t)dh * S; float* GPM = (float*)(F.ws + WS_GATES + GO_PM) + (size_t)dh * S;
    GB[t0] = b0; GB[t1] = b1; GU[t0] = u0; GU[t1] = u1; GPM[t0] = pm0; GPM[t1] = pm1;
    if (lane == 63) { ((float*)(F.ws + WS_GATES + GO_G))[dh * 128 + c] = b1; ((float*)(F.ws + WS_GATES + GO_PML))[dh * 128 + c] = pm1; }
}
__device__ __forceinline__ void ph_post(const Frame& F) {
    const int gw = F.vcu * NWAVES + F.wave, NGW = F.G * NWAVES;
    for (int it = gw; it < 1024; it += NGW) p2_gate_item(F, it);
    for (int it = gw; it < 4096; it += NGW) p2_conv_item(F, it);
    for (int t = gw; t < S; t += NGW) p2_qkv_token(F, t);
}

#define MFMA16(a, b, c) __builtin_amdgcn_mfma_f32_16x16x32_bf16((a), (b), (c), 0, 0, 0)
__device__ __forceinline__ bf16x8 frag_tr(LAS const unsigned char* base, int pitch, int k0, int x0, int lane) {
    const int g = lane >> 4, i = lane & 15;
    LAS const unsigned char* p = base + (k0 + 8 * g + (i >> 2)) * pitch + (x0 + 4 * (i & 3)) * 2;
    const s16x4 lo = __builtin_bit_cast(s16x4, __builtin_amdgcn_ds_read_tr16_b64_v4i16((LAS v4i16_t*)p));
    const s16x4 hi = __builtin_bit_cast(s16x4, __builtin_amdgcn_ds_read_tr16_b64_v4i16((LAS v4i16_t*)(p + 4 * pitch)));
    return (bf16x8){lo[0], lo[1], lo[2], lo[3], hi[0], hi[1], hi[2], hi[3]};
}
__device__ __forceinline__ bf16x8 frag_kc(LAS const unsigned char* base, int pitch, int x0, int k0, int lane) {
    return *(LAS const bf16x8*)(base + (x0 + (lane & 15)) * pitch + (k0 + 8 * (lane >> 4)) * 2);
}

constexpr int MLA_PK = 544, MLA_PV = 288;
constexpr int MLA_OFF_V = 128 * MLA_PK;
__device__ __forceinline__ void ph_mla(const Frame& F) {
    const int tid = F.tid, lane = F.lane, wave = F.wave;
    LAS unsigned char* Kw = F.lds; LAS unsigned char* Vs = F.lds + MLA_OFF_V;
    const float* GU = (const float*)(F.ws + WS_GATES + GO_U); const float* GPML = (const float*)(F.ws + WS_GATES + GO_PML);
    for (int item = F.vcu; item < 2048; item += F.G) {
        const int hv = item & 1, c = (item >> 1) & 127, dh = item >> 8, dir = dh >> 2, head = dh & 3;
        const int tc = dir ? 127 - c : c, t0 = tc * 128;
        const float pml = GPML[dh * 128 + c];
        {   const bf16_t* mk = WSP(bf16_t, WS_MK) + (size_t)t0 * 1024 + head * 256;
#pragma unroll
            for (int j = 0; j < 8; ++j) { const int r = (tid >> 5) + 16 * j, c8 = (tid & 31) * 8;
                const u32x4 x = *(const u32x4*)(mk + (size_t)r * 1024 + c8); const float w = __expf(GU[(size_t)dh * S + t0 + r] - pml);
                u32x4 o; o.x = pk2(bflo(x.x) * w, bfhi(x.x) * w); o.y = pk2(bflo(x.y) * w, bfhi(x.y) * w); o.z = pk2(bflo(x.z) * w, bfhi(x.z) * w); o.w = pk2(bflo(x.w) * w, bfhi(x.w) * w);
                *(LAS u32x4*)(Kw + r * MLA_PK + c8 * 2) = o; }
            const bf16_t* mv = WSP(bf16_t, WS_PROJ) + (size_t)t0 * INP + C_MV + head * 256 + hv * 128;
#pragma unroll
            for (int j = 0; j < 4; ++j) { const int r = (tid >> 4) + 32 * j, c8 = (tid & 15) * 8;
                *(LAS u32x4*)(Vs + r * MLA_PV + c8 * 2) = *(const u32x4*)(mv + (size_t)r * INP + c8); }
        }
        __syncthreads();
        f32x4 acc[4][4];
#pragma unroll
        for (int a = 0; a < 4; ++a)
#pragma unroll
            for (int b = 0; b < 4; ++b) acc[a][b] = (f32x4){0.f, 0.f, 0.f, 0.f};
        const int mb = (wave & 3) * 64, nb = (wave >> 2) * 64;
#pragma unroll
        for (int ks = 0; ks < 4; ++ks) {
            bf16x8 af[4], bfr[4];
#pragma unroll
            for (int a = 0; a < 4; ++a) af[a] = frag_tr(Kw, MLA_PK, 32 * ks, mb + 16 * a, lane);
#pragma unroll
            for (int b = 0; b < 4; ++b) bfr[b] = frag_tr(Vs, MLA_PV, 32 * ks, nb + 16 * b, lane);
#pragma unroll
            for (int a = 0; a < 4; ++a)
#pragma unroll
                for (int b = 0; b < 4; ++b) acc[a][b] = MFMA16(af[a], bfr[b], acc[a][b]);
        }
        {   bf16_t* cst = WSP(bf16_t, WS_CST) + ((size_t)(dh * 128 + c) << 16);
            const int g = lane >> 4, i = lane & 15;
#pragma unroll
            for (int a = 0; a < 4; ++a)
#pragma unroll
                for (int b = 0; b < 4; ++b) { u32x2 o; o.x = pk2(acc[a][b][0], acc[a][b][1]); o.y = pk2(acc[a][b][2], acc[a][b][3]);
                    *(u32x2*)(cst + (size_t)(hv * 128 + nb + 16 * b + i) * 256 + mb + 16 * a + 4 * g) = o; }
        }
        if (hv == 0 && tid < 256) { float s = 0.f;
#pragma unroll 8
            for (int r = 0; r < 128; ++r) s += bflo((unsigned)*(LAS const bf16_t*)(Kw + r * MLA_PK + tid * 2));
            ((float*)(F.ws + WS_NST))[(size_t)(dh * 128 + c) * 256 + tid] = s; }
        __syncthreads();
    }
}

__device__ __forceinline__ void ph_scan(const Frame& F) {
    const float* GG = (const float*)(F.ws + WS_GATES + GO_G); const float* GPML = (const float*)(F.ws + WS_GATES + GO_PML); float* MPREV = (float*)(F.ws + WS_GATES + GO_MPREV);
    const int nthreads = F.G * NTHR;
    for (int gi = F.vcu * NTHR + F.tid; gi < 8 * 16384; gi += nthreads) {
        const int dh = gi >> 14, e4 = gi & 16383;
        bf16_t* base = WSP(bf16_t, WS_CST) + ((size_t)dh * 128 << 16) + e4 * 4;
        float st0 = 0.f, st1 = 0.f, st2 = 0.f, st3 = 0.f, m = 0.f;
#pragma unroll 1
        for (int c0 = 0; c0 < 128; c0 += 32) {
            u32x2 ld[32];
#pragma unroll
            for (int q = 0; q < 32; ++q) ld[q] = *(const u32x2*)(base + ((size_t)(c0 + q) << 16));
#pragma unroll
            for (int q = 0; q < 32; ++q) { const int c = c0 + q;
                const float g = GG[dh * 128 + c], amax = g + GPML[dh * 128 + c];
                const float mn = fmaxf(g + m, amax), dec = __expf(g + m - mn), add = __expf(amax - mn);
                if (e4 == 0) MPREV[dh * 128 + c] = m;
                u32x2 o; o.x = pk2(st0, st1); o.y = pk2(st2, st3);
                *(u32x2*)(base + ((size_t)c << 16)) = o;
                st0 = dec * st0 + add * bflo(ld[q].x); st1 = dec * st1 + add * bfhi(ld[q].x); st2 = dec * st2 + add * bflo(ld[q].y); st3 = dec * st3 + add * bfhi(ld[q].y);
                m = mn; }
        }
    }
    for (int gi = F.vcu * NTHR + F.tid; gi < 8 * 256; gi += nthreads) {
        const int dh = gi >> 8, e = gi & 255;
        float* base = (float*)(F.ws + WS_NST) + (size_t)dh * 128 * 256 + e;
        float st = 0.f, m = 0.f;
#pragma unroll 1
        for (int c0 = 0; c0 < 128; c0 += 32) {
            float ld[32];
#pragma unroll
            for (int q = 0; q < 32; ++q) ld[q] = base[(c0 + q) * 256];
#pragma unroll
            for (int q = 0; q < 32; ++q) { const int c = c0 + q;
                const float g = GG[dh * 128 + c], amax = g + GPML[dh * 128 + c];
                const float mn = fmaxf(g + m, amax), dec = __expf(g + m - mn), add = __expf(amax - mn);
                base[c * 256] = st; st = dec * st + add * ld[q]; m = mn; }
        }
    }
}

constexpr int MLB_PIECE = 34816;
constexpr int MLB_PKC = 528, MLB_PTR = 544, MLB_PP = 272;
constexpr int MLB_OFF_P = 2 * MLB_PIECE;
constexpr int MLB_OFF_N = MLB_OFF_P + 2 * 8 * 16 * MLB_PP;
static_assert(MLB_OFF_N + 2048 <= LDSCTL_OFF, "mLSTM-B LDS map");
__device__ __forceinline__ void ph_mlb(const Frame& F) {
    const int wave = F.wave;
    const float* GB = (const float*)(F.ws + WS_GATES + GO_B); const float* GU = (const float*)(F.ws + WS_GATES + GO_U); const float* GPM = (const float*)(F.ws + WS_GATES + GO_PM);
    const float* MPREV = (const float*)(F.ws + WS_GATES + GO_MPREV);
    LAS unsigned char* buf0 = F.lds; LAS unsigned char* buf1 = F.lds + MLB_PIECE;
    LAS float* nprev = (LAS float*)(F.lds + MLB_OFF_N);
    for (int unit = F.vcu; unit < 512; unit += F.G) {
        int tid = F.tid; asm volatile("" : "+v"(tid));
        const int lane = tid & 63, g = lane >> 4, i = lane & 15;
        const int head = unit >> 7, tc = unit & 127, t0 = tc * 128, j0 = 16 * wave;
        const bf16_t* mkp = WSP(bf16_t, WS_MK) + (size_t)t0 * 1024 + head * 256;
        const bf16_t* mvp = WSP(bf16_t, WS_PROJ) + (size_t)t0 * INP + C_MV + head * 256;
        const int c_f = tc, c_b = 127 - tc;
        u32x4 stg[4];
        const int sr = tid >> 5, sc8 = (tid & 31) * 8;
#define PIECE_LOAD(srcp, pitch_el) do { _Pragma("unroll") for (int q_ = 0; q_ < 4; ++q_) stg[q_] = *(const u32x4*)((srcp) + (size_t)(sr + 16 * q_) * (pitch_el) + sc8); } while (0)
#define PIECE_WRITE(dstbuf, pitchB) do { _Pragma("unroll") for (int q_ = 0; q_ < 4; ++q_) *(LAS u32x4*)((dstbuf) + (sr + 16 * q_) * (pitchB) + sc8 * 2) = stg[q_]; } while (0)
        { const int d = tid >> 8, e = tid & 255; nprev[d * 256 + e] = ((const float*)(F.ws + WS_NST))[(size_t)((d * 4 + head) * 128 + (d ? c_b : c_f)) * 256 + e]; }
        bf16x8 qa[8];
        {   const bf16_t* mq = WSP(bf16_t, WS_MQ) + (size_t)(t0 + j0 + i) * 1024 + head * 256 + 8 * g;
#pragma unroll
            for (int s = 0; s < 8; ++s) qa[s] = *(const bf16x8*)(mq + 32 * s); }
        f32x4 sacc[8];
#pragma unroll
        for (int n = 0; n < 8; ++n) sacc[n] = (f32x4){0.f, 0.f, 0.f, 0.f};
        PIECE_LOAD(mkp, 1024); PIECE_WRITE(buf0, MLB_PKC);
        PIECE_LOAD(mkp + (size_t)64 * 1024, 1024);
        __syncthreads();
#pragma unroll
        for (int n = 0; n < 4; ++n)
            { _Pragma("unroll") for (int s = 0; s < 8; ++s) sacc[n] = MFMA16(qa[s], frag_kc(buf0, MLB_PKC, 16 * n, 32 * s, lane), sacc[n]); __builtin_amdgcn_sched_barrier(0); }
        PIECE_WRITE(buf1, MLB_PKC);
        __syncthreads();
#pragma unroll
        for (int n = 0; n < 4; ++n)
            { _Pragma("unroll") for (int s = 0; s < 8; ++s) sacc[4 + n] = MFMA16(qa[s], frag_kc(buf1, MLB_PKC, 16 * n, 32 * s, lane), sacc[4 + n]); __builtin_amdgcn_sched_barrier(0); }
        const bf16_t* cst0 = WSP(bf16_t, WS_CST) + ((size_t)((0 * 4 + head) * 128 + c_f) << 16);
        const bf16_t* cst1 = WSP(bf16_t, WS_CST) + ((size_t)((1 * 4 + head) * 128 + c_b) << 16);
        PIECE_LOAD(cst0, 256);
        float qsc0, qsc1;
#pragma unroll
        for (int d = 0; d < 2; ++d) {
            const int dh = d * 4 + head; const float mp = MPREV[dh * 128 + (d ? c_b : c_f)];
            f32x4 dacc = (f32x4){0.f, 0.f, 0.f, 0.f};
#pragma unroll
            for (int s = 0; s < 8; ++s) { bf16x8 bn; const LAS float* np = nprev + d * 256 + 32 * s + 8 * g;
#pragma unroll
                for (int e = 0; e < 8; ++e) bn[e] = (i == 0) ? (short)f2bf(np[e]) : (short)0;
                dacc = MFMA16(qa[s], bn, dacc); }
            float ur[8];
#pragma unroll
            for (int n = 0; n < 8; ++n) ur[n] = GU[(size_t)dh * S + t0 + 16 * n + i];
            LAS unsigned char* pw = F.lds + MLB_OFF_P + (d * 8 + wave) * (16 * MLB_PP);
            float es[4];
#pragma unroll
            for (int rg = 0; rg < 4; ++rg) { const int jl = 4 * g + rg, j = j0 + jl;
                const float M = fmaxf(mp, GPM[(size_t)dh * S + t0 + j]), ej = __expf(mp - M), mj = GB[(size_t)dh * S + t0 + j] + M;
                float rs = 0.f;
#pragma unroll
                for (int n = 0; n < 8; ++n) { const int r = 16 * n + i; const bool keep = d ? (r >= j) : (r <= j); rs += keep ? sacc[n][rg] * __expf(ur[n] - M) : 0.f; }
                rs += __shfl_xor(rs, 1); rs += __shfl_xor(rs, 2); rs += __shfl_xor(rs, 4); rs += __shfl_xor(rs, 8);
                const float qn = __shfl(dacc[rg], lane & 48);
                const float den = ej * qn + rs, sj = 1.0f / fmaxf(fabsf(den), __expf(-mj));
                es[rg] = ej * sj;
#pragma unroll
                for (int n = 0; n < 8; ++n) { const int r = 16 * n + i; const bool keep = d ? (r >= j) : (r <= j);
                    const float p = keep ? sacc[n][rg] * __expf(ur[n] - M) * sj : 0.f;
                    *(LAS bf16_t*)(pw + jl * MLB_PP + r * 2) = (bf16_t)f2bf(p); } }
            const int srcl = (i >> 2) << 4;
            const float t0_ = __shfl(es[0], srcl), t1_ = __shfl(es[1], srcl), t2_ = __shfl(es[2], srcl), t3_ = __shfl(es[3], srcl);
            const float qs_ = (i & 3) == 0 ? t0_ : (i & 3) == 1 ? t1_ : (i & 3) == 2 ? t2_ : t3_;
            if (d == 0) qsc0 = qs_; else qsc1 = qs_;
        }
        __syncthreads();
        f32x4 hacc[16];
#pragma unroll
        for (int n = 0; n < 16; ++n) hacc[n] = (f32x4){0.f, 0.f, 0.f, 0.f};
#pragma unroll
        for (int d = 0; d < 2; ++d) {
            const bf16_t* cst = d ? cst1 : cst0; const float qsc = d ? qsc1 : qsc0;
            bf16x8 qs[8];
#pragma unroll
            for (int s = 0; s < 8; ++s) { const u32x4 w = __builtin_bit_cast(u32x4, qa[s]); u32x4 o;
                o.x = pk2(bflo(w.x) * qsc, bfhi(w.x) * qsc); o.y = pk2(bflo(w.y) * qsc, bfhi(w.y) * qsc); o.z = pk2(bflo(w.z) * qsc, bfhi(w.z) * qsc); o.w = pk2(bflo(w.w) * qsc, bfhi(w.w) * qsc);
                qs[s] = __builtin_bit_cast(bf16x8, o); }
#pragma unroll
            for (int cp = 0; cp < 4; ++cp) {
                LAS unsigned char* cur = (cp & 1) ? buf1 : buf0;
                PIECE_WRITE(cur, MLB_PKC);
                if (cp < 3) PIECE_LOAD(cst + (size_t)(64 * (cp + 1)) * 256, 256); else PIECE_LOAD(mvp, INP);
                __syncthreads();
#pragma unroll
                for (int n = 0; n < 4; ++n)
                    { _Pragma("unroll") for (int s = 0; s < 8; ++s) hacc[4 * cp + n] = MFMA16(qs[s], frag_kc(cur, MLB_PKC, 16 * n, 32 * s, lane), hacc[4 * cp + n]); __builtin_amdgcn_sched_barrier(0); }
            }
            LAS const unsigned char* pw = F.lds + MLB_OFF_P + (d * 8 + wave) * (16 * MLB_PP);
#pragma unroll
            for (int vp = 0; vp < 2; ++vp) {
                LAS unsigned char* cur = (vp & 1) ? buf1 : buf0;
                PIECE_WRITE(cur, MLB_PTR);
                if (vp == 0) PIECE_LOAD(mvp + (size_t)64 * INP, INP); else if (d == 0) PIECE_LOAD(cst1, 256);
                __syncthreads();
#pragma unroll
                for (int ks = 0; ks < 2; ++ks) { const bf16x8 a = *(LAS const bf16x8*)(pw + i * MLB_PP + (64 * vp + 32 * ks + 8 * g) * 2);
#pragma unroll
                    for (int n = 0; n < 16; ++n) { hacc[n] = MFMA16(a, frag_tr(cur, MLB_PTR, 32 * ks, 16 * n, lane), hacc[n]); if ((n & 3) == 3) __builtin_amdgcn_sched_barrier(0); } }
            }
            __syncthreads();
        }
        {   const float* mg = FIN(8) + head * 256;
            const bf16_t* mo = WSP(bf16_t, WS_PROJ) + C_MO + head * 256; bf16_t* y = WSP(bf16_t, WS_Y) + 1024 + head * 256;
#pragma unroll
            for (int rg = 0; rg < 4; ++rg) { float ss = 0.f;
#pragma unroll
                for (int n = 0; n < 16; ++n) ss += hacc[n][rg] * hacc[n][rg];
                ss += __shfl_xor(ss, 1); ss += __shfl_xor(ss, 2); ss += __shfl_xor(ss, 4); ss += __shfl_xor(ss, 8);
                const float r = 1.0f / sqrtf(ss * (1.f / 256.f) + EPS); const size_t t = (size_t)(t0 + j0 + 4 * g + rg);
#pragma unroll
                for (int n = 0; n < 16; ++n) { const int col = 16 * n + i; const float o = bflo((unsigned)mo[t * INP + col]);
                    #if defined(DBG_ZERO_ML)
                    y[t * DM + col] = 0;
#else
                    y[t * DM + col] = (bf16_t)f2bf(hacc[n][rg] * r * mg[col] * (1.f / (1.f + __expf(-o))));
#endif
                    } }
        }
#undef PIECE_LOAD
#undef PIECE_WRITE
    }
}

#define MFMA32(a, b, c) __builtin_amdgcn_mfma_f32_32x32x16_bf16((a), (b), (c), 0, 0, 0)
__device__ __forceinline__ int fkey(float x) { const int b = __builtin_bit_cast(int, x); return b ^ ((b >> 31) & 0x7fffffff); }
__device__ __forceinline__ float kval(int k) { return __builtin_bit_cast(float, k ^ ((k >> 31) & 0x7fffffff)); }
#define CE_(a, i, j) { const int hi_ = max(a[i], a[j]); a[j] = min(a[i], a[j]); a[i] = hi_; }
#define SORT16(a) do { CE_(a,0,13) CE_(a,1,12) CE_(a,2,15) CE_(a,3,14) CE_(a,4,8) CE_(a,5,6) CE_(a,7,11) CE_(a,9,10) CE_(a,0,5) CE_(a,1,7) CE_(a,2,9) CE_(a,3,4) CE_(a,6,13) CE_(a,8,14) CE_(a,10,15) CE_(a,11,12) CE_(a,0,1) CE_(a,2,3) CE_(a,4,5) CE_(a,6,8) CE_(a,7,9) CE_(a,10,11) CE_(a,12,13) CE_(a,14,15) CE_(a,0,2) CE_(a,1,3) CE_(a,4,10) CE_(a,5,11) CE_(a,6,7) CE_(a,8,9) CE_(a,12,14) CE_(a,13,15) CE_(a,1,2) CE_(a,3,12) CE_(a,4,6) CE_(a,5,7) CE_(a,8,10) CE_(a,9,11) CE_(a,13,14) CE_(a,1,4) CE_(a,2,6) CE_(a,5,8) CE_(a,7,10) CE_(a,9,13) CE_(a,11,14) CE_(a,2,4) CE_(a,3,6) CE_(a,9,12) CE_(a,11,13) CE_(a,3,5) CE_(a,6,8) CE_(a,7,9) CE_(a,10,12) CE_(a,3,4) CE_(a,5,6) CE_(a,7,8) CE_(a,9,10) CE_(a,11,12) CE_(a,6,7) CE_(a,8,9) } while (0)
#define MERGE16(a, b) do { _Pragma("unroll") for (int k_ = 0; k_ < 16; ++k_) a[k_] = max(a[k_], b[15 - k_]); CE_(a,0,8) CE_(a,1,9) CE_(a,2,10) CE_(a,3,11) CE_(a,4,12) CE_(a,5,13) CE_(a,6,14) CE_(a,7,15) CE_(a,0,4) CE_(a,1,5) CE_(a,2,6) CE_(a,3,7) CE_(a,8,12) CE_(a,9,13) CE_(a,10,14) CE_(a,11,15) CE_(a,0,2) CE_(a,1,3) CE_(a,4,6) CE_(a,5,7) CE_(a,8,10) CE_(a,9,11) CE_(a,12,14) CE_(a,13,15) CE_(a,0,1) CE_(a,2,3) CE_(a,4,5) CE_(a,6,7) CE_(a,8,9) CE_(a,10,11) CE_(a,12,13) CE_(a,14,15) } while (0)
#define TOP_INS(top, x) do { int x_ = (x); _Pragma("unroll") for (int k_ = 0; k_ < 16; ++k_) { const int hi_ = max(top[k_], x_); x_ = min(top[k_], x_); top[k_] = hi_; } } while (0)
__device__ __forceinline__ int pick4(int sel, int a, int b, int c, int d) { return sel == 0 ? a : sel == 1 ? b : sel == 2 ? c : d; }
__device__ __forceinline__ void topk_item(const Frame& F, int layer, int item) {
    const int tile = item >> 3, h = item & 7, lane = F.lane, r32 = lane & 31, hi = lane >> 5;
    const int t = tile * 32 + r32;
    const bf16_t* qrow = WSP(bf16_t, WS_QP) + (size_t)t * DM + h * 256 + 8 * hi;
    int tops[2][16];
#pragma unroll
    for (int p = 0; p < 2; ++p) {
        const bf16_t* keys = WSP(bf16_t, WS_KEYS) + (size_t)(((layer * 8 + h) * 2 + p) * 128) * 128 + 8 * hi;
        bf16x8 bq[8];
#pragma unroll
        for (int s = 0; s < 8; ++s) bq[s] = *(const bf16x8*)(qrow + p * 128 + 16 * s);
        int top[16];
#pragma unroll
        for (int kt = 0; kt < 4; ++kt) {
            f32x16 acc = {};
#pragma unroll
            for (int s = 0; s < 8; ++s) { const bf16x8 a = *(const bf16x8*)(keys + (size_t)(32 * kt + r32) * 128 + 16 * s); acc = MFMA32(a, bq[s], acc); }
            int vals[16];
#pragma unroll
            for (int r = 0; r < 16; ++r) { const int idx = 32 * kt + (r & 3) + 8 * (r >> 2) + 4 * hi; vals[r] = (fkey(acc[r]) & ~127) | idx; }
            SORT16(vals);
            if (kt == 0) {
#pragma unroll
                for (int k = 0; k < 16; ++k) top[k] = vals[k]; }
            else MERGE16(top, vals);
        }
        int pt[16];
#pragma unroll
        for (int k = 0; k < 16; ++k) pt[k] = __shfl_xor(top[k], 32);
        MERGE16(top, pt);
#pragma unroll
        for (int k = 0; k < 16; ++k) tops[p][k] = top[k];
    }
    float af[16], bfv[16];
#pragma unroll
    for (int k = 0; k < 16; ++k) { af[k] = kval(tops[0][k] & ~127); bfv[k] = kval(tops[1][k] & ~127); }
#define CKEY(i, j) ((fkey(af[i] + bfv[j]) & ~255) | (255 - (((i) << 4) | (j))))
    int top2[16], aux[16];
#pragma unroll
    for (int j = 0; j < 16; ++j) top2[j] = CKEY(0, j);
#pragma unroll
    for (int j = 0; j < 16; ++j) aux[j] = j < 8 ? CKEY(1, j) : (int)0x80000000;
    MERGE16(top2, aux);
#pragma unroll
    for (int j = 0; j < 16; ++j) aux[j] = j < 8 ? CKEY(8 + j, 0) : (int)0x80000000;
    MERGE16(top2, aux);
    aux[0] = CKEY(2, 0); aux[1] = CKEY(2, 1); aux[2] = CKEY(2, 2); aux[3] = CKEY(2, 3); aux[4] = CKEY(2, 4); aux[5] = CKEY(3, 0); aux[6] = CKEY(3, 1); aux[7] = CKEY(3, 2);
    aux[8] = CKEY(3, 3); aux[9] = CKEY(4, 0); aux[10] = CKEY(4, 1); aux[11] = CKEY(4, 2); aux[12] = CKEY(5, 0); aux[13] = CKEY(5, 1); aux[14] = CKEY(6, 0); aux[15] = CKEY(6, 1);
    SORT16(aux); MERGE16(top2, aux);
    TOP_INS(top2, CKEY(7, 0)); TOP_INS(top2, CKEY(7, 1));
#undef CKEY
    int pa[4], pb[4];
#pragma unroll
    for (int q = 0; q < 4; ++q) { pa[q] = (tops[0][4 * q] & 127) | ((tops[0][4 * q + 1] & 127) << 8) | ((tops[0][4 * q + 2] & 127) << 16) | ((tops[0][4 * q + 3] & 127) << 24);
                                  pb[q] = (tops[1][4 * q] & 127) | ((tops[1][4 * q + 1] & 127) << 8) | ((tops[1][4 * q + 2] & 127) << 16) | ((tops[1][4 * q + 3] & 127) << 24); }
    int ex[16]; float sc[16];
#pragma unroll
    for (int k = 0; k < 16; ++k) { const int code = 255 - (top2[k] & 255), ii = code >> 4, jj = code & 15;
        const int ea = (pick4(ii >> 2, pa[0], pa[1], pa[2], pa[3]) >> ((ii & 3) * 8)) & 127, eb = (pick4(jj >> 2, pb[0], pb[1], pb[2], pb[3]) >> ((jj & 3) * 8)) & 127;
        ex[k] = ea * 128 + eb; sc[k] = kval(top2[k] & ~255); }
    const float mx = sc[0]; float sum = 0.f;
#pragma unroll
    for (int k = 0; k < 16; ++k) { sc[k] = __expf(sc[k] - mx); sum += sc[k]; }
    const float inv = 1.0f / sum;
    if (hi == 0) { int* d = WSP(int, WS_EIDX) + (size_t)t * 128 + h * 16;
#pragma unroll
        for (int q = 0; q < 4; ++q) *(u32x4*)(d + 4 * q) = (u32x4){(unsigned)ex[4 * q], (unsigned)ex[4 * q + 1], (unsigned)ex[4 * q + 2], (unsigned)ex[4 * q + 3]}; }
    else { float* d = WSP(float, WS_EGATE) + (size_t)t * 128 + h * 16;
#pragma unroll
        for (int q = 0; q < 4; ++q) *(f32x4*)(d + 4 * q) = (f32x4){sc[4 * q] * inv, sc[4 * q + 1] * inv, sc[4 * q + 2] * inv, sc[4 * q + 3] * inv}; }
}
constexpr size_t WS_XH = WS_QB, WS_XL = WS_QB + 16 * MiB;
__device__ __forceinline__ void xq_item2(const Frame& F, int layer, int ta, int tb) {
    const int lane = F.lane;
    const unsigned long long* ssq = (const unsigned long long*)(F.ws + WS_CTL + CTL_SSQ) + (layer ? 2 : 0) * S;
    const float rs[2] = {rstd_of(ssq[ta]) * 16.f, rstd_of(ssq[tb]) * 16.f};
    u32x4 xv[2][4];
#pragma unroll
    for (int z = 0; z < 2; ++z) { const bf16_t* xr = WSP(bf16_t, WS_XN) + (size_t)(z ? tb : ta) * DM + lane * 32;
#pragma unroll
        for (int d = 0; d < 4; ++d) xv[z][d] = *(const u32x4*)(xr + 8 * d); }
#pragma unroll
    for (int z = 0; z < 2; ++z) { unsigned hw[4], lw[4];
#pragma unroll
        for (int d = 0; d < 4; ++d) { const unsigned ww[4] = {xv[z][d].x, xv[z][d].y, xv[z][d].z, xv[z][d].w}; unsigned h = 0u, l = 0u;
#pragma unroll
            for (int e = 0; e < 8; ++e) { const float f = ((e & 1) ? bfhi(ww[e >> 1]) : bflo(ww[e >> 1])) * rs[z];
                const int x8 = (int)fminf(fmaxf(rintf(f), -119.f), 119.f), hi = (x8 + 8) >> 4, lo = x8 - 16 * hi;
                h |= (unsigned)(hi & 15) << (4 * e); l |= (unsigned)(lo & 15) << (4 * e); }
            hw[d] = h; lw[d] = l; }
        const size_t t = (size_t)(z ? tb : ta);
        *(u32x4*)(F.ws + WS_XH + t * 1024 + lane * 16) = (u32x4){hw[0], hw[1], hw[2], hw[3]};
        *(u32x4*)(F.ws + WS_XL + t * 1024 + lane * 16) = (u32x4){lw[0], lw[1], lw[2], lw[3]}; }
}
__device__ __forceinline__ void ph_topk(const Frame& F, int layer) {
    const int gw = F.vcu * NWAVES + F.wave, NGW = F.G * NWAVES;
    for (int it = gw; it < 4096; it += NGW) topk_item(F, layer, it);
    for (int t = gw; t < S; t += 2 * NGW) xq_item2(F, layer, t, t + NGW);
}

typedef __bf16 bf2 __attribute__((ext_vector_type(2)));
__device__ __forceinline__ float dot2bf(bf2 a, unsigned b, float c) { return __builtin_amdgcn_fdot2_f32_bf16(a, __builtin_bit_cast(bf2, b), c, false); }
__device__ __forceinline__ float dot4_fp8(unsigned w, unsigned xlo, unsigned xhi, float c) {
    c = dot2bf(__builtin_amdgcn_cvt_scalef32_pk_bf16_fp8(w, 1.0f, false), xlo, c);
    return dot2bf(__builtin_amdgcn_cvt_scalef32_pk_bf16_fp8(w, 1.0f, true), xhi, c);
}
#if TBL_FP4
constexpr int NSL = 8;
constexpr size_t WS_PART = WS_CST;
constexpr size_t WS_W = WS_KVB;
__device__ __forceinline__ float dot8_fp4(unsigned w, u32x4 x, float c) {
    c = dot2bf(__builtin_amdgcn_cvt_scalef32_pk_bf16_fp4(w, 1.0f, 0), x.x, c); c = dot2bf(__builtin_amdgcn_cvt_scalef32_pk_bf16_fp4(w, 1.0f, 1), x.y, c);
    c = dot2bf(__builtin_amdgcn_cvt_scalef32_pk_bf16_fp4(w, 1.0f, 2), x.z, c); return dot2bf(__builtin_amdgcn_cvt_scalef32_pk_bf16_fp4(w, 1.0f, 3), x.w, c);
}
__device__ __forceinline__ void ph_gu(const Frame& F, int layer) {
    const int lane = F.lane, r8 = lane >> 3, c16 = lane & 7;
    const int nper = F.G >> 3, xl = F.vcu / nper, wx = (F.vcu % nper) * NWAVES + F.wave, nwx = nper * NWAVES;
    const int s = xl;
    const unsigned char* Us = F.ws + WS_UB + (size_t)layer * (16384 * 1024) + (size_t)s * (16384 * 128);
    const unsigned char* eb = F.ws + WS_EIDX; unsigned char* pb = F.ws + WS_PART + (size_t)s * S * 512; const unsigned char* xhb = F.ws + WS_XH + s * 128; const unsigned char* xlb = F.ws + WS_XL + s * 128;
    const unsigned eo = 64u * r8, po = 8u * lane, xo = 16u * c16, uo = 16u * c16;
#define LDU(T, base, off) (*(const T*)((base) + (unsigned)(off)))
    u32x4 ia[2][4];
#pragma unroll
    for (int q = 0; q < 4; ++q) { ia[0][q] = LDU(u32x4, eb, (unsigned)wx * 512u + eo + 16u * q); ia[1][q] = LDU(u32x4, eb, (unsigned)(wx + nwx) * 512u + eo + 16u * q); }
#pragma unroll 1
    for (int t = wx; t < S; t += 2 * nwx) {
        const int t1 = t + nwx;
        u32x4 ur[2][16];
#pragma unroll
        for (int z = 0; z < 2; ++z)
#pragma unroll
            for (int q = 0; q < 16; ++q) { const unsigned id = ia[z][q >> 2][q & 3]; ur[z][q] = LDU(u32x4, Us, id * 128u + uo); }
        { const int tn = (t + 2 * nwx < S) ? t + 2 * nwx : t;
#pragma unroll
          for (int q = 0; q < 4; ++q) { ia[0][q] = LDU(u32x4, eb, (unsigned)tn * 512u + eo + 16u * q); ia[1][q] = LDU(u32x4, eb, (unsigned)(tn + nwx) * 512u + eo + 16u * q); } }
#pragma unroll
        for (int z = 0; z < 2; ++z) {
            const unsigned xoff = (unsigned)(z ? t1 : t) * 1024u + xo; const u32x4 xh = LDU(u32x4, xhb, xoff), xl = LDU(u32x4, xlb, xoff);
            float v[16];
#pragma unroll
            for (int q = 0; q < 16; ++q) { const u32x4 w = ur[z][q]; int ah = 0, al = 0;
                ah = __builtin_amdgcn_sdot8((int)w.x, (int)xh.x, ah, false); al = __builtin_amdgcn_sdot8((int)w.x, (int)xl.x, al, false);
                ah = __builtin_amdgcn_sdot8((int)w.y, (int)xh.y, ah, false); al = __builtin_amdgcn_sdot8((int)w.y, (int)xl.y, al, false);
                ah = __builtin_amdgcn_sdot8((int)w.z, (int)xh.z, ah, false); al = __builtin_amdgcn_sdot8((int)w.z, (int)xl.z, al, false);
                ah = __builtin_amdgcn_sdot8((int)w.w, (int)xh.w, ah, false); al = __builtin_amdgcn_sdot8((int)w.w, (int)xl.w, al, false);
                v[q] = (float)(16 * ah + al); }
            float r8v[8], r4v[4], r2v[2];
            { const bool up = lane & 4;
#pragma unroll
              for (int q = 0; q < 8; ++q) { const float keep = up ? v[q + 8] : v[q], give = up ? v[q] : v[q + 8]; r8v[q] = keep + __shfl_xor(give, 4); } }
            { const bool up = lane & 2;
#pragma unroll
              for (int q = 0; q < 4; ++q) { const float keep = up ? r8v[q + 4] : r8v[q], give = up ? r8v[q] : r8v[q + 4]; r4v[q] = keep + __shfl_xor(give, 2); } }
            { const bool up = lane & 1;
#pragma unroll
              for (int q = 0; q < 2; ++q) { const float keep = up ? r4v[q + 2] : r4v[q], give = up ? r4v[q] : r4v[q + 2]; r2v[q] = keep + __shfl_xor(give, 1); } }
            *(f32x2*)(pb + ((unsigned)(z ? t1 : t) * 512u + po)) = (f32x2){r2v[0], r2v[1]};
        }
    }
}
__device__ __forceinline__ void ph_act(const Frame& F, int layer) {
    const int lane = F.lane, gw = F.vcu * NWAVES + F.wave, NGW = F.G * NWAVES;
    const float* su = (const float*)(F.ws + WS_TSC) + layer * 16384; const float* sv = su + 32768;
    for (int t0 = gw; t0 < S; t0 += 4 * NGW) {
        f32x2 a[4]; u32x2 id[4]; f32x2 g[4];
#pragma unroll
        for (int z = 0; z < 4; ++z) { const int t = t0 + z * NGW;
            id[z] = *(const u32x2*)(WSP(int, WS_EIDX) + (size_t)t * 128 + 2 * lane); g[z] = *(const f32x2*)(WSP(float, WS_EGATE) + (size_t)t * 128 + 2 * lane);
            const float* part = WSP(float, WS_PART) + (size_t)t * 128 + 2 * lane; a[z] = (f32x2){0.f, 0.f};
#pragma unroll
            for (int s = 0; s < NSL; ++s) a[z] += *(const f32x2*)(part + (size_t)s * S * 128); }
        float sx[4][4];
#pragma unroll
        for (int z = 0; z < 4; ++z) { sx[z][0] = su[id[z].x]; sx[z][1] = su[id[z].y]; sx[z][2] = sv[id[z].x]; sx[z][3] = sv[id[z].y]; }
#pragma unroll
        for (int z = 0; z < 4; ++z) { const int t = t0 + z * NGW;
            const float a0 = a[z].x * sx[z][0] * (1.f / 16.f), a1 = a[z].y * sx[z][1] * (1.f / 16.f);
            const float w0 = 0.5f * a0 * (1.f + erff(a0 * 0.70710678118654752f)) * g[z].x * sx[z][2], w1 = 0.5f * a1 * (1.f + erff(a1 * 0.70710678118654752f)) * g[z].y * sx[z][3];
            *(f32x2*)(WSP(float, WS_W) + (size_t)t * 128 + 2 * lane) = (f32x2){w0, w1}; }
    }
}
__device__ __forceinline__ void ph_gv(const Frame& F, int layer) {
    const int lane = F.lane, r8 = lane >> 3, c16 = lane & 7;
    const int nper = F.G >> 3, xl = F.vcu / nper, wx = (F.vcu % nper) * NWAVES + F.wave, nwx = nper * NWAVES;
    const int s = xl;
    const unsigned char* Vs = F.ws + WS_VB + (size_t)layer * (16384 * 1024) + (size_t)s * (16384 * 128);
    const unsigned char* eb = F.ws + WS_EIDX; const unsigned char* wb = F.ws + WS_W; unsigned char* hb = F.ws + WS_XN + s * 512;
    const unsigned eo = 64u * r8, ho = 64u * c16 + 8u * r8, vo = 16u * c16;
    u32x4 ia[2][4];
#pragma unroll
    for (int q = 0; q < 4; ++q) { ia[0][q] = LDU(u32x4, eb, (unsigned)wx * 512u + eo + 16u * q); ia[1][q] = LDU(u32x4, eb, (unsigned)(wx + nwx) * 512u + eo + 16u * q); }
#pragma unroll 1
    for (int t = wx; t < S; t += 2 * nwx) {
        const int t1 = t + nwx;
        u32x4 vr[2][16];
#pragma unroll
        for (int z = 0; z < 2; ++z)
#pragma unroll
            for (int q = 0; q < 16; ++q) { const unsigned id = ia[z][q >> 2][q & 3]; vr[z][q] = LDU(u32x4, Vs, id * 128u + vo); }
        { const int tn = (t + 2 * nwx < S) ? t + 2 * nwx : t;
#pragma unroll
          for (int q = 0; q < 4; ++q) { ia[0][q] = LDU(u32x4, eb, (unsigned)tn * 512u + eo + 16u * q); ia[1][q] = LDU(u32x4, eb, (unsigned)(tn + nwx) * 512u + eo + 16u * q); } }
        f32x4 wqa[2][4]; u32x2 hold[2];
#pragma unroll
        for (int z = 0; z < 2; ++z) { const unsigned tt = (unsigned)(z ? t1 : t);
#pragma unroll
            for (int q = 0; q < 4; ++q) wqa[z][q] = LDU(f32x4, wb, tt * 512u + eo + 16u * q);
            hold[z] = LDU(u32x2, hb, tt * 4096u + ho); }
#pragma unroll
        for (int z = 0; z < 2; ++z) {
            const unsigned tt = (unsigned)(z ? t1 : t);
            f32x2 acc[16];
#pragma unroll
            for (int e = 0; e < 16; ++e) acc[e] = (f32x2){0.f, 0.f};
#pragma unroll
            for (int q = 0; q < 16; ++q) { const float w = wqa[z][q >> 2][q & 3]; const f32x2 ww = {w, w}; const unsigned d4[4] = {vr[z][q].x, vr[z][q].y, vr[z][q].z, vr[z][q].w};
#pragma unroll
                for (int e = 0; e < 4; ++e) { acc[4 * e] += ww * __builtin_amdgcn_cvt_scalef32_pk_f32_fp4(d4[e], 1.0f, 0); acc[4 * e + 1] += ww * __builtin_amdgcn_cvt_scalef32_pk_f32_fp4(d4[e], 1.0f, 1);
                    acc[4 * e + 2] += ww * __builtin_amdgcn_cvt_scalef32_pk_f32_fp4(d4[e], 1.0f, 2); acc[4 * e + 3] += ww * __builtin_amdgcn_cvt_scalef32_pk_f32_fp4(d4[e], 1.0f, 3); } }
            f32x2 b8[8], b4[4], b2[2];
            { const bool up = lane & 32;
#pragma unroll
              for (int e = 0; e < 8; ++e) { const f32x2 keep = up ? acc[e + 8] : acc[e], give = up ? acc[e] : acc[e + 8]; b8[e] = keep + (f32x2){__shfl_xor(give.x, 32), __shfl_xor(give.y, 32)}; } }
            { const bool up = lane & 16;
#pragma unroll
              for (int e = 0; e < 4; ++e) { const f32x2 keep = up ? b8[e + 4] : b8[e], give = up ? b8[e] : b8[e + 4]; b4[e] = keep + (f32x2){__shfl_xor(give.x, 16), __shfl_xor(give.y, 16)}; } }
            { const bool up = lane & 8;
#pragma unroll
              for (int e = 0; e < 2; ++e) { const f32x2 keep = up ? b4[e + 2] : b4[e], give = up ? b4[e] : b4[e + 2]; b2[e] = keep + (f32x2){__shfl_xor(give.x, 8), __shfl_xor(give.y, 8)}; } }
#if defined(DBG_ZERO_PEER)
            b2[0] = (f32x2){0.f, 0.f}; b2[1] = b2[0];
#endif
            const f32x4 hn = (f32x4){bflo(hold[z].x), bfhi(hold[z].x), bflo(hold[z].y), bfhi(hold[z].y)} + (f32x4){b2[0].x, b2[0].y, b2[1].x, b2[1].y};
            u32x2 w; w.x = pk2(hn.x, hn.y); w.y = pk2(hn.z, hn.w); *(u32x2*)(hb + (tt * 4096u + ho)) = w;
            if (layer == 0) {
                const float sq = wave_sum((hn.x * hn.x + hn.y * hn.y) + (hn.z * hn.z + hn.w * hn.w));
                if (lane == 0) atomicAdd((unsigned long long*)(F.ws + WS_CTL + CTL_SSQ) + S + tt, (unsigned long long)(sq * 1048576.0f)); }
        }
    }
}
#else
constexpr int NSL = 16;
constexpr size_t WS_PART = WS_CST;
constexpr size_t WS_W = WS_KVB;
__device__ __forceinline__ void ph_gu(const Frame& F, int layer) {
    const int lane = F.lane, r8 = lane >> 3, c16 = lane & 7;
    const int nper = F.G >> 3, xl = F.vcu / nper, wx = (F.vcu % nper) * NWAVES + F.wave, nwx = nper * NWAVES;
    const unsigned char* U = F.ws + WS_UB + (size_t)layer * 16384 * 2048 + c16 * 16;
    const int* eidx = WSP(int, WS_EIDX) + 16 * r8;
#pragma unroll 1
    for (int p = 0; p < 2; ++p) {
        const int s = xl + 8 * p;
        const unsigned char* Us = U + (size_t)s * (16384 * 128);
        float* part = WSP(float, WS_PART) + (size_t)s * S * 128 + 2 * lane;
        const bf16_t* xs = WSP(bf16_t, WS_XN) + s * 128 + c16 * 16;
        u32x4 ia[2][4];
#pragma unroll
        for (int q = 0; q < 4; ++q) { ia[0][q] = *(const u32x4*)(eidx + (size_t)wx * 128 + 4 * q); ia[1][q] = *(const u32x4*)(eidx + (size_t)(wx + nwx) * 128 + 4 * q); }
#pragma unroll 1
        for (int t = wx; t < S; t += 2 * nwx) {
            const int t1 = t + nwx;
            u32x4 ur[2][16];
#pragma unroll
            for (int z = 0; z < 2; ++z)
#pragma unroll
                for (int q = 0; q < 16; ++q) { const unsigned id = ia[z][q >> 2][q & 3]; ur[z][q] = *(const u32x4*)(Us + (size_t)id * 128); }
            { const int tn = (t + 2 * nwx < S) ? t + 2 * nwx : t;
#pragma unroll
              for (int q = 0; q < 4; ++q) { ia[0][q] = *(const u32x4*)(eidx + (size_t)tn * 128 + 4 * q); ia[1][q] = *(const u32x4*)(eidx + (size_t)(tn + nwx) * 128 + 4 * q); } }
#pragma unroll
            for (int z = 0; z < 2; ++z) {
                const bf16_t* xr = xs + (size_t)(z ? t1 : t) * DM; const u32x4 x0 = *(const u32x4*)xr, x1 = *(const u32x4*)(xr + 8);
                float v[16];
#pragma unroll
                for (int q = 0; q < 16; ++q) { const u32x4 w = ur[z][q]; float a = dot4_fp8(w.x, x0.x, x0.y, 0.f); a = dot4_fp8(w.y, x0.z, x0.w, a); a = dot4_fp8(w.z, x1.x, x1.y, a); v[q] = dot4_fp8(w.w, x1.z, x1.w, a); }
                float r8v[8], r4v[4], r2v[2];
                { const bool up = lane & 4;
#pragma unroll
                  for (int q = 0; q < 8; ++q) { const float keep = up ? v[q + 8] : v[q], give = up ? v[q] : v[q + 8]; r8v[q] = keep + __shfl_xor(give, 4); } }
                { const bool up = lane & 2;
#pragma unroll
                  for (int q = 0; q < 4; ++q) { const float keep = up ? r8v[q + 4] : r8v[q], give = up ? r8v[q] : r8v[q + 4]; r4v[q] = keep + __shfl_xor(give, 2); } }
                { const bool up = lane & 1;
#pragma unroll
                  for (int q = 0; q < 2; ++q) { const float keep = up ? r4v[q + 2] : r4v[q], give = up ? r4v[q] : r4v[q + 2]; r2v[q] = keep + __shfl_xor(give, 1); } }
                *(f32x2*)(part + (size_t)(z ? t1 : t) * 128) = (f32x2){r2v[0], r2v[1]};
            }
        }
    }
}
__device__ __forceinline__ void ph_act(const Frame& F, int layer) {
    const int lane = F.lane, gw = F.vcu * NWAVES + F.wave, NGW = F.G * NWAVES;
    const float* su = (const float*)(F.ws + WS_TSC) + layer * 16384; const float* sv = su + 32768;
    for (int t = gw; t < S; t += NGW) {
        const float* part = WSP(float, WS_PART) + (size_t)t * 128 + 2 * lane;
        f32x2 a = {0.f, 0.f};
#pragma unroll
        for (int s = 0; s < NSL; ++s) a += *(const f32x2*)(part + (size_t)s * S * 128);
        const u32x2 id = *(const u32x2*)(WSP(int, WS_EIDX) + (size_t)t * 128 + 2 * lane); const f32x2 g = *(const f32x2*)(WSP(float, WS_EGATE) + (size_t)t * 128 + 2 * lane);
        const float a0 = a.x * su[id.x], a1 = a.y * su[id.y];
        const float w0 = 0.5f * a0 * (1.f + erff(a0 * 0.70710678118654752f)) * g.x * sv[id.x], w1 = 0.5f * a1 * (1.f + erff(a1 * 0.70710678118654752f)) * g.y * sv[id.y];
        *(f32x2*)(WSP(float, WS_W) + (size_t)t * 128 + 2 * lane) = (f32x2){w0, w1};
    }
}
__device__ __forceinline__ void ph_gv(const Frame& F, int layer) {
    const int lane = F.lane, r8 = lane >> 3, c16 = lane & 7;
    const int nper = F.G >> 3, xl = F.vcu / nper, wx = (F.vcu % nper) * NWAVES + F.wave, nwx = nper * NWAVES;
    const unsigned char* V = F.ws + WS_VB + (size_t)layer * 16384 * 2048 + c16 * 16;
    const int* eidx = WSP(int, WS_EIDX) + 16 * r8; const float* wv = WSP(float, WS_W) + 16 * r8;
#pragma unroll 1
    for (int p = 0; p < 2; ++p) {
        const int s = xl + 8 * p;
        const unsigned char* Vs = V + (size_t)s * (16384 * 128);
        float* hs = WSP(float, WS_H) + s * 128 + 16 * c16 + 2 * r8;
        u32x4 ia[2][4];
#pragma unroll
        for (int q = 0; q < 4; ++q) { ia[0][q] = *(const u32x4*)(eidx + (size_t)wx * 128 + 4 * q); ia[1][q] = *(const u32x4*)(eidx + (size_t)(wx + nwx) * 128 + 4 * q); }
#pragma unroll 1
        for (int t = wx; t < S; t += 2 * nwx) {
            const int t1 = t + nwx;
            u32x4 vr[2][16];
#pragma unroll
            for (int z = 0; z < 2; ++z)
#pragma unroll
                for (int q = 0; q < 16; ++q) { const unsigned id = ia[z][q >> 2][q & 3]; vr[z][q] = *(const u32x4*)(Vs + (size_t)id * 128); }
            { const int tn = (t + 2 * nwx < S) ? t + 2 * nwx : t;
#pragma unroll
              for (int q = 0; q < 4; ++q) { ia[0][q] = *(const u32x4*)(eidx + (size_t)tn * 128 + 4 * q); ia[1][q] = *(const u32x4*)(eidx + (size_t)(tn + nwx) * 128 + 4 * q); } }
            f32x4 wqa[2][4]; f32x2 hold[2];
#pragma unroll
            for (int z = 0; z < 2; ++z) { const size_t tt = (size_t)(z ? t1 : t);
#pragma unroll
                for (int q = 0; q < 4; ++q) wqa[z][q] = *(const f32x4*)(wv + tt * 128 + 4 * q);
                hold[z] = *(const f32x2*)(hs + tt * DM); }
#pragma unroll
            for (int z = 0; z < 2; ++z) {
                const size_t tt = (size_t)(z ? t1 : t);
                f32x4 wq[4];
#pragma unroll
                for (int q = 0; q < 4; ++q) wq[q] = wqa[z][q];
                f32x2 acc[8];
#pragma unroll
                for (int e = 0; e < 8; ++e) acc[e] = (f32x2){0.f, 0.f};
#pragma unroll
                for (int q = 0; q < 16; ++q) { const float w = wq[q >> 2][q & 3]; const f32x2 ww = {w, w}; const unsigned d4[4] = {vr[z][q].x, vr[z][q].y, vr[z][q].z, vr[z][q].w};
#pragma unroll
                    for (int e = 0; e < 4; ++e) { acc[2 * e] += ww * __builtin_amdgcn_cvt_pk_f32_fp8(d4[e], false); acc[2 * e + 1] += ww * __builtin_amdgcn_cvt_pk_f32_fp8(d4[e], true); } }
                f32x2 b4[4], b2[2], b1;
                { const bool up = lane & 32;
#pragma unroll
                  for (int e = 0; e < 4; ++e) { const f32x2 keep = up ? acc[e + 4] : acc[e], give = up ? acc[e] : acc[e + 4]; b4[e] = keep + (f32x2){__shfl_xor(give.x, 32), __shfl_xor(give.y, 32)}; } }
                { const bool up = lane & 16;
#pragma unroll
                  for (int e = 0; e < 2; ++e) { const f32x2 keep = up ? b4[e + 2] : b4[e], give = up ? b4[e] : b4[e + 2]; b2[e] = keep + (f32x2){__shfl_xor(give.x, 16), __shfl_xor(give.y, 16)}; } }
                { const bool up = lane & 8; const f32x2 keep = up ? b2[1] : b2[0], give = up ? b2[0] : b2[1]; b1 = keep + (f32x2){__shfl_xor(give.x, 8), __shfl_xor(give.y, 8)}; }
#if defined(DBG_ZERO_PEER)
                b1 = (f32x2){0.f, 0.f};
#endif
                *(f32x2*)(hs + tt * DM) = hold[z] + b1;
            }
        }
    }
}
#endif
__device__ __forceinline__ void ph_normg(const Frame& F, bool final_layer) {
    const int gw = F.vcu * NWAVES + F.wave, NGW = F.G * NWAVES, lane = F.lane; (void)final_layer;
    const float* g = FIN(16); float* out = FOUT();
    for (int m0 = gw; m0 < S; m0 += 2 * NGW) {
        u32x4 v[2][4]; float s[2] = {0.f, 0.f};
#pragma unroll
        for (int z = 0; z < 2; ++z) { const bf16_t* xr = WSP(bf16_t, WS_XN) + (size_t)(m0 + z * NGW) * DM + lane * 8;
#pragma unroll
            for (int j = 0; j < 4; ++j) v[z][j] = *(const u32x4*)(xr + 512 * j); }
#pragma unroll
        for (int z = 0; z < 2; ++z)
#pragma unroll
            for (int j = 0; j < 4; ++j) { const unsigned ww[4] = {v[z][j].x, v[z][j].y, v[z][j].z, v[z][j].w};
#pragma unroll
                for (int e = 0; e < 4; ++e) s[z] += bflo(ww[e]) * bflo(ww[e]) + bfhi(ww[e]) * bfhi(ww[e]); }
#pragma unroll
        for (int z = 0; z < 2; ++z) { const size_t m = (size_t)(m0 + z * NGW); const float r = 1.0f / sqrtf(wave_sum(s[z]) * (1.f / DM) + EPS);
#pragma unroll
            for (int j = 0; j < 4; ++j) { const int c0 = lane * 8 + 512 * j; const f32x4 g0 = *(const f32x4*)(g + c0), g1 = *(const f32x4*)(g + c0 + 4); const u32x4 x = v[z][j];
                *(f32x4*)(out + m * DM + c0) = (f32x4){bflo(x.x) * r * g0.x, bfhi(x.x) * r * g0.y, bflo(x.y) * r * g0.z, bfhi(x.y) * r * g0.w};
                *(f32x4*)(out + m * DM + c0 + 4) = (f32x4){bflo(x.z) * r * g1.x, bfhi(x.z) * r * g1.y, bflo(x.w) * r * g1.z, bfhi(x.w) * r * g1.w}; } }
    }
}

__device__ __forceinline__ void ph_poolprep(const Frame& F) {
    const int lane = F.lane, gw = F.vcu * NWAVES + F.wave, NGW = F.G * NWAVES;
    const bf16_t* xn = WSP(bf16_t, WS_XN); const unsigned long long* ss = (const unsigned long long*)(F.ws + WS_CTL + CTL_SSQ) + S; const float* g = FIN(1) + DM;
    for (int t = gw; t < S; t += NGW) {
        const int rl = t - 8 + (lane & 15); const float rsl = (rl >= 0 && rl < S) ? rstd_of(ss[rl]) : 0.f;
        float rs[16];
#pragma unroll
        for (int q = 0; q < 16; ++q) rs[q] = __builtin_bit_cast(float, __builtin_amdgcn_readlane(__builtin_bit_cast(int, rsl), q));
        u32x4 o4[4];
#pragma unroll
        for (int j = 0; j < 4; ++j) {
            const int half = 1 << j, lo = max(t - half, 0), hi = min(t + half, S), c0 = (lane + 64 * j) * 8;
            u32x4 xr[16];
#pragma unroll
            for (int q = 0; q < 16; ++q) if (q < 2 * half) { const int r = t - half + q; xr[q] = (r >= 0 && r < S) ? *(const u32x4*)(xn + (size_t)r * DM + c0) : (u32x4){0u, 0u, 0u, 0u}; }
            float a[8];
#pragma unroll
            for (int q = 0; q < 8; ++q) a[q] = 0.f;
#pragma unroll
            for (int q = 0; q < 16; ++q) if (q < 2 * half) { const u32x4 x = xr[q]; const float r1 = rs[8 - half + q];
                a[0] += bflo(x.x) * r1; a[1] += bfhi(x.x) * r1; a[2] += bflo(x.y) * r1; a[3] += bfhi(x.y) * r1; a[4] += bflo(x.z) * r1; a[5] += bfhi(x.z) * r1; a[6] += bflo(x.w) * r1; a[7] += bfhi(x.w) * r1; }
            const u32x4 x = xr[half]; const float ic = 1.0f / (float)(hi - lo), rt = rs[8];
            const f32x4 g0 = *(const f32x4*)(g + c0), g1 = *(const f32x4*)(g + c0 + 4);
            o4[j].x = pk2((a[0] * ic - bflo(x.x) * rt) * g0.x, (a[1] * ic - bfhi(x.x) * rt) * g0.y); o4[j].y = pk2((a[2] * ic - bflo(x.y) * rt) * g0.z, (a[3] * ic - bfhi(x.y) * rt) * g0.w);
            o4[j].z = pk2((a[4] * ic - bflo(x.z) * rt) * g1.x, (a[5] * ic - bfhi(x.z) * rt) * g1.y); o4[j].w = pk2((a[6] * ic - bflo(x.w) * rt) * g1.z, (a[7] * ic - bfhi(x.w) * rt) * g1.w);
        }
#pragma unroll
        for (int j = 0; j < 4; ++j) *(u32x4*)(WSP(bf16_t, WS_POOLED) + (size_t)t * DM + (lane + 64 * j) * 8) = o4[j];
    }
}
__device__ __forceinline__ void ph_norm(const Frame& F, int layer) {
    const int gw = F.vcu * NWAVES + F.wave, NGW = F.G * NWAVES;
    for (int m = gw; m < S; m += NGW) rms_row_to_bf16(WSP(float, WS_H) + (size_t)m * DM, FIN(2) + layer * DM, WSP(bf16_t, WS_XN) + (size_t)m * DM, F.lane);
}


__device__ __forceinline__ void ph_attn(const Frame& F) {
    const int nunits = 8 * 64;
    float gq = fabsf(FIN(6)[F.lane]), gk = fabsf(FIN(7)[F.lane]); gq = fmaxf(gq, fabsf(FIN(6)[64 + F.lane])); gk = fmaxf(gk, fabsf(FIN(7)[64 + F.lane]));
#pragma unroll
    for (int o = 1; o < 64; o <<= 1) { gq = fmaxf(gq, __shfl_xor(gq, o)); gk = fmaxf(gk, __shfl_xor(gk, o)); }
    const float mC = -fminf(11.313708498984761f * gq * gk * 1.01f, 60.f) * 1.4426950408889634f;
    for (int u = F.vcu * 2; u < nunits; u += F.G * 2)
#pragma unroll 1
        for (int k = 0; k < 2; ++k) { const int unit = u + k, head = unit >> 6, qb = unit & 63, kvh = head >> 2;
            att::attn_dense_body<att::bf16>(WSP(att::bf16, WS_QB) + (size_t)(qb * 256) * 1024 + head * 128, WSP(att::bf16, WS_KVB) + kvh * 128, WSP(att::bf16, WS_KVB) + 256 + kvh * 128,
                                 WSP(att::bf16, WS_Y) + (size_t)(qb * 256) * DM + head * 128, S, F.ldsg, mC); }
}

#if defined(DBG_ATTN_CHECK)
constexpr int CW_DBG = 2048;
__device__ __forceinline__ void dbg_attn_check(const Frame& F) {
    __syncthreads();
    LAS float* sc = (LAS float*)F.lds; LAS float* red = sc + 16384; LAS float* po = red + 64;
    const int tid = F.tid, lane = F.lane, wave = F.wave;
    for (int chk = 0; chk < 4; ++chk) {
        const int unit = F.vcu * 2 + (chk & 1), head = unit >> 6, qb = unit & 63, kvh = head >> 2;
        const int t = qb * 256 + ((F.vcu * 37 + chk * 101 + 5) & 255);
        const bf16_t* q = WSP(bf16_t, WS_QB) + (size_t)t * 1024 + head * 128; const bf16_t* K = WSP(bf16_t, WS_KVB) + kvh * 128; const bf16_t* V = WSP(bf16_t, WS_KVB) + 256 + kvh * 128;
        float mx = -1e30f;
        for (int j = 0; j < 32; ++j) { const int key = tid + 512 * j; float s = 0.f;
            for (int d = 0; d < 128; ++d) s += bflo((unsigned)q[d]) * bflo((unsigned)K[(size_t)key * 512 + d]);
            s *= 0.088388347648318440f; sc[key] = s; mx = fmaxf(mx, s); }
        for (int o = 1; o < 64; o <<= 1) mx = fmaxf(mx, __shfl_xor(mx, o));
        if (lane == 0) red[wave] = mx;
        __syncthreads();
        mx = red[0]; for (int w = 1; w < 8; ++w) mx = fmaxf(mx, red[w]);
        __syncthreads();
        float sm = 0.f;
        for (int j = 0; j < 32; ++j) { const int key = tid + 512 * j; const float p = expf(sc[key] - mx); sc[key] = p; sm += p; }
        sm = wave_sum(sm);
        if (lane == 0) red[8 + wave] = sm;
        __syncthreads();
        sm = 0.f; for (int w = 0; w < 8; ++w) sm += red[8 + w];
        const int d = tid & 127, part = tid >> 7; float acc = 0.f;
        for (int kk = 0; kk < 4096; ++kk) { const int key = part * 4096 + kk; acc += sc[key] * bflo((unsigned)V[(size_t)key * 512 + d]); }
        po[part * 128 + d] = acc;
        __syncthreads();
        if (tid < 128) { const float o = (po[d] + po[128 + d] + po[256 + d] + po[384 + d]) / sm;
            const float y = bflo((unsigned)WSP(bf16_t, WS_Y)[(size_t)t * DM + head * 128 + d]);
            float ma = fabsf(o); for (int x = 1; x < 64; x <<= 1) ma = fmaxf(ma, __shfl_xor(ma, x));
            if (lane == 0) red[16 + wave] = ma;
            asm volatile("s_waitcnt lgkmcnt(0)" ::: "memory");
            const float mall = fmaxf(red[16], red[17]);
            const float mown = red[16 + wave]; (void)mall;
            const bool bad = !(fabsf(o - y) <= 0.03f * mown + 1e-5f);
            if (bad) atomicAdd((unsigned*)(F.ws + WS_CTL) + CW_DBG, 1u); }
        __syncthreads();
    }
}
#endif
#if defined(PROBE_MX)
typedef int v8i32p __attribute__((ext_vector_type(8)));
__device__ __forceinline__ unsigned probe_mx(int lane, int ra, int rb) {
    const int i = lane & 15, g = lane >> 4;
    v8i32p A = {0, 0, 0, 0, 0, 0, 0, 0}, B = {0, 0, 0, 0, 0, 0, 0, 0};
    if (g == PROBE_MX_G && i < 6) { const int j0 = (i == 0 ? 1 : i == 1 ? 2 : i == 2 ? 4 : i == 3 ? 8 : i == 4 ? 16 : 0);
#pragma unroll
        for (int d = 0; d < 4; ++d) if ((j0 >> 3) == d) A[d] = 0x2 << (4 * (j0 & 7)); }
    if (g == PROBE_MX_GB) {
#pragma unroll
        for (int d = 0; d < 8; ++d) { unsigned w = 0;
#pragma unroll
            for (int bb = 0; bb < 4; ++bb) { const int b = 4 * d + bb; const unsigned code = (unsigned)(((7 + (b >> 3)) << 3) | (b & 7)); w |= code << (8 * bb); }
            B[d] = (int)w; } }

    f32x4 c = {0.f, 0.f, 0.f, 0.f};
    c = __builtin_amdgcn_mfma_scale_f32_16x16x128_f8f6f4(A, B, c, 4, 0, 0, 0x7f7f7f7f, 0, 0x7f7f7f7f);
    float va = 0.f, vb = 0.f;
#pragma unroll
    for (int r = 0; r < 4; ++r) { const float x = __shfl(c[r], 16 * (ra >> 2)); if ((ra & 3) == r) va = x; const float y = __shfl(c[r], 16 * (rb >> 2)); if ((rb & 3) == r) vb = y; }
    auto dec = [](float v) -> unsigned { if (!(v >= 1.f)) return 33u; int e = 0; while (v >= 2.f && e < 8) { v *= 0.5f; ++e; } return (unsigned)(e * 8) + (unsigned)((v - 1.f) * 8.f + 0.5f); };
    return dec(va) + 40u * dec(vb);
}
#endif
#ifndef PHASE_MASK
#define PHASE_MASK 0x3ffff
#endif
#define PH_ON(k) (((PHASE_MASK) >> (k)) & 1)
struct Args { const float* in[17]; float* out; unsigned char* ws; int ph_lo, ph_hi; };
static_assert(sizeof(Args) == 17 * 8 + 8 + 8 + 8, "Args has no padding");
__global__ void __launch_bounds__(NTHR, 2) fwd_kernel(Args args) {
    extern __shared__ __attribute__((aligned(16))) unsigned char lds[];
    Frame F;
    F.lds = (LAS unsigned char*)lds; F.ldsg = (char*)lds;
    F.tid = threadIdx.x; F.lane = F.tid & 63; F.wave = __builtin_amdgcn_readfirstlane(F.tid >> 6);
    F.G = gridDim.x; { const int bx = blockIdx.x; F.vcu = (F.G % 8 == 0) ? (bx % 8) * (F.G / 8) + bx / 8 : bx; }
    F.ws = args.ws;
    volatile LAS unsigned* MISC = (volatile LAS unsigned*)(F.lds + LDSCTL_OFF);
    if (F.tid < 16) ((LAS unsigned*)(F.lds + LDSCTL_OFF))[F.tid] = 0u;
    if (F.tid >= 64 && F.tid < 64 + 36) ((LAS unsigned*)(F.lds + LDSCTL_OFF + 64))[F.tid - 64] = ((const unsigned*)&args)[F.tid - 64];
    __syncthreads();
    const int lo = args.ph_lo, hi = args.ph_hi;
    XcdBarrier bar; bar.bar = (unsigned*)(F.ws + WS_CTL) + CW_BAR; bar.x = 0; bar.st = nullptr;
    if (hi - lo > 1) bar = xcd_barrier_post((unsigned*)(F.ws + WS_CTL) + CW_BAR, MISC + 8);
#if defined(PROBE_BAR)
    unsigned long long tbar_total = 0;
#endif
#pragma unroll 1
    for (int ph = lo; ph < hi; ++ph) {
#if defined(PROBE_BAR)
        if (ph > lo) { const unsigned long long tb0 = __builtin_amdgcn_s_memrealtime(); xcd_barrier(bar); if (PROBE_BAR == 100 || ph == PROBE_BAR) tbar_total += __builtin_amdgcn_s_memrealtime() - tb0; }
#else
        if (ph > lo) xcd_barrier(bar);
#endif
#if defined(PROBE_PH)
        unsigned long long tprobe0 = 0; if (ph == PROBE_PH) tprobe0 = __builtin_amdgcn_s_memrealtime();
        if (ph == PROBE_PH + 1 || (PROBE_PH == NPH - 1 && false)) { }
#endif
        switch (ph) {
#define PHM(n) do { asm volatile("; PHASE_MARK " #n ::: "memory"); int t_ = threadIdx.x; asm volatile("" : "+v"(t_)); F.tid = t_; F.lane = t_ & 63; F.wave = __builtin_amdgcn_readfirstlane(t_ >> 6); \
    unsigned long long z_ = 0; asm volatile("" : "+s"(z_)); F.ws = args.ws + z_; } while (0)
        case PH_PRO: if constexpr (PH_ON(PH_PRO)) { PHM(PH_PRO); ph_prologue(F); } break;
        case PH_GEMM_IN: if constexpr (PH_ON(PH_GEMM_IN)) { PHM(PH_GEMM_IN);  pg8::Gemm g{WSP(bf16_t, WS_XN), WSP(bf16_t, WS_WIN), S, INP, DM, DM, DM, 0, 0}; pg8::StaticOrder So; So.init(S, INP, F.G, (int)blockIdx.x);
            pg8::EpiBf16<0> E{WSP(bf16_t, WS_PROJ), INP, nullptr, 0, 0, 1.f};
            pg8::gemm_phase<pg8::EpiBf16<0>, pg8::StaticOrder, true, true>(F.lds, g, So, E); } break;
        case PH_POST: if constexpr (PH_ON(PH_POST)) { PHM(PH_POST); ph_post(F); } break;
        case PH_ATTN: if constexpr (PH_ON(PH_ATTN)) { PHM(PH_ATTN); ph_attn(F); ph_mla(F);
#if defined(DBG_ATTN_CHECK)
            dbg_attn_check(F);
#endif
            } break;
        case PH_SCAN: if constexpr (PH_ON(PH_SCAN)) { PHM(PH_SCAN); ph_scan(F); } break;
        case PH_MLB: if constexpr (PH_ON(PH_MLB)) { PHM(PH_MLB); ph_mlb(F); } break;
        case PH_GEMM_OUT: if constexpr (PH_ON(PH_GEMM_OUT)) { PHM(PH_GEMM_OUT);  pg8::Gemm g{WSP(bf16_t, WS_Y), WSP(bf16_t, WS_WOUT), S, DM, DM, DM, DM, 0, 0}; pg8::StaticOrder So; So.init(S, DM, F.G, (int)blockIdx.x);
            pg8::EpiRes<false> E{FIN(0), WSP(bf16_t, WS_XN), DM, nullptr, (unsigned long long*)(F.ws + WS_CTL + CTL_SSQ)};
            pg8::gemm_phase<pg8::EpiRes<false>, pg8::StaticOrder, true, true>(F.lds, g, So, E); } break;
        case PH_GEMM_Q0: case PH_GEMM_Q1: if constexpr (PH_ON(PH_GEMM_Q0)) { PHM(PH_GEMM_Q0);  pg8::Gemm g{WSP(bf16_t, WS_XN), WSP(bf16_t, ph == PH_GEMM_Q0 ? WS_WQ0 : WS_WQ1), S, DM, DM, DM, DM, 0, 0}; pg8::StaticOrder So; So.init(S, DM, F.G, (int)blockIdx.x);
            pg8::EpiBf16Row E{WSP(bf16_t, WS_QP), DM, (const unsigned long long*)(F.ws + WS_CTL + CTL_SSQ) + (ph == PH_GEMM_Q0 ? 0 : 2 * S), 1.0f / DM, EPS};
            pg8::gemm_phase<pg8::EpiBf16Row, pg8::StaticOrder, true, true>(F.lds, g, So, E);
            asm volatile("s_waitcnt vmcnt(0)" ::: "memory"); __syncthreads(); __builtin_amdgcn_fence(__ATOMIC_ACQUIRE, "agent"); asm volatile("s_waitcnt vmcnt(0)" ::: "memory");
            { const int layer = (ph == PH_GEMM_Q0) ? 0 : 1; pg8::Unit u;
              for (int i = 0; So.next(i, u); ++i) topk_item(F, layer, (u.pm * 8 + F.wave) * 8 + u.pn);
              const int gw = F.vcu * NWAVES + F.wave, NGW = F.G * NWAVES;
              for (int t = gw; t < S; t += 2 * NGW) xq_item2(F, layer, t, t + NGW); } } break;
        case PH_GU0: if constexpr (PH_ON(PH_GU0)) { PHM(PH_GU0); ph_gu(F, 0); } break;
        case PH_GU1: if constexpr (PH_ON(PH_GU1)) { PHM(PH_GU1); ph_gu(F, 1); } break;
        case PH_ACT0: if constexpr (PH_ON(PH_ACT0)) { PHM(PH_ACT0); ph_act(F, 0); } break;
        case PH_ACT1: if constexpr (PH_ON(PH_ACT1)) { PHM(PH_ACT1); ph_act(F, 1); } break;
        case PH_GV0: if constexpr (PH_ON(PH_GV0)) { PHM(PH_GV0); ph_gv(F, 0); } break;
        case PH_GV1: if constexpr (PH_ON(PH_GV1)) { PHM(PH_GV1); ph_gv(F, 1); } break;
        case PH_NORMF: if constexpr (PH_ON(PH_NORMF)) { PHM(PH_NORMF); ph_normg(F, true);
#if defined(DBG_ATTN_CHECK)
            { const unsigned nb = __hip_atomic_load((unsigned*)(F.ws + WS_CTL) + CW_DBG, __ATOMIC_RELAXED, __HIP_MEMORY_SCOPE_AGENT);
              if (nb != 0u) { float* o = FOUT(); for (int i = F.vcu * NTHR + F.tid; i < 4096; i += F.G * NTHR) o[(size_t)i * 8192 + 7] += (DBG_ATTN_CHECK == 2 ? 0.f : 1000.f); } }
#endif
            } break;
        case PH_POOLPREP: if constexpr (PH_ON(PH_POOLPREP)) { PHM(PH_POOLPREP); ph_poolprep(F); } break;
        case PH_GEMM_POOL: if constexpr (PH_ON(PH_GEMM_POOL)) { PHM(PH_GEMM_POOL);  pg8::Gemm g{WSP(bf16_t, WS_POOLED), WSP(bf16_t, WS_WPOOL), S, DM, 512, DM, 512, 1, 512 * 2}; pg8::StaticOrder So; So.init(S, DM, F.G, (int)blockIdx.x);
            pg8::EpiRes<true> E{WSP(bf16_t, WS_XN), WSP(bf16_t, WS_XN), DM, FIN(11), (unsigned long long*)(F.ws + WS_CTL + CTL_SSQ) + 2 * S};
            pg8::gemm_phase<pg8::EpiRes<true>, pg8::StaticOrder, true, true>(F.lds, g, So, E); } break;
        default: break;
        }
#if defined(PROBE_BAR)
        if (ph == hi - 1 && F.vcu == PROBE_BAR_VCU) { __syncthreads(); const unsigned long long t1 = __builtin_amdgcn_s_memrealtime(); while (__builtin_amdgcn_s_memrealtime() - t1 < 16ull * tbar_total) __builtin_amdgcn_s_sleep(8); }
#endif
#if defined(PROBE_PH)
#ifndef PROBE_VCU
#define PROBE_VCU -1
#endif
        if (ph == PROBE_PH && (PROBE_VCU < 0 || F.vcu == PROBE_VCU)) { __syncthreads(); const unsigned long long t1 = __builtin_amdgcn_s_memrealtime(), dt = t1 - tprobe0;
            while (__builtin_amdgcn_s_memrealtime() - t1 < 4ull * dt) __builtin_amdgcn_s_sleep(8); }
#endif
    }
}

#if defined(PROBE_MX)
__global__ void __launch_bounds__(64) probe_mx_kernel(int dummy) {
    const unsigned code = probe_mx((int)threadIdx.x, PROBE_MX_RA, PROBE_MX_RB); const unsigned long long t1 = __builtin_amdgcn_s_memrealtime();
    while (__builtin_amdgcn_s_memrealtime() - t1 < 1000ull * code + (unsigned long long)dummy) __builtin_amdgcn_s_sleep(8);
}
#endif
#ifndef N_LAUNCH_MODE
#define N_LAUNCH_MODE 1
#endif
extern "C" void kernel_launch(void* const* d_in, const int* in_sizes, int n_in, void* d_out, int out_size, void* d_ws, size_t ws_size, hipStream_t stream) {
    static int grid = 0;
    if (grid == 0) {
        if (n_in != 17 || in_sizes[0] != S * DM || out_size != S * DM || ws_size < WS_END) { fprintf(stderr, "kernel_launch: unexpected shapes (n_in %d, in0 %d, out %d, ws %zu; need ws >= %zu)\n", n_in, n_in > 0 ? in_sizes[0] : -1, out_size, ws_size, (size_t)WS_END); grid = -1; return; }
        int dev = 0, cus = 0;
        if (hipGetDevice(&dev) != hipSuccess || hipDeviceGetAttribute(&cus, hipDeviceAttributeMultiprocessorCount, dev) != hipSuccess) { grid = -1; return; }
        if (hipFuncSetAttribute((const void*)fwd_kernel, hipFuncAttributeMaxDynamicSharedMemorySize, LDS_BYTES) != hipSuccess) { fprintf(stderr, "kernel_launch: hipFuncSetAttribute failed\n"); grid = -1; return; }
        int per_cu = 0;
        if (hipOccupancyMaxActiveBlocksPerMultiprocessor(&per_cu, (const void*)fwd_kernel, NTHR, LDS_BYTES) != hipSuccess || per_cu < 1) fprintf(stderr, "kernel_launch: occupancy query reports %d\n", per_cu);
        (void)hipGetLastError();
        grid = cus;
        if (grid != 256) { fprintf(stderr, "kernel_launch: built for a 256-CU device (got %d CUs)\n", grid); grid = -1; return; }
    }
    if (grid < 0) return;
    (void)hipMemsetAsync((char*)d_ws + WS_CTL, 0, CTL_ZERO_BYTES, stream);
    Args a{};
    for (int i = 0; i < 17; ++i) a.in[i] = (const float*)d_in[i];
    a.out = (float*)d_out; a.ws = (unsigned char*)d_ws;
#if N_LAUNCH_MODE == 1
    a.ph_lo = 0; a.ph_hi = NPH;
    hipLaunchKernelGGL(fwd_kernel, dim3(grid), dim3(NTHR), LDS_BYTES, stream, a);
#else
    for (int ph = 0; ph < NPH; ++ph) { a.ph_lo = ph; a.ph_hi = ph + 1; hipLaunchKernelGGL(fwd_kernel, dim3(grid), dim3(NTHR), LDS_BYTES, stream, a); }
#endif
#if defined(PROBE_MX)
    hipLaunchKernelGGL(probe_mx_kernel, dim3(1), dim3(64), 0, stream, 0);
#endif
    const hipError_t le = hipPeekAtLastError();
    if (le != hipSuccess) fprintf(stderr, "kernel_launch: launch failed: %s\n", hipGetErrorName(le));
}
```
